# Optimizing an MI355X kernel written in HIP

```python
import jax, jax.numpy as jnp
from jax import lax
import numpy as np

D_MODEL = 1024
BATCH = 8
SEQ = 2048
DEPTH = 1

D_CONV = D_MODEL // 2
CONV_WIDTH = 31
M_INNER = D_MODEL // 2
M_HEADS = 4
M_HEAD_DIM = M_INNER // M_HEADS
QK_CONV_WIDTH = 4
CHUNK = 64
N_GROUPS = 4
E_PER_GROUP = 8
N_EXPERTS = N_GROUPS * E_PER_GROUP
TOP_K = 2
D_EXPERT = D_MODEL // 2
EXPERT_ROWS = 128
RMS_EPS = 1e-6
LN_EPS = 1e-5
IN_WIDTHS = (D_CONV, D_CONV, M_INNER, M_INNER, M_INNER, M_INNER, M_HEADS, M_HEADS, D_MODEL, D_MODEL)
D_IN = 2 * D_CONV + 4 * M_INNER + 2 * M_HEADS + 2 * D_MODEL

kernel_name = "hybrid_conformer_mlstm_hmoe_adaln"


def rmsnorm(x, g):
    xf = x.astype(jnp.float32)
    y = xf * lax.rsqrt(jnp.mean(xf * xf, axis=-1, keepdims=True) + RMS_EPS)
    return (y * g.astype(jnp.float32)).astype(x.dtype)


def layernorm(x, g, b):
    xf = x.astype(jnp.float32)
    mu = jnp.mean(xf, axis=-1, keepdims=True)
    var = jnp.mean(jnp.square(xf - mu), axis=-1, keepdims=True)
    y = (xf - mu) * lax.rsqrt(var + LN_EPS)
    return (y * g.astype(jnp.float32) + b.astype(jnp.float32)).astype(x.dtype)


def modulate(h, shift, scale):
    return h * (1 + scale[:, None, :]) + shift[:, None, :]


def causal_dwconv(u, w, b):
    width = w.shape[0]
    y = lax.conv_general_dilated(
        u, w.astype(u.dtype)[:, None, :], window_strides=(1,), padding=[(width - 1, 0)],
        dimension_numbers=("NWC", "WIO", "NWC"), feature_group_count=u.shape[-1])
    return y + b.astype(u.dtype)


def mlstm_chunkwise(q, k, v, i_pre, f_pre):
    B, S, NH, DH = q.shape
    NC = S // CHUNK
    q = q * (DH ** -0.5)
    lf = jax.nn.log_sigmoid(f_pre)
    li = i_pre

    def to_chunks(a):
        return a.reshape(B, NC, CHUNK, NH, DH).transpose(1, 0, 3, 2, 4)

    def gates_to_chunks(a):
        return a.reshape(B, NC, CHUNK, NH).transpose(1, 0, 3, 2)

    causal = jnp.tril(jnp.ones((CHUNK, CHUNK), dtype=bool))

    def step(carry, xs):
        C, n, m = carry
        qc, kc, vc, lic, lfc = xs
        bcum = jnp.cumsum(lfc, axis=-1)
        dmat = bcum[..., :, None] - bcum[..., None, :] + lic[..., None, :]
        dmat = jnp.where(causal, dmat, -jnp.inf)
        inter = bcum + m[..., None]
        m_t = jnp.maximum(jnp.max(dmat, axis=-1), inter)
        wts = jnp.exp(dmat - m_t[..., None])
        s_inter = jnp.exp(inter - m_t)
        qk = jnp.einsum("bhtd,bhsd->bhts", qc, kc) * wts
        num = jnp.einsum("bhts,bhsd->bhtd", qk, vc) + s_inter[..., None] * jnp.einsum("bhtd,bhde->bhte", qc, C)
        den = jnp.sum(qk, axis=-1) + s_inter * jnp.einsum("bhtd,bhd->bht", qc, n)
        h = num / jnp.maximum(jnp.abs(den), jnp.exp(-m_t))[..., None]
        b_last = bcum[..., -1]
        a = b_last[..., None] - bcum + lic
        m_new = jnp.maximum(b_last + m, jnp.max(a, axis=-1))
        wk = jnp.exp(a - m_new[..., None])
        sc = jnp.exp(b_last + m - m_new)
        C_new = sc[..., None, None] * C + jnp.einsum("bhs,bhsd,bhse->bhde", wk, kc, vc)
        n_new = sc[..., None] * n + jnp.einsum("bhs,bhsd->bhd", wk, kc)
        return (C_new, n_new, m_new), h

    init = (jnp.zeros((B, NH, DH, DH), jnp.float32),
            jnp.zeros((B, NH, DH), jnp.float32),
            jnp.zeros((B, NH), jnp.float32))
    xs = (to_chunks(q), to_chunks(k), to_chunks(v), gates_to_chunks(li), gates_to_chunks(lf))
    _, h = lax.scan(step, init, xs)
    return h.transpose(1, 0, 3, 2, 4).reshape(B, S, NH, DH)


def hybrid_mixer(h, w_in, b_if, conv_dw_w, conv_dw_b, conv_ln_g, conv_ln_b, w_conv_out,
                 qk_conv_w, qk_conv_b, m_norm_g, w_m_out, w_out):
    B, S, _ = h.shape
    z = h @ w_in
    offs = np.cumsum(IN_WIDTHS)[:-1].tolist()
    glu_a, glu_b, q, k, v, o, i_pre, f_pre, g_a, g_b = jnp.split(z, offs, axis=-1)

    u = glu_a * jax.nn.sigmoid(glu_b)
    u = causal_dwconv(u, conv_dw_w, conv_dw_b)
    u = jax.nn.silu(layernorm(u, conv_ln_g, conv_ln_b))
    y_a = u @ w_conv_out

    qk = jax.nn.silu(causal_dwconv(jnp.concatenate([q, k], axis=-1), qk_conv_w, qk_conv_b))
    q, k = jnp.split(qk, 2, axis=-1)
    heads = lambda a: a.astype(jnp.float32).reshape(B, S, M_HEADS, M_HEAD_DIM)
    bif = b_if.astype(jnp.float32)
    i_g = i_pre.astype(jnp.float32) + bif[:M_HEADS]
    f_g = f_pre.astype(jnp.float32) + bif[M_HEADS:]
    hm = mlstm_chunkwise(heads(q), heads(k), heads(v), i_g, f_g)
    mu = jnp.mean(hm, axis=-1, keepdims=True)
    var = jnp.mean(jnp.square(hm - mu), axis=-1, keepdims=True)
    hm = (hm - mu) * lax.rsqrt(var + LN_EPS) * m_norm_g.astype(jnp.float32).reshape(M_HEADS, M_HEAD_DIM)
    hm = hm * jax.nn.sigmoid(heads(o))
    y_b = hm.reshape(B, S, M_INNER).astype(h.dtype) @ w_m_out

    merged = jax.nn.sigmoid(g_a) * y_a + jax.nn.sigmoid(g_b) * y_b
    return merged @ w_out


def hierarchical_moe(h, w_rg, b_rg, w_re, b_re, w_e_gate, w_e_up, w_e_down):
    T, D = h.shape
    hf = h.astype(jnp.float32)
    p_grp = jax.nn.softmax(hf @ w_rg.astype(jnp.float32) + b_rg.astype(jnp.float32), axis=-1)
    g_sel = jnp.argmax(p_grp, axis=-1)
    p_g = jnp.take_along_axis(p_grp, g_sel[:, None], axis=-1)
    le = (hf @ w_re.astype(jnp.float32) + b_re.astype(jnp.float32)).reshape(T, N_GROUPS, E_PER_GROUP)
    le_sel = jnp.take_along_axis(le, g_sel[:, None, None], axis=1)[:, 0]
    top_p, top_e = lax.top_k(jax.nn.softmax(le_sel, axis=-1), TOP_K)
    w_tok = p_g * top_p / jnp.sum(top_p, axis=-1, keepdims=True)
    e_idx = g_sel[:, None] * E_PER_GROUP + top_e

    A = T * TOP_K
    e_flat = e_idx.reshape(A).astype(jnp.int32)
    w_flat = w_tok.reshape(A)
    tok = jnp.arange(A, dtype=jnp.int32) // TOP_K
    order = jnp.argsort(e_flat)
    e_sorted = e_flat[order]
    tok_sorted = tok[order]
    counts = jnp.bincount(e_flat, length=N_EXPERTS)
    padded = (counts + EXPERT_ROWS - 1) // EXPERT_ROWS * EXPERT_ROWS
    starts = jnp.cumsum(counts) - counts
    pends = jnp.cumsum(padded)
    pstarts = pends - padded
    dest = pstarts[e_sorted] + jnp.arange(A, dtype=jnp.int32) - starts[e_sorted]
    n_groups_rows = -(-(A + N_EXPERTS * (EXPERT_ROWS - 1)) // EXPERT_ROWS)
    P = n_groups_rows * EXPERT_ROWS
    xs = jnp.zeros((P, D), h.dtype).at[dest].set(h[tok_sorted])
    grp_e = jnp.minimum(jnp.searchsorted(pends, jnp.arange(n_groups_rows) * EXPERT_ROWS, side="right"),
                        N_EXPERTS - 1)

    def expert_rows(args):
        xb, e = args
        return (jax.nn.silu(xb @ w_e_gate[e]) * (xb @ w_e_up[e])) @ w_e_down[e]

    ys = lax.map(expert_rows, (xs.reshape(n_groups_rows, EXPERT_ROWS, D), grp_e)).reshape(P, D)
    contrib = ys[dest].astype(jnp.float32) * w_flat[order][:, None]
    return jax.ops.segment_sum(contrib, tok_sorted, num_segments=T).astype(h.dtype)


def setup_inputs(seed: int = 0) -> dict:
    key = jax.random.key(seed)
    ks = jax.random.split(key, 32)
    L, D = DEPTH, D_MODEL

    def nrm(k, shape, scale):
        return jax.random.normal(k, shape, jnp.float32) * scale

    b_if = jnp.concatenate([
        nrm(ks[6], (L, M_HEADS), 0.1),
        jnp.linspace(3.0, 6.0, M_HEADS, dtype=jnp.float32)[None, :] + nrm(ks[7], (L, M_HEADS), 0.1)], axis=-1)
    return {
        "x": nrm(ks[0], (BATCH, SEQ, D), 1.0),
        "c": nrm(ks[1], (BATCH, D), 1.0),
        "w_ada": nrm(ks[2], (L, D, 6 * D), 0.5 * D ** -0.5),
        "b_ada": nrm(ks[3], (L, 6 * D), 0.02),
        "g_norm1": 1.0 + nrm(ks[4], (L, D), 0.02),
        "w_in": nrm(ks[5], (L, D, D_IN), D ** -0.5),
        "b_if": b_if,
        "conv_dw_w": nrm(ks[8], (L, CONV_WIDTH, D_CONV), CONV_WIDTH ** -0.5),
        "conv_dw_b": nrm(ks[9], (L, D_CONV), 0.02),
        "conv_ln_g": 1.0 + nrm(ks[10], (L, D_CONV), 0.02),
        "conv_ln_b": nrm(ks[11], (L, D_CONV), 0.02),
        "w_conv_out": nrm(ks[12], (L, D_CONV, D), D_CONV ** -0.5),
        "qk_conv_w": nrm(ks[13], (L, QK_CONV_WIDTH, 2 * M_INNER), QK_CONV_WIDTH ** -0.5),
        "qk_conv_b": nrm(ks[14], (L, 2 * M_INNER), 0.02),
        "m_norm_g": 1.0 + nrm(ks[15], (L, M_INNER), 0.02),
        "w_m_out": nrm(ks[16], (L, M_INNER, D), M_INNER ** -0.5),
        "w_out": nrm(ks[17], (L, D, D), D ** -0.5),
        "g_norm2": 1.0 + nrm(ks[18], (L, D), 0.02),
        "w_rg": nrm(ks[19], (L, D, N_GROUPS), D ** -0.5),
        "b_rg": nrm(ks[20], (L, N_GROUPS), 0.01),
        "w_re": nrm(ks[21], (L, D, N_EXPERTS), D ** -0.5),
        "b_re": nrm(ks[22], (L, N_EXPERTS), 0.01),
        "w_e_gate": nrm(ks[23], (L, N_EXPERTS, D, D_EXPERT), D ** -0.5),
        "w_e_up": nrm(ks[24], (L, N_EXPERTS, D, D_EXPERT), D ** -0.5),
        "w_e_down": nrm(ks[25], (L, N_EXPERTS, D_EXPERT, D), D_EXPERT ** -0.5),
        "g_final": 1.0 + nrm(ks[26], (D,), 0.02),
    }


def reference(x, c, w_ada, b_ada, g_norm1, w_in, b_if, conv_dw_w, conv_dw_b, conv_ln_g, conv_ln_b,
              w_conv_out, qk_conv_w, qk_conv_b, m_norm_g, w_m_out, w_out, g_norm2, w_rg, b_rg,
              w_re, b_re, w_e_gate, w_e_up, w_e_down, g_final):
    B, S, D = x.shape
    for l in range(DEPTH):
        mod = jax.nn.silu(c) @ w_ada[l] + b_ada[l]
        sh1, sc1, gt1, sh2, sc2, gt2 = jnp.split(mod, 6, axis=-1)
        h = modulate(rmsnorm(x, g_norm1[l]), sh1, sc1)
        y = hybrid_mixer(h, w_in[l], b_if[l], conv_dw_w[l], conv_dw_b[l], conv_ln_g[l], conv_ln_b[l],
                         w_conv_out[l], qk_conv_w[l], qk_conv_b[l], m_norm_g[l], w_m_out[l], w_out[l])
        x = x + gt1[:, None, :] * y
        h = modulate(rmsnorm(x, g_norm2[l]), sh2, sc2)
        y = hierarchical_moe(h.reshape(B * S, D), w_rg[l], b_rg[l], w_re[l], b_re[l],
                             w_e_gate[l], w_e_up[l], w_e_down[l]).reshape(B, S, D)
        x = x + gt2[:, None, :] * y
    return rmsnorm(x, g_final)
```

```cpp
#include <hip/hip_runtime.h>
#include <stdint.h>
#include <cstdio>

#ifndef MK_ONE
#define MK_ONE 1
#endif
#ifndef NAIVE_MASK
#define NAIVE_MASK 0
#endif
#ifndef DBG_NPH
#define DBG_NPH 11
#endif
#ifndef DBG_F1
#define DBG_F1 (256+512)
#endif
#ifndef DBG_F7
#define DBG_F7 6
#endif
#ifndef DBG_HREP
#define DBG_HREP 0
#endif
#ifndef DBG_REP
#define DBG_REP 0
#endif
#if DBG_REP
#define REPK(k) for (int _r = 0; _r < 1 + ((DBG_REP >> (k)) & 1); ++_r)
#define REPSYNC() __syncthreads()
#else
#define REPK(k)
#define REPSYNC() do {} while (0)
#endif
#ifndef DBG_CLS
#define DBG_CLS 0
#endif
#ifndef DBG_GATEFIRST
#define DBG_GATEFIRST 0
#endif

typedef unsigned short bf16;
#define DEV __device__ __forceinline__
#define LAS __attribute__((address_space(3)))
typedef short bf16x8 __attribute__((ext_vector_type(8)));
typedef float f32x4 __attribute__((ext_vector_type(4)));
typedef unsigned v4u __attribute__((ext_vector_type(4)));
typedef unsigned v2u __attribute__((ext_vector_type(2)));

constexpr int BATCH = 8, SEQ = 2048, D = 1024, T = BATCH * SEQ;
constexpr int DIN = 5128, NH = 4;
constexpr float RMS_EPS = 1e-6f, LN_EPS = 1e-5f;
constexpr int NWAVES = 8, NTHREADS = 512;

DEV float bf2f(bf16 v) { return __uint_as_float(((unsigned)v) << 16); }
DEV float bflo(unsigned w) { return __uint_as_float(w << 16); }
DEV float bfhi(unsigned w) { return __uint_as_float(w & 0xffff0000u); }
DEV unsigned f2bfu(float f) { unsigned u = __float_as_uint(f); return (u + 0x7fffu + ((u >> 16) & 1u)) >> 16; }
DEV unsigned pk2(float lo, float hi);
DEV bf16 f2bf(float f) { return (bf16)(pk2(f, f) & 0xffffu); }
DEV unsigned pk2(float lo, float hi) { unsigned r; asm volatile("v_cvt_pk_bf16_f32 %0, %1, %2" : "=v"(r) : "v"(lo), "v"(hi)); return r; }
DEV float sigmoidf_(float x) { return __builtin_amdgcn_rcpf(1.f + __expf(-x)); }
DEV float siluf_(float x) { return x * __builtin_amdgcn_rcpf(1.f + __expf(-x)); }
DEV float logsigmoidf_(float x) { return fminf(x, 0.f) - log1pf(__expf(-fabsf(x))); }
template <int CTRL> DEV float dpp0(float v) { return __int_as_float(__builtin_amdgcn_update_dpp(0, __float_as_int(v), CTRL, 0xf, 0xf, true)); }
template <int CTRL> DEV float dppk(float v) { return __int_as_float(__builtin_amdgcn_update_dpp(__float_as_int(v), __float_as_int(v), CTRL, 0xf, 0xf, false)); }
DEV float rdlane(float v, int l) { return __int_as_float(__builtin_amdgcn_readlane(__float_as_int(v), l)); }
DEV float row16_sum(float v) {
    v += dpp0<0xB1>(v); v += dpp0<0x4E>(v); v += dpp0<0x141>(v); v += dpp0<0x140>(v); return v; }
DEV float wave_sum(float v) { v = row16_sum(v); return (rdlane(v, 0) + rdlane(v, 16)) + (rdlane(v, 32) + rdlane(v, 48)); }
DEV float wave_scan_add(float v, int lane) {
    v += dpp0<0x111>(v); v += dpp0<0x112>(v); v += dpp0<0x114>(v); v += dpp0<0x118>(v);
    const float r0 = rdlane(v, 15), r1 = rdlane(v, 31), r2 = rdlane(v, 47);
    return v + ((lane >= 48) ? (r0 + r1) + r2 : (lane >= 32) ? (r0 + r1) : (lane >= 16) ? r0 : 0.f); }
DEV float wave_scan_max(float v, int lane) {
    v = fmaxf(v, dppk<0x111>(v)); v = fmaxf(v, dppk<0x112>(v)); v = fmaxf(v, dppk<0x114>(v)); v = fmaxf(v, dppk<0x118>(v));
    const float r0 = rdlane(v, 15), r1 = rdlane(v, 31), r2 = rdlane(v, 47);
    const float p = (lane >= 48) ? fmaxf(fmaxf(r0, r1), r2) : (lane >= 32) ? fmaxf(r0, r1) : (lane >= 16) ? r0 : -3.0e38f;
    return fmaxf(v, p); }
#define LDS_WAIT() asm volatile("s_waitcnt lgkmcnt(0)" ::: "memory")

constexpr size_t MiB = 1u << 20;
constexpr size_t WS_CTL = 0, CTL_ZERO_BYTES = 65536;
constexpr size_t WS_MOD = 1 * MiB;
constexpr size_t WS_GATES = 1 * MiB + 256 * 1024;
constexpr size_t WS_STSC = 1 * MiB + 768 * 1024;
constexpr size_t WS_RBIAS = 1 * MiB + 800 * 1024;
constexpr size_t WS_WIF = 1 * MiB + 832 * 1024;
constexpr size_t WS_RW = 6 * MiB + 256 * 1024;
constexpr size_t WS_TOKE = 6 * MiB;
constexpr size_t WS_TOKW = 6 * MiB + 128 * 1024;
constexpr size_t WS_LISTT = 2 * MiB;
constexpr size_t WS_LISTW = 4 * MiB;
constexpr size_t WS_W1T = 8 * MiB;
constexpr size_t WS_W2T = 18 * MiB;
constexpr size_t WS_W3T = 20 * MiB;
constexpr size_t WS_STATE = 22 * MiB;
constexpr size_t WS_H = 40 * MiB;
constexpr size_t WS_ZU = 72 * MiB, WS_ZQ = 88 * MiB, WS_ZK = 104 * MiB, WS_ZV = 120 * MiB, WS_ZO = 136 * MiB;
constexpr size_t WS_ZGA = 152 * MiB, WS_ZGB = 184 * MiB;
constexpr size_t WS_UAHM = 216 * MiB;
constexpr size_t WS_MERGED = WS_ZQ;
constexpr size_t WS_WGU = 120 * MiB;
constexpr size_t WS_WD = 184 * MiB;
constexpr size_t WS_ACT = 216 * MiB;
constexpr size_t WS_YS = 40 * MiB;
constexpr size_t WS_QC = WS_H, WS_KC = WS_H + 16 * MiB;
constexpr int CW_BAR = 4096, CW_CNT = 8192, CW_MODCNT = 9216;

constexpr int LDS_TAB = 131072;
constexpr int LDS_MISC = 147456;
constexpr int LDS_BYTES = 151552;

struct Args { const float* in[26]; float* out; unsigned char* ws; int ph_lo, ph_hi, flags, pad; };

namespace pg8 {
constexpr int BM = 256, BK = 64, HALF = 128, HTB = HALF * BK * 2, NXCD = 8, WGM = 8;
DEV int lds_byte(int r, int c) { const int st = (r >> 4) * 2 + (c >> 5), rr = r & 15, cc = c & 31, ob = rr * 64 + cc * 2; return st * 1024 + (ob ^ (((ob >> 9) & 1) << 5)); }
DEV void stage_rc(int b, int& R, int& C) { const int st = b / 1024, sb = b % 1024, swz = sb ^ (((sb >> 9) & 1) << 5); R = (st >> 1) * 16 + swz / 64; C = (st & 1) * 32 + (swz % 64) / 2; }
DEV int perm32(int rho) { const int n = rho >> 4, i = rho & 15; return 8 * (i >> 2) + 4 * n + (i & 3); }
DEV unsigned cvt_pk_bf16(float lo, float hi) { unsigned r; asm volatile("v_cvt_pk_bf16_f32 %0, %1, %2" : "=v"(r) : "v"(lo), "v"(hi)); return r; }

struct Unit { int pm, pn; unsigned ak, bk; int slot, valid, arow0; };

struct StaticOrder {
    int nM, nN, nwg, G, c;
    DEV void init(int M, int N, int G_, int c_) { nM = M / BM; nN = N / BM; nwg = nM * nN; G = G_; c = c_; }
    DEV bool tile(int L, int& pm, int& pn) const {
        if (L >= nwg) return false;
        int wgid = L; { const int q = nwg / NXCD, r = nwg % NXCD, xcd = wgid % NXCD, off = wgid / NXCD; wgid = (xcd < r ? xcd * (q + 1) : r * (q + 1) + (xcd - r) * q) + off; }
        const int nig = WGM * nN, gid = wgid / nig, fm = gid * WGM, gsz = (nM - fm) < WGM ? (nM - fm) : WGM;
        pm = fm + ((wgid % nig) % gsz); pn = (wgid % nig) / gsz; return true;
    }
    DEV bool next(int i, Unit& u) const { u.ak = 0; u.bk = 0; u.slot = 0; u.valid = 256; u.arow0 = 0; return tile(i * G + c, u.pm, u.pn); }
};

template <class Prob, class Epi, class Sched, bool ALIGN_EPI, bool SKIP = false>
DEV void gemm_phase(LAS unsigned char* lds, const Prob& P, const Sched& S, const Epi& E, const int K) {
    int tid = threadIdx.x; asm volatile("" : "+v"(tid));
    const int wid = __builtin_amdgcn_readfirstlane(tid >> 6), lane = tid & 63, wr = wid >> 2, wc = wid & 3, fr = lane & 15, fq = lane >> 4;
    const int nt = K / BK;
    int R[2], C[2], Rb[2];
#pragma unroll
    for (int i = 0; i < 2; ++i) { stage_rc(tid * 16 + i * 8192, R[i], C[i]); Rb[i] = Epi::PERM ? ((R[i] & ~31) + perm32(R[i] & 31)) : R[i]; }
    const unsigned kstep = BK * 2;
    const unsigned ldsw = (unsigned)wid * 1024u;
    const int aoff = lds_byte(wr * 64 + fr, fq * 8), boff = lds_byte(wc * 32 + fr, fq * 8);
    const char* const Abase = (const char*)P.A; const char* const Bbase = (const char*)P.B;
#define PG8_SA(b, h) (((b) * 2 + (h)) * HTB)
#define PG8_SB(b, h) ((4 + (b) * 2 + (h)) * HTB)
#define PG8_STAGE(bufoff, base, offs, kb) do { _Pragma("unroll") for (int _i = 0; _i < 2; ++_i) \
        __builtin_amdgcn_global_load_lds((const unsigned*)((base) + (size_t)((offs)[_i] + (kb))), (LAS unsigned*)(lds + (bufoff) + ldsw + _i * 8192), 16, 0, 0); } while (0)
#define PG8_LDA(dst, b, h) do { _Pragma("unroll") for (int m = 0; m < 4; ++m) _Pragma("unroll") for (int k = 0; k < 2; ++k) dst[m][k] = *(const LAS bf16x8*)(lds + PG8_SA(b, h) + aoff + m * 2048 + k * 1024); } while (0)
#define PG8_LDB(dst, b, h) do { _Pragma("unroll") for (int n = 0; n < 2; ++n) _Pragma("unroll") for (int k = 0; k < 2; ++k) dst[n][k] = *(const LAS bf16x8*)(lds + PG8_SB(b, h) + boff + n * 2048 + k * 1024); } while (0)
#define PG8_MMA(ai, bj, At, Bt) do { __builtin_amdgcn_s_setprio(1); _Pragma("unroll") for (int m = 0; m < 4; ++m) _Pragma("unroll") for (int n = 0; n < 2; ++n) _Pragma("unroll") for (int k = 0; k < 2; ++k) \
        acc[ai][bj][m][n] = __builtin_amdgcn_mfma_f32_16x16x32_bf16(Bt[n][k], At[m][k], acc[ai][bj][m][n], 0, 0, 0); __builtin_amdgcn_s_setprio(0); } while (0)
#define PG8_WAIT_V(n) asm volatile("s_waitcnt vmcnt(" #n ")" ::: "memory")
#define PG8_WAIT_L(n) asm volatile("s_waitcnt lgkmcnt(" #n ")" ::: "memory")
#define PG8_BAR __builtin_amdgcn_s_barrier()
#define PG8_SCHED __builtin_amdgcn_sched_barrier(0)
    Unit cur, nxt; int ui = 0;
    if (!S.next(0, cur)) return;
    f32x4 acc[2][2][4][2];
#pragma unroll
    for (int a = 0; a < 2; ++a)
#pragma unroll
        for (int b = 0; b < 2; ++b)
#pragma unroll
            for (int m = 0; m < 4; ++m)
#pragma unroll
                for (int n = 0; n < 2; ++n) acc[a][b][m][n] = (f32x4){0.f, 0.f, 0.f, 0.f};
    bf16x8 At[4][2], B0[2][2], B1[2][2];
    unsigned ca[2][2], cb[2][2], na[2][2], nb[2][2];
    P.aoffs(cur, R, C, ca); P.boffs(cur, Rb, C, cb);
    PG8_STAGE(PG8_SB(0, 0), Bbase, cb[0], 0u); PG8_STAGE(PG8_SB(0, 1), Bbase, cb[1], 0u); PG8_STAGE(PG8_SA(0, 0), Abase, ca[0], 0u); PG8_STAGE(PG8_SA(0, 1), Abase, ca[1], 0u);
    if (wr == 1) PG8_BAR;
    PG8_WAIT_V(2); PG8_BAR;
    PG8_STAGE(PG8_SB(1, 0), Bbase, cb[0], kstep); PG8_STAGE(PG8_SA(1, 0), Abase, ca[0], kstep); PG8_STAGE(PG8_SB(1, 1), Bbase, cb[1], kstep);
    PG8_WAIT_V(6); PG8_BAR;
    for (;;) {
        const bool has_next = S.next(ui + 1, nxt);
        if (has_next) { P.aoffs(nxt, R, C, na); P.boffs(nxt, Rb, C, nb); }
        else {
#pragma unroll
            for (int h = 0; h < 2; ++h)
#pragma unroll
                for (int i = 0; i < 2; ++i) { na[h][i] = ca[h][i]; nb[h][i] = cb[h][i]; } }
        const bool do0 = !(SKIP && cur.valid <= 64 && wr == 1), do1 = !(SKIP && cur.valid <= 128) && do0;
        for (int t = 0; t < nt; t += 2) {
            const bool last = (t == nt - 2);
            const unsigned k1 = (unsigned)(t + 1) * kstep;
            const unsigned kb2 = last ? 0u : (unsigned)(t + 2) * kstep, kb3 = kb2 + kstep;
            unsigned a2[2][2], b2[2][2];
#pragma unroll
            for (int h = 0; h < 2; ++h)
#pragma unroll
                for (int i = 0; i < 2; ++i) { a2[h][i] = last ? na[h][i] : ca[h][i]; b2[h][i] = last ? nb[h][i] : cb[h][i]; }
            PG8_LDB(B0, 0, 0); PG8_LDB(B1, 0, 1); PG8_SCHED; PG8_LDA(At, 0, 0); PG8_STAGE(PG8_SA(1, 1), Abase, ca[1], k1);
            PG8_WAIT_V(8); PG8_WAIT_L(0); PG8_BAR; if (do0) { PG8_MMA(0, 0, At, B0); PG8_MMA(0, 1, At, B1); } PG8_BAR; PG8_SCHED;
            PG8_LDA(At, 0, 1); PG8_STAGE(PG8_SB(0, 0), Bbase, b2[0], kb2); PG8_STAGE(PG8_SB(0, 1), Bbase, b2[1], kb2); PG8_STAGE(PG8_SA(0, 0), Abase, a2[0], kb2);
            PG8_WAIT_V(8); PG8_WAIT_L(0); PG8_BAR; if (do1) { PG8_MMA(1, 0, At, B0); PG8_MMA(1, 1, At, B1); } PG8_BAR; PG8_SCHED;
            PG8_LDB(B0, 1, 0); PG8_LDB(B1, 1, 1); PG8_SCHED; PG8_LDA(At, 1, 0); PG8_STAGE(PG8_SA(0, 1), Abase, a2[1], kb2);
            PG8_WAIT_V(8); PG8_WAIT_L(0); PG8_BAR; if (do0) { PG8_MMA(0, 0, At, B0); PG8_MMA(0, 1, At, B1); } PG8_BAR; PG8_SCHED;
            PG8_LDA(At, 1, 1); PG8_STAGE(PG8_SB(1, 0), Bbase, b2[0], kb3); PG8_STAGE(PG8_SB(1, 1), Bbase, b2[1], kb3); PG8_STAGE(PG8_SA(1, 0), Abase, a2[0], kb3);
            PG8_WAIT_V(8); PG8_WAIT_L(0); PG8_BAR; if (do1) { PG8_MMA(1, 0, At, B0); PG8_MMA(1, 1, At, B1); } PG8_BAR; PG8_SCHED;
        }
        if constexpr (ALIGN_EPI) { if (wr == 0) PG8_BAR; }
        E(acc, cur, wr, wc, fr, fq);
        if (!has_next) break;
        if (!E.keep(cur)) {
#pragma unroll
            for (int a = 0; a < 2; ++a)
#pragma unroll
                for (int b = 0; b < 2; ++b)
#pragma unroll
                    for (int m = 0; m < 4; ++m)
#pragma unroll
                        for (int n = 0; n < 2; ++n) acc[a][b][m][n] = (f32x4){0.f, 0.f, 0.f, 0.f};
        }
        cur = nxt; ++ui;
#pragma unroll
        for (int h = 0; h < 2; ++h)
#pragma unroll
            for (int i = 0; i < 2; ++i) { ca[h][i] = na[h][i]; cb[h][i] = nb[h][i]; }
        if constexpr (ALIGN_EPI) { if (wr == 1) PG8_BAR; }
    }
    PG8_WAIT_V(0);
    if constexpr (!ALIGN_EPI) { if (wr == 0) PG8_BAR; }
    PG8_BAR;
#undef PG8_SA
#undef PG8_SB
#undef PG8_STAGE
#undef PG8_LDA
#undef PG8_LDB
#undef PG8_MMA
#undef PG8_WAIT_V
#undef PG8_WAIT_L
#undef PG8_BAR
#undef PG8_SCHED
}
}
using pg8::Unit;

struct ProbPlain {
    const bf16* A; const bf16* B; unsigned lda2, ldb2;
    DEV void aoffs(const Unit& u, const int (&R)[2], const int (&C)[2], unsigned (&o)[2][2]) const {
#pragma unroll
        for (int h = 0; h < 2; ++h)
#pragma unroll
            for (int i = 0; i < 2; ++i) o[h][i] = (unsigned)(u.pm * 256 + 128 * h + R[i]) * lda2 + (unsigned)C[i] * 2u + u.ak; }
    DEV void boffs(const Unit& u, const int (&Rb)[2], const int (&C)[2], unsigned (&o)[2][2]) const {
#pragma unroll
        for (int h = 0; h < 2; ++h)
#pragma unroll
            for (int i = 0; i < 2; ++i) o[h][i] = (unsigned)(u.pn * 256 + 128 * h + Rb[i]) * ldb2 + (unsigned)C[i] * 2u + u.bk; }
};
struct ProbMoeUp {
    const bf16* A; const bf16* B; const LAS unsigned* rowtab;
    DEV void aoffs(const Unit& u, const int (&R)[2], const int (&C)[2], unsigned (&o)[2][2]) const {
#pragma unroll
        for (int h = 0; h < 2; ++h)
#pragma unroll
            for (int i = 0; i < 2; ++i) o[h][i] = rowtab[u.slot * 256 + 128 * h + R[i]] + (unsigned)C[i] * 2u; }
    DEV void boffs(const Unit& u, const int (&Rb)[2], const int (&C)[2], unsigned (&o)[2][2]) const {
#pragma unroll
        for (int h = 0; h < 2; ++h)
#pragma unroll
            for (int i = 0; i < 2; ++i) o[h][i] = (unsigned)(u.pn * 256 + 128 * h + Rb[i]) * 2048u + (unsigned)C[i] * 2u + u.bk; }
};
struct ProbMoeDown {
    const bf16* A; const bf16* B;
    DEV void aoffs(const Unit& u, const int (&R)[2], const int (&C)[2], unsigned (&o)[2][2]) const {
#pragma unroll
        for (int h = 0; h < 2; ++h)
#pragma unroll
            for (int i = 0; i < 2; ++i) o[h][i] = (unsigned)(u.arow0 + 128 * h + R[i]) * 1024u + (unsigned)C[i] * 2u; }
    DEV void boffs(const Unit& u, const int (&Rb)[2], const int (&C)[2], unsigned (&o)[2][2]) const {
#pragma unroll
        for (int h = 0; h < 2; ++h)
#pragma unroll
            for (int i = 0; i < 2; ++i) o[h][i] = (unsigned)(u.pn * 256 + 128 * h + Rb[i]) * 1024u + (unsigned)C[i] * 2u + u.bk; }
};

DEV v4u pack8(const f32x4 v0, const f32x4 v1) { v4u w; w.x = pg8::cvt_pk_bf16(v0[0], v0[1]); w.y = pg8::cvt_pk_bf16(v0[2], v0[3]); w.z = pg8::cvt_pk_bf16(v1[0], v1[1]); w.w = pg8::cvt_pk_bf16(v1[2], v1[3]); return w; }
DEV f32x4 sig4(f32x4 v) { f32x4 o; o[0] = sigmoidf_(v[0]); o[1] = sigmoidf_(v[1]); o[2] = sigmoidf_(v[2]); o[3] = sigmoidf_(v[3]); return o; }
DEV void unpack8(const v4u w, f32x4& lo, f32x4& hi) { lo[0] = bflo(w.x); lo[1] = bfhi(w.x); lo[2] = bflo(w.y); lo[3] = bfhi(w.y); hi[0] = bflo(w.z); hi[1] = bfhi(w.z); hi[2] = bflo(w.w); hi[3] = bfhi(w.w); }

struct Epi1 {
    static constexpr bool PERM = true;
    bf16* zu; bf16* zga; int cls;
    DEV bool keep(const Unit&) const { return false; }
    DEV void operator()(f32x4 (&acc)[2][2][4][2], const Unit& u, int wr, int wc, int fr, int fq) const {
        const int row0 = u.pm * 256 + wr * 64 + fr, cl = wc * 32 + 8 * fq;
        if (cls) { const int c = (u.pn < 4) ? 1 : (u.pn < 12) ? 2 : (u.pn < 16) ? 4 : 8; if (!(cls & c)) return; }
        if (u.pn < 4) {
#pragma unroll
            for (int ai = 0; ai < 2; ++ai)
#pragma unroll
                for (int m = 0; m < 4; ++m) { const size_t row = (size_t)(row0 + ai * 128 + m * 16);
                    const f32x4 v0 = acc[ai][0][m][0] * sig4(acc[ai][1][m][0]), v1 = acc[ai][0][m][1] * sig4(acc[ai][1][m][1]);
                    *(v4u*)(zu + row * 512 + 128 * u.pn + cl) = pack8(v0, v1); }
        } else {
            bf16* base; int ld, colb; bool sg;
            if (u.pn < 12) { const int ti = (u.pn - 4) >> 1; base = zu + (size_t)(1 + ti) * T * 512; ld = 512; colb = 256 * ((u.pn - 4) & 1); sg = (ti == 3); }
            else { const int ti = (u.pn - 12) >> 2; base = zga + (size_t)ti * T * 1024; ld = 1024; colb = 256 * ((u.pn - 12) & 3); sg = true; }
#pragma unroll
            for (int ai = 0; ai < 2; ++ai)
#pragma unroll
                for (int m = 0; m < 4; ++m) { const size_t row = (size_t)(row0 + ai * 128 + m * 16);
#pragma unroll
                    for (int bj = 0; bj < 2; ++bj) { f32x4 v0 = acc[ai][bj][m][0], v1 = acc[ai][bj][m][1]; if (sg) { v0 = sig4(v0); v1 = sig4(v1); }
                        *(v4u*)(base + row * ld + colb + 128 * bj + cl) = pack8(v0, v1); } }
        }
    }
};
struct Epi2 {
    static constexpr bool PERM = true;
    const bf16* zga; const bf16* zgb; bf16* merged;
    DEV bool keep(const Unit& u) const { return u.slot == 0; }
    DEV void operator()(f32x4 (&acc)[2][2][4][2], const Unit& u, int wr, int wc, int fr, int fq) const {
        const int row0 = u.pm * 256 + wr * 64 + fr, c0 = u.pn * 256 + wc * 32 + 8 * fq;
#pragma unroll
        for (int ai = 0; ai < 2; ++ai)
#pragma unroll
            for (int m = 0; m < 4; ++m) { const size_t ro = (size_t)(row0 + ai * 128 + m * 16) * 1024 + c0;
#pragma unroll
                for (int bj = 0; bj < 2; ++bj) {
                    f32x4 b0, b1; unpack8(*(const v4u*)(zgb + ro + 128 * bj), b0, b1);
                    if (u.slot == 0) { f32x4 a0, a1; unpack8(*(const v4u*)(zga + ro + 128 * bj), a0, a1);
#pragma unroll
                        for (int j = 0; j < 4; ++j) { acc[ai][bj][m][0][j] *= a0[j] * __builtin_amdgcn_rcpf(fmaxf(b0[j], 1e-30f)); acc[ai][bj][m][1][j] *= a1[j] * __builtin_amdgcn_rcpf(fmaxf(b1[j], 1e-30f)); }
                    } else { *(v4u*)(merged + ro + 128 * bj) = pack8(acc[ai][bj][m][0] * b0, acc[ai][bj][m][1] * b1); }
                } }
    }
};
struct Epi3 {
    static constexpr bool PERM = false;
    const float* x; const float* mod; float* out;
    DEV bool keep(const Unit&) const { return false; }
    DEV void operator()(f32x4 (&acc)[2][2][4][2], const Unit& u, int wr, int wc, int fr, int fq) const {
        const int row0 = u.pm * 256 + wr * 64 + fr, c0 = u.pn * 256 + wc * 32 + 4 * fq; const int b = u.pm >> 3;
        f32x4 gt[2][2];
#pragma unroll
        for (int bj = 0; bj < 2; ++bj)
#pragma unroll
            for (int n = 0; n < 2; ++n) gt[bj][n] = *(const f32x4*)(mod + b * 6144 + 2048 + c0 + 128 * bj + 16 * n);
#pragma unroll
        for (int ai = 0; ai < 2; ++ai)
#pragma unroll
            for (int m = 0; m < 4; ++m) { const size_t ro = (size_t)(row0 + ai * 128 + m * 16) * 1024 + c0;
#pragma unroll
                for (int bj = 0; bj < 2; ++bj)
#pragma unroll
                    for (int n = 0; n < 2; ++n) { const f32x4 xv = *(const f32x4*)(x + ro + 128 * bj + 16 * n); *(f32x4*)(out + ro + 128 * bj + 16 * n) = xv + gt[bj][n] * acc[ai][bj][m][n]; } }
    }
};
struct EpiUp {
    static constexpr bool PERM = true;
    bf16* act;
    DEV bool keep(const Unit&) const { return false; }
    DEV void operator()(f32x4 (&acc)[2][2][4][2], const Unit& u, int wr, int wc, int fr, int fq) const {
        const int cl = 128 * u.pn + wc * 32 + 8 * fq;
#pragma unroll
        for (int ai = 0; ai < 2; ++ai)
#pragma unroll
            for (int m = 0; m < 4; ++m) { const int rt = ai * 128 + wr * 64 + m * 16 + fr;
                if (rt < u.valid) { f32x4 v0, v1;
#pragma unroll
                    for (int j = 0; j < 4; ++j) { v0[j] = siluf_(acc[ai][0][m][0][j]) * acc[ai][1][m][0][j]; v1[j] = siluf_(acc[ai][0][m][1][j]) * acc[ai][1][m][1][j]; }
                    *(v4u*)(act + (size_t)(u.arow0 + rt) * 512 + cl) = pack8(v0, v1); } }
    }
};
struct EpiDown {
    static constexpr bool PERM = true;
    bf16* ys; const LAS unsigned* desttab; const LAS float* wtab;
    DEV bool keep(const Unit&) const { return false; }
    DEV void operator()(f32x4 (&acc)[2][2][4][2], const Unit& u, int wr, int wc, int fr, int fq) const {
        const int cl = 256 * u.pn + wc * 32 + 8 * fq;
#pragma unroll
        for (int ai = 0; ai < 2; ++ai)
#pragma unroll
            for (int m = 0; m < 4; ++m) { const int rt = ai * 128 + wr * 64 + m * 16 + fr;
                if (rt < u.valid) { const unsigned dest = desttab[u.slot * 256 + rt]; const float w = wtab[u.slot * 256 + rt];
#pragma unroll
                    for (int bj = 0; bj < 2; ++bj) *(v4u*)(ys + (size_t)dest * 1024 + cl + 128 * bj) = pack8(acc[ai][bj][m][0] * w, acc[ai][bj][m][1] * w); } }
    }
};

#define XB_TMO      128
#define XB_XCNT(j)  (256  + 64 * (j))
#define XB_XSUB(j)  (1280 + 64 * (j))
#define XB_XGEN(j)  (2304 + 64 * (j))
#define XB_TOP      3328
#define XB_TOPGEN   3392
#define XCD_BAR_WORDS 3456
#define XB_SPIN_CAP (1u << 18)
__device__ __forceinline__ unsigned xb_ld(unsigned* p)              { return __hip_atomic_load(p, __ATOMIC_RELAXED, __HIP_MEMORY_SCOPE_AGENT); }
__device__ __forceinline__ unsigned xb_add(unsigned* p, unsigned v) { return __hip_atomic_fetch_add(p, v, __ATOMIC_RELAXED, __HIP_MEMORY_SCOPE_AGENT); }
__device__ __forceinline__ unsigned xb_xcc_id() { return (unsigned)__builtin_amdgcn_s_getreg((3 << 11) | 20) & 0xFu; }
#define XB_SPIN(cond, bar) do { unsigned _sp = 0; while (cond) { __builtin_amdgcn_s_sleep(1); \
    if ((++_sp & 255u) == 0u) { if (xb_ld(&(bar)[XB_TMO])) break; if (_sp > XB_SPIN_CAP) { atomicAdd(&(bar)[XB_TMO], 1u); break; } } } } while (0)
struct XcdBarrier { unsigned* bar; unsigned x; volatile LAS unsigned* st; };
__device__ __forceinline__ XcdBarrier xcd_barrier_post(unsigned* bar, volatile LAS unsigned* st) {
    XcdBarrier b; b.bar = bar; b.x = xb_xcc_id(); b.st = st;
    if (threadIdx.x == 0) (void)xb_add(&bar[XB_XCNT(b.x)], 1u);
    return b;
}
__device__ __forceinline__ void xcd_barrier_complete(unsigned* bar, unsigned x, unsigned& nloc, unsigned& nx) {
    const unsigned G = gridDim.x * gridDim.y * gridDim.z;
    unsigned sum, cnt, mine, sp = 0u;
    for (;;) {
        sum = 0u; cnt = 0u; mine = 0u;
#pragma unroll
        for (unsigned j = 0; j < 16; ++j) { const unsigned c = xb_ld(&bar[XB_XCNT(j)]); sum += c; cnt += (c > 0u) ? 1u : 0u; mine = (j == x) ? c : mine; }
        if (sum == G) break;
        __builtin_amdgcn_s_sleep(1);
        if ((++sp & 255u) == 0u) { if (xb_ld(&bar[XB_TMO])) break; if (sp > XB_SPIN_CAP) { atomicAdd(&bar[XB_TMO], 1u); break; } }
    }
    nloc = mine > 0u ? mine : 1u; nx = cnt > 0u ? cnt : 1u;
}
__device__ __forceinline__ void xcd_barrier(const XcdBarrier& b) {
    asm volatile("s_waitcnt vmcnt(0)" ::: "memory");
    __syncthreads();
    if (threadIdx.x == 0) {
        unsigned* bar = b.bar;
        __builtin_amdgcn_s_waitcnt(0);
        unsigned nloc = b.st[0], nx = b.st[1];
        if (nloc == 0u) { xcd_barrier_complete(bar, b.x, nloc, nx); b.st[0] = nloc; b.st[1] = nx; }
        const unsigned old = xb_add(&bar[XB_XSUB(b.x)], 1u);
        const unsigned gen = old / nloc;
        if (old + 1u == (gen + 1u) * nloc) {
            __builtin_amdgcn_fence(__ATOMIC_RELEASE, "agent");
            asm volatile("s_waitcnt vmcnt(0)" ::: "memory");
            const unsigned og = xb_add(&bar[XB_TOP], 1u);
            const unsigned tg = og / nx;
            if (og + 1u == (tg + 1u) * nx) xb_add(&bar[XB_TOPGEN], 1u);
            else XB_SPIN(xb_ld(&bar[XB_TOPGEN]) == tg, bar);
            __builtin_amdgcn_fence(__ATOMIC_ACQUIRE, "agent");
            xb_add(&bar[XB_XGEN(b.x)], 1u);
            asm volatile("s_waitcnt vmcnt(0)" ::: "memory");
        } else {
            XB_SPIN(xb_ld(&bar[XB_XGEN(b.x)]) == gen, bar);
            __builtin_amdgcn_fence(__ATOMIC_ACQUIRE, "agent");
            asm volatile("s_waitcnt vmcnt(0)" ::: "memory");
        }
    }
    __syncthreads();
}

DEV f32x4 mma16(bf16x8 a, bf16x8 b, f32x4 c) { return __builtin_amdgcn_mfma_f32_16x16x32_bf16(a, b, c, 0, 0, 0); }
DEV void split8(const f32x4 a, const f32x4 b, bf16x8& hi, bf16x8& lo) {
    v4u h, l; const float r[8] = {a[0], a[1], a[2], a[3], b[0], b[1], b[2], b[3]}; unsigned hw[4], lw[4];
#pragma unroll
    for (int i = 0; i < 4; ++i) { hw[i] = pk2(r[2 * i], r[2 * i + 1]); lw[i] = pk2(r[2 * i] - bflo(hw[i]), r[2 * i + 1] - bfhi(hw[i])); }
    h.x = hw[0]; h.y = hw[1]; h.z = hw[2]; h.w = hw[3]; l.x = lw[0]; l.y = lw[1]; l.z = lw[2]; l.w = lw[3];
    hi = __builtin_bit_cast(bf16x8, h); lo = __builtin_bit_cast(bf16x8, l);
}
DEV void transpose_item(const float* src, int ldsrc, bf16* dst, int lddst, LAS float* scr, int lane) {
#pragma unroll 8
    for (int i = 0; i < 32; ++i) { const int kk = 2 * i + (lane >> 5); scr[kk * 33 + (lane & 31)] = src[(size_t)kk * ldsrc + (lane & 31)]; }
    LDS_WAIT(); asm volatile("" ::: "memory");
    const int c = lane & 7;
#pragma unroll
    for (int j = 0; j < 4; ++j) { const int n = (lane >> 3) + 8 * j; const LAS float* s = scr + (8 * c) * 33 + n;
        v4u o; o.x = pk2(s[0 * 33], s[1 * 33]); o.y = pk2(s[2 * 33], s[3 * 33]); o.z = pk2(s[4 * 33], s[5 * 33]); o.w = pk2(s[6 * 33], s[7 * 33]);
        *(v4u*)(dst + (size_t)n * lddst + 8 * c) = o; }
    LDS_WAIT(); asm volatile("" ::: "memory");
}

DEV void p0_prologue(const Args& a, LAS unsigned char* lds, int bid, int G) {
    const int tid = threadIdx.x, lane = tid & 63, wave = __builtin_amdgcn_readfirstlane(tid >> 6);
    const float* c = a.in[1]; const float* w_ada = a.in[2]; const float* b_ada = a.in[3];
    float* mod = (float*)(a.ws + WS_MOD);
    if (bid < 192) {
        LAS float* sil = (LAS float*)lds;
        LAS float* red = (LAS float*)(lds + 32768);
        for (int i = tid; i < 8192; i += NTHREADS) sil[i] = siluf_(c[i]);
        __syncthreads();
        for (int item = bid; item < 192; item += G) {
            const int n0 = item * 32, lg = lane >> 3, cq = lane & 7;
            float acc[8][4];
#pragma unroll
            for (int b = 0; b < 8; ++b)
#pragma unroll
                for (int j = 0; j < 4; ++j) acc[b][j] = 0.f;
#pragma unroll 4
            for (int j = 0; j < 16; ++j) { const int k = wave * 128 + j * 8 + lg; const f32x4 w = *(const f32x4*)(w_ada + (size_t)k * 6144 + n0 + cq * 4);
#pragma unroll
                for (int b = 0; b < 8; ++b) { const float s = sil[b * 1024 + k]; acc[b][0] += s * w[0]; acc[b][1] += s * w[1]; acc[b][2] += s * w[2]; acc[b][3] += s * w[3]; } }
#pragma unroll
            for (int b = 0; b < 8; ++b)
#pragma unroll
                for (int j = 0; j < 4; ++j) { float v = acc[b][j]; v += dpp0<0x128>(v); if ((lane & 8) == 0) red[(wave * 4 + (lane >> 4)) * 256 + b * 32 + cq * 4 + j] = v; }
            __syncthreads();
            if (tid < 256) { float s = 0.f;
#pragma unroll
                for (int w = 0; w < 32; ++w) s += red[w * 256 + tid];
                const int b = tid >> 5, col = tid & 31; mod[b * 6144 + n0 + col] = s + b_ada[n0 + col]; }
            asm volatile("s_waitcnt vmcnt(0)" ::: "memory");
            __syncthreads();
            if (tid == 0) { __builtin_amdgcn_fence(__ATOMIC_RELEASE, "agent"); asm volatile("s_waitcnt vmcnt(0)" ::: "memory");
                __hip_atomic_fetch_add((unsigned*)(a.ws + WS_CTL) + CW_MODCNT, 1u, __ATOMIC_RELAXED, __HIP_MEMORY_SCOPE_AGENT); }
        }
    }
    if (bid == G - 1) { const float* w_in0 = a.in[5]; float* wif = (float*)(a.ws + WS_WIF);
        for (int i = tid; i < 2048; i += NTHREADS) { const int k = i >> 1, hf = i & 1; *(f32x4*)(wif + k * 8 + 4 * hf) = *(const f32x4*)(w_in0 + (size_t)k * DIN + 3072 + 4 * hf); } }
    LAS float* scr = (LAS float*)(lds + wave * 16384);
    const int gw = bid * NWAVES + wave, NGW = G * NWAVES;
    const float* w_in = a.in[5]; const float* wco = a.in[11]; const float* wmo = a.in[15]; const float* wout = a.in[16];
    bf16* W1T = (bf16*)(a.ws + WS_W1T); bf16* W2T = (bf16*)(a.ws + WS_W2T); bf16* W3T = (bf16*)(a.ws + WS_W3T);
    constexpr int I1 = 16 * 160, I2 = 8 * 32, I3 = 16 * 32, NIT = I1 + 2 * I2 + I3;
    for (int it = gw; it < NIT; it += NGW) {
        int r = it;
        if (r < I1) { const int kb = r / 160, nb = r % 160, np = 32 * nb; int sc;
            if (np < 1024) { const int t = np >> 8, q = np & 255; sc = (q < 128) ? 128 * t + q : 512 + 128 * t + q - 128; } else if (np < 3072) sc = np; else sc = np + 8;
            transpose_item(w_in + (size_t)(64 * kb) * DIN + sc, DIN, W1T + (size_t)np * 1024 + 64 * kb, 1024, scr, lane); continue; }
        r -= I1;
        if (r < I2) { const int kb = r / 32, nb = r % 32; transpose_item(wco + (size_t)(64 * kb) * 1024 + 32 * nb, 1024, W2T + (size_t)(32 * nb) * 1024 + 64 * kb, 1024, scr, lane); continue; }
        r -= I2;
        if (r < I2) { const int kb = r / 32, nb = r % 32; transpose_item(wmo + (size_t)(64 * kb) * 1024 + 32 * nb, 1024, W2T + (size_t)(32 * nb) * 1024 + 512 + 64 * kb, 1024, scr, lane); continue; }
        r -= I2;
        { const int kb = r / 32, nb = r % 32; transpose_item(wout + (size_t)(64 * kb) * 1024 + 32 * nb, 1024, W3T + (size_t)(32 * nb) * 1024 + 64 * kb, 1024, scr, lane); }
    }
}

DEV void p1_h1(const Args& a, LAS unsigned char* lds, int bid, int G) {
    const int tid = threadIdx.x, lane = tid & 63, wave = __builtin_amdgcn_readfirstlane(tid >> 6);
    if (tid == 0) {
        unsigned* mc = (unsigned*)(a.ws + WS_CTL) + CW_MODCNT; unsigned sp = 0;
        while (__hip_atomic_load(mc, __ATOMIC_RELAXED, __HIP_MEMORY_SCOPE_AGENT) < 192u) { __builtin_amdgcn_s_sleep(2); if (++sp > (1u << 22)) break; }
        __builtin_amdgcn_fence(__ATOMIC_ACQUIRE, "agent"); asm volatile("s_waitcnt vmcnt(0)" ::: "memory"); }
    __syncthreads();
    const float* x = a.in[0]; const float* g1 = a.in[4]; const float* w_in = a.in[5]; const float* b_if = a.in[6];
    const float* mod = (const float*)(a.ws + WS_MOD); bf16* h1 = (bf16*)(a.ws + WS_H); float* gates = (float*)(a.ws + WS_GATES);
    LAS float* tab = (LAS float*)lds;
    for (int k = tid; k < 1024; k += NTHREADS) { const int p = ((k >> 8) << 2) | (k & 3), l = (k >> 2) & 63;
        const f32x4 w0 = *(const f32x4*)(w_in + (size_t)k * DIN + 3072), w1 = *(const f32x4*)(w_in + (size_t)k * DIN + 3076);
        *(LAS f32x4*)(tab + (p * 64 + l) * 8) = w0; *(LAS f32x4*)(tab + (p * 64 + l) * 8 + 4) = w1; }
    __syncthreads();
    if (!(a.flags & 512)) {
        const float* g2 = a.in[17]; const float* w_rg = a.in[18]; const float* b_rg = a.in[19]; const float* w_re = a.in[20]; const float* b_re = a.in[21];
        float* rbias = (float*)(a.ws + WS_RBIAS); v4u* rw = (v4u*)(a.ws + WS_RW);
        const int gw = bid * NWAVES + wave, NGW = G * NWAVES;
        for (int it = gw; it < 8 * 36; it += NGW) { const int b = it / 36, n = it % 36; float sacc = 0.f;
#pragma unroll
            for (int i = 0; i < 16; ++i) { const int k = lane + 64 * i; const float w = (n < 4) ? w_rg[k * 4 + n] : w_re[k * 32 + n - 4]; sacc += mod[b * 6144 + 3072 + k] * w; }
            sacc = wave_sum(sacc);
            if (lane == 0) rbias[b * 48 + n] = sacc + ((n < 4) ? b_rg[n] : b_re[n - 4]); }
        for (int it = gw; it < 8 * 8 * 4 * 3; it += NGW) {
            const int nt = it % 3, kk = (it / 3) & 3, w8 = (it / 12) & 7, b = it / 96;
            const int n = 16 * nt + (lane & 15), k0 = 128 * w8 + 32 * kk + 8 * (lane >> 4);
            f32x4 w0, w1;
#pragma unroll
            for (int j = 0; j < 8; ++j) { const int k = k0 + j; const float* wp = (n < 4) ? (w_rg + k * 4 + n) : (w_re + k * 32 + ((n < 36) ? n - 4 : 0));
                float w = *wp; w = (n < 36) ? w : 0.f;
                w *= g2[k] * (1.f + mod[b * 6144 + 4096 + k]); if (j < 4) w0[j] = w; else w1[j - 4] = w; }
            bf16x8 hi, lo; split8(w0, w1, hi, lo);
            rw[((size_t)it * 2) * 64 + lane] = __builtin_bit_cast(v4u, hi); rw[((size_t)it * 2 + 1) * 64 + lane] = __builtin_bit_cast(v4u, lo);
        }
    }
    const float bifv = b_if[lane & 7];
    if (!(a.flags & 256)) for (int tile = bid; tile < T / 64; tile += G) {
        const int b = tile / 32;
        float sc[4][4], sh[4][4];
#pragma unroll
        for (int j = 0; j < 4; ++j) { const int k = 256 * j + 4 * lane; const f32x4 gv = *(const f32x4*)(g1 + k), sv = *(const f32x4*)(mod + b * 6144 + 1024 + k), hv = *(const f32x4*)(mod + b * 6144 + k);
#pragma unroll
            for (int i = 0; i < 4; ++i) { sc[j][i] = gv[i] * (1.f + sv[i]); sh[j][i] = hv[i]; } }
        const int rot = (tile * 9) & 63;
        f32x4 nx[4][4];
#pragma unroll
        for (int p = 0; p < 4; ++p)
#pragma unroll
            for (int j = 0; j < 4; ++j) nx[p][j] = *(const f32x4*)(x + ((size_t)tile * 64 + ((wave + 8 * p + rot) & 63)) * 1024 + 256 * j + 4 * lane);
#pragma unroll
        for (int r8 = 0; r8 < 8; ++r8) {
            const int r = (wave + 8 * r8 + rot) & 63;
            const size_t row = (size_t)tile * 64 + r;
            f32x4 v[4]; float ss = 0.f;
#pragma unroll
            for (int j = 0; j < 4; ++j) { v[j] = nx[r8 & 3][j]; ss += (v[j][0] * v[j][0] + v[j][1] * v[j][1]) + (v[j][2] * v[j][2] + v[j][3] * v[j][3]); }
            if (r8 + 4 < 8) {
#pragma unroll
                for (int j = 0; j < 4; ++j) nx[r8 & 3][j] = *(const f32x4*)(x + ((size_t)tile * 64 + ((r + 32) & 63)) * 1024 + 256 * j + 4 * lane); }
            asm volatile("" ::: "memory");
            const float rstd = rsqrtf(wave_sum(ss) * (1.f / 1024.f) + RMS_EPS);
            float g[8];
#pragma unroll
            for (int q = 0; q < 8; ++q) g[q] = 0.f;
#pragma unroll
            for (int j = 0; j < 4; ++j) {
                float hh[4];
#pragma unroll
                for (int i = 0; i < 4; ++i) hh[i] = v[j][i] * rstd * sc[j][i] + sh[j][i];
                v2u o; o.x = pk2(hh[0], hh[1]); o.y = pk2(hh[2], hh[3]);
                if (!(a.flags & 2048)) *(v2u*)(h1 + row * 1024 + 256 * j + 4 * lane) = o;
                if (!(a.flags & 1024))
#pragma unroll
                for (int i = 0; i < 4; ++i) { const LAS float* tp = tab + ((4 * j + i) * 64 + lane) * 8; const f32x4 w0 = *(const LAS f32x4*)tp, w1 = *(const LAS f32x4*)(tp + 4);
                    g[0] += hh[i] * w0[0]; g[1] += hh[i] * w0[1]; g[2] += hh[i] * w0[2]; g[3] += hh[i] * w0[3]; g[4] += hh[i] * w1[0]; g[5] += hh[i] * w1[1]; g[6] += hh[i] * w1[2]; g[7] += hh[i] * w1[3]; }
            }
            float mine = 0.f;
            if (!(a.flags & 1024))
#pragma unroll
            for (int q = 0; q < 8; ++q) { const float sq = wave_sum(g[q]); mine = (lane == q) ? sq : mine; }
            if (lane < 8 && !(a.flags & 1024)) { const float vv = mine + bifv; gates[row * 8 + lane] = (lane < 4) ? vv : logsigmoidf_(vv); }
        }
    }
}

DEV void p3_conva(const Args& a, LAS unsigned char* lds, int bid, int G) {
    const int tid = threadIdx.x, lane = tid & 63, wave = __builtin_amdgcn_readfirstlane(tid >> 6), sub = wave & 3, gsel = wave >> 2;
    const bf16* zu = (const bf16*)(a.ws + WS_ZU); bf16* uahm = (bf16*)(a.ws + WS_UAHM);
    const float* cw = a.in[7]; const float* cb = a.in[8]; const float* lg = a.in[9]; const float* lb = a.in[10];
    LAS float* red = (LAS float*)(lds + LDS_TAB);
    const int c0 = 128 * sub + 2 * lane;
    float w0[31], w1[31];
#pragma unroll
    for (int k = 0; k < 31; ++k) { w0[k] = cw[k * 512 + c0]; w1[k] = cw[k * 512 + c0 + 1]; }
    const float bias0 = cb[c0], bias1 = cb[c0 + 1], lg0 = lg[c0], lg1 = lg[c0 + 1], lb0 = lb[c0], lb1 = lb[c0 + 1];
    for (int it = bid; it < T / 32; it += G) {
        const int grp = it * 2 + gsel, tbase = grp * 16, s0 = tbase & (SEQ - 1);
        float acc0[16], acc1[16];
#pragma unroll
        for (int i = 0; i < 16; ++i) { acc0[i] = bias0; acc1[i] = bias1; }
#pragma unroll
        for (int r = 0; r < 46; ++r) {
            const int sp = s0 - 30 + r; const int src = tbase - 30 + r + ((sp < 0) ? -sp : 0); const float msk = (sp < 0) ? 0.f : 1.f;
            const unsigned wv = *(const unsigned*)(zu + (size_t)src * 512 + c0);
            const float u0 = bflo(wv) * msk, u1 = bfhi(wv) * msk;
#pragma unroll
            for (int i = 0; i < 16; ++i) { const int k = r - i; if (k >= 0 && k <= 30) { acc0[i] += w0[k] * u0; acc1[i] += w1[k] * u1; } }
        }
        float mean[16];
#pragma unroll
        for (int i = 0; i < 16; ++i) { const float s = wave_sum(acc0[i] + acc1[i]); if (lane == 0) red[(gsel * 4 + sub) * 16 + i] = s; }
        __syncthreads();
#pragma unroll
        for (int i = 0; i < 16; ++i) mean[i] = ((red[(gsel * 4 + 0) * 16 + i] + red[(gsel * 4 + 1) * 16 + i]) + (red[(gsel * 4 + 2) * 16 + i] + red[(gsel * 4 + 3) * 16 + i])) * (1.f / 512.f);
        __syncthreads();
#pragma unroll
        for (int i = 0; i < 16; ++i) { const float d0 = acc0[i] - mean[i], d1 = acc1[i] - mean[i]; const float s = wave_sum(d0 * d0 + d1 * d1); if (lane == 0) red[(gsel * 4 + sub) * 16 + i] = s; }
        __syncthreads();
#pragma unroll
        for (int i = 0; i < 16; ++i) {
            const float var = ((red[(gsel * 4 + 0) * 16 + i] + red[(gsel * 4 + 1) * 16 + i]) + (red[(gsel * 4 + 2) * 16 + i] + red[(gsel * 4 + 3) * 16 + i])) * (1.f / 512.f);
            const float rstd = rsqrtf(var + LN_EPS);
            const float y0 = (acc0[i] - mean[i]) * rstd * lg0 + lb0, y1 = (acc1[i] - mean[i]) * rstd * lg1 + lb1;
            *(unsigned*)(uahm + (size_t)(tbase + i) * 1024 + c0) = pk2(siluf_(y0), siluf_(y1));
        }
        __syncthreads();
    }
}

constexpr int ML_QS = 0, ML_KS = 17408, ML_KWT = 34816, ML_VT = 53248, ML_PS = 73984, ML_CT = 83200, ML_GT = 122368, ML_CW = 123648, ML_DEN = 128768, ML_PART = 129024, ML_VS = 130048;
template <bool OUT>
DEV void mlstm_unit(const Args& a, LAS unsigned char* lds, int unit) {
    int tid = threadIdx.x; asm volatile("" : "+v"(tid));
    const int lane = tid & 63, wave = __builtin_amdgcn_readfirstlane(tid >> 6), l15 = lane & 15, q4 = lane >> 4;
    const int j = unit & 7, bh = unit >> 3, h = bh & 3, b = bh >> 2, t0 = b * SEQ + 256 * j;
    const bf16* zq = (const bf16*)(a.ws + WS_ZQ); const bf16* zk = (const bf16*)(a.ws + WS_ZK); const bf16* zv = (const bf16*)(a.ws + WS_ZV); const bf16* zo = (const bf16*)(a.ws + WS_ZO);
    const float* gates = (const float*)(a.ws + WS_GATES); float* state = (float*)(a.ws + WS_STATE); float* stsc = (float*)(a.ws + WS_STSC);
    bf16* uahm = (bf16*)(a.ws + WS_UAHM); const float* qkw = a.in[12]; const float* qkb = a.in[13]; const float* mng = a.in[14];
    LAS bf16* QS = (LAS bf16*)(lds + ML_QS); LAS bf16* KS = (LAS bf16*)(lds + ML_KS); LAS bf16* KWT = (LAS bf16*)(lds + ML_KWT); LAS bf16* VT = (LAS bf16*)(lds + ML_VT);
    LAS bf16* PS = (LAS bf16*)(lds + ML_PS); LAS bf16* CT = (LAS bf16*)(lds + ML_CT); LAS bf16* VS = (LAS bf16*)(lds + ML_VS);
    LAS float* GTwk = (LAS float*)(lds + ML_GT); LAS float* GTsi = GTwk + 64; LAS float* GTlb = GTwk + 128; LAS float* GTg = GTwk + 192; LAS float* GTM = GTwk + 256;
    LAS float* CW = (LAS float*)(lds + ML_CW); LAS float* DEN = (LAS float*)(lds + ML_DEN); LAS float* PART = (LAS float*)(lds + ML_PART);
    __syncthreads();
    for (int i = tid; i < 1280; i += NTHREADS) {
        const float* p = (i < 512) ? (qkw + (i >> 7) * 1024 + h * 128 + (i & 127)) : (i < 1024) ? (qkw + ((i - 512) >> 7) * 1024 + 512 + h * 128 + (i & 127))
                       : (i < 1152) ? (qkb + h * 128 + (i - 1024)) : (qkb + 512 + h * 128 + (i - 1152));
        CW[i] = *p; }
    for (int i = tid; i < 16 * 72; i += NTHREADS) VT[128 * 72 + i] = (i < 64) ? (bf16)0x3F80 : (bf16)0;
    f32x4 accC[9];
#pragma unroll
    for (int i = 0; i < 9; ++i) accC[i] = (f32x4){0.f, 0.f, 0.f, 0.f};
    float mc = OUT ? 0.f : -1e30f, Btot = 0.f;
    if (OUT) {
        float wgt[7];
        {
            const int base = unit - j; float mi[7], Bi[7];
#pragma unroll
            for (int i = 0; i < 7; ++i) { const int u2 = base + ((i < j) ? i : 0); mi[i] = stsc[u2 * 4]; Bi[i] = stsc[u2 * 4 + 1]; }
#pragma unroll
            for (int i = 0; i < 7; ++i) if (i < j) mc = fmaxf(Bi[i] + mc, mi[i]);
            float suf = 0.f;
#pragma unroll
            for (int i = 6; i >= 0; --i) { wgt[i] = (i < j) ? __expf(mi[i] + suf - mc) : 0.f; if (i < j) suf += Bi[i]; }
        }
#pragma unroll
        for (int ii = 0; ii < 9; ++ii) {
            f32x4 ld[7];
#pragma unroll
            for (int i = 0; i < 7; ++i) { const size_t u2 = (size_t)(unit - j + ((i < j) ? i : 0));
#pragma unroll
                for (int r = 0; r < 4; ++r) ld[i][r] = state[(u2 * 36 + ii * 4 + r) * 512 + tid]; }
#pragma unroll
            for (int i = 0; i < 7; ++i) accC[ii] = accC[ii] + ld[i] * wgt[i];
        }
#pragma unroll
        for (int ii = 0; ii < 9; ++ii)
#pragma unroll
            for (int r = 0; r < 4; ++r) CT[(16 * ii + 4 * q4 + r) * 136 + 16 * wave + l15] = f2bf(accC[ii][r]);
    }
    float mg[4];
    if (OUT) {
#pragma unroll
        for (int i = 0; i < 4; ++i) mg[i] = mng[h * 128 + 16 * (4 * (wave & 1) + i) + l15];
    }
    __syncthreads();
    float li_n = gates[(size_t)(t0 + lane) * 8 + h], lf_n = gates[(size_t)(t0 + lane) * 8 + 4 + h];
    for (int cc = 0; cc < 4; ++cc) {
        const int tc = t0 + 64 * cc;
        const float li = li_n, lf = lf_n;
        if (cc < 3) { li_n = gates[(size_t)(tc + 64 + lane) * 8 + h]; lf_n = gates[(size_t)(tc + 64 + lane) * 8 + 4 + h]; }
        const float bc = wave_scan_add(lf, lane);
        const float g = li - bc;
        const float cm = wave_scan_max(g, lane);
        const float M = fmaxf(mc, cm);
        const float M63 = rdlane(M, 63), blast = rdlane(bc, 63);
        const float wkv = __expf(g - M63), sc = __expf(mc - M63), mnew = blast + M63;
        if (wave == 0) { GTwk[lane] = wkv; GTsi[lane] = __expf(mc - M); GTlb[lane] = __expf(-(bc + M)); GTg[lane] = g; GTM[lane] = M; }
        {
            const int cg = tid & 15, rp = tid >> 4, s0 = 2 * rp;
            v4u kraw[5], qraw[5], vraw[2];
#pragma unroll
            for (int m = 0; m < 5; ++m) { const int spos = 256 * j + 64 * cc + s0 - 3 + m; const bool ok = spos >= 0; const int src = ok ? (tc + s0 - 3 + m) : tc;
                kraw[m] = *(const v4u*)(zk + (size_t)src * 512 + h * 128 + cg * 8); }
#pragma unroll
            for (int rr = 0; rr < 2; ++rr) vraw[rr] = *(const v4u*)(zv + (size_t)(tc + s0 + rr) * 512 + h * 128 + cg * 8);
#define ML_CONV(RAW, WOFF, BOFF, DST, SCALE) do { float ac[2][8]; \
            _Pragma("unroll") for (int e = 0; e < 8; ++e) { ac[0][e] = ac[1][e] = CW[(BOFF) + cg * 8 + e]; } \
            _Pragma("unroll") for (int m = 0; m < 5; ++m) { const v4u rw_ = RAW[m]; const float ms = (256 * j + 64 * cc + s0 - 3 + m >= 0) ? 1.f : 0.f; \
                const float xv[8] = {bflo(rw_.x) * ms, bfhi(rw_.x) * ms, bflo(rw_.y) * ms, bfhi(rw_.y) * ms, bflo(rw_.z) * ms, bfhi(rw_.z) * ms, bflo(rw_.w) * ms, bfhi(rw_.w) * ms}; \
                _Pragma("unroll") for (int rr = 0; rr < 2; ++rr) { const int tap = m - rr; if (tap >= 0 && tap < 4) { \
                    _Pragma("unroll") for (int e = 0; e < 8; ++e) ac[rr][e] += CW[(WOFF) + tap * 128 + cg * 8 + e] * xv[e]; } } } \
            _Pragma("unroll") for (int rr = 0; rr < 2; ++rr) { v4u o; \
                o.x = pk2(siluf_(ac[rr][0]) * (SCALE), siluf_(ac[rr][1]) * (SCALE)); o.y = pk2(siluf_(ac[rr][2]) * (SCALE), siluf_(ac[rr][3]) * (SCALE)); \
                o.z = pk2(siluf_(ac[rr][4]) * (SCALE), siluf_(ac[rr][5]) * (SCALE)); o.w = pk2(siluf_(ac[rr][6]) * (SCALE), siluf_(ac[rr][7]) * (SCALE)); \
                *(LAS v4u*)((DST) + (s0 + rr) * 136 + cg * 8) = o; } } while (0)
            if (OUT) {
#pragma unroll
                for (int m = 0; m < 5; ++m) { const int spos = 256 * j + 64 * cc + s0 - 3 + m; const int src = (spos >= 0) ? (tc + s0 - 3 + m) : tc; qraw[m] = *(const v4u*)(zq + (size_t)src * 512 + h * 128 + cg * 8); } }
            ML_CONV(kraw, 512, 1152, KS, 1.f);
            asm volatile("" ::: "memory");
            if (OUT) ML_CONV(qraw, 0, 1024, QS, 0.08838834764831845f);
#undef ML_CONV
#pragma unroll
            for (int rr = 0; rr < 2; ++rr) *(LAS v4u*)(VS + (s0 + rr) * 136 + cg * 8) = vraw[rr];
        }
        __syncthreads();
        if (OUT) {
            const int tt = wave >> 1;
#pragma unroll
            for (int si = 0; si < 2; ++si) {
                const int st = 2 * (wave & 1) + si;
                f32x4 sacc = (f32x4){0.f, 0.f, 0.f, 0.f};
                if (st <= tt) {
#pragma unroll
                    for (int kk = 0; kk < 4; ++kk) sacc = mma16(*(const LAS bf16x8*)(QS + (16 * tt + l15) * 136 + 32 * kk + 8 * q4), *(const LAS bf16x8*)(KS + (16 * st + l15) * 136 + 32 * kk + 8 * q4), sacc);
                }
                const int sl = 16 * st + l15; const float gs = GTg[sl];
#pragma unroll
                for (int r = 0; r < 4; ++r) { const int tl = 16 * tt + 4 * q4 + r; const float w = (sl <= tl) ? __expf(gs - GTM[tl]) : 0.f; PS[tl * 72 + sl] = f2bf(sacc[r] * w); }
            }
        }
        {
            const int d = tid & 127, sg = tid >> 7; float kv[16];
#pragma unroll
            for (int i = 0; i < 16; ++i) kv[i] = bf2f(KS[(16 * sg + i) * 136 + d]) * GTwk[16 * sg + i];
            v4u o0, o1;
            o0.x = pk2(kv[0], kv[1]); o0.y = pk2(kv[2], kv[3]); o0.z = pk2(kv[4], kv[5]); o0.w = pk2(kv[6], kv[7]);
            o1.x = pk2(kv[8], kv[9]); o1.y = pk2(kv[10], kv[11]); o1.z = pk2(kv[12], kv[13]); o1.w = pk2(kv[14], kv[15]);
            *(LAS v4u*)(KWT + d * 72 + 16 * sg) = o0; *(LAS v4u*)(KWT + d * 72 + 16 * sg + 8) = o1;
            unsigned vw[8];
#pragma unroll
            for (int i = 0; i < 8; ++i) vw[i] = (unsigned)VS[(16 * sg + 2 * i) * 136 + d] | ((unsigned)VS[(16 * sg + 2 * i + 1) * 136 + d] << 16);
            o0.x = vw[0]; o0.y = vw[1]; o0.z = vw[2]; o0.w = vw[3]; o1.x = vw[4]; o1.y = vw[5]; o1.z = vw[6]; o1.w = vw[7];
            *(LAS v4u*)(VT + d * 72 + 16 * sg) = o0; *(LAS v4u*)(VT + d * 72 + 16 * sg + 8) = o1;
        }
        __syncthreads();
        f32x4 res[5];
        if (OUT) {
            const int tt = wave >> 1, dv0 = 4 * (wave & 1);
            bf16x8 pa[2], qa[4];
#pragma unroll
            for (int kk = 0; kk < 2; ++kk) pa[kk] = *(const LAS bf16x8*)(PS + (16 * tt + l15) * 72 + 32 * kk + 8 * q4);
#pragma unroll
            for (int kk = 0; kk < 4; ++kk) qa[kk] = *(const LAS bf16x8*)(QS + (16 * tt + l15) * 136 + 32 * kk + 8 * q4);
            float si[4];
#pragma unroll
            for (int r = 0; r < 4; ++r) si[r] = GTsi[16 * tt + 4 * q4 + r];
#pragma unroll
            for (int i = 0; i < 5; ++i) {
                const int dvt = (i < 4) ? (dv0 + i) : 8;
                if (i < 4 || (wave & 1) == 0) {
                    f32x4 a1 = (f32x4){0.f, 0.f, 0.f, 0.f}, a2 = (f32x4){0.f, 0.f, 0.f, 0.f};
#pragma unroll
                    for (int kk = 0; kk < 2; ++kk) a1 = mma16(pa[kk], *(const LAS bf16x8*)(VT + (16 * dvt + l15) * 72 + 32 * kk + 8 * q4), a1);
#pragma unroll
                    for (int kk = 0; kk < 4; ++kk) a2 = mma16(qa[kk], *(const LAS bf16x8*)(CT + (16 * dvt + l15) * 136 + 32 * kk + 8 * q4), a2);
#pragma unroll
                    for (int r = 0; r < 4; ++r) res[i][r] = a1[r] + si[r] * a2[r];
                } else res[i] = (f32x4){0.f, 0.f, 0.f, 0.f};
            }
            if ((wave & 1) == 0 && l15 == 0) {
#pragma unroll
                for (int r = 0; r < 4; ++r) DEN[16 * tt + 4 * q4 + r] = res[4][r];
            }
        }
        {
            bf16x8 kb[2];
#pragma unroll
            for (int kk = 0; kk < 2; ++kk) kb[kk] = *(const LAS bf16x8*)(KWT + (16 * wave + l15) * 72 + 32 * kk + 8 * q4);
#pragma unroll
            for (int i = 0; i < 9; ++i) { accC[i] = accC[i] * sc;
#pragma unroll
                for (int kk = 0; kk < 2; ++kk) accC[i] = mma16(*(const LAS bf16x8*)(VT + (16 * i + l15) * 72 + 32 * kk + 8 * q4), kb[kk], accC[i]); }
        }
        __syncthreads();
        if (OUT) {
            const int tt = wave >> 1;
            float den[4], lbv[4];
#pragma unroll
            for (int r = 0; r < 4; ++r) { den[r] = DEN[16 * tt + 4 * q4 + r]; lbv[r] = GTlb[16 * tt + 4 * q4 + r]; }
#pragma unroll
            for (int r = 0; r < 4; ++r) { const float inv = 1.f / fmaxf(fabsf(den[r]), lbv[r]); float s1 = 0.f, s2 = 0.f;
#pragma unroll
                for (int i = 0; i < 4; ++i) { res[i][r] *= inv; s1 += res[i][r]; s2 += res[i][r] * res[i][r]; }
                s1 = row16_sum(s1); s2 = row16_sum(s2);
                if (l15 == 0) { PART[((16 * tt + 4 * q4 + r) * 2 + (wave & 1)) * 2] = s1; PART[((16 * tt + 4 * q4 + r) * 2 + (wave & 1)) * 2 + 1] = s2; } }
#pragma unroll
            for (int ii = 0; ii < 9; ++ii)
#pragma unroll
                for (int r = 0; r < 4; ++r) CT[(16 * ii + 4 * q4 + r) * 136 + 16 * wave + l15] = f2bf(accC[ii][r]);
            __syncthreads();
#pragma unroll
            for (int r = 0; r < 4; ++r) { const int tl = 16 * tt + 4 * q4 + r; const size_t trow = (size_t)(tc + tl);
                const float s1 = PART[(tl * 2) * 2] + PART[(tl * 2 + 1) * 2], s2 = PART[(tl * 2) * 2 + 1] + PART[(tl * 2 + 1) * 2 + 1];
                const float mean = s1 * (1.f / 128.f), var = fmaxf(s2 * (1.f / 128.f) - mean * mean, 0.f), rstd = rsqrtf(var + LN_EPS);
#pragma unroll
                for (int i = 0; i < 4; ++i) { const int dvv = 16 * (4 * (wave & 1) + i) + l15;
                    const float y = (res[i][r] - mean) * rstd * mg[i] * bf2f(zo[trow * 512 + h * 128 + dvv]);
                    uahm[trow * 1024 + 512 + h * 128 + dvv] = f2bf(y); } }
        }
        mc = mnew; Btot += blast;
    }
    if (!OUT) {
#pragma unroll
        for (int ii = 0; ii < 9; ++ii)
#pragma unroll
            for (int r = 0; r < 4; ++r) state[((size_t)unit * 36 + ii * 4 + r) * 512 + tid] = accC[ii][r];
        if (tid == 0) { stsc[unit * 4] = mc; stsc[unit * 4 + 1] = Btot; }
    }
}

DEV void p8_route(const Args& a, LAS unsigned char* lds, int bid, int G) {
    const int tid = threadIdx.x, lane = tid & 63, wave = __builtin_amdgcn_readfirstlane(tid >> 6), l15 = lane & 15, q4 = lane >> 4;
    const float* x1 = a.out; const float* g2 = a.in[17]; const float* w_rg = a.in[18]; const float* w_re = a.in[20];
    const float* mod = (const float*)(a.ws + WS_MOD); const float* rbias = (const float*)(a.ws + WS_RBIAS); const v4u* rw = (const v4u*)(a.ws + WS_RW); bf16* h2 = (bf16*)(a.ws + WS_H);
    int* toke = (int*)(a.ws + WS_TOKE); float* tokw = (float*)(a.ws + WS_TOKW);
    int* listt = (int*)(a.ws + WS_LISTT); float* listw = (float*)(a.ws + WS_LISTW); unsigned* cnt = (unsigned*)(a.ws + WS_CTL) + CW_CNT;
    LAS float* PL = (LAS float*)lds;
    LAS float* SS = (LAS float*)(lds + 98304);
    LAS float* LG = (LAS float*)(lds + 100352);
    LAS float* RS = (LAS float*)(lds + 109568);
    LAS unsigned* lcnt = (LAS unsigned*)(lds + LDS_MISC + 256);
    LAS unsigned* lbase = lcnt + 32;
    LAS unsigned* lent = lcnt + 64;
    LAS float* lwt = (LAS float*)(lcnt + 192);
    for (int tile = bid; tile < T / 64; tile += G) {
        const int b = tile / 32;
        __syncthreads();
        if (tid < 32) lcnt[tid] = 0u;
        f32x4 acc[4][3]; float ss[4];
#pragma unroll
        for (int rt = 0; rt < 4; ++rt) { ss[rt] = 0.f;
#pragma unroll
            for (int nt = 0; nt < 3; ++nt) acc[rt][nt] = (f32x4){0.f, 0.f, 0.f, 0.f}; }
#pragma unroll 1
        for (int kk = 0; kk < 4; ++kk) {
            const int k0 = 128 * wave + 32 * kk + 8 * q4;
            bf16x8 bhi[3], blo[3];
#pragma unroll
            for (int nt = 0; nt < 3; ++nt) { const size_t it = ((size_t)(b * 8 + wave) * 4 + kk) * 3 + nt;
                bhi[nt] = __builtin_bit_cast(bf16x8, rw[(it * 2) * 64 + lane]); blo[nt] = __builtin_bit_cast(bf16x8, rw[(it * 2 + 1) * 64 + lane]); }
#pragma unroll
            for (int rt = 0; rt < 4; ++rt) {
                const float* xp = x1 + ((size_t)tile * 64 + 16 * rt + l15) * 1024 + k0;
                const f32x4 xa = *(const f32x4*)xp, xb = *(const f32x4*)(xp + 4);
                ss[rt] += (xa[0] * xa[0] + xa[1] * xa[1]) + (xa[2] * xa[2] + xa[3] * xa[3]) + (xb[0] * xb[0] + xb[1] * xb[1]) + (xb[2] * xb[2] + xb[3] * xb[3]);
                bf16x8 ahi, alo; split8(xa, xb, ahi, alo);
#pragma unroll
                for (int nt = 0; nt < 3; ++nt) { acc[rt][nt] = mma16(ahi, bhi[nt], acc[rt][nt]); acc[rt][nt] = mma16(alo, bhi[nt], acc[rt][nt]); acc[rt][nt] = mma16(ahi, blo[nt], acc[rt][nt]); }
            }
        }
#pragma unroll
        for (int rt = 0; rt < 4; ++rt) {
            float sv = ss[rt]; sv += __shfl_xor(sv, 16); sv += __shfl_xor(sv, 32);
            if (q4 == 0) SS[wave * 64 + 16 * rt + l15] = sv;
#pragma unroll
            for (int nt = 0; nt < 3; ++nt)
#pragma unroll
                for (int r = 0; r < 4; ++r) PL[(wave * 64 + 16 * rt + 4 * q4 + r) * 48 + 16 * nt + l15] = acc[rt][nt][r];
        }
        __syncthreads();
        {
            const int row = tid >> 3, part = tid & 7;
            float ssum = 0.f;
#pragma unroll
            for (int w = 0; w < 8; ++w) ssum += SS[w * 64 + row];
            const float rstd = rsqrtf(ssum * (1.f / 1024.f) + RMS_EPS);
            if (part == 0) RS[row] = rstd;
#pragma unroll
            for (int i = 0; i < 5; ++i) { const int n = part + 8 * i; if (n < 36) { float s = 0.f;
#pragma unroll
                    for (int w = 0; w < 8; ++w) s += PL[(w * 64 + row) * 48 + n];
                    LG[row * 36 + n] = rstd * s + rbias[b * 48 + n]; } }
        }
        __syncthreads();
        if (tid < 64) {
            const int r = tid; const size_t row = (size_t)tile * 64 + r;
            float lg[36];
#pragma unroll
            for (int q = 0; q < 36; ++q) lg[q] = LG[r * 36 + q];
            int gs = 0; float gm = lg[0];
#pragma unroll
            for (int q = 1; q < 4; ++q) if (lg[q] > gm) { gm = lg[q]; gs = q; }
            float se = 0.f;
#pragma unroll
            for (int q = 0; q < 4; ++q) se += __expf(lg[q] - gm);
            const float pg = 1.f / se;
            float le[8];
#pragma unroll
            for (int q = 0; q < 8; ++q) { float vsel = lg[4 + q];
#pragma unroll
                for (int gg = 1; gg < 4; ++gg) vsel = (gs == gg) ? lg[4 + 8 * gg + q] : vsel;
                le[q] = vsel; }
            int e0 = 0; float l0 = le[0];
#pragma unroll
            for (int q = 1; q < 8; ++q) if (le[q] > l0) { l0 = le[q]; e0 = q; }
            int e1 = -1; float l1 = -3.0e38f;
#pragma unroll
            for (int q = 0; q < 8; ++q) if (q != e0 && le[q] > l1) { l1 = le[q]; e1 = q; }
            const float rr = __expf(l1 - l0), w0 = pg / (1.f + rr), w1 = pg * rr / (1.f + rr);
#pragma unroll
            for (int sl = 0; sl < 2; ++sl) { const int e = gs * 8 + (sl ? e1 : e0); const float w = sl ? w1 : w0;
                toke[row * 2 + sl] = e; tokw[row * 2 + sl] = w;
                const unsigned lp = __hip_atomic_fetch_add(lcnt + e, 1u, __ATOMIC_RELAXED, __HIP_MEMORY_SCOPE_WORKGROUP);
                lent[r * 2 + sl] = (unsigned)e | (lp << 8); lwt[r * 2 + sl] = w; }
        }
        __syncthreads();
        if (tid < 32 && !(a.flags & 2)) { const unsigned n = lcnt[tid]; lbase[tid] = n ? atomicAdd(cnt + 16 * tid, n) : 0u; }
        {
            float sc[4][4], sh[4][4];
#pragma unroll
            for (int j = 0; j < 4; ++j) { const int k = 256 * j + 4 * lane; const f32x4 gv = *(const f32x4*)(g2 + k), sv = *(const f32x4*)(mod + b * 6144 + 4096 + k), hv = *(const f32x4*)(mod + b * 6144 + 3072 + k);
#pragma unroll
                for (int i = 0; i < 4; ++i) { sc[j][i] = gv[i] * (1.f + sv[i]); sh[j][i] = hv[i]; } }
            f32x4 nx[4];
#pragma unroll
            for (int j = 0; j < 4; ++j) nx[j] = *(const f32x4*)(x1 + ((size_t)tile * 64 + wave) * 1024 + 256 * j + 4 * lane);
#pragma unroll 1
            for (int r = wave; r < 64; r += NWAVES) {
                const size_t row = (size_t)tile * 64 + r; f32x4 v[4];
#pragma unroll
                for (int j = 0; j < 4; ++j) v[j] = nx[j];
                if (r + NWAVES < 64) {
#pragma unroll
                    for (int j = 0; j < 4; ++j) nx[j] = *(const f32x4*)(x1 + (row + NWAVES) * 1024 + 256 * j + 4 * lane); }
                asm volatile("" ::: "memory");
                const float rstd = RS[r];
#pragma unroll
                for (int j = 0; j < 4; ++j) { v2u o; o.x = pk2(v[j][0] * rstd * sc[j][0] + sh[j][0], v[j][1] * rstd * sc[j][1] + sh[j][1]); o.y = pk2(v[j][2] * rstd * sc[j][2] + sh[j][2], v[j][3] * rstd * sc[j][3] + sh[j][3]);
                    *(v2u*)(h2 + row * 1024 + 256 * j + 4 * lane) = o; }
            }
        }
        __syncthreads();
        if (tid < 128 && !(a.flags & 2)) { const unsigned en = lent[tid]; const unsigned e = en & 255u, lp = en >> 8; const unsigned pos = lbase[e] + lp;
            listt[e * 16384 + pos] = (tile * 64 + (tid >> 1)) * 2 + (tid & 1); listw[e * 16384 + pos] = lwt[tid]; }
    }
    __syncthreads();
}
DEV void p8_convert(const Args& a, LAS unsigned char* lds, int bid, int G) {
    const int tid = threadIdx.x, lane = tid & 63, wave = __builtin_amdgcn_readfirstlane(tid >> 6);
    LAS float* scr = (LAS float*)(lds + wave * 16384);
    const float* wg = a.in[22]; const float* wu = a.in[23]; const float* wd = a.in[24];
    bf16* WGU = (bf16*)(a.ws + WS_WGU); bf16* WD = (bf16*)(a.ws + WS_WD);
    const int gw = bid * NWAVES + wave, NGW = G * NWAVES;
    for (int it = gw; it < 32 * 768; it += NGW) {
        const int e = it / 768; int r = it % 768;
        if (r < 512) { const int up = r >> 8; r &= 255; const int kb = r >> 4, nb = r & 15, n = 32 * nb, np = 256 * (n >> 7) + 128 * up + (n & 127);
            transpose_item((up ? wu : wg) + (size_t)e * 1024 * 512 + (size_t)(64 * kb) * 512 + n, 512, WGU + ((size_t)e * 1024 + np) * 1024 + 64 * kb, 1024, scr, lane); }
        else { r -= 512; const int kb = r >> 5, nb = r & 31;
            transpose_item(wd + (size_t)e * 512 * 1024 + (size_t)(64 * kb) * 1024 + 32 * nb, 1024, WD + ((size_t)e * 1024 + 32 * nb) * 512 + 64 * kb, 512, scr, lane); }
    }
}

struct MoeSched {
    const LAS int* tlist; const LAS int* rstart; const LAS int* ecnt; int U, G, c; unsigned bstride;
    DEV bool next(int i, Unit& u) const {
        const int L = i * G + c; if (L >= U) return false;
        const int ent = tlist[L >> 2]; const int e = ent & 255, rt = ent >> 8; u.pn = L & 3;
        const int left = ecnt[e] - 256 * rt;
        u.pm = 0; u.ak = 0; u.bk = (unsigned)e * bstride; u.slot = i; u.valid = left < 256 ? left : 256; u.arow0 = rstart[e] + 256 * rt; return true;
    }
};
DEV void moe_tables(const Args& a, LAS unsigned char* lds, int bid, int G, MoeSched& S, bool down) {
    const int tid = threadIdx.x;
    LAS int* ti = (LAS int*)(lds + LDS_MISC + 1024); LAS int* rstart = ti, *ecnt = ti + 40, *tlist = ti + 80, *ntl = ti + 260;
    const unsigned* cnt = (const unsigned*)(a.ws + WS_CTL) + CW_CNT;
    const int* listt = (const int*)(a.ws + WS_LISTT); const float* listw = (const float*)(a.ws + WS_LISTW);
    __syncthreads();
    if (tid < 64) {
        const int lane = tid; const int n = (lane < 32) ? (int)__hip_atomic_load(cnt + 16 * (lane & 31), __ATOMIC_RELAXED, __HIP_MEMORY_SCOPE_AGENT) : 0;
        const int ntile = (n + 255) >> 8, nfull = (n + 127) >> 8, ntail = ntile - nfull;
        const int rs = (int)wave_scan_add((float)n, lane) - n, of = (int)wave_scan_add((float)nfull, lane) - nfull, ot = (int)wave_scan_add((float)ntail, lane) - ntail;
        const int totf = (int)rdlane(wave_scan_add((float)nfull, lane), 63), tott = (int)rdlane(wave_scan_add((float)ntail, lane), 63);
        if (lane < 32) { ecnt[lane] = n; rstart[lane] = rs;
            for (int rt = 0; rt < nfull; ++rt) tlist[of + rt] = lane | (rt << 8);
            if (ntail) tlist[totf + ot] = lane | (nfull << 8); }
        if (lane == 32) rstart[32] = rs;
        if (lane == 0) ntl[0] = totf + tott;
    }
    __syncthreads();
    S.tlist = tlist; S.rstart = rstart; S.ecnt = ecnt; S.U = 4 * ntl[0]; S.G = G; S.c = bid;
    LAS unsigned* tab0 = (LAS unsigned*)(lds + LDS_TAB); LAS float* tab1 = (LAS float*)(lds + LDS_TAB + 8192);
    Unit u;
    for (int i = 0; i < 8 && S.next(i, u); ++i) {
        if (tid < 256) { const int e = (int)(u.bk / S.bstride); const int pos = (u.arow0 - rstart[e]) + tid; unsigned v0 = 0u; float v1 = 0.f;
            if (tid < u.valid) { const int tk = listt[e * 16384 + pos]; v0 = down ? (unsigned)tk : (unsigned)(tk >> 1) * 2048u; v1 = listw[e * 16384 + pos]; }
            tab0[i * 256 + tid] = v0; tab1[i * 256 + tid] = v1; }
    }
    __syncthreads();
}

DEV void p11_final(const Args& a, int bid, int G) {
    const int tid = threadIdx.x, lane = tid & 63, wave = __builtin_amdgcn_readfirstlane(tid >> 6);
    const float* mod = (const float*)(a.ws + WS_MOD); const bf16* ys = (const bf16*)(a.ws + WS_YS); const float* gf = a.in[25]; float* out = a.out;
    for (int tile = bid; tile < T / 64; tile += G) {
        const int b = tile / 32;
        f32x4 nx[4], gtv[4], gfv[4]; v2u ny0[4], ny1[4];
#pragma unroll
        for (int j = 0; j < 4; ++j) { const int k = 256 * j + 4 * lane; gtv[j] = *(const f32x4*)(mod + b * 6144 + 5120 + k); gfv[j] = *(const f32x4*)(gf + k); }
#pragma unroll
        for (int j = 0; j < 4; ++j) { const size_t row = (size_t)tile * 64 + wave; const int k = 256 * j + 4 * lane;
            nx[j] = *(const f32x4*)(out + row * 1024 + k); ny0[j] = *(const v2u*)(ys + row * 2048 + k); ny1[j] = *(const v2u*)(ys + row * 2048 + 1024 + k); }
#pragma unroll 1
        for (int r = wave; r < 64; r += NWAVES) {
            const size_t row = (size_t)tile * 64 + r;
            f32x4 v[4]; float ss = 0.f;
#pragma unroll
            for (int j = 0; j < 4; ++j) { const int k = 256 * j + 4 * lane;
                const f32x4 xv = nx[j], gt = gtv[j]; const v2u y0 = ny0[j], y1 = ny1[j];
                v[j][0] = xv[0] + gt[0] * (bflo(y0.x) + bflo(y1.x)); v[j][1] = xv[1] + gt[1] * (bfhi(y0.x) + bfhi(y1.x));
                v[j][2] = xv[2] + gt[2] * (bflo(y0.y) + bflo(y1.y)); v[j][3] = xv[3] + gt[3] * (bfhi(y0.y) + bfhi(y1.y));
                ss += (v[j][0] * v[j][0] + v[j][1] * v[j][1]) + (v[j][2] * v[j][2] + v[j][3] * v[j][3]); }
            if (r + NWAVES < 64) {
#pragma unroll
                for (int j = 0; j < 4; ++j) { const size_t rn = row + NWAVES; const int k = 256 * j + 4 * lane;
                    nx[j] = *(const f32x4*)(out + rn * 1024 + k); ny0[j] = *(const v2u*)(ys + rn * 2048 + k); ny1[j] = *(const v2u*)(ys + rn * 2048 + 1024 + k); } }
            asm volatile("" ::: "memory");
            const float rstd = rsqrtf(wave_sum(ss) * (1.f / 1024.f) + RMS_EPS);
#pragma unroll
            for (int j = 0; j < 4; ++j) { const int k = 256 * j + 4 * lane; *(f32x4*)(out + row * 1024 + k) = v[j] * rstd * gfv[j]; }
        }
    }
}

constexpr int NPHASE = 11;
template <int LO, int HI>
__global__ void __launch_bounds__(NTHREADS, 2) mk_fwd(Args a) {
    extern __shared__ __attribute__((aligned(16))) unsigned char lds_raw[];
    LAS unsigned char* lds = (LAS unsigned char*)lds_raw;
    const int tid = threadIdx.x, G = gridDim.x, bid = blockIdx.x;
    volatile LAS unsigned* MISC = (volatile LAS unsigned*)(lds + LDS_MISC);
    if (tid < 64) MISC[tid] = 0u;
    __syncthreads();
#if MK_ONE
    XcdBarrier bar = xcd_barrier_post((unsigned*)(a.ws + WS_CTL) + CW_BAR, MISC + 8);
#define GRID_BAR() xcd_barrier(bar)
#else
#define GRID_BAR() do {} while (0)
#endif
    constexpr int lo = LO, hi = HI;
#define IN(k) (lo <= (k) && (k) < hi)
#define BOTH(k) (IN(k) && IN((k) + 1))
    if constexpr (IN(0)) { REPK(0) { p0_prologue(a, lds, bid, G); REPSYNC(); } if constexpr (BOTH(0)) __syncthreads(); }
    if constexpr (IN(1)) { REPK(1) { p1_h1(a, lds, bid, G); REPSYNC(); } if constexpr (BOTH(1)) GRID_BAR(); }
    if constexpr (IN(2)) {
        __syncthreads();
        ProbPlain P{(const bf16*)(a.ws + WS_H), (const bf16*)(a.ws + WS_W1T), 2048u, 2048u};
#if DBG_GATEFIRST
        struct SchedG { pg8::StaticOrder so; DEV bool next(int i, Unit& u) const { if (i >= 2) return false; return so.next(i + 3, u); } } S; S.so.init(T, 5120, G, bid);
#else
        pg8::StaticOrder S; S.init(T, 5120, G, bid);
#endif
        Epi1 E{(bf16*)(a.ws + WS_ZU), (bf16*)(a.ws + WS_ZGA), (a.flags >> 8) & 15};
        REPK(2) pg8::gemm_phase<ProbPlain, Epi1, decltype(S), true>(lds, P, S, E, 1024);
        if constexpr (BOTH(2)) GRID_BAR();
    }
    if constexpr (IN(3)) {
        REPK(3) { for (int u = bid; u < 256; u += G) mlstm_unit<false>(a, lds, u);
        __syncthreads(); }
        REPK(11) { p3_conva(a, lds, bid, G); REPSYNC(); }
        if constexpr (BOTH(3)) GRID_BAR();
    }
    if constexpr (IN(4)) {
        REPK(4) { for (int u = bid; u < 256; u += G) mlstm_unit<true>(a, lds, u); REPSYNC(); }
        if constexpr (BOTH(4)) GRID_BAR();
    }
    if constexpr (IN(5)) {
        __syncthreads();
        struct Sched2 { pg8::StaticOrder so; DEV bool next(int i, Unit& u) const { u.ak = (unsigned)(i & 1) * 1024u; u.bk = u.ak; u.slot = i & 1; u.valid = 256; u.arow0 = 0; return so.tile((i >> 1) * so.G + so.c, u.pm, u.pn); } } S;
        S.so.init(T, 1024, G, bid);
        ProbPlain P{(const bf16*)(a.ws + WS_UAHM), (const bf16*)(a.ws + WS_W2T), 2048u, 2048u};
        Epi2 E{(const bf16*)(a.ws + WS_ZGA), (const bf16*)(a.ws + WS_ZGB), (bf16*)(a.ws + WS_MERGED)};
        REPK(5) pg8::gemm_phase<ProbPlain, Epi2, Sched2, false>(lds, P, S, E, 512);
        if constexpr (BOTH(5)) GRID_BAR();
    }
    if constexpr (IN(6)) {
        __syncthreads();
        ProbPlain P{(const bf16*)(a.ws + WS_MERGED), (const bf16*)(a.ws + WS_W3T), 2048u, 2048u};
        pg8::StaticOrder S; S.init(T, 1024, G, bid);
        Epi3 E{a.in[0], (const float*)(a.ws + WS_MOD), a.out};
        REPK(6) pg8::gemm_phase<ProbPlain, Epi3, pg8::StaticOrder, false>(lds, P, S, E, 1024);
        if constexpr (BOTH(6)) GRID_BAR();
    }
    if constexpr (IN(7)) {
        if (!(a.flags & 1)) p8_route(a, lds, bid, G);
        __syncthreads();
        if (!(a.flags & 4)) { p8_convert(a, lds, bid, G); }
        if constexpr (BOTH(7)) GRID_BAR();
    }
    if constexpr (IN(8)) {
        MoeSched S; S.bstride = 1024u * 1024u * 2u;
        moe_tables(a, lds, bid, G, S, false);
        ProbMoeUp P{(const bf16*)(a.ws + WS_H), (const bf16*)(a.ws + WS_WGU), (const LAS unsigned*)(lds + LDS_TAB)};
        EpiUp E{(bf16*)(a.ws + WS_ACT)};
        REPK(8) pg8::gemm_phase<ProbMoeUp, EpiUp, MoeSched, false, true>(lds, P, S, E, 1024);
        if constexpr (BOTH(8)) GRID_BAR();
    }
    if constexpr (IN(9)) {
        MoeSched S; S.bstride = 1024u * 512u * 2u;
        moe_tables(a, lds, bid, G, S, true);
        ProbMoeDown P{(const bf16*)(a.ws + WS_ACT), (const bf16*)(a.ws + WS_WD)};
        EpiDown E{(bf16*)(a.ws + WS_YS), (const LAS unsigned*)(lds + LDS_TAB), (const LAS float*)(lds + LDS_TAB + 8192)};
        REPK(9) pg8::gemm_phase<ProbMoeDown, EpiDown, MoeSched, false, true>(lds, P, S, E, 512);
        if constexpr (BOTH(9)) GRID_BAR();
    }
    if constexpr (IN(10)) { p11_final(a, bid, G); }
#undef IN
#undef BOTH
}

#if NAIVE_MASK
__global__ __launch_bounds__(256) void k_fixw1t(const float* w_in, bf16* W1T) { const size_t i = (size_t)blockIdx.x * 256 + threadIdx.x; const size_t n = i / 1024, k = i % 1024; W1T[(3072 + n) * 1024 + k] = f2bf(w_in[k * 5128 + 3080 + n]); }
DEV float block_sum256(float v, float* red) {
#pragma unroll
    for (int o = 32; o >= 1; o >>= 1) v += __shfl_xor(v, o);
    __syncthreads();
    if ((threadIdx.x & 63) == 0) red[threadIdx.x >> 6] = v;
    __syncthreads();
    return (red[0] + red[1]) + (red[2] + red[3]);
}
__global__ __launch_bounds__(256) void k_mod(const float* c, const float* w_ada, const float* b_ada, float* mod) {
    const int idx = blockIdx.x * 256 + threadIdx.x; const int b = idx / 6144, n = idx % 6144;
    float acc = 0.f;
    for (int k = 0; k < D; ++k) acc += siluf_(c[b * D + k]) * w_ada[(size_t)k * 6144 + n];
    mod[idx] = acc + b_ada[n];
}
__global__ __launch_bounds__(256) void k_h1(const float* x, const float* g1, const float* mod, const float* w_in, const float* b_if, bf16* h1, float* gates) {
    __shared__ float red[4];
    const int t = blockIdx.x, b = t / SEQ, tid = threadIdx.x;
    const float4 xv = ((const float4*)(x + (size_t)t * D))[tid];
    float ss = xv.x * xv.x + xv.y * xv.y + xv.z * xv.z + xv.w * xv.w;
    ss = block_sum256(ss, red);
    const float rstd = rsqrtf(ss * (1.f / D) + RMS_EPS);
    const float* sh = mod + b * 6144, *sc = mod + b * 6144 + 1024;
    float hv[4]; const float xs[4] = {xv.x, xv.y, xv.z, xv.w};
#pragma unroll
    for (int j = 0; j < 4; ++j) { const int k = tid * 4 + j; hv[j] = xs[j] * rstd * g1[k] * (1.f + sc[k]) + sh[k]; }
    ushort4 o; o.x = f2bf(hv[0]); o.y = f2bf(hv[1]); o.z = f2bf(hv[2]); o.w = f2bf(hv[3]);
    ((ushort4*)(h1 + (size_t)t * D))[tid] = o;
    float g[8];
#pragma unroll
    for (int j = 0; j < 8; ++j) g[j] = 0.f;
#pragma unroll
    for (int i = 0; i < 4; ++i) { const float* wr = w_in + (size_t)(tid * 4 + i) * DIN + 3072;
#pragma unroll
        for (int j = 0; j < 8; ++j) g[j] += hv[i] * wr[j]; }
#pragma unroll
    for (int j = 0; j < 8; ++j) g[j] = block_sum256(g[j], red);
    if (tid < 8) { float v = g[0];
#pragma unroll
        for (int j = 1; j < 8; ++j) v = (tid == j) ? g[j] : v;
        v += b_if[tid];
        gates[(size_t)t * 8 + tid] = (tid < 4) ? v : logsigmoidf_(v); }
}
template <class Epi>
__global__ __launch_bounds__(256) void k_ngemm(const bf16* A, int lda, const float* W, int ldw, int N, int K, Epi epi) {
    __shared__ float As[16][68]; __shared__ float Ws[16][68];
    const int tid = threadIdx.x, tx = tid & 15, ty = tid >> 4;
    const int row0 = blockIdx.y * 64, col0 = blockIdx.x * 64;
    float acc[4][4];
#pragma unroll
    for (int i = 0; i < 4; ++i)
#pragma unroll
        for (int j = 0; j < 4; ++j) acc[i][j] = 0.f;
    const int ar = tid >> 2, ak = (tid & 3) * 4;
    const int wk = tid >> 4, wc = (tid & 15) * 4;
    for (int k0 = 0; k0 < K; k0 += 16) {
        const ushort4 av = *(const ushort4*)(A + (size_t)(row0 + ar) * lda + k0 + ak);
        As[ak + 0][ar] = bf2f(av.x); As[ak + 1][ar] = bf2f(av.y); As[ak + 2][ar] = bf2f(av.z); As[ak + 3][ar] = bf2f(av.w);
#pragma unroll
        for (int j = 0; j < 4; ++j) { const int cc = col0 + wc + j; Ws[wk][wc + j] = (cc < N) ? W[(size_t)(k0 + wk) * ldw + cc] : 0.f; }
        __syncthreads();
#pragma unroll
        for (int kk = 0; kk < 16; ++kk) {
            float av2[4], w[4];
#pragma unroll
            for (int i = 0; i < 4; ++i) av2[i] = As[kk][ty * 4 + i];
#pragma unroll
            for (int j = 0; j < 4; ++j) w[j] = Ws[kk][tx * 4 + j];
#pragma unroll
            for (int i = 0; i < 4; ++i)
#pragma unroll
                for (int j = 0; j < 4; ++j) acc[i][j] += av2[i] * w[j];
        }
        __syncthreads();
    }
#pragma unroll
    for (int i = 0; i < 4; ++i)
#pragma unroll
        for (int j = 0; j < 4; ++j) { const int cc = col0 + tx * 4 + j; if (cc < N) epi(row0 + ty * 4 + i, cc, acc[i][j]); }
}
struct NEpi1 {
    float* tmp; bf16 *zq, *zk, *zv, *zo, *zga, *zgb;
    DEV void operator()(int r, int c, float v) const {
        if (c < 1024) tmp[(size_t)r * 1024 + c] = v;
        else if (c < 1536) zq[(size_t)r * 512 + c - 1024] = f2bf(v);
        else if (c < 2048) zk[(size_t)r * 512 + c - 1536] = f2bf(v);
        else if (c < 2560) zv[(size_t)r * 512 + c - 2048] = f2bf(v);
        else if (c < 3072) zo[(size_t)r * 512 + c - 2560] = f2bf(sigmoidf_(v));
        else if (c < 3080) {}
        else if (c < 4104) zga[(size_t)r * 1024 + c - 3080] = f2bf(sigmoidf_(v));
        else zgb[(size_t)r * 1024 + c - 4104] = f2bf(sigmoidf_(v));
    }
};
struct NEpi2a { float* tmp; const bf16* zga; DEV void operator()(int r, int c, float v) const { tmp[(size_t)r * 1024 + c] = v * bf2f(zga[(size_t)r * 1024 + c]); } };
struct NEpi2b { const float* tmp; const bf16* zgb; bf16* merged; DEV void operator()(int r, int c, float v) const { merged[(size_t)r * 1024 + c] = f2bf(tmp[(size_t)r * 1024 + c] + v * bf2f(zgb[(size_t)r * 1024 + c])); } };
struct NEpi3 { const float* x; const float* mod; float* out; DEV void operator()(int r, int c, float v) const { const int b = r / SEQ; out[(size_t)r * 1024 + c] = x[(size_t)r * 1024 + c] + mod[b * 6144 + 2048 + c] * v; } };
__global__ __launch_bounds__(256) void k_glu(const float* tmp, bf16* zu) {
    const size_t i = (size_t)blockIdx.x * 256 + threadIdx.x; const size_t r = i / 512, c = i % 512;
    zu[i] = f2bf(tmp[r * 1024 + c] * sigmoidf_(tmp[r * 1024 + 512 + c]));
}
__global__ __launch_bounds__(256) void k_conva(const bf16* zu, const float* cw, const float* cb, const float* lg, const float* lb, bf16* uahm) {
    __shared__ float red[4];
    const int t = blockIdx.x, s = t % SEQ, tid = threadIdx.x;
    float v[2];
#pragma unroll
    for (int j = 0; j < 2; ++j) { const int c = tid + 256 * j; float a = cb[c];
        for (int k = 0; k < 31; ++k) { const int ss = s - 30 + k; if (ss >= 0) a += cw[k * 512 + c] * bf2f(zu[(size_t)(t - 30 + k) * 512 + c]); }
        v[j] = a; }
    const float mean = block_sum256(v[0] + v[1], red) * (1.f / 512.f);
    const float d0 = v[0] - mean, d1 = v[1] - mean;
    const float var = block_sum256(d0 * d0 + d1 * d1, red) * (1.f / 512.f);
    const float rstd = rsqrtf(var + LN_EPS);
#pragma unroll
    for (int j = 0; j < 2; ++j) { const int c = tid + 256 * j; const float y = (v[j] - mean) * rstd * lg[c] + lb[c]; uahm[(size_t)t * 1024 + c] = f2bf(siluf_(y)); }
}
__global__ __launch_bounds__(256) void k_qkconv(const bf16* zq, const bf16* zk, const float* w, const float* bq, bf16* qc, bf16* kc) {
    const int t = blockIdx.x, s = t % SEQ, tid = threadIdx.x;
#pragma unroll
    for (int j = 0; j < 4; ++j) { const int c = tid + 256 * j; const bf16* src = (c < 512) ? zq : zk; const int cc = c & 511; float a = bq[c];
#pragma unroll
        for (int k = 0; k < 4; ++k) { const int ss = s - 3 + k; if (ss >= 0) a += w[k * 1024 + c] * bf2f(src[(size_t)(t - 3 + k) * 512 + cc]); }
        ((c < 512) ? qc : kc)[(size_t)t * 512 + cc] = f2bf(siluf_(a)); }
}
__global__ __launch_bounds__(256) void k_mlstm_rec(const bf16* qc, const bf16* kc, const bf16* zv, const bf16* zo, const float* gates, const float* mng, bf16* uahm) {
    __shared__ float qs[128], ks[128], vs[128], part[2][128], red[8];
    const int b = blockIdx.x / NH, h = blockIdx.x % NH, tid = threadIdx.x, j = tid & 127, ih = tid >> 7;
    float C[64];
#pragma unroll
    for (int r = 0; r < 64; ++r) C[r] = 0.f;
    float nn = 0.f, m = 0.f;
    for (int s = 0; s < SEQ; ++s) {
        const size_t t = (size_t)b * SEQ + s;
        __syncthreads();
        if (tid < 128) { qs[tid] = bf2f(qc[t * 512 + h * 128 + tid]) * 0.08838834764831845f; ks[tid] = bf2f(kc[t * 512 + h * 128 + tid]); }
        else vs[tid - 128] = bf2f(zv[t * 512 + h * 128 + tid - 128]);
        const float li = gates[t * 8 + h], lf = gates[t * 8 + 4 + h];
        const float mn = fmaxf(lf + m, li), ip = __expf(li - mn), fp = __expf(lf + m - mn); m = mn;
        __syncthreads();
        const float vj = vs[j]; float p = 0.f;
#pragma unroll
        for (int r = 0; r < 64; ++r) { const int i = ih * 64 + r; C[r] = fp * C[r] + ip * ks[i] * vj; p += qs[i] * C[r]; }
        part[ih][j] = p;
        float dn = 0.f;
        if (tid < 128) { nn = fp * nn + ip * ks[tid]; dn = qs[tid] * nn; }
#pragma unroll
        for (int o = 32; o >= 1; o >>= 1) dn += __shfl_xor(dn, o);
        if ((tid & 63) == 0) red[tid >> 6] = dn;
        __syncthreads();
        float hv = 0.f, sm = 0.f;
        if (tid < 128) { const float den = red[0] + red[1]; hv = (part[0][tid] + part[1][tid]) / fmaxf(fabsf(den), __expf(-mn)); sm = hv; }
#pragma unroll
        for (int o = 32; o >= 1; o >>= 1) sm += __shfl_xor(sm, o);
        if ((tid & 63) == 0) red[4 + (tid >> 6)] = sm;
        __syncthreads();
        const float mu = (red[4] + red[5]) * (1.f / 128.f);
        float dv = (tid < 128) ? (hv - mu) : 0.f; float sq = dv * dv;
#pragma unroll
        for (int o = 32; o >= 1; o >>= 1) sq += __shfl_xor(sq, o);
        __syncthreads();
        if ((tid & 63) == 0) red[tid >> 6] = sq;
        __syncthreads();
        if (tid < 128) { const float var = (red[0] + red[1]) * (1.f / 128.f); const float y = dv * rsqrtf(var + LN_EPS) * mng[h * 128 + tid] * bf2f(zo[t * 512 + h * 128 + tid]);
            uahm[t * 1024 + 512 + h * 128 + tid] = f2bf(y); }
    }
}
__global__ __launch_bounds__(256) void k_h2route(const float* x1, const float* g2, const float* mod, const float* w_rg, const float* b_rg, const float* w_re, const float* b_re, bf16* h2, int* toke, float* tokw) {
    __shared__ float red[4]; __shared__ float lg[36];
    const int t = blockIdx.x, b = t / SEQ, tid = threadIdx.x;
    const float4 xv = ((const float4*)(x1 + (size_t)t * D))[tid];
    float ss = xv.x * xv.x + xv.y * xv.y + xv.z * xv.z + xv.w * xv.w;
    ss = block_sum256(ss, red);
    const float rstd = rsqrtf(ss * (1.f / D) + RMS_EPS);
    const float* sh = mod + b * 6144 + 3072, *sc = mod + b * 6144 + 4096;
    float hv[4]; const float xs[4] = {xv.x, xv.y, xv.z, xv.w};
#pragma unroll
    for (int j = 0; j < 4; ++j) { const int k = tid * 4 + j; hv[j] = xs[j] * rstd * g2[k] * (1.f + sc[k]) + sh[k]; }
    ushort4 o; o.x = f2bf(hv[0]); o.y = f2bf(hv[1]); o.z = f2bf(hv[2]); o.w = f2bf(hv[3]);
    ((ushort4*)(h2 + (size_t)t * D))[tid] = o;
    for (int j = 0; j < 36; ++j) {
        float a = 0.f;
#pragma unroll
        for (int i = 0; i < 4; ++i) { const int k = tid * 4 + i; a += hv[i] * ((j < 4) ? w_rg[k * 4 + j] : w_re[k * 32 + j - 4]); }
        a = block_sum256(a, red);
        if (tid == 0) lg[j] = a + ((j < 4) ? b_rg[j] : b_re[j - 4]);
    }
    __syncthreads();
    if (tid == 0) {
        int gs = 0; float gm = lg[0];
        for (int j = 1; j < 4; ++j) if (lg[j] > gm) { gm = lg[j]; gs = j; }
        float se = 0.f; for (int j = 0; j < 4; ++j) se += __expf(lg[j] - gm);
        const float pg = 1.f / se;
        const float* le = lg + 4 + gs * 8;
        int e0 = 0; float l0 = le[0];
        for (int j = 1; j < 8; ++j) if (le[j] > l0) { l0 = le[j]; e0 = j; }
        int e1 = -1; float l1 = -3.0e38f;
        for (int j = 0; j < 8; ++j) if (j != e0 && le[j] > l1) { l1 = le[j]; e1 = j; }
        const float r = __expf(l1 - l0);
        const float w0 = pg / (1.f + r), w1 = pg * r / (1.f + r);
        toke[t * 2] = gs * 8 + e0; toke[t * 2 + 1] = gs * 8 + e1; tokw[t * 2] = w0; tokw[t * 2 + 1] = w1;
    }
}
__global__ __launch_bounds__(256) void k_lists(const int* toke, const float* tokw, unsigned* cnt, int* listt, float* listw) {
    const int i = blockIdx.x * 256 + threadIdx.x; const int e = toke[i]; const unsigned pos = atomicAdd(cnt + 16 * e, 1u);
    listt[e * 16384 + pos] = i; listw[e * 16384 + pos] = tokw[i];
}
__global__ __launch_bounds__(256) void k_moe(const bf16* h2, const int* toke, const float* tokw, const float* wg, const float* wu, const float* wd, bf16* ys) {
    __shared__ float hs[1024]; __shared__ float hid[512];
    const int a = blockIdx.x, t = a >> 1, tid = threadIdx.x;
    const int e = toke[a]; const float w = tokw[a];
    for (int k = tid; k < 1024; k += 256) hs[k] = bf2f(h2[(size_t)t * 1024 + k]);
    __syncthreads();
    const float* Gp = wg + (size_t)e * 1024 * 512, *U = wu + (size_t)e * 1024 * 512, *Dn = wd + (size_t)e * 512 * 1024;
    float g0 = 0.f, g1 = 0.f, u0 = 0.f, u1 = 0.f;
    for (int k = 0; k < 1024; ++k) { const float hk = hs[k]; g0 += hk * Gp[(size_t)k * 512 + tid]; g1 += hk * Gp[(size_t)k * 512 + 256 + tid]; u0 += hk * U[(size_t)k * 512 + tid]; u1 += hk * U[(size_t)k * 512 + 256 + tid]; }
    hid[tid] = siluf_(g0) * u0; hid[tid + 256] = siluf_(g1) * u1;
    __syncthreads();
    float y[4] = {0.f, 0.f, 0.f, 0.f};
    for (int j = 0; j < 512; ++j) { const float hj = hid[j];
#pragma unroll
        for (int i = 0; i < 4; ++i) y[i] += hj * Dn[(size_t)j * 1024 + tid + 256 * i]; }
#pragma unroll
    for (int i = 0; i < 4; ++i) ys[(size_t)a * 1024 + tid + 256 * i] = f2bf(w * y[i]);
}
__global__ __launch_bounds__(256) void k_final(const float* x1, const bf16* ys, const float* mod, const float* gf, float* out) {
    __shared__ float red[4];
    const int t = blockIdx.x, b = t / SEQ, tid = threadIdx.x;
    const float4 xv = ((const float4*)(x1 + (size_t)t * D))[tid];
    const ushort4 y0 = ((const ushort4*)(ys + (size_t)t * 2048))[tid], y1 = ((const ushort4*)(ys + (size_t)t * 2048 + 1024))[tid];
    const float* gt = mod + b * 6144 + 5120 + tid * 4;
    float v[4];
    v[0] = xv.x + gt[0] * (bf2f(y0.x) + bf2f(y1.x)); v[1] = xv.y + gt[1] * (bf2f(y0.y) + bf2f(y1.y));
    v[2] = xv.z + gt[2] * (bf2f(y0.z) + bf2f(y1.z)); v[3] = xv.w + gt[3] * (bf2f(y0.w) + bf2f(y1.w));
    float ss = v[0] * v[0] + v[1] * v[1] + v[2] * v[2] + v[3] * v[3];
    ss = block_sum256(ss, red);
    const float rstd = rsqrtf(ss * (1.f / D) + RMS_EPS);
    float4 o; o.x = v[0] * rstd * gf[tid * 4]; o.y = v[1] * rstd * gf[tid * 4 + 1]; o.z = v[2] * rstd * gf[tid * 4 + 2]; o.w = v[3] * rstd * gf[tid * 4 + 3];
    ((float4*)(out + (size_t)t * D))[tid] = o;
}
#endif


#ifndef DBG_BENCH
#define DBG_BENCH 0
#endif
#if DBG_BENCH
__global__ void __launch_bounds__(512, 2) k_bench_a(const float* x, float* dummy) {
    extern __shared__ __attribute__((aligned(16))) unsigned char lds_b[];
    const int tid = threadIdx.x, lane = tid & 63, wave = tid >> 6, tile = blockIdx.x;
    f32x4 nx[4][4]; float acc = 0.f;
#pragma unroll
    for (int p = 0; p < 4; ++p)
#pragma unroll
        for (int j = 0; j < 4; ++j) nx[p][j] = *(const f32x4*)(x + ((size_t)tile * 64 + wave + 8 * p) * 1024 + 256 * j + 4 * lane);
#pragma unroll
    for (int r8 = 0; r8 < 8; ++r8) {
        const size_t row = (size_t)tile * 64 + wave + 8 * r8;
#pragma unroll
        for (int j = 0; j < 4; ++j) acc += (nx[r8 & 3][j][0] + nx[r8 & 3][j][1]) + (nx[r8 & 3][j][2] + nx[r8 & 3][j][3]);
        if (r8 + 4 < 8) {
#pragma unroll
            for (int j = 0; j < 4; ++j) nx[r8 & 3][j] = *(const f32x4*)(x + (row + 32) * 1024 + 256 * j + 4 * lane); }
    }
    if (acc == 123.456f) dummy[tid] = acc;
}
__global__ void __launch_bounds__(256) k_bench_b(const float* x, float* dummy) {
    const int tid = threadIdx.x, lane = tid & 63, wave = tid >> 6; const size_t row = (size_t)blockIdx.x * 4 + wave; float acc = 0.f;
#pragma unroll
    for (int j = 0; j < 4; ++j) { const f32x4 v = *(const f32x4*)(x + row * 1024 + 256 * j + 4 * lane); acc += (v[0] + v[1]) + (v[2] + v[3]); }
    if (acc == 123.456f) dummy[tid] = acc;
}
#endif
#if MK_ONE
constexpr int NKERN = 1;
static const void* const mk_kernels[NKERN] = {(const void*)mk_fwd<0, NPHASE>};
#else
constexpr int NKERN = NPHASE;
static const void* const mk_kernels[NKERN] = {(const void*)mk_fwd<0, 1>, (const void*)mk_fwd<1, 2>, (const void*)mk_fwd<2, 3>, (const void*)mk_fwd<3, 4>, (const void*)mk_fwd<4, 5>, (const void*)mk_fwd<5, 6>,
    (const void*)mk_fwd<6, 7>, (const void*)mk_fwd<7, 8>, (const void*)mk_fwd<8, 9>, (const void*)mk_fwd<9, 10>, (const void*)mk_fwd<10, 11>};
#endif
extern "C" void kernel_launch(void* const* d_in, const int* in_sizes, int n_in, void* d_out, int out_size, void* d_ws, size_t ws_size, hipStream_t stream) {
    static int grid = 0;
    if (grid == 0) {
        int dev = 0, cus = 0;
        if (hipGetDevice(&dev) != hipSuccess || hipDeviceGetAttribute(&cus, hipDeviceAttributeMultiprocessorCount, dev) != hipSuccess) { grid = -1; return; }
        for (int k = 0; k < NKERN; ++k) if (hipFuncSetAttribute(mk_kernels[k], hipFuncAttributeMaxDynamicSharedMemorySize, LDS_BYTES) != hipSuccess) { grid = -1; return; }
        int per_cu = 0;
        (void)hipOccupancyMaxActiveBlocksPerMultiprocessor(&per_cu, mk_kernels[0], NTHREADS, LDS_BYTES);
        (void)hipGetLastError();
        grid = (per_cu >= 1) ? cus : -1;
    }
    if (grid < 0) return;
    (void)hipMemsetAsync((char*)d_ws + WS_CTL, 0, CTL_ZERO_BYTES, stream);
    Args a{};
    for (int i = 0; i < 26; ++i) a.in[i] = (const float*)d_in[i];
    a.out = (float*)d_out; a.ws = (unsigned char*)d_ws;
#if MK_ONE
    a.ph_lo = 0; a.ph_hi = NPHASE;
    { void* args[] = {&a}; (void)hipLaunchKernel(mk_kernels[0], dim3(grid), dim3(NTHREADS), args, LDS_BYTES, stream); }
#else
    unsigned char* ws = (unsigned char*)d_ws; float* out = (float*)d_out;
    float* mod = (float*)(ws + WS_MOD); float* gates = (float*)(ws + WS_GATES); int* toke = (int*)(ws + WS_TOKE); float* tokw = (float*)(ws + WS_TOKW);
    bf16* hb = (bf16*)(ws + WS_H); bf16* zu = (bf16*)(ws + WS_ZU); bf16* zq = (bf16*)(ws + WS_ZQ); bf16* zk = (bf16*)(ws + WS_ZK); bf16* zv = (bf16*)(ws + WS_ZV); bf16* zo = (bf16*)(ws + WS_ZO);
    bf16* zga = (bf16*)(ws + WS_ZGA); bf16* zgb = (bf16*)(ws + WS_ZGB); bf16* qc = (bf16*)(ws + WS_QC); bf16* kc = (bf16*)(ws + WS_KC); bf16* uahm = (bf16*)(ws + WS_UAHM);
    bf16* merged = (bf16*)(ws + WS_MERGED); bf16* ys = (bf16*)(ws + WS_YS);
    (void)mod; (void)gates; (void)toke; (void)tokw; (void)hb; (void)zu; (void)zq; (void)zk; (void)zv; (void)zo; (void)zga; (void)zgb; (void)qc; (void)kc; (void)uahm; (void)merged; (void)ys; (void)out;
#ifndef DBG_NPH
#define DBG_NPH NPHASE
#endif
#if DBG_BENCH == 1
    { static bool once = false; if (!once) { (void)hipFuncSetAttribute((const void*)k_bench_a, hipFuncAttributeMaxDynamicSharedMemorySize, LDS_BYTES); once = true; }
      for (int rep = 0; rep < 4; ++rep) hipLaunchKernelGGL(k_bench_a, dim3(256), dim3(512), LDS_BYTES, stream, (const float*)d_in[0], (float*)((char*)d_ws + WS_TOKE)); }
#elif DBG_BENCH == 2
    for (int rep = 0; rep < 4; ++rep) hipLaunchKernelGGL(k_bench_b, dim3(4096), dim3(256), 0, stream, (const float*)d_in[0], (float*)((char*)d_ws + WS_TOKE));
#endif
    for (int ph = 0; ph < DBG_NPH; ++ph) {
        a.ph_lo = ph; a.ph_hi = ph + 1; a.flags = 0;
        bool mk = true;
#if NAIVE_MASK
        const float* const* I = (const float* const*)d_in;
        if ((NAIVE_MASK >> ph) & 1) {
            mk = false;
            switch (ph) {
            case 0: k_mod<<<8 * 6144 / 256, 256, 0, stream>>>(I[1], I[2], I[3], mod); mk = true; break;
            case 1: k_h1<<<T, 256, 0, stream>>>(I[0], I[4], mod, I[5], I[6], hb, gates); break;
            case 2: k_ngemm<NEpi1><<<dim3((DIN + 63) / 64, T / 64), 256, 0, stream>>>(hb, 1024, I[5], DIN, DIN, 1024, NEpi1{out, zq, zk, zv, zo, zga, zgb});
                    k_glu<<<T * 512 / 256, 256, 0, stream>>>(out, zu); a.flags = (DBG_CLS) << 8; mk = (DBG_CLS) != 0;
                    k_fixw1t<<<2048 * 1024 / 256, 256, 0, stream>>>(I[5], (bf16*)(ws + WS_W1T)); break;
            case 3: k_conva<<<T, 256, 0, stream>>>(zu, I[7], I[8], I[9], I[10], uahm); mk = ((NAIVE_MASK >> 4) & 1) ? false : true; break;
            case 4: k_qkconv<<<T, 256, 0, stream>>>(zq, zk, I[12], I[13], qc, kc);
                    k_mlstm_rec<<<BATCH * NH, 256, 0, stream>>>(qc, kc, zv, zo, gates, I[14], uahm); break;
            case 5: k_ngemm<NEpi2a><<<dim3(16, T / 64), 256, 0, stream>>>(uahm, 1024, I[11], 1024, 1024, 512, NEpi2a{out, zga});
                    k_ngemm<NEpi2b><<<dim3(16, T / 64), 256, 0, stream>>>(uahm + 512, 1024, I[15], 1024, 1024, 512, NEpi2b{out, zgb, merged}); break;
            case 6: k_ngemm<NEpi3><<<dim3(16, T / 64), 256, 0, stream>>>(merged, 1024, I[16], 1024, 1024, 1024, NEpi3{I[0], mod, out}); break;
            case 7: k_h2route<<<T, 256, 0, stream>>>(out, I[17], mod, I[18], I[19], I[20], I[21], hb, toke, tokw);
                    k_lists<<<T * 2 / 256, 256, 0, stream>>>(toke, tokw, (unsigned*)(ws + WS_CTL) + CW_CNT, (int*)(ws + WS_LISTT), (float*)(ws + WS_LISTW));
                    a.flags = 1; mk = true; break;
            case 8: break;
            case 9: k_moe<<<T * 2, 256, 0, stream>>>(hb, toke, tokw, I[22], I[23], I[24], (bf16*)(ws + WS_ZU)); break;
            case 10: k_final<<<T, 256, 0, stream>>>(out, (const bf16*)(ws + WS_ZU), mod, I[25], out); break;
            }
        }
#endif
        if (mk) { void* args[] = {&a}; (void)hipLaunchKernel(mk_kernels[ph], dim3(grid), dim3(NTHREADS), args, LDS_BYTES, stream);
            if ((DBG_HREP >> ph) & 1) { if (ph == 7) a.flags |= DBG_F7; if (ph == 1) a.flags |= DBG_F1; (void)hipLaunchKernel(mk_kernels[ph], dim3(grid), dim3(NTHREADS), args, LDS_BYTES, stream); } }
    }
#endif
}
```

```cpp
#include <hip/hip_runtime.h>
#include <stdint.h>
#include <cstdio>

#ifndef MK_ONE
#define MK_ONE 1
#endif
#ifndef NAIVE_MASK
#define NAIVE_MASK 0
#endif
#ifndef DBG_NPH
#define DBG_NPH 11
#endif
#ifndef DBG_F1
#define DBG_F1 (256+512)
#endif
#ifndef DBG_F7
#define DBG_F7 6
#endif
#ifndef DBG_HREP
#define DBG_HREP 0
#endif
#ifndef DBG_REP
#define DBG_REP 0
#endif
#if DBG_REP
#define REPK(k) for (int _r = 0; _r < 1 + ((DBG_REP >> (k)) & 1); ++_r)
#define REPSYNC() __syncthreads()
#else
#define REPK(k)
#define REPSYNC() do {} while (0)
#endif
#ifndef DBG_CLS
#define DBG_CLS 0
#endif
#ifndef DBG_GATEFIRST
#define DBG_GATEFIRST 0
#endif

typedef unsigned short bf16;
#define DEV __device__ __forceinline__
#define LAS __attribute__((address_space(3)))
typedef short bf16x8 __attribute__((ext_vector_type(8)));
typedef float f32x4 __attribute__((ext_vector_type(4)));
typedef unsigned v4u __attribute__((ext_vector_type(4)));
typedef unsigned v2u __attribute__((ext_vector_type(2)));

constexpr int BATCH = 8, SEQ = 2048, D = 1024, T = BATCH * SEQ;
constexpr int DIN = 5128, NH = 4;
constexpr float RMS_EPS = 1e-6f, LN_EPS = 1e-5f;
constexpr int NWAVES = 8, NTHREADS = 512;

DEV float bf2f(bf16 v) { return __uint_as_float(((unsigned)v) << 16); }
DEV float bflo(unsigned w) { return __uint_as_float(w << 16); }
DEV float bfhi(unsigned w) { return __uint_as_float(w & 0xffff0000u); }
DEV unsigned f2bfu(float f) { unsigned u = __float_as_uint(f); return (u + 0x7fffu + ((u >> 16) & 1u)) >> 16; }
DEV unsigned pk2(float lo, float hi);
DEV bf16 f2bf(float f) { return (bf16)(pk2(f, f) & 0xffffu); }
DEV unsigned pk2(float lo, float hi) { unsigned r; asm volatile("v_cvt_pk_bf16_f32 %0, %1, %2" : "=v"(r) : "v"(lo), "v"(hi)); return r; }
DEV float sigmoidf_(float x) { return __builtin_amdgcn_rcpf(1.f + __expf(-x)); }
DEV float siluf_(float x) { return x * __builtin_amdgcn_rcpf(1.f + __expf(-x)); }
DEV float logsigmoidf_(float x) { return fminf(x, 0.f) - log1pf(__expf(-fabsf(x))); }
template <int CTRL> DEV float dpp0(float v) { return __int_as_float(__builtin_amdgcn_update_dpp(0, __float_as_int(v), CTRL, 0xf, 0xf, true)); }
template <int CTRL> DEV float dppk(float v) { return __int_as_float(__builtin_amdgcn_update_dpp(__float_as_int(v), __float_as_int(v), CTRL, 0xf, 0xf, false)); }
DEV float rdlane(float v, int l) { return __int_as_float(__builtin_amdgcn_readlane(__float_as_int(v), l)); }
DEV float row16_sum(float v) {
    v += dpp0<0xB1>(v); v += dpp0<0x4E>(v); v += dpp0<0x141>(v); v += dpp0<0x140>(v); return v; }
DEV float wave_sum(float v) { v = row16_sum(v); return (rdlane(v, 0) + rdlane(v, 16)) + (rdlane(v, 32) + rdlane(v, 48)); }
DEV float wave_scan_add(float v, int lane) {
    v += dpp0<0x111>(v); v += dpp0<0x112>(v); v += dpp0<0x114>(v); v += dpp0<0x118>(v);
    const float r0 = rdlane(v, 15), r1 = rdlane(v, 31), r2 = rdlane(v, 47);
    return v + ((lane >= 48) ? (r0 + r1) + r2 : (lane >= 32) ? (r0 + r1) : (lane >= 16) ? r0 : 0.f); }
DEV float wave_scan_max(float v, int lane) {
    v = fmaxf(v, dppk<0x111>(v)); v = fmaxf(v, dppk<0x112>(v)); v = fmaxf(v, dppk<0x114>(v)); v = fmaxf(v, dppk<0x118>(v));
    const float r0 = rdlane(v, 15), r1 = rdlane(v, 31), r2 = rdlane(v, 47);
    const float p = (lane >= 48) ? fmaxf(fmaxf(r0, r1), r2) : (lane >= 32) ? fmaxf(r0, r1) : (lane >= 16) ? r0 : -3.0e38f;
    return fmaxf(v, p); }
#define LDS_WAIT() asm volatile("s_waitcnt lgkmcnt(0)" ::: "memory")

constexpr size_t MiB = 1u << 20;
constexpr size_t WS_CTL = 0, CTL_ZERO_BYTES = 65536;
constexpr size_t WS_MOD = 1 * MiB;
constexpr size_t WS_GATES = 1 * MiB + 256 * 1024;
constexpr size_t WS_STSC = 1 * MiB + 768 * 1024;
constexpr size_t WS_RBIAS = 1 * MiB + 800 * 1024;
constexpr size_t WS_WIF = 1 * MiB + 832 * 1024;
constexpr size_t WS_RW = 6 * MiB + 256 * 1024;
constexpr size_t WS_TOKE = 6 * MiB;
constexpr size_t WS_TOKW = 6 * MiB + 128 * 1024;
constexpr size_t WS_LISTT = 2 * MiB;
constexpr size_t WS_LISTW = 4 * MiB;
constexpr size_t WS_W1T = 8 * MiB;
constexpr size_t WS_W2T = 18 * MiB;
constexpr size_t WS_W3T = 20 * MiB;
constexpr size_t WS_STATE = 22 * MiB;
constexpr size_t WS_H = 40 * MiB;
constexpr size_t WS_ZU = 72 * MiB, WS_ZQ = 88 * MiB, WS_ZK = 104 * MiB, WS_ZV = 120 * MiB, WS_ZO = 136 * MiB;
constexpr size_t WS_ZGA = 152 * MiB, WS_ZGB = 184 * MiB;
constexpr size_t WS_UAHM = 216 * MiB;
constexpr size_t WS_MERGED = WS_ZQ;
constexpr size_t WS_WGU = 120 * MiB;
constexpr size_t WS_WD = 184 * MiB;
constexpr size_t WS_ACT = 216 * MiB;
constexpr size_t WS_YS = 40 * MiB;
constexpr size_t WS_QC = WS_H, WS_KC = WS_H + 16 * MiB;
constexpr int CW_BAR = 4096, CW_CNT = 8192, CW_MODCNT = 9216;

constexpr int LDS_TAB = 131072;
constexpr int LDS_MISC = 147456;
constexpr int LDS_BYTES = 151552;

struct Args { const float* in[26]; float* out; unsigned char* ws; int ph_lo, ph_hi, flags, pad; };

namespace pg8 {
constexpr int BM = 256, BK = 64, HALF = 128, HTB = HALF * BK * 2, NXCD = 8, WGM = 8;
DEV int lds_byte(int r, int c) { const int st = (r >> 4) * 2 + (c >> 5), rr = r & 15, cc = c & 31, ob = rr * 64 + cc * 2; return st * 1024 + (ob ^ (((ob >> 9) & 1) << 5)); }
DEV void stage_rc(int b, int& R, int& C) { const int st = b / 1024, sb = b % 1024, swz = sb ^ (((sb >> 9) & 1) << 5); R = (st >> 1) * 16 + swz / 64; C = (st & 1) * 32 + (swz % 64) / 2; }
DEV int perm32(int rho) { const int n = rho >> 4, i = rho & 15; return 8 * (i >> 2) + 4 * n + (i & 3); }
DEV unsigned cvt_pk_bf16(float lo, float hi) { unsigned r; asm volatile("v_cvt_pk_bf16_f32 %0, %1, %2" : "=v"(r) : "v"(lo), "v"(hi)); return r; }

struct Unit { int pm, pn; unsigned ak, bk; int slot, valid, arow0; };

struct StaticOrder {
    int nM, nN, nwg, G, c;
    DEV void init(int M, int N, int G_, int c_) { nM = M / BM; nN = N / BM; nwg = nM * nN; G = G_; c = c_; }
    DEV bool tile(int L, int& pm, int& pn) const {
        if (L >= nwg) return false;
        int wgid = L; { const int q = nwg / NXCD, r = nwg % NXCD, xcd = wgid % NXCD, off = wgid / NXCD; wgid = (xcd < r ? xcd * (q + 1) : r * (q + 1) + (xcd - r) * q) + off; }
        const int nig = WGM * nN, gid = wgid / nig, fm = gid * WGM, gsz = (nM - fm) < WGM ? (nM - fm) : WGM;
        pm = fm + ((wgid % nig) % gsz); pn = (wgid % nig) / gsz; return true;
    }
    DEV bool next(int i, Unit& u) const { u.ak = 0; u.bk = 0; u.slot = 0; u.valid = 256; u.arow0 = 0; return tile(i * G + c, u.pm, u.pn); }
};

template <class Prob, class Epi, class Sched, bool ALIGN_EPI, bool SKIP = false>
DEV void gemm_phase(LAS unsigned char* lds, const Prob& P, const Sched& S, const Epi& E, const int K) {
    int tid = threadIdx.x; asm volatile("" : "+v"(tid));
    const int wid = __builtin_amdgcn_readfirstlane(tid >> 6), lane = tid & 63, wr = wid >> 2, wc = wid & 3, fr = lane & 15, fq = lane >> 4;
    const int nt = K / BK;
    int R[2], C[2], Rb[2];
#pragma unroll
    for (int i = 0; i < 2; ++i) { stage_rc(tid * 16 + i * 8192, R[i], C[i]); Rb[i] = Epi::PERM ? ((R[i] & ~31) + perm32(R[i] & 31)) : R[i]; }
    const unsigned kstep = BK * 2;
    const unsigned ldsw = (unsigned)wid * 1024u;
    const int aoff = lds_byte(wr * 64 + fr, fq * 8), boff = lds_byte(wc * 32 + fr, fq * 8);
    const char* const Abase = (const char*)P.A; const char* const Bbase = (const char*)P.B;
#define PG8_SA(b, h) (((b) * 2 + (h)) * HTB)
#define PG8_SB(b, h) ((4 + (b) * 2 + (h)) * HTB)
#define PG8_STAGE(bufoff, base, offs, kb) do { _Pragma("unroll") for (int _i = 0; _i < 2; ++_i) \
        __builtin_amdgcn_global_load_lds((const unsigned*)((base) + (size_t)((offs)[_i] + (kb))), (LAS unsigned*)(lds + (bufoff) + ldsw + _i * 8192), 16, 0, 0); } while (0)
#define PG8_LDA(dst, b, h) do { _Pragma("unroll") for (int m = 0; m < 4; ++m) _Pragma("unroll") for (int k = 0; k < 2; ++k) dst[m][k] = *(const LAS bf16x8*)(lds + PG8_SA(b, h) + aoff + m * 2048 + k * 1024); } while (0)
#define PG8_LDB(dst, b, h) do { _Pragma("unroll") for (int n = 0; n < 2; ++n) _Pragma("unroll") for (int k = 0; k < 2; ++k) dst[n][k] = *(const LAS bf16x8*)(lds + PG8_SB(b, h) + boff + n * 2048 + k * 1024); } while (0)
#define PG8_MMA(ai, bj, At, Bt) do { __builtin_amdgcn_s_setprio(1); _Pragma("unroll") for (int m = 0; m < 4; ++m) _Pragma("unroll") for (int n = 0; n < 2; ++n) _Pragma("unroll") for (int k = 0; k < 2; ++k) \
        acc[ai][bj][m][n] = __builtin_amdgcn_mfma_f32_16x16x32_bf16(Bt[n][k], At[m][k], acc[ai][bj][m][n], 0, 0, 0); __builtin_amdgcn_s_setprio(0); } while (0)
#define PG8_WAIT_V(n) asm volatile("s_waitcnt vmcnt(" #n ")" ::: "memory")
#define PG8_WAIT_L(n) asm volatile("s_waitcnt lgkmcnt(" #n ")" ::: "memory")
#define PG8_BAR __builtin_amdgcn_s_barrier()
#define PG8_SCHED __builtin_amdgcn_sched_barrier(0)
    Unit cur, nxt; int ui = 0;
    if (!S.next(0, cur)) return;
    f32x4 acc[2][2][4][2];
#pragma unroll
    for (int a = 0; a < 2; ++a)
#pragma unroll
        for (int b = 0; b < 2; ++b)
#pragma unroll
            for (int m = 0; m < 4; ++m)
#pragma unroll
                for (int n = 0; n < 2; ++n) acc[a][b][m][n] = (f32x4){0.f, 0.f, 0.f, 0.f};
    bf16x8 At[4][2], B0[2][2], B1[2][2];
    unsigned ca[2][2], cb[2][2], na[2][2], nb[2][2];
    P.aoffs(cur, R, C, ca); P.boffs(cur, Rb, C, cb);
    PG8_STAGE(PG8_SB(0, 0), Bbase, cb[0], 0u); PG8_STAGE(PG8_SB(0, 1), Bbase, cb[1], 0u); PG8_STAGE(PG8_SA(0, 0), Abase, ca[0], 0u); PG8_STAGE(PG8_SA(0, 1), Abase, ca[1], 0u);
    if (wr == 1) PG8_BAR;
    PG8_WAIT_V(2); PG8_BAR;
    PG8_STAGE(PG8_SB(1, 0), Bbase, cb[0], kstep); PG8_STAGE(PG8_SA(1, 0), Abase, ca[0], kstep); PG8_STAGE(PG8_SB(1, 1), Bbase, cb[1], kstep);
    PG8_WAIT_V(6); PG8_BAR;
    for (;;) {
        const bool has_next = S.next(ui + 1, nxt);
        if (has_next) { P.aoffs(nxt, R, C, na); P.boffs(nxt, Rb, C, nb); }
        else {
#pragma unroll
            for (int h = 0; h < 2; ++h)
#pragma unroll
                for (int i = 0; i < 2; ++i) { na[h][i] = ca[h][i]; nb[h][i] = cb[h][i]; } }
        const bool do0 = !(SKIP && cur.valid <= 64 && wr == 1), do1 = !(SKIP && cur.valid <= 128) && do0;
        for (int t = 0; t < nt; t += 2) {
            const bool last = (t == nt - 2);
            const unsigned k1 = (unsigned)(t + 1) * kstep;
            const unsigned kb2 = last ? 0u : (unsigned)(t + 2) * kstep, kb3 = kb2 + kstep;
            unsigned a2[2][2], b2[2][2];
#pragma unroll
            for (int h = 0; h < 2; ++h)
#pragma unroll
                for (int i = 0; i < 2; ++i) { a2[h][i] = last ? na[h][i] : ca[h][i]; b2[h][i] = last ? nb[h][i] : cb[h][i]; }
            PG8_LDB(B0, 0, 0); PG8_LDB(B1, 0, 1); PG8_SCHED; PG8_LDA(At, 0, 0); PG8_STAGE(PG8_SA(1, 1), Abase, ca[1], k1);
            PG8_WAIT_V(8); PG8_WAIT_L(0); PG8_BAR; if (do0) { PG8_MMA(0, 0, At, B0); PG8_MMA(0, 1, At, B1); } PG8_BAR; PG8_SCHED;
            PG8_LDA(At, 0, 1); PG8_STAGE(PG8_SB(0, 0), Bbase, b2[0], kb2); PG8_STAGE(PG8_SB(0, 1), Bbase, b2[1], kb2); PG8_STAGE(PG8_SA(0, 0), Abase, a2[0], kb2);
            PG8_WAIT_V(8); PG8_WAIT_L(0); PG8_BAR; if (do1) { PG8_MMA(1, 0, At, B0); PG8_MMA(1, 1, At, B1); } PG8_BAR; PG8_SCHED;
            PG8_LDB(B0, 1, 0); PG8_LDB(B1, 1, 1); PG8_SCHED; PG8_LDA(At, 1, 0); PG8_STAGE(PG8_SA(0, 1), Abase, a2[1], kb2);
            PG8_WAIT_V(8); PG8_WAIT_L(0); PG8_BAR; if (do0) { PG8_MMA(0, 0, At, B0); PG8_MMA(0, 1, At, B1); } PG8_BAR; PG8_SCHED;
            PG8_LDA(At, 1, 1); PG8_STAGE(PG8_SB(1, 0), Bbase, b2[0], kb3); PG8_STAGE(PG8_SB(1, 1), Bbase, b2[1], kb3); PG8_STAGE(PG8_SA(1, 0), Abase, a2[0], kb3);
            PG8_WAIT_V(8); PG8_WAIT_L(0); PG8_BAR; if (do1) { PG8_MMA(1, 0, At, B0); PG8_MMA(1, 1, At, B1); } PG8_BAR; PG8_SCHED;
        }
        if constexpr (ALIGN_EPI) { if (wr == 0) PG8_BAR; }
        E(acc, cur, wr, wc, fr, fq);
        if (!has_next) break;
        if (!E.keep(cur)) {
#pragma unroll
            for (int a = 0; a < 2; ++a)
#pragma unroll
                for (int b = 0; b < 2; ++b)
#pragma unroll
                    for (int m = 0; m < 4; ++m)
#pragma unroll
                        for (int n = 0; n < 2; ++n) acc[a][b][m][n] = (f32x4){0.f, 0.f, 0.f, 0.f};
        }
        cur = nxt; ++ui;
#pragma unroll
        for (int h = 0; h < 2; ++h)
#pragma unroll
            for (int i = 0; i < 2; ++i) { ca[h][i] = na[h][i]; cb[h][i] = nb[h][i]; }
        if constexpr (ALIGN_EPI) { if (wr == 1) PG8_BAR; }
    }
    PG8_WAIT_V(0);
    if constexpr (!ALIGN_EPI) { if (wr == 0) PG8_BAR; }
    PG8_BAR;
#undef PG8_SA
#undef PG8_SB
#undef PG8_STAGE
#undef PG8_LDA
#undef PG8_LDB
#undef PG8_MMA
#undef PG8_WAIT_V
#undef PG8_WAIT_L
#undef PG8_BAR
#undef PG8_SCHED
}
}
using pg8::Unit;

struct ProbPlain {
    const bf16* A; const bf16* B; unsigned lda2, ldb2;
    DEV void aoffs(const Unit& u, const int (&R)[2], const int (&C)[2], unsigned (&o)[2][2]) const {
#pragma unroll
        for (int h = 0; h < 2; ++h)
#pragma unroll
            for (int i = 0; i < 2; ++i) o[h][i] = (unsigned)(u.pm * 256 + 128 * h + R[i]) * lda2 + (unsigned)C[i] * 2u + u.ak; }
    DEV void boffs(const Unit& u, const int (&Rb)[2], const int (&C)[2], unsigned (&o)[2][2]) const {
#pragma unroll
        for (int h = 0; h < 2; ++h)
#pragma unroll
            for (int i = 0; i < 2; ++i) o[h][i] = (unsigned)(u.pn * 256 + 128 * h + Rb[i]) * ldb2 + (unsigned)C[i] * 2u + u.bk; }
};
struct ProbMoeUp {
    const bf16* A; const bf16* B; const LAS unsigned* rowtab;
    DEV void aoffs(const Unit& u, const int (&R)[2], const int (&C)[2], unsigned (&o)[2][2]) const {
#pragma unroll
        for (int h = 0; h < 2; ++h)
#pragma unroll
            for (int i = 0; i < 2; ++i) o[h][i] = rowtab[u.slot * 256 + 128 * h + R[i]] + (unsigned)C[i] * 2u; }
    DEV void boffs(const Unit& u, const int (&Rb)[2], const int (&C)[2], unsigned (&o)[2][2]) const {
#pragma unroll
        for (int h = 0; h < 2; ++h)
#pragma unroll
            for (int i = 0; i < 2; ++i) o[h][i] = (unsigned)(u.pn * 256 + 128 * h + Rb[i]) * 2048u + (unsigned)C[i] * 2u + u.bk; }
};
struct ProbMoeDown {
    const bf16* A; const bf16* B;
    DEV void aoffs(const Unit& u, const int (&R)[2], const int (&C)[2], unsigned (&o)[2][2]) const {
#pragma unroll
        for (int h = 0; h < 2; ++h)
#pragma unroll
            for (int i = 0; i < 2; ++i) o[h][i] = (unsigned)(u.arow0 + 128 * h + R[i]) * 1024u + (unsigned)C[i] * 2u; }
    DEV void boffs(const Unit& u, const int (&Rb)[2], const int (&C)[2], unsigned (&o)[2][2]) const {
#pragma unroll
        for (int h = 0; h < 2; ++h)
#pragma unroll
            for (int i = 0; i < 2; ++i) o[h][i] = (unsigned)(u.pn * 256 + 128 * h + Rb[i]) * 1024u + (unsigned)C[i] * 2u + u.bk; }
};

DEV void st16_wt(void* p, const v4u v) { asm volatile("global_store_dwordx4 %0, %1, off sc1\n\ts_nop 1" :: "v"(p), "v"(v) : "memory"); }
DEV v4u pack8(const f32x4 v0, const f32x4 v1) { v4u w; w.x = pg8::cvt_pk_bf16(v0[0], v0[1]); w.y = pg8::cvt_pk_bf16(v0[2], v0[3]); w.z = pg8::cvt_pk_bf16(v1[0], v1[1]); w.w = pg8::cvt_pk_bf16(v1[2], v1[3]); return w; }
DEV f32x4 sig4(f32x4 v) { f32x4 o; o[0] = sigmoidf_(v[0]); o[1] = sigmoidf_(v[1]); o[2] = sigmoidf_(v[2]); o[3] = sigmoidf_(v[3]); return o; }
DEV void unpack8(const v4u w, f32x4& lo, f32x4& hi) { lo[0] = bflo(w.x); lo[1] = bfhi(w.x); lo[2] = bflo(w.y); lo[3] = bfhi(w.y); hi[0] = bflo(w.z); hi[1] = bfhi(w.z); hi[2] = bflo(w.w); hi[3] = bfhi(w.w); }

struct Epi1 {
    static constexpr bool PERM = true;
    bf16* zu; bf16* zga; int cls;
    DEV bool keep(const Unit&) const { return false; }
    DEV void operator()(f32x4 (&acc)[2][2][4][2], const Unit& u, int wr, int wc, int fr, int fq) const {
        const int row0 = u.pm * 256 + wr * 64 + fr, cl = wc * 32 + 8 * fq;
        if (cls) { const int c = (u.pn < 4) ? 1 : (u.pn < 12) ? 2 : (u.pn < 16) ? 4 : 8; if (!(cls & c)) return; }
        if (u.pn < 4) {
#pragma unroll
            for (int ai = 0; ai < 2; ++ai)
#pragma unroll
                for (int m = 0; m < 4; ++m) { const size_t row = (size_t)(row0 + ai * 128 + m * 16);
                    const f32x4 v0 = acc[ai][0][m][0] * sig4(acc[ai][1][m][0]), v1 = acc[ai][0][m][1] * sig4(acc[ai][1][m][1]);
                    *(v4u*)(zu + row * 512 + 128 * u.pn + cl) = pack8(v0, v1); }
        } else {
            bf16* base; int ld, colb; bool sg;
            if (u.pn < 12) { const int ti = (u.pn - 4) >> 1; base = zu + (size_t)(1 + ti) * T * 512; ld = 512; colb = 256 * ((u.pn - 4) & 1); sg = (ti == 3); }
            else { const int ti = (u.pn - 12) >> 2; base = zga + (size_t)ti * T * 1024; ld = 1024; colb = 256 * ((u.pn - 12) & 3); sg = true; }
#pragma unroll
            for (int ai = 0; ai < 2; ++ai)
#pragma unroll
                for (int m = 0; m < 4; ++m) { const size_t row = (size_t)(row0 + ai * 128 + m * 16);
#pragma unroll
                    for (int bj = 0; bj < 2; ++bj) { f32x4 v0 = acc[ai][bj][m][0], v1 = acc[ai][bj][m][1]; if (sg) { v0 = sig4(v0); v1 = sig4(v1); }
                        *(v4u*)(base + row * ld + colb + 128 * bj + cl) = pack8(v0, v1); } }
        }
    }
};
struct Epi2 {
    static constexpr bool PERM = true;
    const bf16* zga; const bf16* zgb; bf16* merged;
    DEV bool keep(const Unit& u) const { return u.slot == 0; }
    DEV void operator()(f32x4 (&acc)[2][2][4][2], const Unit& u, int wr, int wc, int fr, int fq) const {
        const int row0 = u.pm * 256 + wr * 64 + fr, c0 = u.pn * 256 + wc * 32 + 8 * fq;
#pragma unroll
        for (int ai = 0; ai < 2; ++ai)
#pragma unroll
            for (int m = 0; m < 4; ++m) { const size_t ro = (size_t)(row0 + ai * 128 + m * 16) * 1024 + c0;
#pragma unroll
                for (int bj = 0; bj < 2; ++bj) {
                    f32x4 b0, b1; unpack8(*(const v4u*)(zgb + ro + 128 * bj), b0, b1);
                    if (u.slot == 0) { f32x4 a0, a1; unpack8(*(const v4u*)(zga + ro + 128 * bj), a0, a1);
#pragma unroll
                        for (int j = 0; j < 4; ++j) { acc[ai][bj][m][0][j] *= a0[j] * __builtin_amdgcn_rcpf(fmaxf(b0[j], 1e-30f)); acc[ai][bj][m][1][j] *= a1[j] * __builtin_amdgcn_rcpf(fmaxf(b1[j], 1e-30f)); }
                    } else { *(v4u*)(merged + ro + 128 * bj) = pack8(acc[ai][bj][m][0] * b0, acc[ai][bj][m][1] * b1); }
                } }
    }
};
struct Epi3 {
    static constexpr bool PERM = false;
    const float* x; const float* mod; float* out;
    DEV bool keep(const Unit&) const { return false; }
    DEV void operator()(f32x4 (&acc)[2][2][4][2], const Unit& u, int wr, int wc, int fr, int fq) const {
        const int row0 = u.pm * 256 + wr * 64 + fr, c0 = u.pn * 256 + wc * 32 + 4 * fq; const int b = u.pm >> 3;
        f32x4 gt[2][2];
#pragma unroll
        for (int bj = 0; bj < 2; ++bj)
#pragma unroll
            for (int n = 0; n < 2; ++n) gt[bj][n] = *(const f32x4*)(mod + b * 6144 + 2048 + c0 + 128 * bj + 16 * n);
#pragma unroll
        for (int ai = 0; ai < 2; ++ai)
#pragma unroll
            for (int m = 0; m < 4; ++m) { const size_t ro = (size_t)(row0 + ai * 128 + m * 16) * 1024 + c0;
#pragma unroll
                for (int bj = 0; bj < 2; ++bj)
#pragma unroll
                    for (int n = 0; n < 2; ++n) { const f32x4 xv = *(const f32x4*)(x + ro + 128 * bj + 16 * n); *(f32x4*)(out + ro + 128 * bj + 16 * n) = xv + gt[bj][n] * acc[ai][bj][m][n]; } }
    }
};
struct EpiUp {
    static constexpr bool PERM = true;
    bf16* act;
    DEV bool keep(const Unit&) const { return false; }
    DEV void operator()(f32x4 (&acc)[2][2][4][2], const Unit& u, int wr, int wc, int fr, int fq) const {
        const int cl = 128 * u.pn + wc * 32 + 8 * fq;
#pragma unroll
        for (int ai = 0; ai < 2; ++ai)
#pragma unroll
            for (int m = 0; m < 4; ++m) { const int rt = ai * 128 + wr * 64 + m * 16 + fr;
                if (rt < u.valid) { f32x4 v0, v1;
#pragma unroll
                    for (int j = 0; j < 4; ++j) { v0[j] = siluf_(acc[ai][0][m][0][j]) * acc[ai][1][m][0][j]; v1[j] = siluf_(acc[ai][0][m][1][j]) * acc[ai][1][m][1][j]; }
                    *(v4u*)(act + (size_t)(u.arow0 + rt) * 512 + cl) = pack8(v0, v1); } }
    }
};
struct EpiDown {
    static constexpr bool PERM = true;
    bf16* ys; const LAS unsigned* desttab; const LAS float* wtab;
    DEV bool keep(const Unit&) const { return false; }
    DEV void operator()(f32x4 (&acc)[2][2][4][2], const Unit& u, int wr, int wc, int fr, int fq) const {
        const int cl = 256 * u.pn + wc * 32 + 8 * fq;
#pragma unroll
        for (int ai = 0; ai < 2; ++ai)
#pragma unroll
            for (int m = 0; m < 4; ++m) { const int rt = ai * 128 + wr * 64 + m * 16 + fr;
                if (rt < u.valid) { const unsigned dest = desttab[u.slot * 256 + rt]; const float w = wtab[u.slot * 256 + rt];
#pragma unroll
                    for (int bj = 0; bj < 2; ++bj) *(v4u*)(ys + (size_t)dest * 1024 + cl + 128 * bj) = pack8(acc[ai][bj][m][0] * w, acc[ai][bj][m][1] * w); } }
    }
};

#define XB_TMO      128
#define XB_XCNT(j)  (256  + 64 * (j))
#define XB_XSUB(j)  (1280 + 64 * (j))
#define XB_XGEN(j)  (2304 + 64 * (j))
#define XB_TOP      3328
#define XB_TOPGEN   3392
#define XCD_BAR_WORDS 3456
#define XB_SPIN_CAP (1u << 18)
__device__ __forceinline__ unsigned xb_ld(unsigned* p)              { return __hip_atomic_load(p, __ATOMIC_RELAXED, __HIP_MEMORY_SCOPE_AGENT); }
__device__ __forceinline__ unsigned xb_add(unsigned* p, unsigned v) { return __hip_atomic_fetch_add(p, v, __ATOMIC_RELAXED, __HIP_MEMORY_SCOPE_AGENT); }
__device__ __forceinline__ unsigned xb_xcc_id() { return (unsigned)__builtin_amdgcn_s_getreg((3 << 11) | 20) & 0xFu; }
#define XB_SPIN(cond, bar) do { unsigned _sp = 0; while (cond) { __builtin_amdgcn_s_sleep(1); \
    if ((++_sp & 255u) == 0u) { if (xb_ld(&(bar)[XB_TMO])) break; if (_sp > XB_SPIN_CAP) { atomicAdd(&(bar)[XB_TMO], 1u); break; } } } } while (0)
struct XcdBarrier { unsigned* bar; unsigned x; volatile LAS unsigned* st; };
__device__ __forceinline__ XcdBarrier xcd_barrier_post(unsigned* bar, volatile LAS unsigned* st) {
    XcdBarrier b; b.bar = bar; b.x = xb_xcc_id(); b.st = st;
    if (threadIdx.x == 0) (void)xb_add(&bar[XB_XCNT(b.x)], 1u);
    return b;
}
__device__ __forceinline__ void xcd_barrier_complete(unsigned* bar, unsigned x, unsigned& nloc, unsigned& nx) {
    const unsigned G = gridDim.x * gridDim.y * gridDim.z;
    unsigned sum, cnt, mine, sp = 0u;
    for (;;) {
        sum = 0u; cnt = 0u; mine = 0u;
#pragma unroll
        for (unsigned j = 0; j < 16; ++j) { const unsigned c = xb_ld(&bar[XB_XCNT(j)]); sum += c; cnt += (c > 0u) ? 1u : 0u; mine = (j == x) ? c : mine; }
        if (sum == G) break;
        __builtin_amdgcn_s_sleep(1);
        if ((++sp & 255u) == 0u) { if (xb_ld(&bar[XB_TMO])) break; if (sp > XB_SPIN_CAP) { atomicAdd(&bar[XB_TMO], 1u); break; } }
    }
    nloc = mine > 0u ? mine : 1u; nx = cnt > 0u ? cnt : 1u;
}
__device__ __forceinline__ void xcd_barrier(const XcdBarrier& b) {
    asm volatile("s_waitcnt vmcnt(0)" ::: "memory");
    __syncthreads();
    if (threadIdx.x == 0) {
        unsigned* bar = b.bar;
        __builtin_amdgcn_s_waitcnt(0);
        unsigned nloc = b.st[0], nx = b.st[1];
        if (nloc == 0u) { xcd_barrier_complete(bar, b.x, nloc, nx); b.st[0] = nloc; b.st[1] = nx; }
        const unsigned old = xb_add(&bar[XB_XSUB(b.x)], 1u);
        const unsigned gen = old / nloc;
        if (old + 1u == (gen + 1u) * nloc) {
            __builtin_amdgcn_fence(__ATOMIC_RELEASE, "agent");
            asm volatile("s_waitcnt vmcnt(0)" ::: "memory");
            const unsigned og = xb_add(&bar[XB_TOP], 1u);
            const unsigned tg = og / nx;
            if (og + 1u == (tg + 1u) * nx) xb_add(&bar[XB_TOPGEN], 1u);
            else XB_SPIN(xb_ld(&bar[XB_TOPGEN]) == tg, bar);
            __builtin_amdgcn_fence(__ATOMIC_ACQUIRE, "agent");
            xb_add(&bar[XB_XGEN(b.x)], 1u);
            asm volatile("s_waitcnt vmcnt(0)" ::: "memory");
        } else {
            XB_SPIN(xb_ld(&bar[XB_XGEN(b.x)]) == gen, bar);
            __builtin_amdgcn_fence(__ATOMIC_ACQUIRE, "agent");
            asm volatile("s_waitcnt vmcnt(0)" ::: "memory");
        }
    }
    __syncthreads();
}

DEV f32x4 mma16(bf16x8 a, bf16x8 b, f32x4 c) { return __builtin_amdgcn_mfma_f32_16x16x32_bf16(a, b, c, 0, 0, 0); }
DEV void split8(const f32x4 a, const f32x4 b, bf16x8& hi, bf16x8& lo) {
    v4u h, l; const float r[8] = {a[0], a[1], a[2], a[3], b[0], b[1], b[2], b[3]}; unsigned hw[4], lw[4];
#pragma unroll
    for (int i = 0; i < 4; ++i) { hw[i] = pk2(r[2 * i], r[2 * i + 1]); lw[i] = pk2(r[2 * i] - bflo(hw[i]), r[2 * i + 1] - bfhi(hw[i])); }
    h.x = hw[0]; h.y = hw[1]; h.z = hw[2]; h.w = hw[3]; l.x = lw[0]; l.y = lw[1]; l.z = lw[2]; l.w = lw[3];
    hi = __builtin_bit_cast(bf16x8, h); lo = __builtin_bit_cast(bf16x8, l);
}
DEV void transpose_item(const float* src, int ldsrc, bf16* dst, int lddst, LAS float* scr, int lane) {
#pragma unroll 8
    for (int i = 0; i < 32; ++i) { const int kk = 2 * i + (lane >> 5); scr[kk * 33 + (lane & 31)] = src[(size_t)kk * ldsrc + (lane & 31)]; }
    LDS_WAIT(); asm volatile("" ::: "memory");
    const int c = lane & 7;
#pragma unroll
    for (int j = 0; j < 4; ++j) { const int n = (lane >> 3) + 8 * j; const LAS float* s = scr + (8 * c) * 33 + n;
        v4u o; o.x = pk2(s[0 * 33], s[1 * 33]); o.y = pk2(s[2 * 33], s[3 * 33]); o.z = pk2(s[4 * 33], s[5 * 33]); o.w = pk2(s[6 * 33], s[7 * 33]);
        *(v4u*)(dst + (size_t)n * lddst + 8 * c) = o; }
    LDS_WAIT(); asm volatile("" ::: "memory");
}

DEV void p0_prologue(const Args& a, LAS unsigned char* lds, int bid, int G) {
    const int tid = threadIdx.x, lane = tid & 63, wave = __builtin_amdgcn_readfirstlane(tid >> 6);
    const float* c = a.in[1]; const float* w_ada = a.in[2]; const float* b_ada = a.in[3];
    float* mod = (float*)(a.ws + WS_MOD);
    if (bid < 192) {
        LAS float* sil = (LAS float*)lds;
        LAS float* red = (LAS float*)(lds + 32768);
        for (int i = tid; i < 8192; i += NTHREADS) sil[i] = siluf_(c[i]);
        __syncthreads();
        for (int item = bid; item < 192; item += G) {
            const int n0 = item * 32, lg = lane >> 3, cq = lane & 7;
            float acc[8][4];
#pragma unroll
            for (int b = 0; b < 8; ++b)
#pragma unroll
                for (int j = 0; j < 4; ++j) acc[b][j] = 0.f;
#pragma unroll 4
            for (int j = 0; j < 16; ++j) { const int k = wave * 128 + j * 8 + lg; const f32x4 w = *(const f32x4*)(w_ada + (size_t)k * 6144 + n0 + cq * 4);
#pragma unroll
                for (int b = 0; b < 8; ++b) { const float s = sil[b * 1024 + k]; acc[b][0] += s * w[0]; acc[b][1] += s * w[1]; acc[b][2] += s * w[2]; acc[b][3] += s * w[3]; } }
#pragma unroll
            for (int b = 0; b < 8; ++b)
#pragma unroll
                for (int j = 0; j < 4; ++j) { float v = acc[b][j]; v += dpp0<0x128>(v); if ((lane & 8) == 0) red[(wave * 4 + (lane >> 4)) * 256 + b * 32 + cq * 4 + j] = v; }
            __syncthreads();
            if (tid < 256) { float s = 0.f;
#pragma unroll
                for (int w = 0; w < 32; ++w) s += red[w * 256 + tid];
                const int b = tid >> 5, col = tid & 31; mod[b * 6144 + n0 + col] = s + b_ada[n0 + col]; }
            asm volatile("s_waitcnt vmcnt(0)" ::: "memory");
            __syncthreads();
            if (tid == 0) { __builtin_amdgcn_fence(__ATOMIC_RELEASE, "agent"); asm volatile("s_waitcnt vmcnt(0)" ::: "memory");
                __hip_atomic_fetch_add((unsigned*)(a.ws + WS_CTL) + CW_MODCNT, 1u, __ATOMIC_RELAXED, __HIP_MEMORY_SCOPE_AGENT); }
        }
    }
    if (bid == G - 1) { const float* w_in0 = a.in[5]; float* wif = (float*)(a.ws + WS_WIF);
        for (int i = tid; i < 2048; i += NTHREADS) { const int k = i >> 1, hf = i & 1; *(f32x4*)(wif + k * 8 + 4 * hf) = *(const f32x4*)(w_in0 + (size_t)k * DIN + 3072 + 4 * hf); } }
    LAS float* scr = (LAS float*)(lds + wave * 16384);
    const int gw = bid * NWAVES + wave, NGW = G * NWAVES;
    const float* w_in = a.in[5]; const float* wco = a.in[11]; const float* wmo = a.in[15]; const float* wout = a.in[16];
    bf16* W1T = (bf16*)(a.ws + WS_W1T); bf16* W2T = (bf16*)(a.ws + WS_W2T); bf16* W3T = (bf16*)(a.ws + WS_W3T);
    constexpr int I1 = 16 * 160, I2 = 8 * 32, I3 = 16 * 32, NIT = I1 + 2 * I2 + I3;
    for (int it = gw; it < NIT; it += NGW) {
        int r = it;
        if (r < I1) { const int kb = r / 160, nb = r % 160, np = 32 * nb; int sc;
            if (np < 1024) { const int t = np >> 8, q = np & 255; sc = (q < 128) ? 128 * t + q : 512 + 128 * t + q - 128; } else if (np < 3072) sc = np; else sc = np + 8;
            transpose_item(w_in + (size_t)(64 * kb) * DIN + sc, DIN, W1T + (size_t)np * 1024 + 64 * kb, 1024, scr, lane); continue; }
        r -= I1;
        if (r < I2) { const int kb = r / 32, nb = r % 32; transpose_item(wco + (size_t)(64 * kb) * 1024 + 32 * nb, 1024, W2T + (size_t)(32 * nb) * 1024 + 64 * kb, 1024, scr, lane); continue; }
        r -= I2;
        if (r < I2) { const int kb = r / 32, nb = r % 32; transpose_item(wmo + (size_t)(64 * kb) * 1024 + 32 * nb, 1024, W2T + (size_t)(32 * nb) * 1024 + 512 + 64 * kb, 1024, scr, lane); continue; }
        r -= I2;
        { const int kb = r / 32, nb = r % 32; transpose_item(wout + (size_t)(64 * kb) * 1024 + 32 * nb, 1024, W3T + (size_t)(32 * nb) * 1024 + 64 * kb, 1024, scr, lane); }
    }
}

DEV void p1_h1(const Args& a, LAS unsigned char* lds, int bid, int G) {
    const int tid = threadIdx.x, lane = tid & 63, wave = __builtin_amdgcn_readfirstlane(tid >> 6);
    if (tid == 0) {
        unsigned* mc = (unsigned*)(a.ws + WS_CTL) + CW_MODCNT; unsigned sp = 0;
        while (__hip_atomic_load(mc, __ATOMIC_RELAXED, __HIP_MEMORY_SCOPE_AGENT) < 192u) { __builtin_amdgcn_s_sleep(2); if (++sp > (1u << 22)) break; }
        __builtin_amdgcn_fence(__ATOMIC_ACQUIRE, "agent"); asm volatile("s_waitcnt vmcnt(0)" ::: "memory"); }
    __syncthreads();
    const float* x = a.in[0]; const float* g1 = a.in[4]; const float* w_in = a.in[5]; const float* b_if = a.in[6];
    const float* mod = (const float*)(a.ws + WS_MOD); bf16* h1 = (bf16*)(a.ws + WS_H); float* gates = (float*)(a.ws + WS_GATES);
    LAS float* tab = (LAS float*)lds;
    for (int k = tid; k < 1024; k += NTHREADS) { const int p = ((k >> 8) << 2) | (k & 3), l = (k >> 2) & 63;
        const f32x4 w0 = *(const f32x4*)(w_in + (size_t)k * DIN + 3072), w1 = *(const f32x4*)(w_in + (size_t)k * DIN + 3076);
        *(LAS f32x4*)(tab + (p * 64 + l) * 8) = w0; *(LAS f32x4*)(tab + (p * 64 + l) * 8 + 4) = w1; }
    __syncthreads();
    if (!(a.flags & 512)) {
        const float* g2 = a.in[17]; const float* w_rg = a.in[18]; const float* b_rg = a.in[19]; const float* w_re = a.in[20]; const float* b_re = a.in[21];
        float* rbias = (float*)(a.ws + WS_RBIAS); v4u* rw = (v4u*)(a.ws + WS_RW);
        const int gw = bid * NWAVES + wave, NGW = G * NWAVES;
        for (int it = gw; it < 8 * 36; it += NGW) { const int b = it / 36, n = it % 36; float sacc = 0.f;
#pragma unroll
            for (int i = 0; i < 16; ++i) { const int k = lane + 64 * i; const float w = (n < 4) ? w_rg[k * 4 + n] : w_re[k * 32 + n - 4]; sacc += mod[b * 6144 + 3072 + k] * w; }
            sacc = wave_sum(sacc);
            if (lane == 0) rbias[b * 48 + n] = sacc + ((n < 4) ? b_rg[n] : b_re[n - 4]); }
        for (int it = gw; it < 8 * 8 * 4 * 3; it += NGW) {
            const int nt = it % 3, kk = (it / 3) & 3, w8 = (it / 12) & 7, b = it / 96;
            const int n = 16 * nt + (lane & 15), k0 = 128 * w8 + 32 * kk + 8 * (lane >> 4);
            f32x4 w0, w1;
#pragma unroll
            for (int j = 0; j < 8; ++j) { const int k = k0 + j; const float* wp = (n < 4) ? (w_rg + k * 4 + n) : (w_re + k * 32 + ((n < 36) ? n - 4 : 0));
                float w = *wp; w = (n < 36) ? w : 0.f;
                w *= g2[k] * (1.f + mod[b * 6144 + 4096 + k]); if (j < 4) w0[j] = w; else w1[j - 4] = w; }
            bf16x8 hi, lo; split8(w0, w1, hi, lo);
            rw[((size_t)it * 2) * 64 + lane] = __builtin_bit_cast(v4u, hi); rw[((size_t)it * 2 + 1) * 64 + lane] = __builtin_bit_cast(v4u, lo);
        }
    }
    const float bifv = b_if[lane & 7];
    if (!(a.flags & 256)) for (int tile = bid; tile < T / 64; tile += G) {
        const int b = tile / 32;
        float sc[4][4], sh[4][4];
#pragma unroll
        for (int j = 0; j < 4; ++j) { const int k = 256 * j + 4 * lane; const f32x4 gv = *(const f32x4*)(g1 + k), sv = *(const f32x4*)(mod + b * 6144 + 1024 + k), hv = *(const f32x4*)(mod + b * 6144 + k);
#pragma unroll
            for (int i = 0; i < 4; ++i) { sc[j][i] = gv[i] * (1.f + sv[i]); sh[j][i] = hv[i]; } }
        const int rot = (tile * 9) & 63;
        f32x4 nx[4][4];
#pragma unroll
        for (int p = 0; p < 4; ++p)
#pragma unroll
            for (int j = 0; j < 4; ++j) nx[p][j] = *(const f32x4*)(x + ((size_t)tile * 64 + ((wave + 8 * p + rot) & 63)) * 1024 + 256 * j + 4 * lane);
#pragma unroll
        for (int r8 = 0; r8 < 8; ++r8) {
            const int r = (wave + 8 * r8 + rot) & 63;
            const size_t row = (size_t)tile * 64 + r;
            f32x4 v[4]; float ss = 0.f;
#pragma unroll
            for (int j = 0; j < 4; ++j) { v[j] = nx[r8 & 3][j]; ss += (v[j][0] * v[j][0] + v[j][1] * v[j][1]) + (v[j][2] * v[j][2] + v[j][3] * v[j][3]); }
            if (r8 + 4 < 8) {
#pragma unroll
                for (int j = 0; j < 4; ++j) nx[r8 & 3][j] = *(const f32x4*)(x + ((size_t)tile * 64 + ((r + 32) & 63)) * 1024 + 256 * j + 4 * lane); }
            asm volatile("" ::: "memory");
            const float rstd = rsqrtf(wave_sum(ss) * (1.f / 1024.f) + RMS_EPS);
            float g[8];
#pragma unroll
            for (int q = 0; q < 8; ++q) g[q] = 0.f;
#pragma unroll
            for (int j = 0; j < 4; ++j) {
                float hh[4];
#pragma unroll
                for (int i = 0; i < 4; ++i) hh[i] = v[j][i] * rstd * sc[j][i] + sh[j][i];
                v2u o; o.x = pk2(hh[0], hh[1]); o.y = pk2(hh[2], hh[3]);
                if (!(a.flags & 2048)) *(v2u*)(h1 + row * 1024 + 256 * j + 4 * lane) = o;
                if (!(a.flags & 1024))
#pragma unroll
                for (int i = 0; i < 4; ++i) { const LAS float* tp = tab + ((4 * j + i) * 64 + lane) * 8; const f32x4 w0 = *(const LAS f32x4*)tp, w1 = *(const LAS f32x4*)(tp + 4);
                    g[0] += hh[i] * w0[0]; g[1] += hh[i] * w0[1]; g[2] += hh[i] * w0[2]; g[3] += hh[i] * w0[3]; g[4] += hh[i] * w1[0]; g[5] += hh[i] * w1[1]; g[6] += hh[i] * w1[2]; g[7] += hh[i] * w1[3]; }
            }
            float mine = 0.f;
            if (!(a.flags & 1024))
#pragma unroll
            for (int q = 0; q < 8; ++q) { const float sq = wave_sum(g[q]); mine = (lane == q) ? sq : mine; }
            if (lane < 8 && !(a.flags & 1024)) { const float vv = mine + bifv; gates[row * 8 + lane] = (lane < 4) ? vv : logsigmoidf_(vv); }
        }
    }
}

DEV void p3_conva(const Args& a, LAS unsigned char* lds, int bid, int G) {
    const int tid = threadIdx.x, lane = tid & 63, wave = __builtin_amdgcn_readfirstlane(tid >> 6), sub = wave & 3, gsel = wave >> 2;
    const bf16* zu = (const bf16*)(a.ws + WS_ZU); bf16* uahm = (bf16*)(a.ws + WS_UAHM);
    const float* cw = a.in[7]; const float* cb = a.in[8]; const float* lg = a.in[9]; const float* lb = a.in[10];
    LAS float* red = (LAS float*)(lds + LDS_TAB);
    const int c0 = 128 * sub + 2 * lane;
    float w0[31], w1[31];
#pragma unroll
    for (int k = 0; k < 31; ++k) { w0[k] = cw[k * 512 + c0]; w1[k] = cw[k * 512 + c0 + 1]; }
    const float bias0 = cb[c0], bias1 = cb[c0 + 1], lg0 = lg[c0], lg1 = lg[c0 + 1], lb0 = lb[c0], lb1 = lb[c0 + 1];
    for (int it = bid; it < T / 32; it += G) {
        const int grp = it * 2 + gsel, tbase = grp * 16, s0 = tbase & (SEQ - 1);
        float acc0[16], acc1[16];
#pragma unroll
        for (int i = 0; i < 16; ++i) { acc0[i] = bias0; acc1[i] = bias1; }
#pragma unroll
        for (int r = 0; r < 46; ++r) {
            const int sp = s0 - 30 + r; const int src = tbase - 30 + r + ((sp < 0) ? -sp : 0); const float msk = (sp < 0) ? 0.f : 1.f;
            const unsigned wv = *(const unsigned*)(zu + (size_t)src * 512 + c0);
            const float u0 = bflo(wv) * msk, u1 = bfhi(wv) * msk;
#pragma unroll
            for (int i = 0; i < 16; ++i) { const int k = r - i; if (k >= 0 && k <= 30) { acc0[i] += w0[k] * u0; acc1[i] += w1[k] * u1; } }
        }
        float mean[16];
#pragma unroll
        for (int i = 0; i < 16; ++i) { const float s = wave_sum(acc0[i] + acc1[i]); if (lane == 0) red[(gsel * 4 + sub) * 16 + i] = s; }
        __syncthreads();
#pragma unroll
        for (int i = 0; i < 16; ++i) mean[i] = ((red[(gsel * 4 + 0) * 16 + i] + red[(gsel * 4 + 1) * 16 + i]) + (red[(gsel * 4 + 2) * 16 + i] + red[(gsel * 4 + 3) * 16 + i])) * (1.f / 512.f);
        __syncthreads();
#pragma unroll
        for (int i = 0; i < 16; ++i) { const float d0 = acc0[i] - mean[i], d1 = acc1[i] - mean[i]; const float s = wave_sum(d0 * d0 + d1 * d1); if (lane == 0) red[(gsel * 4 + sub) * 16 + i] = s; }
        __syncthreads();
#pragma unroll
        for (int i = 0; i < 16; ++i) {
            const float var = ((red[(gsel * 4 + 0) * 16 + i] + red[(gsel * 4 + 1) * 16 + i]) + (red[(gsel * 4 + 2) * 16 + i] + red[(gsel * 4 + 3) * 16 + i])) * (1.f / 512.f);
            const float rstd = rsqrtf(var + LN_EPS);
            const float y0 = (acc0[i] - mean[i]) * rstd * lg0 + lb0, y1 = (acc1[i] - mean[i]) * rstd * lg1 + lb1;
            *(unsigned*)(uahm + (size_t)(tbase + i) * 1024 + c0) = pk2(siluf_(y0), siluf_(y1));
        }
        __syncthreads();
    }
}

constexpr int ML_QS = 0, ML_KS = 17408, ML_KWT = 34816, ML_VT = 53248, ML_PS = 73984, ML_CT = 83200, ML_GT = 122368, ML_CW = 123648, ML_DEN = 128768, ML_PART = 129024, ML_VS = 130048;
template <bool OUT>
DEV void mlstm_unit(const Args& a, LAS unsigned char* lds, int unit) {
    int tid = threadIdx.x; asm volatile("" : "+v"(tid));
    const int lane = tid & 63, wave = __builtin_amdgcn_readfirstlane(tid >> 6), l15 = lane & 15, q4 = lane >> 4;
    const int j = unit & 7, bh = unit >> 3, h = bh & 3, b = bh >> 2, t0 = b * SEQ + 256 * j;
    const bf16* zq = (const bf16*)(a.ws + WS_ZQ); const bf16* zk = (const bf16*)(a.ws + WS_ZK); const bf16* zv = (const bf16*)(a.ws + WS_ZV); const bf16* zo = (const bf16*)(a.ws + WS_ZO);
    const float* gates = (const float*)(a.ws + WS_GATES); float* state = (float*)(a.ws + WS_STATE); float* stsc = (float*)(a.ws + WS_STSC);
    bf16* uahm = (bf16*)(a.ws + WS_UAHM); const float* qkw = a.in[12]; const float* qkb = a.in[13]; const float* mng = a.in[14];
    LAS bf16* QS = (LAS bf16*)(lds + ML_QS); LAS bf16* KS = (LAS bf16*)(lds + ML_KS); LAS bf16* KWT = (LAS bf16*)(lds + ML_KWT); LAS bf16* VT = (LAS bf16*)(lds + ML_VT);
    LAS bf16* PS = (LAS bf16*)(lds + ML_PS); LAS bf16* CT = (LAS bf16*)(lds + ML_CT); LAS bf16* VS = (LAS bf16*)(lds + ML_VS);
    LAS float* GTwk = (LAS float*)(lds + ML_GT); LAS float* GTsi = GTwk + 64; LAS float* GTlb = GTwk + 128; LAS float* GTg = GTwk + 192; LAS float* GTM = GTwk + 256;
    LAS float* CW = (LAS float*)(lds + ML_CW); LAS float* DEN = (LAS float*)(lds + ML_DEN); LAS float* PART = (LAS float*)(lds + ML_PART);
    __syncthreads();
    for (int i = tid; i < 1280; i += NTHREADS) {
        const float* p = (i < 512) ? (qkw + (i >> 7) * 1024 + h * 128 + (i & 127)) : (i < 1024) ? (qkw + ((i - 512) >> 7) * 1024 + 512 + h * 128 + (i & 127))
                       : (i < 1152) ? (qkb + h * 128 + (i - 1024)) : (qkb + 512 + h * 128 + (i - 1152));
        CW[i] = *p; }
    for (int i = tid; i < 16 * 72; i += NTHREADS) VT[128 * 72 + i] = (i < 64) ? (bf16)0x3F80 : (bf16)0;
    f32x4 accC[9];
#pragma unroll
    for (int i = 0; i < 9; ++i) accC[i] = (f32x4){0.f, 0.f, 0.f, 0.f};
    float mc = OUT ? 0.f : -1e30f, Btot = 0.f;
    if (OUT) {
        float wgt[7];
        {
            const int base = unit - j; float mi[7], Bi[7];
#pragma unroll
            for (int i = 0; i < 7; ++i) { const int u2 = base + ((i < j) ? i : 0); mi[i] = stsc[u2 * 4]; Bi[i] = stsc[u2 * 4 + 1]; }
#pragma unroll
            for (int i = 0; i < 7; ++i) if (i < j) mc = fmaxf(Bi[i] + mc, mi[i]);
            float suf = 0.f;
#pragma unroll
            for (int i = 6; i >= 0; --i) { wgt[i] = (i < j) ? __expf(mi[i] + suf - mc) : 0.f; if (i < j) suf += Bi[i]; }
        }
#pragma unroll
        for (int ii = 0; ii < 9; ++ii) {
            f32x4 ld[7];
#pragma unroll
            for (int i = 0; i < 7; ++i) { const size_t u2 = (size_t)(unit - j + ((i < j) ? i : 0));
#pragma unroll
                for (int r = 0; r < 4; ++r) ld[i][r] = state[(u2 * 36 + ii * 4 + r) * 512 + tid]; }
#pragma unroll
            for (int i = 0; i < 7; ++i) accC[ii] = accC[ii] + ld[i] * wgt[i];
        }
#pragma unroll
        for (int ii = 0; ii < 9; ++ii)
#pragma unroll
            for (int r = 0; r < 4; ++r) CT[(16 * ii + 4 * q4 + r) * 136 + 16 * wave + l15] = f2bf(accC[ii][r]);
    }
    float mg[4];
    if (OUT) {
#pragma unroll
        for (int i = 0; i < 4; ++i) mg[i] = mng[h * 128 + 16 * (4 * (wave & 1) + i) + l15];
    }
    __syncthreads();
    float li_n = gates[(size_t)(t0 + lane) * 8 + h], lf_n = gates[(size_t)(t0 + lane) * 8 + 4 + h];
    for (int cc = 0; cc < 4; ++cc) {
        const int tc = t0 + 64 * cc;
        const float li = li_n, lf = lf_n;
        if (cc < 3) { li_n = gates[(size_t)(tc + 64 + lane) * 8 + h]; lf_n = gates[(size_t)(tc + 64 + lane) * 8 + 4 + h]; }
        const float bc = wave_scan_add(lf, lane);
        const float g = li - bc;
        const float cm = wave_scan_max(g, lane);
        const float M = fmaxf(mc, cm);
        const float M63 = rdlane(M, 63), blast = rdlane(bc, 63);
        const float wkv = __expf(g - M63), sc = __expf(mc - M63), mnew = blast + M63;
        if (wave == 0) { GTwk[lane] = wkv; GTsi[lane] = __expf(mc - M); GTlb[lane] = __expf(-(bc + M)); GTg[lane] = g; GTM[lane] = M; }
        {
            const int cg = tid & 15, rp = tid >> 4, s0 = 2 * rp;
            v4u kraw[5], qraw[5], vraw[2];
#pragma unroll
            for (int m = 0; m < 5; ++m) { const int spos = 256 * j + 64 * cc + s0 - 3 + m; const bool ok = spos >= 0; const int src = ok ? (tc + s0 - 3 + m) : tc;
                kraw[m] = *(const v4u*)(zk + (size_t)src * 512 + h * 128 + cg * 8); }
#pragma unroll
            for (int rr = 0; rr < 2; ++rr) vraw[rr] = *(const v4u*)(zv + (size_t)(tc + s0 + rr) * 512 + h * 128 + cg * 8);
#define ML_CONV(RAW, WOFF, BOFF, DST, SCALE) do { float ac[2][8]; \
            _Pragma("unroll") for (int e = 0; e < 8; ++e) { ac[0][e] = ac[1][e] = CW[(BOFF) + cg * 8 + e]; } \
            _Pragma("unroll") for (int m = 0; m < 5; ++m) { const v4u rw_ = RAW[m]; const float ms = (256 * j + 64 * cc + s0 - 3 + m >= 0) ? 1.f : 0.f; \
                const float xv[8] = {bflo(rw_.x) * ms, bfhi(rw_.x) * ms, bflo(rw_.y) * ms, bfhi(rw_.y) * ms, bflo(rw_.z) * ms, bfhi(rw_.z) * ms, bflo(rw_.w) * ms, bfhi(rw_.w) * ms}; \
                _Pragma("unroll") for (int rr = 0; rr < 2; ++rr) { const int tap = m - rr; if (tap >= 0 && tap < 4) { \
                    _Pragma("unroll") for (int e = 0; e < 8; ++e) ac[rr][e] += CW[(WOFF) + tap * 128 + cg * 8 + e] * xv[e]; } } } \
            _Pragma("unroll") for (int rr = 0; rr < 2; ++rr) { v4u o; \
                o.x = pk2(siluf_(ac[rr][0]) * (SCALE), siluf_(ac[rr][1]) * (SCALE)); o.y = pk2(siluf_(ac[rr][2]) * (SCALE), siluf_(ac[rr][3]) * (SCALE)); \
                o.z = pk2(siluf_(ac[rr][4]) * (SCALE), siluf_(ac[rr][5]) * (SCALE)); o.w = pk2(siluf_(ac[rr][6]) * (SCALE), siluf_(ac[rr][7]) * (SCALE)); \
                *(LAS v4u*)((DST) + (s0 + rr) * 136 + cg * 8) = o; } } while (0)
            if (OUT) {
#pragma unroll
                for (int m = 0; m < 5; ++m) { const int spos = 256 * j + 64 * cc + s0 - 3 + m; const int src = (spos >= 0) ? (tc + s0 - 3 + m) : tc; qraw[m] = *(const v4u*)(zq + (size_t)src * 512 + h * 128 + cg * 8); } }
            ML_CONV(kraw, 512, 1152, KS, 1.f);
            asm volatile("" ::: "memory");
            if (OUT) ML_CONV(qraw, 0, 1024, QS, 0.08838834764831845f);
#undef ML_CONV
#pragma unroll
            for (int rr = 0; rr < 2; ++rr) *(LAS v4u*)(VS + (s0 + rr) * 136 + cg * 8) = vraw[rr];
        }
        __syncthreads();
        if (OUT) {
            const int tt = wave >> 1;
#pragma unroll
            for (int si = 0; si < 2; ++si) {
                const int st = 2 * (wave & 1) + si;
                f32x4 sacc = (f32x4){0.f, 0.f, 0.f, 0.f};
                if (st <= tt) {
#pragma unroll
                    for (int kk = 0; kk < 4; ++kk) sacc = mma16(*(const LAS bf16x8*)(QS + (16 * tt + l15) * 136 + 32 * kk + 8 * q4), *(const LAS bf16x8*)(KS + (16 * st + l15) * 136 + 32 * kk + 8 * q4), sacc);
                }
                const int sl = 16 * st + l15; const float gs = GTg[sl];
#pragma unroll
                for (int r = 0; r < 4; ++r) { const int tl = 16 * tt + 4 * q4 + r; const float w = (sl <= tl) ? __expf(gs - GTM[tl]) : 0.f; PS[tl * 72 + sl] = f2bf(sacc[r] * w); }
            }
        }
        {
            const int d = tid & 127, sg = tid >> 7; float kv[16];
#pragma unroll
            for (int i = 0; i < 16; ++i) kv[i] = bf2f(KS[(16 * sg + i) * 136 + d]) * GTwk[16 * sg + i];
            v4u o0, o1;
            o0.x = pk2(kv[0], kv[1]); o0.y = pk2(kv[2], kv[3]); o0.z = pk2(kv[4], kv[5]); o0.w = pk2(kv[6], kv[7]);
            o1.x = pk2(kv[8], kv[9]); o1.y = pk2(kv[10], kv[11]); o1.z = pk2(kv[12], kv[13]); o1.w = pk2(kv[14], kv[15]);
            *(LAS v4u*)(KWT + d * 72 + 16 * sg) = o0; *(LAS v4u*)(KWT + d * 72 + 16 * sg + 8) = o1;
            unsigned vw[8];
#pragma unroll
            for (int i = 0; i < 8; ++i) vw[i] = (unsigned)VS[(16 * sg + 2 * i) * 136 + d] | ((unsigned)VS[(16 * sg + 2 * i + 1) * 136 + d] << 16);
            o0.x = vw[0]; o0.y = vw[1]; o0.z = vw[2]; o0.w = vw[3]; o1.x = vw[4]; o1.y = vw[5]; o1.z = vw[6]; o1.w = vw[7];
            *(LAS v4u*)(VT + d * 72 + 16 * sg) = o0; *(LAS v4u*)(VT + d * 72 + 16 * sg + 8) = o1;
        }
        __syncthreads();
        f32x4 res[5];
        if (OUT) {
            const int tt = wave >> 1, dv0 = 4 * (wave & 1);
            bf16x8 pa[2], qa[4];
#pragma unroll
            for (int kk = 0; kk < 2; ++kk) pa[kk] = *(const LAS bf16x8*)(PS + (16 * tt + l15) * 72 + 32 * kk + 8 * q4);
#pragma unroll
            for (int kk = 0; kk < 4; ++kk) qa[kk] = *(const LAS bf16x8*)(QS + (16 * tt + l15) * 136 + 32 * kk + 8 * q4);
            float si[4];
#pragma unroll
            for (int r = 0; r < 4; ++r) si[r] = GTsi[16 * tt + 4 * q4 + r];
#pragma unroll
            for (int i = 0; i < 5; ++i) {
                const int dvt = (i < 4) ? (dv0 + i) : 8;
                if (i < 4 || (wave & 1) == 0) {
                    f32x4 a1 = (f32x4){0.f, 0.f, 0.f, 0.f}, a2 = (f32x4){0.f, 0.f, 0.f, 0.f};
#pragma unroll
                    for (int kk = 0; kk < 2; ++kk) a1 = mma16(pa[kk], *(const LAS bf16x8*)(VT + (16 * dvt + l15) * 72 + 32 * kk + 8 * q4), a1);
#pragma unroll
                    for (int kk = 0; kk < 4; ++kk) a2 = mma16(qa[kk], *(const LAS bf16x8*)(CT + (16 * dvt + l15) * 136 + 32 * kk + 8 * q4), a2);
#pragma unroll
                    for (int r = 0; r < 4; ++r) res[i][r] = a1[r] + si[r] * a2[r];
                } else res[i] = (f32x4){0.f, 0.f, 0.f, 0.f};
            }
            if ((wave & 1) == 0 && l15 == 0) {
#pragma unroll
                for (int r = 0; r < 4; ++r) DEN[16 * tt + 4 * q4 + r] = res[4][r];
            }
        }
        {
            bf16x8 kb[2];
#pragma unroll
            for (int kk = 0; kk < 2; ++kk) kb[kk] = *(const LAS bf16x8*)(KWT + (16 * wave + l15) * 72 + 32 * kk + 8 * q4);
#pragma unroll
            for (int i = 0; i < 9; ++i) { accC[i] = accC[i] * sc;
#pragma unroll
                for (int kk = 0; kk < 2; ++kk) accC[i] = mma16(*(const LAS bf16x8*)(VT + (16 * i + l15) * 72 + 32 * kk + 8 * q4), kb[kk], accC[i]); }
        }
        __syncthreads();
        if (OUT) {
            const int tt = wave >> 1;
            float den[4], lbv[4];
#pragma unroll
            for (int r = 0; r < 4; ++r) { den[r] = DEN[16 * tt + 4 * q4 + r]; lbv[r] = GTlb[16 * tt + 4 * q4 + r]; }
#pragma unroll
            for (int r = 0; r < 4; ++r) { const float inv = 1.f / fmaxf(fabsf(den[r]), lbv[r]); float s1 = 0.f, s2 = 0.f;
#pragma unroll
                for (int i = 0; i < 4; ++i) { res[i][r] *= inv; s1 += res[i][r]; s2 += res[i][r] * res[i][r]; }
                s1 = row16_sum(s1); s2 = row16_sum(s2);
                if (l15 == 0) { PART[((16 * tt + 4 * q4 + r) * 2 + (wave & 1)) * 2] = s1; PART[((16 * tt + 4 * q4 + r) * 2 + (wave & 1)) * 2 + 1] = s2; } }
#pragma unroll
            for (int ii = 0; ii < 9; ++ii)
#pragma unroll
                for (int r = 0; r < 4; ++r) CT[(16 * ii + 4 * q4 + r) * 136 + 16 * wave + l15] = f2bf(accC[ii][r]);
            __syncthreads();
#pragma unroll
            for (int r = 0; r < 4; ++r) { const int tl = 16 * tt + 4 * q4 + r; const size_t trow = (size_t)(tc + tl);
                const float s1 = PART[(tl * 2) * 2] + PART[(tl * 2 + 1) * 2], s2 = PART[(tl * 2) * 2 + 1] + PART[(tl * 2 + 1) * 2 + 1];
                const float mean = s1 * (1.f / 128.f), var = fmaxf(s2 * (1.f / 128.f) - mean * mean, 0.f), rstd = rsqrtf(var + LN_EPS);
#pragma unroll
                for (int i = 0; i < 4; ++i) { const int dvv = 16 * (4 * (wave & 1) + i) + l15;
                    const float y = (res[i][r] - mean) * rstd * mg[i] * bf2f(zo[trow * 512 + h * 128 + dvv]);
                    uahm[trow * 1024 + 512 + h * 128 + dvv] = f2bf(y); } }
        }
        mc = mnew; Btot += blast;
    }
    if (!OUT) {
#pragma unroll
        for (int ii = 0; ii < 9; ++ii)
#pragma unroll
            for (int r = 0; r < 4; ++r) state[((size_t)unit * 36 + ii * 4 + r) * 512 + tid] = accC[ii][r];
        if (tid == 0) { stsc[unit * 4] = mc; stsc[unit * 4 + 1] = Btot; }
    }
}

DEV void p8_route(const Args& a, LAS unsigned char* lds, int bid, int G) {
    const int tid = threadIdx.x, lane = tid & 63, wave = __builtin_amdgcn_readfirstlane(tid >> 6), l15 = lane & 15, q4 = lane >> 4;
    const float* x1 = a.out; const float* g2 = a.in[17]; const float* w_rg = a.in[18]; const float* w_re = a.in[20];
    const float* mod = (const float*)(a.ws + WS_MOD); const float* rbias = (const float*)(a.ws + WS_RBIAS); const v4u* rw = (const v4u*)(a.ws + WS_RW); bf16* h2 = (bf16*)(a.ws + WS_H);
    int* toke = (int*)(a.ws + WS_TOKE); float* tokw = (float*)(a.ws + WS_TOKW);
    int* listt = (int*)(a.ws + WS_LISTT); float* listw = (float*)(a.ws + WS_LISTW); unsigned* cnt = (unsigned*)(a.ws + WS_CTL) + CW_CNT;
    LAS float* PL = (LAS float*)lds;
    LAS float* SS = (LAS float*)(lds + 98304);
    LAS float* LG = (LAS float*)(lds + 100352);
    LAS float* RS = (LAS float*)(lds + 109568);
    LAS unsigned* lcnt = (LAS unsigned*)(lds + LDS_MISC + 256);
    LAS unsigned* lbase = lcnt + 32;
    LAS unsigned* lent = lcnt + 64;
    LAS float* lwt = (LAS float*)(lcnt + 192);
    for (int tile = bid; tile < T / 64; tile += G) {
        const int b = tile / 32;
        __syncthreads();
        if (tid < 32) lcnt[tid] = 0u;
        f32x4 acc[4][3]; float ss[4];
#pragma unroll
        for (int rt = 0; rt < 4; ++rt) { ss[rt] = 0.f;
#pragma unroll
            for (int nt = 0; nt < 3; ++nt) acc[rt][nt] = (f32x4){0.f, 0.f, 0.f, 0.f}; }
#pragma unroll 1
        for (int kk = 0; kk < 4; ++kk) {
            const int k0 = 128 * wave + 32 * kk + 8 * q4;
            bf16x8 bhi[3], blo[3];
#pragma unroll
            for (int nt = 0; nt < 3; ++nt) { const size_t it = ((size_t)(b * 8 + wave) * 4 + kk) * 3 + nt;
                bhi[nt] = __builtin_bit_cast(bf16x8, rw[(it * 2) * 64 + lane]); blo[nt] = __builtin_bit_cast(bf16x8, rw[(it * 2 + 1) * 64 + lane]); }
#pragma unroll
            for (int rt = 0; rt < 4; ++rt) {
                const float* xp = x1 + ((size_t)tile * 64 + 16 * rt + l15) * 1024 + k0;
                const f32x4 xa = *(const f32x4*)xp, xb = *(const f32x4*)(xp + 4);
                ss[rt] += (xa[0] * xa[0] + xa[1] * xa[1]) + (xa[2] * xa[2] + xa[3] * xa[3]) + (xb[0] * xb[0] + xb[1] * xb[1]) + (xb[2] * xb[2] + xb[3] * xb[3]);
                bf16x8 ahi, alo; split8(xa, xb, ahi, alo);
#pragma unroll
                for (int nt = 0; nt < 3; ++nt) { acc[rt][nt] = mma16(ahi, bhi[nt], acc[rt][nt]); acc[rt][nt] = mma16(alo, bhi[nt], acc[rt][nt]); acc[rt][nt] = mma16(ahi, blo[nt], acc[rt][nt]); }
            }
        }
#pragma unroll
        for (int rt = 0; rt < 4; ++rt) {
            float sv = ss[rt]; sv += __shfl_xor(sv, 16); sv += __shfl_xor(sv, 32);
            if (q4 == 0) SS[wave * 64 + 16 * rt + l15] = sv;
#pragma unroll
            for (int nt = 0; nt < 3; ++nt)
#pragma unroll
                for (int r = 0; r < 4; ++r) PL[(wave * 64 + 16 * rt + 4 * q4 + r) * 48 + 16 * nt + l15] = acc[rt][nt][r];
        }
        __syncthreads();
        {
            const int row = tid >> 3, part = tid & 7;
            float ssum = 0.f;
#pragma unroll
            for (int w = 0; w < 8; ++w) ssum += SS[w * 64 + row];
            const float rstd = rsqrtf(ssum * (1.f / 1024.f) + RMS_EPS);
            if (part == 0) RS[row] = rstd;
#pragma unroll
            for (int i = 0; i < 5; ++i) { const int n = part + 8 * i; if (n < 36) { float s = 0.f;
#pragma unroll
                    for (int w = 0; w < 8; ++w) s += PL[(w * 64 + row) * 48 + n];
                    LG[row * 36 + n] = rstd * s + rbias[b * 48 + n]; } }
        }
        __syncthreads();
        if (tid < 64) {
            const int r = tid; const size_t row = (size_t)tile * 64 + r;
            float lg[36];
#pragma unroll
            for (int q = 0; q < 36; ++q) lg[q] = LG[r * 36 + q];
            int gs = 0; float gm = lg[0];
#pragma unroll
            for (int q = 1; q < 4; ++q) if (lg[q] > gm) { gm = lg[q]; gs = q; }
            float se = 0.f;
#pragma unroll
            for (int q = 0; q < 4; ++q) se += __expf(lg[q] - gm);
            const float pg = 1.f / se;
            float le[8];
#pragma unroll
            for (int q = 0; q < 8; ++q) { float vsel = lg[4 + q];
#pragma unroll
                for (int gg = 1; gg < 4; ++gg) vsel = (gs == gg) ? lg[4 + 8 * gg + q] : vsel;
                le[q] = vsel; }
            int e0 = 0; float l0 = le[0];
#pragma unroll
            for (int q = 1; q < 8; ++q) if (le[q] > l0) { l0 = le[q]; e0 = q; }
            int e1 = -1; float l1 = -3.0e38f;
#pragma unroll
            for (int q = 0; q < 8; ++q) if (q != e0 && le[q] > l1) { l1 = le[q]; e1 = q; }
            const float rr = __expf(l1 - l0), w0 = pg / (1.f + rr), w1 = pg * rr / (1.f + rr);
#pragma unroll
            for (int sl = 0; sl < 2; ++sl) { const int e = gs * 8 + (sl ? e1 : e0); const float w = sl ? w1 : w0;
                toke[row * 2 + sl] = e; tokw[row * 2 + sl] = w;
                const unsigned lp = __hip_atomic_fetch_add(lcnt + e, 1u, __ATOMIC_RELAXED, __HIP_MEMORY_SCOPE_WORKGROUP);
                lent[r * 2 + sl] = (unsigned)e | (lp << 8); lwt[r * 2 + sl] = w; }
        }
        __syncthreads();
        if (tid < 32 && !(a.flags & 2)) { const unsigned n = lcnt[tid]; lbase[tid] = n ? atomicAdd(cnt + 16 * tid, n) : 0u; }
        {
            float sc[4][4], sh[4][4];
#pragma unroll
            for (int j = 0; j < 4; ++j) { const int k = 256 * j + 4 * lane; const f32x4 gv = *(const f32x4*)(g2 + k), sv = *(const f32x4*)(mod + b * 6144 + 4096 + k), hv = *(const f32x4*)(mod + b * 6144 + 3072 + k);
#pragma unroll
                for (int i = 0; i < 4; ++i) { sc[j][i] = gv[i] * (1.f + sv[i]); sh[j][i] = hv[i]; } }
            f32x4 nx[4];
#pragma unroll
            for (int j = 0; j < 4; ++j) nx[j] = *(const f32x4*)(x1 + ((size_t)tile * 64 + wave) * 1024 + 256 * j + 4 * lane);
#pragma unroll 1
            for (int r = wave; r < 64; r += NWAVES) {
                const size_t row = (size_t)tile * 64 + r; f32x4 v[4];
#pragma unroll
                for (int j = 0; j < 4; ++j) v[j] = nx[j];
                if (r + NWAVES < 64) {
#pragma unroll
                    for (int j = 0; j < 4; ++j) nx[j] = *(const f32x4*)(x1 + (row + NWAVES) * 1024 + 256 * j + 4 * lane); }
                asm volatile("" ::: "memory");
                const float rstd = RS[r];
#pragma unroll
                for (int j = 0; j < 4; ++j) { v2u o; o.x = pk2(v[j][0] * rstd * sc[j][0] + sh[j][0], v[j][1] * rstd * sc[j][1] + sh[j][1]); o.y = pk2(v[j][2] * rstd * sc[j][2] + sh[j][2], v[j][3] * rstd * sc[j][3] + sh[j][3]);
                    *(v2u*)(h2 + row * 1024 + 256 * j + 4 * lane) = o; }
            }
        }
        __syncthreads();
        if (tid < 128 && !(a.flags & 2)) { const unsigned en = lent[tid]; const unsigned e = en & 255u, lp = en >> 8; const unsigned pos = lbase[e] + lp;
            listt[e * 16384 + pos] = (tile * 64 + (tid >> 1)) * 2 + (tid & 1); listw[e * 16384 + pos] = lwt[tid]; }
    }
    __syncthreads();
}
DEV void p8_convert(const Args& a, LAS unsigned char* lds, int bid, int G) {
    const int tid = threadIdx.x, lane = tid & 63, wave = __builtin_amdgcn_readfirstlane(tid >> 6);
    LAS float* scr = (LAS float*)(lds + wave * 16384);
    const float* wg = a.in[22]; const float* wu = a.in[23]; const float* wd = a.in[24];
    bf16* WGU = (bf16*)(a.ws + WS_WGU); bf16* WD = (bf16*)(a.ws + WS_WD);
    const int gw = bid * NWAVES + wave, NGW = G * NWAVES;
    for (int it = gw; it < 32 * 768; it += NGW) {
        const int e = it / 768; int r = it % 768;
        if (r < 512) { const int up = r >> 8; r &= 255; const int kb = r >> 4, nb = r & 15, n = 32 * nb, np = 256 * (n >> 7) + 128 * up + (n & 127);
            transpose_item((up ? wu : wg) + (size_t)e * 1024 * 512 + (size_t)(64 * kb) * 512 + n, 512, WGU + ((size_t)e * 1024 + np) * 1024 + 64 * kb, 1024, scr, lane); }
        else { r -= 512; const int kb = r >> 5, nb = r & 31;
            transpose_item(wd + (size_t)e * 512 * 1024 + (size_t)(64 * kb) * 1024 + 32 * nb, 1024, WD + ((size_t)e * 1024 + 32 * nb) * 512 + 64 * kb, 512, scr, lane); }
    }
}

struct MoeSched {
    const LAS int* tlist; const LAS int* rstart; const LAS int* ecnt; int U, G, c; unsigned bstride;
    DEV bool next(int i, Unit& u) const {
        const int L = i * G + c; if (L >= U) return false;
        const int ent = tlist[L >> 2]; const int e = ent & 255, rt = ent >> 8; u.pn = L & 3;
        const int left = ecnt[e] - 256 * rt;
        u.pm = 0; u.ak = 0; u.bk = (unsigned)e * bstride; u.slot = i; u.valid = left < 256 ? left : 256; u.arow0 = rstart[e] + 256 * rt; return true;
    }
};
DEV void moe_tables(const Args& a, LAS unsigned char* lds, int bid, int G, MoeSched& S, bool down) {
    const int tid = threadIdx.x;
    LAS int* ti = (LAS int*)(lds + LDS_MISC + 1024); LAS int* rstart = ti, *ecnt = ti + 40, *tlist = ti + 80, *ntl = ti + 260;
    const unsigned* cnt = (const unsigned*)(a.ws + WS_CTL) + CW_CNT;
    const int* listt = (const int*)(a.ws + WS_LISTT); const float* listw = (const float*)(a.ws + WS_LISTW);
    __syncthreads();
    if (tid < 64) {
        const int lane = tid; const int n = (lane < 32) ? (int)__hip_atomic_load(cnt + 16 * (lane & 31), __ATOMIC_RELAXED, __HIP_MEMORY_SCOPE_AGENT) : 0;
        const int ntile = (n + 255) >> 8, nfull = (n + 127) >> 8, ntail = ntile - nfull;
        const int rs = (int)wave_scan_add((float)n, lane) - n, of = (int)wave_scan_add((float)nfull, lane) - nfull, ot = (int)wave_scan_add((float)ntail, lane) - ntail;
        const int totf = (int)rdlane(wave_scan_add((float)nfull, lane), 63), tott = (int)rdlane(wave_scan_add((float)ntail, lane), 63);
        if (lane < 32) { ecnt[lane] = n; rstart[lane] = rs;
            for (int rt = 0; rt < nfull; ++rt) tlist[of + rt] = lane | (rt << 8);
            if (ntail) tlist[totf + ot] = lane | (nfull << 8); }
        if (lane == 32) rstart[32] = rs;
        if (lane == 0) ntl[0] = totf + tott;
    }
    __syncthreads();
    S.tlist = tlist; S.rstart = rstart; S.ecnt = ecnt; S.U = 4 * ntl[0]; S.G = G; S.c = bid;
    LAS unsigned* tab0 = (LAS unsigned*)(lds + LDS_TAB); LAS float* tab1 = (LAS float*)(lds + LDS_TAB + 8192);
    Unit u;
    for (int i = 0; i < 8 && S.next(i, u); ++i) {
        if (tid < 256) { const int e = (int)(u.bk / S.bstride); const int pos = (u.arow0 - rstart[e]) + tid; unsigned v0 = 0u; float v1 = 0.f;
            if (tid < u.valid) { const int tk = listt[e * 16384 + pos]; v0 = down ? (unsigned)tk : (unsigned)(tk >> 1) * 2048u; v1 = listw[e * 16384 + pos]; }
            tab0[i * 256 + tid] = v0; tab1[i * 256 + tid] = v1; }
    }
    __syncthreads();
}

DEV void p11_final(const Args& a, int bid, int G) {
    const int tid = threadIdx.x, lane = tid & 63, wave = __builtin_amdgcn_readfirstlane(tid >> 6);
    const float* mod = (const float*)(a.ws + WS_MOD); const bf16* ys = (const bf16*)(a.ws + WS_YS); const float* gf = a.in[25]; float* out = a.out;
    for (int tile = bid; tile < T / 64; tile += G) {
        const int b = tile / 32;
        f32x4 nx[4], gtv[4], gfv[4]; v2u ny0[4], ny1[4];
#pragma unroll
        for (int j = 0; j < 4; ++j) { const int k = 256 * j + 4 * lane; gtv[j] = *(const f32x4*)(mod + b * 6144 + 5120 + k); gfv[j] = *(const f32x4*)(gf + k); }
#pragma unroll
        for (int j = 0; j < 4; ++j) { const size_t row = (size_t)tile * 64 + wave; const int k = 256 * j + 4 * lane;
            nx[j] = *(const f32x4*)(out + row * 1024 + k); ny0[j] = *(const v2u*)(ys + row * 2048 + k); ny1[j] = *(const v2u*)(ys + row * 2048 + 1024 + k); }
#pragma unroll 1
        for (int r = wave; r < 64; r += NWAVES) {
            const size_t row = (size_t)tile * 64 + r;
            f32x4 v[4]; float ss = 0.f;
#pragma unroll
            for (int j = 0; j < 4; ++j) { const int k = 256 * j + 4 * lane;
                const f32x4 xv = nx[j], gt = gtv[j]; const v2u y0 = ny0[j], y1 = ny1[j];
                v[j][0] = xv[0] + gt[0] * (bflo(y0.x) + bflo(y1.x)); v[j][1] = xv[1] + gt[1] * (bfhi(y0.x) + bfhi(y1.x));
                v[j][2] = xv[2] + gt[2] * (bflo(y0.y) + bflo(y1.y)); v[j][3] = xv[3] + gt[3] * (bfhi(y0.y) + bfhi(y1.y));
                ss += (v[j][0] * v[j][0] + v[j][1] * v[j][1]) + (v[j][2] * v[j][2] + v[j][3] * v[j][3]); }
            if (r + NWAVES < 64) {
#pragma unroll
                for (int j = 0; j < 4; ++j) { const size_t rn = row + NWAVES; const int k = 256 * j + 4 * lane;
                    nx[j] = *(const f32x4*)(out + rn * 1024 + k); ny0[j] = *(const v2u*)(ys + rn * 2048 + k); ny1[j] = *(const v2u*)(ys + rn * 2048 + 1024 + k); } }
            asm volatile("" ::: "memory");
            const float rstd = rsqrtf(wave_sum(ss) * (1.f / 1024.f) + RMS_EPS);
#pragma unroll
            for (int j = 0; j < 4; ++j) { const int k = 256 * j + 4 * lane; *(f32x4*)(out + row * 1024 + k) = v[j] * rstd * gfv[j]; }
        }
    }
}

constexpr int NPHASE = 11;
template <int LO, int HI>
__global__ void __launch_bounds__(NTHREADS, 2) mk_fwd(Args a) {
    extern __shared__ __attribute__((aligned(16))) unsigned char lds_raw[];
    LAS unsigned char* lds = (LAS unsigned char*)lds_raw;
    const int tid = threadIdx.x, G = gridDim.x, bid = blockIdx.x;
    volatile LAS unsigned* MISC = (volatile LAS unsigned*)(lds + LDS_MISC);
    if (tid < 64) MISC[tid] = 0u;
    __syncthreads();
#if MK_ONE
    XcdBarrier bar = xcd_barrier_post((unsigned*)(a.ws + WS_CTL) + CW_BAR, MISC + 8);
#define GRID_BAR() xcd_barrier(bar)
#else
#define GRID_BAR() do {} while (0)
#endif
    constexpr int lo = LO, hi = HI;
#define IN(k) (lo <= (k) && (k) < hi)
#define BOTH(k) (IN(k) && IN((k) + 1))
    if constexpr (IN(0)) { REPK(0) { p0_prologue(a, lds, bid, G); REPSYNC(); } if constexpr (BOTH(0)) __syncthreads(); }
    if constexpr (IN(1)) { REPK(1) { p1_h1(a, lds, bid, G); REPSYNC(); } if constexpr (BOTH(1)) GRID_BAR(); }
    if constexpr (IN(2)) {
        __syncthreads();
        ProbPlain P{(const bf16*)(a.ws + WS_H), (const bf16*)(a.ws + WS_W1T), 2048u, 2048u};
#if DBG_GATEFIRST
        struct SchedG { pg8::StaticOrder so; DEV bool next(int i, Unit& u) const { if (i >= 2) return false; return so.next(i + 3, u); } } S; S.so.init(T, 5120, G, bid);
#else
        pg8::StaticOrder S; S.init(T, 5120, G, bid);
#endif
        Epi1 E{(bf16*)(a.ws + WS_ZU), (bf16*)(a.ws + WS_ZGA), (a.flags >> 8) & 15};
        REPK(2) pg8::gemm_phase<ProbPlain, Epi1, decltype(S), true>(lds, P, S, E, 1024);
        if constexpr (BOTH(2)) GRID_BAR();
    }
    if constexpr (IN(3)) {
        REPK(3) { for (int u = bid; u < 256; u += G) mlstm_unit<false>(a, lds, u);
        __syncthreads(); }
        REPK(11) { p3_conva(a, lds, bid, G); REPSYNC(); }
        if constexpr (BOTH(3)) GRID_BAR();
    }
    if constexpr (IN(4)) {
        REPK(4) { for (int u = bid; u < 256; u += G) mlstm_unit<true>(a, lds, u); REPSYNC(); }
        if constexpr (BOTH(4)) GRID_BAR();
    }
    if constexpr (IN(5)) {
        __syncthreads();
        struct Sched2 { pg8::StaticOrder so; DEV bool next(int i, Unit& u) const { u.ak = (unsigned)(i & 1) * 1024u; u.bk = u.ak; u.slot = i & 1; u.valid = 256; u.arow0 = 0; return so.tile((i >> 1) * so.G + so.c, u.pm, u.pn); } } S;
        S.so.init(T, 1024, G, bid);
        ProbPlain P{(const bf16*)(a.ws + WS_UAHM), (const bf16*)(a.ws + WS_W2T), 2048u, 2048u};
        Epi2 E{(const bf16*)(a.ws + WS_ZGA), (const bf16*)(a.ws + WS_ZGB), (bf16*)(a.ws + WS_MERGED)};
        REPK(5) pg8::gemm_phase<ProbPlain, Epi2, Sched2, false>(lds, P, S, E, 512);
        if constexpr (BOTH(5)) GRID_BAR();
    }
    if constexpr (IN(6)) {
        __syncthreads();
        ProbPlain P{(const bf16*)(a.ws + WS_MERGED), (const bf16*)(a.ws + WS_W3T), 2048u, 2048u};
        pg8::StaticOrder S; S.init(T, 1024, G, bid);
        Epi3 E{a.in[0], (const float*)(a.ws + WS_MOD), a.out};
        REPK(6) pg8::gemm_phase<ProbPlain, Epi3, pg8::StaticOrder, false>(lds, P, S, E, 1024);
        if constexpr (BOTH(6)) GRID_BAR();
    }
    if constexpr (IN(7)) {
        if (!(a.flags & 1)) p8_route(a, lds, bid, G);
        __syncthreads();
        if (!(a.flags & 4)) { p8_convert(a, lds, bid, G); }
        if constexpr (BOTH(7)) GRID_BAR();
    }
    if constexpr (IN(8)) {
        MoeSched S; S.bstride = 1024u * 1024u * 2u;
        moe_tables(a, lds, bid, G, S, false);
        ProbMoeUp P{(const bf16*)(a.ws + WS_H), (const bf16*)(a.ws + WS_WGU), (const LAS unsigned*)(lds + LDS_TAB)};
        EpiUp E{(bf16*)(a.ws + WS_ACT)};
        REPK(8) pg8::gemm_phase<ProbMoeUp, EpiUp, MoeSched, false, true>(lds, P, S, E, 1024);
        if constexpr (BOTH(8)) GRID_BAR();
    }
    if constexpr (IN(9)) {
        MoeSched S; S.bstride = 1024u * 512u * 2u;
        moe_tables(a, lds, bid, G, S, true);
        ProbMoeDown P{(const bf16*)(a.ws + WS_ACT), (const bf16*)(a.ws + WS_WD)};
        EpiDown E{(bf16*)(a.ws + WS_YS), (const LAS unsigned*)(lds + LDS_TAB), (const LAS float*)(lds + LDS_TAB + 8192)};
        REPK(9) pg8::gemm_phase<ProbMoeDown, EpiDown, MoeSched, false, true>(lds, P, S, E, 512);
        if constexpr (BOTH(9)) GRID_BAR();
    }
    if constexpr (IN(10)) { p11_final(a, bid, G); }
#undef IN
#undef BOTH
}

#if NAIVE_MASK
__global__ __launch_bounds__(256) void k_fixw1t(const float* w_in, bf16* W1T) { const size_t i = (size_t)blockIdx.x * 256 + threadIdx.x; const size_t n = i / 1024, k = i % 1024; W1T[(3072 + n) * 1024 + k] = f2bf(w_in[k * 5128 + 3080 + n]); }
DEV float block_sum256(float v, float* red) {
#pragma unroll
    for (int o = 32; o >= 1; o >>= 1) v += __shfl_xor(v, o);
    __syncthreads();
    if ((threadIdx.x & 63) == 0) red[threadIdx.x >> 6] = v;
    __syncthreads();
    return (red[0] + red[1]) + (red[2] + red[3]);
}
__global__ __launch_bounds__(256) void k_mod(const float* c, const float* w_ada, const float* b_ada, float* mod) {
    const int idx = blockIdx.x * 256 + threadIdx.x; const int b = idx / 6144, n = idx % 6144;
    float acc = 0.f;
    for (int k = 0; k < D; ++k) acc += siluf_(c[b * D + k]) * w_ada[(size_t)k * 6144 + n];
    mod[idx] = acc + b_ada[n];
}
__global__ __launch_bounds__(256) void k_h1(const float* x, const float* g1, const float* mod, const float* w_in, const float* b_if, bf16* h1, float* gates) {
    __shared__ float red[4];
    const int t = blockIdx.x, b = t / SEQ, tid = threadIdx.x;
    const float4 xv = ((const float4*)(x + (size_t)t * D))[tid];
    float ss = xv.x * xv.x + xv.y * xv.y + xv.z * xv.z + xv.w * xv.w;
    ss = block_sum256(ss, red);
    const float rstd = rsqrtf(ss * (1.f / D) + RMS_EPS);
    const float* sh = mod + b * 6144, *sc = mod + b * 6144 + 1024;
    float hv[4]; const float xs[4] = {xv.x, xv.y, xv.z, xv.w};
#pragma unroll
    for (int j = 0; j < 4; ++j) { const int k = tid * 4 + j; hv[j] = xs[j] * rstd * g1[k] * (1.f + sc[k]) + sh[k]; }
    ushort4 o; o.x = f2bf(hv[0]); o.y = f2bf(hv[1]); o.z = f2bf(hv[2]); o.w = f2bf(hv[3]);
    ((ushort4*)(h1 + (size_t)t * D))[tid] = o;
    float g[8];
#pragma unroll
    for (int j = 0; j < 8; ++j) g[j] = 0.f;
#pragma unroll
    for (int i = 0; i < 4; ++i) { const float* wr = w_in + (size_t)(tid * 4 + i) * DIN + 3072;
#pragma unroll
        for (int j = 0; j < 8; ++j) g[j] += hv[i] * wr[j]; }
#pragma unroll
    for (int j = 0; j < 8; ++j) g[j] = block_sum256(g[j], red);
    if (tid < 8) { float v = g[0];
#pragma unroll
        for (int j = 1; j < 8; ++j) v = (tid == j) ? g[j] : v;
        v += b_if[tid];
        gates[(size_t)t * 8 + tid] = (tid < 4) ? v : logsigmoidf_(v); }
}
template <class Epi>
__global__ __launch_bounds__(256) void k_ngemm(const bf16* A, int lda, const float* W, int ldw, int N, int K, Epi epi) {
    __shared__ float As[16][68]; __shared__ float Ws[16][68];
    const int tid = threadIdx.x, tx = tid & 15, ty = tid >> 4;
    const int row0 = blockIdx.y * 64, col0 = blockIdx.x * 64;
    float acc[4][4];
#pragma unroll
    for (int i = 0; i < 4; ++i)
#pragma unroll
        for (int j = 0; j < 4; ++j) acc[i][j] = 0.f;
    const int ar = tid >> 2, ak = (tid & 3) * 4;
    const int wk = tid >> 4, wc = (tid & 15) * 4;
    for (int k0 = 0; k0 < K; k0 += 16) {
        const ushort4 av = *(const ushort4*)(A + (size_t)(row0 + ar) * lda + k0 + ak);
        As[ak + 0][ar] = bf2f(av.x); As[ak + 1][ar] = bf2f(av.y); As[ak + 2][ar] = bf2f(av.z); As[ak + 3][ar] = bf2f(av.w);
#pragma unroll
        for (int j = 0; j < 4; ++j) { const int cc = col0 + wc + j; Ws[wk][wc + j] = (cc < N) ? W[(size_t)(k0 + wk) * ldw + cc] : 0.f; }
        __syncthreads();
#pragma unroll
        for (int kk = 0; kk < 16; ++kk) {
            float av2[4], w[4];
#pragma unroll
            for (int i = 0; i < 4; ++i) av2[i] = As[kk][ty * 4 + i];
#pragma unroll
            for (int j = 0; j < 4; ++j) w[j] = Ws[kk][tx * 4 + j];
#pragma unroll
            for (int i = 0; i < 4; ++i)
#pragma unroll
                for (int j = 0; j < 4; ++j) acc[i][j] += av2[i] * w[j];
        }
        __syncthreads();
    }
#pragma unroll
    for (int i = 0; i < 4; ++i)
#pragma unroll
        for (int j = 0; j < 4; ++j) { const int cc = col0 + tx * 4 + j; if (cc < N) epi(row0 + ty * 4 + i, cc, acc[i][j]); }
}
struct NEpi1 {
    float* tmp; bf16 *zq, *zk, *zv, *zo, *zga, *zgb;
    DEV void operator()(int r, int c, float v) const {
        if (c < 1024) tmp[(size_t)r * 1024 + c] = v;
        else if (c < 1536) zq[(size_t)r * 512 + c - 1024] = f2bf(v);
        else if (c < 2048) zk[(size_t)r * 512 + c - 1536] = f2bf(v);
        else if (c < 2560) zv[(size_t)r * 512 + c - 2048] = f2bf(v);
        else if (c < 3072) zo[(size_t)r * 512 + c - 2560] = f2bf(sigmoidf_(v));
        else if (c < 3080) {}
        else if (c < 4104) zga[(size_t)r * 1024 + c - 3080] = f2bf(sigmoidf_(v));
        else zgb[(size_t)r * 1024 + c - 4104] = f2bf(sigmoidf_(v));
    }
};
struct NEpi2a { float* tmp; const bf16* zga; DEV void operator()(int r, int c, float v) const { tmp[(size_t)r * 1024 + c] = v * bf2f(zga[(size_t)r * 1024 + c]); } };
struct NEpi2b { const float* tmp; const bf16* zgb; bf16* merged; DEV void operator()(int r, int c, float v) const { merged[(size_t)r * 1024 + c] = f2bf(tmp[(size_t)r * 1024 + c] + v * bf2f(zgb[(size_t)r * 1024 + c])); } };
struct NEpi3 { const float* x; const float* mod; float* out; DEV void operator()(int r, int c, float v) const { const int b = r / SEQ; out[(size_t)r * 1024 + c] = x[(size_t)r * 1024 + c] + mod[b * 6144 + 2048 + c] * v; } };
__global__ __launch_bounds__(256) void k_glu(const float* tmp, bf16* zu) {
    const size_t i = (size_t)blockIdx.x * 256 + threadIdx.x; const size_t r = i / 512, c = i % 512;
    zu[i] = f2bf(tmp[r * 1024 + c] * sigmoidf_(tmp[r * 1024 + 512 + c]));
}
__global__ __launch_bounds__(256) void k_conva(const bf16* zu, const float* cw, const float* cb, const float* lg, const float* lb, bf16* uahm) {
    __shared__ float red[4];
    const int t = blockIdx.x, s = t % SEQ, tid = threadIdx.x;
    float v[2];
#pragma unroll
    for (int j = 0; j < 2; ++j) { const int c = tid + 256 * j; float a = cb[c];
        for (int k = 0; k < 31; ++k) { const int ss = s - 30 + k; if (ss >= 0) a += cw[k * 512 + c] * bf2f(zu[(size_t)(t - 30 + k) * 512 + c]); }
        v[j] = a; }
    const float mean = block_sum256(v[0] + v[1], red) * (1.f / 512.f);
    const float d0 = v[0] - mean, d1 = v[1] - mean;
    const float var = block_sum256(d0 * d0 + d1 * d1, red) * (1.f / 512.f);
    const float rstd = rsqrtf(var + LN_EPS);
#pragma unroll
    for (int j = 0; j < 2; ++j) { const int c = tid + 256 * j; const float y = (v[j] - mean) * rstd * lg[c] + lb[c]; uahm[(size_t)t * 1024 + c] = f2bf(siluf_(y)); }
}
__global__ __launch_bounds__(256) void k_qkconv(const bf16* zq, const bf16* zk, const float* w, const float* bq, bf16* qc, bf16* kc) {
    const int t = blockIdx.x, s = t % SEQ, tid = threadIdx.x;
#pragma unroll
    for (int j = 0; j < 4; ++j) { const int c = tid + 256 * j; const bf16* src = (c < 512) ? zq : zk; const int cc = c & 511; float a = bq[c];
#pragma unroll
        for (int k = 0; k < 4; ++k) { const int ss = s - 3 + k; if (ss >= 0) a += w[k * 1024 + c] * bf2f(src[(size_t)(t - 3 + k) * 512 + cc]); }
        ((c < 512) ? qc : kc)[(size_t)t * 512 + cc] = f2bf(siluf_(a)); }
}
__global__ __launch_bounds__(256) void k_mlstm_rec(const bf16* qc, const bf16* kc, const bf16* zv, const bf16* zo, const float* gates, const float* mng, bf16* uahm) {
    __shared__ float qs[128], ks[128], vs[128], part[2][128], red[8];
    const int b = blockIdx.x / NH, h = blockIdx.x % NH, tid = threadIdx.x, j = tid & 127, ih = tid >> 7;
    float C[64];
#pragma unroll
    for (int r = 0; r < 64; ++r) C[r] = 0.f;
    float nn = 0.f, m = 0.f;
    for (int s = 0; s < SEQ; ++s) {
        const size_t t = (size_t)b * SEQ + s;
        __syncthreads();
        if (tid < 128) { qs[tid] = bf2f(qc[t * 512 + h * 128 + tid]) * 0.08838834764831845f; ks[tid] = bf2f(kc[t * 512 + h * 128 + tid]); }
        else vs[tid - 128] = bf2f(zv[t * 512 + h * 128 + tid - 128]);
        const float li = gates[t * 8 + h], lf = gates[t * 8 + 4 + h];
        const float mn = fmaxf(lf + m, li), ip = __expf(li - mn), fp = __expf(lf + m - mn); m = mn;
        __syncthreads();
        const float vj = vs[j]; float p = 0.f;
#pragma unroll
        for (int r = 0; r < 64; ++r) { const int i = ih * 64 + r; C[r] = fp * C[r] + ip * ks[i] * vj; p += qs[i] * C[r]; }
        part[ih][j] = p;
        float dn = 0.f;
        if (tid < 128) { nn = fp * nn + ip * ks[tid]; dn = qs[tid] * nn; }
#pragma unroll
        for (int o = 32; o >= 1; o >>= 1) dn += __shfl_xor(dn, o);
        if ((tid & 63) == 0) red[tid >> 6] = dn;
        __syncthreads();
        float hv = 0.f, sm = 0.f;
        if (tid < 128) { const float den = red[0] + red[1]; hv = (part[0][tid] + part[1][tid]) / fmaxf(fabsf(den), __expf(-mn)); sm = hv; }
#pragma unroll
        for (int o = 32; o >= 1; o >>= 1) sm += __shfl_xor(sm, o);
        if ((tid & 63) == 0) red[4 + (tid >> 6)] = sm;
        __syncthreads();
        const float mu = (red[4] + red[5]) * (1.f / 128.f);
        float dv = (tid < 128) ? (hv - mu) : 0.f; float sq = dv * dv;
#pragma unroll
        for (int o = 32; o >= 1; o >>= 1) sq += __shfl_xor(sq, o);
        __syncthreads();
        if ((tid & 63) == 0) red[tid >> 6] = sq;
        __syncthreads();
        if (tid < 128) { const float var = (red[0] + red[1]) * (1.f / 128.f); const float y = dv * rsqrtf(var + LN_EPS) * mng[h * 128 + tid] * bf2f(zo[t * 512 + h * 128 + tid]);
            uahm[t * 1024 + 512 + h * 128 + tid] = f2bf(y); }
    }
}
__global__ __launch_bounds__(256) void k_h2route(const float* x1, const float* g2, const float* mod, const float* w_rg, const float* b_rg, const float* w_re, const float* b_re, bf16* h2, int* toke, float* tokw) {
    __shared__ float red[4]; __shared__ float lg[36];
    const int t = blockIdx.x, b = t / SEQ, tid = threadIdx.x;
    const float4 xv = ((const float4*)(x1 + (size_t)t * D))[tid];
    float ss = xv.x * xv.x + xv.y * xv.y + xv.z * xv.z + xv.w * xv.w;
    ss = block_sum256(ss, red);
    const float rstd = rsqrtf(ss * (1.f / D) + RMS_EPS);
    const float* sh = mod + b * 6144 + 3072, *sc = mod + b * 6144 + 4096;
    float hv[4]; const float xs[4] = {xv.x, xv.y, xv.z, xv.w};
#pragma unroll
    for (int j = 0; j < 4; ++j) { const int k = tid * 4 + j; hv[j] = xs[j] * rstd * g2[k] * (1.f + sc[k]) + sh[k]; }
    ushort4 o; o.x = f2bf(hv[0]); o.y = f2bf(hv[1]); o.z = f2bf(hv[2]); o.w = f2bf(hv[3]);
    ((ushort4*)(h2 + (size_t)t * D))[tid] = o;
    for (int j = 0; j < 36; ++j) {
        float a = 0.f;
#pragma unroll
        for (int i = 0; i < 4; ++i) { const int k = tid * 4 + i; a += hv[i] * ((j < 4) ? w_rg[k * 4 + j] : w_re[k * 32 + j - 4]); }
        a = block_sum256(a, red);
        if (tid == 0) lg[j] = a + ((j < 4) ? b_rg[j] : b_re[j - 4]);
    }
    __syncthreads();
    if (tid == 0) {
        int gs = 0; float gm = lg[0];
        for (int j = 1; j < 4; ++j) if (lg[j] > gm) { gm = lg[j]; gs = j; }
        float se = 0.f; for (int j = 0; j < 4; ++j) se += __expf(lg[j] - gm);
        const float pg = 1.f / se;
        const float* le = lg + 4 + gs * 8;
        int e0 = 0; float l0 = le[0];
        for (int j = 1; j < 8; ++j) if (le[j] > l0) { l0 = le[j]; e0 = j; }
        int e1 = -1; float l1 = -3.0e38f;
        for (int j = 0; j < 8; ++j) if (j != e0 && le[j] > l1) { l1 = le[j]; e1 = j; }
        const float r = __expf(l1 - l0);
        const float w0 = pg / (1.f + r), w1 = pg * r / (1.f + r);
        toke[t * 2] = gs * 8 + e0; toke[t * 2 + 1] = gs * 8 + e1; tokw[t * 2] = w0; tokw[t * 2 + 1] = w1;
    }
}
__global__ __launch_bounds__(256) void k_lists(const int* toke, const float* tokw, unsigned* cnt, int* listt, float* listw) {
    const int i = blockIdx.x * 256 + threadIdx.x; const int e = toke[i]; const unsigned pos = atomicAdd(cnt + 16 * e, 1u);
    listt[e * 16384 + pos] = i; listw[e * 16384 + pos] = tokw[i];
}
__global__ __launch_bounds__(256) void k_moe(const bf16* h2, const int* toke, const float* tokw, const float* wg, const float* wu, const float* wd, bf16* ys) {
    __shared__ float hs[1024]; __shared__ float hid[512];
    const int a = blockIdx.x, t = a >> 1, tid = threadIdx.x;
    const int e = toke[a]; const float w = tokw[a];
    for (int k = tid; k < 1024; k += 256) hs[k] = bf2f(h2[(size_t)t * 1024 + k]);
    __syncthreads();
    const float* Gp = wg + (size_t)e * 1024 * 512, *U = wu + (size_t)e * 1024 * 512, *Dn = wd + (size_t)e * 512 * 1024;
    float g0 = 0.f, g1 = 0.f, u0 = 0.f, u1 = 0.f;
    for (int k = 0; k < 1024; ++k) { const float hk = hs[k]; g0 += hk * Gp[(size_t)k * 512 + tid]; g1 += hk * Gp[(size_t)k * 512 + 256 + tid]; u0 += hk * U[(size_t)k * 512 + tid]; u1 += hk * U[(size_t)k * 512 + 256 + tid]; }
    hid[tid] = siluf_(g0) * u0; hid[tid + 256] = siluf_(g1) * u1;
    __syncthreads();
    float y[4] = {0.f, 0.f, 0.f, 0.f};
    for (int j = 0; j < 512; ++j) { const float hj = hid[j];
#pragma unroll
        for (int i = 0; i < 4; ++i) y[i] += hj * Dn[(size_t)j * 1024 + tid + 256 * i]; }
#pragma unroll
    for (int i = 0; i < 4; ++i) ys[(size_t)a * 1024 + tid + 256 * i] = f2bf(w * y[i]);
}
__global__ __launch_bounds__(256) void k_final(const float* x1, const bf16* ys, const float* mod, const float* gf, float* out) {
    __shared__ float red[4];
    const int t = blockIdx.x, b = t / SEQ, tid = threadIdx.x;
    const float4 xv = ((const float4*)(x1 + (size_t)t * D))[tid];
    const ushort4 y0 = ((const ushort4*)(ys + (size_t)t * 2048))[tid], y1 = ((const ushort4*)(ys + (size_t)t * 2048 + 1024))[tid];
    const float* gt = mod + b * 6144 + 5120 + tid * 4;
    float v[4];
    v[0] = xv.x + gt[0] * (bf2f(y0.x) + bf2f(y1.x)); v[1] = xv.y + gt[1] * (bf2f(y0.y) + bf2f(y1.y));
    v[2] = xv.z + gt[2] * (bf2f(y0.z) + bf2f(y1.z)); v[3] = xv.w + gt[3] * (bf2f(y0.w) + bf2f(y1.w));
    float ss = v[0] * v[0] + v[1] * v[1] + v[2] * v[2] + v[3] * v[3];
    ss = block_sum256(ss, red);
    const float rstd = rsqrtf(ss * (1.f / D) + RMS_EPS);
    float4 o; o.x = v[0] * rstd * gf[tid * 4]; o.y = v[1] * rstd * gf[tid * 4 + 1]; o.z = v[2] * rstd * gf[tid * 4 + 2]; o.w = v[3] * rstd * gf[tid * 4 + 3];
    ((float4*)(out + (size_t)t * D))[tid] = o;
}
#endif


#ifndef DBG_BENCH
#define DBG_BENCH 0
#endif
#if DBG_BENCH
__global__ void __launch_bounds__(512, 2) k_bench_a(const float* x, float* dummy) {
    extern __shared__ __attribute__((aligned(16))) unsigned char lds_b[];
    const int tid = threadIdx.x, lane = tid & 63, wave = tid >> 6, tile = blockIdx.x;
    f32x4 nx[4][4]; float acc = 0.f;
#pragma unroll
    for (int p = 0; p < 4; ++p)
#pragma unroll
        for (int j = 0; j < 4; ++j) nx[p][j] = *(const f32x4*)(x + ((size_t)tile * 64 + wave + 8 * p) * 1024 + 256 * j + 4 * lane);
#pragma unroll
    for (int r8 = 0; r8 < 8; ++r8) {
        const size_t row = (size_t)tile * 64 + wave + 8 * r8;
#pragma unroll
        for (int j = 0; j < 4; ++j) acc += (nx[r8 & 3][j][0] + nx[r8 & 3][j][1]) + (nx[r8 & 3][j][2] + nx[r8 & 3][j][3]);
        if (r8 + 4 < 8) {
#pragma unroll
            for (int j = 0; j < 4; ++j) nx[r8 & 3][j] = *(const f32x4*)(x + (row + 32) * 1024 + 256 * j + 4 * lane); }
    }
    if (acc == 123.456f) dummy[tid] = acc;
}
__global__ void __launch_bounds__(256) k_bench_b(const float* x, float* dummy) {
    const int tid = threadIdx.x, lane = tid & 63, wave = tid >> 6; const size_t row = (size_t)blockIdx.x * 4 + wave; float acc = 0.f;
#pragma unroll
    for (int j = 0; j < 4; ++j) { const f32x4 v = *(const f32x4*)(x + row * 1024 + 256 * j + 4 * lane); acc += (v[0] + v[1]) + (v[2] + v[3]); }
    if (acc == 123.456f) dummy[tid] = acc;
}
#endif
#if MK_ONE
constexpr int NKERN = 1;
static const void* const mk_kernels[NKERN] = {(const void*)mk_fwd<0, NPHASE>};
#else
constexpr int NKERN = NPHASE;
static const void* const mk_kernels[NKERN] = {(const void*)mk_fwd<0, 1>, (const void*)mk_fwd<1, 2>, (const void*)mk_fwd<2, 3>, (const void*)mk_fwd<3, 4>, (const void*)mk_fwd<4, 5>, (const void*)mk_fwd<5, 6>,
    (const void*)mk_fwd<6, 7>, (const void*)mk_fwd<7, 8>, (const void*)mk_fwd<8, 9>, (const void*)mk_fwd<9, 10>, (const void*)mk_fwd<10, 11>};
#endif
extern "C" void kernel_launch(void* const* d_in, const int* in_sizes, int n_in, void* d_out, int out_size, void* d_ws, size_t ws_size, hipStream_t stream) {
    static int grid = 0;
    if (grid == 0) {
        int dev = 0, cus = 0;
        if (hipGetDevice(&dev) != hipSuccess || hipDeviceGetAttribute(&cus, hipDeviceAttributeMultiprocessorCount, dev) != hipSuccess) { grid = -1; return; }
        for (int k = 0; k < NKERN; ++k) if (hipFuncSetAttribute(mk_kernels[k], hipFuncAttributeMaxDynamicSharedMemorySize, LDS_BYTES) != hipSuccess) { grid = -1; return; }
        int per_cu = 0;
        (void)hipOccupancyMaxActiveBlocksPerMultiprocessor(&per_cu, mk_kernels[0], NTHREADS, LDS_BYTES);
        (void)hipGetLastError();
        grid = (per_cu >= 1) ? cus : -1;
    }
    if (grid < 0) return;
    (void)hipMemsetAsync((char*)d_ws + WS_CTL, 0, CTL_ZERO_BYTES, stream);
    Args a{};
    for (int i = 0; i < 26; ++i) a.in[i] = (const float*)d_in[i];
    a.out = (float*)d_out; a.ws = (unsigned char*)d_ws;
#if MK_ONE
    a.ph_lo = 0; a.ph_hi = NPHASE;
    { void* args[] = {&a}; (void)hipLaunchKernel(mk_kernels[0], dim3(grid), dim3(NTHREADS), args, LDS_BYTES, stream); }
#else
    unsigned char* ws = (unsigned char*)d_ws; float* out = (float*)d_out;
    float* mod = (float*)(ws + WS_MOD); float* gates = (float*)(ws + WS_GATES); int* toke = (int*)(ws + WS_TOKE); float* tokw = (float*)(ws + WS_TOKW);
    bf16* hb = (bf16*)(ws + WS_H); bf16* zu = (bf16*)(ws + WS_ZU); bf16* zq = (bf16*)(ws + WS_ZQ); bf16* zk = (bf16*)(ws + WS_ZK); bf16* zv = (bf16*)(ws + WS_ZV); bf16* zo = (bf16*)(ws + WS_ZO);
    bf16* zga = (bf16*)(ws + WS_ZGA); bf16* zgb = (bf16*)(ws + WS_ZGB); bf16* qc = (bf16*)(ws + WS_QC); bf16* kc = (bf16*)(ws + WS_KC); bf16* uahm = (bf16*)(ws + WS_UAHM);
    bf16* merged = (bf16*)(ws + WS_MERGED); bf16* ys = (bf16*)(ws + WS_YS);
    (void)mod; (void)gates; (void)toke; (void)tokw; (void)hb; (void)zu; (void)zq; (void)zk; (void)zv; (void)zo; (void)zga; (void)zgb; (void)qc; (void)kc; (void)uahm; (void)merged; (void)ys; (void)out;
#ifndef DBG_NPH
#define DBG_NPH NPHASE
#endif
#if DBG_BENCH == 1
    { static bool once = false; if (!once) { (void)hipFuncSetAttribute((const void*)k_bench_a, hipFuncAttributeMaxDynamicSharedMemorySize, LDS_BYTES); once = true; }
      for (int rep = 0; rep < 4; ++rep) hipLaunchKernelGGL(k_bench_a, dim3(256), dim3(512), LDS_BYTES, stream, (const float*)d_in[0], (float*)((char*)d_ws + WS_TOKE)); }
#elif DBG_BENCH == 2
    for (int rep = 0; rep < 4; ++rep) hipLaunchKernelGGL(k_bench_b, dim3(4096), dim3(256), 0, stream, (const float*)d_in[0], (float*)((char*)d_ws + WS_TOKE));
#endif
    for (int ph = 0; ph < DBG_NPH; ++ph) {
        a.ph_lo = ph; a.ph_hi = ph + 1; a.flags = 0;
        bool mk = true;
#if NAIVE_MASK
        const float* const* I = (const float* const*)d_in;
        if ((NAIVE_MASK >> ph) & 1) {
            mk = false;
            switch (ph) {
            case 0: k_mod<<<8 * 6144 / 256, 256, 0, stream>>>(I[1], I[2], I[3], mod); mk = true; break;
            case 1: k_h1<<<T, 256, 0, stream>>>(I[0], I[4], mod, I[5], I[6], hb, gates); break;
            case 2: k_ngemm<NEpi1><<<dim3((DIN + 63) / 64, T / 64), 256, 0, stream>>>(hb, 1024, I[5], DIN, DIN, 1024, NEpi1{out, zq, zk, zv, zo, zga, zgb});
                    k_glu<<<T * 512 / 256, 256, 0, stream>>>(out, zu); a.flags = (DBG_CLS) << 8; mk = (DBG_CLS) != 0;
                    k_fixw1t<<<2048 * 1024 / 256, 256, 0, stream>>>(I[5], (bf16*)(ws + WS_W1T)); break;
            case 3: k_conva<<<T, 256, 0, stream>>>(zu, I[7], I[8], I[9], I[10], uahm); mk = ((NAIVE_MASK >> 4) & 1) ? false : true; break;
            case 4: k_qkconv<<<T, 256, 0, stream>>>(zq, zk, I[12], I[13], qc, kc);
                    k_mlstm_rec<<<BATCH * NH, 256, 0, stream>>>(qc, kc, zv, zo, gates, I[14], uahm); break;
            case 5: k_ngemm<NEpi2a><<<dim3(16, T / 64), 256, 0, stream>>>(uahm, 1024, I[11], 1024, 1024, 512, NEpi2a{out, zga});
                    k_ngemm<NEpi2b><<<dim3(16, T / 64), 256, 0, stream>>>(uahm + 512, 1024, I[15], 1024, 1024, 512, NEpi2b{out, zgb, merged}); break;
            case 6: k_ngemm<NEpi3><<<dim3(16, T / 64), 256, 0, stream>>>(merged, 1024, I[16], 1024, 1024, 1024, NEpi3{I[0], mod, out}); break;
            case 7: k_h2route<<<T, 256, 0, stream>>>(out, I[17], mod, I[18], I[19], I[20], I[21], hb, toke, tokw);
                    k_lists<<<T * 2 / 256, 256, 0, stream>>>(toke, tokw, (unsigned*)(ws + WS_CTL) + CW_CNT, (int*)(ws + WS_LISTT), (float*)(ws + WS_LISTW));
                    a.flags = 1; mk = true; break;
            case 8: break;
            case 9: k_moe<<<T * 2, 256, 0, stream>>>(hb, toke, tokw, I[22], I[23], I[24], (bf16*)(ws + WS_ZU)); break;
            case 10: k_final<<<T, 256, 0, stream>>>(out, (const bf16*)(ws + WS_ZU), mod, I[25], out); break;
            }
        }
#endif
        if (mk) { void* args[] = {&a}; (void)hipLaunchKernel(mk_kernels[ph], dim3(grid), dim3(NTHREADS), args, LDS_BYTES, stream);
            if ((DBG_HREP >> ph) & 1) { if (ph == 7) a.flags |= DBG_F7; if (ph == 1) a.flags |= DBG_F1; (void)hipLaunchKernel(mk_kernels[ph], dim3(grid), dim3(NTHREADS), args, LDS_BYTES, stream); } }
    }
#endif
}
```

```cpp
#include <hip/hip_runtime.h>
#include <stdint.h>
#include <cstdio>

#ifndef MK_ONE
#define MK_ONE 1
#endif
#ifndef NAIVE_MASK
#define NAIVE_MASK 0
#endif
#ifndef DBG_NPH
#define DBG_NPH 11
#endif
#ifndef DBG_F1
#define DBG_F1 (256+512)
#endif
#ifndef DBG_F7
#define DBG_F7 6
#endif
#ifndef DBG_HREP
#define DBG_HREP 0
#endif
#ifndef DBG_REP
#define DBG_REP 0
#endif
#if DBG_REP
#define REPK(k) for (int _r = 0; _r < 1 + ((DBG_REP >> (k)) & 1); ++_r)
#define REPSYNC() __syncthreads()
#else
#define REPK(k)
#define REPSYNC() do {} while (0)
#endif
#ifndef DBG_CLS
#define DBG_CLS 0
#endif
#ifndef DBG_GATEFIRST
#define DBG_GATEFIRST 0
#endif

typedef unsigned short bf16;
#define DEV __device__ __forceinline__
#define LAS __attribute__((address_space(3)))
typedef short bf16x8 __attribute__((ext_vector_type(8)));
typedef float f32x4 __attribute__((ext_vector_type(4)));
typedef unsigned v4u __attribute__((ext_vector_type(4)));
typedef unsigned v2u __attribute__((ext_vector_type(2)));

constexpr int BATCH = 8, SEQ = 2048, D = 1024, T = BATCH * SEQ;
constexpr int DIN = 5128, NH = 4;
constexpr float RMS_EPS = 1e-6f, LN_EPS = 1e-5f;
constexpr int NWAVES = 8, NTHREADS = 512;

DEV float bf2f(bf16 v) { return __uint_as_float(((unsigned)v) << 16); }
DEV float bflo(unsigned w) { return __uint_as_float(w << 16); }
DEV float bfhi(unsigned w) { return __uint_as_float(w & 0xffff0000u); }
DEV unsigned f2bfu(float f) { unsigned u = __float_as_uint(f); return (u + 0x7fffu + ((u >> 16) & 1u)) >> 16; }
DEV unsigned pk2(float lo, float hi);
DEV bf16 f2bf(float f) { return (bf16)(pk2(f, f) & 0xffffu); }
DEV unsigned pk2(float lo, float hi) { unsigned r; asm volatile("v_cvt_pk_bf16_f32 %0, %1, %2" : "=v"(r) : "v"(lo), "v"(hi)); return r; }
DEV float sigmoidf_(float x) { return __builtin_amdgcn_rcpf(1.f + __expf(-x)); }
DEV float siluf_(float x) { return x * __builtin_amdgcn_rcpf(1.f + __expf(-x)); }
DEV float logsigmoidf_(float x) { return fminf(x, 0.f) - log1pf(__expf(-fabsf(x))); }
template <int CTRL> DEV float dpp0(float v) { return __int_as_float(__builtin_amdgcn_update_dpp(0, __float_as_int(v), CTRL, 0xf, 0xf, true)); }
template <int CTRL> DEV float dppk(float v) { return __int_as_float(__builtin_amdgcn_update_dpp(__float_as_int(v), __float_as_int(v), CTRL, 0xf, 0xf, false)); }
DEV float rdlane(float v, int l) { return __int_as_float(__builtin_amdgcn_readlane(__float_as_int(v), l)); }
DEV float row16_sum(float v) {
    v += dpp0<0xB1>(v); v += dpp0<0x4E>(v); v += dpp0<0x141>(v); v += dpp0<0x140>(v); return v; }
DEV float wave_sum(float v) { v = row16_sum(v); return (rdlane(v, 0) + rdlane(v, 16)) + (rdlane(v, 32) + rdlane(v, 48)); }
DEV float wave_scan_add(float v, int lane) {
    v += dpp0<0x111>(v); v += dpp0<0x112>(v); v += dpp0<0x114>(v); v += dpp0<0x118>(v);
    const float r0 = rdlane(v, 15), r1 = rdlane(v, 31), r2 = rdlane(v, 47);
    return v + ((lane >= 48) ? (r0 + r1) + r2 : (lane >= 32) ? (r0 + r1) : (lane >= 16) ? r0 : 0.f); }
DEV float wave_scan_max(float v, int lane) {
    v = fmaxf(v, dppk<0x111>(v)); v = fmaxf(v, dppk<0x112>(v)); v = fmaxf(v, dppk<0x114>(v)); v = fmaxf(v, dppk<0x118>(v));
    const float r0 = rdlane(v, 15), r1 = rdlane(v, 31), r2 = rdlane(v, 47);
    const float p = (lane >= 48) ? fmaxf(fmaxf(r0, r1), r2) : (lane >= 32) ? fmaxf(r0, r1) : (lane >= 16) ? r0 : -3.0e38f;
    return fmaxf(v, p); }
#define LDS_WAIT() asm volatile("s_waitcnt lgkmcnt(0)" ::: "memory")

constexpr size_t MiB = 1u << 20;
constexpr size_t WS_CTL = 0, CTL_ZERO_BYTES = 65536;
constexpr size_t WS_MOD = 1 * MiB;
constexpr size_t WS_GATES = 1 * MiB + 256 * 1024;
constexpr size_t WS_STSC = 1 * MiB + 768 * 1024;
constexpr size_t WS_RBIAS = 1 * MiB + 800 * 1024;
constexpr size_t WS_WIF = 1 * MiB + 832 * 1024;
constexpr size_t WS_RW = 6 * MiB + 256 * 1024;
constexpr size_t WS_TOKE = 6 * MiB;
constexpr size_t WS_TOKW = 6 * MiB + 128 * 1024;
constexpr size_t WS_LISTT = 2 * MiB;
constexpr size_t WS_LISTW = 4 * MiB;
constexpr size_t WS_W1T = 8 * MiB;
constexpr size_t WS_W2T = 18 * MiB;
constexpr size_t WS_W3T = 20 * MiB;
constexpr size_t WS_STATE = 22 * MiB;
constexpr size_t WS_H = 40 * MiB;
constexpr size_t WS_ZU = 72 * MiB, WS_ZQ = 88 * MiB, WS_ZK = 104 * MiB, WS_ZV = 120 * MiB, WS_ZO = 136 * MiB;
constexpr size_t WS_ZGA = 152 * MiB, WS_ZGB = 184 * MiB;
constexpr size_t WS_UAHM = 216 * MiB;
constexpr size_t WS_MERGED = WS_ZQ;
constexpr size_t WS_WGU = 120 * MiB;
constexpr size_t WS_WD = 184 * MiB;
constexpr size_t WS_ACT = 216 * MiB;
constexpr size_t WS_YS = 40 * MiB;
constexpr size_t WS_QC = WS_H, WS_KC = WS_H + 16 * MiB;
constexpr int CW_BAR = 4096, CW_CNT = 8192, CW_MODCNT = 9216;

constexpr int LDS_TAB = 131072;
constexpr int LDS_MISC = 147456;
constexpr int LDS_BYTES = 151552;

struct Args { const float* in[26]; float* out; unsigned char* ws; int ph_lo, ph_hi, flags, pad; };

namespace pg8 {
constexpr int BM = 256, BK = 64, HALF = 128, HTB = HALF * BK * 2, NXCD = 8, WGM = 8;
DEV int lds_byte(int r, int c) { const int st = (r >> 4) * 2 + (c >> 5), rr = r & 15, cc = c & 31, ob = rr * 64 + cc * 2; return st * 1024 + (ob ^ (((ob >> 9) & 1) << 5)); }
DEV void stage_rc(int b, int& R, int& C) { const int st = b / 1024, sb = b % 1024, swz = sb ^ (((sb >> 9) & 1) << 5); R = (st >> 1) * 16 + swz / 64; C = (st & 1) * 32 + (swz % 64) / 2; }
DEV int perm32(int rho) { const int n = rho >> 4, i = rho & 15; return 8 * (i >> 2) + 4 * n + (i & 3); }
DEV unsigned cvt_pk_bf16(float lo, float hi) { unsigned r; asm volatile("v_cvt_pk_bf16_f32 %0, %1, %2" : "=v"(r) : "v"(lo), "v"(hi)); return r; }

struct Unit { int pm, pn; unsigned ak, bk; int slot, valid, arow0; };

struct StaticOrder {
    int nM, nN, nwg, G, c;
    DEV void init(int M, int N, int G_, int c_) { nM = M / BM; nN = N / BM; nwg = nM * nN; G = G_; c = c_; }
    DEV bool tile(int L, int& pm, int& pn) const {
        if (L >= nwg) return false;
        int wgid = L; { const int q = nwg / NXCD, r = nwg % NXCD, xcd = wgid % NXCD, off = wgid / NXCD; wgid = (xcd < r ? xcd * (q + 1) : r * (q + 1) + (xcd - r) * q) + off; }
        const int nig = WGM * nN, gid = wgid / nig, fm = gid * WGM, gsz = (nM - fm) < WGM ? (nM - fm) : WGM;
        pm = fm + ((wgid % nig) % gsz); pn = (wgid % nig) / gsz; return true;
    }
    DEV bool next(int i, Unit& u) const { u.ak = 0; u.bk = 0; u.slot = 0; u.valid = 256; u.arow0 = 0; return tile(i * G + c, u.pm, u.pn); }
};

template <class Prob, class Epi, class Sched, bool ALIGN_EPI, bool SKIP = false>
DEV void gemm_phase(LAS unsigned char* lds, const Prob& P, const Sched& S, const Epi& E, const int K) {
    int tid = threadIdx.x; asm volatile("" : "+v"(tid));
    const int wid = __builtin_amdgcn_readfirstlane(tid >> 6), lane = tid & 63, wr = wid >> 2, wc = wid & 3, fr = lane & 15, fq = lane >> 4;
    const int nt = K / BK;
    int R[2], C[2], Rb[2];
#pragma unroll
    for (int i = 0; i < 2; ++i) { stage_rc(tid * 16 + i * 8192, R[i], C[i]); Rb[i] = Epi::PERM ? ((R[i] & ~31) + perm32(R[i] & 31)) : R[i]; }
    const unsigned kstep = BK * 2;
    const unsigned ldsw = (unsigned)wid * 1024u;
    const int aoff = lds_byte(wr * 64 + fr, fq * 8), boff = lds_byte(wc * 32 + fr, fq * 8);
    const char* const Abase = (const char*)P.A; const char* const Bbase = (const char*)P.B;
#define PG8_SA(b, h) (((b) * 2 + (h)) * HTB)
#define PG8_SB(b, h) ((4 + (b) * 2 + (h)) * HTB)
#define PG8_STAGE(bufoff, base, offs, kb) do { _Pragma("unroll") for (int _i = 0; _i < 2; ++_i) \
        __builtin_amdgcn_global_load_lds((const unsigned*)((base) + (size_t)((offs)[_i] + (kb))), (LAS unsigned*)(lds + (bufoff) + ldsw + _i * 8192), 16, 0, 0); } while (0)
#define PG8_LDA(dst, b, h) do { _Pragma("unroll") for (int m = 0; m < 4; ++m) _Pragma("unroll") for (int k = 0; k < 2; ++k) dst[m][k] = *(const LAS bf16x8*)(lds + PG8_SA(b, h) + aoff + m * 2048 + k * 1024); } while (0)
#define PG8_LDB(dst, b, h) do { _Pragma("unroll") for (int n = 0; n < 2; ++n) _Pragma("unroll") for (int k = 0; k < 2; ++k) dst[n][k] = *(const LAS bf16x8*)(lds + PG8_SB(b, h) + boff + n * 2048 + k * 1024); } while (0)
#define PG8_MMA(ai, bj, At, Bt) do { __builtin_amdgcn_s_setprio(1); _Pragma("unroll") for (int m = 0; m < 4; ++m) _Pragma("unroll") for (int n = 0; n < 2; ++n) _Pragma("unroll") for (int k = 0; k < 2; ++k) \
        acc[ai][bj][m][n] = __builtin_amdgcn_mfma_f32_16x16x32_bf16(Bt[n][k], At[m][k], acc[ai][bj][m][n], 0, 0, 0); __builtin_amdgcn_s_setprio(0); } while (0)
#define PG8_WAIT_V(n) asm volatile("s_waitcnt vmcnt(" #n ")" ::: "memory")
#define PG8_WAIT_L(n) asm volatile("s_waitcnt lgkmcnt(" #n ")" ::: "memory")
#define PG8_BAR __builtin_amdgcn_s_barrier()
#define PG8_SCHED __builtin_amdgcn_sched_barrier(0)
    Unit cur, nxt; int ui = 0;
    if (!S.next(0, cur)) return;
    f32x4 acc[2][2][4][2];
#pragma unroll
    for (int a = 0; a < 2; ++a)
#pragma unroll
        for (int b = 0; b < 2; ++b)
#pragma unroll
            for (int m = 0; m < 4; ++m)
#pragma unroll
                for (int n = 0; n < 2; ++n) acc[a][b][m][n] = (f32x4){0.f, 0.f, 0.f, 0.f};
    bf16x8 At[4][2], B0[2][2], B1[2][2];
    unsigned ca[2][2], cb[2][2], na[2][2], nb[2][2];
    P.aoffs(cur, R, C, ca); P.boffs(cur, Rb, C, cb);
    PG8_STAGE(PG8_SB(0, 0), Bbase, cb[0], 0u); PG8_STAGE(PG8_SB(0, 1), Bbase, cb[1], 0u); PG8_STAGE(PG8_SA(0, 0), Abase, ca[0], 0u); PG8_STAGE(PG8_SA(0, 1), Abase, ca[1], 0u);
    if (wr == 1) PG8_BAR;
    PG8_WAIT_V(2); PG8_BAR;
    PG8_STAGE(PG8_SB(1, 0), Bbase, cb[0], kstep); PG8_STAGE(PG8_SA(1, 0), Abase, ca[0], kstep); PG8_STAGE(PG8_SB(1, 1), Bbase, cb[1], kstep);
    PG8_WAIT_V(6); PG8_BAR;
    for (;;) {
        const bool has_next = S.next(ui + 1, nxt);
        if (has_next) { P.aoffs(nxt, R, C, na); P.boffs(nxt, Rb, C, nb); }
        else {
#pragma unroll
            for (int h = 0; h < 2; ++h)
#pragma unroll
                for (int i = 0; i < 2; ++i) { na[h][i] = ca[h][i]; nb[h][i] = cb[h][i]; } }
        const bool do0 = !(SKIP && cur.valid <= 64 && wr == 1), do1 = !(SKIP && cur.valid <= 128) && do0;
        for (int t = 0; t < nt; t += 2) {
            const bool last = (t == nt - 2);
            const unsigned k1 = (unsigned)(t + 1) * kstep;
            const unsigned kb2 = last ? 0u : (unsigned)(t + 2) * kstep, kb3 = kb2 + kstep;
            unsigned a2[2][2], b2[2][2];
#pragma unroll
            for (int h = 0; h < 2; ++h)
#pragma unroll
                for (int i = 0; i < 2; ++i) { a2[h][i] = last ? na[h][i] : ca[h][i]; b2[h][i] = last ? nb[h][i] : cb[h][i]; }
            PG8_LDB(B0, 0, 0); PG8_LDB(B1, 0, 1); PG8_SCHED; PG8_LDA(At, 0, 0); PG8_STAGE(PG8_SA(1, 1), Abase, ca[1], k1);
            PG8_WAIT_V(8); PG8_WAIT_L(0); PG8_BAR; if (do0) { PG8_MMA(0, 0, At, B0); PG8_MMA(0, 1, At, B1); } PG8_BAR; PG8_SCHED;
            PG8_LDA(At, 0, 1); PG8_STAGE(PG8_SB(0, 0), Bbase, b2[0], kb2); PG8_STAGE(PG8_SB(0, 1), Bbase, b2[1], kb2); PG8_STAGE(PG8_SA(0, 0), Abase, a2[0], kb2);
            PG8_WAIT_V(8); PG8_WAIT_L(0); PG8_BAR; if (do1) { PG8_MMA(1, 0, At, B0); PG8_MMA(1, 1, At, B1); } PG8_BAR; PG8_SCHED;
            PG8_LDB(B0, 1, 0); PG8_LDB(B1, 1, 1); PG8_SCHED; PG8_LDA(At, 1, 0); PG8_STAGE(PG8_SA(0, 1), Abase, a2[1], kb2);
            PG8_WAIT_V(8); PG8_WAIT_L(0); PG8_BAR; if (do0) { PG8_MMA(0, 0, At, B0); PG8_MMA(0, 1, At, B1); } PG8_BAR; PG8_SCHED;
            PG8_LDA(At, 1, 1); PG8_STAGE(PG8_SB(1, 0), Bbase, b2[0], kb3); PG8_STAGE(PG8_SB(1, 1), Bbase, b2[1], kb3); PG8_STAGE(PG8_SA(1, 0), Abase, a2[0], kb3);
            PG8_WAIT_V(8); PG8_WAIT_L(0); PG8_BAR; if (do1) { PG8_MMA(1, 0, At, B0); PG8_MMA(1, 1, At, B1); } PG8_BAR; PG8_SCHED;
        }
        if constexpr (ALIGN_EPI) { if (wr == 0) PG8_BAR; }
        E(acc, cur, wr, wc, fr, fq);
        if (!has_next) break;
        if (!E.keep(cur)) {
#pragma unroll
            for (int a = 0; a < 2; ++a)
#pragma unroll
                for (int b = 0; b < 2; ++b)
#pragma unroll
                    for (int m = 0; m < 4; ++m)
#pragma unroll
                        for (int n = 0; n < 2; ++n) acc[a][b][m][n] = (f32x4){0.f, 0.f, 0.f, 0.f};
        }
        cur = nxt; ++ui;
#pragma unroll
        for (int h = 0; h < 2; ++h)
#pragma unroll
            for (int i = 0; i < 2; ++i) { ca[h][i] = na[h][i]; cb[h][i] = nb[h][i]; }
        if constexpr (ALIGN_EPI) { if (wr == 1) PG8_BAR; }
    }
    PG8_WAIT_V(0);
    if constexpr (!ALIGN_EPI) { if (wr == 0) PG8_BAR; }
    PG8_BAR;
#undef PG8_SA
#undef PG8_SB
#undef PG8_STAGE
#undef PG8_LDA
#undef PG8_LDB
#undef PG8_MMA
#undef PG8_WAIT_V
#undef PG8_WAIT_L
#undef PG8_BAR
#undef PG8_SCHED
}
}
using pg8::Unit;

struct ProbPlain {
    const bf16* A; const bf16* B; unsigned lda2, ldb2;
    DEV void aoffs(const Unit& u, const int (&R)[2], const int (&C)[2], unsigned (&o)[2][2]) const {
#pragma unroll
        for (int h = 0; h < 2; ++h)
#pragma unroll
            for (int i = 0; i < 2; ++i) o[h][i] = (unsigned)(u.pm * 256 + 128 * h + R[i]) * lda2 + (unsigned)C[i] * 2u + u.ak; }
    DEV void boffs(const Unit& u, const int (&Rb)[2], const int (&C)[2], unsigned (&o)[2][2]) const {
#pragma unroll
        for (int h = 0; h < 2; ++h)
#pragma unroll
            for (int i = 0; i < 2; ++i) o[h][i] = (unsigned)(u.pn * 256 + 128 * h + Rb[i]) * ldb2 + (unsigned)C[i] * 2u + u.bk; }
};
struct ProbMoeUp {
    const bf16* A; const bf16* B; const LAS unsigned* rowtab;
    DEV void aoffs(const Unit& u, const int (&R)[2], const int (&C)[2], unsigned (&o)[2][2]) const {
#pragma unroll
        for (int h = 0; h < 2; ++h)
#pragma unroll
            for (int i = 0; i < 2; ++i) o[h][i] = rowtab[u.slot * 256 + 128 * h + R[i]] + (unsigned)C[i] * 2u; }
    DEV void boffs(const Unit& u, const int (&Rb)[2], const int (&C)[2], unsigned (&o)[2][2]) const {
#pragma unroll
        for (int h = 0; h < 2; ++h)
#pragma unroll
            for (int i = 0; i < 2; ++i) o[h][i] = (unsigned)(u.pn * 256 + 128 * h + Rb[i]) * 2048u + (unsigned)C[i] * 2u + u.bk; }
};
struct ProbMoeDown {
    const bf16* A; const bf16* B;
    DEV void aoffs(const Unit& u, const int (&R)[2], const int (&C)[2], unsigned (&o)[2][2]) const {
#pragma unroll
        for (int h = 0; h < 2; ++h)
#pragma unroll
            for (int i = 0; i < 2; ++i) o[h][i] = (unsigned)(u.arow0 + 128 * h + R[i]) * 1024u + (unsigned)C[i] * 2u; }
    DEV void boffs(const Unit& u, const int (&Rb)[2], const int (&C)[2], unsigned (&o)[2][2]) const {
#pragma unroll
        for (int h = 0; h < 2; ++h)
#pragma unroll
            for (int i = 0; i < 2; ++i) o[h][i] = (unsigned)(u.pn * 256 + 128 * h + Rb[i]) * 1024u + (unsigned)C[i] * 2u + u.bk; }
};

DEV void st16_wt(void* p, const v4u v) { asm volatile("global_store_dwordx4 %0, %1, off sc1\n\ts_nop 1" :: "v"(p), "v"(v) : "memory"); }
DEV v4u pack8(const f32x4 v0, const f32x4 v1) { v4u w; w.x = pg8::cvt_pk_bf16(v0[0], v0[1]); w.y = pg8::cvt_pk_bf16(v0[2], v0[3]); w.z = pg8::cvt_pk_bf16(v1[0], v1[1]); w.w = pg8::cvt_pk_bf16(v1[2], v1[3]); return w; }
DEV f32x4 sig4(f32x4 v) { f32x4 o; o[0] = sigmoidf_(v[0]); o[1] = sigmoidf_(v[1]); o[2] = sigmoidf_(v[2]); o[3] = sigmoidf_(v[3]); return o; }
DEV void unpack8(const v4u w, f32x4& lo, f32x4& hi) { lo[0] = bflo(w.x); lo[1] = bfhi(w.x); lo[2] = bflo(w.y); lo[3] = bfhi(w.y); hi[0] = bflo(w.z); hi[1] = bfhi(w.z); hi[2] = bflo(w.w); hi[3] = bfhi(w.w); }

struct Epi1 {
    static constexpr bool PERM = true;
    bf16* zu; bf16* zga; int cls;
    DEV bool keep(const Unit&) const { return false; }
    DEV void operator()(f32x4 (&acc)[2][2][4][2], const Unit& u, int wr, int wc, int fr, int fq) const {
        const int row0 = u.pm * 256 + wr * 64 + fr, cl = wc * 32 + 8 * fq;
        if (cls) { const int c = (u.pn < 4) ? 1 : (u.pn < 12) ? 2 : (u.pn < 16) ? 4 : 8; if (!(cls & c)) return; }
        if (u.pn < 4) {
#pragma unroll
            for (int ai = 0; ai < 2; ++ai)
#pragma unroll
                for (int m = 0; m < 4; ++m) { const size_t row = (size_t)(row0 + ai * 128 + m * 16);
                    const f32x4 v0 = acc[ai][0][m][0] * sig4(acc[ai][1][m][0]), v1 = acc[ai][0][m][1] * sig4(acc[ai][1][m][1]);
                    *(v4u*)(zu + row * 512 + 128 * u.pn + cl) = pack8(v0, v1); }
        } else {
            bf16* base; int ld, colb; bool sg;
            if (u.pn < 12) { const int ti = (u.pn - 4) >> 1; base = zu + (size_t)(1 + ti) * T * 512; ld = 512; colb = 256 * ((u.pn - 4) & 1); sg = (ti == 3); }
            else { const int ti = (u.pn - 12) >> 2; base = zga + (size_t)ti * T * 1024; ld = 1024; colb = 256 * ((u.pn - 12) & 3); sg = true; }
#pragma unroll
            for (int ai = 0; ai < 2; ++ai)
#pragma unroll
                for (int m = 0; m < 4; ++m) { const size_t row = (size_t)(row0 + ai * 128 + m * 16);
#pragma unroll
                    for (int bj = 0; bj < 2; ++bj) { f32x4 v0 = acc[ai][bj][m][0], v1 = acc[ai][bj][m][1]; if (sg) { v0 = sig4(v0); v1 = sig4(v1); }
                        *(v4u*)(base + row * ld + colb + 128 * bj + cl) = pack8(v0, v1); } }
        }
    }
};
struct Epi2 {
    static constexpr bool PERM = true;
    const bf16* zga; const bf16* zgb; bf16* merged;
    DEV bool keep(const Unit& u) const { return u.slot == 0; }
    DEV void operator()(f32x4 (&acc)[2][2][4][2], const Unit& u, int wr, int wc, int fr, int fq) const {
        const int row0 = u.pm * 256 + wr * 64 + fr, c0 = u.pn * 256 + wc * 32 + 8 * fq;
#pragma unroll
        for (int ai = 0; ai < 2; ++ai)
#pragma unroll
            for (int m = 0; m < 4; ++m) { const size_t ro = (size_t)(row0 + ai * 128 + m * 16) * 1024 + c0;
#pragma unroll
                for (int bj = 0; bj < 2; ++bj) {
                    f32x4 b0, b1; unpack8(*(const v4u*)(zgb + ro + 128 * bj), b0, b1);
                    if (u.slot == 0) { f32x4 a0, a1; unpack8(*(const v4u*)(zga + ro + 128 * bj), a0, a1);
#pragma unroll
                        for (int j = 0; j < 4; ++j) { acc[ai][bj][m][0][j] *= a0[j] * __builtin_amdgcn_rcpf(fmaxf(b0[j], 1e-30f)); acc[ai][bj][m][1][j] *= a1[j] * __builtin_amdgcn_rcpf(fmaxf(b1[j], 1e-30f)); }
                    } else { *(v4u*)(merged + ro + 128 * bj) = pack8(acc[ai][bj][m][0] * b0, acc[ai][bj][m][1] * b1); }
                } }
    }
};
struct Epi3 {
    static constexpr bool PERM = false;
    const float* x; const float* mod; float* out;
    DEV bool keep(const Unit&) const { return false; }
    DEV void operator()(f32x4 (&acc)[2][2][4][2], const Unit& u, int wr, int wc, int fr, int fq) const {
        const int row0 = u.pm * 256 + wr * 64 + fr, c0 = u.pn * 256 + wc * 32 + 4 * fq; const int b = u.pm >> 3;
        f32x4 gt[2][2];
#pragma unroll
        for (int bj = 0; bj < 2; ++bj)
#pragma unroll
            for (int n = 0; n < 2; ++n) gt[bj][n] = *(const f32x4*)(mod + b * 6144 + 2048 + c0 + 128 * bj + 16 * n);
#pragma unroll
        for (int ai = 0; ai < 2; ++ai)
#pragma unroll
            for (int m = 0; m < 4; ++m) { const size_t ro = (size_t)(row0 + ai * 128 + m * 16) * 1024 + c0;
#pragma unroll
                for (int bj = 0; bj < 2; ++bj)
#pragma unroll
                    for (int n = 0; n < 2; ++n) { const f32x4 xv = *(const f32x4*)(x + ro + 128 * bj + 16 * n); *(f32x4*)(out + ro + 128 * bj + 16 * n) = xv + gt[bj][n] * acc[ai][bj][m][n]; } }
    }
};
struct EpiUp {
    static constexpr bool PERM = true;
    bf16* act;
    DEV bool keep(const Unit&) const { return false; }
    DEV void operator()(f32x4 (&acc)[2][2][4][2], const Unit& u, int wr, int wc, int fr, int fq) const {
        const int cl = 128 * u.pn + wc * 32 + 8 * fq;
#pragma unroll
        for (int ai = 0; ai < 2; ++ai)
#pragma unroll
            for (int m = 0; m < 4; ++m) { const int rt = ai * 128 + wr * 64 + m * 16 + fr;
                if (rt < u.valid) { f32x4 v0, v1;
#pragma unroll
                    for (int j = 0; j < 4; ++j) { v0[j] = siluf_(acc[ai][0][m][0][j]) * acc[ai][1][m][0][j]; v1[j] = siluf_(acc[ai][0][m][1][j]) * acc[ai][1][m][1][j]; }
                    *(v4u*)(act + (size_t)(u.arow0 + rt) * 512 + cl) = pack8(v0, v1); } }
    }
};
struct EpiDown {
    static constexpr bool PERM = true;
    bf16* ys; const LAS unsigned* desttab; const LAS float* wtab;
    DEV bool keep(const Unit&) const { return false; }
    DEV void operator()(f32x4 (&acc)[2][2][4][2], const Unit& u, int wr, int wc, int fr, int fq) const {
        const int cl = 256 * u.pn + wc * 32 + 8 * fq;
#pragma unroll
        for (int ai = 0; ai < 2; ++ai)
#pragma unroll
            for (int m = 0; m < 4; ++m) { const int rt = ai * 128 + wr * 64 + m * 16 + fr;
                if (rt < u.valid) { const unsigned dest = desttab[u.slot * 256 + rt]; const float w = wtab[u.slot * 256 + rt];
#pragma unroll
                    for (int bj = 0; bj < 2; ++bj) *(v4u*)(ys + (size_t)dest * 1024 + cl + 128 * bj) = pack8(acc[ai][bj][m][0] * w, acc[ai][bj][m][1] * w); } }
    }
};

#define XB_TMO      128
#define XB_XCNT(j)  (256  + 64 * (j))
#define XB_XSUB(j)  (1280 + 64 * (j))
#define XB_XGEN(j)  (2304 + 64 * (j))
#define XB_TOP      3328
#define XB_TOPGEN   3392
#define XCD_BAR_WORDS 3456
#define XB_SPIN_CAP (1u << 18)
__device__ __forceinline__ unsigned xb_ld(unsigned* p)              { return __hip_atomic_load(p, __ATOMIC_RELAXED, __HIP_MEMORY_SCOPE_AGENT); }
__device__ __forceinline__ unsigned xb_add(unsigned* p, unsigned v) { return __hip_atomic_fetch_add(p, v, __ATOMIC_RELAXED, __HIP_MEMORY_SCOPE_AGENT); }
__device__ __forceinline__ unsigned xb_xcc_id() { return (unsigned)__builtin_amdgcn_s_getreg((3 << 11) | 20) & 0xFu; }
#define XB_SPIN(cond, bar) do { unsigned _sp = 0; while (cond) { __builtin_amdgcn_s_sleep(1); \
    if ((++_sp & 255u) == 0u) { if (xb_ld(&(bar)[XB_TMO])) break; if (_sp > XB_SPIN_CAP) { atomicAdd(&(bar)[XB_TMO], 1u); break; } } } } while (0)
struct XcdBarrier { unsigned* bar; unsigned x; volatile LAS unsigned* st; };
__device__ __forceinline__ XcdBarrier xcd_barrier_post(unsigned* bar, volatile LAS unsigned* st) {
    XcdBarrier b; b.bar = bar; b.x = xb_xcc_id(); b.st = st;
    if (threadIdx.x == 0) (void)xb_add(&bar[XB_XCNT(b.x)], 1u);
    return b;
}
__device__ __forceinline__ void xcd_barrier_complete(unsigned* bar, unsigned x, unsigned& nloc, unsigned& nx) {
    const unsigned G = gridDim.x * gridDim.y * gridDim.z;
    unsigned sum, cnt, mine, sp = 0u;
    for (;;) {
        sum = 0u; cnt = 0u; mine = 0u;
#pragma unroll
        for (unsigned j = 0; j < 16; ++j) { const unsigned c = xb_ld(&bar[XB_XCNT(j)]); sum += c; cnt += (c > 0u) ? 1u : 0u; mine = (j == x) ? c : mine; }
        if (sum == G) break;
        __builtin_amdgcn_s_sleep(1);
        if ((++sp & 255u) == 0u) { if (xb_ld(&bar[XB_TMO])) break; if (sp > XB_SPIN_CAP) { atomicAdd(&bar[XB_TMO], 1u); break; } }
    }
    nloc = mine > 0u ? mine : 1u; nx = cnt > 0u ? cnt : 1u;
}
__device__ __forceinline__ void xcd_barrier(const XcdBarrier& b) {
    asm volatile("s_waitcnt vmcnt(0)" ::: "memory");
    __syncthreads();
    if (threadIdx.x == 0) {
        unsigned* bar = b.bar;
        __builtin_amdgcn_s_waitcnt(0);
        unsigned nloc = b.st[0], nx = b.st[1];
        if (nloc == 0u) { xcd_barrier_complete(bar, b.x, nloc, nx); b.st[0] = nloc; b.st[1] = nx; }
        const unsigned old = xb_add(&bar[XB_XSUB(b.x)], 1u);
        const unsigned gen = old / nloc;
        if (old + 1u == (gen + 1u) * nloc) {
            __builtin_amdgcn_fence(__ATOMIC_RELEASE, "agent");
            asm volatile("s_waitcnt vmcnt(0)" ::: "memory");
            const unsigned og = xb_add(&bar[XB_TOP], 1u);
            const unsigned tg = og / nx;
            if (og + 1u == (tg + 1u) * nx) xb_add(&bar[XB_TOPGEN], 1u);
            else XB_SPIN(xb_ld(&bar[XB_TOPGEN]) == tg, bar);
            __builtin_amdgcn_fence(__ATOMIC_ACQUIRE, "agent");
            xb_add(&bar[XB_XGEN(b.x)], 1u);
            asm volatile("s_waitcnt vmcnt(0)" ::: "memory");
        } else {
            XB_SPIN(xb_ld(&bar[XB_XGEN(b.x)]) == gen, bar);
            __builtin_amdgcn_fence(__ATOMIC_ACQUIRE, "agent");
            asm volatile("s_waitcnt vmcnt(0)" ::: "memory");
        }
    }
    __syncthreads();
}

DEV f32x4 mma16(bf16x8 a, bf16x8 b, f32x4 c) { return __builtin_amdgcn_mfma_f32_16x16x32_bf16(a, b, c, 0, 0, 0); }
DEV void split8(const f32x4 a, const f32x4 b, bf16x8& hi, bf16x8& lo) {
    v4u h, l; const float r[8] = {a[0], a[1], a[2], a[3], b[0], b[1], b[2], b[3]}; unsigned hw[4], lw[4];
#pragma unroll
    for (int i = 0; i < 4; ++i) { hw[i] = pk2(r[2 * i], r[2 * i + 1]); lw[i] = pk2(r[2 * i] - bflo(hw[i]), r[2 * i + 1] - bfhi(hw[i])); }
    h.x = hw[0]; h.y = hw[1]; h.z = hw[2]; h.w = hw[3]; l.x = lw[0]; l.y = lw[1]; l.z = lw[2]; l.w = lw[3];
    hi = __builtin_bit_cast(bf16x8, h); lo = __builtin_bit_cast(bf16x8, l);
}
DEV void transpose_item(const float* src, int ldsrc, bf16* dst, int lddst, LAS float* scr, int lane) {
#pragma unroll 8
    for (int i = 0; i < 32; ++i) { const int kk = 2 * i + (lane >> 5); scr[kk * 33 + (lane & 31)] = src[(size_t)kk * ldsrc + (lane & 31)]; }
    LDS_WAIT(); asm volatile("" ::: "memory");
    const int c = lane & 7;
#pragma unroll
    for (int j = 0; j < 4; ++j) { const int n = (lane >> 3) + 8 * j; const LAS float* s = scr + (8 * c) * 33 + n;
        v4u o; o.x = pk2(s[0 * 33], s[1 * 33]); o.y = pk2(s[2 * 33], s[3 * 33]); o.z = pk2(s[4 * 33], s[5 * 33]); o.w = pk2(s[6 * 33], s[7 * 33]);
        *(v4u*)(dst + (size_t)n * lddst + 8 * c) = o; }
    LDS_WAIT(); asm volatile("" ::: "memory");
}

DEV void p0_prologue(const Args& a, LAS unsigned char* lds, int bid, int G) {
    const int tid = threadIdx.x, lane = tid & 63, wave = __builtin_amdgcn_readfirstlane(tid >> 6);
    const float* c = a.in[1]; const float* w_ada = a.in[2]; const float* b_ada = a.in[3];
    float* mod = (float*)(a.ws + WS_MOD);
    if (bid < 192) {
        LAS float* sil = (LAS float*)lds;
        LAS float* red = (LAS float*)(lds + 32768);
        for (int i = tid; i < 8192; i += NTHREADS) sil[i] = siluf_(c[i]);
        __syncthreads();
        for (int item = bid; item < 192; item += G) {
            const int n0 = item * 32, lg = lane >> 3, cq = lane & 7;
            float acc[8][4];
#pragma unroll
            for (int b = 0; b < 8; ++b)
#pragma unroll
                for (int j = 0; j < 4; ++j) acc[b][j] = 0.f;
#pragma unroll 4
            for (int j = 0; j < 16; ++j) { const int k = wave * 128 + j * 8 + lg; const f32x4 w = *(const f32x4*)(w_ada + (size_t)k * 6144 + n0 + cq * 4);
#pragma unroll
                for (int b = 0; b < 8; ++b) { const float s = sil[b * 1024 + k]; acc[b][0] += s * w[0]; acc[b][1] += s * w[1]; acc[b][2] += s * w[2]; acc[b][3] += s * w[3]; } }
#pragma unroll
            for (int b = 0; b < 8; ++b)
#pragma unroll
                for (int j = 0; j < 4; ++j) { float v = acc[b][j]; v += dpp0<0x128>(v); if ((lane & 8) == 0) red[(wave * 4 + (lane >> 4)) * 256 + b * 32 + cq * 4 + j] = v; }
            __syncthreads();
            if (tid < 256) { float s = 0.f;
#pragma unroll
                for (int w = 0; w < 32; ++w) s += red[w * 256 + tid];
                const int b = tid >> 5, col = tid & 31; mod[b * 6144 + n0 + col] = s + b_ada[n0 + col]; }
            asm volatile("s_waitcnt vmcnt(0)" ::: "memory");
            __syncthreads();
            if (tid == 0) { __builtin_amdgcn_fence(__ATOMIC_RELEASE, "agent"); asm volatile("s_waitcnt vmcnt(0)" ::: "memory");
                __hip_atomic_fetch_add((unsigned*)(a.ws + WS_CTL) + CW_MODCNT, 1u, __ATOMIC_RELAXED, __HIP_MEMORY_SCOPE_AGENT); }
        }
    }
    if (bid == G - 1) { const float* w_in0 = a.in[5]; float* wif = (float*)(a.ws + WS_WIF);
        for (int i = tid; i < 2048; i += NTHREADS) { const int k = i >> 1, hf = i & 1; *(f32x4*)(wif + k * 8 + 4 * hf) = *(const f32x4*)(w_in0 + (size_t)k * DIN + 3072 + 4 * hf); } }
    LAS float* scr = (LAS float*)(lds + wave * 16384);
    const int gw = bid * NWAVES + wave, NGW = G * NWAVES;
    const float* w_in = a.in[5]; const float* wco = a.in[11]; const float* wmo = a.in[15]; const float* wout = a.in[16];
    bf16* W1T = (bf16*)(a.ws + WS_W1T); bf16* W2T = (bf16*)(a.ws + WS_W2T); bf16* W3T = (bf16*)(a.ws + WS_W3T);
    constexpr int I1 = 16 * 160, I2 = 8 * 32, I3 = 16 * 32, NIT = I1 + 2 * I2 + I3;
    for (int it = gw; it < NIT; it += NGW) {
        int r = it;
        if (r < I1) { const int kb = r / 160, nb = r % 160, np = 32 * nb; int sc;
            if (np < 1024) { const int t = np >> 8, q = np & 255; sc = (q < 128) ? 128 * t + q : 512 + 128 * t + q - 128; } else if (np < 3072) sc = np; else sc = np + 8;
            transpose_item(w_in + (size_t)(64 * kb) * DIN + sc, DIN, W1T + (size_t)np * 1024 + 64 * kb, 1024, scr, lane); continue; }
        r -= I1;
        if (r < I2) { const int kb = r / 32, nb = r % 32; transpose_item(wco + (size_t)(64 * kb) * 1024 + 32 * nb, 1024, W2T + (size_t)(32 * nb) * 1024 + 64 * kb, 1024, scr, lane); continue; }
        r -= I2;
        if (r < I2) { const int kb = r / 32, nb = r % 32; transpose_item(wmo + (size_t)(64 * kb) * 1024 + 32 * nb, 1024, W2T + (size_t)(32 * nb) * 1024 + 512 + 64 * kb, 1024, scr, lane); continue; }
        r -= I2;
        { const int kb = r / 32, nb = r % 32; transpose_item(wout + (size_t)(64 * kb) * 1024 + 32 * nb, 1024, W3T + (size_t)(32 * nb) * 1024 + 64 * kb, 1024, scr, lane); }
    }
}

DEV void p1_h1(const Args& a, LAS unsigned char* lds, int bid, int G) {
    const int tid = threadIdx.x, lane = tid & 63, wave = __builtin_amdgcn_readfirstlane(tid >> 6);
    if (tid == 0) {
        unsigned* mc = (unsigned*)(a.ws + WS_CTL) + CW_MODCNT; unsigned sp = 0;
        while (__hip_atomic_load(mc, __ATOMIC_RELAXED, __HIP_MEMORY_SCOPE_AGENT) < 192u) { __builtin_amdgcn_s_sleep(2); if (++sp > (1u << 22)) break; }
        __builtin_amdgcn_fence(__ATOMIC_ACQUIRE, "agent"); asm volatile("s_waitcnt vmcnt(0)" ::: "memory"); }
    __syncthreads();
    const float* x = a.in[0]; const float* g1 = a.in[4]; const float* w_in = a.in[5]; const float* b_if = a.in[6];
    const float* mod = (const float*)(a.ws + WS_MOD); bf16* h1 = (bf16*)(a.ws + WS_H); float* gates = (float*)(a.ws + WS_GATES);
    LAS float* tab = (LAS float*)lds;
    for (int k = tid; k < 1024; k += NTHREADS) { const int p = ((k >> 8) << 2) | (k & 3), l = (k >> 2) & 63;
        const f32x4 w0 = *(const f32x4*)(w_in + (size_t)k * DIN + 3072), w1 = *(const f32x4*)(w_in + (size_t)k * DIN + 3076);
        *(LAS f32x4*)(tab + (p * 64 + l) * 8) = w0; *(LAS f32x4*)(tab + (p * 64 + l) * 8 + 4) = w1; }
    __syncthreads();
    {
        const float* g2 = a.in[17]; const float* w_rg = a.in[18]; const float* b_rg = a.in[19]; const float* w_re = a.in[20]; const float* b_re = a.in[21];
        float* rbias = (float*)(a.ws + WS_RBIAS); v4u* rw = (v4u*)(a.ws + WS_RW);
        const int gw = bid * NWAVES + wave, NGW = G * NWAVES;
        for (int it = gw; it < 8 * 36; it += NGW) { const int b = it / 36, n = it % 36; float sacc = 0.f;
#pragma unroll
            for (int i = 0; i < 16; ++i) { const int k = lane + 64 * i; const float w = (n < 4) ? w_rg[k * 4 + n] : w_re[k * 32 + n - 4]; sacc += mod[b * 6144 + 3072 + k] * w; }
            sacc = wave_sum(sacc);
            if (lane == 0) rbias[b * 48 + n] = sacc + ((n < 4) ? b_rg[n] : b_re[n - 4]); }
        for (int it = gw; it < 8 * 8 * 4 * 3; it += NGW) {
            const int nt = it % 3, kk = (it / 3) & 3, w8 = (it / 12) & 7, b = it / 96;
            const int n = 16 * nt + (lane & 15), k0 = 128 * w8 + 32 * kk + 8 * (lane >> 4);
            f32x4 w0, w1;
#pragma unroll
            for (int j = 0; j < 8; ++j) { const int k = k0 + j; const float* wp = (n < 4) ? (w_rg + k * 4 + n) : (w_re + k * 32 + ((n < 36) ? n - 4 : 0));
                float w = *wp; w = (n < 36) ? w : 0.f;
                w *= g2[k] * (1.f + mod[b * 6144 + 4096 + k]); if (j < 4) w0[j] = w; else w1[j - 4] = w; }
            bf16x8 hi, lo; split8(w0, w1, hi, lo);
            rw[((size_t)it * 2) * 64 + lane] = __builtin_bit_cast(v4u, hi); rw[((size_t)it * 2 + 1) * 64 + lane] = __builtin_bit_cast(v4u, lo);
        }
    }
    const float bifv = b_if[lane & 7];
    for (int tile = bid; tile < T / 64; tile += G) {
        const int b = tile / 32;
        float sc[4][4], sh[4][4];
#pragma unroll
        for (int j = 0; j < 4; ++j) { const int k = 256 * j + 4 * lane; const f32x4 gv = *(const f32x4*)(g1 + k), sv = *(const f32x4*)(mod + b * 6144 + 1024 + k), hv = *(const f32x4*)(mod + b * 6144 + k);
#pragma unroll
            for (int i = 0; i < 4; ++i) { sc[j][i] = gv[i] * (1.f + sv[i]); sh[j][i] = hv[i]; } }
        const int rot = (tile * 9) & 63;
        f32x4 nx[4][4];
#pragma unroll
        for (int p = 0; p < 4; ++p)
#pragma unroll
            for (int j = 0; j < 4; ++j) nx[p][j] = *(const f32x4*)(x + ((size_t)tile * 64 + ((wave + 8 * p + rot) & 63)) * 1024 + 256 * j + 4 * lane);
#pragma unroll
        for (int r8 = 0; r8 < 8; ++r8) {
            const int r = (wave + 8 * r8 + rot) & 63;
            const size_t row = (size_t)tile * 64 + r;
            f32x4 v[4]; float ss = 0.f;
#pragma unroll
            for (int j = 0; j < 4; ++j) { v[j] = nx[r8 & 3][j]; ss += (v[j][0] * v[j][0] + v[j][1] * v[j][1]) + (v[j][2] * v[j][2] + v[j][3] * v[j][3]); }
            if (r8 + 4 < 8) {
#pragma unroll
                for (int j = 0; j < 4; ++j) nx[r8 & 3][j] = *(const f32x4*)(x + ((size_t)tile * 64 + ((r + 32) & 63)) * 1024 + 256 * j + 4 * lane); }
            asm volatile("" ::: "memory");
            const float rstd = rsqrtf(wave_sum(ss) * (1.f / 1024.f) + RMS_EPS);
            float g[8];
#pragma unroll
            for (int q = 0; q < 8; ++q) g[q] = 0.f;
#pragma unroll
            for (int j = 0; j < 4; ++j) {
                float hh[4];
#pragma unroll
                for (int i = 0; i < 4; ++i) hh[i] = v[j][i] * rstd * sc[j][i] + sh[j][i];
                v2u o; o.x = pk2(hh[0], hh[1]); o.y = pk2(hh[2], hh[3]);
                *(v2u*)(h1 + row * 1024 + 256 * j + 4 * lane) = o;
#pragma unroll
                for (int i = 0; i < 4; ++i) { const LAS float* tp = tab + ((4 * j + i) * 64 + lane) * 8; const f32x4 w0 = *(const LAS f32x4*)tp, w1 = *(const LAS f32x4*)(tp + 4);
                    g[0] += hh[i] * w0[0]; g[1] += hh[i] * w0[1]; g[2] += hh[i] * w0[2]; g[3] += hh[i] * w0[3]; g[4] += hh[i] * w1[0]; g[5] += hh[i] * w1[1]; g[6] += hh[i] * w1[2]; g[7] += hh[i] * w1[3]; }
            }
            float mine = 0.f;
#pragma unroll
            for (int q = 0; q < 8; ++q) { const float sq = wave_sum(g[q]); mine = (lane == q) ? sq : mine; }
            if (lane < 8) { const float vv = mine + bifv; gates[row * 8 + lane] = (lane < 4) ? vv : logsigmoidf_(vv); }
        }
    }
}

DEV void p3_conva(const Args& a, LAS unsigned char* lds, int bid, int G) {
    const int tid = threadIdx.x, lane = tid & 63, wave = __builtin_amdgcn_readfirstlane(tid >> 6), sub = wave & 3, gsel = wave >> 2;
    const bf16* zu = (const bf16*)(a.ws + WS_ZU); bf16* uahm = (bf16*)(a.ws + WS_UAHM);
    const float* cw = a.in[7]; const float* cb = a.in[8]; const float* lg = a.in[9]; const float* lb = a.in[10];
    LAS float* red = (LAS float*)(lds + LDS_TAB);
    const int c0 = 128 * sub + 2 * lane;
    float w0[31], w1[31];
#pragma unroll
    for (int k = 0; k < 31; ++k) { w0[k] = cw[k * 512 + c0]; w1[k] = cw[k * 512 + c0 + 1]; }
    const float bias0 = cb[c0], bias1 = cb[c0 + 1], lg0 = lg[c0], lg1 = lg[c0 + 1], lb0 = lb[c0], lb1 = lb[c0 + 1];
    for (int it = bid; it < T / 32; it += G) {
        const int grp = it * 2 + gsel, tbase = grp * 16, s0 = tbase & (SEQ - 1);
        float acc0[16], acc1[16];
#pragma unroll
        for (int i = 0; i < 16; ++i) { acc0[i] = bias0; acc1[i] = bias1; }
#pragma unroll
        for (int r = 0; r < 46; ++r) {
            const int sp = s0 - 30 + r; const int src = tbase - 30 + r + ((sp < 0) ? -sp : 0); const float msk = (sp < 0) ? 0.f : 1.f;
            const unsigned wv = *(const unsigned*)(zu + (size_t)src * 512 + c0);
            const float u0 = bflo(wv) * msk, u1 = bfhi(wv) * msk;
#pragma unroll
            for (int i = 0; i < 16; ++i) { const int k = r - i; if (k >= 0 && k <= 30) { acc0[i] += w0[k] * u0; acc1[i] += w1[k] * u1; } }
        }
        float mean[16];
#pragma unroll
        for (int i = 0; i < 16; ++i) { const float s = wave_sum(acc0[i] + acc1[i]); if (lane == 0) red[(gsel * 4 + sub) * 16 + i] = s; }
        __syncthreads();
#pragma unroll
        for (int i = 0; i < 16; ++i) mean[i] = ((red[(gsel * 4 + 0) * 16 + i] + red[(gsel * 4 + 1) * 16 + i]) + (red[(gsel * 4 + 2) * 16 + i] + red[(gsel * 4 + 3) * 16 + i])) * (1.f / 512.f);
        __syncthreads();
#pragma unroll
        for (int i = 0; i < 16; ++i) { const float d0 = acc0[i] - mean[i], d1 = acc1[i] - mean[i]; const float s = wave_sum(d0 * d0 + d1 * d1); if (lane == 0) red[(gsel * 4 + sub) * 16 + i] = s; }
        __syncthreads();
#pragma unroll
        for (int i = 0; i < 16; ++i) {
            const float var = ((red[(gsel * 4 + 0) * 16 + i] + red[(gsel * 4 + 1) * 16 + i]) + (red[(gsel * 4 + 2) * 16 + i] + red[(gsel * 4 + 3) * 16 + i])) * (1.f / 512.f);
            const float rstd = rsqrtf(var + LN_EPS);
            const float y0 = (acc0[i] - mean[i]) * rstd * lg0 + lb0, y1 = (acc1[i] - mean[i]) * rstd * lg1 + lb1;
            *(unsigned*)(uahm + (size_t)(tbase + i) * 1024 + c0) = pk2(siluf_(y0), siluf_(y1));
        }
        __syncthreads();
    }
}

constexpr int ML_QS = 0, ML_KS = 17408, ML_KWT = 34816, ML_VT = 53248, ML_PS = 73984, ML_CT = 83200, ML_GT = 122368, ML_CW = 123648, ML_DEN = 128768, ML_PART = 129024, ML_VS = 130048;
template <bool OUT>
DEV void mlstm_unit(const Args& a, LAS unsigned char* lds, int unit) {
    int tid = threadIdx.x; asm volatile("" : "+v"(tid));
    const int lane = tid & 63, wave = __builtin_amdgcn_readfirstlane(tid >> 6), l15 = lane & 15, q4 = lane >> 4;
    const int j = unit & 7, bh = unit >> 3, h = bh & 3, b = bh >> 2, t0 = b * SEQ + 256 * j;
    const bf16* zq = (const bf16*)(a.ws + WS_ZQ); const bf16* zk = (const bf16*)(a.ws + WS_ZK); const bf16* zv = (const bf16*)(a.ws + WS_ZV); const bf16* zo = (const bf16*)(a.ws + WS_ZO);
    const float* gates = (const float*)(a.ws + WS_GATES); float* state = (float*)(a.ws + WS_STATE); float* stsc = (float*)(a.ws + WS_STSC);
    bf16* uahm = (bf16*)(a.ws + WS_UAHM); const float* qkw = a.in[12]; const float* qkb = a.in[13]; const float* mng = a.in[14];
    LAS bf16* QS = (LAS bf16*)(lds + ML_QS); LAS bf16* KS = (LAS bf16*)(lds + ML_KS); LAS bf16* KWT = (LAS bf16*)(lds + ML_KWT); LAS bf16* VT = (LAS bf16*)(lds + ML_VT);
    LAS bf16* PS = (LAS bf16*)(lds + ML_PS); LAS bf16* CT = (LAS bf16*)(lds + ML_CT); LAS bf16* VS = (LAS bf16*)(lds + ML_VS);
    LAS float* GTwk = (LAS float*)(lds + ML_GT); LAS float* GTsi = GTwk + 64; LAS float* GTlb = GTwk + 128; LAS float* GTg = GTwk + 192; LAS float* GTM = GTwk + 256;
    LAS float* CW = (LAS float*)(lds + ML_CW); LAS float* DEN = (LAS float*)(lds + ML_DEN); LAS float* PART = (LAS float*)(lds + ML_PART);
    __syncthreads();
    for (int i = tid; i < 1280; i += NTHREADS) {
        const float* p = (i < 512) ? (qkw + (i >> 7) * 1024 + h * 128 + (i & 127)) : (i < 1024) ? (qkw + ((i - 512) >> 7) * 1024 + 512 + h * 128 + (i & 127))
                       : (i < 1152) ? (qkb + h * 128 + (i - 1024)) : (qkb + 512 + h * 128 + (i - 1152));
        CW[i] = *p; }
    for (int i = tid; i < 16 * 72; i += NTHREADS) VT[128 * 72 + i] = (i < 64) ? (bf16)0x3F80 : (bf16)0;
    f32x4 accC[9];
#pragma unroll
    for (int i = 0; i < 9; ++i) accC[i] = (f32x4){0.f, 0.f, 0.f, 0.f};
    float mc = OUT ? 0.f : -1e30f, Btot = 0.f;
    if (OUT) {
        float wgt[7];
        {
            const int base = unit - j; float mi[7], Bi[7];
#pragma unroll
            for (int i = 0; i < 7; ++i) { const int u2 = base + ((i < j) ? i : 0); mi[i] = stsc[u2 * 4]; Bi[i] = stsc[u2 * 4 + 1]; }
#pragma unroll
            for (int i = 0; i < 7; ++i) if (i < j) mc = fmaxf(Bi[i] + mc, mi[i]);
            float suf = 0.f;
#pragma unroll
            for (int i = 6; i >= 0; --i) { wgt[i] = (i < j) ? __expf(mi[i] + suf - mc) : 0.f; if (i < j) suf += Bi[i]; }
        }
#pragma unroll
        for (int ii = 0; ii < 9; ++ii) {
            f32x4 ld[7];
#pragma unroll
            for (int i = 0; i < 7; ++i) { const size_t u2 = (size_t)(unit - j + ((i < j) ? i : 0));
#pragma unroll
                for (int r = 0; r < 4; ++r) ld[i][r] = state[(u2 * 36 + ii * 4 + r) * 512 + tid]; }
#pragma unroll
            for (int i = 0; i < 7; ++i) accC[ii] = accC[ii] + ld[i] * wgt[i];
        }
#pragma unroll
        for (int ii = 0; ii < 9; ++ii)
#pragma unroll
            for (int r = 0; r < 4; ++r) CT[(16 * ii + 4 * q4 + r) * 136 + 16 * wave + l15] = f2bf(accC[ii][r]);
    }
    float mg[4];
    if (OUT) {
#pragma unroll
        for (int i = 0; i < 4; ++i) mg[i] = mng[h * 128 + 16 * (4 * (wave & 1) + i) + l15];
    }
    __syncthreads();
    float li_n = gates[(size_t)(t0 + lane) * 8 + h], lf_n = gates[(size_t)(t0 + lane) * 8 + 4 + h];
    for (int cc = 0; cc < 4; ++cc) {
        const int tc = t0 + 64 * cc;
        const float li = li_n, lf = lf_n;
        if (cc < 3) { li_n = gates[(size_t)(tc + 64 + lane) * 8 + h]; lf_n = gates[(size_t)(tc + 64 + lane) * 8 + 4 + h]; }
        const float bc = wave_scan_add(lf, lane);
        const float g = li - bc;
        const float cm = wave_scan_max(g, lane);
        const float M = fmaxf(mc, cm);
        const float M63 = rdlane(M, 63), blast = rdlane(bc, 63);
        const float wkv = __expf(g - M63), sc = __expf(mc - M63), mnew = blast + M63;
        if (wave == 0) { GTwk[lane] = wkv; GTsi[lane] = __expf(mc - M); GTlb[lane] = __expf(-(bc + M)); GTg[lane] = g; GTM[lane] = M; }
        {
            const int cg = tid & 15, rp = tid >> 4, s0 = 2 * rp;
            v4u kraw[5], qraw[5], vraw[2];
#pragma unroll
            for (int m = 0; m < 5; ++m) { const int spos = 256 * j + 64 * cc + s0 - 3 + m; const bool ok = spos >= 0; const int src = ok ? (tc + s0 - 3 + m) : tc;
                kraw[m] = *(const v4u*)(zk + (size_t)src * 512 + h * 128 + cg * 8); }
#pragma unroll
            for (int rr = 0; rr < 2; ++rr) vraw[rr] = *(const v4u*)(zv + (size_t)(tc + s0 + rr) * 512 + h * 128 + cg * 8);
#define ML_CONV(RAW, WOFF, BOFF, DST, SCALE) do { float ac[2][8]; \
            _Pragma("unroll") for (int e = 0; e < 8; ++e) { ac[0][e] = ac[1][e] = CW[(BOFF) + cg * 8 + e]; } \
            _Pragma("unroll") for (int m = 0; m < 5; ++m) { const v4u rw_ = RAW[m]; const float ms = (256 * j + 64 * cc + s0 - 3 + m >= 0) ? 1.f : 0.f; \
                const float xv[8] = {bflo(rw_.x) * ms, bfhi(rw_.x) * ms, bflo(rw_.y) * ms, bfhi(rw_.y) * ms, bflo(rw_.z) * ms, bfhi(rw_.z) * ms, bflo(rw_.w) * ms, bfhi(rw_.w) * ms}; \
                _Pragma("unroll") for (int rr = 0; rr < 2; ++rr) { const int tap = m - rr; if (tap >= 0 && tap < 4) { \
                    _Pragma("unroll") for (int e = 0; e < 8; ++e) ac[rr][e] += CW[(WOFF) + tap * 128 + cg * 8 + e] * xv[e]; } } } \
            _Pragma("unroll") for (int rr = 0; rr < 2; ++rr) { v4u o; \
                o.x = pk2(siluf_(ac[rr][0]) * (SCALE), siluf_(ac[rr][1]) * (SCALE)); o.y = pk2(siluf_(ac[rr][2]) * (SCALE), siluf_(ac[rr][3]) * (SCALE)); \
                o.z = pk2(siluf_(ac[rr][4]) * (SCALE), siluf_(ac[rr][5]) * (SCALE)); o.w = pk2(siluf_(ac[rr][6]) * (SCALE), siluf_(ac[rr][7]) * (SCALE)); \
                *(LAS v4u*)((DST) + (s0 + rr) * 136 + cg * 8) = o; } } while (0)
            if (OUT) {
#pragma unroll
                for (int m = 0; m < 5; ++m) { const int spos = 256 * j + 64 * cc + s0 - 3 + m; const int src = (spos >= 0) ? (tc + s0 - 3 + m) : tc; qraw[m] = *(const v4u*)(zq + (size_t)src * 512 + h * 128 + cg * 8); } }
            ML_CONV(kraw, 512, 1152, KS, 1.f);
            asm volatile("" ::: "memory");
            if (OUT) ML_CONV(qraw, 0, 1024, QS, 0.08838834764831845f);
#undef ML_CONV
#pragma unroll
            for (int rr = 0; rr < 2; ++rr) *(LAS v4u*)(VS + (s0 + rr) * 136 + cg * 8) = vraw[rr];
        }
        __syncthreads();
        if (OUT) {
            const int tt = wave >> 1;
#pragma unroll
            for (int si = 0; si < 2; ++si) {
                const int st = 2 * (wave & 1) + si;
                f32x4 sacc = (f32x4){0.f, 0.f, 0.f, 0.f};
                if (st <= tt) {
#pragma unroll
                    for (int kk = 0; kk < 4; ++kk) sacc = mma16(*(const LAS bf16x8*)(QS + (16 * tt + l15) * 136 + 32 * kk + 8 * q4), *(const LAS bf16x8*)(KS + (16 * st + l15) * 136 + 32 * kk + 8 * q4), sacc);
                }
                const int sl = 16 * st + l15; const float gs = GTg[sl];
#pragma unroll
                for (int r = 0; r < 4; ++r) { const int tl = 16 * tt + 4 * q4 + r; const float w = (sl <= tl) ? __expf(gs - GTM[tl]) : 0.f; PS[tl * 72 + sl] = f2bf(sacc[r] * w); }
            }
        }
        {
            const int d = tid & 127, sg = tid >> 7; float kv[16];
#pragma unroll
            for (int i = 0; i < 16; ++i) kv[i] = bf2f(KS[(16 * sg + i) * 136 + d]) * GTwk[16 * sg + i];
            v4u o0, o1;
            o0.x = pk2(kv[0], kv[1]); o0.y = pk2(kv[2], kv[3]); o0.z = pk2(kv[4], kv[5]); o0.w = pk2(kv[6], kv[7]);
            o1.x = pk2(kv[8], kv[9]); o1.y = pk2(kv[10], kv[11]); o1.z = pk2(kv[12], kv[13]); o1.w = pk2(kv[14], kv[15]);
            *(LAS v4u*)(KWT + d * 72 + 16 * sg) = o0; *(LAS v4u*)(KWT + d * 72 + 16 * sg + 8) = o1;
            unsigned vw[8];
#pragma unroll
            for (int i = 0; i < 8; ++i) vw[i] = (unsigned)VS[(16 * sg + 2 * i) * 136 + d] | ((unsigned)VS[(16 * sg + 2 * i + 1) * 136 + d] << 16);
            o0.x = vw[0]; o0.y = vw[1]; o0.z = vw[2]; o0.w = vw[3]; o1.x = vw[4]; o1.y = vw[5]; o1.z = vw[6]; o1.w = vw[7];
            *(LAS v4u*)(VT + d * 72 + 16 * sg) = o0; *(LAS v4u*)(VT + d * 72 + 16 * sg + 8) = o1;
        }
        __syncthreads();
        f32x4 res[5];
        if (OUT) {
            const int tt = wave >> 1, dv0 = 4 * (wave & 1);
            bf16x8 pa[2], qa[4];
#pragma unroll
            for (int kk = 0; kk < 2; ++kk) pa[kk] = *(const LAS bf16x8*)(PS + (16 * tt + l15) * 72 + 32 * kk + 8 * q4);
#pragma unroll
            for (int kk = 0; kk < 4; ++kk) qa[kk] = *(const LAS bf16x8*)(QS + (16 * tt + l15) * 136 + 32 * kk + 8 * q4);
            float si[4];
#pragma unroll
            for (int r = 0; r < 4; ++r) si[r] = GTsi[16 * tt + 4 * q4 + r];
#pragma unroll
            for (int i = 0; i < 5; ++i) {
                const int dvt = (i < 4) ? (dv0 + i) : 8;
                if (i < 4 || (wave & 1) == 0) {
                    f32x4 a1 = (f32x4){0.f, 0.f, 0.f, 0.f}, a2 = (f32x4){0.f, 0.f, 0.f, 0.f};
#pragma unroll
                    for (int kk = 0; kk < 2; ++kk) a1 = mma16(pa[kk], *(const LAS bf16x8*)(VT + (16 * dvt + l15) * 72 + 32 * kk + 8 * q4), a1);
#pragma unroll
                    for (int kk = 0; kk < 4; ++kk) a2 = mma16(qa[kk], *(const LAS bf16x8*)(CT + (16 * dvt + l15) * 136 + 32 * kk + 8 * q4), a2);
#pragma unroll
                    for (int r = 0; r < 4; ++r) res[i][r] = a1[r] + si[r] * a2[r];
                } else res[i] = (f32x4){0.f, 0.f, 0.f, 0.f};
            }
            if ((wave & 1) == 0 && l15 == 0) {
#pragma unroll
                for (int r = 0; r < 4; ++r) DEN[16 * tt + 4 * q4 + r] = res[4][r];
            }
        }
        {
            bf16x8 kb[2];
#pragma unroll
            for (int kk = 0; kk < 2; ++kk) kb[kk] = *(const LAS bf16x8*)(KWT + (16 * wave + l15) * 72 + 32 * kk + 8 * q4);
#pragma unroll
            for (int i = 0; i < 9; ++i) { accC[i] = accC[i] * sc;
#pragma unroll
                for (int kk = 0; kk < 2; ++kk) accC[i] = mma16(*(const LAS bf16x8*)(VT + (16 * i + l15) * 72 + 32 * kk + 8 * q4), kb[kk], accC[i]); }
        }
        __syncthreads();
        if (OUT) {
            const int tt = wave >> 1;
            float den[4], lbv[4];
#pragma unroll
            for (int r = 0; r < 4; ++r) { den[r] = DEN[16 * tt + 4 * q4 + r]; lbv[r] = GTlb[16 * tt + 4 * q4 + r]; }
#pragma unroll
            for (int r = 0; r < 4; ++r) { const float inv = 1.f / fmaxf(fabsf(den[r]), lbv[r]); float s1 = 0.f, s2 = 0.f;
#pragma unroll
                for (int i = 0; i < 4; ++i) { res[i][r] *= inv; s1 += res[i][r]; s2 += res[i][r] * res[i][r]; }
                s1 = row16_sum(s1); s2 = row16_sum(s2);
                if (l15 == 0) { PART[((16 * tt + 4 * q4 + r) * 2 + (wave & 1)) * 2] = s1; PART[((16 * tt + 4 * q4 + r) * 2 + (wave & 1)) * 2 + 1] = s2; } }
#pragma unroll
            for (int ii = 0; ii < 9; ++ii)
#pragma unroll
                for (int r = 0; r < 4; ++r) CT[(16 * ii + 4 * q4 + r) * 136 + 16 * wave + l15] = f2bf(accC[ii][r]);
            __syncthreads();
#pragma unroll
            for (int r = 0; r < 4; ++r) { const int tl = 16 * tt + 4 * q4 + r; const size_t trow = (size_t)(tc + tl);
                const float s1 = PART[(tl * 2) * 2] + PART[(tl * 2 + 1) * 2], s2 = PART[(tl * 2) * 2 + 1] + PART[(tl * 2 + 1) * 2 + 1];
                const float mean = s1 * (1.f / 128.f), var = fmaxf(s2 * (1.f / 128.f) - mean * mean, 0.f), rstd = rsqrtf(var + LN_EPS);
#pragma unroll
                for (int i = 0; i < 4; ++i) { const int dvv = 16 * (4 * (wave & 1) + i) + l15;
                    const float y = (res[i][r] - mean) * rstd * mg[i] * bf2f(zo[trow * 512 + h * 128 + dvv]);
                    uahm[trow * 1024 + 512 + h * 128 + dvv] = f2bf(y); } }
        }
        mc = mnew; Btot += blast;
    }
    if (!OUT) {
#pragma unroll
        for (int ii = 0; ii < 9; ++ii)
#pragma unroll
            for (int r = 0; r < 4; ++r) state[((size_t)unit * 36 + ii * 4 + r) * 512 + tid] = accC[ii][r];
        if (tid == 0) { stsc[unit * 4] = mc; stsc[unit * 4 + 1] = Btot; }
    }
}

DEV void p8_route(const Args& a, LAS unsigned char* lds, int bid, int G) {
    const int tid = threadIdx.x, lane = tid & 63, wave = __builtin_amdgcn_readfirstlane(tid >> 6), l15 = lane & 15, q4 = lane >> 4;
    const float* x1 = a.out; const float* g2 = a.in[17]; const float* w_rg = a.in[18]; const float* w_re = a.in[20];
    const float* mod = (const float*)(a.ws + WS_MOD); const float* rbias = (const float*)(a.ws + WS_RBIAS); const v4u* rw = (const v4u*)(a.ws + WS_RW); bf16* h2 = (bf16*)(a.ws + WS_H);
    int* toke = (int*)(a.ws + WS_TOKE); float* tokw = (float*)(a.ws + WS_TOKW);
    int* listt = (int*)(a.ws + WS_LISTT); float* listw = (float*)(a.ws + WS_LISTW); unsigned* cnt = (unsigned*)(a.ws + WS_CTL) + CW_CNT;
    LAS float* PL = (LAS float*)lds;
    LAS float* SS = (LAS float*)(lds + 98304);
    LAS float* LG = (LAS float*)(lds + 100352);
    LAS float* RS = (LAS float*)(lds + 109568);
    LAS unsigned* lcnt = (LAS unsigned*)(lds + LDS_MISC + 256);
    LAS unsigned* lbase = lcnt + 32;
    LAS unsigned* lent = lcnt + 64;
    LAS float* lwt = (LAS float*)(lcnt + 192);
    for (int tile = bid; tile < T / 64; tile += G) {
        const int b = tile / 32;
        __syncthreads();
        if (tid < 32) lcnt[tid] = 0u;
        f32x4 acc[4][3]; float ss[4];
#pragma unroll
        for (int rt = 0; rt < 4; ++rt) { ss[rt] = 0.f;
#pragma unroll
            for (int nt = 0; nt < 3; ++nt) acc[rt][nt] = (f32x4){0.f, 0.f, 0.f, 0.f}; }
#pragma unroll 1
        for (int kk = 0; kk < 4; ++kk) {
            const int k0 = 128 * wave + 32 * kk + 8 * q4;
            bf16x8 bhi[3], blo[3];
#pragma unroll
            for (int nt = 0; nt < 3; ++nt) { const size_t it = ((size_t)(b * 8 + wave) * 4 + kk) * 3 + nt;
                bhi[nt] = __builtin_bit_cast(bf16x8, rw[(it * 2) * 64 + lane]); blo[nt] = __builtin_bit_cast(bf16x8, rw[(it * 2 + 1) * 64 + lane]); }
#pragma unroll
            for (int rt = 0; rt < 4; ++rt) {
                const float* xp = x1 + ((size_t)tile * 64 + 16 * rt + l15) * 1024 + k0;
                const f32x4 xa = *(const f32x4*)xp, xb = *(const f32x4*)(xp + 4);
                ss[rt] += (xa[0] * xa[0] + xa[1] * xa[1]) + (xa[2] * xa[2] + xa[3] * xa[3]) + (xb[0] * xb[0] + xb[1] * xb[1]) + (xb[2] * xb[2] + xb[3] * xb[3]);
                bf16x8 ahi, alo; split8(xa, xb, ahi, alo);
#pragma unroll
                for (int nt = 0; nt < 3; ++nt) { acc[rt][nt] = mma16(ahi, bhi[nt], acc[rt][nt]); acc[rt][nt] = mma16(alo, bhi[nt], acc[rt][nt]); acc[rt][nt] = mma16(ahi, blo[nt], acc[rt][nt]); }
            }
        }
#pragma unroll
        for (int rt = 0; rt < 4; ++rt) {
            float sv = ss[rt]; sv += __shfl_xor(sv, 16); sv += __shfl_xor(sv, 32);
            if (q4 == 0) SS[wave * 64 + 16 * rt + l15] = sv;
#pragma unroll
            for (int nt = 0; nt < 3; ++nt)
#pragma unroll
                for (int r = 0; r < 4; ++r) PL[(wave * 64 + 16 * rt + 4 * q4 + r) * 48 + 16 * nt + l15] = acc[rt][nt][r];
        }
        __syncthreads();
        {
            const int row = tid >> 3, part = tid & 7;
            float ssum = 0.f;
#pragma unroll
            for (int w = 0; w < 8; ++w) ssum += SS[w * 64 + row];
            const float rstd = rsqrtf(ssum * (1.f / 1024.f) + RMS_EPS);
            if (part == 0) RS[row] = rstd;
#pragma unroll
            for (int i = 0; i < 5; ++i) { const int n = part + 8 * i; if (n < 36) { float s = 0.f;
#pragma unroll
                    for (int w = 0; w < 8; ++w) s += PL[(w * 64 + row) * 48 + n];
                    LG[row * 36 + n] = rstd * s + rbias[b * 48 + n]; } }
        }
        __syncthreads();
        if (tid < 64) {
            const int r = tid; const size_t row = (size_t)tile * 64 + r;
            float lg[36];
#pragma unroll
            for (int q = 0; q < 36; ++q) lg[q] = LG[r * 36 + q];
            int gs = 0; float gm = lg[0];
#pragma unroll
            for (int q = 1; q < 4; ++q) if (lg[q] > gm) { gm = lg[q]; gs = q; }
            float se = 0.f;
#pragma unroll
            for (int q = 0; q < 4; ++q) se += __expf(lg[q] - gm);
            const float pg = 1.f / se;
            float le[8];
#pragma unroll
            for (int q = 0; q < 8; ++q) { float vsel = lg[4 + q];
#pragma unroll
                for (int gg = 1; gg < 4; ++gg) vsel = (gs == gg) ? lg[4 + 8 * gg + q] : vsel;
                le[q] = vsel; }
            int e0 = 0; float l0 = le[0];
#pragma unroll
            for (int q = 1; q < 8; ++q) if (le[q] > l0) { l0 = le[q]; e0 = q; }
            int e1 = -1; float l1 = -3.0e38f;
#pragma unroll
            for (int q = 0; q < 8; ++q) if (q != e0 && le[q] > l1) { l1 = le[q]; e1 = q; }
            const float rr = __expf(l1 - l0), w0 = pg / (1.f + rr), w1 = pg * rr / (1.f + rr);
#pragma unroll
            for (int sl = 0; sl < 2; ++sl) { const int e = gs * 8 + (sl ? e1 : e0); const float w = sl ? w1 : w0;
                toke[row * 2 + sl] = e; tokw[row * 2 + sl] = w;
                const unsigned lp = __hip_atomic_fetch_add(lcnt + e, 1u, __ATOMIC_RELAXED, __HIP_MEMORY_SCOPE_WORKGROUP);
                lent[r * 2 + sl] = (unsigned)e | (lp << 8); lwt[r * 2 + sl] = w; }
        }
        __syncthreads();
        if (tid < 32 && !(a.flags & 2)) { const unsigned n = lcnt[tid]; lbase[tid] = n ? atomicAdd(cnt + 16 * tid, n) : 0u; }
        {
            float sc[4][4], sh[4][4];
#pragma unroll
            for (int j = 0; j < 4; ++j) { const int k = 256 * j + 4 * lane; const f32x4 gv = *(const f32x4*)(g2 + k), sv = *(const f32x4*)(mod + b * 6144 + 4096 + k), hv = *(const f32x4*)(mod + b * 6144 + 3072 + k);
#pragma unroll
                for (int i = 0; i < 4; ++i) { sc[j][i] = gv[i] * (1.f + sv[i]); sh[j][i] = hv[i]; } }
            f32x4 nx[4];
#pragma unroll
            for (int j = 0; j < 4; ++j) nx[j] = *(const f32x4*)(x1 + ((size_t)tile * 64 + wave) * 1024 + 256 * j + 4 * lane);
#pragma unroll 1
            for (int r = wave; r < 64; r += NWAVES) {
                const size_t row = (size_t)tile * 64 + r; f32x4 v[4];
#pragma unroll
                for (int j = 0; j < 4; ++j) v[j] = nx[j];
                if (r + NWAVES < 64) {
#pragma unroll
                    for (int j = 0; j < 4; ++j) nx[j] = *(const f32x4*)(x1 + (row + NWAVES) * 1024 + 256 * j + 4 * lane); }
                asm volatile("" ::: "memory");
                const float rstd = RS[r];
#pragma unroll
                for (int j = 0; j < 4; ++j) { v2u o; o.x = pk2(v[j][0] * rstd * sc[j][0] + sh[j][0], v[j][1] * rstd * sc[j][1] + sh[j][1]); o.y = pk2(v[j][2] * rstd * sc[j][2] + sh[j][2], v[j][3] * rstd * sc[j][3] + sh[j][3]);
                    *(v2u*)(h2 + row * 1024 + 256 * j + 4 * lane) = o; }
            }
        }
        __syncthreads();
        if (tid < 128 && !(a.flags & 2)) { const unsigned en = lent[tid]; const unsigned e = en & 255u, lp = en >> 8; const unsigned pos = lbase[e] + lp;
            listt[e * 16384 + pos] = (tile * 64 + (tid >> 1)) * 2 + (tid & 1); listw[e * 16384 + pos] = lwt[tid]; }
    }
    __syncthreads();
}
DEV void p8_convert(const Args& a, LAS unsigned char* lds, int bid, int G) {
    const int tid = threadIdx.x, lane = tid & 63, wave = __builtin_amdgcn_readfirstlane(tid >> 6);
    LAS float* scr = (LAS float*)(lds + wave * 16384);
    const float* wg = a.in[22]; const float* wu = a.in[23]; const float* wd = a.in[24];
    bf16* WGU = (bf16*)(a.ws + WS_WGU); bf16* WD = (bf16*)(a.ws + WS_WD);
    const int gw = bid * NWAVES + wave, NGW = G * NWAVES;
    for (int it = gw; it < 32 * 768; it += NGW) {
        const int e = it / 768; int r = it % 768;
        if (r < 512) { const int up = r >> 8; r &= 255; const int kb = r >> 4, nb = r & 15, n = 32 * nb, np = 256 * (n >> 7) + 128 * up + (n & 127);
            transpose_item((up ? wu : wg) + (size_t)e * 1024 * 512 + (size_t)(64 * kb) * 512 + n, 512, WGU + ((size_t)e * 1024 + np) * 1024 + 64 * kb, 1024, scr, lane); }
        else { r -= 512; const int kb = r >> 5, nb = r & 31;
            transpose_item(wd + (size_t)e * 512 * 1024 + (size_t)(64 * kb) * 1024 + 32 * nb, 1024, WD + ((size_t)e * 1024 + 32 * nb) * 512 + 64 * kb, 512, scr, lane); }
    }
}

struct MoeSched {
    const LAS int* tlist; const LAS int* rstart; const LAS int* ecnt; int U, G, c; unsigned bstride;
    DEV bool next(int i, Unit& u) const {
        const int L = i * G + c; if (L >= U) return false;
        const int ent = tlist[L >> 2]; const int e = ent & 255, rt = ent >> 8; u.pn = L & 3;
        const int left = ecnt[e] - 256 * rt;
        u.pm = 0; u.ak = 0; u.bk = (unsigned)e * bstride; u.slot = i; u.valid = left < 256 ? left : 256; u.arow0 = rstart[e] + 256 * rt; return true;
    }
};
DEV void moe_tables(const Args& a, LAS unsigned char* lds, int bid, int G, MoeSched& S, bool down) {
    const int tid = threadIdx.x;
    LAS int* ti = (LAS int*)(lds + LDS_MISC + 1024); LAS int* rstart = ti, *ecnt = ti + 40, *tlist = ti + 80, *ntl = ti + 260;
    const unsigned* cnt = (const unsigned*)(a.ws + WS_CTL) + CW_CNT;
    const int* listt = (const int*)(a.ws + WS_LISTT); const float* listw = (const float*)(a.ws + WS_LISTW);
    __syncthreads();
    if (tid < 64) {
        const int lane = tid; const int n = (lane < 32) ? (int)__hip_atomic_load(cnt + 16 * (lane & 31), __ATOMIC_RELAXED, __HIP_MEMORY_SCOPE_AGENT) : 0;
        const int ntile = (n + 255) >> 8, nfull = (n + 127) >> 8, ntail = ntile - nfull;
        const int rs = (int)wave_scan_add((float)n, lane) - n, of = (int)wave_scan_add((float)nfull, lane) - nfull, ot = (int)wave_scan_add((float)ntail, lane) - ntail;
        const int totf = (int)rdlane(wave_scan_add((float)nfull, lane), 63), tott = (int)rdlane(wave_scan_add((float)ntail, lane), 63);
        if (lane < 32) { ecnt[lane] = n; rstart[lane] = rs;
            for (int rt = 0; rt < nfull; ++rt) tlist[of + rt] = lane | (rt << 8);
            if (ntail) tlist[totf + ot] = lane | (nfull << 8); }
        if (lane == 32) rstart[32] = rs;
        if (lane == 0) ntl[0] = totf + tott;
    }
    __syncthreads();
    S.tlist = tlist; S.rstart = rstart; S.ecnt = ecnt; S.U = 4 * ntl[0]; S.G = G; S.c = bid;
    LAS unsigned* tab0 = (LAS unsigned*)(lds + LDS_TAB); LAS float* tab1 = (LAS float*)(lds + LDS_TAB + 8192);
    Unit u;
    for (int i = 0; i < 8 && S.next(i, u); ++i) {
        if (tid < 256) { const int e = (int)(u.bk / S.bstride); const int pos = (u.arow0 - rstart[e]) + tid; unsigned v0 = 0u; float v1 = 0.f;
            if (tid < u.valid) { const int tk = listt[e * 16384 + pos]; v0 = down ? (unsigned)tk : (unsigned)(tk >> 1) * 2048u; v1 = listw[e * 16384 + pos]; }
            tab0[i * 256 + tid] = v0; tab1[i * 256 + tid] = v1; }
    }
    __syncthreads();
}

DEV void p11_final(const Args& a, int bid, int G) {
    const int tid = threadIdx.x, lane = tid & 63, wave = __builtin_amdgcn_readfirstlane(tid >> 6);
    const float* mod = (const float*)(a.ws + WS_MOD); const bf16* ys = (const bf16*)(a.ws + WS_YS); const float* gf = a.in[25]; float* out = a.out;
    for (int tile = bid; tile < T / 64; tile += G) {
        const int b = tile / 32;
        f32x4 nx[4], gtv[4], gfv[4]; v2u ny0[4], ny1[4];
#pragma unroll
        for (int j = 0; j < 4; ++j) { const int k = 256 * j + 4 * lane; gtv[j] = *(const f32x4*)(mod + b * 6144 + 5120 + k); gfv[j] = *(const f32x4*)(gf + k); }
#pragma unroll
        for (int j = 0; j < 4; ++j) { const size_t row = (size_t)tile * 64 + wave; const int k = 256 * j + 4 * lane;
            nx[j] = *(const f32x4*)(out + row * 1024 + k); ny0[j] = *(const v2u*)(ys + row * 2048 + k); ny1[j] = *(const v2u*)(ys + row * 2048 + 1024 + k); }
#pragma unroll 1
        for (int r = wave; r < 64; r += NWAVES) {
            const size_t row = (size_t)tile * 64 + r;
            f32x4 v[4]; float ss = 0.f;
#pragma unroll
            for (int j = 0; j < 4; ++j) { const int k = 256 * j + 4 * lane;
                const f32x4 xv = nx[j], gt = gtv[j]; const v2u y0 = ny0[j], y1 = ny1[j];
                v[j][0] = xv[0] + gt[0] * (bflo(y0.x) + bflo(y1.x)); v[j][1] = xv[1] + gt[1] * (bfhi(y0.x) + bfhi(y1.x));
                v[j][2] = xv[2] + gt[2] * (bflo(y0.y) + bflo(y1.y)); v[j][3] = xv[3] + gt[3] * (bfhi(y0.y) + bfhi(y1.y));
                ss += (v[j][0] * v[j][0] + v[j][1] * v[j][1]) + (v[j][2] * v[j][2] + v[j][3] * v[j][3]); }
            if (r + NWAVES < 64) {
#pragma unroll
                for (int j = 0; j < 4; ++j) { const size_t rn = row + NWAVES; const int k = 256 * j + 4 * lane;
                    nx[j] = *(const f32x4*)(out + rn * 1024 + k); ny0[j] = *(const v2u*)(ys + rn * 2048 + k); ny1[j] = *(const v2u*)(ys + rn * 2048 + 1024 + k); } }
            asm volatile("" ::: "memory");
            const float rstd = rsqrtf(wave_sum(ss) * (1.f / 1024.f) + RMS_EPS);
#pragma unroll
            for (int j = 0; j < 4; ++j) { const int k = 256 * j + 4 * lane; *(f32x4*)(out + row * 1024 + k) = v[j] * rstd * gfv[j]; }
        }
    }
}

constexpr int NPHASE = 11;
template <int LO, int HI>
__global__ void __launch_bounds__(NTHREADS, 2) mk_fwd(Args a) {
    extern __shared__ __attribute__((aligned(16))) unsigned char lds_raw[];
    LAS unsigned char* lds = (LAS unsigned char*)lds_raw;
    const int tid = threadIdx.x, G = gridDim.x, bid = blockIdx.x;
    volatile LAS unsigned* MISC = (volatile LAS unsigned*)(lds + LDS_MISC);
    if (tid < 64) MISC[tid] = 0u;
    __syncthreads();
#if MK_ONE
    XcdBarrier bar = xcd_barrier_post((unsigned*)(a.ws + WS_CTL) + CW_BAR, MISC + 8);
#define GRID_BAR() xcd_barrier(bar)
#else
#define GRID_BAR() do {} while (0)
#endif
    constexpr int lo = LO, hi = HI;
#define IN(k) (lo <= (k) && (k) < hi)
#define BOTH(k) (IN(k) && IN((k) + 1))
    if constexpr (IN(0)) { REPK(0) { p0_prologue(a, lds, bid, G); REPSYNC(); } if constexpr (BOTH(0)) __syncthreads(); }
    if constexpr (IN(1)) { REPK(1) { p1_h1(a, lds, bid, G); REPSYNC(); } if constexpr (BOTH(1)) GRID_BAR(); }
    if constexpr (IN(2)) {
        __syncthreads();
        ProbPlain P{(const bf16*)(a.ws + WS_H), (const bf16*)(a.ws + WS_W1T), 2048u, 2048u};
#if DBG_GATEFIRST
        struct SchedG { pg8::StaticOrder so; DEV bool next(int i, Unit& u) const { if (i >= 2) return false; return so.next(i + 3, u); } } S; S.so.init(T, 5120, G, bid);
#else
        pg8::StaticOrder S; S.init(T, 5120, G, bid);
#endif
        Epi1 E{(bf16*)(a.ws + WS_ZU), (bf16*)(a.ws + WS_ZGA), (a.flags >> 8) & 15};
        REPK(2) pg8::gemm_phase<ProbPlain, Epi1, decltype(S), true>(lds, P, S, E, 1024);
        if constexpr (BOTH(2)) GRID_BAR();
    }
    if constexpr (IN(3)) {
        REPK(3) { for (int u = bid; u < 256; u += G) mlstm_unit<false>(a, lds, u);
        __syncthreads(); }
        REPK(11) { p3_conva(a, lds, bid, G); REPSYNC(); }
        if constexpr (BOTH(3)) GRID_BAR();
    }
    if constexpr (IN(4)) {
        REPK(4) { for (int u = bid; u < 256; u += G) mlstm_unit<true>(a, lds, u); REPSYNC(); }
        if constexpr (BOTH(4)) GRID_BAR();
    }
    if constexpr (IN(5)) {
        __syncthreads();
        struct Sched2 { pg8::StaticOrder so; DEV bool next(int i, Unit& u) const { u.ak = (unsigned)(i & 1) * 1024u; u.bk = u.ak; u.slot = i & 1; u.valid = 256; u.arow0 = 0; return so.tile((i >> 1) * so.G + so.c, u.pm, u.pn); } } S;
        S.so.init(T, 1024, G, bid);
        ProbPlain P{(const bf16*)(a.ws + WS_UAHM), (const bf16*)(a.ws + WS_W2T), 2048u, 2048u};
        Epi2 E{(const bf16*)(a.ws + WS_ZGA), (const bf16*)(a.ws + WS_ZGB), (bf16*)(a.ws + WS_MERGED)};
        REPK(5) pg8::gemm_phase<ProbPlain, Epi2, Sched2, false>(lds, P, S, E, 512);
        if constexpr (BOTH(5)) GRID_BAR();
    }
    if constexpr (IN(6)) {
        __syncthreads();
        ProbPlain P{(const bf16*)(a.ws + WS_MERGED), (const bf16*)(a.ws + WS_W3T), 2048u, 2048u};
        pg8::StaticOrder S; S.init(T, 1024, G, bid);
        Epi3 E{a.in[0], (const float*)(a.ws + WS_MOD), a.out};
        REPK(6) pg8::gemm_phase<ProbPlain, Epi3, pg8::StaticOrder, false>(lds, P, S, E, 1024);
        if constexpr (BOTH(6)) GRID_BAR();
    }
    if constexpr (IN(7)) {
        if (!(a.flags & 1)) p8_route(a, lds, bid, G);
        __syncthreads();
        if (!(a.flags & 4)) { p8_convert(a, lds, bid, G); }
        if constexpr (BOTH(7)) GRID_BAR();
    }
    if constexpr (IN(8)) {
        MoeSched S; S.bstride = 1024u * 1024u * 2u;
        moe_tables(a, lds, bid, G, S, false);
        ProbMoeUp P{(const bf16*)(a.ws + WS_H), (const bf16*)(a.ws + WS_WGU), (const LAS unsigned*)(lds + LDS_TAB)};
        EpiUp E{(bf16*)(a.ws + WS_ACT)};
        REPK(8) pg8::gemm_phase<ProbMoeUp, EpiUp, MoeSched, false, true>(lds, P, S, E, 1024);
        if constexpr (BOTH(8)) GRID_BAR();
    }
    if constexpr (IN(9)) {
        MoeSched S; S.bstride = 1024u * 512u * 2u;
        moe_tables(a, lds, bid, G, S, true);
        ProbMoeDown P{(const bf16*)(a.ws + WS_ACT), (const bf16*)(a.ws + WS_WD)};
        EpiDown E{(bf16*)(a.ws + WS_YS), (const LAS unsigned*)(lds + LDS_TAB), (const LAS float*)(lds + LDS_TAB + 8192)};
        REPK(9) pg8::gemm_phase<ProbMoeDown, EpiDown, MoeSched, false, true>(lds, P, S, E, 512);
        if constexpr (BOTH(9)) GRID_BAR();
    }
    if constexpr (IN(10)) { p11_final(a, bid, G); }
#undef IN
#undef BOTH
}

#if NAIVE_MASK
__global__ __launch_bounds__(256) void k_fixw1t(const float* w_in, bf16* W1T) { const size_t i = (size_t)blockIdx.x * 256 + threadIdx.x; const size_t n = i / 1024, k = i % 1024; W1T[(3072 + n) * 1024 + k] = f2bf(w_in[k * 5128 + 3080 + n]); }
DEV float block_sum256(float v, float* red) {
#pragma unroll
    for (int o = 32; o >= 1; o >>= 1) v += __shfl_xor(v, o);
    __syncthreads();
    if ((threadIdx.x & 63) == 0) red[threadIdx.x >> 6] = v;
    __syncthreads();
    return (red[0] + red[1]) + (red[2] + red[3]);
}
__global__ __launch_bounds__(256) void k_mod(const float* c, const float* w_ada, const float* b_ada, float* mod) {
    const int idx = blockIdx.x * 256 + threadIdx.x; const int b = idx / 6144, n = idx % 6144;
    float acc = 0.f;
    for (int k = 0; k < D; ++k) acc += siluf_(c[b * D + k]) * w_ada[(size_t)k * 6144 + n];
    mod[idx] = acc + b_ada[n];
}
__global__ __launch_bounds__(256) void k_h1(const float* x, const float* g1, const float* mod, const float* w_in, const float* b_if, bf16* h1, float* gates) {
    __shared__ float red[4];
    const int t = blockIdx.x, b = t / SEQ, tid = threadIdx.x;
    const float4 xv = ((const float4*)(x + (size_t)t * D))[tid];
    float ss = xv.x * xv.x + xv.y * xv.y + xv.z * xv.z + xv.w * xv.w;
    ss = block_sum256(ss, red);
    const float rstd = rsqrtf(ss * (1.f / D) + RMS_EPS);
    const float* sh = mod + b * 6144, *sc = mod + b * 6144 + 1024;
    float hv[4]; const float xs[4] = {xv.x, xv.y, xv.z, xv.w};
#pragma unroll
    for (int j = 0; j < 4; ++j) { const int k = tid * 4 + j; hv[j] = xs[j] * rstd * g1[k] * (1.f + sc[k]) + sh[k]; }
    ushort4 o; o.x = f2bf(hv[0]); o.y = f2bf(hv[1]); o.z = f2bf(hv[2]); o.w = f2bf(hv[3]);
    ((ushort4*)(h1 + (size_t)t * D))[tid] = o;
    float g[8];
#pragma unroll
    for (int j = 0; j < 8; ++j) g[j] = 0.f;
#pragma unroll
    for (int i = 0; i < 4; ++i) { const float* wr = w_in + (size_t)(tid * 4 + i) * DIN + 3072;
#pragma unroll
        for (int j = 0; j < 8; ++j) g[j] += hv[i] * wr[j]; }
#pragma unroll
    for (int j = 0; j < 8; ++j) g[j] = block_sum256(g[j], red);
    if (tid < 8) { float v = g[0];
#pragma unroll
        for (int j = 1; j < 8; ++j) v = (tid == j) ? g[j] : v;
        v += b_if[tid];
        gates[(size_t)t * 8 + tid] = (tid < 4) ? v : logsigmoidf_(v); }
}
template <class Epi>
__global__ __launch_bounds__(256) void k_ngemm(const bf16* A, int lda, const float* W, int ldw, int N, int K, Epi epi) {
    __shared__ float As[16][68]; __shared__ float Ws[16][68];
    const int tid = threadIdx.x, tx = tid & 15, ty = tid >> 4;
    const int row0 = blockIdx.y * 64, col0 = blockIdx.x * 64;
    float acc[4][4];
#pragma unroll
    for (int i = 0; i < 4; ++i)
#pragma unroll
        for (int j = 0; j < 4; ++j) acc[i][j] = 0.f;
    const int ar = tid >> 2, ak = (tid & 3) * 4;
    const int wk = tid >> 4, wc = (tid & 15) * 4;
    for (int k0 = 0; k0 < K; k0 += 16) {
        const ushort4 av = *(const ushort4*)(A + (size_t)(row0 + ar) * lda + k0 + ak);
        As[ak + 0][ar] = bf2f(av.x); As[ak + 1][ar] = bf2f(av.y); As[ak + 2][ar] = bf2f(av.z); As[ak + 3][ar] = bf2f(av.w);
#pragma unroll
        for (int j = 0; j < 4; ++j) { const int cc = col0 + wc + j; Ws[wk][wc + j] = (cc < N) ? W[(size_t)(k0 + wk) * ldw + cc] : 0.f; }
        __syncthreads();
#pragma unroll
        for (int kk = 0; kk < 16; ++kk) {
            float av2[4], w[4];
#pragma unroll
            for (int i = 0; i < 4; ++i) av2[i] = As[kk][ty * 4 + i];
#pragma unroll
            for (int j = 0; j < 4; ++j) w[j] = Ws[kk][tx * 4 + j];
#pragma unroll
            for (int i = 0; i < 4; ++i)
#pragma unroll
                for (int j = 0; j < 4; ++j) acc[i][j] += av2[i] * w[j];
        }
        __syncthreads();
    }
#pragma unroll
    for (int i = 0; i < 4; ++i)
#pragma unroll
        for (int j = 0; j < 4; ++j) { const int cc = col0 + tx * 4 + j; if (cc < N) epi(row0 + ty * 4 + i, cc, acc[i][j]); }
}
struct NEpi1 {
    float* tmp; bf16 *zq, *zk, *zv, *zo, *zga, *zgb;
    DEV void operator()(int r, int c, float v) const {
        if (c < 1024) tmp[(size_t)r * 1024 + c] = v;
        else if (c < 1536) zq[(size_t)r * 512 + c - 1024] = f2bf(v);
        else if (c < 2048) zk[(size_t)r * 512 + c - 1536] = f2bf(v);
        else if (c < 2560) zv[(size_t)r * 512 + c - 2048] = f2bf(v);
        else if (c < 3072) zo[(size_t)r * 512 + c - 2560] = f2bf(sigmoidf_(v));
        else if (c < 3080) {}
        else if (c < 4104) zga[(size_t)r * 1024 + c - 3080] = f2bf(sigmoidf_(v));
        else zgb[(size_t)r * 1024 + c - 4104] = f2bf(sigmoidf_(v));
    }
};
struct NEpi2a { float* tmp; const bf16* zga; DEV void operator()(int r, int c, float v) const { tmp[(size_t)r * 1024 + c] = v * bf2f(zga[(size_t)r * 1024 + c]); } };
struct NEpi2b { const float* tmp; const bf16* zgb; bf16* merged; DEV void operator()(int r, int c, float v) const { merged[(size_t)r * 1024 + c] = f2bf(tmp[(size_t)r * 1024 + c] + v * bf2f(zgb[(size_t)r * 1024 + c])); } };
struct NEpi3 { const float* x; const float* mod; float* out; DEV void operator()(int r, int c, float v) const { const int b = r / SEQ; out[(size_t)r * 1024 + c] = x[(size_t)r * 1024 + c] + mod[b * 6144 + 2048 + c] * v; } };
__global__ __launch_bounds__(256) void k_glu(const float* tmp, bf16* zu) {
    const size_t i = (size_t)blockIdx.x * 256 + threadIdx.x; const size_t r = i / 512, c = i % 512;
    zu[i] = f2bf(tmp[r * 1024 + c] * sigmoidf_(tmp[r * 1024 + 512 + c]));
}
__global__ __launch_bounds__(256) void k_conva(const bf16* zu, const float* cw, const float* cb, const float* lg, const float* lb, bf16* uahm) {
    __shared__ float red[4];
    const int t = blockIdx.x, s = t % SEQ, tid = threadIdx.x;
    float v[2];
#pragma unroll
    for (int j = 0; j < 2; ++j) { const int c = tid + 256 * j; float a = cb[c];
        for (int k = 0; k < 31; ++k) { const int ss = s - 30 + k; if (ss >= 0) a += cw[k * 512 + c] * bf2f(zu[(size_t)(t - 30 + k) * 512 + c]); }
        v[j] = a; }
    const float mean = block_sum256(v[0] + v[1], red) * (1.f / 512.f);
    const float d0 = v[0] - mean, d1 = v[1] - mean;
    const float var = block_sum256(d0 * d0 + d1 * d1, red) * (1.f / 512.f);
    const float rstd = rsqrtf(var + LN_EPS);
#pragma unroll
    for (int j = 0; j < 2; ++j) { const int c = tid + 256 * j; const float y = (v[j] - mean) * rstd * lg[c] + lb[c]; uahm[(size_t)t * 1024 + c] = f2bf(siluf_(y)); }
}
__global__ __launch_bounds__(256) void k_qkconv(const bf16* zq, const bf16* zk, const float* w, const float* bq, bf16* qc, bf16* kc) {
    const int t = blockIdx.x, s = t % SEQ, tid = threadIdx.x;
#pragma unroll
    for (int j = 0; j < 4; ++j) { const int c = tid + 256 * j; const bf16* src = (c < 512) ? zq : zk; const int cc = c & 511; float a = bq[c];
#pragma unroll
        for (int k = 0; k < 4; ++k) { const int ss = s - 3 + k; if (ss >= 0) a += w[k * 1024 + c] * bf2f(src[(size_t)(t - 3 + k) * 512 + cc]); }
        ((c < 512) ? qc : kc)[(size_t)t * 512 + cc] = f2bf(siluf_(a)); }
}
__global__ __launch_bounds__(256) void k_mlstm_rec(const bf16* qc, const bf16* kc, const bf16* zv, const bf16* zo, const float* gates, const float* mng, bf16* uahm) {
    __shared__ float qs[128], ks[128], vs[128], part[2][128], red[8];
    const int b = blockIdx.x / NH, h = blockIdx.x % NH, tid = threadIdx.x, j = tid & 127, ih = tid >> 7;
    float C[64];
#pragma unroll
    for (int r = 0; r < 64; ++r) C[r] = 0.f;
    float nn = 0.f, m = 0.f;
    for (int s = 0; s < SEQ; ++s) {
        const size_t t = (size_t)b * SEQ + s;
        __syncthreads();
        if (tid < 128) { qs[tid] = bf2f(qc[t * 512 + h * 128 + tid]) * 0.08838834764831845f; ks[tid] = bf2f(kc[t * 512 + h * 128 + tid]); }
        else vs[tid - 128] = bf2f(zv[t * 512 + h * 128 + tid - 128]);
        const float li = gates[t * 8 + h], lf = gates[t * 8 + 4 + h];
        const float mn = fmaxf(lf + m, li), ip = __expf(li - mn), fp = __expf(lf + m - mn); m = mn;
        __syncthreads();
        const float vj = vs[j]; float p = 0.f;
#pragma unroll
        for (int r = 0; r < 64; ++r) { const int i = ih * 64 + r; C[r] = fp * C[r] + ip * ks[i] * vj; p += qs[i] * C[r]; }
        part[ih][j] = p;
        float dn = 0.f;
        if (tid < 128) { nn = fp * nn + ip * ks[tid]; dn = qs[tid] * nn; }
#pragma unroll
        for (int o = 32; o >= 1; o >>= 1) dn += __shfl_xor(dn, o);
        if ((tid & 63) == 0) red[tid >> 6] = dn;
        __syncthreads();
        float hv = 0.f, sm = 0.f;
        if (tid < 128) { const float den = red[0] + red[1]; hv = (part[0][tid] + part[1][tid]) / fmaxf(fabsf(den), __expf(-mn)); sm = hv; }
#pragma unroll
        for (int o = 32; o >= 1; o >>= 1) sm += __shfl_xor(sm, o);
        if ((tid & 63) == 0) red[4 + (tid >> 6)] = sm;
        __syncthreads();
        const float mu = (red[4] + red[5]) * (1.f / 128.f);
        float dv = (tid < 128) ? (hv - mu) : 0.f; float sq = dv * dv;
#pragma unroll
        for (int o = 32; o >= 1; o >>= 1) sq += __shfl_xor(sq, o);
        __syncthreads();
        if ((tid & 63) == 0) red[tid >> 6] = sq;
        __syncthreads();
        if (tid < 128) { const float var = (red[0] + red[1]) * (1.f / 128.f); const float y = dv * rsqrtf(var + LN_EPS) * mng[h * 128 + tid] * bf2f(zo[t * 512 + h * 128 + tid]);
            uahm[t * 1024 + 512 + h * 128 + tid] = f2bf(y); }
    }
}
__global__ __launch_bounds__(256) void k_h2route(const float* x1, const float* g2, const float* mod, const float* w_rg, const float* b_rg, const float* w_re, const float* b_re, bf16* h2, int* toke, float* tokw) {
    __shared__ float red[4]; __shared__ float lg[36];
    const int t = blockIdx.x, b = t / SEQ, tid = threadIdx.x;
    const float4 xv = ((const float4*)(x1 + (size_t)t * D))[tid];
    float ss = xv.x * xv.x + xv.y * xv.y + xv.z * xv.z + xv.w * xv.w;
    ss = block_sum256(ss, red);
    const float rstd = rsqrtf(ss * (1.f / D) + RMS_EPS);
    const float* sh = mod + b * 6144 + 3072, *sc = mod + b * 6144 + 4096;
    float hv[4]; const float xs[4] = {xv.x, xv.y, xv.z, xv.w};
#pragma unroll
    for (int j = 0; j < 4; ++j) { const int k = tid * 4 + j; hv[j] = xs[j] * rstd * g2[k] * (1.f + sc[k]) + sh[k]; }
    ushort4 o; o.x = f2bf(hv[0]); o.y = f2bf(hv[1]); o.z = f2bf(hv[2]); o.w = f2bf(hv[3]);
    ((ushort4*)(h2 + (size_t)t * D))[tid] = o;
    for (int j = 0; j < 36; ++j) {
        float a = 0.f;
#pragma unroll
        for (int i = 0; i < 4; ++i) { const int k = tid * 4 + i; a += hv[i] * ((j < 4) ? w_rg[k * 4 + j] : w_re[k * 32 + j - 4]); }
        a = block_sum256(a, red);
        if (tid == 0) lg[j] = a + ((j < 4) ? b_rg[j] : b_re[j - 4]);
    }
    __syncthreads();
    if (tid == 0) {
        int gs = 0; float gm = lg[0];
        for (int j = 1; j < 4; ++j) if (lg[j] > gm) { gm = lg[j]; gs = j; }
        float se = 0.f; for (int j = 0; j < 4; ++j) se += __expf(lg[j] - gm);
        const float pg = 1.f / se;
        const float* le = lg + 4 + gs * 8;
        int e0 = 0; float l0 = le[0];
        for (int j = 1; j < 8; ++j) if (le[j] > l0) { l0 = le[j]; e0 = j; }
        int e1 = -1; float l1 = -3.0e38f;
        for (int j = 0; j < 8; ++j) if (j != e0 && le[j] > l1) { l1 = le[j]; e1 = j; }
        const float r = __expf(l1 - l0);
        const float w0 = pg / (1.f + r), w1 = pg * r / (1.f + r);
        toke[t * 2] = gs * 8 + e0; toke[t * 2 + 1] = gs * 8 + e1; tokw[t * 2] = w0; tokw[t * 2 + 1] = w1;
    }
}
__global__ __launch_bounds__(256) void k_lists(const int* toke, const float* tokw, unsigned* cnt, int* listt, float* listw) {
    const int i = blockIdx.x * 256 + threadIdx.x; const int e = toke[i]; const unsigned pos = atomicAdd(cnt + 16 * e, 1u);
    listt[e * 16384 + pos] = i; listw[e * 16384 + pos] = tokw[i];
}
__global__ __launch_bounds__(256) void k_moe(const bf16* h2, const int* toke, const float* tokw, const float* wg, const float* wu, const float* wd, bf16* ys) {
    __shared__ float hs[1024]; __shared__ float hid[512];
    const int a = blockIdx.x, t = a >> 1, tid = threadIdx.x;
    const int e = toke[a]; const float w = tokw[a];
    for (int k = tid; k < 1024; k += 256) hs[k] = bf2f(h2[(size_t)t * 1024 + k]);
    __syncthreads();
    const float* Gp = wg + (size_t)e * 1024 * 512, *U = wu + (size_t)e * 1024 * 512, *Dn = wd + (size_t)e * 512 * 1024;
    float g0 = 0.f, g1 = 0.f, u0 = 0.f, u1 = 0.f;
    for (int k = 0; k < 1024; ++k) { const float hk = hs[k]; g0 += hk * Gp[(size_t)k * 512 + tid]; g1 += hk * Gp[(size_t)k * 512 + 256 + tid]; u0 += hk * U[(size_t)k * 512 + tid]; u1 += hk * U[(size_t)k * 512 + 256 + tid]; }
    hid[tid] = siluf_(g0) * u0; hid[tid + 256] = siluf_(g1) * u1;
    __syncthreads();
    float y[4] = {0.f, 0.f, 0.f, 0.f};
    for (int j = 0; j < 512; ++j) { const float hj = hid[j];
#pragma unroll
        for (int i = 0; i < 4; ++i) y[i] += hj * Dn[(size_t)j * 1024 + tid + 256 * i]; }
#pragma unroll
    for (int i = 0; i < 4; ++i) ys[(size_t)a * 1024 + tid + 256 * i] = f2bf(w * y[i]);
}
__global__ __launch_bounds__(256) void k_final(const float* x1, const bf16* ys, const float* mod, const float* gf, float* out) {
    __shared__ float red[4];
    const int t = blockIdx.x, b = t / SEQ, tid = threadIdx.x;
    const float4 xv = ((const float4*)(x1 + (size_t)t * D))[tid];
    const ushort4 y0 = ((const ushort4*)(ys + (size_t)t * 2048))[tid], y1 = ((const ushort4*)(ys + (size_t)t * 2048 + 1024))[tid];
    const float* gt = mod + b * 6144 + 5120 + tid * 4;
    float v[4];
    v[0] = xv.x + gt[0] * (bf2f(y0.x) + bf2f(y1.x)); v[1] = xv.y + gt[1] * (bf2f(y0.y) + bf2f(y1.y));
    v[2] = xv.z + gt[2] * (bf2f(y0.z) + bf2f(y1.z)); v[3] = xv.w + gt[3] * (bf2f(y0.w) + bf2f(y1.w));
    float ss = v[0] * v[0] + v[1] * v[1] + v[2] * v[2] + v[3] * v[3];
    ss = block_sum256(ss, red);
    const float rstd = rsqrtf(ss * (1.f / D) + RMS_EPS);
    float4 o; o.x = v[0] * rstd * gf[tid * 4]; o.y = v[1] * rstd * gf[tid * 4 + 1]; o.z = v[2] * rstd * gf[tid * 4 + 2]; o.w = v[3] * rstd * gf[tid * 4 + 3];
    ((float4*)(out + (size_t)t * D))[tid] = o;
}
#endif


#ifndef DBG_BENCH
#define DBG_BENCH 0
#endif
#if DBG_BENCH
__global__ void __launch_bounds__(512, 2) k_bench_a(const float* x, float* dummy) {
    extern __shared__ __attribute__((aligned(16))) unsigned char lds_b[];
    const int tid = threadIdx.x, lane = tid & 63, wave = tid >> 6, tile = blockIdx.x;
    f32x4 nx[4][4]; float acc = 0.f;
#pragma unroll
    for (int p = 0; p < 4; ++p)
#pragma unroll
        for (int j = 0; j < 4; ++j) nx[p][j] = *(const f32x4*)(x + ((size_t)tile * 64 + wave + 8 * p) * 1024 + 256 * j + 4 * lane);
#pragma unroll
    for (int r8 = 0; r8 < 8; ++r8) {
        const size_t row = (size_t)tile * 64 + wave + 8 * r8;
#pragma unroll
        for (int j = 0; j < 4; ++j) acc += (nx[r8 & 3][j][0] + nx[r8 & 3][j][1]) + (nx[r8 & 3][j][2] + nx[r8 & 3][j][3]);
        if (r8 + 4 < 8) {
#pragma unroll
            for (int j = 0; j < 4; ++j) nx[r8 & 3][j] = *(const f32x4*)(x + (row + 32) * 1024 + 256 * j + 4 * lane); }
    }
    if (acc == 123.456f) dummy[tid] = acc;
}
__global__ void __launch_bounds__(256) k_bench_b(const float* x, float* dummy) {
    const int tid = threadIdx.x, lane = tid & 63, wave = tid >> 6; const size_t row = (size_t)blockIdx.x * 4 + wave; float acc = 0.f;
#pragma unroll
    for (int j = 0; j < 4; ++j) { const f32x4 v = *(const f32x4*)(x + row * 1024 + 256 * j + 4 * lane); acc += (v[0] + v[1]) + (v[2] + v[3]); }
    if (acc == 123.456f) dummy[tid] = acc;
}
#endif
#if MK_ONE
constexpr int NKERN = 1;
static const void* const mk_kernels[NKERN] = {(const void*)mk_fwd<0, NPHASE>};
#else
constexpr int NKERN = NPHASE;
static const void* const mk_kernels[NKERN] = {(const void*)mk_fwd<0, 1>, (const void*)mk_fwd<1, 2>, (const void*)mk_fwd<2, 3>, (const void*)mk_fwd<3, 4>, (const void*)mk_fwd<4, 5>, (const void*)mk_fwd<5, 6>,
    (const void*)mk_fwd<6, 7>, (const void*)mk_fwd<7, 8>, (const void*)mk_fwd<8, 9>, (const void*)mk_fwd<9, 10>, (const void*)mk_fwd<10, 11>};
#endif
extern "C" void kernel_launch(void* const* d_in, const int* in_sizes, int n_in, void* d_out, int out_size, void* d_ws, size_t ws_size, hipStream_t stream) {
    static int grid = 0;
    if (grid == 0) {
        int dev = 0, cus = 0;
        if (hipGetDevice(&dev) != hipSuccess || hipDeviceGetAttribute(&cus, hipDeviceAttributeMultiprocessorCount, dev) != hipSuccess) { grid = -1; return; }
        for (int k = 0; k < NKERN; ++k) if (hipFuncSetAttribute(mk_kernels[k], hipFuncAttributeMaxDynamicSharedMemorySize, LDS_BYTES) != hipSuccess) { grid = -1; return; }
        int per_cu = 0;
        (void)hipOccupancyMaxActiveBlocksPerMultiprocessor(&per_cu, mk_kernels[0], NTHREADS, LDS_BYTES);
        (void)hipGetLastError();
        grid = (per_cu >= 1) ? cus : -1;
    }
    if (grid < 0) return;
    (void)hipMemsetAsync((char*)d_ws + WS_CTL, 0, CTL_ZERO_BYTES, stream);
    Args a{};
    for (int i = 0; i < 26; ++i) a.in[i] = (const float*)d_in[i];
    a.out = (float*)d_out; a.ws = (unsigned char*)d_ws;
#if MK_ONE
    a.ph_lo = 0; a.ph_hi = NPHASE;
    { void* args[] = {&a}; (void)hipLaunchKernel(mk_kernels[0], dim3(grid), dim3(NTHREADS), args, LDS_BYTES, stream); }
#else
    unsigned char* ws = (unsigned char*)d_ws; float* out = (float*)d_out;
    float* mod = (float*)(ws + WS_MOD); float* gates = (float*)(ws + WS_GATES); int* toke = (int*)(ws + WS_TOKE); float* tokw = (float*)(ws + WS_TOKW);
    bf16* hb = (bf16*)(ws + WS_H); bf16* zu = (bf16*)(ws + WS_ZU); bf16* zq = (bf16*)(ws + WS_ZQ); bf16* zk = (bf16*)(ws + WS_ZK); bf16* zv = (bf16*)(ws + WS_ZV); bf16* zo = (bf16*)(ws + WS_ZO);
    bf16* zga = (bf16*)(ws + WS_ZGA); bf16* zgb = (bf16*)(ws + WS_ZGB); bf16* qc = (bf16*)(ws + WS_QC); bf16* kc = (bf16*)(ws + WS_KC); bf16* uahm = (bf16*)(ws + WS_UAHM);
    bf16* merged = (bf16*)(ws + WS_MERGED); bf16* ys = (bf16*)(ws + WS_YS);
    (void)mod; (void)gates; (void)toke; (void)tokw; (void)hb; (void)zu; (void)zq; (void)zk; (void)zv; (void)zo; (void)zga; (void)zgb; (void)qc; (void)kc; (void)uahm; (void)merged; (void)ys; (void)out;
#ifndef DBG_NPH
#define DBG_NPH NPHASE
#endif
#if DBG_BENCH == 1
    { static bool once = false; if (!once) { (void)hipFuncSetAttribute((const void*)k_bench_a, hipFuncAttributeMaxDynamicSharedMemorySize, LDS_BYTES); once = true; }
      for (int rep = 0; rep < 4; ++rep) hipLaunchKernelGGL(k_bench_a, dim3(256), dim3(512), LDS_BYTES, stream, (const float*)d_in[0], (float*)((char*)d_ws + WS_TOKE)); }
#elif DBG_BENCH == 2
    for (int rep = 0; rep < 4; ++rep) hipLaunchKernelGGL(k_bench_b, dim3(4096), dim3(256), 0, stream, (const float*)d_in[0], (float*)((char*)d_ws + WS_TOKE));
#endif
    for (int ph = 0; ph < DBG_NPH; ++ph) {
        a.ph_lo = ph; a.ph_hi = ph + 1; a.flags = 0;
        bool mk = true;
#if NAIVE_MASK
        const float* const* I = (const float* const*)d_in;
        if ((NAIVE_MASK >> ph) & 1) {
            mk = false;
            switch (ph) {
            case 0: k_mod<<<8 * 6144 / 256, 256, 0, stream>>>(I[1], I[2], I[3], mod); mk = true; break;
            case 1: k_h1<<<T, 256, 0, stream>>>(I[0], I[4], mod, I[5], I[6], hb, gates); break;
            case 2: k_ngemm<NEpi1><<<dim3((DIN + 63) / 64, T / 64), 256, 0, stream>>>(hb, 1024, I[5], DIN, DIN, 1024, NEpi1{out, zq, zk, zv, zo, zga, zgb});
                    k_glu<<<T * 512 / 256, 256, 0, stream>>>(out, zu); a.flags = (DBG_CLS) << 8; mk = (DBG_CLS) != 0;
                    k_fixw1t<<<2048 * 1024 / 256, 256, 0, stream>>>(I[5], (bf16*)(ws + WS_W1T)); break;
            case 3: k_conva<<<T, 256, 0, stream>>>(zu, I[7], I[8], I[9], I[10], uahm); mk = ((NAIVE_MASK >> 4) & 1) ? false : true; break;
            case 4: k_qkconv<<<T, 256, 0, stream>>>(zq, zk, I[12], I[13], qc, kc);
                    k_mlstm_rec<<<BATCH * NH, 256, 0, stream>>>(qc, kc, zv, zo, gates, I[14], uahm); break;
            case 5: k_ngemm<NEpi2a><<<dim3(16, T / 64), 256, 0, stream>>>(uahm, 1024, I[11], 1024, 1024, 512, NEpi2a{out, zga});
                    k_ngemm<NEpi2b><<<dim3(16, T / 64), 256, 0, stream>>>(uahm + 512, 1024, I[15], 1024, 1024, 512, NEpi2b{out, zgb, merged}); break;
            case 6: k_ngemm<NEpi3><<<dim3(16, T / 64), 256, 0, stream>>>(merged, 1024, I[16], 1024, 1024, 1024, NEpi3{I[0], mod, out}); break;
            case 7: k_h2route<<<T, 256, 0, stream>>>(out, I[17], mod, I[18], I[19], I[20], I[21], hb, toke, tokw);
                    k_lists<<<T * 2 / 256, 256, 0, stream>>>(toke, tokw, (unsigned*)(ws + WS_CTL) + CW_CNT, (int*)(ws + WS_LISTT), (float*)(ws + WS_LISTW));
                    a.flags = 1; mk = true; break;
            case 8: break;
            case 9: k_moe<<<T * 2, 256, 0, stream>>>(hb, toke, tokw, I[22], I[23], I[24], (bf16*)(ws + WS_ZU)); break;
            case 10: k_final<<<T, 256, 0, stream>>>(out, (const bf16*)(ws + WS_ZU), mod, I[25], out); break;
            }
        }
#endif
        if (mk) { void* args[] = {&a}; (void)hipLaunchKernel(mk_kernels[ph], dim3(grid), dim3(NTHREADS), args, LDS_BYTES, stream);
            if ((DBG_HREP >> ph) & 1) { if (ph == 7) a.flags |= DBG_F7; if (ph == 1) a.flags |= DBG_F1; (void)hipLaunchKernel(mk_kernels[ph], dim3(grid), dim3(NTHREADS), args, LDS_BYTES, stream); } }
    }
#endif
}
```

```cpp
#include <hip/hip_runtime.h>
#include <stdint.h>
#include <cstdio>

#ifndef MK_ONE
#define MK_ONE 1
#endif
#ifndef NAIVE_MASK
#define NAIVE_MASK 0
#endif
#ifndef DBG_NPH
#define DBG_NPH 11
#endif
#ifndef P1_MFMA
#define P1_MFMA 0
#endif
#if P1_MFMA
#define P1_FN p1_h1_mfma
#else
#define P1_FN p1_h1
#endif
#ifndef XB_EARLY_ACQ
#define XB_EARLY_ACQ 1
#endif
#ifndef USE_XCD_BARRIER
#define USE_XCD_BARRIER 1
#endif
#ifndef DBG_XBAR
#define DBG_XBAR 0
#endif
#ifndef DBG_F4
#define DBG_F4 0
#endif
#ifndef DBG_F1
#define DBG_F1 0
#endif
#ifndef DBG_F7
#define DBG_F7 6
#endif
#ifndef DBG_HREP
#define DBG_HREP 0
#endif
#ifndef DBG_REP
#define DBG_REP 0
#endif
#if DBG_REP
#define REPK(k) for (int _r = 0; _r < 1 + ((DBG_REP >> (k)) & 1); ++_r)
#define REPSYNC() __syncthreads()
#else
#define REPK(k)
#define REPSYNC() do {} while (0)
#endif
#ifndef DBG_CLS
#define DBG_CLS 0
#endif
#ifndef DBG_GATEFIRST
#define DBG_GATEFIRST 0
#endif

typedef unsigned short bf16;
#define DEV __device__ __forceinline__
#define LAS __attribute__((address_space(3)))
typedef short bf16x8 __attribute__((ext_vector_type(8)));
typedef float f32x4 __attribute__((ext_vector_type(4)));
typedef unsigned v4u __attribute__((ext_vector_type(4)));
typedef unsigned v2u __attribute__((ext_vector_type(2)));

constexpr int BATCH = 8, SEQ = 2048, D = 1024, T = BATCH * SEQ;
constexpr int DIN = 5128, NH = 4;
constexpr float RMS_EPS = 1e-6f, LN_EPS = 1e-5f;
constexpr int NWAVES = 8, NTHREADS = 512;

DEV float bf2f(bf16 v) { return __uint_as_float(((unsigned)v) << 16); }
DEV float bflo(unsigned w) { return __uint_as_float(w << 16); }
DEV float bfhi(unsigned w) { return __uint_as_float(w & 0xffff0000u); }
DEV unsigned f2bfu(float f) { unsigned u = __float_as_uint(f); return (u + 0x7fffu + ((u >> 16) & 1u)) >> 16; }
DEV unsigned pk2(float lo, float hi);
DEV bf16 f2bf(float f) { return (bf16)(pk2(f, f) & 0xffffu); }
DEV unsigned pk2(float lo, float hi) { unsigned r; asm volatile("v_cvt_pk_bf16_f32 %0, %1, %2" : "=v"(r) : "v"(lo), "v"(hi)); return r; }
DEV float sigmoidf_(float x) { return __builtin_amdgcn_rcpf(1.f + __expf(-x)); }
DEV float siluf_(float x) { return x * __builtin_amdgcn_rcpf(1.f + __expf(-x)); }
DEV float logsigmoidf_(float x) { return fminf(x, 0.f) - log1pf(__expf(-fabsf(x))); }
template <int CTRL> DEV float dpp0(float v) { return __int_as_float(__builtin_amdgcn_update_dpp(0, __float_as_int(v), CTRL, 0xf, 0xf, true)); }
template <int CTRL> DEV float dppk(float v) { return __int_as_float(__builtin_amdgcn_update_dpp(__float_as_int(v), __float_as_int(v), CTRL, 0xf, 0xf, false)); }
DEV float rdlane(float v, int l) { return __int_as_float(__builtin_amdgcn_readlane(__float_as_int(v), l)); }
DEV float row16_sum(float v) {
    v += dpp0<0xB1>(v); v += dpp0<0x4E>(v); v += dpp0<0x141>(v); v += dpp0<0x140>(v); return v; }
DEV float wave_sum(float v) { v = row16_sum(v); return (rdlane(v, 0) + rdlane(v, 16)) + (rdlane(v, 32) + rdlane(v, 48)); }
DEV float wave_scan_add(float v, int lane) {
    v += dpp0<0x111>(v); v += dpp0<0x112>(v); v += dpp0<0x114>(v); v += dpp0<0x118>(v);
    const float r0 = rdlane(v, 15), r1 = rdlane(v, 31), r2 = rdlane(v, 47);
    return v + ((lane >= 48) ? (r0 + r1) + r2 : (lane >= 32) ? (r0 + r1) : (lane >= 16) ? r0 : 0.f); }
DEV float wave_scan_max(float v, int lane) {
    v = fmaxf(v, dppk<0x111>(v)); v = fmaxf(v, dppk<0x112>(v)); v = fmaxf(v, dppk<0x114>(v)); v = fmaxf(v, dppk<0x118>(v));
    const float r0 = rdlane(v, 15), r1 = rdlane(v, 31), r2 = rdlane(v, 47);
    const float p = (lane >= 48) ? fmaxf(fmaxf(r0, r1), r2) : (lane >= 32) ? fmaxf(r0, r1) : (lane >= 16) ? r0 : -3.0e38f;
    return fmaxf(v, p); }
#define LDS_WAIT() asm volatile("s_waitcnt lgkmcnt(0)" ::: "memory")

constexpr size_t MiB = 1u << 20;
constexpr size_t WS_CTL = 0, CTL_ZERO_BYTES = 65536;
constexpr size_t WS_MOD = 1 * MiB;
constexpr size_t WS_GATES = 1 * MiB + 256 * 1024;
constexpr size_t WS_STSC = 1 * MiB + 768 * 1024;
constexpr size_t WS_RBIAS = 1 * MiB + 800 * 1024;
constexpr size_t WS_WIF = 1 * MiB + 832 * 1024;
constexpr size_t WS_RW = 6 * MiB + 256 * 1024;
constexpr size_t WS_TOKE = 6 * MiB;
constexpr size_t WS_TOKW = 6 * MiB + 128 * 1024;
constexpr size_t WS_LISTT = 2 * MiB;
constexpr size_t WS_LISTW = 4 * MiB;
constexpr size_t WS_W1T = 8 * MiB;
constexpr size_t WS_W2T = 18 * MiB;
constexpr size_t WS_W3T = 20 * MiB;
constexpr size_t WS_STATE = 22 * MiB;
constexpr size_t WS_H = 40 * MiB;
constexpr size_t WS_ZU = 72 * MiB, WS_ZQ = 88 * MiB, WS_ZK = 104 * MiB, WS_ZV = 120 * MiB, WS_ZO = 136 * MiB;
constexpr size_t WS_ZGA = 152 * MiB, WS_ZGB = 184 * MiB;
constexpr size_t WS_UAHM = 216 * MiB;
constexpr size_t WS_MERGED = WS_ZQ;
constexpr size_t WS_WGU = 120 * MiB;
constexpr size_t WS_WD = 184 * MiB;
constexpr size_t WS_ACT = 216 * MiB;
constexpr size_t WS_YS = 40 * MiB;
constexpr size_t WS_QC = WS_H, WS_KC = WS_H + 16 * MiB;
constexpr int CW_BAR = 4096, CW_CNT = 8192, CW_MODCNT = 9216, CW_FLATBAR = 9280;

constexpr int LDS_TAB = 131072;
constexpr int LDS_MISC = 147456;
constexpr int LDS_BYTES = 151552;

struct Args { const float* in[26]; float* out; unsigned char* ws; int ph_lo, ph_hi, flags, pad; };

namespace pg8 {
constexpr int BM = 256, BK = 64, HALF = 128, HTB = HALF * BK * 2, NXCD = 8, WGM = 8;
DEV int lds_byte(int r, int c) { const int st = (r >> 4) * 2 + (c >> 5), rr = r & 15, cc = c & 31, ob = rr * 64 + cc * 2; return st * 1024 + (ob ^ (((ob >> 9) & 1) << 5)); }
DEV void stage_rc(int b, int& R, int& C) { const int st = b / 1024, sb = b % 1024, swz = sb ^ (((sb >> 9) & 1) << 5); R = (st >> 1) * 16 + swz / 64; C = (st & 1) * 32 + (swz % 64) / 2; }
DEV int perm32(int rho) { const int n = rho >> 4, i = rho & 15; return 8 * (i >> 2) + 4 * n + (i & 3); }
DEV unsigned cvt_pk_bf16(float lo, float hi) { unsigned r; asm volatile("v_cvt_pk_bf16_f32 %0, %1, %2" : "=v"(r) : "v"(lo), "v"(hi)); return r; }

struct Unit { int pm, pn; unsigned ak, bk; int slot, valid, arow0; };

struct StaticOrder {
    int nM, nN, nwg, G, c;
    DEV void init(int M, int N, int G_, int c_) { nM = M / BM; nN = N / BM; nwg = nM * nN; G = G_; c = c_; }
    DEV bool tile(int L, int& pm, int& pn) const {
        if (L >= nwg) return false;
        int wgid = L; { const int q = nwg / NXCD, r = nwg % NXCD, xcd = wgid % NXCD, off = wgid / NXCD; wgid = (xcd < r ? xcd * (q + 1) : r * (q + 1) + (xcd - r) * q) + off; }
        const int nig = WGM * nN, gid = wgid / nig, fm = gid * WGM, gsz = (nM - fm) < WGM ? (nM - fm) : WGM;
        pm = fm + ((wgid % nig) % gsz); pn = (wgid % nig) / gsz; return true;
    }
    DEV bool next(int i, Unit& u) const { u.ak = 0; u.bk = 0; u.slot = 0; u.valid = 256; u.arow0 = 0; return tile(i * G + c, u.pm, u.pn); }
};

template <class Prob, class Epi, class Sched, bool ALIGN_EPI, bool SKIP = false>
DEV void gemm_phase(LAS unsigned char* lds, const Prob& P, const Sched& S, const Epi& E, const int K) {
    int tid = threadIdx.x; asm volatile("" : "+v"(tid));
    const int wid = __builtin_amdgcn_readfirstlane(tid >> 6), lane = tid & 63, wr = wid >> 2, wc = wid & 3, fr = lane & 15, fq = lane >> 4;
    const int nt = K / BK;
    int R[2], C[2], Rb[2];
#pragma unroll
    for (int i = 0; i < 2; ++i) { stage_rc(tid * 16 + i * 8192, R[i], C[i]); Rb[i] = Epi::PERM ? ((R[i] & ~31) + perm32(R[i] & 31)) : R[i]; }
    const unsigned kstep = BK * 2;
    const unsigned ldsw = (unsigned)wid * 1024u;
    const int aoff = lds_byte(wr * 64 + fr, fq * 8), boff = lds_byte(wc * 32 + fr, fq * 8);
    const char* const Abase = (const char*)P.A; const char* const Bbase = (const char*)P.B;
#define PG8_SA(b, h) (((b) * 2 + (h)) * HTB)
#define PG8_SB(b, h) ((4 + (b) * 2 + (h)) * HTB)
#define PG8_STAGE(bufoff, base, offs, kb) do { _Pragma("unroll") for (int _i = 0; _i < 2; ++_i) \
        __builtin_amdgcn_global_load_lds((const unsigned*)((base) + (size_t)((offs)[_i] + (kb))), (LAS unsigned*)(lds + (bufoff) + ldsw + _i * 8192), 16, 0, 0); } while (0)
#define PG8_LDA(dst, b, h) do { _Pragma("unroll") for (int m = 0; m < 4; ++m) _Pragma("unroll") for (int k = 0; k < 2; ++k) dst[m][k] = *(const LAS bf16x8*)(lds + PG8_SA(b, h) + aoff + m * 2048 + k * 1024); } while (0)
#define PG8_LDB(dst, b, h) do { _Pragma("unroll") for (int n = 0; n < 2; ++n) _Pragma("unroll") for (int k = 0; k < 2; ++k) dst[n][k] = *(const LAS bf16x8*)(lds + PG8_SB(b, h) + boff + n * 2048 + k * 1024); } while (0)
#define PG8_MMA(ai, bj, At, Bt) do { __builtin_amdgcn_s_setprio(1); _Pragma("unroll") for (int m = 0; m < 4; ++m) _Pragma("unroll") for (int n = 0; n < 2; ++n) _Pragma("unroll") for (int k = 0; k < 2; ++k) \
        acc[ai][bj][m][n] = __builtin_amdgcn_mfma_f32_16x16x32_bf16(Bt[n][k], At[m][k], acc[ai][bj][m][n], 0, 0, 0); __builtin_amdgcn_s_setprio(0); } while (0)
#define PG8_WAIT_V(n) asm volatile("s_waitcnt vmcnt(" #n ")" ::: "memory")
#define PG8_WAIT_L(n) asm volatile("s_waitcnt lgkmcnt(" #n ")" ::: "memory")
#define PG8_BAR __builtin_amdgcn_s_barrier()
#define PG8_SCHED __builtin_amdgcn_sched_barrier(0)
    Unit cur, nxt; int ui = 0;
    if (!S.next(0, cur)) return;
    f32x4 acc[2][2][4][2];
#pragma unroll
    for (int a = 0; a < 2; ++a)
#pragma unroll
        for (int b = 0; b < 2; ++b)
#pragma unroll
            for (int m = 0; m < 4; ++m)
#pragma unroll
                for (int n = 0; n < 2; ++n) acc[a][b][m][n] = (f32x4){0.f, 0.f, 0.f, 0.f};
    bf16x8 At[4][2], B0[2][2], B1[2][2];
    unsigned ca[2][2], cb[2][2], na[2][2], nb[2][2];
    P.aoffs(cur, R, C, ca); P.boffs(cur, Rb, C, cb);
    PG8_STAGE(PG8_SB(0, 0), Bbase, cb[0], 0u); PG8_STAGE(PG8_SB(0, 1), Bbase, cb[1], 0u); PG8_STAGE(PG8_SA(0, 0), Abase, ca[0], 0u); PG8_STAGE(PG8_SA(0, 1), Abase, ca[1], 0u);
    if (wr == 1) PG8_BAR;
    PG8_WAIT_V(2); PG8_BAR;
    PG8_STAGE(PG8_SB(1, 0), Bbase, cb[0], kstep); PG8_STAGE(PG8_SA(1, 0), Abase, ca[0], kstep); PG8_STAGE(PG8_SB(1, 1), Bbase, cb[1], kstep);
    PG8_WAIT_V(6); PG8_BAR;
    for (;;) {
        const bool has_next = S.next(ui + 1, nxt);
        if (has_next) { P.aoffs(nxt, R, C, na); P.boffs(nxt, Rb, C, nb); }
        else {
#pragma unroll
            for (int h = 0; h < 2; ++h)
#pragma unroll
                for (int i = 0; i < 2; ++i) { na[h][i] = ca[h][i]; nb[h][i] = cb[h][i]; } }
        const bool do0 = !(SKIP && cur.valid <= 64 && wr == 1), do1 = !(SKIP && cur.valid <= 128) && do0;
        for (int t = 0; t < nt; t += 2) {
            const bool last = (t == nt - 2);
            const unsigned k1 = (unsigned)(t + 1) * kstep;
            const unsigned kb2 = last ? 0u : (unsigned)(t + 2) * kstep, kb3 = kb2 + kstep;
            unsigned a2[2][2], b2[2][2];
#pragma unroll
            for (int h = 0; h < 2; ++h)
#pragma unroll
                for (int i = 0; i < 2; ++i) { a2[h][i] = last ? na[h][i] : ca[h][i]; b2[h][i] = last ? nb[h][i] : cb[h][i]; }
            PG8_LDB(B0, 0, 0); PG8_LDB(B1, 0, 1); PG8_SCHED; PG8_LDA(At, 0, 0); PG8_STAGE(PG8_SA(1, 1), Abase, ca[1], k1);
            PG8_WAIT_V(8); PG8_WAIT_L(0); PG8_BAR; if (do0) { PG8_MMA(0, 0, At, B0); PG8_MMA(0, 1, At, B1); } PG8_BAR; PG8_SCHED;
            PG8_LDA(At, 0, 1); PG8_STAGE(PG8_SB(0, 0), Bbase, b2[0], kb2); PG8_STAGE(PG8_SB(0, 1), Bbase, b2[1], kb2); PG8_STAGE(PG8_SA(0, 0), Abase, a2[0], kb2);
            PG8_WAIT_V(8); PG8_WAIT_L(0); PG8_BAR; if (do1) { PG8_MMA(1, 0, At, B0); PG8_MMA(1, 1, At, B1); } PG8_BAR; PG8_SCHED;
            PG8_LDB(B0, 1, 0); PG8_LDB(B1, 1, 1); PG8_SCHED; PG8_LDA(At, 1, 0); PG8_STAGE(PG8_SA(0, 1), Abase, a2[1], kb2);
            PG8_WAIT_V(8); PG8_WAIT_L(0); PG8_BAR; if (do0) { PG8_MMA(0, 0, At, B0); PG8_MMA(0, 1, At, B1); } PG8_BAR; PG8_SCHED;
            PG8_LDA(At, 1, 1); PG8_STAGE(PG8_SB(1, 0), Bbase, b2[0], kb3); PG8_STAGE(PG8_SB(1, 1), Bbase, b2[1], kb3); PG8_STAGE(PG8_SA(1, 0), Abase, a2[0], kb3);
            PG8_WAIT_V(8); PG8_WAIT_L(0); PG8_BAR; if (do1) { PG8_MMA(1, 0, At, B0); PG8_MMA(1, 1, At, B1); } PG8_BAR; PG8_SCHED;
        }
        if constexpr (ALIGN_EPI) { if (wr == 0) PG8_BAR; }
        E(acc, cur, wr, wc, fr, fq);
        if (!has_next) break;
        if (!E.keep(cur)) {
#pragma unroll
            for (int a = 0; a < 2; ++a)
#pragma unroll
                for (int b = 0; b < 2; ++b)
#pragma unroll
                    for (int m = 0; m < 4; ++m)
#pragma unroll
                        for (int n = 0; n < 2; ++n) acc[a][b][m][n] = (f32x4){0.f, 0.f, 0.f, 0.f};
        }
        cur = nxt; ++ui;
#pragma unroll
        for (int h = 0; h < 2; ++h)
#pragma unroll
            for (int i = 0; i < 2; ++i) { ca[h][i] = na[h][i]; cb[h][i] = nb[h][i]; }
        if constexpr (ALIGN_EPI) { if (wr == 1) PG8_BAR; }
    }
    PG8_WAIT_V(0);
    if constexpr (!ALIGN_EPI) { if (wr == 0) PG8_BAR; }
    PG8_BAR;
#undef PG8_SA
#undef PG8_SB
#undef PG8_STAGE
#undef PG8_LDA
#undef PG8_LDB
#undef PG8_MMA
#undef PG8_WAIT_V
#undef PG8_WAIT_L
#undef PG8_BAR
#undef PG8_SCHED
}
}
using pg8::Unit;

struct ProbPlain {
    const bf16* A; const bf16* B; unsigned lda2, ldb2;
    DEV void aoffs(const Unit& u, const int (&R)[2], const int (&C)[2], unsigned (&o)[2][2]) const {
#pragma unroll
        for (int h = 0; h < 2; ++h)
#pragma unroll
            for (int i = 0; i < 2; ++i) o[h][i] = (unsigned)(u.pm * 256 + 128 * h + R[i]) * lda2 + (unsigned)C[i] * 2u + u.ak; }
    DEV void boffs(const Unit& u, const int (&Rb)[2], const int (&C)[2], unsigned (&o)[2][2]) const {
#pragma unroll
        for (int h = 0; h < 2; ++h)
#pragma unroll
            for (int i = 0; i < 2; ++i) o[h][i] = (unsigned)(u.pn * 256 + 128 * h + Rb[i]) * ldb2 + (unsigned)C[i] * 2u + u.bk; }
};
struct ProbMoeUp {
    const bf16* A; const bf16* B; const LAS unsigned* rowtab;
    DEV void aoffs(const Unit& u, const int (&R)[2], const int (&C)[2], unsigned (&o)[2][2]) const {
#pragma unroll
        for (int h = 0; h < 2; ++h)
#pragma unroll
            for (int i = 0; i < 2; ++i) o[h][i] = rowtab[u.slot * 256 + 128 * h + R[i]] + (unsigned)C[i] * 2u; }
    DEV void boffs(const Unit& u, const int (&Rb)[2], const int (&C)[2], unsigned (&o)[2][2]) const {
#pragma unroll
        for (int h = 0; h < 2; ++h)
#pragma unroll
            for (int i = 0; i < 2; ++i) o[h][i] = (unsigned)(u.pn * 256 + 128 * h + Rb[i]) * 2048u + (unsigned)C[i] * 2u + u.bk; }
};
struct ProbMoeDown {
    const bf16* A; const bf16* B;
    DEV void aoffs(const Unit& u, const int (&R)[2], const int (&C)[2], unsigned (&o)[2][2]) const {
#pragma unroll
        for (int h = 0; h < 2; ++h)
#pragma unroll
            for (int i = 0; i < 2; ++i) o[h][i] = (unsigned)(u.arow0 + 128 * h + R[i]) * 1024u + (unsigned)C[i] * 2u; }
    DEV void boffs(const Unit& u, const int (&Rb)[2], const int (&C)[2], unsigned (&o)[2][2]) const {
#pragma unroll
        for (int h = 0; h < 2; ++h)
#pragma unroll
            for (int i = 0; i < 2; ++i) o[h][i] = (unsigned)(u.pn * 256 + 128 * h + Rb[i]) * 1024u + (unsigned)C[i] * 2u + u.bk; }
};

DEV void st16_wt(void* p, const v4u v) { asm volatile("global_store_dwordx4 %0, %1, off sc1\n\ts_nop 1" :: "v"(p), "v"(v) : "memory"); }
DEV v4u pack8(const f32x4 v0, const f32x4 v1) { v4u w; w.x = pg8::cvt_pk_bf16(v0[0], v0[1]); w.y = pg8::cvt_pk_bf16(v0[2], v0[3]); w.z = pg8::cvt_pk_bf16(v1[0], v1[1]); w.w = pg8::cvt_pk_bf16(v1[2], v1[3]); return w; }
DEV f32x4 sig4(f32x4 v) { f32x4 o; o[0] = sigmoidf_(v[0]); o[1] = sigmoidf_(v[1]); o[2] = sigmoidf_(v[2]); o[3] = sigmoidf_(v[3]); return o; }
DEV void unpack8(const v4u w, f32x4& lo, f32x4& hi) { lo[0] = bflo(w.x); lo[1] = bfhi(w.x); lo[2] = bflo(w.y); lo[3] = bfhi(w.y); hi[0] = bflo(w.z); hi[1] = bfhi(w.z); hi[2] = bflo(w.w); hi[3] = bfhi(w.w); }

struct Epi1 {
    static constexpr bool PERM = true;
    bf16* zu; bf16* zga; int cls;
    DEV bool keep(const Unit&) const { return false; }
    DEV void operator()(f32x4 (&acc)[2][2][4][2], const Unit& u, int wr, int wc, int fr, int fq) const {
        const int row0 = u.pm * 256 + wr * 64 + fr, cl = wc * 32 + 8 * fq;
        if (cls) { const int c = (u.pn < 4) ? 1 : (u.pn < 12) ? 2 : (u.pn < 16) ? 4 : 8; if (!(cls & c)) return; }
        if (u.pn < 4) {
#pragma unroll
            for (int ai = 0; ai < 2; ++ai)
#pragma unroll
                for (int m = 0; m < 4; ++m) { const size_t row = (size_t)(row0 + ai * 128 + m * 16);
                    const f32x4 v0 = acc[ai][0][m][0] * sig4(acc[ai][1][m][0]), v1 = acc[ai][0][m][1] * sig4(acc[ai][1][m][1]);
                    *(v4u*)(zu + row * 512 + 128 * u.pn + cl) = pack8(v0, v1); }
        } else {
            bf16* base; int ld, colb; bool sg;
            if (u.pn < 12) { const int ti = (u.pn - 4) >> 1; base = zu + (size_t)(1 + ti) * T * 512; ld = 512; colb = 256 * ((u.pn - 4) & 1); sg = (ti == 3); }
            else { const int ti = (u.pn - 12) >> 2; base = zga + (size_t)ti * T * 1024; ld = 1024; colb = 256 * ((u.pn - 12) & 3); sg = true; }
#pragma unroll
            for (int ai = 0; ai < 2; ++ai)
#pragma unroll
                for (int m = 0; m < 4; ++m) { const size_t row = (size_t)(row0 + ai * 128 + m * 16);
#pragma unroll
                    for (int bj = 0; bj < 2; ++bj) { f32x4 v0 = acc[ai][bj][m][0], v1 = acc[ai][bj][m][1]; if (sg) { v0 = sig4(v0); v1 = sig4(v1); }
                        *(v4u*)(base + row * ld + colb + 128 * bj + cl) = pack8(v0, v1); } }
        }
    }
};
struct Epi2 {
    static constexpr bool PERM = true;
    const bf16* zga; const bf16* zgb; bf16* merged;
    DEV bool keep(const Unit& u) const { return u.slot == 0; }
    DEV void operator()(f32x4 (&acc)[2][2][4][2], const Unit& u, int wr, int wc, int fr, int fq) const {
        const int row0 = u.pm * 256 + wr * 64 + fr, c0 = u.pn * 256 + wc * 32 + 8 * fq;
#pragma unroll
        for (int ai = 0; ai < 2; ++ai)
#pragma unroll
            for (int m = 0; m < 4; ++m) { const size_t ro = (size_t)(row0 + ai * 128 + m * 16) * 1024 + c0;
#pragma unroll
                for (int bj = 0; bj < 2; ++bj) {
                    f32x4 b0, b1; unpack8(*(const v4u*)(zgb + ro + 128 * bj), b0, b1);
                    if (u.slot == 0) { f32x4 a0, a1; unpack8(*(const v4u*)(zga + ro + 128 * bj), a0, a1);
#pragma unroll
                        for (int j = 0; j < 4; ++j) { acc[ai][bj][m][0][j] *= a0[j] * __builtin_amdgcn_rcpf(fmaxf(b0[j], 1e-30f)); acc[ai][bj][m][1][j] *= a1[j] * __builtin_amdgcn_rcpf(fmaxf(b1[j], 1e-30f)); }
                    } else { *(v4u*)(merged + ro + 128 * bj) = pack8(acc[ai][bj][m][0] * b0, acc[ai][bj][m][1] * b1); }
                } }
    }
};
struct Epi3 {
    static constexpr bool PERM = false;
    const float* x; const float* mod; float* out;
    DEV bool keep(const Unit&) const { return false; }
    DEV void operator()(f32x4 (&acc)[2][2][4][2], const Unit& u, int wr, int wc, int fr, int fq) const {
        const int row0 = u.pm * 256 + wr * 64 + fr, c0 = u.pn * 256 + wc * 32 + 4 * fq; const int b = u.pm >> 3;
        f32x4 gt[2][2];
#pragma unroll
        for (int bj = 0; bj < 2; ++bj)
#pragma unroll
            for (int n = 0; n < 2; ++n) gt[bj][n] = *(const f32x4*)(mod + b * 6144 + 2048 + c0 + 128 * bj + 16 * n);
#pragma unroll
        for (int ai = 0; ai < 2; ++ai)
#pragma unroll
            for (int m = 0; m < 4; ++m) { const size_t ro = (size_t)(row0 + ai * 128 + m * 16) * 1024 + c0;
#pragma unroll
                for (int bj = 0; bj < 2; ++bj)
#pragma unroll
                    for (int n = 0; n < 2; ++n) { const f32x4 xv = *(const f32x4*)(x + ro + 128 * bj + 16 * n); *(f32x4*)(out + ro + 128 * bj + 16 * n) = xv + gt[bj][n] * acc[ai][bj][m][n]; } }
    }
};
struct EpiUp {
    static constexpr bool PERM = true;
    bf16* act;
    DEV bool keep(const Unit&) const { return false; }
    DEV void operator()(f32x4 (&acc)[2][2][4][2], const Unit& u, int wr, int wc, int fr, int fq) const {
        const int cl = 128 * u.pn + wc * 32 + 8 * fq;
#pragma unroll
        for (int ai = 0; ai < 2; ++ai)
#pragma unroll
            for (int m = 0; m < 4; ++m) { const int rt = ai * 128 + wr * 64 + m * 16 + fr;
                if (rt < u.valid) { f32x4 v0, v1;
#pragma unroll
                    for (int j = 0; j < 4; ++j) { v0[j] = siluf_(acc[ai][0][m][0][j]) * acc[ai][1][m][0][j]; v1[j] = siluf_(acc[ai][0][m][1][j]) * acc[ai][1][m][1][j]; }
                    *(v4u*)(act + (size_t)(u.arow0 + rt) * 512 + cl) = pack8(v0, v1); } }
    }
};
struct EpiDown {
    static constexpr bool PERM = true;
    bf16* ys; const LAS unsigned* desttab; const LAS float* wtab;
    DEV bool keep(const Unit&) const { return false; }
    DEV void operator()(f32x4 (&acc)[2][2][4][2], const Unit& u, int wr, int wc, int fr, int fq) const {
        const int cl = 256 * u.pn + wc * 32 + 8 * fq;
#pragma unroll
        for (int ai = 0; ai < 2; ++ai)
#pragma unroll
            for (int m = 0; m < 4; ++m) { const int rt = ai * 128 + wr * 64 + m * 16 + fr;
                if (rt < u.valid) { const unsigned dest = desttab[u.slot * 256 + rt]; const float w = wtab[u.slot * 256 + rt];
#pragma unroll
                    for (int bj = 0; bj < 2; ++bj) *(v4u*)(ys + (size_t)dest * 1024 + cl + 128 * bj) = pack8(acc[ai][bj][m][0] * w, acc[ai][bj][m][1] * w); } }
    }
};

#define XB_TMO      128
#define XB_XCNT(j)  (256  + 64 * (j))
#define XB_XSUB(j)  (1280 + 64 * (j))
#define XB_XGEN(j)  (2304 + 64 * (j))
#define XB_TOP      3328
#define XB_TOPGEN   3392
#define XCD_BAR_WORDS 3456
#define XB_SPIN_CAP (1u << 18)
__device__ __forceinline__ unsigned xb_ld(unsigned* p)              { return __hip_atomic_load(p, __ATOMIC_RELAXED, __HIP_MEMORY_SCOPE_AGENT); }
__device__ __forceinline__ unsigned xb_add(unsigned* p, unsigned v) { return __hip_atomic_fetch_add(p, v, __ATOMIC_RELAXED, __HIP_MEMORY_SCOPE_AGENT); }
__device__ __forceinline__ unsigned xb_xcc_id() { return (unsigned)__builtin_amdgcn_s_getreg((3 << 11) | 20) & 0xFu; }
#define XB_SPIN(cond, bar) do { unsigned _sp = 0; while (cond) { __builtin_amdgcn_s_sleep(1); \
    if ((++_sp & 255u) == 0u) { if (xb_ld(&(bar)[XB_TMO])) break; if (_sp > XB_SPIN_CAP) { atomicAdd(&(bar)[XB_TMO], 1u); break; } } } } while (0)
struct XcdBarrier { unsigned* bar; unsigned x; volatile LAS unsigned* st; };
__device__ __forceinline__ XcdBarrier xcd_barrier_post(unsigned* bar, volatile LAS unsigned* st) {
    XcdBarrier b; b.bar = bar; b.x = xb_xcc_id(); b.st = st;
    if (threadIdx.x == 0) (void)xb_add(&bar[XB_XCNT(b.x)], 1u);
    return b;
}
__device__ __forceinline__ void xcd_barrier_complete(unsigned* bar, unsigned x, unsigned& nloc, unsigned& nx) {
    const unsigned G = gridDim.x * gridDim.y * gridDim.z;
    unsigned sum, cnt, mine, sp = 0u;
    for (;;) {
        sum = 0u; cnt = 0u; mine = 0u;
#pragma unroll
        for (unsigned j = 0; j < 16; ++j) { const unsigned c = xb_ld(&bar[XB_XCNT(j)]); sum += c; cnt += (c > 0u) ? 1u : 0u; mine = (j == x) ? c : mine; }
        if (sum == G) break;
        __builtin_amdgcn_s_sleep(1);
        if ((++sp & 255u) == 0u) { if (xb_ld(&bar[XB_TMO])) break; if (sp > XB_SPIN_CAP) { atomicAdd(&bar[XB_TMO], 1u); break; } }
    }
    nloc = mine > 0u ? mine : 1u; nx = cnt > 0u ? cnt : 1u;
}
__device__ __forceinline__ void xcd_barrier(const XcdBarrier& b) {
    asm volatile("s_waitcnt vmcnt(0)" ::: "memory");
    __syncthreads();
    if (threadIdx.x == 0) {
        unsigned* bar = b.bar;
        __builtin_amdgcn_s_waitcnt(0);
        unsigned nloc = b.st[0], nx = b.st[1];
        if (nloc == 0u) { xcd_barrier_complete(bar, b.x, nloc, nx); b.st[0] = nloc; b.st[1] = nx; }
        const unsigned old = xb_add(&bar[XB_XSUB(b.x)], 1u);
        const unsigned gen = old / nloc;
        if (old + 1u == (gen + 1u) * nloc) {
            __builtin_amdgcn_fence(__ATOMIC_RELEASE, "agent");
            asm volatile("s_waitcnt vmcnt(0)" ::: "memory");
            const unsigned og = xb_add(&bar[XB_TOP], 1u);
            const unsigned tg = og / nx;
            if (og + 1u == (tg + 1u) * nx) xb_add(&bar[XB_TOPGEN], 1u);
            else XB_SPIN(xb_ld(&bar[XB_TOPGEN]) == tg, bar);
            __builtin_amdgcn_fence(__ATOMIC_ACQUIRE, "agent");
            xb_add(&bar[XB_XGEN(b.x)], 1u);
            asm volatile("s_waitcnt vmcnt(0)" ::: "memory");
        } else {
#if XB_EARLY_ACQ
            __builtin_amdgcn_fence(__ATOMIC_ACQUIRE, "agent");
            XB_SPIN(xb_ld(&bar[XB_XGEN(b.x)]) == gen, bar);
            asm volatile("s_waitcnt vmcnt(0)" ::: "memory");
#else
            XB_SPIN(xb_ld(&bar[XB_XGEN(b.x)]) == gen, bar);
            __builtin_amdgcn_fence(__ATOMIC_ACQUIRE, "agent");
            asm volatile("s_waitcnt vmcnt(0)" ::: "memory");
#endif
        }
    }
    __syncthreads();
}

__device__ __forceinline__ void flat_barrier(unsigned* cnt, unsigned& gen) {
    asm volatile("s_waitcnt vmcnt(0)" ::: "memory");
    __syncthreads();
    ++gen;
    if (threadIdx.x == 0) {
        __builtin_amdgcn_fence(__ATOMIC_RELEASE, "agent");
        asm volatile("s_waitcnt vmcnt(0)" ::: "memory");
        (void)xb_add(cnt, 1u);
        const unsigned want = gen * gridDim.x; unsigned sp = 0;
        while (xb_ld(cnt) < want) { __builtin_amdgcn_s_sleep(1); if (++sp > (1u << 22)) break; }
        __builtin_amdgcn_fence(__ATOMIC_ACQUIRE, "agent");
        asm volatile("s_waitcnt vmcnt(0)" ::: "memory");
    }
    __syncthreads();
}
DEV f32x4 mma16(bf16x8 a, bf16x8 b, f32x4 c) { return __builtin_amdgcn_mfma_f32_16x16x32_bf16(a, b, c, 0, 0, 0); }
DEV void split8(const f32x4 a, const f32x4 b, bf16x8& hi, bf16x8& lo) {
    v4u h, l; const float r[8] = {a[0], a[1], a[2], a[3], b[0], b[1], b[2], b[3]}; unsigned hw[4], lw[4];
#pragma unroll
    for (int i = 0; i < 4; ++i) { hw[i] = pk2(r[2 * i], r[2 * i + 1]); lw[i] = pk2(r[2 * i] - bflo(hw[i]), r[2 * i + 1] - bfhi(hw[i])); }
    h.x = hw[0]; h.y = hw[1]; h.z = hw[2]; h.w = hw[3]; l.x = lw[0]; l.y = lw[1]; l.z = lw[2]; l.w = lw[3];
    hi = __builtin_bit_cast(bf16x8, h); lo = __builtin_bit_cast(bf16x8, l);
}
DEV void transpose_item(const float* src, int ldsrc, bf16* dst, int lddst, LAS float* scr, int lane) {
#pragma unroll 8
    for (int i = 0; i < 32; ++i) { const int kk = 2 * i + (lane >> 5); scr[kk * 33 + (lane & 31)] = src[(size_t)kk * ldsrc + (lane & 31)]; }
    LDS_WAIT(); asm volatile("" ::: "memory");
    const int c = lane & 7;
#pragma unroll
    for (int j = 0; j < 4; ++j) { const int n = (lane >> 3) + 8 * j; const LAS float* s = scr + (8 * c) * 33 + n;
        v4u o; o.x = pk2(s[0 * 33], s[1 * 33]); o.y = pk2(s[2 * 33], s[3 * 33]); o.z = pk2(s[4 * 33], s[5 * 33]); o.w = pk2(s[6 * 33], s[7 * 33]);
        *(v4u*)(dst + (size_t)n * lddst + 8 * c) = o; }
    LDS_WAIT(); asm volatile("" ::: "memory");
}

DEV void p0_prologue(const Args& a, LAS unsigned char* lds, int bid, int G) {
    int tid = threadIdx.x; asm volatile("" : "+v"(tid));
    const int lane = tid & 63, wave = __builtin_amdgcn_readfirstlane(tid >> 6);
    const float* c = a.in[1]; const float* w_ada = a.in[2]; const float* b_ada = a.in[3];
    float* mod = (float*)(a.ws + WS_MOD);
    if (bid < 192) {
        LAS float* sil = (LAS float*)lds;
        LAS float* red = (LAS float*)(lds + 32768);
        for (int i = tid; i < 8192; i += NTHREADS) sil[i] = siluf_(c[i]);
        __syncthreads();
        for (int item = bid; item < 192; item += G) {
            const int n0 = item * 32, lg = lane >> 3, cq = lane & 7;
            float acc[8][4];
#pragma unroll
            for (int b = 0; b < 8; ++b)
#pragma unroll
                for (int j = 0; j < 4; ++j) acc[b][j] = 0.f;
#pragma unroll 4
            for (int j = 0; j < 16; ++j) { const int k = wave * 128 + j * 8 + lg; const f32x4 w = *(const f32x4*)(w_ada + (size_t)k * 6144 + n0 + cq * 4);
#pragma unroll
                for (int b = 0; b < 8; ++b) { const float s = sil[b * 1024 + k]; acc[b][0] += s * w[0]; acc[b][1] += s * w[1]; acc[b][2] += s * w[2]; acc[b][3] += s * w[3]; } }
#pragma unroll
            for (int b = 0; b < 8; ++b)
#pragma unroll
                for (int j = 0; j < 4; ++j) { float v = acc[b][j]; v += dpp0<0x128>(v); if ((lane & 8) == 0) red[(wave * 4 + (lane >> 4)) * 256 + b * 32 + cq * 4 + j] = v; }
            __syncthreads();
            if (tid < 256) { float s = 0.f;
#pragma unroll
                for (int w = 0; w < 32; ++w) s += red[w * 256 + tid];
                const int b = tid >> 5, col = tid & 31; mod[b * 6144 + n0 + col] = s + b_ada[n0 + col]; }
            asm volatile("s_waitcnt vmcnt(0)" ::: "memory");
            __syncthreads();
            if (tid == 0) { __builtin_amdgcn_fence(__ATOMIC_RELEASE, "agent"); asm volatile("s_waitcnt vmcnt(0)" ::: "memory");
                __hip_atomic_fetch_add((unsigned*)(a.ws + WS_CTL) + CW_MODCNT, 1u, __ATOMIC_RELAXED, __HIP_MEMORY_SCOPE_AGENT); }
        }
    }
    if (bid == G - 1) { const float* w_in0 = a.in[5]; float* wif = (float*)(a.ws + WS_WIF);
        for (int i = tid; i < 2048; i += NTHREADS) { const int k = i >> 1, hf = i & 1; *(f32x4*)(wif + k * 8 + 4 * hf) = *(const f32x4*)(w_in0 + (size_t)k * DIN + 3072 + 4 * hf); } }
    LAS float* scr = (LAS float*)(lds + wave * 16384);
    const int gw = bid * NWAVES + wave, NGW = G * NWAVES;
    const float* w_in = a.in[5]; const float* wco = a.in[11]; const float* wmo = a.in[15]; const float* wout = a.in[16];
    bf16* W1T = (bf16*)(a.ws + WS_W1T); bf16* W2T = (bf16*)(a.ws + WS_W2T); bf16* W3T = (bf16*)(a.ws + WS_W3T);
    constexpr int I1 = 16 * 160, I2 = 8 * 32, I3 = 16 * 32, NIT = I1 + 2 * I2 + I3;
    for (int it = gw; it < NIT; it += NGW) {
        int r = it;
        if (r < I1) { const int kb = r / 160, nb = r % 160, np = 32 * nb; int sc;
            if (np < 1024) { const int t = np >> 8, q = np & 255; sc = (q < 128) ? 128 * t + q : 512 + 128 * t + q - 128; } else if (np < 3072) sc = np; else sc = np + 8;
            transpose_item(w_in + (size_t)(64 * kb) * DIN + sc, DIN, W1T + (size_t)np * 1024 + 64 * kb, 1024, scr, lane); continue; }
        r -= I1;
        if (r < I2) { const int kb = r / 32, nb = r % 32; transpose_item(wco + (size_t)(64 * kb) * 1024 + 32 * nb, 1024, W2T + (size_t)(32 * nb) * 1024 + 64 * kb, 1024, scr, lane); continue; }
        r -= I2;
        if (r < I2) { const int kb = r / 32, nb = r % 32; transpose_item(wmo + (size_t)(64 * kb) * 1024 + 32 * nb, 1024, W2T + (size_t)(32 * nb) * 1024 + 512 + 64 * kb, 1024, scr, lane); continue; }
        r -= I2;
        { const int kb = r / 32, nb = r % 32; transpose_item(wout + (size_t)(64 * kb) * 1024 + 32 * nb, 1024, W3T + (size_t)(32 * nb) * 1024 + 64 * kb, 1024, scr, lane); }
    }
}

DEV void p1_h1(const Args& a, LAS unsigned char* lds, int bid, int G) {
    int tid = threadIdx.x; asm volatile("" : "+v"(tid));
    const int lane = tid & 63, wave = __builtin_amdgcn_readfirstlane(tid >> 6);
    if (tid == 0) {
        unsigned* mc = (unsigned*)(a.ws + WS_CTL) + CW_MODCNT; unsigned sp = 0;
        while (__hip_atomic_load(mc, __ATOMIC_RELAXED, __HIP_MEMORY_SCOPE_AGENT) < 192u) { __builtin_amdgcn_s_sleep(2); if (++sp > (1u << 22)) break; }
        __builtin_amdgcn_fence(__ATOMIC_ACQUIRE, "agent"); asm volatile("s_waitcnt vmcnt(0)" ::: "memory"); }
    __syncthreads();
    const float* x = a.in[0]; const float* g1 = a.in[4]; const float* w_in = a.in[5]; const float* b_if = a.in[6];
    const float* mod = (const float*)(a.ws + WS_MOD); bf16* h1 = (bf16*)(a.ws + WS_H); float* gates = (float*)(a.ws + WS_GATES);
    LAS float* tab = (LAS float*)lds;
    for (int k = tid; k < 1024; k += NTHREADS) { const int p = ((k >> 8) << 2) | (k & 3), l = (k >> 2) & 63;
        const f32x4 w0 = *(const f32x4*)(w_in + (size_t)k * DIN + 3072), w1 = *(const f32x4*)(w_in + (size_t)k * DIN + 3076);
        *(LAS f32x4*)(tab + (p * 64 + l) * 8) = w0; *(LAS f32x4*)(tab + (p * 64 + l) * 8 + 4) = w1; }
    __syncthreads();
    {
        const float* g2 = a.in[17]; const float* w_rg = a.in[18]; const float* b_rg = a.in[19]; const float* w_re = a.in[20]; const float* b_re = a.in[21];
        float* rbias = (float*)(a.ws + WS_RBIAS); v4u* rw = (v4u*)(a.ws + WS_RW);
        const int gw = bid * NWAVES + wave, NGW = G * NWAVES;
        for (int it = gw; it < 8 * 36; it += NGW) { const int b = it / 36, n = it % 36; float sacc = 0.f;
#pragma unroll
            for (int i = 0; i < 16; ++i) { const int k = lane + 64 * i; const float w = (n < 4) ? w_rg[k * 4 + n] : w_re[k * 32 + n - 4]; sacc += mod[b * 6144 + 3072 + k] * w; }
            sacc = wave_sum(sacc);
            if (lane == 0) rbias[b * 48 + n] = sacc + ((n < 4) ? b_rg[n] : b_re[n - 4]); }
        for (int it = gw; it < 8 * 8 * 4 * 3; it += NGW) {
            const int nt = it % 3, kk = (it / 3) & 3, w8 = (it / 12) & 7, b = it / 96;
            const int n = 16 * nt + (lane & 15), k0 = 128 * w8 + 32 * kk + 8 * (lane >> 4);
            f32x4 w0, w1;
#pragma unroll
            for (int j = 0; j < 8; ++j) { const int k = k0 + j; const float* wp = (n < 4) ? (w_rg + k * 4 + n) : (w_re + k * 32 + ((n < 36) ? n - 4 : 0));
                float w = *wp; w = (n < 36) ? w : 0.f;
                w *= g2[k] * (1.f + mod[b * 6144 + 4096 + k]); if (j < 4) w0[j] = w; else w1[j - 4] = w; }
            bf16x8 hi, lo; split8(w0, w1, hi, lo);
            rw[((size_t)it * 2) * 64 + lane] = __builtin_bit_cast(v4u, hi); rw[((size_t)it * 2 + 1) * 64 + lane] = __builtin_bit_cast(v4u, lo);
        }
    }
    const float bifv = b_if[lane & 7];
    for (int tile = bid; tile < T / 64; tile += G) {
        const int b = tile / 32;
        float sc[4][4], sh[4][4];
#pragma unroll
        for (int j = 0; j < 4; ++j) { const int k = 256 * j + 4 * lane; const f32x4 gv = *(const f32x4*)(g1 + k), sv = *(const f32x4*)(mod + b * 6144 + 1024 + k), hv = *(const f32x4*)(mod + b * 6144 + k);
#pragma unroll
            for (int i = 0; i < 4; ++i) { sc[j][i] = gv[i] * (1.f + sv[i]); sh[j][i] = hv[i]; } }
        f32x4 xr[2][4];
#pragma unroll
        for (int p = 0; p < 2; ++p)
#pragma unroll
            for (int j = 0; j < 4; ++j) xr[p][j] = *(const f32x4*)(x + ((size_t)tile * 64 + wave + 8 * p) * 1024 + 256 * j + 4 * lane);
#pragma unroll 1
        for (int gq = 0; gq < 4; ++gq) {
            float rstd[2];
#pragma unroll
            for (int p = 0; p < 2; ++p) { float ss = 0.f;
#pragma unroll
                for (int j = 0; j < 4; ++j) { const f32x4 v = xr[p][j]; ss += (v[0] * v[0] + v[1] * v[1]) + (v[2] * v[2] + v[3] * v[3]); }
                rstd[p] = rsqrtf(wave_sum(ss) * (1.f / 1024.f) + RMS_EPS); }
            float g[2][8];
#pragma unroll
            for (int p = 0; p < 2; ++p)
#pragma unroll
                for (int q = 0; q < 8; ++q) g[p][q] = 0.f;
#pragma unroll
            for (int j = 0; j < 4; ++j) {
                float hh[2][4];
#pragma unroll
                for (int p = 0; p < 2; ++p) { const f32x4 v = xr[p][j]; const size_t row = (size_t)tile * 64 + wave + 8 * (2 * gq + p);
#pragma unroll
                    for (int i = 0; i < 4; ++i) hh[p][i] = v[i] * rstd[p] * sc[j][i] + sh[j][i];
                    if (gq < 3) xr[p][j] = *(const f32x4*)(x + (row + 16) * 1024 + 256 * j + 4 * lane);
                    v2u o; o.x = pk2(hh[p][0], hh[p][1]); o.y = pk2(hh[p][2], hh[p][3]);
                    *(v2u*)(h1 + row * 1024 + 256 * j + 4 * lane) = o; }
#pragma unroll
                for (int i = 0; i < 4; ++i) { const LAS float* tp = tab + ((4 * j + i) * 64 + lane) * 8; const f32x4 w0 = *(const LAS f32x4*)tp, w1 = *(const LAS f32x4*)(tp + 4);
#pragma unroll
                    for (int p = 0; p < 2; ++p) { const float hv = hh[p][i];
                        g[p][0] += hv * w0[0]; g[p][1] += hv * w0[1]; g[p][2] += hv * w0[2]; g[p][3] += hv * w0[3]; g[p][4] += hv * w1[0]; g[p][5] += hv * w1[1]; g[p][6] += hv * w1[2]; g[p][7] += hv * w1[3]; } }
            }
#pragma unroll
            for (int p = 0; p < 2; ++p) { const size_t row = (size_t)tile * 64 + wave + 8 * (2 * gq + p); float mine = 0.f;
#pragma unroll
                for (int q = 0; q < 8; ++q) { const float sq = wave_sum(g[p][q]); mine = (lane == q) ? sq : mine; }
                if (lane < 8) { const float vv = mine + bifv; gates[row * 8 + lane] = (lane < 4) ? vv : logsigmoidf_(vv); } }
        }
    }
}

DEV void p1_h1_mfma(const Args& a, LAS unsigned char* lds, int bid, int G) {
    int tid = threadIdx.x; asm volatile("" : "+v"(tid));
    const int lane = tid & 63, wave = __builtin_amdgcn_readfirstlane(tid >> 6), l15 = lane & 15, q4 = lane >> 4;
    if (tid == 0) {
        unsigned* mc = (unsigned*)(a.ws + WS_CTL) + CW_MODCNT; unsigned sp = 0;
        while (__hip_atomic_load(mc, __ATOMIC_RELAXED, __HIP_MEMORY_SCOPE_AGENT) < 192u) { __builtin_amdgcn_s_sleep(2); if (++sp > (1u << 22)) break; }
        __builtin_amdgcn_fence(__ATOMIC_ACQUIRE, "agent"); asm volatile("s_waitcnt vmcnt(0)" ::: "memory"); }
    __syncthreads();
    const float* x = a.in[0]; const float* g1 = a.in[4]; const float* b_if = a.in[6];
    const float* mod = (const float*)(a.ws + WS_MOD); bf16* h1 = (bf16*)(a.ws + WS_H); float* gates = (float*)(a.ws + WS_GATES);
    LAS float* PL = (LAS float*)lds;
    LAS float* SS = (LAS float*)(lds + 32768);
    LAS float* RS = (LAS float*)(lds + 34816);
    LAS float* GB = (LAS float*)(lds + 35072);
    LAS float* WF = (LAS float*)(lds + 36864);
    { const float* wif = (const float*)(a.ws + WS_WIF); for (int i = tid; i < 2048; i += NTHREADS) *(LAS f32x4*)(WF + 4 * i) = *(const f32x4*)(wif + 4 * i); }
    {
        const float* g2 = a.in[17]; const float* w_rg = a.in[18]; const float* b_rg = a.in[19]; const float* w_re = a.in[20]; const float* b_re = a.in[21];
        float* rbias = (float*)(a.ws + WS_RBIAS); v4u* rw = (v4u*)(a.ws + WS_RW);
        const int gw = bid * NWAVES + wave, NGW = G * NWAVES;
        for (int it = gw; it < 8 * 36; it += NGW) { const int b = it / 36, n = it % 36; float sacc = 0.f;
#pragma unroll
            for (int i = 0; i < 16; ++i) { const int k = lane + 64 * i; const float w = (n < 4) ? w_rg[k * 4 + n] : w_re[k * 32 + n - 4]; sacc += mod[b * 6144 + 3072 + k] * w; }
            sacc = wave_sum(sacc);
            if (lane == 0) rbias[b * 48 + n] = sacc + ((n < 4) ? b_rg[n] : b_re[n - 4]); }
        for (int it = gw; it < 8 * 8 * 4 * 3; it += NGW) {
            const int nt = it % 3, kk = (it / 3) & 3, w8 = (it / 12) & 7, b = it / 96;
            const int n = 16 * nt + (lane & 15), k0 = 128 * w8 + 32 * kk + 8 * (lane >> 4);
            f32x4 w0, w1;
#pragma unroll
            for (int j = 0; j < 8; ++j) { const int k = k0 + j; const float* wp = (n < 4) ? (w_rg + k * 4 + n) : (w_re + k * 32 + ((n < 36) ? n - 4 : 0));
                float w = *wp; w = (n < 36) ? w : 0.f;
                w *= g2[k] * (1.f + mod[b * 6144 + 4096 + k]); if (j < 4) w0[j] = w; else w1[j - 4] = w; }
            bf16x8 hi, lo; split8(w0, w1, hi, lo);
            rw[((size_t)it * 2) * 64 + lane] = __builtin_bit_cast(v4u, hi); rw[((size_t)it * 2 + 1) * 64 + lane] = __builtin_bit_cast(v4u, lo);
        }
    }
    for (int tile = bid; tile < T / 64; tile += G) {
        const int b = tile / 32, ncol = (l15 < 8) ? l15 : 0;
        __syncthreads();
        {
            float sacc = 0.f;
#pragma unroll
            for (int i = 0; i < 16; ++i) { const int k = lane + 64 * i; sacc += mod[b * 6144 + k] * WF[k * 8 + wave]; }
            sacc = wave_sum(sacc);
            if (lane == 0) GB[wave] = sacc + b_if[wave];
        }
        f32x4 acc[4]; float ss[4];
#pragma unroll
        for (int rt = 0; rt < 4; ++rt) { ss[rt] = 0.f; acc[rt] = (f32x4){0.f, 0.f, 0.f, 0.f}; }
#pragma unroll
        for (int kk = 0; kk < 4; ++kk) {
            const int k0 = 128 * wave + 32 * kk + 8 * q4;
            bf16x8 bhi, blo;
            { const f32x4 ga = *(const f32x4*)(g1 + k0), gb = *(const f32x4*)(g1 + k0 + 4), sa = *(const f32x4*)(mod + b * 6144 + 1024 + k0), sb = *(const f32x4*)(mod + b * 6144 + 1024 + k0 + 4);
                f32x4 w0, w1;
#pragma unroll
                for (int jj = 0; jj < 4; ++jj) { float wa = WF[(k0 + jj) * 8 + ncol], wb = WF[(k0 + 4 + jj) * 8 + ncol];
                    wa = (l15 < 8) ? wa : 0.f; wb = (l15 < 8) ? wb : 0.f; w0[jj] = wa * ga[jj] * (1.f + sa[jj]); w1[jj] = wb * gb[jj] * (1.f + sb[jj]); }
                split8(w0, w1, bhi, blo); }
#pragma unroll
            for (int rt = 0; rt < 4; ++rt) {
                const float* xp = x + ((size_t)tile * 64 + 16 * rt + l15) * 1024 + k0;
                const f32x4 xa = *(const f32x4*)xp, xb = *(const f32x4*)(xp + 4);
                ss[rt] += (xa[0] * xa[0] + xa[1] * xa[1]) + (xa[2] * xa[2] + xa[3] * xa[3]) + (xb[0] * xb[0] + xb[1] * xb[1]) + (xb[2] * xb[2] + xb[3] * xb[3]);
                bf16x8 ahi, alo; split8(xa, xb, ahi, alo);
                acc[rt] = mma16(ahi, bhi, acc[rt]); acc[rt] = mma16(alo, bhi, acc[rt]); acc[rt] = mma16(ahi, blo, acc[rt]);
            }
        }
#pragma unroll
        for (int rt = 0; rt < 4; ++rt) {
            float sv = ss[rt]; sv += __shfl_xor(sv, 16); sv += __shfl_xor(sv, 32);
            if (q4 == 0) SS[wave * 64 + 16 * rt + l15] = sv;
#pragma unroll
            for (int r = 0; r < 4; ++r) PL[(wave * 64 + 16 * rt + 4 * q4 + r) * 16 + l15] = acc[rt][r];
        }
        __syncthreads();
        {
            const int row = tid >> 3, n = tid & 7; float ssum = 0.f, sg = 0.f;
#pragma unroll
            for (int w = 0; w < 8; ++w) { ssum += SS[w * 64 + row]; sg += PL[(w * 64 + row) * 16 + n]; }
            const float rstd = rsqrtf(ssum * (1.f / 1024.f) + RMS_EPS);
            if (n == 0) RS[row] = rstd;
            const float vv = rstd * sg + GB[n];
            gates[((size_t)tile * 64 + row) * 8 + n] = (n < 4) ? vv : logsigmoidf_(vv);
        }
        __syncthreads();
        {
            float sc[4][4], sh[4][4];
#pragma unroll
            for (int j = 0; j < 4; ++j) { const int k = 256 * j + 4 * lane; const f32x4 gv = *(const f32x4*)(g1 + k), sv = *(const f32x4*)(mod + b * 6144 + 1024 + k), hv = *(const f32x4*)(mod + b * 6144 + k);
#pragma unroll
                for (int i = 0; i < 4; ++i) { sc[j][i] = gv[i] * (1.f + sv[i]); sh[j][i] = hv[i]; } }
            f32x4 nx[4][4];
#pragma unroll
            for (int p = 0; p < 4; ++p)
#pragma unroll
                for (int j = 0; j < 4; ++j) nx[p][j] = *(const f32x4*)(x + ((size_t)tile * 64 + wave + 8 * p) * 1024 + 256 * j + 4 * lane);
#pragma unroll
            for (int r8 = 0; r8 < 8; ++r8) {
                const int r = wave + 8 * r8; const size_t row = (size_t)tile * 64 + r;
                f32x4 v[4];
#pragma unroll
                for (int j = 0; j < 4; ++j) v[j] = nx[r8 & 3][j];
                if (r8 + 4 < 8) {
#pragma unroll
                    for (int j = 0; j < 4; ++j) nx[r8 & 3][j] = *(const f32x4*)(x + (row + 32) * 1024 + 256 * j + 4 * lane); }
                asm volatile("" ::: "memory");
                const float rstd = RS[r];
#pragma unroll
                for (int j = 0; j < 4; ++j) { v2u o; o.x = pk2(v[j][0] * rstd * sc[j][0] + sh[j][0], v[j][1] * rstd * sc[j][1] + sh[j][1]); o.y = pk2(v[j][2] * rstd * sc[j][2] + sh[j][2], v[j][3] * rstd * sc[j][3] + sh[j][3]);
                    *(v2u*)(h1 + row * 1024 + 256 * j + 4 * lane) = o; }
            }
        }
    }
    __syncthreads();
}

DEV void p3_conva(const Args& a, LAS unsigned char* lds, int bid, int G) {
    int tid = threadIdx.x; asm volatile("" : "+v"(tid));
    const int lane = tid & 63, wave = __builtin_amdgcn_readfirstlane(tid >> 6), sub = wave & 3, gsel = wave >> 2;
    const bf16* zu = (const bf16*)(a.ws + WS_ZU); bf16* uahm = (bf16*)(a.ws + WS_UAHM);
    const float* cw = a.in[7]; const float* cb = a.in[8]; const float* lg = a.in[9]; const float* lb = a.in[10];
    LAS float* red = (LAS float*)(lds + LDS_TAB);
    const int c0 = 128 * sub + 2 * lane;
    float w0[31], w1[31];
#pragma unroll
    for (int k = 0; k < 31; ++k) { w0[k] = cw[k * 512 + c0]; w1[k] = cw[k * 512 + c0 + 1]; }
    const float bias0 = cb[c0], bias1 = cb[c0 + 1], lg0 = lg[c0], lg1 = lg[c0 + 1], lb0 = lb[c0], lb1 = lb[c0 + 1];
    for (int it = bid; it < T / 32; it += G) {
        const int grp = it * 2 + gsel, tbase = grp * 16, s0 = tbase & (SEQ - 1);
        float acc0[16], acc1[16];
#pragma unroll
        for (int i = 0; i < 16; ++i) { acc0[i] = bias0; acc1[i] = bias1; }
#pragma unroll
        for (int r = 0; r < 46; ++r) {
            const int sp = s0 - 30 + r; const int src = tbase - 30 + r + ((sp < 0) ? -sp : 0); const float msk = (sp < 0) ? 0.f : 1.f;
            const unsigned wv = *(const unsigned*)(zu + (size_t)src * 512 + c0);
            const float u0 = bflo(wv) * msk, u1 = bfhi(wv) * msk;
#pragma unroll
            for (int i = 0; i < 16; ++i) { const int k = r - i; if (k >= 0 && k <= 30) { acc0[i] += w0[k] * u0; acc1[i] += w1[k] * u1; } }
        }
        float mean[16];
#pragma unroll
        for (int i = 0; i < 16; ++i) { const float s = wave_sum(acc0[i] + acc1[i]); if (lane == 0) red[(gsel * 4 + sub) * 16 + i] = s; }
        __syncthreads();
#pragma unroll
        for (int i = 0; i < 16; ++i) mean[i] = ((red[(gsel * 4 + 0) * 16 + i] + red[(gsel * 4 + 1) * 16 + i]) + (red[(gsel * 4 + 2) * 16 + i] + red[(gsel * 4 + 3) * 16 + i])) * (1.f / 512.f);
        __syncthreads();
#pragma unroll
        for (int i = 0; i < 16; ++i) { const float d0 = acc0[i] - mean[i], d1 = acc1[i] - mean[i]; const float s = wave_sum(d0 * d0 + d1 * d1); if (lane == 0) red[(gsel * 4 + sub) * 16 + i] = s; }
        __syncthreads();
#pragma unroll
        for (int i = 0; i < 16; ++i) {
            const float var = ((red[(gsel * 4 + 0) * 16 + i] + red[(gsel * 4 + 1) * 16 + i]) + (red[(gsel * 4 + 2) * 16 + i] + red[(gsel * 4 + 3) * 16 + i])) * (1.f / 512.f);
            const float rstd = rsqrtf(var + LN_EPS);
            const float y0 = (acc0[i] - mean[i]) * rstd * lg0 + lb0, y1 = (acc1[i] - mean[i]) * rstd * lg1 + lb1;
            *(unsigned*)(uahm + (size_t)(tbase + i) * 1024 + c0) = pk2(siluf_(y0), siluf_(y1));
        }
        __syncthreads();
    }
}

constexpr int ML_QS = 0, ML_KS = 17408, ML_KWT = 34816, ML_VT = 53248, ML_PS = 73984, ML_CT = 83200, ML_GT = 122368, ML_CW = 123648, ML_DEN = 128768, ML_PART = 129024, ML_VS = 130048;
template <bool OUT>
DEV void mlstm_unit(const Args& a, LAS unsigned char* lds, int unit) {
    int tid = threadIdx.x; asm volatile("" : "+v"(tid));
    const int lane = tid & 63, wave = __builtin_amdgcn_readfirstlane(tid >> 6), l15 = lane & 15, q4 = lane >> 4;
    const int j = unit & 7, bh = unit >> 3, h = bh & 3, b = bh >> 2, t0 = b * SEQ + 256 * j;
    const bf16* zq = (const bf16*)(a.ws + WS_ZQ); const bf16* zk = (const bf16*)(a.ws + WS_ZK); const bf16* zv = (const bf16*)(a.ws + WS_ZV); const bf16* zo = (const bf16*)(a.ws + WS_ZO);
    const float* gates = (const float*)(a.ws + WS_GATES); float* state = (float*)(a.ws + WS_STATE); float* stsc = (float*)(a.ws + WS_STSC);
    bf16* uahm = (bf16*)(a.ws + WS_UAHM); const float* qkw = a.in[12]; const float* qkb = a.in[13]; const float* mng = a.in[14];
    LAS bf16* QS = (LAS bf16*)(lds + ML_QS); LAS bf16* KS = (LAS bf16*)(lds + ML_KS); LAS bf16* KWT = (LAS bf16*)(lds + ML_KWT); LAS bf16* VT = (LAS bf16*)(lds + ML_VT);
    LAS bf16* PS = (LAS bf16*)(lds + ML_PS); LAS bf16* CT = (LAS bf16*)(lds + ML_CT); LAS bf16* VS = (LAS bf16*)(lds + ML_VS);
    LAS float* GTwk = (LAS float*)(lds + ML_GT); LAS float* GTsi = GTwk + 64; LAS float* GTlb = GTwk + 128; LAS float* GTg = GTwk + 192; LAS float* GTM = GTwk + 256;
    LAS float* CW = (LAS float*)(lds + ML_CW); LAS float* DEN = (LAS float*)(lds + ML_DEN); LAS float* PART = (LAS float*)(lds + ML_PART);
    __syncthreads();
    for (int i = tid; i < 1280; i += NTHREADS) {
        const float* p = (i < 512) ? (qkw + (i >> 7) * 1024 + h * 128 + (i & 127)) : (i < 1024) ? (qkw + ((i - 512) >> 7) * 1024 + 512 + h * 128 + (i & 127))
                       : (i < 1152) ? (qkb + h * 128 + (i - 1024)) : (qkb + 512 + h * 128 + (i - 1152));
        CW[i] = *p; }
    for (int i = tid; i < 16 * 72; i += NTHREADS) VT[128 * 72 + i] = (i < 64) ? (bf16)0x3F80 : (bf16)0;
    f32x4 accC[9];
#pragma unroll
    for (int i = 0; i < 9; ++i) accC[i] = (f32x4){0.f, 0.f, 0.f, 0.f};
    float mc = OUT ? 0.f : -1e30f, Btot = 0.f;
    if (OUT) {
        float wgt[7];
        {
            const int base = unit - j; float mi[7], Bi[7];
#pragma unroll
            for (int i = 0; i < 7; ++i) { const int u2 = base + ((i < j) ? i : 0); mi[i] = stsc[u2 * 4]; Bi[i] = stsc[u2 * 4 + 1]; }
#pragma unroll
            for (int i = 0; i < 7; ++i) if (i < j) mc = fmaxf(Bi[i] + mc, mi[i]);
            float suf = 0.f;
#pragma unroll
            for (int i = 6; i >= 0; --i) { wgt[i] = (i < j) ? __expf(mi[i] + suf - mc) : 0.f; if (i < j) suf += Bi[i]; }
        }
#pragma unroll
        for (int ii = 0; ii < 9; ++ii) {
            f32x4 ld[7];
#pragma unroll
            for (int i = 0; i < 7; ++i) { const size_t u2 = (size_t)(unit - j + ((i < j) ? i : 0));
#pragma unroll
                for (int r = 0; r < 4; ++r) ld[i][r] = state[(u2 * 36 + ii * 4 + r) * 512 + tid]; }
#pragma unroll
            for (int i = 0; i < 7; ++i) accC[ii] = accC[ii] + ld[i] * wgt[i];
        }
#pragma unroll
        for (int ii = 0; ii < 9; ++ii)
#pragma unroll
            for (int r = 0; r < 4; ++r) CT[(16 * ii + 4 * q4 + r) * 136 + 16 * wave + l15] = f2bf(accC[ii][r]);
    }
    float mg[4];
    if (OUT) {
#pragma unroll
        for (int i = 0; i < 4; ++i) mg[i] = mng[h * 128 + 16 * (4 * (wave & 1) + i) + l15];
    }
    __syncthreads();
    float li_n = gates[(size_t)(t0 + lane) * 8 + h], lf_n = gates[(size_t)(t0 + lane) * 8 + 4 + h];
    const int ncc = (OUT && (a.flags & 4096)) ? 1 : 4;
    for (int cc = 0; cc < ncc; ++cc) {
        const int tc = t0 + 64 * cc;
        const float li = li_n, lf = lf_n;
        if (cc < 3) { li_n = gates[(size_t)(tc + 64 + lane) * 8 + h]; lf_n = gates[(size_t)(tc + 64 + lane) * 8 + 4 + h]; }
        const float bc = wave_scan_add(lf, lane);
        const float g = li - bc;
        const float cm = wave_scan_max(g, lane);
        const float M = fmaxf(mc, cm);
        const float M63 = rdlane(M, 63), blast = rdlane(bc, 63);
        const float wkv = __expf(g - M63), sc = __expf(mc - M63), mnew = blast + M63;
        if (wave == 0) { GTwk[lane] = wkv; GTsi[lane] = __expf(mc - M); GTlb[lane] = __expf(-(bc + M)); GTg[lane] = g; GTM[lane] = M; }
        {
            const int cg = tid & 15, rp = tid >> 4, s0 = 2 * rp;
            v4u kraw[5], qraw[5], vraw[2];
#pragma unroll
            for (int m = 0; m < 5; ++m) { const int spos = 256 * j + 64 * cc + s0 - 3 + m; const bool ok = spos >= 0; const int src = ok ? (tc + s0 - 3 + m) : tc;
                kraw[m] = *(const v4u*)(zk + (size_t)src * 512 + h * 128 + cg * 8); }
#pragma unroll
            for (int rr = 0; rr < 2; ++rr) vraw[rr] = *(const v4u*)(zv + (size_t)(tc + s0 + rr) * 512 + h * 128 + cg * 8);
#define ML_CONV(RAW, WOFF, BOFF, DST, SCALE) do { float ac[2][8]; \
            _Pragma("unroll") for (int e = 0; e < 8; ++e) { ac[0][e] = ac[1][e] = CW[(BOFF) + cg * 8 + e]; } \
            _Pragma("unroll") for (int m = 0; m < 5; ++m) { const v4u rw_ = RAW[m]; const float ms = (256 * j + 64 * cc + s0 - 3 + m >= 0) ? 1.f : 0.f; \
                const float xv[8] = {bflo(rw_.x) * ms, bfhi(rw_.x) * ms, bflo(rw_.y) * ms, bfhi(rw_.y) * ms, bflo(rw_.z) * ms, bfhi(rw_.z) * ms, bflo(rw_.w) * ms, bfhi(rw_.w) * ms}; \
                _Pragma("unroll") for (int rr = 0; rr < 2; ++rr) { const int tap = m - rr; if (tap >= 0 && tap < 4) { \
                    _Pragma("unroll") for (int e = 0; e < 8; ++e) ac[rr][e] += CW[(WOFF) + tap * 128 + cg * 8 + e] * xv[e]; } } } \
            _Pragma("unroll") for (int rr = 0; rr < 2; ++rr) { v4u o; \
                o.x = pk2(siluf_(ac[rr][0]) * (SCALE), siluf_(ac[rr][1]) * (SCALE)); o.y = pk2(siluf_(ac[rr][2]) * (SCALE), siluf_(ac[rr][3]) * (SCALE)); \
                o.z = pk2(siluf_(ac[rr][4]) * (SCALE), siluf_(ac[rr][5]) * (SCALE)); o.w = pk2(siluf_(ac[rr][6]) * (SCALE), siluf_(ac[rr][7]) * (SCALE)); \
                *(LAS v4u*)((DST) + (s0 + rr) * 136 + cg * 8) = o; } } while (0)
            if (OUT) {
#pragma unroll
                for (int m = 0; m < 5; ++m) { const int spos = 256 * j + 64 * cc + s0 - 3 + m; const int src = (spos >= 0) ? (tc + s0 - 3 + m) : tc; qraw[m] = *(const v4u*)(zq + (size_t)src * 512 + h * 128 + cg * 8); } }
            ML_CONV(kraw, 512, 1152, KS, 1.f);
            asm volatile("" ::: "memory");
            if (OUT) ML_CONV(qraw, 0, 1024, QS, 0.08838834764831845f);
#undef ML_CONV
#pragma unroll
            for (int rr = 0; rr < 2; ++rr) *(LAS v4u*)(VS + (s0 + rr) * 136 + cg * 8) = vraw[rr];
        }
        __syncthreads();
        if (OUT) {
            const int tt = wave >> 1;
#pragma unroll
            for (int si = 0; si < 2; ++si) {
                const int st = 2 * (wave & 1) + si;
                f32x4 sacc = (f32x4){0.f, 0.f, 0.f, 0.f};
                if (st <= tt) {
#pragma unroll
                    for (int kk = 0; kk < 4; ++kk) sacc = mma16(*(const LAS bf16x8*)(QS + (16 * tt + l15) * 136 + 32 * kk + 8 * q4), *(const LAS bf16x8*)(KS + (16 * st + l15) * 136 + 32 * kk + 8 * q4), sacc);
                }
                const int sl = 16 * st + l15; const float gs = GTg[sl];
#pragma unroll
                for (int r = 0; r < 4; ++r) { const int tl = 16 * tt + 4 * q4 + r; const float w = (sl <= tl) ? __expf(gs - GTM[tl]) : 0.f; PS[tl * 72 + sl] = f2bf(sacc[r] * w); }
            }
        }
        {
            const int d = tid & 127, sg = tid >> 7; float kv[16];
#pragma unroll
            for (int i = 0; i < 16; ++i) kv[i] = bf2f(KS[(16 * sg + i) * 136 + d]) * GTwk[16 * sg + i];
            v4u o0, o1;
            o0.x = pk2(kv[0], kv[1]); o0.y = pk2(kv[2], kv[3]); o0.z = pk2(kv[4], kv[5]); o0.w = pk2(kv[6], kv[7]);
            o1.x = pk2(kv[8], kv[9]); o1.y = pk2(kv[10], kv[11]); o1.z = pk2(kv[12], kv[13]); o1.w = pk2(kv[14], kv[15]);
            *(LAS v4u*)(KWT + d * 72 + 16 * sg) = o0; *(LAS v4u*)(KWT + d * 72 + 16 * sg + 8) = o1;
            unsigned vw[8];
#pragma unroll
            for (int i = 0; i < 8; ++i) vw[i] = (unsigned)VS[(16 * sg + 2 * i) * 136 + d] | ((unsigned)VS[(16 * sg + 2 * i + 1) * 136 + d] << 16);
            o0.x = vw[0]; o0.y = vw[1]; o0.z = vw[2]; o0.w = vw[3]; o1.x = vw[4]; o1.y = vw[5]; o1.z = vw[6]; o1.w = vw[7];
            *(LAS v4u*)(VT + d * 72 + 16 * sg) = o0; *(LAS v4u*)(VT + d * 72 + 16 * sg + 8) = o1;
        }
        __syncthreads();
        f32x4 res[5];
        if (OUT) {
            const int tt = wave >> 1, dv0 = 4 * (wave & 1);
            bf16x8 pa[2], qa[4];
#pragma unroll
            for (int kk = 0; kk < 2; ++kk) pa[kk] = *(const LAS bf16x8*)(PS + (16 * tt + l15) * 72 + 32 * kk + 8 * q4);
#pragma unroll
            for (int kk = 0; kk < 4; ++kk) qa[kk] = *(const LAS bf16x8*)(QS + (16 * tt + l15) * 136 + 32 * kk + 8 * q4);
            float si[4];
#pragma unroll
            for (int r = 0; r < 4; ++r) si[r] = GTsi[16 * tt + 4 * q4 + r];
#pragma unroll
            for (int i = 0; i < 5; ++i) {
                const int dvt = (i < 4) ? (dv0 + i) : 8;
                if (i < 4 || (wave & 1) == 0) {
                    f32x4 a1 = (f32x4){0.f, 0.f, 0.f, 0.f}, a2 = (f32x4){0.f, 0.f, 0.f, 0.f};
#pragma unroll
                    for (int kk = 0; kk < 2; ++kk) a1 = mma16(pa[kk], *(const LAS bf16x8*)(VT + (16 * dvt + l15) * 72 + 32 * kk + 8 * q4), a1);
#pragma unroll
                    for (int kk = 0; kk < 4; ++kk) a2 = mma16(qa[kk], *(const LAS bf16x8*)(CT + (16 * dvt + l15) * 136 + 32 * kk + 8 * q4), a2);
#pragma unroll
                    for (int r = 0; r < 4; ++r) res[i][r] = a1[r] + si[r] * a2[r];
                } else res[i] = (f32x4){0.f, 0.f, 0.f, 0.f};
            }
            if ((wave & 1) == 0 && l15 == 0) {
#pragma unroll
                for (int r = 0; r < 4; ++r) DEN[16 * tt + 4 * q4 + r] = res[4][r];
            }
        }
        {
            bf16x8 kb[2];
#pragma unroll
            for (int kk = 0; kk < 2; ++kk) kb[kk] = *(const LAS bf16x8*)(KWT + (16 * wave + l15) * 72 + 32 * kk + 8 * q4);
#pragma unroll
            for (int i = 0; i < 9; ++i) { accC[i] = accC[i] * sc;
#pragma unroll
                for (int kk = 0; kk < 2; ++kk) accC[i] = mma16(*(const LAS bf16x8*)(VT + (16 * i + l15) * 72 + 32 * kk + 8 * q4), kb[kk], accC[i]); }
        }
        __syncthreads();
        if (OUT) {
            const int tt = wave >> 1;
            float den[4], lbv[4];
#pragma unroll
            for (int r = 0; r < 4; ++r) { den[r] = DEN[16 * tt + 4 * q4 + r]; lbv[r] = GTlb[16 * tt + 4 * q4 + r]; }
#pragma unroll
            for (int r = 0; r < 4; ++r) { const float inv = 1.f / fmaxf(fabsf(den[r]), lbv[r]); float s1 = 0.f, s2 = 0.f;
#pragma unroll
                for (int i = 0; i < 4; ++i) { res[i][r] *= inv; s1 += res[i][r]; s2 += res[i][r] * res[i][r]; }
                s1 = row16_sum(s1); s2 = row16_sum(s2);
                if (l15 == 0) { PART[((16 * tt + 4 * q4 + r) * 2 + (wave & 1)) * 2] = s1; PART[((16 * tt + 4 * q4 + r) * 2 + (wave & 1)) * 2 + 1] = s2; } }
#pragma unroll
            for (int ii = 0; ii < 9; ++ii)
#pragma unroll
                for (int r = 0; r < 4; ++r) CT[(16 * ii + 4 * q4 + r) * 136 + 16 * wave + l15] = f2bf(accC[ii][r]);
            __syncthreads();
#pragma unroll
            for (int r = 0; r < 4; ++r) { const int tl = 16 * tt + 4 * q4 + r; const size_t trow = (size_t)(tc + tl);
                const float s1 = PART[(tl * 2) * 2] + PART[(tl * 2 + 1) * 2], s2 = PART[(tl * 2) * 2 + 1] + PART[(tl * 2 + 1) * 2 + 1];
                const float mean = s1 * (1.f / 128.f), var = fmaxf(s2 * (1.f / 128.f) - mean * mean, 0.f), rstd = rsqrtf(var + LN_EPS);
#pragma unroll
                for (int i = 0; i < 4; ++i) { const int dvv = 16 * (4 * (wave & 1) + i) + l15;
                    const float y = (res[i][r] - mean) * rstd * mg[i] * bf2f(zo[trow * 512 + h * 128 + dvv]);
                    uahm[trow * 1024 + 512 + h * 128 + dvv] = f2bf(y); } }
        }
        mc = mnew; Btot += blast;
    }
    if (!OUT) {
#pragma unroll
        for (int ii = 0; ii < 9; ++ii)
#pragma unroll
            for (int r = 0; r < 4; ++r) state[((size_t)unit * 36 + ii * 4 + r) * 512 + tid] = accC[ii][r];
        if (tid == 0) { stsc[unit * 4] = mc; stsc[unit * 4 + 1] = Btot; }
    }
}

DEV void p8_route(const Args& a, LAS unsigned char* lds, int bid, int G) {
    int tid = threadIdx.x; asm volatile("" : "+v"(tid));
    const int lane = tid & 63, wave = __builtin_amdgcn_readfirstlane(tid >> 6), l15 = lane & 15, q4 = lane >> 4;
    const float* x1 = a.out; const float* g2 = a.in[17]; const float* w_rg = a.in[18]; const float* w_re = a.in[20];
    const float* mod = (const float*)(a.ws + WS_MOD); const float* rbias = (const float*)(a.ws + WS_RBIAS); const v4u* rw = (const v4u*)(a.ws + WS_RW); bf16* h2 = (bf16*)(a.ws + WS_H);
    int* toke = (int*)(a.ws + WS_TOKE); float* tokw = (float*)(a.ws + WS_TOKW);
    int* listt = (int*)(a.ws + WS_LISTT); float* listw = (float*)(a.ws + WS_LISTW); unsigned* cnt = (unsigned*)(a.ws + WS_CTL) + CW_CNT;
    LAS float* PL = (LAS float*)lds;
    LAS float* SS = (LAS float*)(lds + 98304);
    LAS float* LG = (LAS float*)(lds + 100352);
    LAS float* RS = (LAS float*)(lds + 109568);
    LAS unsigned* lcnt = (LAS unsigned*)(lds + LDS_MISC + 256);
    LAS unsigned* lbase = lcnt + 32;
    LAS unsigned* lent = lcnt + 64;
    LAS float* lwt = (LAS float*)(lcnt + 192);
    for (int tile = bid; tile < T / 64; tile += G) {
        const int b = tile / 32;
        __syncthreads();
        if (tid < 32) lcnt[tid] = 0u;
        f32x4 acc[4][3]; float ss[4];
#pragma unroll
        for (int rt = 0; rt < 4; ++rt) { ss[rt] = 0.f;
#pragma unroll
            for (int nt = 0; nt < 3; ++nt) acc[rt][nt] = (f32x4){0.f, 0.f, 0.f, 0.f}; }
#pragma unroll 1
        for (int kk = 0; kk < 4; ++kk) {
            const int k0 = 128 * wave + 32 * kk + 8 * q4;
            bf16x8 bhi[3], blo[3];
#pragma unroll
            for (int nt = 0; nt < 3; ++nt) { const size_t it = ((size_t)(b * 8 + wave) * 4 + kk) * 3 + nt;
                bhi[nt] = __builtin_bit_cast(bf16x8, rw[(it * 2) * 64 + lane]); blo[nt] = __builtin_bit_cast(bf16x8, rw[(it * 2 + 1) * 64 + lane]); }
#pragma unroll
            for (int rt = 0; rt < 4; ++rt) {
                const float* xp = x1 + ((size_t)tile * 64 + 16 * rt + l15) * 1024 + k0;
                const f32x4 xa = *(const f32x4*)xp, xb = *(const f32x4*)(xp + 4);
                ss[rt] += (xa[0] * xa[0] + xa[1] * xa[1]) + (xa[2] * xa[2] + xa[3] * xa[3]) + (xb[0] * xb[0] + xb[1] * xb[1]) + (xb[2] * xb[2] + xb[3] * xb[3]);
                bf16x8 ahi, alo; split8(xa, xb, ahi, alo);
#pragma unroll
                for (int nt = 0; nt < 3; ++nt) { acc[rt][nt] = mma16(ahi, bhi[nt], acc[rt][nt]); acc[rt][nt] = mma16(alo, bhi[nt], acc[rt][nt]); acc[rt][nt] = mma16(ahi, blo[nt], acc[rt][nt]); }
            }
        }
#pragma unroll
        for (int rt = 0; rt < 4; ++rt) {
            float sv = ss[rt]; sv += __shfl_xor(sv, 16); sv += __shfl_xor(sv, 32);
            if (q4 == 0) SS[wave * 64 + 16 * rt + l15] = sv;
#pragma unroll
            for (int nt = 0; nt < 3; ++nt)
#pragma unroll
                for (int r = 0; r < 4; ++r) PL[(wave * 64 + 16 * rt + 4 * q4 + r) * 48 + 16 * nt + l15] = acc[rt][nt][r];
        }
        __syncthreads();
        {
            const int row = tid >> 3, part = tid & 7;
            float ssum = 0.f;
#pragma unroll
            for (int w = 0; w < 8; ++w) ssum += SS[w * 64 + row];
            const float rstd = rsqrtf(ssum * (1.f / 1024.f) + RMS_EPS);
            if (part == 0) RS[row] = rstd;
#pragma unroll
            for (int i = 0; i < 5; ++i) { const int n = part + 8 * i; if (n < 36) { float s = 0.f;
#pragma unroll
                    for (int w = 0; w < 8; ++w) s += PL[(w * 64 + row) * 48 + n];
                    LG[row * 36 + n] = rstd * s + rbias[b * 48 + n]; } }
        }
        __syncthreads();
        if (tid < 64) {
            const int r = tid; const size_t row = (size_t)tile * 64 + r;
            float lg[36];
#pragma unroll
            for (int q = 0; q < 36; ++q) lg[q] = LG[r * 36 + q];
            int gs = 0; float gm = lg[0];
#pragma unroll
            for (int q = 1; q < 4; ++q) if (lg[q] > gm) { gm = lg[q]; gs = q; }
            float se = 0.f;
#pragma unroll
            for (int q = 0; q < 4; ++q) se += __expf(lg[q] - gm);
            const float pg = 1.f / se;
            float le[8];
#pragma unroll
            for (int q = 0; q < 8; ++q) { float vsel = lg[4 + q];
#pragma unroll
                for (int gg = 1; gg < 4; ++gg) vsel = (gs == gg) ? lg[4 + 8 * gg + q] : vsel;
                le[q] = vsel; }
            int e0 = 0; float l0 = le[0];
#pragma unroll
            for (int q = 1; q < 8; ++q) if (le[q] > l0) { l0 = le[q]; e0 = q; }
            int e1 = -1; float l1 = -3.0e38f;
#pragma unroll
            for (int q = 0; q < 8; ++q) if (q != e0 && le[q] > l1) { l1 = le[q]; e1 = q; }
            const float rr = __expf(l1 - l0), w0 = pg / (1.f + rr), w1 = pg * rr / (1.f + rr);
#pragma unroll
            for (int sl = 0; sl < 2; ++sl) { const int e = gs * 8 + (sl ? e1 : e0); const float w = sl ? w1 : w0;
                toke[row * 2 + sl] = e; tokw[row * 2 + sl] = w;
                const unsigned lp = __hip_atomic_fetch_add(lcnt + e, 1u, __ATOMIC_RELAXED, __HIP_MEMORY_SCOPE_WORKGROUP);
                lent[r * 2 + sl] = (unsigned)e | (lp << 8); lwt[r * 2 + sl] = w; }
        }
        __syncthreads();
        if (tid < 32 && !(a.flags & 2)) { const unsigned n = lcnt[tid]; lbase[tid] = n ? atomicAdd(cnt + 16 * tid, n) : 0u; }
        {
            float sc[4][4], sh[4][4];
#pragma unroll
            for (int j = 0; j < 4; ++j) { const int k = 256 * j + 4 * lane; const f32x4 gv = *(const f32x4*)(g2 + k), sv = *(const f32x4*)(mod + b * 6144 + 4096 + k), hv = *(const f32x4*)(mod + b * 6144 + 3072 + k);
#pragma unroll
                for (int i = 0; i < 4; ++i) { sc[j][i] = gv[i] * (1.f + sv[i]); sh[j][i] = hv[i]; } }
            f32x4 nx[4];
#pragma unroll
            for (int j = 0; j < 4; ++j) nx[j] = *(const f32x4*)(x1 + ((size_t)tile * 64 + wave) * 1024 + 256 * j + 4 * lane);
#pragma unroll 1
            for (int r = wave; r < 64; r += NWAVES) {
                const size_t row = (size_t)tile * 64 + r; f32x4 v[4];
#pragma unroll
                for (int j = 0; j < 4; ++j) v[j] = nx[j];
                if (r + NWAVES < 64) {
#pragma unroll
                    for (int j = 0; j < 4; ++j) nx[j] = *(const f32x4*)(x1 + (row + NWAVES) * 1024 + 256 * j + 4 * lane); }
                asm volatile("" ::: "memory");
                const float rstd = RS[r];
#pragma unroll
                for (int j = 0; j < 4; ++j) { v2u o; o.x = pk2(v[j][0] * rstd * sc[j][0] + sh[j][0], v[j][1] * rstd * sc[j][1] + sh[j][1]); o.y = pk2(v[j][2] * rstd * sc[j][2] + sh[j][2], v[j][3] * rstd * sc[j][3] + sh[j][3]);
                    *(v2u*)(h2 + row * 1024 + 256 * j + 4 * lane) = o; }
            }
        }
        __syncthreads();
        if (tid < 128 && !(a.flags & 2)) { const unsigned en = lent[tid]; const unsigned e = en & 255u, lp = en >> 8; const unsigned pos = lbase[e] + lp;
            listt[e * 16384 + pos] = (tile * 64 + (tid >> 1)) * 2 + (tid & 1); listw[e * 16384 + pos] = lwt[tid]; }
    }
    __syncthreads();
}
DEV void p8_convert(const Args& a, LAS unsigned char* lds, int bid, int G) {
    int tid = threadIdx.x; asm volatile("" : "+v"(tid));
    const int lane = tid & 63, wave = __builtin_amdgcn_readfirstlane(tid >> 6);
    LAS float* scr = (LAS float*)(lds + wave * 16384);
    const float* wg = a.in[22]; const float* wu = a.in[23]; const float* wd = a.in[24];
    bf16* WGU = (bf16*)(a.ws + WS_WGU); bf16* WD = (bf16*)(a.ws + WS_WD);
    const int gw = bid * NWAVES + wave, NGW = G * NWAVES;
    for (int it = gw; it < 32 * 768; it += NGW) {
        const int e = it / 768; int r = it % 768;
        if (r < 512) { const int up = r >> 8; r &= 255; const int kb = r >> 4, nb = r & 15, n = 32 * nb, np = 256 * (n >> 7) + 128 * up + (n & 127);
            transpose_item((up ? wu : wg) + (size_t)e * 1024 * 512 + (size_t)(64 * kb) * 512 + n, 512, WGU + ((size_t)e * 1024 + np) * 1024 + 64 * kb, 1024, scr, lane); }
        else { r -= 512; const int kb = r >> 5, nb = r & 31;
            transpose_item(wd + (size_t)e * 512 * 1024 + (size_t)(64 * kb) * 1024 + 32 * nb, 1024, WD + ((size_t)e * 1024 + 32 * nb) * 512 + 64 * kb, 512, scr, lane); }
    }
}

struct MoeSched {
    const LAS int* tlist; const LAS int* rstart; const LAS int* ecnt; int U, G, c; unsigned bstride;
    DEV bool next(int i, Unit& u) const {
        const int L = i * G + c; if (L >= U) return false;
        const int ent = tlist[L >> 2]; const int e = ent & 255, rt = ent >> 8; u.pn = L & 3;
        const int left = ecnt[e] - 256 * rt;
        u.pm = 0; u.ak = 0; u.bk = (unsigned)e * bstride; u.slot = i; u.valid = left < 256 ? left : 256; u.arow0 = rstart[e] + 256 * rt; return true;
    }
};
DEV void moe_tables(const Args& a, LAS unsigned char* lds, int bid, int G, MoeSched& S, bool down) {
    int tid = threadIdx.x; asm volatile("" : "+v"(tid));
    LAS int* ti = (LAS int*)(lds + LDS_MISC + 1024); LAS int* rstart = ti, *ecnt = ti + 40, *tlist = ti + 80, *ntl = ti + 260;
    const unsigned* cnt = (const unsigned*)(a.ws + WS_CTL) + CW_CNT;
    const int* listt = (const int*)(a.ws + WS_LISTT); const float* listw = (const float*)(a.ws + WS_LISTW);
    __syncthreads();
    if (tid < 64) {
        const int lane = tid; const int n = (lane < 32) ? (int)__hip_atomic_load(cnt + 16 * (lane & 31), __ATOMIC_RELAXED, __HIP_MEMORY_SCOPE_AGENT) : 0;
        const int ntile = (n + 255) >> 8, nfull = (n + 127) >> 8, ntail = ntile - nfull;
        const int rs = (int)wave_scan_add((float)n, lane) - n, of = (int)wave_scan_add((float)nfull, lane) - nfull, ot = (int)wave_scan_add((float)ntail, lane) - ntail;
        const int totf = (int)rdlane(wave_scan_add((float)nfull, lane), 63), tott = (int)rdlane(wave_scan_add((float)ntail, lane), 63);
        if (lane < 32) { ecnt[lane] = n; rstart[lane] = rs;
            for (int rt = 0; rt < nfull; ++rt) tlist[of + rt] = lane | (rt << 8);
            if (ntail) tlist[totf + ot] = lane | (nfull << 8); }
        if (lane == 32) rstart[32] = rs;
        if (lane == 0) ntl[0] = totf + tott;
    }
    __syncthreads();
    S.tlist = tlist; S.rstart = rstart; S.ecnt = ecnt; S.U = 4 * ntl[0]; S.G = G; S.c = bid;
    LAS unsigned* tab0 = (LAS unsigned*)(lds + LDS_TAB); LAS float* tab1 = (LAS float*)(lds + LDS_TAB + 8192);
    Unit u;
    for (int i = 0; i < 8 && S.next(i, u); ++i) {
        if (tid < 256) { const int e = (int)(u.bk / S.bstride); const int pos = (u.arow0 - rstart[e]) + tid; unsigned v0 = 0u; float v1 = 0.f;
            if (tid < u.valid) { const int tk = listt[e * 16384 + pos]; v0 = down ? (unsigned)tk : (unsigned)(tk >> 1) * 2048u; v1 = listw[e * 16384 + pos]; }
            tab0[i * 256 + tid] = v0; tab1[i * 256 + tid] = v1; }
    }
    __syncthreads();
}

DEV void p11_final(const Args& a, int bid, int G) {
    int tid = threadIdx.x; asm volatile("" : "+v"(tid));
    const int lane = tid & 63, wave = __builtin_amdgcn_readfirstlane(tid >> 6);
    const float* mod = (const float*)(a.ws + WS_MOD); const bf16* ys = (const bf16*)(a.ws + WS_YS); const float* gf = a.in[25]; float* out = a.out;
    for (int tile = bid; tile < T / 64; tile += G) {
        const int b = tile / 32;
        f32x4 nx[4], gtv[4], gfv[4]; v2u ny0[4], ny1[4];
#pragma unroll
        for (int j = 0; j < 4; ++j) { const int k = 256 * j + 4 * lane; gtv[j] = *(const f32x4*)(mod + b * 6144 + 5120 + k); gfv[j] = *(const f32x4*)(gf + k); }
#pragma unroll
        for (int j = 0; j < 4; ++j) { const size_t row = (size_t)tile * 64 + wave; const int k = 256 * j + 4 * lane;
            nx[j] = *(const f32x4*)(out + row * 1024 + k); ny0[j] = *(const v2u*)(ys + row * 2048 + k); ny1[j] = *(const v2u*)(ys + row * 2048 + 1024 + k); }
#pragma unroll 1
        for (int r = wave; r < 64; r += NWAVES) {
            const size_t row = (size_t)tile * 64 + r;
            f32x4 v[4]; float ss = 0.f;
#pragma unroll
            for (int j = 0; j < 4; ++j) { const int k = 256 * j + 4 * lane;
                const f32x4 xv = nx[j], gt = gtv[j]; const v2u y0 = ny0[j], y1 = ny1[j];
                v[j][0] = xv[0] + gt[0] * (bflo(y0.x) + bflo(y1.x)); v[j][1] = xv[1] + gt[1] * (bfhi(y0.x) + bfhi(y1.x));
                v[j][2] = xv[2] + gt[2] * (bflo(y0.y) + bflo(y1.y)); v[j][3] = xv[3] + gt[3] * (bfhi(y0.y) + bfhi(y1.y));
                ss += (v[j][0] * v[j][0] + v[j][1] * v[j][1]) + (v[j][2] * v[j][2] + v[j][3] * v[j][3]); }
            if (r + NWAVES < 64) {
#pragma unroll
                for (int j = 0; j < 4; ++j) { const size_t rn = row + NWAVES; const int k = 256 * j + 4 * lane;
                    nx[j] = *(const f32x4*)(out + rn * 1024 + k); ny0[j] = *(const v2u*)(ys + rn * 2048 + k); ny1[j] = *(const v2u*)(ys + rn * 2048 + 1024 + k); } }
            asm volatile("" ::: "memory");
            const float rstd = rsqrtf(wave_sum(ss) * (1.f / 1024.f) + RMS_EPS);
#pragma unroll
            for (int j = 0; j < 4; ++j) { const int k = 256 * j + 4 * lane; *(f32x4*)(out + row * 1024 + k) = v[j] * rstd * gfv[j]; }
        }
    }
}

constexpr int NPHASE = 11;
template <int LO, int HI>
__global__ void __launch_bounds__(NTHREADS, 2) mk_fwd(Args a) {
    extern __shared__ __attribute__((aligned(16))) unsigned char lds_raw[];
    LAS unsigned char* lds = (LAS unsigned char*)lds_raw;
    const int tid = threadIdx.x, G = gridDim.x, bid = blockIdx.x;
    volatile LAS unsigned* MISC = (volatile LAS unsigned*)(lds + LDS_MISC);
    if (tid < 64) MISC[tid] = 0u;
    __syncthreads();
#if MK_ONE
#if USE_XCD_BARRIER
    XcdBarrier bar = xcd_barrier_post((unsigned*)(a.ws + WS_CTL) + CW_BAR, MISC + 8);
#define GRID_BAR() xcd_barrier(bar)
#else
    unsigned fgen = 0;
#define GRID_BAR() flat_barrier((unsigned*)(a.ws + WS_CTL) + CW_FLATBAR, fgen)
#endif
#else
#define GRID_BAR() do {} while (0)
#endif
    constexpr int lo = LO, hi = HI;
#define IN(k) (lo <= (k) && (k) < hi)
#define BOTH(k) (IN(k) && IN((k) + 1))
    if constexpr (IN(0)) { REPK(0) { p0_prologue(a, lds, bid, G); REPSYNC(); } if constexpr (BOTH(0)) __syncthreads(); }
    if constexpr (IN(1)) { REPK(1) { P1_FN(a, lds, bid, G); REPSYNC(); } if constexpr (BOTH(1)) GRID_BAR(); }
    if constexpr (IN(2)) {
        __syncthreads();
        ProbPlain P{(const bf16*)(a.ws + WS_H), (const bf16*)(a.ws + WS_W1T), 2048u, 2048u};
#if DBG_GATEFIRST
        struct SchedG { pg8::StaticOrder so; DEV bool next(int i, Unit& u) const { if (i >= 2) return false; return so.next(i + 3, u); } } S; S.so.init(T, 5120, G, bid);
#else
        pg8::StaticOrder S; S.init(T, 5120, G, bid);
#endif
        Epi1 E{(bf16*)(a.ws + WS_ZU), (bf16*)(a.ws + WS_ZGA), (a.flags >> 8) & 15};
        REPK(2) pg8::gemm_phase<ProbPlain, Epi1, decltype(S), true>(lds, P, S, E, 1024);
        if constexpr (BOTH(2)) GRID_BAR();
    }
    if constexpr (IN(3)) {
        REPK(3) { for (int u = bid; u < 256; u += G) mlstm_unit<false>(a, lds, u);
        __syncthreads(); }
        REPK(11) { p3_conva(a, lds, bid, G); REPSYNC(); }
        if constexpr (BOTH(3)) GRID_BAR();
    }
    if constexpr (IN(4)) {
        REPK(4) { for (int u = bid; u < 256; u += G) mlstm_unit<true>(a, lds, u); REPSYNC(); }
        if constexpr (BOTH(4)) GRID_BAR();
    }
    if constexpr (IN(5)) {
        __syncthreads();
        struct Sched2 { pg8::StaticOrder so; DEV bool next(int i, Unit& u) const { u.ak = (unsigned)(i & 1) * 1024u; u.bk = u.ak; u.slot = i & 1; u.valid = 256; u.arow0 = 0; return so.tile((i >> 1) * so.G + so.c, u.pm, u.pn); } } S;
        S.so.init(T, 1024, G, bid);
        ProbPlain P{(const bf16*)(a.ws + WS_UAHM), (const bf16*)(a.ws + WS_W2T), 2048u, 2048u};
        Epi2 E{(const bf16*)(a.ws + WS_ZGA), (const bf16*)(a.ws + WS_ZGB), (bf16*)(a.ws + WS_MERGED)};
        REPK(5) pg8::gemm_phase<ProbPlain, Epi2, Sched2, false>(lds, P, S, E, 512);
        if constexpr (BOTH(5)) GRID_BAR();
    }
    if constexpr (IN(6)) {
        __syncthreads();
        ProbPlain P{(const bf16*)(a.ws + WS_MERGED), (const bf16*)(a.ws + WS_W3T), 2048u, 2048u};
        pg8::StaticOrder S; S.init(T, 1024, G, bid);
        Epi3 E{a.in[0], (const float*)(a.ws + WS_MOD), a.out};
        REPK(6) pg8::gemm_phase<ProbPlain, Epi3, pg8::StaticOrder, false>(lds, P, S, E, 1024);
        if constexpr (BOTH(6)) { GRID_BAR(); for (int xb = 0; xb < DBG_XBAR; ++xb) GRID_BAR(); }
    }
    if constexpr (IN(7)) {
        if (!(a.flags & 1)) p8_route(a, lds, bid, G);
        __syncthreads();
        if (!(a.flags & 4)) { p8_convert(a, lds, bid, G); }
        if constexpr (BOTH(7)) GRID_BAR();
    }
    if constexpr (IN(8)) {
        MoeSched S; S.bstride = 1024u * 1024u * 2u;
        moe_tables(a, lds, bid, G, S, false);
        ProbMoeUp P{(const bf16*)(a.ws + WS_H), (const bf16*)(a.ws + WS_WGU), (const LAS unsigned*)(lds + LDS_TAB)};
        EpiUp E{(bf16*)(a.ws + WS_ACT)};
        REPK(8) pg8::gemm_phase<ProbMoeUp, EpiUp, MoeSched, false, true>(lds, P, S, E, 1024);
        if constexpr (BOTH(8)) GRID_BAR();
    }
    if constexpr (IN(9)) {
        MoeSched S; S.bstride = 1024u * 512u * 2u;
        moe_tables(a, lds, bid, G, S, true);
        ProbMoeDown P{(const bf16*)(a.ws + WS_ACT), (const bf16*)(a.ws + WS_WD)};
        EpiDown E{(bf16*)(a.ws + WS_YS), (const LAS unsigned*)(lds + LDS_TAB), (const LAS float*)(lds + LDS_TAB + 8192)};
        REPK(9) pg8::gemm_phase<ProbMoeDown, EpiDown, MoeSched, false, true>(lds, P, S, E, 512);
        if constexpr (BOTH(9)) GRID_BAR();
    }
    if constexpr (IN(10)) { p11_final(a, bid, G); }
#undef IN
#undef BOTH
}

#if NAIVE_MASK
__global__ __launch_bounds__(256) void k_fixw1t(const float* w_in, bf16* W1T) { const size_t i = (size_t)blockIdx.x * 256 + threadIdx.x; const size_t n = i / 1024, k = i % 1024; W1T[(3072 + n) * 1024 + k] = f2bf(w_in[k * 5128 + 3080 + n]); }
DEV float block_sum256(float v, float* red) {
#pragma unroll
    for (int o = 32; o >= 1; o >>= 1) v += __shfl_xor(v, o);
    __syncthreads();
    if ((threadIdx.x & 63) == 0) red[threadIdx.x >> 6] = v;
    __syncthreads();
    return (red[0] + red[1]) + (red[2] + red[3]);
}
__global__ __launch_bounds__(256) void k_mod(const float* c, const float* w_ada, const float* b_ada, float* mod) {
    const int idx = blockIdx.x * 256 + threadIdx.x; const int b = idx / 6144, n = idx % 6144;
    float acc = 0.f;
    for (int k = 0; k < D; ++k) acc += siluf_(c[b * D + k]) * w_ada[(size_t)k * 6144 + n];
    mod[idx] = acc + b_ada[n];
}
__global__ __launch_bounds__(256) void k_h1(const float* x, const float* g1, const float* mod, const float* w_in, const float* b_if, bf16* h1, float* gates) {
    __shared__ float red[4];
    const int t = blockIdx.x, b = t / SEQ, tid = threadIdx.x;
    const float4 xv = ((const float4*)(x + (size_t)t * D))[tid];
    float ss = xv.x * xv.x + xv.y * xv.y + xv.z * xv.z + xv.w * xv.w;
    ss = block_sum256(ss, red);
    const float rstd = rsqrtf(ss * (1.f / D) + RMS_EPS);
    const float* sh = mod + b * 6144, *sc = mod + b * 6144 + 1024;
    float hv[4]; const float xs[4] = {xv.x, xv.y, xv.z, xv.w};
#pragma unroll
    for (int j = 0; j < 4; ++j) { const int k = tid * 4 + j; hv[j] = xs[j] * rstd * g1[k] * (1.f + sc[k]) + sh[k]; }
    ushort4 o; o.x = f2bf(hv[0]); o.y = f2bf(hv[1]); o.z = f2bf(hv[2]); o.w = f2bf(hv[3]);
    ((ushort4*)(h1 + (size_t)t * D))[tid] = o;
    float g[8];
#pragma unroll
    for (int j = 0; j < 8; ++j) g[j] = 0.f;
#pragma unroll
    for (int i = 0; i < 4; ++i) { const float* wr = w_in + (size_t)(tid * 4 + i) * DIN + 3072;
#pragma unroll
        for (int j = 0; j < 8; ++j) g[j] += hv[i] * wr[j]; }
#pragma unroll
    for (int j = 0; j < 8; ++j) g[j] = block_sum256(g[j], red);
    if (tid < 8) { float v = g[0];
#pragma unroll
        for (int j = 1; j < 8; ++j) v = (tid == j) ? g[j] : v;
        v += b_if[tid];
        gates[(size_t)t * 8 + tid] = (tid < 4) ? v : logsigmoidf_(v); }
}
template <class Epi>
__global__ __launch_bounds__(256) void k_ngemm(const bf16* A, int lda, const float* W, int ldw, int N, int K, Epi epi) {
    __shared__ float As[16][68]; __shared__ float Ws[16][68];
    const int tid = threadIdx.x, tx = tid & 15, ty = tid >> 4;
    const int row0 = blockIdx.y * 64, col0 = blockIdx.x * 64;
    float acc[4][4];
#pragma unroll
    for (int i = 0; i < 4; ++i)
#pragma unroll
        for (int j = 0; j < 4; ++j) acc[i][j] = 0.f;
    const int ar = tid >> 2, ak = (tid & 3) * 4;
    const int wk = tid >> 4, wc = (tid & 15) * 4;
    for (int k0 = 0; k0 < K; k0 += 16) {
        const ushort4 av = *(const ushort4*)(A + (size_t)(row0 + ar) * lda + k0 + ak);
        As[ak + 0][ar] = bf2f(av.x); As[ak + 1][ar] = bf2f(av.y); As[ak + 2][ar] = bf2f(av.z); As[ak + 3][ar] = bf2f(av.w);
#pragma unroll
        for (int j = 0; j < 4; ++j) { const int cc = col0 + wc + j; Ws[wk][wc + j] = (cc < N) ? W[(size_t)(k0 + wk) * ldw + cc] : 0.f; }
        __syncthreads();
#pragma unroll
        for (int kk = 0; kk < 16; ++kk) {
            float av2[4], w[4];
#pragma unroll
            for (int i = 0; i < 4; ++i) av2[i] = As[kk][ty * 4 + i];
#pragma unroll
            for (int j = 0; j < 4; ++j) w[j] = Ws[kk][tx * 4 + j];
#pragma unroll
            for (int i = 0; i < 4; ++i)
#pragma unroll
                for (int j = 0; j < 4; ++j) acc[i][j] += av2[i] * w[j];
        }
        __syncthreads();
    }
#pragma unroll
    for (int i = 0; i < 4; ++i)
#pragma unroll
        for (int j = 0; j < 4; ++j) { const int cc = col0 + tx * 4 + j; if (cc < N) epi(row0 + ty * 4 + i, cc, acc[i][j]); }
}
struct NEpi1 {
    float* tmp; bf16 *zq, *zk, *zv, *zo, *zga, *zgb;
    DEV void operator()(int r, int c, float v) const {
        if (c < 1024) tmp[(size_t)r * 1024 + c] = v;
        else if (c < 1536) zq[(size_t)r * 512 + c - 1024] = f2bf(v);
        else if (c < 2048) zk[(size_t)r * 512 + c - 1536] = f2bf(v);
        else if (c < 2560) zv[(size_t)r * 512 + c - 2048] = f2bf(v);
        else if (c < 3072) zo[(size_t)r * 512 + c - 2560] = f2bf(sigmoidf_(v));
        else if (c < 3080) {}
        else if (c < 4104) zga[(size_t)r * 1024 + c - 3080] = f2bf(sigmoidf_(v));
        else zgb[(size_t)r * 1024 + c - 4104] = f2bf(sigmoidf_(v));
    }
};
struct NEpi2a { float* tmp; const bf16* zga; DEV void operator()(int r, int c, float v) const { tmp[(size_t)r * 1024 + c] = v * bf2f(zga[(size_t)r * 1024 + c]); } };
struct NEpi2b { const float* tmp; const bf16* zgb; bf16* merged; DEV void operator()(int r, int c, float v) const { merged[(size_t)r * 1024 + c] = f2bf(tmp[(size_t)r * 1024 + c] + v * bf2f(zgb[(size_t)r * 1024 + c])); } };
struct NEpi3 { const float* x; const float* mod; float* out; DEV void operator()(int r, int c, float v) const { const int b = r / SEQ; out[(size_t)r * 1024 + c] = x[(size_t)r * 1024 + c] + mod[b * 6144 + 2048 + c] * v; } };
__global__ __launch_bounds__(256) void k_glu(const float* tmp, bf16* zu) {
    const size_t i = (size_t)blockIdx.x * 256 + threadIdx.x; const size_t r = i / 512, c = i % 512;
    zu[i] = f2bf(tmp[r * 1024 + c] * sigmoidf_(tmp[r * 1024 + 512 + c]));
}
__global__ __launch_bounds__(256) void k_conva(const bf16* zu, const float* cw, const float* cb, const float* lg, const float* lb, bf16* uahm) {
    __shared__ float red[4];
    const int t = blockIdx.x, s = t % SEQ, tid = threadIdx.x;
    float v[2];
#pragma unroll
    for (int j = 0; j < 2; ++j) { const int c = tid + 256 * j; float a = cb[c];
        for (int k = 0; k < 31; ++k) { const int ss = s - 30 + k; if (ss >= 0) a += cw[k * 512 + c] * bf2f(zu[(size_t)(t - 30 + k) * 512 + c]); }
        v[j] = a; }
    const float mean = block_sum256(v[0] + v[1], red) * (1.f / 512.f);
    const float d0 = v[0] - mean, d1 = v[1] - mean;
    const float var = block_sum256(d0 * d0 + d1 * d1, red) * (1.f / 512.f);
    const float rstd = rsqrtf(var + LN_EPS);
#pragma unroll
    for (int j = 0; j < 2; ++j) { const int c = tid + 256 * j; const float y = (v[j] - mean) * rstd * lg[c] + lb[c]; uahm[(size_t)t * 1024 + c] = f2bf(siluf_(y)); }
}
__global__ __launch_bounds__(256) void k_qkconv(const bf16* zq, const bf16* zk, const float* w, const float* bq, bf16* qc, bf16* kc) {
    const int t = blockIdx.x, s = t % SEQ, tid = threadIdx.x;
#pragma unroll
    for (int j = 0; j < 4; ++j) { const int c = tid + 256 * j; const bf16* src = (c < 512) ? zq : zk; const int cc = c & 511; float a = bq[c];
#pragma unroll
        for (int k = 0; k < 4; ++k) { const int ss = s - 3 + k; if (ss >= 0) a += w[k * 1024 + c] * bf2f(src[(size_t)(t - 3 + k) * 512 + cc]); }
        ((c < 512) ? qc : kc)[(size_t)t * 512 + cc] = f2bf(siluf_(a)); }
}
__global__ __launch_bounds__(256) void k_mlstm_rec(const bf16* qc, const bf16* kc, const bf16* zv, const bf16* zo, const float* gates, const float* mng, bf16* uahm) {
    __shared__ float qs[128], ks[128], vs[128], part[2][128], red[8];
    const int b = blockIdx.x / NH, h = blockIdx.x % NH, tid = threadIdx.x, j = tid & 127, ih = tid >> 7;
    float C[64];
#pragma unroll
    for (int r = 0; r < 64; ++r) C[r] = 0.f;
    float nn = 0.f, m = 0.f;
    for (int s = 0; s < SEQ; ++s) {
        const size_t t = (size_t)b * SEQ + s;
        __syncthreads();
        if (tid < 128) { qs[tid] = bf2f(qc[t * 512 + h * 128 + tid]) * 0.08838834764831845f; ks[tid] = bf2f(kc[t * 512 + h * 128 + tid]); }
        else vs[tid - 128] = bf2f(zv[t * 512 + h * 128 + tid - 128]);
        const float li = gates[t * 8 + h], lf = gates[t * 8 + 4 + h];
        const float mn = fmaxf(lf + m, li), ip = __expf(li - mn), fp = __expf(lf + m - mn); m = mn;
        __syncthreads();
        const float vj = vs[j]; float p = 0.f;
#pragma unroll
        for (int r = 0; r < 64; ++r) { const int i = ih * 64 + r; C[r] = fp * C[r] + ip * ks[i] * vj; p += qs[i] * C[r]; }
        part[ih][j] = p;
        float dn = 0.f;
        if (tid < 128) { nn = fp * nn + ip * ks[tid]; dn = qs[tid] * nn; }
#pragma unroll
        for (int o = 32; o >= 1; o >>= 1) dn += __shfl_xor(dn, o);
        if ((tid & 63) == 0) red[tid >> 6] = dn;
        __syncthreads();
        float hv = 0.f, sm = 0.f;
        if (tid < 128) { const float den = red[0] + red[1]; hv = (part[0][tid] + part[1][tid]) / fmaxf(fabsf(den), __expf(-mn)); sm = hv; }
#pragma unroll
        for (int o = 32; o >= 1; o >>= 1) sm += __shfl_xor(sm, o);
        if ((tid & 63) == 0) red[4 + (tid >> 6)] = sm;
        __syncthreads();
        const float mu = (red[4] + red[5]) * (1.f / 128.f);
        float dv = (tid < 128) ? (hv - mu) : 0.f; float sq = dv * dv;
#pragma unroll
        for (int o = 32; o >= 1; o >>= 1) sq += __shfl_xor(sq, o);
        __syncthreads();
        if ((tid & 63) == 0) red[tid >> 6] = sq;
        __syncthreads();
        if (tid < 128) { const float var = (red[0] + red[1]) * (1.f / 128.f); const float y = dv * rsqrtf(var + LN_EPS) * mng[h * 128 + tid] * bf2f(zo[t * 512 + h * 128 + tid]);
            uahm[t * 1024 + 512 + h * 128 + tid] = f2bf(y); }
    }
}
__global__ __launch_bounds__(256) void k_h2route(const float* x1, const float* g2, const float* mod, const float* w_rg, const float* b_rg, const float* w_re, const float* b_re, bf16* h2, int* toke, float* tokw) {
    __shared__ float red[4]; __shared__ float lg[36];
    const int t = blockIdx.x, b = t / SEQ, tid = threadIdx.x;
    const float4 xv = ((const float4*)(x1 + (size_t)t * D))[tid];
    float ss = xv.x * xv.x + xv.y * xv.y + xv.z * xv.z + xv.w * xv.w;
    ss = block_sum256(ss, red);
    const float rstd = rsqrtf(ss * (1.f / D) + RMS_EPS);
    const float* sh = mod + b * 6144 + 3072, *sc = mod + b * 6144 + 4096;
    float hv[4]; const float xs[4] = {xv.x, xv.y, xv.z, xv.w};
#pragma unroll
    for (int j = 0; j < 4; ++j) { const int k = tid * 4 + j; hv[j] = xs[j] * rstd * g2[k] * (1.f + sc[k]) + sh[k]; }
    ushort4 o; o.x = f2bf(hv[0]); o.y = f2bf(hv[1]); o.z = f2bf(hv[2]); o.w = f2bf(hv[3]);
    ((ushort4*)(h2 + (size_t)t * D))[tid] = o;
    for (int j = 0; j < 36; ++j) {
        float a = 0.f;
#pragma unroll
        for (int i = 0; i < 4; ++i) { const int k = tid * 4 + i; a += hv[i] * ((j < 4) ? w_rg[k * 4 + j] : w_re[k * 32 + j - 4]); }
        a = block_sum256(a, red);
        if (tid == 0) lg[j] = a + ((j < 4) ? b_rg[j] : b_re[j - 4]);
    }
    __syncthreads();
    if (tid == 0) {
        int gs = 0; float gm = lg[0];
        for (int j = 1; j < 4; ++j) if (lg[j] > gm) { gm = lg[j]; gs = j; }
        float se = 0.f; for (int j = 0; j < 4; ++j) se += __expf(lg[j] - gm);
        const float pg = 1.f / se;
        const float* le = lg + 4 + gs * 8;
        int e0 = 0; float l0 = le[0];
        for (int j = 1; j < 8; ++j) if (le[j] > l0) { l0 = le[j]; e0 = j; }
        int e1 = -1; float l1 = -3.0e38f;
        for (int j = 0; j < 8; ++j) if (j != e0 && le[j] > l1) { l1 = le[j]; e1 = j; }
        const float r = __expf(l1 - l0);
        const float w0 = pg / (1.f + r), w1 = pg * r / (1.f + r);
        toke[t * 2] = gs * 8 + e0; toke[t * 2 + 1] = gs * 8 + e1; tokw[t * 2] = w0; tokw[t * 2 + 1] = w1;
    }
}
__global__ __launch_bounds__(256) void k_lists(const int* toke, const float* tokw, unsigned* cnt, int* listt, float* listw) {
    const int i = blockIdx.x * 256 + threadIdx.x; const int e = toke[i]; const unsigned pos = atomicAdd(cnt + 16 * e, 1u);
    listt[e * 16384 + pos] = i; listw[e * 16384 + pos] = tokw[i];
}
__global__ __launch_bounds__(256) void k_moe(const bf16* h2, const int* toke, const float* tokw, const float* wg, const float* wu, const float* wd, bf16* ys) {
    __shared__ float hs[1024]; __shared__ float hid[512];
    const int a = blockIdx.x, t = a >> 1, tid = threadIdx.x;
    const int e = toke[a]; const float w = tokw[a];
    for (int k = tid; k < 1024; k += 256) hs[k] = bf2f(h2[(size_t)t * 1024 + k]);
    __syncthreads();
    const float* Gp = wg + (size_t)e * 1024 * 512, *U = wu + (size_t)e * 1024 * 512, *Dn = wd + (size_t)e * 512 * 1024;
    float g0 = 0.f, g1 = 0.f, u0 = 0.f, u1 = 0.f;
    for (int k = 0; k < 1024; ++k) { const float hk = hs[k]; g0 += hk * Gp[(size_t)k * 512 + tid]; g1 += hk * Gp[(size_t)k * 512 + 256 + tid]; u0 += hk * U[(size_t)k * 512 + tid]; u1 += hk * U[(size_t)k * 512 + 256 + tid]; }
    hid[tid] = siluf_(g0) * u0; hid[tid + 256] = siluf_(g1) * u1;
    __syncthreads();
    float y[4] = {0.f, 0.f, 0.f, 0.f};
    for (int j = 0; j < 512; ++j) { const float hj = hid[j];
#pragma unroll
        for (int i = 0; i < 4; ++i) y[i] += hj * Dn[(size_t)j * 1024 + tid + 256 * i]; }
#pragma unroll
    for (int i = 0; i < 4; ++i) ys[(size_t)a * 1024 + tid + 256 * i] = f2bf(w * y[i]);
}
__global__ __launch_bounds__(256) void k_final(const float* x1, const bf16* ys, const float* mod, const float* gf, float* out) {
    __shared__ float red[4];
    const int t = blockIdx.x, b = t / SEQ, tid = threadIdx.x;
    const float4 xv = ((const float4*)(x1 + (size_t)t * D))[tid];
    const ushort4 y0 = ((const ushort4*)(ys + (size_t)t * 2048))[tid], y1 = ((const ushort4*)(ys + (size_t)t * 2048 + 1024))[tid];
    const float* gt = mod + b * 6144 + 5120 + tid * 4;
    float v[4];
    v[0] = xv.x + gt[0] * (bf2f(y0.x) + bf2f(y1.x)); v[1] = xv.y + gt[1] * (bf2f(y0.y) + bf2f(y1.y));
    v[2] = xv.z + gt[2] * (bf2f(y0.z) + bf2f(y1.z)); v[3] = xv.w + gt[3] * (bf2f(y0.w) + bf2f(y1.w));
    float ss = v[0] * v[0] + v[1] * v[1] + v[2] * v[2] + v[3] * v[3];
    ss = block_sum256(ss, red);
    const float rstd = rsqrtf(ss * (1.f / D) + RMS_EPS);
    float4 o; o.x = v[0] * rstd * gf[tid * 4]; o.y = v[1] * rstd * gf[tid * 4 + 1]; o.z = v[2] * rstd * gf[tid * 4 + 2]; o.w = v[3] * rstd * gf[tid * 4 + 3];
    ((float4*)(out + (size_t)t * D))[tid] = o;
}
#endif


#ifndef DBG_BENCH
#define DBG_BENCH 0
#endif
#if DBG_BENCH
__global__ void __launch_bounds__(512, 2) k_bench_a(const float* x, float* dummy) {
    extern __shared__ __attribute__((aligned(16))) unsigned char lds_b[];
    const int tid = threadIdx.x, lane = tid & 63, wave = tid >> 6, tile = blockIdx.x;
    f32x4 nx[4][4]; float acc = 0.f;
#pragma unroll
    for (int p = 0; p < 4; ++p)
#pragma unroll
        for (int j = 0; j < 4; ++j) nx[p][j] = *(const f32x4*)(x + ((size_t)tile * 64 + wave + 8 * p) * 1024 + 256 * j + 4 * lane);
#pragma unroll
    for (int r8 = 0; r8 < 8; ++r8) {
        const size_t row = (size_t)tile * 64 + wave + 8 * r8;
#pragma unroll
        for (int j = 0; j < 4; ++j) acc += (nx[r8 & 3][j][0] + nx[r8 & 3][j][1]) + (nx[r8 & 3][j][2] + nx[r8 & 3][j][3]);
        if (r8 + 4 < 8) {
#pragma unroll
            for (int j = 0; j < 4; ++j) nx[r8 & 3][j] = *(const f32x4*)(x + (row + 32) * 1024 + 256 * j + 4 * lane); }
    }
    if (acc == 123.456f) dummy[tid] = acc;
}
__global__ void __launch_bounds__(256) k_bench_b(const float* x, float* dummy) {
    const int tid = threadIdx.x, lane = tid & 63, wave = tid >> 6; const size_t row = (size_t)blockIdx.x * 4 + wave; float acc = 0.f;
#pragma unroll
    for (int j = 0; j < 4; ++j) { const f32x4 v = *(const f32x4*)(x + row * 1024 + 256 * j + 4 * lane); acc += (v[0] + v[1]) + (v[2] + v[3]); }
    if (acc == 123.456f) dummy[tid] = acc;
}
#endif
#if DBG_BENCH >= 4
template <int LVL>
__global__ void __launch_bounds__(512, 2) k_bench_d(const float* x, const float* g1, const float* mod, bf16* h1, float* dummy) {
    extern __shared__ __attribute__((aligned(16))) unsigned char lds_b[];
    const int tid = threadIdx.x, lane = tid & 63, wave = tid >> 6, tile = blockIdx.x, b = tile / 32;
    float sc[4][4], sh[4][4];
#pragma unroll
    for (int j = 0; j < 4; ++j) { const int k = 256 * j + 4 * lane; const f32x4 gv = *(const f32x4*)(g1 + k), sv = *(const f32x4*)(mod + b * 6144 + 1024 + k), hv = *(const f32x4*)(mod + b * 6144 + k);
#pragma unroll
        for (int i = 0; i < 4; ++i) { sc[j][i] = gv[i] * (1.f + sv[i]); sh[j][i] = hv[i]; } }
    f32x4 nx[4][4];
#pragma unroll
    for (int p = 0; p < 4; ++p)
#pragma unroll
        for (int j = 0; j < 4; ++j) nx[p][j] = *(const f32x4*)(x + ((size_t)tile * 64 + wave + 8 * p) * 1024 + 256 * j + 4 * lane);
#pragma unroll
    for (int r8 = 0; r8 < 8; ++r8) {
        const size_t row = (size_t)tile * 64 + wave + 8 * r8;
        f32x4 v[4]; float ss = 0.f;
#pragma unroll
        for (int j = 0; j < 4; ++j) { v[j] = nx[r8 & 3][j]; ss += (v[j][0] * v[j][0] + v[j][1] * v[j][1]) + (v[j][2] * v[j][2] + v[j][3] * v[j][3]); }
        if (r8 + 4 < 8) {
#pragma unroll
            for (int j = 0; j < 4; ++j) nx[r8 & 3][j] = *(const f32x4*)(x + (row + 32) * 1024 + 256 * j + 4 * lane); }
        asm volatile("" ::: "memory");
        const float rstd = rsqrtf(wave_sum(ss) * (1.f / 1024.f) + RMS_EPS);
        if (LVL >= 5) {
            float g[8];
#pragma unroll
            for (int q = 0; q < 8; ++q) g[q] = 0.f;
#pragma unroll
            for (int j = 0; j < 4; ++j) { float hh[4];
#pragma unroll
                for (int i = 0; i < 4; ++i) hh[i] = v[j][i] * rstd * sc[j][i] + sh[j][i];
                v2u o; o.x = pk2(hh[0], hh[1]); o.y = pk2(hh[2], hh[3]);
                *(v2u*)(h1 + row * 1024 + 256 * j + 4 * lane) = o;
                if (LVL >= 6) {
#pragma unroll
                    for (int i = 0; i < 4; ++i) { const LAS float* tp = (const LAS float*)lds_b + ((4 * j + i) * 64 + lane) * 8; f32x4 w0, w1;
                        if (LVL == 8) { w0 = (f32x4){1.f, 2.f, 3.f, 4.f}; w1 = (f32x4){5.f, 6.f, 7.f, 8.f}; } else { w0 = *(const LAS f32x4*)tp; w1 = *(const LAS f32x4*)(tp + 4); }
                        g[0] += hh[i] * w0[0]; g[1] += hh[i] * w0[1]; g[2] += hh[i] * w0[2]; g[3] += hh[i] * w0[3]; g[4] += hh[i] * w1[0]; g[5] += hh[i] * w1[1]; g[6] += hh[i] * w1[2]; g[7] += hh[i] * w1[3]; } } }
            if (LVL == 6 || LVL == 8) { const float t = ((g[0] + g[1]) + (g[2] + g[3])) + ((g[4] + g[5]) + (g[6] + g[7])); if (t == 123.456f) dummy[row] = t; }
            if (LVL == 7) { float mine = 0.f;
#pragma unroll
                for (int q = 0; q < 8; ++q) { const float sq = wave_sum(g[q]); mine = (lane == q) ? sq : mine; }
                if (lane < 8) dummy[row * 8 + lane] = (lane < 4) ? mine : logsigmoidf_(mine); }
        } else if (lane == 0) dummy[row] = rstd;
    }
}
#endif
#if DBG_BENCH == 3
__global__ void __launch_bounds__(512, 2) k_bench_c(float* dummy, float seed) {
    extern __shared__ __attribute__((aligned(16))) unsigned char lds_b[];
    float a0 = seed + threadIdx.x, a1 = a0 + 1.f, a2 = a0 + 2.f, a3 = a0 + 3.f; const float m = 1.0000001f, c = 1e-9f;
#pragma unroll 1
    for (int i = 0; i < 2048; ++i) {
#pragma unroll
        for (int j = 0; j < 4; ++j) { a0 = a0 * m + c; a1 = a1 * m + c; a2 = a2 * m + c; a3 = a3 * m + c; }
    }
    if (a0 + a1 + a2 + a3 == 123.456f) dummy[threadIdx.x] = a0;
}
#endif
#if MK_ONE
constexpr int NKERN = 1;
static const void* const mk_kernels[NKERN] = {(const void*)mk_fwd<0, NPHASE>};
#else
constexpr int NKERN = NPHASE;
static const void* const mk_kernels[NKERN] = {(const void*)mk_fwd<0, 1>, (const void*)mk_fwd<1, 2>, (const void*)mk_fwd<2, 3>, (const void*)mk_fwd<3, 4>, (const void*)mk_fwd<4, 5>, (const void*)mk_fwd<5, 6>,
    (const void*)mk_fwd<6, 7>, (const void*)mk_fwd<7, 8>, (const void*)mk_fwd<8, 9>, (const void*)mk_fwd<9, 10>, (const void*)mk_fwd<10, 11>};
#endif
extern "C" void kernel_launch(void* const* d_in, const int* in_sizes, int n_in, void* d_out, int out_size, void* d_ws, size_t ws_size, hipStream_t stream) {
    static int grid = 0;
    if (grid == 0) {
        int dev = 0, cus = 0;
        if (hipGetDevice(&dev) != hipSuccess || hipDeviceGetAttribute(&cus, hipDeviceAttributeMultiprocessorCount, dev) != hipSuccess) { grid = -1; return; }
        for (int k = 0; k < NKERN; ++k) if (hipFuncSetAttribute(mk_kernels[k], hipFuncAttributeMaxDynamicSharedMemorySize, LDS_BYTES) != hipSuccess) { grid = -1; return; }
        int per_cu = 0;
        (void)hipOccupancyMaxActiveBlocksPerMultiprocessor(&per_cu, mk_kernels[0], NTHREADS, LDS_BYTES);
        (void)hipGetLastError();
        grid = (per_cu >= 1) ? cus : -1;
    }
    if (grid < 0) return;
    (void)hipMemsetAsync((char*)d_ws + WS_CTL, 0, CTL_ZERO_BYTES, stream);
    Args a{};
    for (int i = 0; i < 26; ++i) a.in[i] = (const float*)d_in[i];
    a.out = (float*)d_out; a.ws = (unsigned char*)d_ws;
#if MK_ONE
    a.ph_lo = 0; a.ph_hi = NPHASE;
    { void* args[] = {&a}; (void)hipLaunchKernel(mk_kernels[0], dim3(grid), dim3(NTHREADS), args, LDS_BYTES, stream); }
#else
    unsigned char* ws = (unsigned char*)d_ws; float* out = (float*)d_out;
    float* mod = (float*)(ws + WS_MOD); float* gates = (float*)(ws + WS_GATES); int* toke = (int*)(ws + WS_TOKE); float* tokw = (float*)(ws + WS_TOKW);
    bf16* hb = (bf16*)(ws + WS_H); bf16* zu = (bf16*)(ws + WS_ZU); bf16* zq = (bf16*)(ws + WS_ZQ); bf16* zk = (bf16*)(ws + WS_ZK); bf16* zv = (bf16*)(ws + WS_ZV); bf16* zo = (bf16*)(ws + WS_ZO);
    bf16* zga = (bf16*)(ws + WS_ZGA); bf16* zgb = (bf16*)(ws + WS_ZGB); bf16* qc = (bf16*)(ws + WS_QC); bf16* kc = (bf16*)(ws + WS_KC); bf16* uahm = (bf16*)(ws + WS_UAHM);
    bf16* merged = (bf16*)(ws + WS_MERGED); bf16* ys = (bf16*)(ws + WS_YS);
    (void)mod; (void)gates; (void)toke; (void)tokw; (void)hb; (void)zu; (void)zq; (void)zk; (void)zv; (void)zo; (void)zga; (void)zgb; (void)qc; (void)kc; (void)uahm; (void)merged; (void)ys; (void)out;
#ifndef DBG_NPH
#define DBG_NPH NPHASE
#endif
#if DBG_BENCH == 1
    { static bool once = false; if (!once) { (void)hipFuncSetAttribute((const void*)k_bench_a, hipFuncAttributeMaxDynamicSharedMemorySize, LDS_BYTES); once = true; }
      for (int rep = 0; rep < 4; ++rep) hipLaunchKernelGGL(k_bench_a, dim3(256), dim3(512), LDS_BYTES, stream, (const float*)d_in[0], (float*)((char*)d_ws + WS_TOKE)); }
#elif DBG_BENCH >= 4
    { static bool once = false; if (!once) { (void)hipFuncSetAttribute((const void*)k_bench_d<DBG_BENCH>, hipFuncAttributeMaxDynamicSharedMemorySize, LDS_BYTES); once = true; }
      (void)hipMemsetAsync((char*)d_ws + WS_MOD, 0, 256 * 1024, stream);
      for (int rep = 0; rep < 2; ++rep) hipLaunchKernelGGL(k_bench_d<DBG_BENCH>, dim3(256), dim3(512), LDS_BYTES, stream, (const float*)d_in[0], (const float*)d_in[4], (const float*)((char*)d_ws + WS_MOD), (bf16*)((char*)d_ws + WS_H), (float*)((char*)d_ws + WS_TOKE)); }
#elif DBG_BENCH == 3
    { static bool once = false; if (!once) { (void)hipFuncSetAttribute((const void*)k_bench_c, hipFuncAttributeMaxDynamicSharedMemorySize, LDS_BYTES); once = true; }
      for (int rep = 0; rep < 2; ++rep) hipLaunchKernelGGL(k_bench_c, dim3(256), dim3(512), LDS_BYTES, stream, (float*)((char*)d_ws + WS_TOKE), 1.0f); }
#elif DBG_BENCH == 2
    for (int rep = 0; rep < 4; ++rep) hipLaunchKernelGGL(k_bench_b, dim3(4096), dim3(256), 0, stream, (const float*)d_in[0], (float*)((char*)d_ws + WS_TOKE));
#endif
    for (int ph = 0; ph < DBG_NPH; ++ph) {
        a.ph_lo = ph; a.ph_hi = ph + 1; a.flags = 0;
        bool mk = true;
#if NAIVE_MASK
        const float* const* I = (const float* const*)d_in;
        if ((NAIVE_MASK >> ph) & 1) {
            mk = false;
            switch (ph) {
            case 0: k_mod<<<8 * 6144 / 256, 256, 0, stream>>>(I[1], I[2], I[3], mod); mk = true; break;
            case 1: k_h1<<<T, 256, 0, stream>>>(I[0], I[4], mod, I[5], I[6], hb, gates); break;
            case 2: k_ngemm<NEpi1><<<dim3((DIN + 63) / 64, T / 64), 256, 0, stream>>>(hb, 1024, I[5], DIN, DIN, 1024, NEpi1{out, zq, zk, zv, zo, zga, zgb});
                    k_glu<<<T * 512 / 256, 256, 0, stream>>>(out, zu); a.flags = (DBG_CLS) << 8; mk = (DBG_CLS) != 0;
                    k_fixw1t<<<2048 * 1024 / 256, 256, 0, stream>>>(I[5], (bf16*)(ws + WS_W1T)); break;
            case 3: k_conva<<<T, 256, 0, stream>>>(zu, I[7], I[8], I[9], I[10], uahm); mk = ((NAIVE_MASK >> 4) & 1) ? false : true; break;
            case 4: k_qkconv<<<T, 256, 0, stream>>>(zq, zk, I[12], I[13], qc, kc);
                    k_mlstm_rec<<<BATCH * NH, 256, 0, stream>>>(qc, kc, zv, zo, gates, I[14], uahm); break;
            case 5: k_ngemm<NEpi2a><<<dim3(16, T / 64), 256, 0, stream>>>(uahm, 1024, I[11], 1024, 1024, 512, NEpi2a{out, zga});
                    k_ngemm<NEpi2b><<<dim3(16, T / 64), 256, 0, stream>>>(uahm + 512, 1024, I[15], 1024, 1024, 512, NEpi2b{out, zgb, merged}); break;
            case 6: k_ngemm<NEpi3><<<dim3(16, T / 64), 256, 0, stream>>>(merged, 1024, I[16], 1024, 1024, 1024, NEpi3{I[0], mod, out}); break;
            case 7: k_h2route<<<T, 256, 0, stream>>>(out, I[17], mod, I[18], I[19], I[20], I[21], hb, toke, tokw);
                    k_lists<<<T * 2 / 256, 256, 0, stream>>>(toke, tokw, (unsigned*)(ws + WS_CTL) + CW_CNT, (int*)(ws + WS_LISTT), (float*)(ws + WS_LISTW));
                    a.flags = 1; mk = true; break;
            case 8: break;
            case 9: k_moe<<<T * 2, 256, 0, stream>>>(hb, toke, tokw, I[22], I[23], I[24], (bf16*)(ws + WS_ZU)); break;
            case 10: k_final<<<T, 256, 0, stream>>>(out, (const bf16*)(ws + WS_ZU), mod, I[25], out); break;
            }
        }
#endif
        if (mk) { void* args[] = {&a}; (void)hipLaunchKernel(mk_kernels[ph], dim3(grid), dim3(NTHREADS), args, LDS_BYTES, stream);
            if ((DBG_HREP >> ph) & 1) { if (ph == 7) a.flags |= DBG_F7; if (ph == 1) a.flags |= DBG_F1; if (ph == 4) a.flags |= DBG_F4; (void)hipLaunchKernel(mk_kernels[ph], dim3(grid), dim3(NTHREADS), args, LDS_BYTES, stream); } }
    }
#endif
}
```

```cpp
#include <hip/hip_runtime.h>
#include <stdint.h>
#include <cstdio>

#ifndef MK_ONE
#define MK_ONE 1
#endif
#ifndef NAIVE_MASK
#define NAIVE_MASK 0
#endif
#ifndef DBG_NPH
#define DBG_NPH 11
#endif
#ifndef P1_MFMA
#define P1_MFMA 0
#endif
#if P1_MFMA
#define P1_FN p1_h1_mfma
#else
#define P1_FN p1_h1
#endif
#ifndef XB_EARLY_ACQ
#define XB_EARLY_ACQ 1
#endif
#ifndef USE_XCD_BARRIER
#define USE_XCD_BARRIER 1
#endif
#ifndef DBG_XBAR
#define DBG_XBAR 0
#endif
#ifndef DBG_F4
#define DBG_F4 0
#endif
#ifndef DBG_F1
#define DBG_F1 0
#endif
#ifndef DBG_F7
#define DBG_F7 6
#endif
#ifndef DBG_HREP
#define DBG_HREP 0
#endif
#ifndef DBG_REP
#define DBG_REP 0
#endif
#if DBG_REP
#define REPK(k) for (int _r = 0; _r < 1 + ((DBG_REP >> (k)) & 1); ++_r)
#define REPSYNC() __syncthreads()
#else
#define REPK(k)
#define REPSYNC() do {} while (0)
#endif
#ifndef DBG_CLS
#define DBG_CLS 0
#endif
#ifndef DBG_GATEFIRST
#define DBG_GATEFIRST 0
#endif

typedef unsigned short bf16;
#define DEV __device__ __forceinline__
#define LAS __attribute__((address_space(3)))
typedef short bf16x8 __attribute__((ext_vector_type(8)));
typedef float f32x4 __attribute__((ext_vector_type(4)));
typedef unsigned v4u __attribute__((ext_vector_type(4)));
typedef unsigned v2u __attribute__((ext_vector_type(2)));

constexpr int BATCH = 8, SEQ = 2048, D = 1024, T = BATCH * SEQ;
constexpr int DIN = 5128, NH = 4;
constexpr float RMS_EPS = 1e-6f, LN_EPS = 1e-5f;
constexpr int NWAVES = 8, NTHREADS = 512;

DEV float bf2f(bf16 v) { return __uint_as_float(((unsigned)v) << 16); }
DEV float bflo(unsigned w) { return __uint_as_float(w << 16); }
DEV float bfhi(unsigned w) { return __uint_as_float(w & 0xffff0000u); }
DEV unsigned f2bfu(float f) { unsigned u = __float_as_uint(f); return (u + 0x7fffu + ((u >> 16) & 1u)) >> 16; }
DEV unsigned pk2(float lo, float hi);
DEV bf16 f2bf(float f) { return (bf16)(pk2(f, f) & 0xffffu); }
DEV unsigned pk2(float lo, float hi) { unsigned r; asm volatile("v_cvt_pk_bf16_f32 %0, %1, %2" : "=v"(r) : "v"(lo), "v"(hi)); return r; }
DEV float sigmoidf_(float x) { return __builtin_amdgcn_rcpf(1.f + __expf(-x)); }
DEV float siluf_(float x) { return x * __builtin_amdgcn_rcpf(1.f + __expf(-x)); }
DEV float logsigmoidf_(float x) { return fminf(x, 0.f) - log1pf(__expf(-fabsf(x))); }
template <int CTRL> DEV float dpp0(float v) { return __int_as_float(__builtin_amdgcn_update_dpp(0, __float_as_int(v), CTRL, 0xf, 0xf, true)); }
template <int CTRL> DEV float dppk(float v) { return __int_as_float(__builtin_amdgcn_update_dpp(__float_as_int(v), __float_as_int(v), CTRL, 0xf, 0xf, false)); }
DEV float rdlane(float v, int l) { return __int_as_float(__builtin_amdgcn_readlane(__float_as_int(v), l)); }
DEV float row16_sum(float v) {
    v += dpp0<0xB1>(v); v += dpp0<0x4E>(v); v += dpp0<0x141>(v); v += dpp0<0x140>(v); return v; }
DEV float wave_sum(float v) { v = row16_sum(v); return (rdlane(v, 0) + rdlane(v, 16)) + (rdlane(v, 32) + rdlane(v, 48)); }
DEV float wave_scan_add(float v, int lane) {
    v += dpp0<0x111>(v); v += dpp0<0x112>(v); v += dpp0<0x114>(v); v += dpp0<0x118>(v);
    const float r0 = rdlane(v, 15), r1 = rdlane(v, 31), r2 = rdlane(v, 47);
    return v + ((lane >= 48) ? (r0 + r1) + r2 : (lane >= 32) ? (r0 + r1) : (lane >= 16) ? r0 : 0.f); }
DEV float wave_scan_max(float v, int lane) {
    v = fmaxf(v, dppk<0x111>(v)); v = fmaxf(v, dppk<0x112>(v)); v = fmaxf(v, dppk<0x114>(v)); v = fmaxf(v, dppk<0x118>(v));
    const float r0 = rdlane(v, 15), r1 = rdlane(v, 31), r2 = rdlane(v, 47);
    const float p = (lane >= 48) ? fmaxf(fmaxf(r0, r1), r2) : (lane >= 32) ? fmaxf(r0, r1) : (lane >= 16) ? r0 : -3.0e38f;
    return fmaxf(v, p); }
#define LDS_WAIT() asm volatile("s_waitcnt lgkmcnt(0)" ::: "memory")

constexpr size_t MiB = 1u << 20;
constexpr size_t WS_CTL = 0, CTL_ZERO_BYTES = 65536;
constexpr size_t WS_MOD = 1 * MiB;
constexpr size_t WS_GATES = 1 * MiB + 256 * 1024;
constexpr size_t WS_STSC = 1 * MiB + 768 * 1024;
constexpr size_t WS_RBIAS = 1 * MiB + 800 * 1024;
constexpr size_t WS_WIF = 1 * MiB + 832 * 1024;
constexpr size_t WS_RW = 6 * MiB + 256 * 1024;
constexpr size_t WS_TOKE = 6 * MiB;
constexpr size_t WS_TOKW = 6 * MiB + 128 * 1024;
constexpr size_t WS_LISTT = 2 * MiB;
constexpr size_t WS_LISTW = 4 * MiB;
constexpr size_t WS_W1T = 8 * MiB;
constexpr size_t WS_W2T = 18 * MiB;
constexpr size_t WS_W3T = 20 * MiB;
constexpr size_t WS_STATE = 22 * MiB;
constexpr size_t WS_H = 40 * MiB;
constexpr size_t WS_ZU = 72 * MiB, WS_ZQ = 88 * MiB, WS_ZK = 104 * MiB, WS_ZV = 120 * MiB, WS_ZO = 136 * MiB;
constexpr size_t WS_ZGA = 152 * MiB, WS_ZGB = 184 * MiB;
constexpr size_t WS_UAHM = 216 * MiB;
constexpr size_t WS_MERGED = WS_ZQ;
constexpr size_t WS_WGU = 120 * MiB;
constexpr size_t WS_WD = 184 * MiB;
constexpr size_t WS_ACT = 216 * MiB;
constexpr size_t WS_YS = 40 * MiB;
constexpr size_t WS_QC = WS_H, WS_KC = WS_H + 16 * MiB;
constexpr int CW_BAR = 4096, CW_CNT = 8192, CW_MODCNT = 9216, CW_FLATBAR = 9280;

constexpr int LDS_TAB = 131072;
constexpr int LDS_MISC = 147456;
constexpr int LDS_BYTES = 151552;

struct Args { const float* in[26]; float* out; unsigned char* ws; int ph_lo, ph_hi, flags, pad; };

namespace pg8 {
constexpr int BM = 256, BK = 64, HALF = 128, HTB = HALF * BK * 2, NXCD = 8, WGM = 8;
DEV int lds_byte(int r, int c) { const int st = (r >> 4) * 2 + (c >> 5), rr = r & 15, cc = c & 31, ob = rr * 64 + cc * 2; return st * 1024 + (ob ^ (((ob >> 9) & 1) << 5)); }
DEV void stage_rc(int b, int& R, int& C) { const int st = b / 1024, sb = b % 1024, swz = sb ^ (((sb >> 9) & 1) << 5); R = (st >> 1) * 16 + swz / 64; C = (st & 1) * 32 + (swz % 64) / 2; }
DEV int perm32(int rho) { const int n = rho >> 4, i = rho & 15; return 8 * (i >> 2) + 4 * n + (i & 3); }
DEV unsigned cvt_pk_bf16(float lo, float hi) { unsigned r; asm volatile("v_cvt_pk_bf16_f32 %0, %1, %2" : "=v"(r) : "v"(lo), "v"(hi)); return r; }

struct Unit { int pm, pn; unsigned ak, bk; int slot, valid, arow0; };

struct StaticOrder {
    int nM, nN, nwg, G, c;
    DEV void init(int M, int N, int G_, int c_) { nM = M / BM; nN = N / BM; nwg = nM * nN; G = G_; c = c_; }
    DEV bool tile(int L, int& pm, int& pn) const {
        if (L >= nwg) return false;
        int wgid = L; { const int q = nwg / NXCD, r = nwg % NXCD, xcd = wgid % NXCD, off = wgid / NXCD; wgid = (xcd < r ? xcd * (q + 1) : r * (q + 1) + (xcd - r) * q) + off; }
        const int nig = WGM * nN, gid = wgid / nig, fm = gid * WGM, gsz = (nM - fm) < WGM ? (nM - fm) : WGM;
        pm = fm + ((wgid % nig) % gsz); pn = (wgid % nig) / gsz; return true;
    }
    DEV bool next(int i, Unit& u) const { u.ak = 0; u.bk = 0; u.slot = 0; u.valid = 256; u.arow0 = 0; return tile(i * G + c, u.pm, u.pn); }
};

template <class Prob, class Epi, class Sched, bool ALIGN_EPI, bool SKIP = false>
DEV void gemm_phase(LAS unsigned char* lds, const Prob& P, const Sched& S, const Epi& E, const int K) {
    int tid = threadIdx.x; asm volatile("" : "+v"(tid));
    const int wid = __builtin_amdgcn_readfirstlane(tid >> 6), lane = tid & 63, wr = wid >> 2, wc = wid & 3, fr = lane & 15, fq = lane >> 4;
    const int nt = K / BK;
    int R[2], C[2], Rb[2];
#pragma unroll
    for (int i = 0; i < 2; ++i) { stage_rc(tid * 16 + i * 8192, R[i], C[i]); Rb[i] = Epi::PERM ? ((R[i] & ~31) + perm32(R[i] & 31)) : R[i]; }
    const unsigned kstep = BK * 2;
    const unsigned ldsw = (unsigned)wid * 1024u;
    const int aoff = lds_byte(wr * 64 + fr, fq * 8), boff = lds_byte(wc * 32 + fr, fq * 8);
    const char* const Abase = (const char*)P.A; const char* const Bbase = (const char*)P.B;
#define PG8_SA(b, h) (((b) * 2 + (h)) * HTB)
#define PG8_SB(b, h) ((4 + (b) * 2 + (h)) * HTB)
#define PG8_STAGE(bufoff, base, offs, kb) do { _Pragma("unroll") for (int _i = 0; _i < 2; ++_i) \
        __builtin_amdgcn_global_load_lds((const unsigned*)((base) + (size_t)((offs)[_i] + (kb))), (LAS unsigned*)(lds + (bufoff) + ldsw + _i * 8192), 16, 0, 0); } while (0)
#define PG8_LDA(dst, b, h) do { _Pragma("unroll") for (int m = 0; m < 4; ++m) _Pragma("unroll") for (int k = 0; k < 2; ++k) dst[m][k] = *(const LAS bf16x8*)(lds + PG8_SA(b, h) + aoff + m * 2048 + k * 1024); } while (0)
#define PG8_LDB(dst, b, h) do { _Pragma("unroll") for (int n = 0; n < 2; ++n) _Pragma("unroll") for (int k = 0; k < 2; ++k) dst[n][k] = *(const LAS bf16x8*)(lds + PG8_SB(b, h) + boff + n * 2048 + k * 1024); } while (0)
#define PG8_MMA(ai, bj, At, Bt) do { __builtin_amdgcn_s_setprio(1); _Pragma("unroll") for (int m = 0; m < 4; ++m) _Pragma("unroll") for (int n = 0; n < 2; ++n) _Pragma("unroll") for (int k = 0; k < 2; ++k) \
        acc[ai][bj][m][n] = __builtin_amdgcn_mfma_f32_16x16x32_bf16(Bt[n][k], At[m][k], acc[ai][bj][m][n], 0, 0, 0); __builtin_amdgcn_s_setprio(0); } while (0)
#define PG8_WAIT_V(n) asm volatile("s_waitcnt vmcnt(" #n ")" ::: "memory")
#define PG8_WAIT_L(n) asm volatile("s_waitcnt lgkmcnt(" #n ")" ::: "memory")
#define PG8_BAR __builtin_amdgcn_s_barrier()
#define PG8_SCHED __builtin_amdgcn_sched_barrier(0)
    Unit cur, nxt; int ui = 0;
    if (!S.next(0, cur)) return;
    f32x4 acc[2][2][4][2];
#pragma unroll
    for (int a = 0; a < 2; ++a)
#pragma unroll
        for (int b = 0; b < 2; ++b)
#pragma unroll
            for (int m = 0; m < 4; ++m)
#pragma unroll
                for (int n = 0; n < 2; ++n) acc[a][b][m][n] = (f32x4){0.f, 0.f, 0.f, 0.f};
    bf16x8 At[4][2], B0[2][2], B1[2][2];
    unsigned ca[2][2], cb[2][2], na[2][2], nb[2][2];
    P.aoffs(cur, R, C, ca); P.boffs(cur, Rb, C, cb);
    PG8_STAGE(PG8_SB(0, 0), Bbase, cb[0], 0u); PG8_STAGE(PG8_SB(0, 1), Bbase, cb[1], 0u); PG8_STAGE(PG8_SA(0, 0), Abase, ca[0], 0u); PG8_STAGE(PG8_SA(0, 1), Abase, ca[1], 0u);
    if (wr == 1) PG8_BAR;
    PG8_WAIT_V(2); PG8_BAR;
    PG8_STAGE(PG8_SB(1, 0), Bbase, cb[0], kstep); PG8_STAGE(PG8_SA(1, 0), Abase, ca[0], kstep); PG8_STAGE(PG8_SB(1, 1), Bbase, cb[1], kstep);
    PG8_WAIT_V(6); PG8_BAR;
    for (;;) {
        const bool has_next = S.next(ui + 1, nxt);
        if (has_next) { P.aoffs(nxt, R, C, na); P.boffs(nxt, Rb, C, nb); }
        else {
#pragma unroll
            for (int h = 0; h < 2; ++h)
#pragma unroll
                for (int i = 0; i < 2; ++i) { na[h][i] = ca[h][i]; nb[h][i] = cb[h][i]; } }
        const bool do0 = !(SKIP && cur.valid <= 64 && wr == 1), do1 = !(SKIP && cur.valid <= 128) && do0;
        for (int t = 0; t < nt; t += 2) {
            const bool last = (t == nt - 2);
            const unsigned k1 = (unsigned)(t + 1) * kstep;
            const unsigned kb2 = last ? 0u : (unsigned)(t + 2) * kstep, kb3 = kb2 + kstep;
            unsigned a2[2][2], b2[2][2];
#pragma unroll
            for (int h = 0; h < 2; ++h)
#pragma unroll
                for (int i = 0; i < 2; ++i) { a2[h][i] = last ? na[h][i] : ca[h][i]; b2[h][i] = last ? nb[h][i] : cb[h][i]; }
            PG8_LDB(B0, 0, 0); PG8_LDB(B1, 0, 1); PG8_SCHED; PG8_LDA(At, 0, 0); PG8_STAGE(PG8_SA(1, 1), Abase, ca[1], k1);
            PG8_WAIT_V(8); PG8_WAIT_L(0); PG8_BAR; if (do0) { PG8_MMA(0, 0, At, B0); PG8_MMA(0, 1, At, B1); } PG8_BAR; PG8_SCHED;
            PG8_LDA(At, 0, 1); PG8_STAGE(PG8_SB(0, 0), Bbase, b2[0], kb2); PG8_STAGE(PG8_SB(0, 1), Bbase, b2[1], kb2); PG8_STAGE(PG8_SA(0, 0), Abase, a2[0], kb2);
            PG8_WAIT_V(8); PG8_WAIT_L(0); PG8_BAR; if (do1) { PG8_MMA(1, 0, At, B0); PG8_MMA(1, 1, At, B1); } PG8_BAR; PG8_SCHED;
            PG8_LDB(B0, 1, 0); PG8_LDB(B1, 1, 1); PG8_SCHED; PG8_LDA(At, 1, 0); PG8_STAGE(PG8_SA(0, 1), Abase, a2[1], kb2);
            PG8_WAIT_V(8); PG8_WAIT_L(0); PG8_BAR; if (do0) { PG8_MMA(0, 0, At, B0); PG8_MMA(0, 1, At, B1); } PG8_BAR; PG8_SCHED;
            PG8_LDA(At, 1, 1); PG8_STAGE(PG8_SB(1, 0), Bbase, b2[0], kb3); PG8_STAGE(PG8_SB(1, 1), Bbase, b2[1], kb3); PG8_STAGE(PG8_SA(1, 0), Abase, a2[0], kb3);
            PG8_WAIT_V(8); PG8_WAIT_L(0); PG8_BAR; if (do1) { PG8_MMA(1, 0, At, B0); PG8_MMA(1, 1, At, B1); } PG8_BAR; PG8_SCHED;
        }
        if constexpr (ALIGN_EPI) { if (wr == 0) PG8_BAR; }
        E(acc, cur, wr, wc, fr, fq);
        if (!has_next) break;
        if (!E.keep(cur)) {
#pragma unroll
            for (int a = 0; a < 2; ++a)
#pragma unroll
                for (int b = 0; b < 2; ++b)
#pragma unroll
                    for (int m = 0; m < 4; ++m)
#pragma unroll
                        for (int n = 0; n < 2; ++n) acc[a][b][m][n] = (f32x4){0.f, 0.f, 0.f, 0.f};
        }
        cur = nxt; ++ui;
#pragma unroll
        for (int h = 0; h < 2; ++h)
#pragma unroll
            for (int i = 0; i < 2; ++i) { ca[h][i] = na[h][i]; cb[h][i] = nb[h][i]; }
        if constexpr (ALIGN_EPI) { if (wr == 1) PG8_BAR; }
    }
    PG8_WAIT_V(0);
    if constexpr (!ALIGN_EPI) { if (wr == 0) PG8_BAR; }
    PG8_BAR;
#undef PG8_SA
#undef PG8_SB
#undef PG8_STAGE
#undef PG8_LDA
#undef PG8_LDB
#undef PG8_MMA
#undef PG8_WAIT_V
#undef PG8_WAIT_L
#undef PG8_BAR
#undef PG8_SCHED
}
}
using pg8::Unit;

struct ProbPlain {
    const bf16* A; const bf16* B; unsigned lda2, ldb2;
    DEV void aoffs(const Unit& u, const int (&R)[2], const int (&C)[2], unsigned (&o)[2][2]) const {
#pragma unroll
        for (int h = 0; h < 2; ++h)
#pragma unroll
            for (int i = 0; i < 2; ++i) o[h][i] = (unsigned)(u.pm * 256 + 128 * h + R[i]) * lda2 + (unsigned)C[i] * 2u + u.ak; }
    DEV void boffs(const Unit& u, const int (&Rb)[2], const int (&C)[2], unsigned (&o)[2][2]) const {
#pragma unroll
        for (int h = 0; h < 2; ++h)
#pragma unroll
            for (int i = 0; i < 2; ++i) o[h][i] = (unsigned)(u.pn * 256 + 128 * h + Rb[i]) * ldb2 + (unsigned)C[i] * 2u + u.bk; }
};
struct ProbMoeUp {
    const bf16* A; const bf16* B; const LAS unsigned* rowtab;
    DEV void aoffs(const Unit& u, const int (&R)[2], const int (&C)[2], unsigned (&o)[2][2]) const {
#pragma unroll
        for (int h = 0; h < 2; ++h)
#pragma unroll
            for (int i = 0; i < 2; ++i) o[h][i] = rowtab[u.slot * 256 + 128 * h + R[i]] + (unsigned)C[i] * 2u; }
    DEV void boffs(const Unit& u, const int (&Rb)[2], const int (&C)[2], unsigned (&o)[2][2]) const {
#pragma unroll
        for (int h = 0; h < 2; ++h)
#pragma unroll
            for (int i = 0; i < 2; ++i) o[h][i] = (unsigned)(u.pn * 256 + 128 * h + Rb[i]) * 2048u + (unsigned)C[i] * 2u + u.bk; }
};
struct ProbMoeDown {
    const bf16* A; const bf16* B;
    DEV void aoffs(const Unit& u, const int (&R)[2], const int (&C)[2], unsigned (&o)[2][2]) const {
#pragma unroll
        for (int h = 0; h < 2; ++h)
#pragma unroll
            for (int i = 0; i < 2; ++i) o[h][i] = (unsigned)(u.arow0 + 128 * h + R[i]) * 1024u + (unsigned)C[i] * 2u; }
    DEV void boffs(const Unit& u, const int (&Rb)[2], const int (&C)[2], unsigned (&o)[2][2]) const {
#pragma unroll
        for (int h = 0; h < 2; ++h)
#pragma unroll
            for (int i = 0; i < 2; ++i) o[h][i] = (unsigned)(u.pn * 256 + 128 * h + Rb[i]) * 1024u + (unsigned)C[i] * 2u + u.bk; }
};

DEV void st16_wt(void* p, const v4u v) { asm volatile("global_store_dwordx4 %0, %1, off sc1\n\ts_nop 1" :: "v"(p), "v"(v) : "memory"); }
DEV v4u pack8(const f32x4 v0, const f32x4 v1) { v4u w; w.x = pg8::cvt_pk_bf16(v0[0], v0[1]); w.y = pg8::cvt_pk_bf16(v0[2], v0[3]); w.z = pg8::cvt_pk_bf16(v1[0], v1[1]); w.w = pg8::cvt_pk_bf16(v1[2], v1[3]); return w; }
DEV f32x4 sig4(f32x4 v) { f32x4 o; o[0] = sigmoidf_(v[0]); o[1] = sigmoidf_(v[1]); o[2] = sigmoidf_(v[2]); o[3] = sigmoidf_(v[3]); return o; }
DEV void unpack8(const v4u w, f32x4& lo, f32x4& hi) { lo[0] = bflo(w.x); lo[1] = bfhi(w.x); lo[2] = bflo(w.y); lo[3] = bfhi(w.y); hi[0] = bflo(w.z); hi[1] = bfhi(w.z); hi[2] = bflo(w.w); hi[3] = bfhi(w.w); }

struct Epi1 {
    static constexpr bool PERM = true;
    bf16* zu; bf16* zga; int cls;
    DEV bool keep(const Unit&) const { return false; }
    DEV void operator()(f32x4 (&acc)[2][2][4][2], const Unit& u, int wr, int wc, int fr, int fq) const {
        const int row0 = u.pm * 256 + wr * 64 + fr, cl = wc * 32 + 8 * fq;
        if (cls) { const int c = (u.pn < 4) ? 1 : (u.pn < 12) ? 2 : (u.pn < 16) ? 4 : 8; if (!(cls & c)) return; }
        if (u.pn < 4) {
#pragma unroll
            for (int ai = 0; ai < 2; ++ai)
#pragma unroll
                for (int m = 0; m < 4; ++m) { const size_t row = (size_t)(row0 + ai * 128 + m * 16);
                    const f32x4 v0 = acc[ai][0][m][0] * sig4(acc[ai][1][m][0]), v1 = acc[ai][0][m][1] * sig4(acc[ai][1][m][1]);
                    *(v4u*)(zu + row * 512 + 128 * u.pn + cl) = pack8(v0, v1); }
        } else {
            bf16* base; int ld, colb; bool sg;
            if (u.pn < 12) { const int ti = (u.pn - 4) >> 1; base = zu + (size_t)(1 + ti) * T * 512; ld = 512; colb = 256 * ((u.pn - 4) & 1); sg = (ti == 3); }
            else { const int ti = (u.pn - 12) >> 2; base = zga + (size_t)ti * T * 1024; ld = 1024; colb = 256 * ((u.pn - 12) & 3); sg = true; }
#pragma unroll
            for (int ai = 0; ai < 2; ++ai)
#pragma unroll
                for (int m = 0; m < 4; ++m) { const size_t row = (size_t)(row0 + ai * 128 + m * 16);
#pragma unroll
                    for (int bj = 0; bj < 2; ++bj) { f32x4 v0 = acc[ai][bj][m][0], v1 = acc[ai][bj][m][1]; if (sg) { v0 = sig4(v0); v1 = sig4(v1); }
                        *(v4u*)(base + row * ld + colb + 128 * bj + cl) = pack8(v0, v1); } }
        }
    }
};
struct Epi2 {
    static constexpr bool PERM = true;
    const bf16* zga; const bf16* zgb; bf16* merged;
    DEV bool keep(const Unit& u) const { return u.slot == 0; }
    DEV void operator()(f32x4 (&acc)[2][2][4][2], const Unit& u, int wr, int wc, int fr, int fq) const {
        const int row0 = u.pm * 256 + wr * 64 + fr, c0 = u.pn * 256 + wc * 32 + 8 * fq;
#pragma unroll
        for (int ai = 0; ai < 2; ++ai)
#pragma unroll
            for (int m = 0; m < 4; ++m) { const size_t ro = (size_t)(row0 + ai * 128 + m * 16) * 1024 + c0;
#pragma unroll
                for (int bj = 0; bj < 2; ++bj) {
                    f32x4 b0, b1; unpack8(*(const v4u*)(zgb + ro + 128 * bj), b0, b1);
                    if (u.slot == 0) { f32x4 a0, a1; unpack8(*(const v4u*)(zga + ro + 128 * bj), a0, a1);
#pragma unroll
                        for (int j = 0; j < 4; ++j) { acc[ai][bj][m][0][j] *= a0[j] * __builtin_amdgcn_rcpf(fmaxf(b0[j], 1e-30f)); acc[ai][bj][m][1][j] *= a1[j] * __builtin_amdgcn_rcpf(fmaxf(b1[j], 1e-30f)); }
                    } else { *(v4u*)(merged + ro + 128 * bj) = pack8(acc[ai][bj][m][0] * b0, acc[ai][bj][m][1] * b1); }
                } }
    }
};
struct Epi3 {
    static constexpr bool PERM = false;
    const float* x; const float* mod; float* out;
    DEV bool keep(const Unit&) const { return false; }
    DEV void operator()(f32x4 (&acc)[2][2][4][2], const Unit& u, int wr, int wc, int fr, int fq) const {
        const int row0 = u.pm * 256 + wr * 64 + fr, c0 = u.pn * 256 + wc * 32 + 4 * fq; const int b = u.pm >> 3;
        f32x4 gt[2][2];
#pragma unroll
        for (int bj = 0; bj < 2; ++bj)
#pragma unroll
            for (int n = 0; n < 2; ++n) gt[bj][n] = *(const f32x4*)(mod + b * 6144 + 2048 + c0 + 128 * bj + 16 * n);
#pragma unroll
        for (int ai = 0; ai < 2; ++ai)
#pragma unroll
            for (int m = 0; m < 4; ++m) { const size_t ro = (size_t)(row0 + ai * 128 + m * 16) * 1024 + c0;
#pragma unroll
                for (int bj = 0; bj < 2; ++bj)
#pragma unroll
                    for (int n = 0; n < 2; ++n) { const f32x4 xv = *(const f32x4*)(x + ro + 128 * bj + 16 * n); *(f32x4*)(out + ro + 128 * bj + 16 * n) = xv + gt[bj][n] * acc[ai][bj][m][n]; } }
    }
};
struct EpiUp {
    static constexpr bool PERM = true;
    bf16* act;
    DEV bool keep(const Unit&) const { return false; }
    DEV void operator()(f32x4 (&acc)[2][2][4][2], const Unit& u, int wr, int wc, int fr, int fq) const {
        const int cl = 128 * u.pn + wc * 32 + 8 * fq;
#pragma unroll
        for (int ai = 0; ai < 2; ++ai)
#pragma unroll
            for (int m = 0; m < 4; ++m) { const int rt = ai * 128 + wr * 64 + m * 16 + fr;
                if (rt < u.valid) { f32x4 v0, v1;
#pragma unroll
                    for (int j = 0; j < 4; ++j) { v0[j] = siluf_(acc[ai][0][m][0][j]) * acc[ai][1][m][0][j]; v1[j] = siluf_(acc[ai][0][m][1][j]) * acc[ai][1][m][1][j]; }
                    *(v4u*)(act + (size_t)(u.arow0 + rt) * 512 + cl) = pack8(v0, v1); } }
    }
};
struct EpiDown {
    static constexpr bool PERM = true;
    bf16* ys; const LAS unsigned* desttab; const LAS float* wtab;
    DEV bool keep(const Unit&) const { return false; }
    DEV void operator()(f32x4 (&acc)[2][2][4][2], const Unit& u, int wr, int wc, int fr, int fq) const {
        const int cl = 256 * u.pn + wc * 32 + 8 * fq;
#pragma unroll
        for (int ai = 0; ai < 2; ++ai)
#pragma unroll
            for (int m = 0; m < 4; ++m) { const int rt = ai * 128 + wr * 64 + m * 16 + fr;
                if (rt < u.valid) { const unsigned dest = desttab[u.slot * 256 + rt]; const float w = wtab[u.slot * 256 + rt];
#pragma unroll
                    for (int bj = 0; bj < 2; ++bj) *(v4u*)(ys + (size_t)dest * 1024 + cl + 128 * bj) = pack8(acc[ai][bj][m][0] * w, acc[ai][bj][m][1] * w); } }
    }
};

#define XB_TMO      128
#define XB_XCNT(j)  (256  + 64 * (j))
#define XB_XSUB(j)  (1280 + 64 * (j))
#define XB_XGEN(j)  (2304 + 64 * (j))
#define XB_TOP      3328
#define XB_TOPGEN   3392
#define XCD_BAR_WORDS 3456
#define XB_SPIN_CAP (1u << 18)
__device__ __forceinline__ unsigned xb_ld(unsigned* p)              { return __hip_atomic_load(p, __ATOMIC_RELAXED, __HIP_MEMORY_SCOPE_AGENT); }
__device__ __forceinline__ unsigned xb_add(unsigned* p, unsigned v) { return __hip_atomic_fetch_add(p, v, __ATOMIC_RELAXED, __HIP_MEMORY_SCOPE_AGENT); }
__device__ __forceinline__ unsigned xb_xcc_id() { return (unsigned)__builtin_amdgcn_s_getreg((3 << 11) | 20) & 0xFu; }
#define XB_SPIN(cond, bar) do { unsigned _sp = 0; while (cond) { __builtin_amdgcn_s_sleep(1); \
    if ((++_sp & 255u) == 0u) { if (xb_ld(&(bar)[XB_TMO])) break; if (_sp > XB_SPIN_CAP) { atomicAdd(&(bar)[XB_TMO], 1u); break; } } } } while (0)
struct XcdBarrier { unsigned* bar; unsigned x; volatile LAS unsigned* st; };
__device__ __forceinline__ XcdBarrier xcd_barrier_post(unsigned* bar, volatile LAS unsigned* st) {
    XcdBarrier b; b.bar = bar; b.x = xb_xcc_id(); b.st = st;
    if (threadIdx.x == 0) (void)xb_add(&bar[XB_XCNT(b.x)], 1u);
    return b;
}
__device__ __forceinline__ void xcd_barrier_complete(unsigned* bar, unsigned x, unsigned& nloc, unsigned& nx) {
    const unsigned G = gridDim.x * gridDim.y * gridDim.z;
    unsigned sum, cnt, mine, sp = 0u;
    for (;;) {
        sum = 0u; cnt = 0u; mine = 0u;
#pragma unroll
        for (unsigned j = 0; j < 16; ++j) { const unsigned c = xb_ld(&bar[XB_XCNT(j)]); sum += c; cnt += (c > 0u) ? 1u : 0u; mine = (j == x) ? c : mine; }
        if (sum == G) break;
        __builtin_amdgcn_s_sleep(1);
        if ((++sp & 255u) == 0u) { if (xb_ld(&bar[XB_TMO])) break; if (sp > XB_SPIN_CAP) { atomicAdd(&bar[XB_TMO], 1u); break; } }
    }
    nloc = mine > 0u ? mine : 1u; nx = cnt > 0u ? cnt : 1u;
}
__device__ __forceinline__ void xcd_barrier(const XcdBarrier& b) {
    asm volatile("s_waitcnt vmcnt(0)" ::: "memory");
    __syncthreads();
    if (threadIdx.x == 0) {
        unsigned* bar = b.bar;
        __builtin_amdgcn_s_waitcnt(0);
        unsigned nloc = b.st[0], nx = b.st[1];
        if (nloc == 0u) { xcd_barrier_complete(bar, b.x, nloc, nx); b.st[0] = nloc; b.st[1] = nx; }
        const unsigned old = xb_add(&bar[XB_XSUB(b.x)], 1u);
        const unsigned gen = old / nloc;
        if (old + 1u == (gen + 1u) * nloc) {
            __builtin_amdgcn_fence(__ATOMIC_RELEASE, "agent");
            asm volatile("s_waitcnt vmcnt(0)" ::: "memory");
            const unsigned og = xb_add(&bar[XB_TOP], 1u);
            const unsigned tg = og / nx;
            if (og + 1u == (tg + 1u) * nx) xb_add(&bar[XB_TOPGEN], 1u);
            else XB_SPIN(xb_ld(&bar[XB_TOPGEN]) == tg, bar);
            __builtin_amdgcn_fence(__ATOMIC_ACQUIRE, "agent");
            xb_add(&bar[XB_XGEN(b.x)], 1u);
            asm volatile("s_waitcnt vmcnt(0)" ::: "memory");
        } else {
#if XB_EARLY_ACQ
            __builtin_amdgcn_fence(__ATOMIC_ACQUIRE, "agent");
            XB_SPIN(xb_ld(&bar[XB_XGEN(b.x)]) == gen, bar);
            asm volatile("s_waitcnt vmcnt(0)" ::: "memory");
#else
            XB_SPIN(xb_ld(&bar[XB_XGEN(b.x)]) == gen, bar);
            __builtin_amdgcn_fence(__ATOMIC_ACQUIRE, "agent");
            asm volatile("s_waitcnt vmcnt(0)" ::: "memory");
#endif
        }
    }
    __syncthreads();
}

__device__ __forceinline__ void flat_barrier(unsigned* cnt, unsigned& gen) {
    asm volatile("s_waitcnt vmcnt(0)" ::: "memory");
    __syncthreads();
    ++gen;
    if (threadIdx.x == 0) {
        __builtin_amdgcn_fence(__ATOMIC_RELEASE, "agent");
        asm volatile("s_waitcnt vmcnt(0)" ::: "memory");
        (void)xb_add(cnt, 1u);
        const unsigned want = gen * gridDim.x; unsigned sp = 0;
        while (xb_ld(cnt) < want) { __builtin_amdgcn_s_sleep(1); if (++sp > (1u << 22)) break; }
        __builtin_amdgcn_fence(__ATOMIC_ACQUIRE, "agent");
        asm volatile("s_waitcnt vmcnt(0)" ::: "memory");
    }
    __syncthreads();
}
DEV f32x4 mma16(bf16x8 a, bf16x8 b, f32x4 c) { return __builtin_amdgcn_mfma_f32_16x16x32_bf16(a, b, c, 0, 0, 0); }
DEV void split8(const f32x4 a, const f32x4 b, bf16x8& hi, bf16x8& lo) {
    v4u h, l; const float r[8] = {a[0], a[1], a[2], a[3], b[0], b[1], b[2], b[3]}; unsigned hw[4], lw[4];
#pragma unroll
    for (int i = 0; i < 4; ++i) { hw[i] = pk2(r[2 * i], r[2 * i + 1]); lw[i] = pk2(r[2 * i] - bflo(hw[i]), r[2 * i + 1] - bfhi(hw[i])); }
    h.x = hw[0]; h.y = hw[1]; h.z = hw[2]; h.w = hw[3]; l.x = lw[0]; l.y = lw[1]; l.z = lw[2]; l.w = lw[3];
    hi = __builtin_bit_cast(bf16x8, h); lo = __builtin_bit_cast(bf16x8, l);
}
DEV void transpose_item(const float* src, int ldsrc, bf16* dst, int lddst, LAS float* scr, int lane) {
#pragma unroll 8
    for (int i = 0; i < 32; ++i) { const int kk = 2 * i + (lane >> 5); scr[kk * 33 + (lane & 31)] = src[(size_t)kk * ldsrc + (lane & 31)]; }
    LDS_WAIT(); asm volatile("" ::: "memory");
    const int c = lane & 7;
#pragma unroll
    for (int j = 0; j < 4; ++j) { const int n = (lane >> 3) + 8 * j; const LAS float* s = scr + (8 * c) * 33 + n;
        v4u o; o.x = pk2(s[0 * 33], s[1 * 33]); o.y = pk2(s[2 * 33], s[3 * 33]); o.z = pk2(s[4 * 33], s[5 * 33]); o.w = pk2(s[6 * 33], s[7 * 33]);
        *(v4u*)(dst + (size_t)n * lddst + 8 * c) = o; }
    LDS_WAIT(); asm volatile("" ::: "memory");
}

DEV void router_prep(const Args& a, int gw, int NGW, int lane) {
    const float* mod = (const float*)(a.ws + WS_MOD);
    const float* g2 = a.in[17]; const float* w_rg = a.in[18]; const float* b_rg = a.in[19]; const float* w_re = a.in[20]; const float* b_re = a.in[21];
    float* rbias = (float*)(a.ws + WS_RBIAS); v4u* rw = (v4u*)(a.ws + WS_RW);
    for (int it = gw; it < 8 * 36; it += NGW) { const int b = it / 36, n = it % 36; float sacc = 0.f;
#pragma unroll
        for (int i = 0; i < 16; ++i) { const int k = lane + 64 * i; const float w = (n < 4) ? w_rg[k * 4 + n] : w_re[k * 32 + n - 4]; sacc += mod[b * 6144 + 3072 + k] * w; }
        sacc = wave_sum(sacc);
        if (lane == 0) rbias[b * 48 + n] = sacc + ((n < 4) ? b_rg[n] : b_re[n - 4]); }
    for (int it = gw; it < 8 * 8 * 4 * 3; it += NGW) {
        const int nt = it % 3, kk = (it / 3) & 3, w8 = (it / 12) & 7, b = it / 96;
        const int n = 16 * nt + (lane & 15), k0 = 128 * w8 + 32 * kk + 8 * (lane >> 4);
        f32x4 w0, w1;
#pragma unroll
        for (int j = 0; j < 8; ++j) { const int k = k0 + j; const float* wp = (n < 4) ? (w_rg + k * 4 + n) : (w_re + k * 32 + ((n < 36) ? n - 4 : 0));
            float w = *wp; w = (n < 36) ? w : 0.f;
            w *= g2[k] * (1.f + mod[b * 6144 + 4096 + k]); if (j < 4) w0[j] = w; else w1[j - 4] = w; }
        bf16x8 hi, lo; split8(w0, w1, hi, lo);
        rw[((size_t)it * 2) * 64 + lane] = __builtin_bit_cast(v4u, hi); rw[((size_t)it * 2 + 1) * 64 + lane] = __builtin_bit_cast(v4u, lo);
    }
}
DEV void wait_mod(const Args& a, int tid) {
    if (tid == 0) {
        unsigned* mc = (unsigned*)(a.ws + WS_CTL) + CW_MODCNT; unsigned sp = 0;
        while (__hip_atomic_load(mc, __ATOMIC_RELAXED, __HIP_MEMORY_SCOPE_AGENT) < 192u) { __builtin_amdgcn_s_sleep(2); if (++sp > (1u << 22)) break; }
        __builtin_amdgcn_fence(__ATOMIC_ACQUIRE, "agent"); asm volatile("s_waitcnt vmcnt(0)" ::: "memory"); }
    __syncthreads();
}
DEV void p0_prologue(const Args& a, LAS unsigned char* lds, int bid, int G) {
    int tid = threadIdx.x; asm volatile("" : "+v"(tid));
    const int lane = tid & 63, wave = __builtin_amdgcn_readfirstlane(tid >> 6);
    const float* c = a.in[1]; const float* w_ada = a.in[2]; const float* b_ada = a.in[3];
    float* mod = (float*)(a.ws + WS_MOD);
    if (bid < 192) {
        LAS float* sil = (LAS float*)lds;
        LAS float* red = (LAS float*)(lds + 32768);
        for (int i = tid; i < 8192; i += NTHREADS) sil[i] = siluf_(c[i]);
        __syncthreads();
        for (int item = bid; item < 192; item += G) {
            const int n0 = item * 32, lg = lane >> 3, cq = lane & 7;
            float acc[8][4];
#pragma unroll
            for (int b = 0; b < 8; ++b)
#pragma unroll
                for (int j = 0; j < 4; ++j) acc[b][j] = 0.f;
#pragma unroll 4
            for (int j = 0; j < 16; ++j) { const int k = wave * 128 + j * 8 + lg; const f32x4 w = *(const f32x4*)(w_ada + (size_t)k * 6144 + n0 + cq * 4);
#pragma unroll
                for (int b = 0; b < 8; ++b) { const float s = sil[b * 1024 + k]; acc[b][0] += s * w[0]; acc[b][1] += s * w[1]; acc[b][2] += s * w[2]; acc[b][3] += s * w[3]; } }
#pragma unroll
            for (int b = 0; b < 8; ++b)
#pragma unroll
                for (int j = 0; j < 4; ++j) { float v = acc[b][j]; v += dpp0<0x128>(v); if ((lane & 8) == 0) red[(wave * 4 + (lane >> 4)) * 256 + b * 32 + cq * 4 + j] = v; }
            __syncthreads();
            if (tid < 256) { float s = 0.f;
#pragma unroll
                for (int w = 0; w < 32; ++w) s += red[w * 256 + tid];
                const int b = tid >> 5, col = tid & 31; mod[b * 6144 + n0 + col] = s + b_ada[n0 + col]; }
            asm volatile("s_waitcnt vmcnt(0)" ::: "memory");
            __syncthreads();
            if (tid == 0) { __builtin_amdgcn_fence(__ATOMIC_RELEASE, "agent"); asm volatile("s_waitcnt vmcnt(0)" ::: "memory");
                __hip_atomic_fetch_add((unsigned*)(a.ws + WS_CTL) + CW_MODCNT, 1u, __ATOMIC_RELAXED, __HIP_MEMORY_SCOPE_AGENT); }
        }
    }
    if (bid == G - 1) { const float* w_in0 = a.in[5]; float* wif = (float*)(a.ws + WS_WIF);
        for (int i = tid; i < 2048; i += NTHREADS) { const int k = i >> 1, hf = i & 1; *(f32x4*)(wif + k * 8 + 4 * hf) = *(const f32x4*)(w_in0 + (size_t)k * DIN + 3072 + 4 * hf); } }
    LAS float* scr = (LAS float*)(lds + wave * 16384);
    const int gw = bid * NWAVES + wave, NGW = G * NWAVES;
    const float* w_in = a.in[5]; const float* wco = a.in[11]; const float* wmo = a.in[15]; const float* wout = a.in[16];
    bf16* W1T = (bf16*)(a.ws + WS_W1T); bf16* W2T = (bf16*)(a.ws + WS_W2T); bf16* W3T = (bf16*)(a.ws + WS_W3T);
    constexpr int I1 = 16 * 160, I2 = 8 * 32, I3 = 16 * 32, NIT = I1 + 2 * I2 + I3;
    for (int it = gw; it < NIT; it += NGW) {
        int r = it;
        if (r < I1) { const int kb = r / 160, nb = r % 160, np = 32 * nb; int sc;
            if (np < 1024) { const int t = np >> 8, q = np & 255; sc = (q < 128) ? 128 * t + q : 512 + 128 * t + q - 128; } else if (np < 3072) sc = np; else sc = np + 8;
            transpose_item(w_in + (size_t)(64 * kb) * DIN + sc, DIN, W1T + (size_t)np * 1024 + 64 * kb, 1024, scr, lane); continue; }
        r -= I1;
        if (r < I2) { const int kb = r / 32, nb = r % 32; transpose_item(wco + (size_t)(64 * kb) * 1024 + 32 * nb, 1024, W2T + (size_t)(32 * nb) * 1024 + 64 * kb, 1024, scr, lane); continue; }
        r -= I2;
        if (r < I2) { const int kb = r / 32, nb = r % 32; transpose_item(wmo + (size_t)(64 * kb) * 1024 + 32 * nb, 1024, W2T + (size_t)(32 * nb) * 1024 + 512 + 64 * kb, 1024, scr, lane); continue; }
        r -= I2;
        { const int kb = r / 32, nb = r % 32; transpose_item(wout + (size_t)(64 * kb) * 1024 + 32 * nb, 1024, W3T + (size_t)(32 * nb) * 1024 + 64 * kb, 1024, scr, lane); }
    }
    if (G > 192 && bid >= 192) { wait_mod(a, tid); router_prep(a, (bid - 192) * NWAVES + wave, (G - 192) * NWAVES, lane); }
}

DEV void p1_h1(const Args& a, LAS unsigned char* lds, int bid, int G) {
    int tid = threadIdx.x; asm volatile("" : "+v"(tid));
    const int lane = tid & 63, wave = __builtin_amdgcn_readfirstlane(tid >> 6);
    if (tid == 0) {
        unsigned* mc = (unsigned*)(a.ws + WS_CTL) + CW_MODCNT; unsigned sp = 0;
        while (__hip_atomic_load(mc, __ATOMIC_RELAXED, __HIP_MEMORY_SCOPE_AGENT) < 192u) { __builtin_amdgcn_s_sleep(2); if (++sp > (1u << 22)) break; }
        __builtin_amdgcn_fence(__ATOMIC_ACQUIRE, "agent"); asm volatile("s_waitcnt vmcnt(0)" ::: "memory"); }
    __syncthreads();
    const float* x = a.in[0]; const float* g1 = a.in[4]; const float* w_in = a.in[5]; const float* b_if = a.in[6];
    const float* mod = (const float*)(a.ws + WS_MOD); bf16* h1 = (bf16*)(a.ws + WS_H); float* gates = (float*)(a.ws + WS_GATES);
    LAS float* tab = (LAS float*)lds;
    for (int k = tid; k < 1024; k += NTHREADS) { const int p = ((k >> 8) << 2) | (k & 3), l = (k >> 2) & 63;
        const f32x4 w0 = *(const f32x4*)(w_in + (size_t)k * DIN + 3072), w1 = *(const f32x4*)(w_in + (size_t)k * DIN + 3076);
        *(LAS f32x4*)(tab + (p * 64 + l) * 8) = w0; *(LAS f32x4*)(tab + (p * 64 + l) * 8 + 4) = w1; }
    __syncthreads();
    if (G <= 192) router_prep(a, bid * NWAVES + wave, G * NWAVES, lane);
    const float bifv = b_if[lane & 7];
    for (int tile = bid; tile < T / 64; tile += G) {
        const int b = tile / 32;
        float sc[4][4], sh[4][4];
#pragma unroll
        for (int j = 0; j < 4; ++j) { const int k = 256 * j + 4 * lane; const f32x4 gv = *(const f32x4*)(g1 + k), sv = *(const f32x4*)(mod + b * 6144 + 1024 + k), hv = *(const f32x4*)(mod + b * 6144 + k);
#pragma unroll
            for (int i = 0; i < 4; ++i) { sc[j][i] = gv[i] * (1.f + sv[i]); sh[j][i] = hv[i]; } }
        f32x4 xr[2][4];
#pragma unroll
        for (int p = 0; p < 2; ++p)
#pragma unroll
            for (int j = 0; j < 4; ++j) xr[p][j] = *(const f32x4*)(x + ((size_t)tile * 64 + wave + 8 * p) * 1024 + 256 * j + 4 * lane);
#pragma unroll 1
        for (int gq = 0; gq < 4; ++gq) {
            float rstd[2];
#pragma unroll
            for (int p = 0; p < 2; ++p) { float ss = 0.f;
#pragma unroll
                for (int j = 0; j < 4; ++j) { const f32x4 v = xr[p][j]; ss += (v[0] * v[0] + v[1] * v[1]) + (v[2] * v[2] + v[3] * v[3]); }
                rstd[p] = rsqrtf(wave_sum(ss) * (1.f / 1024.f) + RMS_EPS); }
            float g[2][8];
#pragma unroll
            for (int p = 0; p < 2; ++p)
#pragma unroll
                for (int q = 0; q < 8; ++q) g[p][q] = 0.f;
#pragma unroll
            for (int j = 0; j < 4; ++j) {
                float hh[2][4];
#pragma unroll
                for (int p = 0; p < 2; ++p) { const f32x4 v = xr[p][j]; const size_t row = (size_t)tile * 64 + wave + 8 * (2 * gq + p);
#pragma unroll
                    for (int i = 0; i < 4; ++i) hh[p][i] = v[i] * rstd[p] * sc[j][i] + sh[j][i];
                    if (gq < 3) xr[p][j] = *(const f32x4*)(x + (row + 16) * 1024 + 256 * j + 4 * lane);
                    v2u o; o.x = pk2(hh[p][0], hh[p][1]); o.y = pk2(hh[p][2], hh[p][3]);
                    *(v2u*)(h1 + row * 1024 + 256 * j + 4 * lane) = o; }
#pragma unroll
                for (int i = 0; i < 4; ++i) { const LAS float* tp = tab + ((4 * j + i) * 64 + lane) * 8; const f32x4 w0 = *(const LAS f32x4*)tp, w1 = *(const LAS f32x4*)(tp + 4);
#pragma unroll
                    for (int p = 0; p < 2; ++p) { const float hv = hh[p][i];
                        g[p][0] += hv * w0[0]; g[p][1] += hv * w0[1]; g[p][2] += hv * w0[2]; g[p][3] += hv * w0[3]; g[p][4] += hv * w1[0]; g[p][5] += hv * w1[1]; g[p][6] += hv * w1[2]; g[p][7] += hv * w1[3]; } }
            }
#pragma unroll
            for (int p = 0; p < 2; ++p) { const size_t row = (size_t)tile * 64 + wave + 8 * (2 * gq + p); float mine = 0.f;
#pragma unroll
                for (int q = 0; q < 8; ++q) { const float sq = wave_sum(g[p][q]); mine = (lane == q) ? sq : mine; }
                if (lane < 8) { const float vv = mine + bifv; gates[row * 8 + lane] = (lane < 4) ? vv : logsigmoidf_(vv); } }
        }
    }
}

DEV void p1_h1_mfma(const Args& a, LAS unsigned char* lds, int bid, int G) {
    int tid = threadIdx.x; asm volatile("" : "+v"(tid));
    const int lane = tid & 63, wave = __builtin_amdgcn_readfirstlane(tid >> 6), l15 = lane & 15, q4 = lane >> 4;
    if (tid == 0) {
        unsigned* mc = (unsigned*)(a.ws + WS_CTL) + CW_MODCNT; unsigned sp = 0;
        while (__hip_atomic_load(mc, __ATOMIC_RELAXED, __HIP_MEMORY_SCOPE_AGENT) < 192u) { __builtin_amdgcn_s_sleep(2); if (++sp > (1u << 22)) break; }
        __builtin_amdgcn_fence(__ATOMIC_ACQUIRE, "agent"); asm volatile("s_waitcnt vmcnt(0)" ::: "memory"); }
    __syncthreads();
    const float* x = a.in[0]; const float* g1 = a.in[4]; const float* b_if = a.in[6];
    const float* mod = (const float*)(a.ws + WS_MOD); bf16* h1 = (bf16*)(a.ws + WS_H); float* gates = (float*)(a.ws + WS_GATES);
    LAS float* PL = (LAS float*)lds;
    LAS float* SS = (LAS float*)(lds + 32768);
    LAS float* RS = (LAS float*)(lds + 34816);
    LAS float* GB = (LAS float*)(lds + 35072);
    LAS float* WF = (LAS float*)(lds + 36864);
    { const float* wif = (const float*)(a.ws + WS_WIF); for (int i = tid; i < 2048; i += NTHREADS) *(LAS f32x4*)(WF + 4 * i) = *(const f32x4*)(wif + 4 * i); }
    {
        const float* g2 = a.in[17]; const float* w_rg = a.in[18]; const float* b_rg = a.in[19]; const float* w_re = a.in[20]; const float* b_re = a.in[21];
        float* rbias = (float*)(a.ws + WS_RBIAS); v4u* rw = (v4u*)(a.ws + WS_RW);
        const int gw = bid * NWAVES + wave, NGW = G * NWAVES;
        for (int it = gw; it < 8 * 36; it += NGW) { const int b = it / 36, n = it % 36; float sacc = 0.f;
#pragma unroll
            for (int i = 0; i < 16; ++i) { const int k = lane + 64 * i; const float w = (n < 4) ? w_rg[k * 4 + n] : w_re[k * 32 + n - 4]; sacc += mod[b * 6144 + 3072 + k] * w; }
            sacc = wave_sum(sacc);
            if (lane == 0) rbias[b * 48 + n] = sacc + ((n < 4) ? b_rg[n] : b_re[n - 4]); }
        for (int it = gw; it < 8 * 8 * 4 * 3; it += NGW) {
            const int nt = it % 3, kk = (it / 3) & 3, w8 = (it / 12) & 7, b = it / 96;
            const int n = 16 * nt + (lane & 15), k0 = 128 * w8 + 32 * kk + 8 * (lane >> 4);
            f32x4 w0, w1;
#pragma unroll
            for (int j = 0; j < 8; ++j) { const int k = k0 + j; const float* wp = (n < 4) ? (w_rg + k * 4 + n) : (w_re + k * 32 + ((n < 36) ? n - 4 : 0));
                float w = *wp; w = (n < 36) ? w : 0.f;
                w *= g2[k] * (1.f + mod[b * 6144 + 4096 + k]); if (j < 4) w0[j] = w; else w1[j - 4] = w; }
            bf16x8 hi, lo; split8(w0, w1, hi, lo);
            rw[((size_t)it * 2) * 64 + lane] = __builtin_bit_cast(v4u, hi); rw[((size_t)it * 2 + 1) * 64 + lane] = __builtin_bit_cast(v4u, lo);
        }
    }
    for (int tile = bid; tile < T / 64; tile += G) {
        const int b = tile / 32, ncol = (l15 < 8) ? l15 : 0;
        __syncthreads();
        {
            float sacc = 0.f;
#pragma unroll
            for (int i = 0; i < 16; ++i) { const int k = lane + 64 * i; sacc += mod[b * 6144 + k] * WF[k * 8 + wave]; }
            sacc = wave_sum(sacc);
            if (lane == 0) GB[wave] = sacc + b_if[wave];
        }
        f32x4 acc[4]; float ss[4];
#pragma unroll
        for (int rt = 0; rt < 4; ++rt) { ss[rt] = 0.f; acc[rt] = (f32x4){0.f, 0.f, 0.f, 0.f}; }
#pragma unroll
        for (int kk = 0; kk < 4; ++kk) {
            const int k0 = 128 * wave + 32 * kk + 8 * q4;
            bf16x8 bhi, blo;
            { const f32x4 ga = *(const f32x4*)(g1 + k0), gb = *(const f32x4*)(g1 + k0 + 4), sa = *(const f32x4*)(mod + b * 6144 + 1024 + k0), sb = *(const f32x4*)(mod + b * 6144 + 1024 + k0 + 4);
                f32x4 w0, w1;
#pragma unroll
                for (int jj = 0; jj < 4; ++jj) { float wa = WF[(k0 + jj) * 8 + ncol], wb = WF[(k0 + 4 + jj) * 8 + ncol];
                    wa = (l15 < 8) ? wa : 0.f; wb = (l15 < 8) ? wb : 0.f; w0[jj] = wa * ga[jj] * (1.f + sa[jj]); w1[jj] = wb * gb[jj] * (1.f + sb[jj]); }
                split8(w0, w1, bhi, blo); }
#pragma unroll
            for (int rt = 0; rt < 4; ++rt) {
                const float* xp = x + ((size_t)tile * 64 + 16 * rt + l15) * 1024 + k0;
                const f32x4 xa = *(const f32x4*)xp, xb = *(const f32x4*)(xp + 4);
                ss[rt] += (xa[0] * xa[0] + xa[1] * xa[1]) + (xa[2] * xa[2] + xa[3] * xa[3]) + (xb[0] * xb[0] + xb[1] * xb[1]) + (xb[2] * xb[2] + xb[3] * xb[3]);
                bf16x8 ahi, alo; split8(xa, xb, ahi, alo);
                acc[rt] = mma16(ahi, bhi, acc[rt]); acc[rt] = mma16(alo, bhi, acc[rt]); acc[rt] = mma16(ahi, blo, acc[rt]);
            }
        }
#pragma unroll
        for (int rt = 0; rt < 4; ++rt) {
            float sv = ss[rt]; sv += __shfl_xor(sv, 16); sv += __shfl_xor(sv, 32);
            if (q4 == 0) SS[wave * 64 + 16 * rt + l15] = sv;
#pragma unroll
            for (int r = 0; r < 4; ++r) PL[(wave * 64 + 16 * rt + 4 * q4 + r) * 16 + l15] = acc[rt][r];
        }
        __syncthreads();
        {
            const int row = tid >> 3, n = tid & 7; float ssum = 0.f, sg = 0.f;
#pragma unroll
            for (int w = 0; w < 8; ++w) { ssum += SS[w * 64 + row]; sg += PL[(w * 64 + row) * 16 + n]; }
            const float rstd = rsqrtf(ssum * (1.f / 1024.f) + RMS_EPS);
            if (n == 0) RS[row] = rstd;
            const float vv = rstd * sg + GB[n];
            gates[((size_t)tile * 64 + row) * 8 + n] = (n < 4) ? vv : logsigmoidf_(vv);
        }
        __syncthreads();
        {
            float sc[4][4], sh[4][4];
#pragma unroll
            for (int j = 0; j < 4; ++j) { const int k = 256 * j + 4 * lane; const f32x4 gv = *(const f32x4*)(g1 + k), sv = *(const f32x4*)(mod + b * 6144 + 1024 + k), hv = *(const f32x4*)(mod + b * 6144 + k);
#pragma unroll
                for (int i = 0; i < 4; ++i) { sc[j][i] = gv[i] * (1.f + sv[i]); sh[j][i] = hv[i]; } }
            f32x4 nx[4][4];
#pragma unroll
            for (int p = 0; p < 4; ++p)
#pragma unroll
                for (int j = 0; j < 4; ++j) nx[p][j] = *(const f32x4*)(x + ((size_t)tile * 64 + wave + 8 * p) * 1024 + 256 * j + 4 * lane);
#pragma unroll
            for (int r8 = 0; r8 < 8; ++r8) {
                const int r = wave + 8 * r8; const size_t row = (size_t)tile * 64 + r;
                f32x4 v[4];
#pragma unroll
                for (int j = 0; j < 4; ++j) v[j] = nx[r8 & 3][j];
                if (r8 + 4 < 8) {
#pragma unroll
                    for (int j = 0; j < 4; ++j) nx[r8 & 3][j] = *(const f32x4*)(x + (row + 32) * 1024 + 256 * j + 4 * lane); }
                asm volatile("" ::: "memory");
                const float rstd = RS[r];
#pragma unroll
                for (int j = 0; j < 4; ++j) { v2u o; o.x = pk2(v[j][0] * rstd * sc[j][0] + sh[j][0], v[j][1] * rstd * sc[j][1] + sh[j][1]); o.y = pk2(v[j][2] * rstd * sc[j][2] + sh[j][2], v[j][3] * rstd * sc[j][3] + sh[j][3]);
                    *(v2u*)(h1 + row * 1024 + 256 * j + 4 * lane) = o; }
            }
        }
    }
    __syncthreads();
}

DEV void p3_conva(const Args& a, LAS unsigned char* lds, int bid, int G) {
    int tid = threadIdx.x; asm volatile("" : "+v"(tid));
    const int lane = tid & 63, wave = __builtin_amdgcn_readfirstlane(tid >> 6), sub = wave & 3, gsel = wave >> 2;
    const bf16* zu = (const bf16*)(a.ws + WS_ZU); bf16* uahm = (bf16*)(a.ws + WS_UAHM);
    const float* cw = a.in[7]; const float* cb = a.in[8]; const float* lg = a.in[9]; const float* lb = a.in[10];
    LAS float* red = (LAS float*)(lds + LDS_TAB);
    const int c0 = 128 * sub + 2 * lane;
    float w0[31], w1[31];
#pragma unroll
    for (int k = 0; k < 31; ++k) { w0[k] = cw[k * 512 + c0]; w1[k] = cw[k * 512 + c0 + 1]; }
    const float bias0 = cb[c0], bias1 = cb[c0 + 1], lg0 = lg[c0], lg1 = lg[c0 + 1], lb0 = lb[c0], lb1 = lb[c0 + 1];
    for (int it = bid; it < T / 32; it += G) {
        const int grp = it * 2 + gsel, tbase = grp * 16, s0 = tbase & (SEQ - 1);
        float acc0[16], acc1[16];
#pragma unroll
        for (int i = 0; i < 16; ++i) { acc0[i] = bias0; acc1[i] = bias1; }
#pragma unroll
        for (int r = 0; r < 46; ++r) {
            const int sp = s0 - 30 + r; const int src = tbase - 30 + r + ((sp < 0) ? -sp : 0); const float msk = (sp < 0) ? 0.f : 1.f;
            const unsigned wv = *(const unsigned*)(zu + (size_t)src * 512 + c0);
            const float u0 = bflo(wv) * msk, u1 = bfhi(wv) * msk;
#pragma unroll
            for (int i = 0; i < 16; ++i) { const int k = r - i; if (k >= 0 && k <= 30) { acc0[i] += w0[k] * u0; acc1[i] += w1[k] * u1; } }
        }
        float mean[16];
#pragma unroll
        for (int i = 0; i < 16; ++i) { const float s = wave_sum(acc0[i] + acc1[i]); if (lane == 0) red[(gsel * 4 + sub) * 16 + i] = s; }
        __syncthreads();
#pragma unroll
        for (int i = 0; i < 16; ++i) mean[i] = ((red[(gsel * 4 + 0) * 16 + i] + red[(gsel * 4 + 1) * 16 + i]) + (red[(gsel * 4 + 2) * 16 + i] + red[(gsel * 4 + 3) * 16 + i])) * (1.f / 512.f);
        __syncthreads();
#pragma unroll
        for (int i = 0; i < 16; ++i) { const float d0 = acc0[i] - mean[i], d1 = acc1[i] - mean[i]; const float s = wave_sum(d0 * d0 + d1 * d1); if (lane == 0) red[(gsel * 4 + sub) * 16 + i] = s; }
        __syncthreads();
#pragma unroll
        for (int i = 0; i < 16; ++i) {
            const float var = ((red[(gsel * 4 + 0) * 16 + i] + red[(gsel * 4 + 1) * 16 + i]) + (red[(gsel * 4 + 2) * 16 + i] + red[(gsel * 4 + 3) * 16 + i])) * (1.f / 512.f);
            const float rstd = rsqrtf(var + LN_EPS);
            const float y0 = (acc0[i] - mean[i]) * rstd * lg0 + lb0, y1 = (acc1[i] - mean[i]) * rstd * lg1 + lb1;
            *(unsigned*)(uahm + (size_t)(tbase + i) * 1024 + c0) = pk2(siluf_(y0), siluf_(y1));
        }
        __syncthreads();
    }
}

constexpr int ML_QS = 0, ML_KS = 17408, ML_KWT = 34816, ML_VT = 53248, ML_PS = 73984, ML_CT = 83200, ML_GT = 122368, ML_CW = 123648, ML_DEN = 128768, ML_PART = 129024, ML_VS = 130048;
template <bool OUT>
DEV void mlstm_unit(const Args& a, LAS unsigned char* lds, int unit) {
    int tid = threadIdx.x; asm volatile("" : "+v"(tid));
    const int lane = tid & 63, wave = __builtin_amdgcn_readfirstlane(tid >> 6), l15 = lane & 15, q4 = lane >> 4;
    const int j = unit & 7, bh = unit >> 3, h = bh & 3, b = bh >> 2, t0 = b * SEQ + 256 * j;
    const bf16* zq = (const bf16*)(a.ws + WS_ZQ); const bf16* zk = (const bf16*)(a.ws + WS_ZK); const bf16* zv = (const bf16*)(a.ws + WS_ZV); const bf16* zo = (const bf16*)(a.ws + WS_ZO);
    const float* gates = (const float*)(a.ws + WS_GATES); v2u* stateh = (v2u*)(a.ws + WS_STATE); float* stsc = (float*)(a.ws + WS_STSC);
    bf16* uahm = (bf16*)(a.ws + WS_UAHM); const float* qkw = a.in[12]; const float* qkb = a.in[13]; const float* mng = a.in[14];
    LAS bf16* QS = (LAS bf16*)(lds + ML_QS); LAS bf16* KS = (LAS bf16*)(lds + ML_KS); LAS bf16* KWT = (LAS bf16*)(lds + ML_KWT); LAS bf16* VT = (LAS bf16*)(lds + ML_VT);
    LAS bf16* PS = (LAS bf16*)(lds + ML_PS); LAS bf16* CT = (LAS bf16*)(lds + ML_CT); LAS bf16* VS = (LAS bf16*)(lds + ML_VS);
    LAS float* GTwk = (LAS float*)(lds + ML_GT); LAS float* GTsi = GTwk + 64; LAS float* GTlb = GTwk + 128; LAS float* GTg = GTwk + 192; LAS float* GTM = GTwk + 256;
    LAS float* CW = (LAS float*)(lds + ML_CW); LAS float* DEN = (LAS float*)(lds + ML_DEN); LAS float* PART = (LAS float*)(lds + ML_PART);
    __syncthreads();
    for (int i = tid; i < 1280; i += NTHREADS) {
        const float* p = (i < 512) ? (qkw + (i >> 7) * 1024 + h * 128 + (i & 127)) : (i < 1024) ? (qkw + ((i - 512) >> 7) * 1024 + 512 + h * 128 + (i & 127))
                       : (i < 1152) ? (qkb + h * 128 + (i - 1024)) : (qkb + 512 + h * 128 + (i - 1152));
        CW[i] = *p; }
    for (int i = tid; i < 16 * 72; i += NTHREADS) VT[128 * 72 + i] = (i < 64) ? (bf16)0x3F80 : (bf16)0;
    f32x4 accC[9];
#pragma unroll
    for (int i = 0; i < 9; ++i) accC[i] = (f32x4){0.f, 0.f, 0.f, 0.f};
    float mc = OUT ? 0.f : -1e30f, Btot = 0.f;
    if (OUT) {
        float wgt[7];
        {
            const int base = unit - j; float mi[7], Bi[7];
#pragma unroll
            for (int i = 0; i < 7; ++i) { const int u2 = base + ((i < j) ? i : 0); mi[i] = stsc[u2 * 4]; Bi[i] = stsc[u2 * 4 + 1]; }
#pragma unroll
            for (int i = 0; i < 7; ++i) if (i < j) mc = fmaxf(Bi[i] + mc, mi[i]);
            float suf = 0.f;
#pragma unroll
            for (int i = 6; i >= 0; --i) { wgt[i] = (i < j) ? __expf(mi[i] + suf - mc) : 0.f; if (i < j) suf += Bi[i]; }
        }
#pragma unroll
        for (int ii = 0; ii < 9; ++ii) {
            v2u ld[7];
#pragma unroll
            for (int i = 0; i < 7; ++i) { ld[i] = (v2u){0u, 0u}; if (i < j) ld[i] = stateh[((size_t)(unit - j + i) * 9 + ii) * 512 + tid]; }
#pragma unroll
            for (int i = 0; i < 7; ++i) { const f32x4 v = (f32x4){bflo(ld[i].x), bfhi(ld[i].x), bflo(ld[i].y), bfhi(ld[i].y)}; accC[ii] = accC[ii] + v * wgt[i]; }
        }
#pragma unroll
        for (int ii = 0; ii < 9; ++ii)
#pragma unroll
            for (int r = 0; r < 4; ++r) CT[(16 * ii + 4 * q4 + r) * 136 + 16 * wave + l15] = f2bf(accC[ii][r]);
    }
    __syncthreads();
    float li_n = gates[(size_t)(t0 + lane) * 8 + h], lf_n = gates[(size_t)(t0 + lane) * 8 + 4 + h];
    const int ncc = (OUT && (a.flags & 4096)) ? 1 : 4; const bool skipAB = OUT && (a.flags & 16384), skipQ = OUT && (a.flags & 32768);
    for (int cc = 0; cc < ncc; ++cc) {
        const int tc = t0 + 64 * cc;
        const float li = li_n, lf = lf_n;
        if (cc < 3) { li_n = gates[(size_t)(tc + 64 + lane) * 8 + h]; lf_n = gates[(size_t)(tc + 64 + lane) * 8 + 4 + h]; }
        const float bc = wave_scan_add(lf, lane);
        const float g = li - bc;
        const float cm = wave_scan_max(g, lane);
        const float M = fmaxf(mc, cm);
        const float M63 = rdlane(M, 63), blast = rdlane(bc, 63);
        const float wkv = __expf(g - M63), sc = __expf(mc - M63), mnew = blast + M63;
        if (wave == 0) { GTwk[lane] = wkv; GTsi[lane] = __expf(mc - M); GTlb[lane] = __expf(-(bc + M)); GTg[lane] = g; GTM[lane] = M; }
        {
            const int cg = tid & 15, rp = tid >> 4, s0 = 2 * rp;
            v4u kraw[5], qraw[5], vraw[2];
#pragma unroll
            for (int m = 0; m < 5; ++m) { const int spos = 256 * j + 64 * cc + s0 - 3 + m; const bool ok = spos >= 0; const int src = ok ? (tc + s0 - 3 + m) : tc;
                kraw[m] = *(const v4u*)(zk + (size_t)src * 512 + h * 128 + cg * 8); }
#pragma unroll
            for (int rr = 0; rr < 2; ++rr) vraw[rr] = *(const v4u*)(zv + (size_t)(tc + s0 + rr) * 512 + h * 128 + cg * 8);
#define ML_CONV(RAW, WOFF, BOFF, DST, SCALE) do { float ac[2][8]; \
            _Pragma("unroll") for (int e = 0; e < 8; ++e) { ac[0][e] = ac[1][e] = CW[(BOFF) + cg * 8 + e]; } \
            _Pragma("unroll") for (int m = 0; m < 5; ++m) { v4u rw_ = RAW[m]; if (256 * j + 64 * cc + s0 - 3 + m < 0) rw_ = (v4u){0u, 0u, 0u, 0u};     \
                const float xv[8] = {bflo(rw_.x), bfhi(rw_.x), bflo(rw_.y), bfhi(rw_.y), bflo(rw_.z), bfhi(rw_.z), bflo(rw_.w), bfhi(rw_.w)}; \
                _Pragma("unroll") for (int rr = 0; rr < 2; ++rr) { const int tap = m - rr; if (tap >= 0 && tap < 4) { \
                    _Pragma("unroll") for (int e = 0; e < 8; ++e) ac[rr][e] += CW[(WOFF) + tap * 128 + cg * 8 + e] * xv[e]; } } } \
            _Pragma("unroll") for (int rr = 0; rr < 2; ++rr) { v4u o; \
                o.x = pk2(siluf_(ac[rr][0]) * (SCALE), siluf_(ac[rr][1]) * (SCALE)); o.y = pk2(siluf_(ac[rr][2]) * (SCALE), siluf_(ac[rr][3]) * (SCALE)); \
                o.z = pk2(siluf_(ac[rr][4]) * (SCALE), siluf_(ac[rr][5]) * (SCALE)); o.w = pk2(siluf_(ac[rr][6]) * (SCALE), siluf_(ac[rr][7]) * (SCALE)); \
                *(LAS v4u*)((DST) + (s0 + rr) * 136 + cg * 8) = o; } } while (0)
            if (OUT && !skipQ) {
#pragma unroll
                for (int m = 0; m < 5; ++m) { const int spos = 256 * j + 64 * cc + s0 - 3 + m; const int src = (spos >= 0) ? (tc + s0 - 3 + m) : tc; qraw[m] = *(const v4u*)(zq + (size_t)src * 512 + h * 128 + cg * 8); } }
            ML_CONV(kraw, 512, 1152, KS, 1.f);
            asm volatile("" ::: "memory");
            if (OUT && !skipQ) ML_CONV(qraw, 0, 1024, QS, 0.08838834764831845f);
#undef ML_CONV
#pragma unroll
            for (int rr = 0; rr < 2; ++rr) *(LAS v4u*)(VS + (s0 + rr) * 136 + cg * 8) = vraw[rr];
        }
        __syncthreads();
        if (OUT && !skipAB) {
            const int tt = wave >> 1;
#pragma unroll
            for (int si = 0; si < 2; ++si) {
                const int st = 2 * (wave & 1) + si;
                f32x4 sacc = (f32x4){0.f, 0.f, 0.f, 0.f};
                if (st <= tt) {
#pragma unroll
                    for (int kk = 0; kk < 4; ++kk) sacc = mma16(*(const LAS bf16x8*)(QS + (16 * tt + l15) * 136 + 32 * kk + 8 * q4), *(const LAS bf16x8*)(KS + (16 * st + l15) * 136 + 32 * kk + 8 * q4), sacc);
                }
                const int sl = 16 * st + l15; const float gs = GTg[sl];
#pragma unroll
                for (int r = 0; r < 4; ++r) { const int tl = 16 * tt + 4 * q4 + r; const float w = (sl <= tl) ? __expf(gs - GTM[tl]) : 0.f; PS[tl * 72 + sl] = f2bf(sacc[r] * w); }
            }
        }
        {
            const int d = tid & 127, sg = tid >> 7; float kv[16];
#pragma unroll
            for (int i = 0; i < 16; ++i) kv[i] = bf2f(KS[(16 * sg + i) * 136 + d]) * GTwk[16 * sg + i];
            v4u o0, o1;
            o0.x = pk2(kv[0], kv[1]); o0.y = pk2(kv[2], kv[3]); o0.z = pk2(kv[4], kv[5]); o0.w = pk2(kv[6], kv[7]);
            o1.x = pk2(kv[8], kv[9]); o1.y = pk2(kv[10], kv[11]); o1.z = pk2(kv[12], kv[13]); o1.w = pk2(kv[14], kv[15]);
            *(LAS v4u*)(KWT + d * 72 + 16 * sg) = o0; *(LAS v4u*)(KWT + d * 72 + 16 * sg + 8) = o1;
            unsigned vw[8];
#pragma unroll
            for (int i = 0; i < 8; ++i) vw[i] = (unsigned)VS[(16 * sg + 2 * i) * 136 + d] | ((unsigned)VS[(16 * sg + 2 * i + 1) * 136 + d] << 16);
            o0.x = vw[0]; o0.y = vw[1]; o0.z = vw[2]; o0.w = vw[3]; o1.x = vw[4]; o1.y = vw[5]; o1.z = vw[6]; o1.w = vw[7];
            *(LAS v4u*)(VT + d * 72 + 16 * sg) = o0; *(LAS v4u*)(VT + d * 72 + 16 * sg + 8) = o1;
        }
        __syncthreads();
        f32x4 res[5];
        if (OUT && !skipAB) {
            const int tt = wave >> 1, dv0 = 4 * (wave & 1);
            bf16x8 pa[2], qa[4];
#pragma unroll
            for (int kk = 0; kk < 2; ++kk) pa[kk] = *(const LAS bf16x8*)(PS + (16 * tt + l15) * 72 + 32 * kk + 8 * q4);
#pragma unroll
            for (int kk = 0; kk < 4; ++kk) qa[kk] = *(const LAS bf16x8*)(QS + (16 * tt + l15) * 136 + 32 * kk + 8 * q4);
            float si[4];
#pragma unroll
            for (int r = 0; r < 4; ++r) si[r] = GTsi[16 * tt + 4 * q4 + r];
#pragma unroll
            for (int i = 0; i < 5; ++i) {
                const int dvt = (i < 4) ? (dv0 + i) : 8;
                if (i < 4 || (wave & 1) == 0) {
                    f32x4 a1 = (f32x4){0.f, 0.f, 0.f, 0.f}, a2 = (f32x4){0.f, 0.f, 0.f, 0.f};
#pragma unroll
                    for (int kk = 0; kk < 2; ++kk) a1 = mma16(pa[kk], *(const LAS bf16x8*)(VT + (16 * dvt + l15) * 72 + 32 * kk + 8 * q4), a1);
#pragma unroll
                    for (int kk = 0; kk < 4; ++kk) a2 = mma16(qa[kk], *(const LAS bf16x8*)(CT + (16 * dvt + l15) * 136 + 32 * kk + 8 * q4), a2);
#pragma unroll
                    for (int r = 0; r < 4; ++r) res[i][r] = a1[r] + si[r] * a2[r];
                } else res[i] = (f32x4){0.f, 0.f, 0.f, 0.f};
            }
            if ((wave & 1) == 0 && l15 == 0) {
#pragma unroll
                for (int r = 0; r < 4; ++r) DEN[16 * tt + 4 * q4 + r] = res[4][r];
            }
        }
        asm volatile("" ::: "memory");
        {
            bf16x8 kb[2];
#pragma unroll
            for (int kk = 0; kk < 2; ++kk) kb[kk] = *(const LAS bf16x8*)(KWT + (16 * wave + l15) * 72 + 32 * kk + 8 * q4);
#pragma unroll
            for (int i = 0; i < 9; ++i) { accC[i] = accC[i] * sc;
#pragma unroll
                for (int kk = 0; kk < 2; ++kk) accC[i] = mma16(*(const LAS bf16x8*)(VT + (16 * i + l15) * 72 + 32 * kk + 8 * q4), kb[kk], accC[i]); }
        }
        __syncthreads();
        if (OUT && !skipAB) {
            const int tt = wave >> 1;
            float den[4], lbv[4];
#pragma unroll
            for (int r = 0; r < 4; ++r) { den[r] = DEN[16 * tt + 4 * q4 + r]; lbv[r] = GTlb[16 * tt + 4 * q4 + r]; }
#pragma unroll
            for (int r = 0; r < 4; ++r) { const float inv = 1.f / fmaxf(fabsf(den[r]), lbv[r]); float s1 = 0.f, s2 = 0.f;
#pragma unroll
                for (int i = 0; i < 4; ++i) { res[i][r] *= inv; s1 += res[i][r]; s2 += res[i][r] * res[i][r]; }
                s1 = row16_sum(s1); s2 = row16_sum(s2);
                if (l15 == 0) { PART[((16 * tt + 4 * q4 + r) * 2 + (wave & 1)) * 2] = s1; PART[((16 * tt + 4 * q4 + r) * 2 + (wave & 1)) * 2 + 1] = s2; } }
#pragma unroll
            for (int ii = 0; ii < 9; ++ii)
#pragma unroll
                for (int r = 0; r < 4; ++r) CT[(16 * ii + 4 * q4 + r) * 136 + 16 * wave + l15] = f2bf(accC[ii][r]);
            __syncthreads();
            const int os = tid >> 3, ocg = tid & 7; const size_t orow = (size_t)(tc + os);
            const v4u zo0 = *(const v4u*)(zo + orow * 512 + h * 128 + 16 * ocg), zo1 = *(const v4u*)(zo + orow * 512 + h * 128 + 16 * ocg + 8);
            LAS float* YS = (LAS float*)(lds + ML_KWT);
#pragma unroll
            for (int r = 0; r < 4; ++r) { const int tl = 16 * tt + 4 * q4 + r;
                const float s1 = PART[(tl * 2) * 2] + PART[(tl * 2 + 1) * 2], s2 = PART[(tl * 2) * 2 + 1] + PART[(tl * 2 + 1) * 2 + 1];
                const float mean = s1 * (1.f / 128.f), var = fmaxf(s2 * (1.f / 128.f) - mean * mean, 0.f), rstd = rsqrtf(var + LN_EPS);
#pragma unroll
                for (int i = 0; i < 4; ++i) YS[tl * 132 + 16 * (4 * (wave & 1) + i) + l15] = (res[i][r] - mean) * rstd; }
            __syncthreads();
            {
                f32x4 yv[4];
#pragma unroll
                for (int q = 0; q < 4; ++q) yv[q] = *(const LAS f32x4*)(YS + os * 132 + 16 * ocg + 4 * q);
                f32x4 g0, g1, g2, g3; unpack8(zo0, g0, g1); unpack8(zo1, g2, g3);
                { const float* mp = mng + h * 128 + 16 * ocg; g0 = g0 * *(const f32x4*)mp; g1 = g1 * *(const f32x4*)(mp + 4); g2 = g2 * *(const f32x4*)(mp + 8); g3 = g3 * *(const f32x4*)(mp + 12); }
                *(v4u*)(uahm + orow * 1024 + 512 + h * 128 + 16 * ocg) = pack8(yv[0] * g0, yv[1] * g1);
                *(v4u*)(uahm + orow * 1024 + 512 + h * 128 + 16 * ocg + 8) = pack8(yv[2] * g2, yv[3] * g3);
            }
        }
        mc = mnew; Btot += blast;
    }
    if (!OUT) {
#pragma unroll
        for (int ii = 0; ii < 9; ++ii) { v2u pk; pk.x = pk2(accC[ii][0], accC[ii][1]); pk.y = pk2(accC[ii][2], accC[ii][3]); stateh[((size_t)unit * 9 + ii) * 512 + tid] = pk; }
        if (tid == 0) { stsc[unit * 4] = mc; stsc[unit * 4 + 1] = Btot; }
    }
}

DEV void p8_route(const Args& a, LAS unsigned char* lds, int bid, int G) {
    int tid = threadIdx.x; asm volatile("" : "+v"(tid));
    const int lane = tid & 63, wave = __builtin_amdgcn_readfirstlane(tid >> 6), l15 = lane & 15, q4 = lane >> 4;
    const float* x1 = a.out; const float* g2 = a.in[17]; const float* w_rg = a.in[18]; const float* w_re = a.in[20];
    const float* mod = (const float*)(a.ws + WS_MOD); const float* rbias = (const float*)(a.ws + WS_RBIAS); const v4u* rw = (const v4u*)(a.ws + WS_RW); bf16* h2 = (bf16*)(a.ws + WS_H);
    int* toke = (int*)(a.ws + WS_TOKE); float* tokw = (float*)(a.ws + WS_TOKW);
    int* listt = (int*)(a.ws + WS_LISTT); float* listw = (float*)(a.ws + WS_LISTW); unsigned* cnt = (unsigned*)(a.ws + WS_CTL) + CW_CNT;
    LAS float* PL = (LAS float*)lds;
    LAS float* SS = (LAS float*)(lds + 98304);
    LAS float* LG = (LAS float*)(lds + 100352);
    LAS float* RS = (LAS float*)(lds + 109568);
    LAS unsigned* lcnt = (LAS unsigned*)(lds + LDS_MISC + 256);
    LAS unsigned* lbase = lcnt + 32;
    LAS unsigned* lent = lcnt + 64;
    LAS float* lwt = (LAS float*)(lcnt + 192);
    for (int tile = bid; tile < T / 64; tile += G) {
        const int b = tile / 32;
        __syncthreads();
        if (tid < 32) lcnt[tid] = 0u;
        f32x4 acc[4][3]; float ss[4];
#pragma unroll
        for (int rt = 0; rt < 4; ++rt) { ss[rt] = 0.f;
#pragma unroll
            for (int nt = 0; nt < 3; ++nt) acc[rt][nt] = (f32x4){0.f, 0.f, 0.f, 0.f}; }
#pragma unroll 1
        for (int kk = 0; kk < 4; ++kk) {
            const int k0 = 128 * wave + 32 * kk + 8 * q4;
            bf16x8 bhi[3], blo[3];
#pragma unroll
            for (int nt = 0; nt < 3; ++nt) { const size_t it = ((size_t)(b * 8 + wave) * 4 + kk) * 3 + nt;
                bhi[nt] = __builtin_bit_cast(bf16x8, rw[(it * 2) * 64 + lane]); blo[nt] = __builtin_bit_cast(bf16x8, rw[(it * 2 + 1) * 64 + lane]); }
#pragma unroll
            for (int rt = 0; rt < 4; ++rt) {
                const float* xp = x1 + ((size_t)tile * 64 + 16 * rt + l15) * 1024 + k0;
                const f32x4 xa = *(const f32x4*)xp, xb = *(const f32x4*)(xp + 4);
                ss[rt] += (xa[0] * xa[0] + xa[1] * xa[1]) + (xa[2] * xa[2] + xa[3] * xa[3]) + (xb[0] * xb[0] + xb[1] * xb[1]) + (xb[2] * xb[2] + xb[3] * xb[3]);
                bf16x8 ahi, alo; split8(xa, xb, ahi, alo);
#pragma unroll
                for (int nt = 0; nt < 3; ++nt) { acc[rt][nt] = mma16(ahi, bhi[nt], acc[rt][nt]); acc[rt][nt] = mma16(alo, bhi[nt], acc[rt][nt]); acc[rt][nt] = mma16(ahi, blo[nt], acc[rt][nt]); }
            }
        }
#pragma unroll
        for (int rt = 0; rt < 4; ++rt) {
            float sv = ss[rt]; sv += __shfl_xor(sv, 16); sv += __shfl_xor(sv, 32);
            if (q4 == 0) SS[wave * 64 + 16 * rt + l15] = sv;
#pragma unroll
            for (int nt = 0; nt < 3; ++nt)
#pragma unroll
                for (int r = 0; r < 4; ++r) PL[(wave * 64 + 16 * rt + 4 * q4 + r) * 48 + 16 * nt + l15] = acc[rt][nt][r];
        }
        __syncthreads();
        {
            const int row = tid >> 3, part = tid & 7;
            float ssum = 0.f;
#pragma unroll
            for (int w = 0; w < 8; ++w) ssum += SS[w * 64 + row];
            const float rstd = rsqrtf(ssum * (1.f / 1024.f) + RMS_EPS);
            if (part == 0) RS[row] = rstd;
#pragma unroll
            for (int i = 0; i < 5; ++i) { const int n = part + 8 * i; if (n < 36) { float s = 0.f;
#pragma unroll
                    for (int w = 0; w < 8; ++w) s += PL[(w * 64 + row) * 48 + n];
                    LG[row * 36 + n] = rstd * s + rbias[b * 48 + n]; } }
        }
        __syncthreads();
        if (tid < 64) {
            const int r = tid; const size_t row = (size_t)tile * 64 + r;
            float lg[36];
#pragma unroll
            for (int q = 0; q < 36; ++q) lg[q] = LG[r * 36 + q];
            int gs = 0; float gm = lg[0];
#pragma unroll
            for (int q = 1; q < 4; ++q) if (lg[q] > gm) { gm = lg[q]; gs = q; }
            float se = 0.f;
#pragma unroll
            for (int q = 0; q < 4; ++q) se += __expf(lg[q] - gm);
            const float pg = 1.f / se;
            float le[8];
#pragma unroll
            for (int q = 0; q < 8; ++q) { float vsel = lg[4 + q];
#pragma unroll
                for (int gg = 1; gg < 4; ++gg) vsel = (gs == gg) ? lg[4 + 8 * gg + q] : vsel;
                le[q] = vsel; }
            int e0 = 0; float l0 = le[0];
#pragma unroll
            for (int q = 1; q < 8; ++q) if (le[q] > l0) { l0 = le[q]; e0 = q; }
            int e1 = -1; float l1 = -3.0e38f;
#pragma unroll
            for (int q = 0; q < 8; ++q) if (q != e0 && le[q] > l1) { l1 = le[q]; e1 = q; }
            const float rr = __expf(l1 - l0), w0 = pg / (1.f + rr), w1 = pg * rr / (1.f + rr);
#pragma unroll
            for (int sl = 0; sl < 2; ++sl) { const int e = gs * 8 + (sl ? e1 : e0); const float w = sl ? w1 : w0;
                toke[row * 2 + sl] = e; tokw[row * 2 + sl] = w;
                const unsigned lp = __hip_atomic_fetch_add(lcnt + e, 1u, __ATOMIC_RELAXED, __HIP_MEMORY_SCOPE_WORKGROUP);
                lent[r * 2 + sl] = (unsigned)e | (lp << 8); lwt[r * 2 + sl] = w; }
        }
        __syncthreads();
        if (tid < 32 && !(a.flags & 2)) { const unsigned n = lcnt[tid]; lbase[tid] = n ? atomicAdd(cnt + 16 * tid, n) : 0u; }
        {
            float sc[4][4], sh[4][4];
#pragma unroll
            for (int j = 0; j < 4; ++j) { const int k = 256 * j + 4 * lane; const f32x4 gv = *(const f32x4*)(g2 + k), sv = *(const f32x4*)(mod + b * 6144 + 4096 + k), hv = *(const f32x4*)(mod + b * 6144 + 3072 + k);
#pragma unroll
                for (int i = 0; i < 4; ++i) { sc[j][i] = gv[i] * (1.f + sv[i]); sh[j][i] = hv[i]; } }
            f32x4 nx[4];
#pragma unroll
            for (int j = 0; j < 4; ++j) nx[j] = *(const f32x4*)(x1 + ((size_t)tile * 64 + wave) * 1024 + 256 * j + 4 * lane);
#pragma unroll 1
            for (int r = wave; r < 64; r += NWAVES) {
                const size_t row = (size_t)tile * 64 + r; f32x4 v[4];
#pragma unroll
                for (int j = 0; j < 4; ++j) v[j] = nx[j];
                if (r + NWAVES < 64) {
#pragma unroll
                    for (int j = 0; j < 4; ++j) nx[j] = *(const f32x4*)(x1 + (row + NWAVES) * 1024 + 256 * j + 4 * lane); }
                asm volatile("" ::: "memory");
                const float rstd = RS[r];
#pragma unroll
                for (int j = 0; j < 4; ++j) { v2u o; o.x = pk2(v[j][0] * rstd * sc[j][0] + sh[j][0], v[j][1] * rstd * sc[j][1] + sh[j][1]); o.y = pk2(v[j][2] * rstd * sc[j][2] + sh[j][2], v[j][3] * rstd * sc[j][3] + sh[j][3]);
                    *(v2u*)(h2 + row * 1024 + 256 * j + 4 * lane) = o; }
            }
        }
        __syncthreads();
        if (tid < 128 && !(a.flags & 2)) { const unsigned en = lent[tid]; const unsigned e = en & 255u, lp = en >> 8; const unsigned pos = lbase[e] + lp;
            listt[e * 16384 + pos] = (tile * 64 + (tid >> 1)) * 2 + (tid & 1); listw[e * 16384 + pos] = lwt[tid]; }
    }
    __syncthreads();
}
DEV void p8_convert(const Args& a, LAS unsigned char* lds, int bid, int G) {
    int tid = threadIdx.x; asm volatile("" : "+v"(tid));
    const int lane = tid & 63, wave = __builtin_amdgcn_readfirstlane(tid >> 6);
    LAS float* scr = (LAS float*)(lds + wave * 16384);
    const float* wg = a.in[22]; const float* wu = a.in[23]; const float* wd = a.in[24];
    bf16* WGU = (bf16*)(a.ws + WS_WGU); bf16* WD = (bf16*)(a.ws + WS_WD);
    const int gw = bid * NWAVES + wave, NGW = G * NWAVES;
    for (int it = gw; it < 32 * 768; it += NGW) {
        const int e = it / 768; int r = it % 768;
        if (r < 512) { const int up = r >> 8; r &= 255; const int kb = r >> 4, nb = r & 15, n = 32 * nb, np = 256 * (n >> 7) + 128 * up + (n & 127);
            transpose_item((up ? wu : wg) + (size_t)e * 1024 * 512 + (size_t)(64 * kb) * 512 + n, 512, WGU + ((size_t)e * 1024 + np) * 1024 + 64 * kb, 1024, scr, lane); }
        else { r -= 512; const int kb = r >> 5, nb = r & 31;
            transpose_item(wd + (size_t)e * 512 * 1024 + (size_t)(64 * kb) * 1024 + 32 * nb, 1024, WD + ((size_t)e * 1024 + 32 * nb) * 512 + 64 * kb, 512, scr, lane); }
    }
}

struct MoeSched {
    const LAS int* tlist; const LAS int* rstart; const LAS int* ecnt; int U, G, c; unsigned bstride;
    DEV bool next(int i, Unit& u) const {
        const int L = i * G + c; if (L >= U) return false;
        const int ent = tlist[L >> 2]; const int e = ent & 255, rt = ent >> 8; u.pn = L & 3;
        const int left = ecnt[e] - 256 * rt;
        u.pm = 0; u.ak = 0; u.bk = (unsigned)e * bstride; u.slot = i; u.valid = left < 256 ? left : 256; u.arow0 = rstart[e] + 256 * rt; return true;
    }
};
DEV void moe_tables(const Args& a, LAS unsigned char* lds, int bid, int G, MoeSched& S, bool down) {
    int tid = threadIdx.x; asm volatile("" : "+v"(tid));
    LAS int* ti = (LAS int*)(lds + LDS_MISC + 1024); LAS int* rstart = ti, *ecnt = ti + 40, *tlist = ti + 80, *ntl = ti + 260;
    const unsigned* cnt = (const unsigned*)(a.ws + WS_CTL) + CW_CNT;
    const int* listt = (const int*)(a.ws + WS_LISTT); const float* listw = (const float*)(a.ws + WS_LISTW);
    __syncthreads();
    if (tid < 64) {
        const int lane = tid; const int n = (lane < 32) ? (int)__hip_atomic_load(cnt + 16 * (lane & 31), __ATOMIC_RELAXED, __HIP_MEMORY_SCOPE_AGENT) : 0;
        const int ntile = (n + 255) >> 8, nfull = (n + 127) >> 8, ntail = ntile - nfull;
        const int rs = (int)wave_scan_add((float)n, lane) - n, of = (int)wave_scan_add((float)nfull, lane) - nfull, ot = (int)wave_scan_add((float)ntail, lane) - ntail;
        const int totf = (int)rdlane(wave_scan_add((float)nfull, lane), 63), tott = (int)rdlane(wave_scan_add((float)ntail, lane), 63);
        if (lane < 32) { ecnt[lane] = n; rstart[lane] = rs;
            for (int rt = 0; rt < nfull; ++rt) tlist[of + rt] = lane | (rt << 8);
            if (ntail) tlist[totf + ot] = lane | (nfull << 8); }
        if (lane == 32) rstart[32] = rs;
        if (lane == 0) ntl[0] = totf + tott;
    }
    __syncthreads();
    S.tlist = tlist; S.rstart = rstart; S.ecnt = ecnt; S.U = 4 * ntl[0]; S.G = G; S.c = bid;
    LAS unsigned* tab0 = (LAS unsigned*)(lds + LDS_TAB); LAS float* tab1 = (LAS float*)(lds + LDS_TAB + 8192);
    Unit u;
    for (int i = 0; i < 8 && S.next(i, u); ++i) {
        if (tid < 256) { const int e = (int)(u.bk / S.bstride); const int pos = (u.arow0 - rstart[e]) + tid; unsigned v0 = 0u; float v1 = 0.f;
            if (tid < u.valid) { const int tk = listt[e * 16384 + pos]; v0 = down ? (unsigned)tk : (unsigned)(tk >> 1) * 2048u; v1 = listw[e * 16384 + pos]; }
            tab0[i * 256 + tid] = v0; tab1[i * 256 + tid] = v1; }
    }
    __syncthreads();
}

DEV void p11_final(const Args& a, int bid, int G) {
    int tid = threadIdx.x; asm volatile("" : "+v"(tid));
    const int lane = tid & 63, wave = __builtin_amdgcn_readfirstlane(tid >> 6);
    const float* mod = (const float*)(a.ws + WS_MOD); const bf16* ys = (const bf16*)(a.ws + WS_YS); const float* gf = a.in[25]; float* out = a.out;
    float* outw = (a.flags & 65536) ? (float*)(a.ws + WS_WGU) : a.out;
    for (int tile = bid; tile < T / 64; tile += G) {
        const int b = tile / 32;
        f32x4 nx[4], gtv[4], gfv[4]; v2u ny0[4], ny1[4];
#pragma unroll
        for (int j = 0; j < 4; ++j) { const int k = 256 * j + 4 * lane; gtv[j] = *(const f32x4*)(mod + b * 6144 + 5120 + k); gfv[j] = *(const f32x4*)(gf + k); }
#pragma unroll
        for (int j = 0; j < 4; ++j) { const size_t row = (size_t)tile * 64 + wave; const int k = 256 * j + 4 * lane;
            nx[j] = *(const f32x4*)(out + row * 1024 + k); ny0[j] = *(const v2u*)(ys + row * 2048 + k); ny1[j] = *(const v2u*)(ys + row * 2048 + 1024 + k); }
#pragma unroll 1
        for (int r = wave; r < 64; r += NWAVES) {
            const size_t row = (size_t)tile * 64 + r;
            f32x4 v[4]; float ss = 0.f;
#pragma unroll
            for (int j = 0; j < 4; ++j) { const int k = 256 * j + 4 * lane;
                const f32x4 xv = nx[j], gt = gtv[j]; const v2u y0 = ny0[j], y1 = ny1[j];
                v[j][0] = xv[0] + gt[0] * (bflo(y0.x) + bflo(y1.x)); v[j][1] = xv[1] + gt[1] * (bfhi(y0.x) + bfhi(y1.x));
                v[j][2] = xv[2] + gt[2] * (bflo(y0.y) + bflo(y1.y)); v[j][3] = xv[3] + gt[3] * (bfhi(y0.y) + bfhi(y1.y));
                ss += (v[j][0] * v[j][0] + v[j][1] * v[j][1]) + (v[j][2] * v[j][2] + v[j][3] * v[j][3]); }
            if (r + NWAVES < 64) {
#pragma unroll
                for (int j = 0; j < 4; ++j) { const size_t rn = row + NWAVES; const int k = 256 * j + 4 * lane;
                    nx[j] = *(const f32x4*)(out + rn * 1024 + k); ny0[j] = *(const v2u*)(ys + rn * 2048 + k); ny1[j] = *(const v2u*)(ys + rn * 2048 + 1024 + k); } }
            asm volatile("" ::: "memory");
            const float rstd = rsqrtf(wave_sum(ss) * (1.f / 1024.f) + RMS_EPS);
#pragma unroll
            for (int j = 0; j < 4; ++j) { const int k = 256 * j + 4 * lane; *(f32x4*)(outw + row * 1024 + k) = v[j] * rstd * gfv[j]; }
        }
    }
}

constexpr int NPHASE = 11;
template <int LO, int HI>
__global__ void __launch_bounds__(NTHREADS, 2) mk_fwd(Args a) {
    extern __shared__ __attribute__((aligned(16))) unsigned char lds_raw[];
    LAS unsigned char* lds = (LAS unsigned char*)lds_raw;
    const int tid = threadIdx.x, G = gridDim.x, bid = blockIdx.x;
    volatile LAS unsigned* MISC = (volatile LAS unsigned*)(lds + LDS_MISC);
    if (tid < 64) MISC[tid] = 0u;
    __syncthreads();
#if MK_ONE
#if USE_XCD_BARRIER
    XcdBarrier bar = xcd_barrier_post((unsigned*)(a.ws + WS_CTL) + CW_BAR, MISC + 8);
#define GRID_BAR() xcd_barrier(bar)
#else
    unsigned fgen = 0;
#define GRID_BAR() flat_barrier((unsigned*)(a.ws + WS_CTL) + CW_FLATBAR, fgen)
#endif
#else
#define GRID_BAR() do {} while (0)
#endif
    constexpr int lo = LO, hi = HI;
#define IN(k) (lo <= (k) && (k) < hi)
#define BOTH(k) (IN(k) && IN((k) + 1))
    if constexpr (IN(0)) { REPK(0) { p0_prologue(a, lds, bid, G); REPSYNC(); } if constexpr (BOTH(0)) __syncthreads(); }
    if constexpr (IN(1)) { REPK(1) { P1_FN(a, lds, bid, G); REPSYNC(); } if constexpr (BOTH(1)) GRID_BAR(); }
    if constexpr (IN(2)) {
        __syncthreads();
        ProbPlain P{(const bf16*)(a.ws + WS_H), (const bf16*)(a.ws + WS_W1T), 2048u, 2048u};
#if DBG_GATEFIRST
        struct SchedG { pg8::StaticOrder so; DEV bool next(int i, Unit& u) const { if (i >= 2) return false; return so.next(i + 3, u); } } S; S.so.init(T, 5120, G, bid);
#else
        pg8::StaticOrder S; S.init(T, 5120, G, bid);
#endif
        Epi1 E{(bf16*)(a.ws + WS_ZU), (bf16*)(a.ws + WS_ZGA), (a.flags >> 8) & 15};
        REPK(2) pg8::gemm_phase<ProbPlain, Epi1, decltype(S), true>(lds, P, S, E, 1024);
        if constexpr (BOTH(2)) GRID_BAR();
    }
    if constexpr (IN(3)) {
        REPK(3) { for (int u = bid; u < 256; u += G) mlstm_unit<false>(a, lds, u);
        __syncthreads(); }
        REPK(11) { p3_conva(a, lds, bid, G); REPSYNC(); }
        if constexpr (BOTH(3)) GRID_BAR();
    }
    if constexpr (IN(4)) {
        REPK(4) { for (int u = bid; u < 256; u += G) mlstm_unit<true>(a, lds, u); REPSYNC(); }
        if constexpr (BOTH(4)) GRID_BAR();
    }
    if constexpr (IN(5)) {
        __syncthreads();
        struct Sched2 { pg8::StaticOrder so; DEV bool next(int i, Unit& u) const { u.ak = (unsigned)(i & 1) * 1024u; u.bk = u.ak; u.slot = i & 1; u.valid = 256; u.arow0 = 0; return so.tile((i >> 1) * so.G + so.c, u.pm, u.pn); } } S;
        S.so.init(T, 1024, G, bid);
        ProbPlain P{(const bf16*)(a.ws + WS_UAHM), (const bf16*)(a.ws + WS_W2T), 2048u, 2048u};
        Epi2 E{(const bf16*)(a.ws + WS_ZGA), (const bf16*)(a.ws + WS_ZGB), (bf16*)(a.ws + WS_MERGED)};
        REPK(5) pg8::gemm_phase<ProbPlain, Epi2, Sched2, true>(lds, P, S, E, 512);
        if constexpr (BOTH(5)) GRID_BAR();
    }
    if constexpr (IN(6)) {
        __syncthreads();
        ProbPlain P{(const bf16*)(a.ws + WS_MERGED), (const bf16*)(a.ws + WS_W3T), 2048u, 2048u};
        pg8::StaticOrder S; S.init(T, 1024, G, bid);
        Epi3 E{a.in[0], (const float*)(a.ws + WS_MOD), a.out};
        REPK(6) pg8::gemm_phase<ProbPlain, Epi3, pg8::StaticOrder, true>(lds, P, S, E, 1024);
        if constexpr (BOTH(6)) { GRID_BAR(); for (int xb = 0; xb < DBG_XBAR; ++xb) GRID_BAR(); }
    }
    if constexpr (IN(7)) {
        if (!(a.flags & 1)) p8_route(a, lds, bid, G);
        __syncthreads();
        if (!(a.flags & 4)) { p8_convert(a, lds, bid, G); }
        if constexpr (BOTH(7)) GRID_BAR();
    }
    if constexpr (IN(8)) {
        MoeSched S; S.bstride = 1024u * 1024u * 2u;
        moe_tables(a, lds, bid, G, S, false);
        ProbMoeUp P{(const bf16*)(a.ws + WS_H), (const bf16*)(a.ws + WS_WGU), (const LAS unsigned*)(lds + LDS_TAB)};
        EpiUp E{(bf16*)(a.ws + WS_ACT)};
        REPK(8) pg8::gemm_phase<ProbMoeUp, EpiUp, MoeSched, true, true>(lds, P, S, E, 1024);
        if constexpr (BOTH(8)) GRID_BAR();
    }
    if constexpr (IN(9)) {
        MoeSched S; S.bstride = 1024u * 512u * 2u;
        moe_tables(a, lds, bid, G, S, true);
        ProbMoeDown P{(const bf16*)(a.ws + WS_ACT), (const bf16*)(a.ws + WS_WD)};
        EpiDown E{(bf16*)(a.ws + WS_YS), (const LAS unsigned*)(lds + LDS_TAB), (const LAS float*)(lds + LDS_TAB + 8192)};
        REPK(9) pg8::gemm_phase<ProbMoeDown, EpiDown, MoeSched, true, true>(lds, P, S, E, 512);
        if constexpr (BOTH(9)) GRID_BAR();
    }
    if constexpr (IN(10)) { p11_final(a, bid, G); }
#undef IN
#undef BOTH
}

#if NAIVE_MASK
__global__ __launch_bounds__(256) void k_fixw1t(const float* w_in, bf16* W1T) { const size_t i = (size_t)blockIdx.x * 256 + threadIdx.x; const size_t n = i / 1024, k = i % 1024; W1T[(3072 + n) * 1024 + k] = f2bf(w_in[k * 5128 + 3080 + n]); }
DEV float block_sum256(float v, float* red) {
#pragma unroll
    for (int o = 32; o >= 1; o >>= 1) v += __shfl_xor(v, o);
    __syncthreads();
    if ((threadIdx.x & 63) == 0) red[threadIdx.x >> 6] = v;
    __syncthreads();
    return (red[0] + red[1]) + (red[2] + red[3]);
}
__global__ __launch_bounds__(256) void k_mod(const float* c, const float* w_ada, const float* b_ada, float* mod) {
    const int idx = blockIdx.x * 256 + threadIdx.x; const int b = idx / 6144, n = idx % 6144;
    float acc = 0.f;
    for (int k = 0; k < D; ++k) acc += siluf_(c[b * D + k]) * w_ada[(size_t)k * 6144 + n];
    mod[idx] = acc + b_ada[n];
}
__global__ __launch_bounds__(256) void k_h1(const float* x, const float* g1, const float* mod, const float* w_in, const float* b_if, bf16* h1, float* gates) {
    __shared__ float red[4];
    const int t = blockIdx.x, b = t / SEQ, tid = threadIdx.x;
    const float4 xv = ((const float4*)(x + (size_t)t * D))[tid];
    float ss = xv.x * xv.x + xv.y * xv.y + xv.z * xv.z + xv.w * xv.w;
    ss = block_sum256(ss, red);
    const float rstd = rsqrtf(ss * (1.f / D) + RMS_EPS);
    const float* sh = mod + b * 6144, *sc = mod + b * 6144 + 1024;
    float hv[4]; const float xs[4] = {xv.x, xv.y, xv.z, xv.w};
#pragma unroll
    for (int j = 0; j < 4; ++j) { const int k = tid * 4 + j; hv[j] = xs[j] * rstd * g1[k] * (1.f + sc[k]) + sh[k]; }
    ushort4 o; o.x = f2bf(hv[0]); o.y = f2bf(hv[1]); o.z = f2bf(hv[2]); o.w = f2bf(hv[3]);
    ((ushort4*)(h1 + (size_t)t * D))[tid] = o;
    float g[8];
#pragma unroll
    for (int j = 0; j < 8; ++j) g[j] = 0.f;
#pragma unroll
    for (int i = 0; i < 4; ++i) { const float* wr = w_in + (size_t)(tid * 4 + i) * DIN + 3072;
#pragma unroll
        for (int j = 0; j < 8; ++j) g[j] += hv[i] * wr[j]; }
#pragma unroll
    for (int j = 0; j < 8; ++j) g[j] = block_sum256(g[j], red);
    if (tid < 8) { float v = g[0];
#pragma unroll
        for (int j = 1; j < 8; ++j) v = (tid == j) ? g[j] : v;
        v += b_if[tid];
        gates[(size_t)t * 8 + tid] = (tid < 4) ? v : logsigmoidf_(v); }
}
template <class Epi>
__global__ __launch_bounds__(256) void k_ngemm(const bf16* A, int lda, const float* W, int ldw, int N, int K, Epi epi) {
    __shared__ float As[16][68]; __shared__ float Ws[16][68];
    const int tid = threadIdx.x, tx = tid & 15, ty = tid >> 4;
    const int row0 = blockIdx.y * 64, col0 = blockIdx.x * 64;
    float acc[4][4];
#pragma unroll
    for (int i = 0; i < 4; ++i)
#pragma unroll
        for (int j = 0; j < 4; ++j) acc[i][j] = 0.f;
    const int ar = tid >> 2, ak = (tid & 3) * 4;
    const int wk = tid >> 4, wc = (tid & 15) * 4;
    for (int k0 = 0; k0 < K; k0 += 16) {
        const ushort4 av = *(const ushort4*)(A + (size_t)(row0 + ar) * lda + k0 + ak);
        As[ak + 0][ar] = bf2f(av.x); As[ak + 1][ar] = bf2f(av.y); As[ak + 2][ar] = bf2f(av.z); As[ak + 3][ar] = bf2f(av.w);
#pragma unroll
        for (int j = 0; j < 4; ++j) { const int cc = col0 + wc + j; Ws[wk][wc + j] = (cc < N) ? W[(size_t)(k0 + wk) * ldw + cc] : 0.f; }
        __syncthreads();
#pragma unroll
        for (int kk = 0; kk < 16; ++kk) {
            float av2[4], w[4];
#pragma unroll
            for (int i = 0; i < 4; ++i) av2[i] = As[kk][ty * 4 + i];
#pragma unroll
            for (int j = 0; j < 4; ++j) w[j] = Ws[kk][tx * 4 + j];
#pragma unroll
            for (int i = 0; i < 4; ++i)
#pragma unroll
                for (int j = 0; j < 4; ++j) acc[i][j] += av2[i] * w[j];
        }
        __syncthreads();
    }
#pragma unroll
    for (int i = 0; i < 4; ++i)
#pragma unroll
        for (int j = 0; j < 4; ++j) { const int cc = col0 + tx * 4 + j; if (cc < N) epi(row0 + ty * 4 + i, cc, acc[i][j]); }
}
struct NEpi1 {
    float* tmp; bf16 *zq, *zk, *zv, *zo, *zga, *zgb;
    DEV void operator()(int r, int c, float v) const {
        if (c < 1024) tmp[(size_t)r * 1024 + c] = v;
        else if (c < 1536) zq[(size_t)r * 512 + c - 1024] = f2bf(v);
        else if (c < 2048) zk[(size_t)r * 512 + c - 1536] = f2bf(v);
        else if (c < 2560) zv[(size_t)r * 512 + c - 2048] = f2bf(v);
        else if (c < 3072) zo[(size_t)r * 512 + c - 2560] = f2bf(sigmoidf_(v));
        else if (c < 3080) {}
        else if (c < 4104) zga[(size_t)r * 1024 + c - 3080] = f2bf(sigmoidf_(v));
        else zgb[(size_t)r * 1024 + c - 4104] = f2bf(sigmoidf_(v));
    }
};
struct NEpi2a { float* tmp; const bf16* zga; DEV void operator()(int r, int c, float v) const { tmp[(size_t)r * 1024 + c] = v * bf2f(zga[(size_t)r * 1024 + c]); } };
struct NEpi2b { const float* tmp; const bf16* zgb; bf16* merged; DEV void operator()(int r, int c, float v) const { merged[(size_t)r * 1024 + c] = f2bf(tmp[(size_t)r * 1024 + c] + v * bf2f(zgb[(size_t)r * 1024 + c])); } };
struct NEpi3 { const float* x; const float* mod; float* out; DEV void operator()(int r, int c, float v) const { const int b = r / SEQ; out[(size_t)r * 1024 + c] = x[(size_t)r * 1024 + c] + mod[b * 6144 + 2048 + c] * v; } };
__global__ __launch_bounds__(256) void k_glu(const float* tmp, bf16* zu) {
    const size_t i = (size_t)blockIdx.x * 256 + threadIdx.x; const size_t r = i / 512, c = i % 512;
    zu[i] = f2bf(tmp[r * 1024 + c] * sigmoidf_(tmp[r * 1024 + 512 + c]));
}
__global__ __launch_bounds__(256) void k_conva(const bf16* zu, const float* cw, const float* cb, const float* lg, const float* lb, bf16* uahm) {
    __shared__ float red[4];
    const int t = blockIdx.x, s = t % SEQ, tid = threadIdx.x;
    float v[2];
#pragma unroll
    for (int j = 0; j < 2; ++j) { const int c = tid + 256 * j; float a = cb[c];
        for (int k = 0; k < 31; ++k) { const int ss = s - 30 + k; if (ss >= 0) a += cw[k * 512 + c] * bf2f(zu[(size_t)(t - 30 + k) * 512 + c]); }
        v[j] = a; }
    const float mean = block_sum256(v[0] + v[1], red) * (1.f / 512.f);
    const float d0 = v[0] - mean, d1 = v[1] - mean;
    const float var = block_sum256(d0 * d0 + d1 * d1, red) * (1.f / 512.f);
    const float rstd = rsqrtf(var + LN_EPS);
#pragma unroll
    for (int j = 0; j < 2; ++j) { const int c = tid + 256 * j; const float y = (v[j] - mean) * rstd * lg[c] + lb[c]; uahm[(size_t)t * 1024 + c] = f2bf(siluf_(y)); }
}
__global__ __launch_bounds__(256) void k_qkconv(const bf16* zq, const bf16* zk, const float* w, const float* bq, bf16* qc, bf16* kc) {
    const int t = blockIdx.x, s = t % SEQ, tid = threadIdx.x;
#pragma unroll
    for (int j = 0; j < 4; ++j) { const int c = tid + 256 * j; const bf16* src = (c < 512) ? zq : zk; const int cc = c & 511; float a = bq[c];
#pragma unroll
        for (int k = 0; k < 4; ++k) { const int ss = s - 3 + k; if (ss >= 0) a += w[k * 1024 + c] * bf2f(src[(size_t)(t - 3 + k) * 512 + cc]); }
        ((c < 512) ? qc : kc)[(size_t)t * 512 + cc] = f2bf(siluf_(a)); }
}
__global__ __launch_bounds__(256) void k_mlstm_rec(const bf16* qc, const bf16* kc, const bf16* zv, const bf16* zo, const float* gates, const float* mng, bf16* uahm) {
    __shared__ float qs[128], ks[128], vs[128], part[2][128], red[8];
    const int b = blockIdx.x / NH, h = blockIdx.x % NH, tid = threadIdx.x, j = tid & 127, ih = tid >> 7;
    float C[64];
#pragma unroll
    for (int r = 0; r < 64; ++r) C[r] = 0.f;
    float nn = 0.f, m = 0.f;
    for (int s = 0; s < SEQ; ++s) {
        const size_t t = (size_t)b * SEQ + s;
        __syncthreads();
        if (tid < 128) { qs[tid] = bf2f(qc[t * 512 + h * 128 + tid]) * 0.08838834764831845f; ks[tid] = bf2f(kc[t * 512 + h * 128 + tid]); }
        else vs[tid - 128] = bf2f(zv[t * 512 + h * 128 + tid - 128]);
        const float li = gates[t * 8 + h], lf = gates[t * 8 + 4 + h];
        const float mn = fmaxf(lf + m, li), ip = __expf(li - mn), fp = __expf(lf + m - mn); m = mn;
        __syncthreads();
        const float vj = vs[j]; float p = 0.f;
#pragma unroll
        for (int r = 0; r < 64; ++r) { const int i = ih * 64 + r; C[r] = fp * C[r] + ip * ks[i] * vj; p += qs[i] * C[r]; }
        part[ih][j] = p;
        float dn = 0.f;
        if (tid < 128) { nn = fp * nn + ip * ks[tid]; dn = qs[tid] * nn; }
#pragma unroll
        for (int o = 32; o >= 1; o >>= 1) dn += __shfl_xor(dn, o);
        if ((tid & 63) == 0) red[tid >> 6] = dn;
        __syncthreads();
        float hv = 0.f, sm = 0.f;
        if (tid < 128) { const float den = red[0] + red[1]; hv = (part[0][tid] + part[1][tid]) / fmaxf(fabsf(den), __expf(-mn)); sm = hv; }
#pragma unroll
        for (int o = 32; o >= 1; o >>= 1) sm += __shfl_xor(sm, o);
        if ((tid & 63) == 0) red[4 + (tid >> 6)] = sm;
        __syncthreads();
        const float mu = (red[4] + red[5]) * (1.f / 128.f);
        float dv = (tid < 128) ? (hv - mu) : 0.f; float sq = dv * dv;
#pragma unroll
        for (int o = 32; o >= 1; o >>= 1) sq += __shfl_xor(sq, o);
        __syncthreads();
        if ((tid & 63) == 0) red[tid >> 6] = sq;
        __syncthreads();
        if (tid < 128) { const float var = (red[0] + red[1]) * (1.f / 128.f); const float y = dv * rsqrtf(var + LN_EPS) * mng[h * 128 + tid] * bf2f(zo[t * 512 + h * 128 + tid]);
            uahm[t * 1024 + 512 + h * 128 + tid] = f2bf(y); }
    }
}
__global__ __launch_bounds__(256) void k_h2route(const float* x1, const float* g2, const float* mod, const float* w_rg, const float* b_rg, const float* w_re, const float* b_re, bf16* h2, int* toke, float* tokw) {
    __shared__ float red[4]; __shared__ float lg[36];
    const int t = blockIdx.x, b = t / SEQ, tid = threadIdx.x;
    const float4 xv = ((const float4*)(x1 + (size_t)t * D))[tid];
    float ss = xv.x * xv.x + xv.y * xv.y + xv.z * xv.z + xv.w * xv.w;
    ss = block_sum256(ss, red);
    const float rstd = rsqrtf(ss * (1.f / D) + RMS_EPS);
    const float* sh = mod + b * 6144 + 3072, *sc = mod + b * 6144 + 4096;
    float hv[4]; const float xs[4] = {xv.x, xv.y, xv.z, xv.w};
#pragma unroll
    for (int j = 0; j < 4; ++j) { const int k = tid * 4 + j; hv[j] = xs[j] * rstd * g2[k] * (1.f + sc[k]) + sh[k]; }
    ushort4 o; o.x = f2bf(hv[0]); o.y = f2bf(hv[1]); o.z = f2bf(hv[2]); o.w = f2bf(hv[3]);
    ((ushort4*)(h2 + (size_t)t * D))[tid] = o;
    for (int j = 0; j < 36; ++j) {
        float a = 0.f;
#pragma unroll
        for (int i = 0; i < 4; ++i) { const int k = tid * 4 + i; a += hv[i] * ((j < 4) ? w_rg[k * 4 + j] : w_re[k * 32 + j - 4]); }
        a = block_sum256(a, red);
        if (tid == 0) lg[j] = a + ((j < 4) ? b_rg[j] : b_re[j - 4]);
    }
    __syncthreads();
    if (tid == 0) {
        int gs = 0; float gm = lg[0];
        for (int j = 1; j < 4; ++j) if (lg[j] > gm) { gm = lg[j]; gs = j; }
        float se = 0.f; for (int j = 0; j < 4; ++j) se += __expf(lg[j] - gm);
        const float pg = 1.f / se;
        const float* le = lg + 4 + gs * 8;
        int e0 = 0; float l0 = le[0];
        for (int j = 1; j < 8; ++j) if (le[j] > l0) { l0 = le[j]; e0 = j; }
        int e1 = -1; float l1 = -3.0e38f;
        for (int j = 0; j < 8; ++j) if (j != e0 && le[j] > l1) { l1 = le[j]; e1 = j; }
        const float r = __expf(l1 - l0);
        const float w0 = pg / (1.f + r), w1 = pg * r / (1.f + r);
        toke[t * 2] = gs * 8 + e0; toke[t * 2 + 1] = gs * 8 + e1; tokw[t * 2] = w0; tokw[t * 2 + 1] = w1;
    }
}
__global__ __launch_bounds__(256) void k_lists(const int* toke, const float* tokw, unsigned* cnt, int* listt, float* listw) {
    const int i = blockIdx.x * 256 + threadIdx.x; const int e = toke[i]; const unsigned pos = atomicAdd(cnt + 16 * e, 1u);
    listt[e * 16384 + pos] = i; listw[e * 16384 + pos] = tokw[i];
}
__global__ __launch_bounds__(256) void k_moe(const bf16* h2, const int* toke, const float* tokw, const float* wg, const float* wu, const float* wd, bf16* ys) {
    __shared__ float hs[1024]; __shared__ float hid[512];
    const int a = blockIdx.x, t = a >> 1, tid = threadIdx.x;
    const int e = toke[a]; const float w = tokw[a];
    for (int k = tid; k < 1024; k += 256) hs[k] = bf2f(h2[(size_t)t * 1024 + k]);
    __syncthreads();
    const float* Gp = wg + (size_t)e * 1024 * 512, *U = wu + (size_t)e * 1024 * 512, *Dn = wd + (size_t)e * 512 * 1024;
    float g0 = 0.f, g1 = 0.f, u0 = 0.f, u1 = 0.f;
    for (int k = 0; k < 1024; ++k) { const float hk = hs[k]; g0 += hk * Gp[(size_t)k * 512 + tid]; g1 += hk * Gp[(size_t)k * 512 + 256 + tid]; u0 += hk * U[(size_t)k * 512 + tid]; u1 += hk * U[(size_t)k * 512 + 256 + tid]; }
    hid[tid] = siluf_(g0) * u0; hid[tid + 256] = siluf_(g1) * u1;
    __syncthreads();
    float y[4] = {0.f, 0.f, 0.f, 0.f};
    for (int j = 0; j < 512; ++j) { const float hj = hid[j];
#pragma unroll
        for (int i = 0; i < 4; ++i) y[i] += hj * Dn[(size_t)j * 1024 + tid + 256 * i]; }
#pragma unroll
    for (int i = 0; i < 4; ++i) ys[(size_t)a * 1024 + tid + 256 * i] = f2bf(w * y[i]);
}
__global__ __launch_bounds__(256) void k_final(const float* x1, const bf16* ys, const float* mod, const float* gf, float* out) {
    __shared__ float red[4];
    const int t = blockIdx.x, b = t / SEQ, tid = threadIdx.x;
    const float4 xv = ((const float4*)(x1 + (size_t)t * D))[tid];
    const ushort4 y0 = ((const ushort4*)(ys + (size_t)t * 2048))[tid], y1 = ((const ushort4*)(ys + (size_t)t * 2048 + 1024))[tid];
    const float* gt = mod + b * 6144 + 5120 + tid * 4;
    float v[4];
    v[0] = xv.x + gt[0] * (bf2f(y0.x) + bf2f(y1.x)); v[1] = xv.y + gt[1] * (bf2f(y0.y) + bf2f(y1.y));
    v[2] = xv.z + gt[2] * (bf2f(y0.z) + bf2f(y1.z)); v[3] = xv.w + gt[3] * (bf2f(y0.w) + bf2f(y1.w));
    float ss = v[0] * v[0] + v[1] * v[1] + v[2] * v[2] + v[3] * v[3];
    ss = block_sum256(ss, red);
    const float rstd = rsqrtf(ss * (1.f / D) + RMS_EPS);
    float4 o; o.x = v[0] * rstd * gf[tid * 4]; o.y = v[1] * rstd * gf[tid * 4 + 1]; o.z = v[2] * rstd * gf[tid * 4 + 2]; o.w = v[3] * rstd * gf[tid * 4 + 3];
    ((float4*)(out + (size_t)t * D))[tid] = o;
}
#endif


#ifndef DBG_BENCH
#define DBG_BENCH 0
#endif
#if DBG_BENCH
__global__ void __launch_bounds__(512, 2) k_bench_a(const float* x, float* dummy) {
    extern __shared__ __attribute__((aligned(16))) unsigned char lds_b[];
    const int tid = threadIdx.x, lane = tid & 63, wave = tid >> 6, tile = blockIdx.x;
    f32x4 nx[4][4]; float acc = 0.f;
#pragma unroll
    for (int p = 0; p < 4; ++p)
#pragma unroll
        for (int j = 0; j < 4; ++j) nx[p][j] = *(const f32x4*)(x + ((size_t)tile * 64 + wave + 8 * p) * 1024 + 256 * j + 4 * lane);
#pragma unroll
    for (int r8 = 0; r8 < 8; ++r8) {
        const size_t row = (size_t)tile * 64 + wave + 8 * r8;
#pragma unroll
        for (int j = 0; j < 4; ++j) acc += (nx[r8 & 3][j][0] + nx[r8 & 3][j][1]) + (nx[r8 & 3][j][2] + nx[r8 & 3][j][3]);
        if (r8 + 4 < 8) {
#pragma unroll
            for (int j = 0; j < 4; ++j) nx[r8 & 3][j] = *(const f32x4*)(x + (row + 32) * 1024 + 256 * j + 4 * lane); }
    }
    if (acc == 123.456f) dummy[tid] = acc;
}
__global__ void __launch_bounds__(256) k_bench_b(const float* x, float* dummy) {
    const int tid = threadIdx.x, lane = tid & 63, wave = tid >> 6; const size_t row = (size_t)blockIdx.x * 4 + wave; float acc = 0.f;
#pragma unroll
    for (int j = 0; j < 4; ++j) { const f32x4 v = *(const f32x4*)(x + row * 1024 + 256 * j + 4 * lane); acc += (v[0] + v[1]) + (v[2] + v[3]); }
    if (acc == 123.456f) dummy[tid] = acc;
}
#endif
#if DBG_BENCH >= 4
template <int LVL>
__global__ void __launch_bounds__(512, 2) k_bench_d(const float* x, const float* g1, const float* mod, bf16* h1, float* dummy) {
    extern __shared__ __attribute__((aligned(16))) unsigned char lds_b[];
    const int tid = threadIdx.x, lane = tid & 63, wave = tid >> 6, tile = blockIdx.x, b = tile / 32;
    float sc[4][4], sh[4][4];
#pragma unroll
    for (int j = 0; j < 4; ++j) { const int k = 256 * j + 4 * lane; const f32x4 gv = *(const f32x4*)(g1 + k), sv = *(const f32x4*)(mod + b * 6144 + 1024 + k), hv = *(const f32x4*)(mod + b * 6144 + k);
#pragma unroll
        for (int i = 0; i < 4; ++i) { sc[j][i] = gv[i] * (1.f + sv[i]); sh[j][i] = hv[i]; } }
    f32x4 nx[4][4];
#pragma unroll
    for (int p = 0; p < 4; ++p)
#pragma unroll
        for (int j = 0; j < 4; ++j) nx[p][j] = *(const f32x4*)(x + ((size_t)tile * 64 + wave + 8 * p) * 1024 + 256 * j + 4 * lane);
#pragma unroll
    for (int r8 = 0; r8 < 8; ++r8) {
        const size_t row = (size_t)tile * 64 + wave + 8 * r8;
        f32x4 v[4]; float ss = 0.f;
#pragma unroll
        for (int j = 0; j < 4; ++j) { v[j] = nx[r8 & 3][j]; ss += (v[j][0] * v[j][0] + v[j][1] * v[j][1]) + (v[j][2] * v[j][2] + v[j][3] * v[j][3]); }
        if (r8 + 4 < 8) {
#pragma unroll
            for (int j = 0; j < 4; ++j) nx[r8 & 3][j] = *(const f32x4*)(x + (row + 32) * 1024 + 256 * j + 4 * lane); }
        asm volatile("" ::: "memory");
        const float rstd = rsqrtf(wave_sum(ss) * (1.f / 1024.f) + RMS_EPS);
        if (LVL >= 5) {
            float g[8];
#pragma unroll
            for (int q = 0; q < 8; ++q) g[q] = 0.f;
#pragma unroll
            for (int j = 0; j < 4; ++j) { float hh[4];
#pragma unroll
                for (int i = 0; i < 4; ++i) hh[i] = v[j][i] * rstd * sc[j][i] + sh[j][i];
                v2u o; o.x = pk2(hh[0], hh[1]); o.y = pk2(hh[2], hh[3]);
                *(v2u*)(h1 + row * 1024 + 256 * j + 4 * lane) = o;
                if (LVL >= 6) {
#pragma unroll
                    for (int i = 0; i < 4; ++i) { const LAS float* tp = (const LAS float*)lds_b + ((4 * j + i) * 64 + lane) * 8; f32x4 w0, w1;
                        if (LVL == 8) { w0 = (f32x4){1.f, 2.f, 3.f, 4.f}; w1 = (f32x4){5.f, 6.f, 7.f, 8.f}; } else { w0 = *(const LAS f32x4*)tp; w1 = *(const LAS f32x4*)(tp + 4); }
                        g[0] += hh[i] * w0[0]; g[1] += hh[i] * w0[1]; g[2] += hh[i] * w0[2]; g[3] += hh[i] * w0[3]; g[4] += hh[i] * w1[0]; g[5] += hh[i] * w1[1]; g[6] += hh[i] * w1[2]; g[7] += hh[i] * w1[3]; } } }
            if (LVL == 6 || LVL == 8) { const float t = ((g[0] + g[1]) + (g[2] + g[3])) + ((g[4] + g[5]) + (g[6] + g[7])); if (t == 123.456f) dummy[row] = t; }
            if (LVL == 7) { float mine = 0.f;
#pragma unroll
                for (int q = 0; q < 8; ++q) { const float sq = wave_sum(g[q]); mine = (lane == q) ? sq : mine; }
                if (lane < 8) dummy[row * 8 + lane] = (lane < 4) ? mine : logsigmoidf_(mine); }
        } else if (lane == 0) dummy[row] = rstd;
    }
}
#endif
#if DBG_BENCH == 3
__global__ void __launch_bounds__(512, 2) k_bench_c(float* dummy, float seed) {
    extern __shared__ __attribute__((aligned(16))) unsigned char lds_b[];
    float a0 = seed + threadIdx.x, a1 = a0 + 1.f, a2 = a0 + 2.f, a3 = a0 + 3.f; const float m = 1.0000001f, c = 1e-9f;
#pragma unroll 1
    for (int i = 0; i < 2048; ++i) {
#pragma unroll
        for (int j = 0; j < 4; ++j) { a0 = a0 * m + c; a1 = a1 * m + c; a2 = a2 * m + c; a3 = a3 * m + c; }
    }
    if (a0 + a1 + a2 + a3 == 123.456f) dummy[threadIdx.x] = a0;
}
#endif
#if MK_ONE
constexpr int NKERN = 1;
static const void* const mk_kernels[NKERN] = {(const void*)mk_fwd<0, NPHASE>};
#else
constexpr int NKERN = NPHASE;
static const void* const mk_kernels[NKERN] = {(const void*)mk_fwd<0, 1>, (const void*)mk_fwd<1, 2>, (const void*)mk_fwd<2, 3>, (const void*)mk_fwd<3, 4>, (const void*)mk_fwd<4, 5>, (const void*)mk_fwd<5, 6>,
    (const void*)mk_fwd<6, 7>, (const void*)mk_fwd<7, 8>, (const void*)mk_fwd<8, 9>, (const void*)mk_fwd<9, 10>, (const void*)mk_fwd<10, 11>};
#endif
extern "C" void kernel_launch(void* const* d_in, const int* in_sizes, int n_in, void* d_out, int out_size, void* d_ws, size_t ws_size, hipStream_t stream) {
    static int grid = 0;
    if (grid == 0) {
        int dev = 0, cus = 0;
        if (hipGetDevice(&dev) != hipSuccess || hipDeviceGetAttribute(&cus, hipDeviceAttributeMultiprocessorCount, dev) != hipSuccess) { grid = -1; return; }
        for (int k = 0; k < NKERN; ++k) if (hipFuncSetAttribute(mk_kernels[k], hipFuncAttributeMaxDynamicSharedMemorySize, LDS_BYTES) != hipSuccess) { grid = -1; return; }
        int per_cu = 0;
        (void)hipOccupancyMaxActiveBlocksPerMultiprocessor(&per_cu, mk_kernels[0], NTHREADS, LDS_BYTES);
        (void)hipGetLastError();
        grid = (per_cu >= 1) ? cus : -1;
    }
    if (grid < 0) return;
    (void)hipMemsetAsync((char*)d_ws + WS_CTL, 0, CTL_ZERO_BYTES, stream);
    Args a{};
    for (int i = 0; i < 26; ++i) a.in[i] = (const float*)d_in[i];
    a.out = (float*)d_out; a.ws = (unsigned char*)d_ws;
#if MK_ONE
    a.ph_lo = 0; a.ph_hi = NPHASE;
    { void* args[] = {&a}; (void)hipLaunchKernel(mk_kernels[0], dim3(grid), dim3(NTHREADS), args, LDS_BYTES, stream); }
#else
    unsigned char* ws = (unsigned char*)d_ws; float* out = (float*)d_out;
    float* mod = (float*)(ws + WS_MOD); float* gates = (float*)(ws + WS_GATES); int* toke = (int*)(ws + WS_TOKE); float* tokw = (float*)(ws + WS_TOKW);
    bf16* hb = (bf16*)(ws + WS_H); bf16* zu = (bf16*)(ws + WS_ZU); bf16* zq = (bf16*)(ws + WS_ZQ); bf16* zk = (bf16*)(ws + WS_ZK); bf16* zv = (bf16*)(ws + WS_ZV); bf16* zo = (bf16*)(ws + WS_ZO);
    bf16* zga = (bf16*)(ws + WS_ZGA); bf16* zgb = (bf16*)(ws + WS_ZGB); bf16* qc = (bf16*)(ws + WS_QC); bf16* kc = (bf16*)(ws + WS_KC); bf16* uahm = (bf16*)(ws + WS_UAHM);
    bf16* merged = (bf16*)(ws + WS_MERGED); bf16* ys = (bf16*)(ws + WS_YS);
    (void)mod; (void)gates; (void)toke; (void)tokw; (void)hb; (void)zu; (void)zq; (void)zk; (void)zv; (void)zo; (void)zga; (void)zgb; (void)qc; (void)kc; (void)uahm; (void)merged; (void)ys; (void)out;
#ifndef DBG_NPH
#define DBG_NPH NPHASE
#endif
#if DBG_BENCH == 1
    { static bool once = false; if (!once) { (void)hipFuncSetAttribute((const void*)k_bench_a, hipFuncAttributeMaxDynamicSharedMemorySize, LDS_BYTES); once = true; }
      for (int rep = 0; rep < 4; ++rep) hipLaunchKernelGGL(k_bench_a, dim3(256), dim3(512), LDS_BYTES, stream, (const float*)d_in[0], (float*)((char*)d_ws + WS_TOKE)); }
#elif DBG_BENCH >= 4
    { static bool once = false; if (!once) { (void)hipFuncSetAttribute((const void*)k_bench_d<DBG_BENCH>, hipFuncAttributeMaxDynamicSharedMemorySize, LDS_BYTES); once = true; }
      (void)hipMemsetAsync((char*)d_ws + WS_MOD, 0, 256 * 1024, stream);
      for (int rep = 0; rep < 2; ++rep) hipLaunchKernelGGL(k_bench_d<DBG_BENCH>, dim3(256), dim3(512), LDS_BYTES, stream, (const float*)d_in[0], (const float*)d_in[4], (const float*)((char*)d_ws + WS_MOD), (bf16*)((char*)d_ws + WS_H), (float*)((char*)d_ws + WS_TOKE)); }
#elif DBG_BENCH == 3
    { static bool once = false; if (!once) { (void)hipFuncSetAttribute((const void*)k_bench_c, hipFuncAttributeMaxDynamicSharedMemorySize, LDS_BYTES); once = true; }
      for (int rep = 0; rep < 2; ++rep) hipLaunchKernelGGL(k_bench_c, dim3(256), dim3(512), LDS_BYTES, stream, (float*)((char*)d_ws + WS_TOKE), 1.0f); }
#elif DBG_BENCH == 2
    for (int rep = 0; rep < 4; ++rep) hipLaunchKernelGGL(k_bench_b, dim3(4096), dim3(256), 0, stream, (const float*)d_in[0], (float*)((char*)d_ws + WS_TOKE));
#endif
    for (int ph = 0; ph < DBG_NPH; ++ph) {
        a.ph_lo = ph; a.ph_hi = ph + 1; a.flags = 0;
        bool mk = true;
#if NAIVE_MASK
        const float* const* I = (const float* const*)d_in;
        if ((NAIVE_MASK >> ph) & 1) {
            mk = false;
            switch (ph) {
            case 0: k_mod<<<8 * 6144 / 256, 256, 0, stream>>>(I[1], I[2], I[3], mod); mk = true; break;
            case 1: k_h1<<<T, 256, 0, stream>>>(I[0], I[4], mod, I[5], I[6], hb, gates); break;
            case 2: k_ngemm<NEpi1><<<dim3((DIN + 63) / 64, T / 64), 256, 0, stream>>>(hb, 1024, I[5], DIN, DIN, 1024, NEpi1{out, zq, zk, zv, zo, zga, zgb});
                    k_glu<<<T * 512 / 256, 256, 0, stream>>>(out, zu); a.flags = (DBG_CLS) << 8; mk = (DBG_CLS) != 0;
                    k_fixw1t<<<2048 * 1024 / 256, 256, 0, stream>>>(I[5], (bf16*)(ws + WS_W1T)); break;
            case 3: k_conva<<<T, 256, 0, stream>>>(zu, I[7], I[8], I[9], I[10], uahm); mk = ((NAIVE_MASK >> 4) & 1) ? false : true; break;
            case 4: k_qkconv<<<T, 256, 0, stream>>>(zq, zk, I[12], I[13], qc, kc);
                    k_mlstm_rec<<<BATCH * NH, 256, 0, stream>>>(qc, kc, zv, zo, gates, I[14], uahm); break;
            case 5: k_ngemm<NEpi2a><<<dim3(16, T / 64), 256, 0, stream>>>(uahm, 1024, I[11], 1024, 1024, 512, NEpi2a{out, zga});
                    k_ngemm<NEpi2b><<<dim3(16, T / 64), 256, 0, stream>>>(uahm + 512, 1024, I[15], 1024, 1024, 512, NEpi2b{out, zgb, merged}); break;
            case 6: k_ngemm<NEpi3><<<dim3(16, T / 64), 256, 0, stream>>>(merged, 1024, I[16], 1024, 1024, 1024, NEpi3{I[0], mod, out}); break;
            case 7: k_h2route<<<T, 256, 0, stream>>>(out, I[17], mod, I[18], I[19], I[20], I[21], hb, toke, tokw);
                    k_lists<<<T * 2 / 256, 256, 0, stream>>>(toke, tokw, (unsigned*)(ws + WS_CTL) + CW_CNT, (int*)(ws + WS_LISTT), (float*)(ws + WS_LISTW));
                    a.flags = 1; mk = true; break;
            case 8: break;
            case 9: k_moe<<<T * 2, 256, 0, stream>>>(hb, toke, tokw, I[22], I[23], I[24], (bf16*)(ws + WS_ZU)); break;
            case 10: k_final<<<T, 256, 0, stream>>>(out, (const bf16*)(ws + WS_ZU), mod, I[25], out); break;
            }
        }
#endif
        if (mk && ph == 10 && ((DBG_HREP >> 10) & 1)) { a.flags = 65536; void* args0[] = {&a}; (void)hipLaunchKernel(mk_kernels[ph], dim3(grid), dim3(NTHREADS), args0, LDS_BYTES, stream); a.flags = 0; }
        if (mk) { void* args[] = {&a}; (void)hipLaunchKernel(mk_kernels[ph], dim3(grid), dim3(NTHREADS), args, LDS_BYTES, stream);
            if (((DBG_HREP >> ph) & 1) && ph != 10) { if (ph == 7) a.flags |= DBG_F7; if (ph == 1) a.flags |= DBG_F1; if (ph == 4) a.flags |= DBG_F4; (void)hipLaunchKernel(mk_kernels[ph], dim3(grid), dim3(NTHREADS), args, LDS_BYTES, stream); } }
    }
#endif
}
```

```cpp
#include <hip/hip_runtime.h>
#include <stdint.h>
#include <cstdio>

#ifndef MK_ONE
#define MK_ONE 1
#endif
#ifndef NAIVE_MASK
#define NAIVE_MASK 0
#endif
#ifndef DBG_NPH
#define DBG_NPH 11
#endif
#ifndef P1_MFMA
#define P1_MFMA 0
#endif
#if P1_MFMA
#define P1_FN p1_h1_mfma
#else
#define P1_FN p1_h1
#endif
#ifndef XB_EARLY_ACQ
#define XB_EARLY_ACQ 1
#endif
#ifndef USE_XCD_BARRIER
#define USE_XCD_BARRIER 1
#endif
#ifndef DBG_XBAR
#define DBG_XBAR 0
#endif
#ifndef DBG_F4
#define DBG_F4 0
#endif
#ifndef DBG_F1
#define DBG_F1 0
#endif
#ifndef DBG_F7
#define DBG_F7 6
#endif
#ifndef DBG_HREP
#define DBG_HREP 0
#endif
#ifndef DBG_REP
#define DBG_REP 0
#endif
#if DBG_REP
#define REPK(k) for (int _r = 0; _r < 1 + ((DBG_REP >> (k)) & 1); ++_r)
#define REPSYNC() __syncthreads()
#else
#define REPK(k)
#define REPSYNC() do {} while (0)
#endif
#ifndef DBG_CLS
#define DBG_CLS 0
#endif
#ifndef DBG_GATEFIRST
#define DBG_GATEFIRST 0
#endif

typedef unsigned short bf16;
#define DEV __device__ __forceinline__
#define LAS __attribute__((address_space(3)))
typedef short bf16x8 __attribute__((ext_vector_type(8)));
typedef float f32x4 __attribute__((ext_vector_type(4)));
typedef unsigned v4u __attribute__((ext_vector_type(4)));
typedef unsigned v2u __attribute__((ext_vector_type(2)));

constexpr int BATCH = 8, SEQ = 2048, D = 1024, T = BATCH * SEQ;
constexpr int DIN = 5128, NH = 4;
constexpr float RMS_EPS = 1e-6f, LN_EPS = 1e-5f;
constexpr int NWAVES = 8, NTHREADS = 512;

DEV float bf2f(bf16 v) { return __uint_as_float(((unsigned)v) << 16); }
DEV float bflo(unsigned w) { return __uint_as_float(w << 16); }
DEV float bfhi(unsigned w) { return __uint_as_float(w & 0xffff0000u); }
DEV unsigned f2bfu(float f) { unsigned u = __float_as_uint(f); return (u + 0x7fffu + ((u >> 16) & 1u)) >> 16; }
DEV unsigned pk2(float lo, float hi);
DEV bf16 f2bf(float f) { return (bf16)(pk2(f, f) & 0xffffu); }
typedef float f32x2_cv __attribute__((ext_vector_type(2)));
typedef __bf16 bf16x2_cv __attribute__((ext_vector_type(2)));
DEV unsigned pk2(float lo, float hi) { const f32x2_cv v = {lo, hi}; const bf16x2_cv b = __builtin_convertvector(v, bf16x2_cv); return __builtin_bit_cast(unsigned, b); }
DEV float sigmoidf_(float x) { return __builtin_amdgcn_rcpf(1.f + __expf(-x)); }
DEV float siluf_(float x) { return x * __builtin_amdgcn_rcpf(1.f + __expf(-x)); }
DEV float logsigmoidf_(float x) { return fminf(x, 0.f) - log1pf(__expf(-fabsf(x))); }
template <int CTRL> DEV float dpp0(float v) { return __int_as_float(__builtin_amdgcn_update_dpp(0, __float_as_int(v), CTRL, 0xf, 0xf, true)); }
template <int CTRL> DEV float dppk(float v) { return __int_as_float(__builtin_amdgcn_update_dpp(__float_as_int(v), __float_as_int(v), CTRL, 0xf, 0xf, false)); }
DEV float rdlane(float v, int l) { return __int_as_float(__builtin_amdgcn_readlane(__float_as_int(v), l)); }
DEV float row16_sum(float v) {
    v += dpp0<0xB1>(v); v += dpp0<0x4E>(v); v += dpp0<0x141>(v); v += dpp0<0x140>(v); return v; }
DEV float wave_sum(float v) { v = row16_sum(v); return (rdlane(v, 0) + rdlane(v, 16)) + (rdlane(v, 32) + rdlane(v, 48)); }
DEV float wave_scan_add(float v, int lane) {
    v += dpp0<0x111>(v); v += dpp0<0x112>(v); v += dpp0<0x114>(v); v += dpp0<0x118>(v);
    const float r0 = rdlane(v, 15), r1 = rdlane(v, 31), r2 = rdlane(v, 47);
    return v + ((lane >= 48) ? (r0 + r1) + r2 : (lane >= 32) ? (r0 + r1) : (lane >= 16) ? r0 : 0.f); }
DEV float wave_scan_max(float v, int lane) {
    v = fmaxf(v, dppk<0x111>(v)); v = fmaxf(v, dppk<0x112>(v)); v = fmaxf(v, dppk<0x114>(v)); v = fmaxf(v, dppk<0x118>(v));
    const float r0 = rdlane(v, 15), r1 = rdlane(v, 31), r2 = rdlane(v, 47);
    const float p = (lane >= 48) ? fmaxf(fmaxf(r0, r1), r2) : (lane >= 32) ? fmaxf(r0, r1) : (lane >= 16) ? r0 : -3.0e38f;
    return fmaxf(v, p); }
#define LDS_WAIT() asm volatile("s_waitcnt lgkmcnt(0)" ::: "memory")

constexpr size_t MiB = 1u << 20;
constexpr size_t WS_CTL = 0, CTL_ZERO_BYTES = 65536;
constexpr size_t WS_MOD = 1 * MiB;
constexpr size_t WS_GATES = 1 * MiB + 256 * 1024;
constexpr size_t WS_STSC = 1 * MiB + 768 * 1024;
constexpr size_t WS_RBIAS = 1 * MiB + 800 * 1024;
constexpr size_t WS_WIF = 1 * MiB + 832 * 1024;
constexpr size_t WS_RW = 6 * MiB + 256 * 1024;
constexpr size_t WS_TOKE = 6 * MiB;
constexpr size_t WS_TOKW = 6 * MiB + 128 * 1024;
constexpr size_t WS_LISTT = 2 * MiB;
constexpr size_t WS_LISTW = 4 * MiB;
constexpr size_t WS_W1T = 8 * MiB;
constexpr size_t WS_W2T = 18 * MiB;
constexpr size_t WS_W3T = 20 * MiB;
constexpr size_t WS_STATE = 22 * MiB;
constexpr size_t WS_H = 40 * MiB;
constexpr size_t WS_ZU = 72 * MiB, WS_ZQ = 88 * MiB, WS_ZK = 104 * MiB, WS_ZV = 120 * MiB, WS_ZO = 136 * MiB;
constexpr size_t WS_ZGA = 152 * MiB, WS_ZGB = 184 * MiB;
constexpr size_t WS_UAHM = 216 * MiB;
constexpr size_t WS_MERGED = WS_ZQ;
constexpr size_t WS_WGU = 120 * MiB;
constexpr size_t WS_WD = 184 * MiB;
constexpr size_t WS_ACT = 216 * MiB;
constexpr size_t WS_YS = 40 * MiB;
constexpr size_t WS_QC = WS_H, WS_KC = WS_H + 16 * MiB;
constexpr int CW_BAR = 4096, CW_CNT = 8192, CW_MODCNT = 9216, CW_FLATBAR = 9280;

constexpr int LDS_TAB = 131072;
constexpr int LDS_MISC = 147456;
constexpr int LDS_BYTES = 151552;

struct Args { const float* in[26]; float* out; unsigned char* ws; int ph_lo, ph_hi, flags, pad; };

namespace pg8 {
constexpr int BM = 256, BK = 64, HALF = 128, HTB = HALF * BK * 2, NXCD = 8, WGM = 8;
DEV int lds_byte(int r, int c) { const int st = (r >> 4) * 2 + (c >> 5), rr = r & 15, cc = c & 31, ob = rr * 64 + cc * 2; return st * 1024 + (ob ^ (((ob >> 9) & 1) << 5)); }
DEV void stage_rc(int b, int& R, int& C) { const int st = b / 1024, sb = b % 1024, swz = sb ^ (((sb >> 9) & 1) << 5); R = (st >> 1) * 16 + swz / 64; C = (st & 1) * 32 + (swz % 64) / 2; }
DEV int perm32(int rho) { const int n = rho >> 4, i = rho & 15; return 8 * (i >> 2) + 4 * n + (i & 3); }
DEV unsigned cvt_pk_bf16(float lo, float hi) { return pk2(lo, hi); }

struct Unit { int pm, pn; unsigned ak, bk; int slot, valid, arow0; };

struct StaticOrder {
    int nM, nN, nwg, G, c;
    DEV void init(int M, int N, int G_, int c_) { nM = M / BM; nN = N / BM; nwg = nM * nN; G = G_; c = c_; }
    DEV bool tile(int L, int& pm, int& pn) const {
        if (L >= nwg) return false;
        int wgid = L; { const int q = nwg / NXCD, r = nwg % NXCD, xcd = wgid % NXCD, off = wgid / NXCD; wgid = (xcd < r ? xcd * (q + 1) : r * (q + 1) + (xcd - r) * q) + off; }
        const int nig = WGM * nN, gid = wgid / nig, fm = gid * WGM, gsz = (nM - fm) < WGM ? (nM - fm) : WGM;
        pm = fm + ((wgid % nig) % gsz); pn = (wgid % nig) / gsz; return true;
    }
    DEV bool next(int i, Unit& u) const { u.ak = 0; u.bk = 0; u.slot = 0; u.valid = 256; u.arow0 = 0; return tile(i * G + c, u.pm, u.pn); }
};

template <class Prob, class Epi, class Sched, bool ALIGN_EPI, bool SKIP = false>
DEV void gemm_phase(LAS unsigned char* lds, const Prob& P, const Sched& S, const Epi& E, const int K) {
    int tid = threadIdx.x; asm volatile("" : "+v"(tid));
    const int wid = __builtin_amdgcn_readfirstlane(tid >> 6), lane = tid & 63, wr = wid >> 2, wc = wid & 3, fr = lane & 15, fq = lane >> 4;
    const int nt = K / BK;
    int R[2], C[2], Rb[2];
#pragma unroll
    for (int i = 0; i < 2; ++i) { stage_rc(tid * 16 + i * 8192, R[i], C[i]); Rb[i] = Epi::PERM ? ((R[i] & ~31) + perm32(R[i] & 31)) : R[i]; }
    const unsigned kstep = BK * 2;
    const unsigned ldsw = (unsigned)wid * 1024u;
    const int aoff = lds_byte(wr * 64 + fr, fq * 8), boff = lds_byte(wc * 32 + fr, fq * 8);
    const char* const Abase = (const char*)P.A; const char* const Bbase = (const char*)P.B;
#define PG8_SA(b, h) (((b) * 2 + (h)) * HTB)
#define PG8_SB(b, h) ((4 + (b) * 2 + (h)) * HTB)
#define PG8_STAGE(bufoff, base, offs, kb) do { _Pragma("unroll") for (int _i = 0; _i < 2; ++_i) \
        __builtin_amdgcn_global_load_lds((const unsigned*)((base) + (size_t)((offs)[_i] + (kb))), (LAS unsigned*)(lds + (bufoff) + ldsw + _i * 8192), 16, 0, 0); } while (0)
#define PG8_LDA(dst, b, h) do { _Pragma("unroll") for (int m = 0; m < 4; ++m) _Pragma("unroll") for (int k = 0; k < 2; ++k) dst[m][k] = *(const LAS bf16x8*)(lds + PG8_SA(b, h) + aoff + m * 2048 + k * 1024); } while (0)
#define PG8_LDB(dst, b, h) do { _Pragma("unroll") for (int n = 0; n < 2; ++n) _Pragma("unroll") for (int k = 0; k < 2; ++k) dst[n][k] = *(const LAS bf16x8*)(lds + PG8_SB(b, h) + boff + n * 2048 + k * 1024); } while (0)
#define PG8_MMA(ai, bj, At, Bt) do { __builtin_amdgcn_s_setprio(1); _Pragma("unroll") for (int m = 0; m < 4; ++m) _Pragma("unroll") for (int n = 0; n < 2; ++n) _Pragma("unroll") for (int k = 0; k < 2; ++k) \
        acc[ai][bj][m][n] = __builtin_amdgcn_mfma_f32_16x16x32_bf16(Bt[n][k], At[m][k], acc[ai][bj][m][n], 0, 0, 0); __builtin_amdgcn_s_setprio(0); } while (0)
#define PG8_WAIT_V(n) asm volatile("s_waitcnt vmcnt(" #n ")" ::: "memory")
#define PG8_WAIT_L(n) asm volatile("s_waitcnt lgkmcnt(" #n ")" ::: "memory")
#define PG8_BAR __builtin_amdgcn_s_barrier()
#define PG8_SCHED __builtin_amdgcn_sched_barrier(0)
    Unit cur, nxt; int ui = 0;
    if (!S.next(0, cur)) return;
    f32x4 acc[2][2][4][2];
#pragma unroll
    for (int a = 0; a < 2; ++a)
#pragma unroll
        for (int b = 0; b < 2; ++b)
#pragma unroll
            for (int m = 0; m < 4; ++m)
#pragma unroll
                for (int n = 0; n < 2; ++n) acc[a][b][m][n] = (f32x4){0.f, 0.f, 0.f, 0.f};
    bf16x8 At[4][2], B0[2][2], B1[2][2];
    unsigned ca[2][2], cb[2][2], na[2][2], nb[2][2];
    P.aoffs(cur, R, C, ca); P.boffs(cur, Rb, C, cb);
    PG8_STAGE(PG8_SB(0, 0), Bbase, cb[0], 0u); PG8_STAGE(PG8_SB(0, 1), Bbase, cb[1], 0u); PG8_STAGE(PG8_SA(0, 0), Abase, ca[0], 0u); PG8_STAGE(PG8_SA(0, 1), Abase, ca[1], 0u);
    if (wr == 1) PG8_BAR;
    PG8_WAIT_V(2); PG8_BAR;
    PG8_STAGE(PG8_SB(1, 0), Bbase, cb[0], kstep); PG8_STAGE(PG8_SA(1, 0), Abase, ca[0], kstep); PG8_STAGE(PG8_SB(1, 1), Bbase, cb[1], kstep);
    PG8_WAIT_V(6); PG8_BAR;
    for (;;) {
        const bool has_next = S.next(ui + 1, nxt);
        if (has_next) { P.aoffs(nxt, R, C, na); P.boffs(nxt, Rb, C, nb); }
        else {
#pragma unroll
            for (int h = 0; h < 2; ++h)
#pragma unroll
                for (int i = 0; i < 2; ++i) { na[h][i] = ca[h][i]; nb[h][i] = cb[h][i]; } }
        const bool do0 = !(SKIP && cur.valid <= 64 && wr == 1), do1 = !(SKIP && cur.valid <= 128) && do0;
        for (int t = 0; t < nt; t += 2) {
            const bool last = (t == nt - 2);
            const unsigned k1 = (unsigned)(t + 1) * kstep;
            const unsigned kb2 = last ? 0u : (unsigned)(t + 2) * kstep, kb3 = kb2 + kstep;
            unsigned a2[2][2], b2[2][2];
#pragma unroll
            for (int h = 0; h < 2; ++h)
#pragma unroll
                for (int i = 0; i < 2; ++i) { a2[h][i] = last ? na[h][i] : ca[h][i]; b2[h][i] = last ? nb[h][i] : cb[h][i]; }
            PG8_LDB(B0, 0, 0); PG8_LDB(B1, 0, 1); PG8_SCHED; PG8_LDA(At, 0, 0); PG8_STAGE(PG8_SA(1, 1), Abase, ca[1], k1);
            PG8_WAIT_V(8); PG8_WAIT_L(0); PG8_BAR; if (do0) { PG8_MMA(0, 0, At, B0); PG8_MMA(0, 1, At, B1); } PG8_BAR; PG8_SCHED;
            PG8_LDA(At, 0, 1); PG8_STAGE(PG8_SB(0, 0), Bbase, b2[0], kb2); PG8_STAGE(PG8_SB(0, 1), Bbase, b2[1], kb2); PG8_STAGE(PG8_SA(0, 0), Abase, a2[0], kb2);
            PG8_WAIT_V(8); PG8_WAIT_L(0); PG8_BAR; if (do1) { PG8_MMA(1, 0, At, B0); PG8_MMA(1, 1, At, B1); } PG8_BAR; PG8_SCHED;
            PG8_LDB(B0, 1, 0); PG8_LDB(B1, 1, 1); PG8_SCHED; PG8_LDA(At, 1, 0); PG8_STAGE(PG8_SA(0, 1), Abase, a2[1], kb2);
            PG8_WAIT_V(8); PG8_WAIT_L(0); PG8_BAR; if (do0) { PG8_MMA(0, 0, At, B0); PG8_MMA(0, 1, At, B1); } PG8_BAR; PG8_SCHED;
            PG8_LDA(At, 1, 1); PG8_STAGE(PG8_SB(1, 0), Bbase, b2[0], kb3); PG8_STAGE(PG8_SB(1, 1), Bbase, b2[1], kb3); PG8_STAGE(PG8_SA(1, 0), Abase, a2[0], kb3);
            PG8_WAIT_V(8); PG8_WAIT_L(0); PG8_BAR; if (do1) { PG8_MMA(1, 0, At, B0); PG8_MMA(1, 1, At, B1); } PG8_BAR; PG8_SCHED;
        }
        if constexpr (ALIGN_EPI) { if (wr == 0) PG8_BAR; }
        E(acc, cur, wr, wc, fr, fq);
        if (!has_next) break;
        if (!E.keep(cur)) {
#pragma unroll
            for (int a = 0; a < 2; ++a)
#pragma unroll
                for (int b = 0; b < 2; ++b)
#pragma unroll
                    for (int m = 0; m < 4; ++m)
#pragma unroll
                        for (int n = 0; n < 2; ++n) acc[a][b][m][n] = (f32x4){0.f, 0.f, 0.f, 0.f};
        }
        cur = nxt; ++ui;
#pragma unroll
        for (int h = 0; h < 2; ++h)
#pragma unroll
            for (int i = 0; i < 2; ++i) { ca[h][i] = na[h][i]; cb[h][i] = nb[h][i]; }
        if constexpr (ALIGN_EPI) { if (wr == 1) PG8_BAR; }
    }
    PG8_WAIT_V(0);
    if constexpr (!ALIGN_EPI) { if (wr == 0) PG8_BAR; }
    PG8_BAR;
#undef PG8_SA
#undef PG8_SB
#undef PG8_STAGE
#undef PG8_LDA
#undef PG8_LDB
#undef PG8_MMA
#undef PG8_WAIT_V
#undef PG8_WAIT_L
#undef PG8_BAR
#undef PG8_SCHED
}
}
using pg8::Unit;

struct ProbPlain {
    const bf16* A; const bf16* B; unsigned lda2, ldb2;
    DEV void aoffs(const Unit& u, const int (&R)[2], const int (&C)[2], unsigned (&o)[2][2]) const {
#pragma unroll
        for (int h = 0; h < 2; ++h)
#pragma unroll
            for (int i = 0; i < 2; ++i) o[h][i] = (unsigned)(u.pm * 256 + 128 * h + R[i]) * lda2 + (unsigned)C[i] * 2u + u.ak; }
    DEV void boffs(const Unit& u, const int (&Rb)[2], const int (&C)[2], unsigned (&o)[2][2]) const {
#pragma unroll
        for (int h = 0; h < 2; ++h)
#pragma unroll
            for (int i = 0; i < 2; ++i) o[h][i] = (unsigned)(u.pn * 256 + 128 * h + Rb[i]) * ldb2 + (unsigned)C[i] * 2u + u.bk; }
};
struct ProbMoeUp {
    const bf16* A; const bf16* B; const LAS unsigned* rowtab;
    DEV void aoffs(const Unit& u, const int (&R)[2], const int (&C)[2], unsigned (&o)[2][2]) const {
#pragma unroll
        for (int h = 0; h < 2; ++h)
#pragma unroll
            for (int i = 0; i < 2; ++i) o[h][i] = rowtab[u.slot * 256 + 128 * h + R[i]] + (unsigned)C[i] * 2u; }
    DEV void boffs(const Unit& u, const int (&Rb)[2], const int (&C)[2], unsigned (&o)[2][2]) const {
#pragma unroll
        for (int h = 0; h < 2; ++h)
#pragma unroll
            for (int i = 0; i < 2; ++i) o[h][i] = (unsigned)(u.pn * 256 + 128 * h + Rb[i]) * 2048u + (unsigned)C[i] * 2u + u.bk; }
};
struct ProbMoeDown {
    const bf16* A; const bf16* B;
    DEV void aoffs(const Unit& u, const int (&R)[2], const int (&C)[2], unsigned (&o)[2][2]) const {
#pragma unroll
        for (int h = 0; h < 2; ++h)
#pragma unroll
            for (int i = 0; i < 2; ++i) o[h][i] = (unsigned)(u.arow0 + 128 * h + R[i]) * 1024u + (unsigned)C[i] * 2u; }
    DEV void boffs(const Unit& u, const int (&Rb)[2], const int (&C)[2], unsigned (&o)[2][2]) const {
#pragma unroll
        for (int h = 0; h < 2; ++h)
#pragma unroll
            for (int i = 0; i < 2; ++i) o[h][i] = (unsigned)(u.pn * 256 + 128 * h + Rb[i]) * 1024u + (unsigned)C[i] * 2u + u.bk; }
};

DEV void st16_wt(void* p, const v4u v) { asm volatile("global_store_dwordx4 %0, %1, off sc1\n\ts_nop 1" :: "v"(p), "v"(v) : "memory"); }
DEV v4u pack8(const f32x4 v0, const f32x4 v1) { v4u w; w.x = pg8::cvt_pk_bf16(v0[0], v0[1]); w.y = pg8::cvt_pk_bf16(v0[2], v0[3]); w.z = pg8::cvt_pk_bf16(v1[0], v1[1]); w.w = pg8::cvt_pk_bf16(v1[2], v1[3]); return w; }
DEV f32x4 sig4(f32x4 v) { f32x4 o; o[0] = sigmoidf_(v[0]); o[1] = sigmoidf_(v[1]); o[2] = sigmoidf_(v[2]); o[3] = sigmoidf_(v[3]); return o; }
DEV void unpack8(const v4u w, f32x4& lo, f32x4& hi) { lo[0] = bflo(w.x); lo[1] = bfhi(w.x); lo[2] = bflo(w.y); lo[3] = bfhi(w.y); hi[0] = bflo(w.z); hi[1] = bfhi(w.z); hi[2] = bflo(w.w); hi[3] = bfhi(w.w); }

struct Epi1 {
    static constexpr bool PERM = true;
    bf16* zu; bf16* zga; int cls;
    DEV bool keep(const Unit&) const { return false; }
    DEV void operator()(f32x4 (&acc)[2][2][4][2], const Unit& u, int wr, int wc, int fr, int fq) const {
        const int row0 = u.pm * 256 + wr * 64 + fr, cl = wc * 32 + 8 * fq;
        if (cls) { const int c = (u.pn < 4) ? 1 : (u.pn < 12) ? 2 : (u.pn < 16) ? 4 : 8; if (!(cls & c)) return; }
        if (u.pn < 4) {
#pragma unroll
            for (int ai = 0; ai < 2; ++ai)
#pragma unroll
                for (int m = 0; m < 4; ++m) { const size_t row = (size_t)(row0 + ai * 128 + m * 16);
                    const f32x4 v0 = acc[ai][0][m][0] * sig4(acc[ai][1][m][0]), v1 = acc[ai][0][m][1] * sig4(acc[ai][1][m][1]);
                    *(v4u*)(zu + row * 512 + 128 * u.pn + cl) = pack8(v0, v1); }
        } else {
            bf16* base; int ld, colb; bool sg;
            if (u.pn < 12) { const int ti = (u.pn - 4) >> 1; base = zu + (size_t)(1 + ti) * T * 512; ld = 512; colb = 256 * ((u.pn - 4) & 1); sg = (ti == 3); }
            else { const int ti = (u.pn - 12) >> 2; base = zga + (size_t)ti * T * 1024; ld = 1024; colb = 256 * ((u.pn - 12) & 3); sg = true; }
            if (u.pn >= 12) {
                bf16* fb = base + ((size_t)(u.pm * 4 + ((u.pn - 12) & 3)) * 65536) + (size_t)((wr * 4 + wc) * 64 + fq * 16 + fr) * 8;
#pragma unroll
                for (int ai = 0; ai < 2; ++ai)
#pragma unroll
                    for (int m = 0; m < 4; ++m)
#pragma unroll
                        for (int bj = 0; bj < 2; ++bj) *(v4u*)(fb + (size_t)(((ai * 4 + m) * 2 + bj) * 4096)) = pack8(sig4(acc[ai][bj][m][0]), sig4(acc[ai][bj][m][1]));
            } else
#pragma unroll
            for (int ai = 0; ai < 2; ++ai)
#pragma unroll
                for (int m = 0; m < 4; ++m) { const size_t row = (size_t)(row0 + ai * 128 + m * 16);
#pragma unroll
                    for (int bj = 0; bj < 2; ++bj) { f32x4 v0 = acc[ai][bj][m][0], v1 = acc[ai][bj][m][1]; if (sg) { v0 = sig4(v0); v1 = sig4(v1); }
                        *(v4u*)(base + row * ld + colb + 128 * bj + cl) = pack8(v0, v1); } }
        }
    }
};
struct Epi2 {
    static constexpr bool PERM = true;
    const bf16* zga; const bf16* zgb; bf16* merged;
    DEV bool keep(const Unit& u) const { return u.slot == 0; }
    DEV void operator()(f32x4 (&acc)[2][2][4][2], const Unit& u, int wr, int wc, int fr, int fq) const {
        const int row0 = u.pm * 256 + wr * 64 + fr, c0 = u.pn * 256 + wc * 32 + 8 * fq;
        const size_t fo = ((size_t)(u.pm * 4 + u.pn) * 65536) + (size_t)((wr * 4 + wc) * 64 + fq * 16 + fr) * 8;
#pragma unroll
        for (int ai = 0; ai < 2; ++ai)
#pragma unroll
            for (int m = 0; m < 4; ++m) { const size_t ro = (size_t)(row0 + ai * 128 + m * 16) * 1024 + c0;
#pragma unroll
                for (int bj = 0; bj < 2; ++bj) { const size_t fa = fo + (size_t)(((ai * 4 + m) * 2 + bj) * 4096);
                    f32x4 b0, b1; unpack8(*(const v4u*)(zgb + fa), b0, b1);
                    if (u.slot == 0) { f32x4 a0, a1; unpack8(*(const v4u*)(zga + fa), a0, a1);
#pragma unroll
                        for (int j = 0; j < 4; ++j) { acc[ai][bj][m][0][j] *= a0[j] * __builtin_amdgcn_rcpf(fmaxf(b0[j], 1e-30f)); acc[ai][bj][m][1][j] *= a1[j] * __builtin_amdgcn_rcpf(fmaxf(b1[j], 1e-30f)); }
                    } else { *(v4u*)(merged + ro + 128 * bj) = pack8(acc[ai][bj][m][0] * b0, acc[ai][bj][m][1] * b1); }
                } }
    }
};
struct Epi3 {
    static constexpr bool PERM = false;
    const float* x; const float* mod; float* out;
    DEV bool keep(const Unit&) const { return false; }
    DEV void operator()(f32x4 (&acc)[2][2][4][2], const Unit& u, int wr, int wc, int fr, int fq) const {
        const int row0 = u.pm * 256 + wr * 64 + fr, c0 = u.pn * 256 + wc * 32 + 4 * fq; const int b = u.pm >> 3;
        f32x4 gt[2][2];
#pragma unroll
        for (int bj = 0; bj < 2; ++bj)
#pragma unroll
            for (int n = 0; n < 2; ++n) gt[bj][n] = *(const f32x4*)(mod + b * 6144 + 2048 + c0 + 128 * bj + 16 * n);
#pragma unroll
        for (int ai = 0; ai < 2; ++ai)
#pragma unroll
            for (int m = 0; m < 4; ++m) { const size_t ro = (size_t)(row0 + ai * 128 + m * 16) * 1024 + c0;
#pragma unroll
                for (int bj = 0; bj < 2; ++bj)
#pragma unroll
                    for (int n = 0; n < 2; ++n) { const f32x4 xv = *(const f32x4*)(x + ro + 128 * bj + 16 * n); *(f32x4*)(out + ro + 128 * bj + 16 * n) = xv + gt[bj][n] * acc[ai][bj][m][n]; } }
    }
};
struct EpiUp {
    static constexpr bool PERM = true;
    bf16* act;
    DEV bool keep(const Unit&) const { return false; }
    DEV void operator()(f32x4 (&acc)[2][2][4][2], const Unit& u, int wr, int wc, int fr, int fq) const {
        const int cl = 128 * u.pn + wc * 32 + 8 * fq;
#pragma unroll
        for (int ai = 0; ai < 2; ++ai)
#pragma unroll
            for (int m = 0; m < 4; ++m) { const int rt = ai * 128 + wr * 64 + m * 16 + fr;
                if (rt < u.valid) { f32x4 v0, v1;
#pragma unroll
                    for (int j = 0; j < 4; ++j) { v0[j] = siluf_(acc[ai][0][m][0][j]) * acc[ai][1][m][0][j]; v1[j] = siluf_(acc[ai][0][m][1][j]) * acc[ai][1][m][1][j]; }
                    *(v4u*)(act + (size_t)(u.arow0 + rt) * 512 + cl) = pack8(v0, v1); } }
    }
};
struct EpiDown {
    static constexpr bool PERM = true;
    bf16* ys; const LAS unsigned* desttab; const LAS float* wtab;
    DEV bool keep(const Unit&) const { return false; }
    DEV void operator()(f32x4 (&acc)[2][2][4][2], const Unit& u, int wr, int wc, int fr, int fq) const {
        const int cl = 256 * u.pn + wc * 32 + 8 * fq;
#pragma unroll
        for (int ai = 0; ai < 2; ++ai)
#pragma unroll
            for (int m = 0; m < 4; ++m) { const int rt = ai * 128 + wr * 64 + m * 16 + fr;
                if (rt < u.valid) { const unsigned dest = desttab[u.slot * 256 + rt]; const float w = wtab[u.slot * 256 + rt];
#pragma unroll
                    for (int bj = 0; bj < 2; ++bj) *(v4u*)(ys + (size_t)dest * 1024 + cl + 128 * bj) = pack8(acc[ai][bj][m][0] * w, acc[ai][bj][m][1] * w); } }
    }
};

#define XB_TMO      128
#define XB_XCNT(j)  (256  + 64 * (j))
#define XB_XSUB(j)  (1280 + 64 * (j))
#define XB_XGEN(j)  (2304 + 64 * (j))
#define XB_TOP      3328
#define XB_TOPGEN   3392
#define XCD_BAR_WORDS 3456
#define XB_SPIN_CAP (1u << 18)
__device__ __forceinline__ unsigned xb_ld(unsigned* p)              { return __hip_atomic_load(p, __ATOMIC_RELAXED, __HIP_MEMORY_SCOPE_AGENT); }
__device__ __forceinline__ unsigned xb_add(unsigned* p, unsigned v) { return __hip_atomic_fetch_add(p, v, __ATOMIC_RELAXED, __HIP_MEMORY_SCOPE_AGENT); }
__device__ __forceinline__ unsigned xb_xcc_id() { return (unsigned)__builtin_amdgcn_s_getreg((3 << 11) | 20) & 0xFu; }
#define XB_SPIN(cond, bar) do { unsigned _sp = 0; while (cond) { __builtin_amdgcn_s_sleep(1); \
    if ((++_sp & 255u) == 0u) { if (xb_ld(&(bar)[XB_TMO])) break; if (_sp > XB_SPIN_CAP) { atomicAdd(&(bar)[XB_TMO], 1u); break; } } } } while (0)
struct XcdBarrier { unsigned* bar; unsigned x; volatile LAS unsigned* st; };
__device__ __forceinline__ XcdBarrier xcd_barrier_post(unsigned* bar, volatile LAS unsigned* st) {
    XcdBarrier b; b.bar = bar; b.x = xb_xcc_id(); b.st = st;
    if (threadIdx.x == 0) (void)xb_add(&bar[XB_XCNT(b.x)], 1u);
    return b;
}
__device__ __forceinline__ void xcd_barrier_complete(unsigned* bar, unsigned x, unsigned& nloc, unsigned& nx) {
    const unsigned G = gridDim.x * gridDim.y * gridDim.z;
    unsigned sum, cnt, mine, sp = 0u;
    for (;;) {
        sum = 0u; cnt = 0u; mine = 0u;
#pragma unroll
        for (unsigned j = 0; j < 16; ++j) { const unsigned c = xb_ld(&bar[XB_XCNT(j)]); sum += c; cnt += (c > 0u) ? 1u : 0u; mine = (j == x) ? c : mine; }
        if (sum == G) break;
        __builtin_amdgcn_s_sleep(1);
        if ((++sp & 255u) == 0u) { if (xb_ld(&bar[XB_TMO])) break; if (sp > XB_SPIN_CAP) { atomicAdd(&bar[XB_TMO], 1u); break; } }
    }
    nloc = mine > 0u ? mine : 1u; nx = cnt > 0u ? cnt : 1u;
}
__device__ __forceinline__ void xcd_barrier(const XcdBarrier& b) {
    asm volatile("s_waitcnt vmcnt(0)" ::: "memory");
    __syncthreads();
    if (threadIdx.x == 0) {
        unsigned* bar = b.bar;
        __builtin_amdgcn_s_waitcnt(0);
        unsigned nloc = b.st[0], nx = b.st[1];
        if (nloc == 0u) { xcd_barrier_complete(bar, b.x, nloc, nx); b.st[0] = nloc; b.st[1] = nx; }
        const unsigned old = xb_add(&bar[XB_XSUB(b.x)], 1u);
        const unsigned gen = old / nloc;
        if (old + 1u == (gen + 1u) * nloc) {
            __builtin_amdgcn_fence(__ATOMIC_RELEASE, "agent");
            asm volatile("s_waitcnt vmcnt(0)" ::: "memory");
            const unsigned og = xb_add(&bar[XB_TOP], 1u);
            const unsigned tg = og / nx;
            if (og + 1u == (tg + 1u) * nx) xb_add(&bar[XB_TOPGEN], 1u);
            else XB_SPIN(xb_ld(&bar[XB_TOPGEN]) == tg, bar);
            __builtin_amdgcn_fence(__ATOMIC_ACQUIRE, "agent");
            xb_add(&bar[XB_XGEN(b.x)], 1u);
            asm volatile("s_waitcnt vmcnt(0)" ::: "memory");
        } else {
#if XB_EARLY_ACQ
            __builtin_amdgcn_fence(__ATOMIC_ACQUIRE, "agent");
            XB_SPIN(xb_ld(&bar[XB_XGEN(b.x)]) == gen, bar);
            asm volatile("s_waitcnt vmcnt(0)" ::: "memory");
#else
            XB_SPIN(xb_ld(&bar[XB_XGEN(b.x)]) == gen, bar);
            __builtin_amdgcn_fence(__ATOMIC_ACQUIRE, "agent");
            asm volatile("s_waitcnt vmcnt(0)" ::: "memory");
#endif
        }
    }
    __syncthreads();
}

__device__ __forceinline__ void flat_barrier(unsigned* cnt, unsigned& gen) {
    asm volatile("s_waitcnt vmcnt(0)" ::: "memory");
    __syncthreads();
    ++gen;
    if (threadIdx.x == 0) {
        __builtin_amdgcn_fence(__ATOMIC_RELEASE, "agent");
        asm volatile("s_waitcnt vmcnt(0)" ::: "memory");
        (void)xb_add(cnt, 1u);
        const unsigned want = gen * gridDim.x; unsigned sp = 0;
        while (xb_ld(cnt) < want) { __builtin_amdgcn_s_sleep(1); if (++sp > (1u << 22)) break; }
        __builtin_amdgcn_fence(__ATOMIC_ACQUIRE, "agent");
        asm volatile("s_waitcnt vmcnt(0)" ::: "memory");
    }
    __syncthreads();
}
DEV f32x4 mma16(bf16x8 a, bf16x8 b, f32x4 c) { return __builtin_amdgcn_mfma_f32_16x16x32_bf16(a, b, c, 0, 0, 0); }
DEV void split8(const f32x4 a, const f32x4 b, bf16x8& hi, bf16x8& lo) {
    v4u h, l; const float r[8] = {a[0], a[1], a[2], a[3], b[0], b[1], b[2], b[3]}; unsigned hw[4], lw[4];
#pragma unroll
    for (int i = 0; i < 4; ++i) { hw[i] = pk2(r[2 * i], r[2 * i + 1]); lw[i] = pk2(r[2 * i] - bflo(hw[i]), r[2 * i + 1] - bfhi(hw[i])); }
    h.x = hw[0]; h.y = hw[1]; h.z = hw[2]; h.w = hw[3]; l.x = lw[0]; l.y = lw[1]; l.z = lw[2]; l.w = lw[3];
    hi = __builtin_bit_cast(bf16x8, h); lo = __builtin_bit_cast(bf16x8, l);
}
DEV void transpose_item(const float* src, int ldsrc, bf16* dst, int lddst, LAS float* scr, int lane) {
#pragma unroll 8
    for (int i = 0; i < 32; ++i) { const int kk = 2 * i + (lane >> 5); scr[kk * 33 + (lane & 31)] = src[(size_t)kk * ldsrc + (lane & 31)]; }
    LDS_WAIT(); asm volatile("" ::: "memory");
    const int c = lane & 7;
#pragma unroll
    for (int j = 0; j < 4; ++j) { const int n = (lane >> 3) + 8 * j; const LAS float* s = scr + (8 * c) * 33 + n;
        v4u o; o.x = pk2(s[0 * 33], s[1 * 33]); o.y = pk2(s[2 * 33], s[3 * 33]); o.z = pk2(s[4 * 33], s[5 * 33]); o.w = pk2(s[6 * 33], s[7 * 33]);
        *(v4u*)(dst + (size_t)n * lddst + 8 * c) = o; }
    LDS_WAIT(); asm volatile("" ::: "memory");
}

DEV void router_prep(const Args& a, int gw, int NGW, int lane) {
    const float* mod = (const float*)(a.ws + WS_MOD);
    const float* g2 = a.in[17]; const float* w_rg = a.in[18]; const float* b_rg = a.in[19]; const float* w_re = a.in[20]; const float* b_re = a.in[21];
    float* rbias = (float*)(a.ws + WS_RBIAS); v4u* rw = (v4u*)(a.ws + WS_RW);
    for (int it = gw; it < 8 * 36; it += NGW) { const int b = it / 36, n = it % 36; float sacc = 0.f;
#pragma unroll
        for (int i = 0; i < 16; ++i) { const int k = lane + 64 * i; const float w = (n < 4) ? w_rg[k * 4 + n] : w_re[k * 32 + n - 4]; sacc += mod[b * 6144 + 3072 + k] * w; }
        sacc = wave_sum(sacc);
        if (lane == 0) rbias[b * 48 + n] = sacc + ((n < 4) ? b_rg[n] : b_re[n - 4]); }
    for (int it = gw; it < 8 * 8 * 4 * 3; it += NGW) {
        const int nt = it % 3, kk = (it / 3) & 3, w8 = (it / 12) & 7, b = it / 96;
        const int n = 16 * nt + (lane & 15), k0 = 128 * w8 + 32 * kk + 8 * (lane >> 4);
        f32x4 w0, w1;
#pragma unroll
        for (int j = 0; j < 8; ++j) { const int k = k0 + j; const float* wp = (n < 4) ? (w_rg + k * 4 + n) : (w_re + k * 32 + ((n < 36) ? n - 4 : 0));
            float w = *wp; w = (n < 36) ? w : 0.f;
            w *= g2[k] * (1.f + mod[b * 6144 + 4096 + k]); if (j < 4) w0[j] = w; else w1[j - 4] = w; }
        bf16x8 hi, lo; split8(w0, w1, hi, lo);
        rw[((size_t)it * 2) * 64 + lane] = __builtin_bit_cast(v4u, hi); rw[((size_t)it * 2 + 1) * 64 + lane] = __builtin_bit_cast(v4u, lo);
    }
}
DEV void wait_mod(const Args& a, int tid) {
    if (tid == 0) {
        unsigned* mc = (unsigned*)(a.ws + WS_CTL) + CW_MODCNT; unsigned sp = 0;
        while (__hip_atomic_load(mc, __ATOMIC_RELAXED, __HIP_MEMORY_SCOPE_AGENT) < 192u) { __builtin_amdgcn_s_sleep(2); if (++sp > (1u << 22)) break; }
        __builtin_amdgcn_fence(__ATOMIC_ACQUIRE, "agent"); asm volatile("s_waitcnt vmcnt(0)" ::: "memory"); }
    __syncthreads();
}
DEV void p0_prologue(const Args& a, LAS unsigned char* lds, int bid, int G) {
    int tid = threadIdx.x; asm volatile("" : "+v"(tid));
    const int lane = tid & 63, wave = __builtin_amdgcn_readfirstlane(tid >> 6);
    const float* c = a.in[1]; const float* w_ada = a.in[2]; const float* b_ada = a.in[3];
    float* mod = (float*)(a.ws + WS_MOD);
    if (bid < 192) {
        LAS float* sil = (LAS float*)lds;
        LAS float* red = (LAS float*)(lds + 32768);
        for (int i = tid; i < 8192; i += NTHREADS) sil[i] = siluf_(c[i]);
        __syncthreads();
        for (int item = bid; item < 192; item += G) {
            const int n0 = item * 32, lg = lane >> 3, cq = lane & 7;
            float acc[8][4];
#pragma unroll
            for (int b = 0; b < 8; ++b)
#pragma unroll
                for (int j = 0; j < 4; ++j) acc[b][j] = 0.f;
#pragma unroll 4
            for (int j = 0; j < 16; ++j) { const int k = wave * 128 + j * 8 + lg; const f32x4 w = *(const f32x4*)(w_ada + (size_t)k * 6144 + n0 + cq * 4);
#pragma unroll
                for (int b = 0; b < 8; ++b) { const float s = sil[b * 1024 + k]; acc[b][0] += s * w[0]; acc[b][1] += s * w[1]; acc[b][2] += s * w[2]; acc[b][3] += s * w[3]; } }
#pragma unroll
            for (int b = 0; b < 8; ++b)
#pragma unroll
                for (int j = 0; j < 4; ++j) { float v = acc[b][j]; v += dpp0<0x128>(v); if ((lane & 8) == 0) red[(wave * 4 + (lane >> 4)) * 256 + b * 32 + cq * 4 + j] = v; }
            __syncthreads();
            if (tid < 256) { float s = 0.f;
#pragma unroll
                for (int w = 0; w < 32; ++w) s += red[w * 256 + tid];
                const int b = tid >> 5, col = tid & 31; mod[b * 6144 + n0 + col] = s + b_ada[n0 + col]; }
            asm volatile("s_waitcnt vmcnt(0)" ::: "memory");
            __syncthreads();
            if (tid == 0) { __builtin_amdgcn_fence(__ATOMIC_RELEASE, "agent"); asm volatile("s_waitcnt vmcnt(0)" ::: "memory");
                __hip_atomic_fetch_add((unsigned*)(a.ws + WS_CTL) + CW_MODCNT, 1u, __ATOMIC_RELAXED, __HIP_MEMORY_SCOPE_AGENT); }
        }
    }
    if (bid == G - 1) { const float* w_in0 = a.in[5]; float* wif = (float*)(a.ws + WS_WIF);
        for (int i = tid; i < 2048; i += NTHREADS) { const int k = i >> 1, hf = i & 1; *(f32x4*)(wif + k * 8 + 4 * hf) = *(const f32x4*)(w_in0 + (size_t)k * DIN + 3072 + 4 * hf); } }
    LAS float* scr = (LAS float*)(lds + wave * 16384);
    const int gw = bid * NWAVES + wave, NGW = G * NWAVES;
    const float* w_in = a.in[5]; const float* wco = a.in[11]; const float* wmo = a.in[15]; const float* wout = a.in[16];
    bf16* W1T = (bf16*)(a.ws + WS_W1T); bf16* W2T = (bf16*)(a.ws + WS_W2T); bf16* W3T = (bf16*)(a.ws + WS_W3T);
    constexpr int I1 = 16 * 160, I2 = 8 * 32, I3 = 16 * 32, NIT = I1 + 2 * I2 + I3;
    for (int it = gw; it < NIT; it += NGW) {
        int r = it;
        if (r < I1) { const int kb = r / 160, nb = r % 160, np = 32 * nb; int sc;
            if (np < 1024) { const int t = np >> 8, q = np & 255; sc = (q < 128) ? 128 * t + q : 512 + 128 * t + q - 128; } else if (np < 3072) sc = np; else sc = np + 8;
            transpose_item(w_in + (size_t)(64 * kb) * DIN + sc, DIN, W1T + (size_t)np * 1024 + 64 * kb, 1024, scr, lane); continue; }
        r -= I1;
        if (r < I2) { const int kb = r / 32, nb = r % 32; transpose_item(wco + (size_t)(64 * kb) * 1024 + 32 * nb, 1024, W2T + (size_t)(32 * nb) * 1024 + 64 * kb, 1024, scr, lane); continue; }
        r -= I2;
        if (r < I2) { const int kb = r / 32, nb = r % 32; transpose_item(wmo + (size_t)(64 * kb) * 1024 + 32 * nb, 1024, W2T + (size_t)(32 * nb) * 1024 + 512 + 64 * kb, 1024, scr, lane); continue; }
        r -= I2;
        { const int kb = r / 32, nb = r % 32; transpose_item(wout + (size_t)(64 * kb) * 1024 + 32 * nb, 1024, W3T + (size_t)(32 * nb) * 1024 + 64 * kb, 1024, scr, lane); }
    }
    if (G > 192 && bid >= 192) { wait_mod(a, tid); router_prep(a, (bid - 192) * NWAVES + wave, (G - 192) * NWAVES, lane); }
}

DEV void p1_h1(const Args& a, LAS unsigned char* lds, int bid, int G) {
    int tid = threadIdx.x; asm volatile("" : "+v"(tid));
    const int lane = tid & 63, wave = __builtin_amdgcn_readfirstlane(tid >> 6);
    if (tid == 0) {
        unsigned* mc = (unsigned*)(a.ws + WS_CTL) + CW_MODCNT; unsigned sp = 0;
        while (__hip_atomic_load(mc, __ATOMIC_RELAXED, __HIP_MEMORY_SCOPE_AGENT) < 192u) { __builtin_amdgcn_s_sleep(2); if (++sp > (1u << 22)) break; }
        __builtin_amdgcn_fence(__ATOMIC_ACQUIRE, "agent"); asm volatile("s_waitcnt vmcnt(0)" ::: "memory"); }
    __syncthreads();
    const float* x = a.in[0]; const float* g1 = a.in[4]; const float* w_in = a.in[5]; const float* b_if = a.in[6];
    const float* mod = (const float*)(a.ws + WS_MOD); bf16* h1 = (bf16*)(a.ws + WS_H); float* gates = (float*)(a.ws + WS_GATES);
    LAS float* tab = (LAS float*)lds;
    for (int k = tid; k < 1024; k += NTHREADS) { const int p = ((k >> 8) << 2) | (k & 3), l = (k >> 2) & 63;
        const f32x4 w0 = *(const f32x4*)(w_in + (size_t)k * DIN + 3072), w1 = *(const f32x4*)(w_in + (size_t)k * DIN + 3076);
        *(LAS f32x4*)(tab + (p * 64 + l) * 8) = w0; *(LAS f32x4*)(tab + (p * 64 + l) * 8 + 4) = w1; }
    __syncthreads();
    if (G <= 192) router_prep(a, bid * NWAVES + wave, G * NWAVES, lane);
    const float bifv = b_if[lane & 7];
    for (int tile = bid; tile < T / 64; tile += G) {
        const int b = tile / 32;
        float sc[4][4], sh[4][4];
#pragma unroll
        for (int j = 0; j < 4; ++j) { const int k = 256 * j + 4 * lane; const f32x4 gv = *(const f32x4*)(g1 + k), sv = *(const f32x4*)(mod + b * 6144 + 1024 + k), hv = *(const f32x4*)(mod + b * 6144 + k);
#pragma unroll
            for (int i = 0; i < 4; ++i) { sc[j][i] = gv[i] * (1.f + sv[i]); sh[j][i] = hv[i]; } }
        f32x4 xr[2][4];
#pragma unroll
        for (int p = 0; p < 2; ++p)
#pragma unroll
            for (int j = 0; j < 4; ++j) xr[p][j] = *(const f32x4*)(x + ((size_t)tile * 64 + wave + 8 * p) * 1024 + 256 * j + 4 * lane);
#pragma unroll 1
        for (int gq = 0; gq < 4; ++gq) {
            float rstd[2];
#pragma unroll
            for (int p = 0; p < 2; ++p) { float ss = 0.f;
#pragma unroll
                for (int j = 0; j < 4; ++j) { const f32x4 v = xr[p][j]; ss += (v[0] * v[0] + v[1] * v[1]) + (v[2] * v[2] + v[3] * v[3]); }
                rstd[p] = rsqrtf(wave_sum(ss) * (1.f / 1024.f) + RMS_EPS); }
            float g[2][8];
#pragma unroll
            for (int p = 0; p < 2; ++p)
#pragma unroll
                for (int q = 0; q < 8; ++q) g[p][q] = 0.f;
#pragma unroll
            for (int j = 0; j < 4; ++j) {
                float hh[2][4];
#pragma unroll
                for (int p = 0; p < 2; ++p) { const f32x4 v = xr[p][j]; const size_t row = (size_t)tile * 64 + wave + 8 * (2 * gq + p);
#pragma unroll
                    for (int i = 0; i < 4; ++i) hh[p][i] = v[i] * rstd[p] * sc[j][i] + sh[j][i];
                    if (gq < 3) xr[p][j] = *(const f32x4*)(x + (row + 16) * 1024 + 256 * j + 4 * lane);
                    v2u o; o.x = pk2(hh[p][0], hh[p][1]); o.y = pk2(hh[p][2], hh[p][3]);
                    *(v2u*)(h1 + row * 1024 + 256 * j + 4 * lane) = o; }
#pragma unroll
                for (int i = 0; i < 4; ++i) { const LAS float* tp = tab + ((4 * j + i) * 64 + lane) * 8; const f32x4 w0 = *(const LAS f32x4*)tp, w1 = *(const LAS f32x4*)(tp + 4);
#pragma unroll
                    for (int p = 0; p < 2; ++p) { const float hv = hh[p][i];
                        g[p][0] += hv * w0[0]; g[p][1] += hv * w0[1]; g[p][2] += hv * w0[2]; g[p][3] += hv * w0[3]; g[p][4] += hv * w1[0]; g[p][5] += hv * w1[1]; g[p][6] += hv * w1[2]; g[p][7] += hv * w1[3]; } }
                asm volatile("" ::: "memory");
            }
#pragma unroll
            for (int p = 0; p < 2; ++p) { const size_t row = (size_t)tile * 64 + wave + 8 * (2 * gq + p); float mine = 0.f;
#pragma unroll
                for (int q = 0; q < 8; ++q) { const float sq = wave_sum(g[p][q]); mine = (lane == q) ? sq : mine; }
                if (lane < 8) { const float vv = mine + bifv; gates[row * 8 + lane] = (lane < 4) ? vv : logsigmoidf_(vv); } }
        }
    }
}

DEV void p1_h1_mfma(const Args& a, LAS unsigned char* lds, int bid, int G) {
    int tid = threadIdx.x; asm volatile("" : "+v"(tid));
    const int lane = tid & 63, wave = __builtin_amdgcn_readfirstlane(tid >> 6), l15 = lane & 15, q4 = lane >> 4;
    if (tid == 0) {
        unsigned* mc = (unsigned*)(a.ws + WS_CTL) + CW_MODCNT; unsigned sp = 0;
        while (__hip_atomic_load(mc, __ATOMIC_RELAXED, __HIP_MEMORY_SCOPE_AGENT) < 192u) { __builtin_amdgcn_s_sleep(2); if (++sp > (1u << 22)) break; }
        __builtin_amdgcn_fence(__ATOMIC_ACQUIRE, "agent"); asm volatile("s_waitcnt vmcnt(0)" ::: "memory"); }
    __syncthreads();
    const float* x = a.in[0]; const float* g1 = a.in[4]; const float* b_if = a.in[6];
    const float* mod = (const float*)(a.ws + WS_MOD); bf16* h1 = (bf16*)(a.ws + WS_H); float* gates = (float*)(a.ws + WS_GATES);
    LAS float* PL = (LAS float*)lds;
    LAS float* SS = (LAS float*)(lds + 32768);
    LAS float* RS = (LAS float*)(lds + 34816);
    LAS float* GB = (LAS float*)(lds + 35072);
    LAS float* WF = (LAS float*)(lds + 36864);
    { const float* wif = (const float*)(a.ws + WS_WIF); for (int i = tid; i < 2048; i += NTHREADS) *(LAS f32x4*)(WF + 4 * i) = *(const f32x4*)(wif + 4 * i); }
    {
        const float* g2 = a.in[17]; const float* w_rg = a.in[18]; const float* b_rg = a.in[19]; const float* w_re = a.in[20]; const float* b_re = a.in[21];
        float* rbias = (float*)(a.ws + WS_RBIAS); v4u* rw = (v4u*)(a.ws + WS_RW);
        const int gw = bid * NWAVES + wave, NGW = G * NWAVES;
        for (int it = gw; it < 8 * 36; it += NGW) { const int b = it / 36, n = it % 36; float sacc = 0.f;
#pragma unroll
            for (int i = 0; i < 16; ++i) { const int k = lane + 64 * i; const float w = (n < 4) ? w_rg[k * 4 + n] : w_re[k * 32 + n - 4]; sacc += mod[b * 6144 + 3072 + k] * w; }
            sacc = wave_sum(sacc);
            if (lane == 0) rbias[b * 48 + n] = sacc + ((n < 4) ? b_rg[n] : b_re[n - 4]); }
        for (int it = gw; it < 8 * 8 * 4 * 3; it += NGW) {
            const int nt = it % 3, kk = (it / 3) & 3, w8 = (it / 12) & 7, b = it / 96;
            const int n = 16 * nt + (lane & 15), k0 = 128 * w8 + 32 * kk + 8 * (lane >> 4);
            f32x4 w0, w1;
#pragma unroll
            for (int j = 0; j < 8; ++j) { const int k = k0 + j; const float* wp = (n < 4) ? (w_rg + k * 4 + n) : (w_re + k * 32 + ((n < 36) ? n - 4 : 0));
                float w = *wp; w = (n < 36) ? w : 0.f;
                w *= g2[k] * (1.f + mod[b * 6144 + 4096 + k]); if (j < 4) w0[j] = w; else w1[j - 4] = w; }
            bf16x8 hi, lo; split8(w0, w1, hi, lo);
            rw[((size_t)it * 2) * 64 + lane] = __builtin_bit_cast(v4u, hi); rw[((size_t)it * 2 + 1) * 64 + lane] = __builtin_bit_cast(v4u, lo);
        }
    }
    for (int tile = bid; tile < T / 64; tile += G) {
        const int b = tile / 32, ncol = (l15 < 8) ? l15 : 0;
        __syncthreads();
        {
            float sacc = 0.f;
#pragma unroll
            for (int i = 0; i < 16; ++i) { const int k = lane + 64 * i; sacc += mod[b * 6144 + k] * WF[k * 8 + wave]; }
            sacc = wave_sum(sacc);
            if (lane == 0) GB[wave] = sacc + b_if[wave];
        }
        f32x4 acc[4]; float ss[4];
#pragma unroll
        for (int rt = 0; rt < 4; ++rt) { ss[rt] = 0.f; acc[rt] = (f32x4){0.f, 0.f, 0.f, 0.f}; }
#pragma unroll
        for (int kk = 0; kk < 4; ++kk) {
            const int k0 = 128 * wave + 32 * kk + 8 * q4;
            bf16x8 bhi, blo;
            { const f32x4 ga = *(const f32x4*)(g1 + k0), gb = *(const f32x4*)(g1 + k0 + 4), sa = *(const f32x4*)(mod + b * 6144 + 1024 + k0), sb = *(const f32x4*)(mod + b * 6144 + 1024 + k0 + 4);
                f32x4 w0, w1;
#pragma unroll
                for (int jj = 0; jj < 4; ++jj) { float wa = WF[(k0 + jj) * 8 + ncol], wb = WF[(k0 + 4 + jj) * 8 + ncol];
                    wa = (l15 < 8) ? wa : 0.f; wb = (l15 < 8) ? wb : 0.f; w0[jj] = wa * ga[jj] * (1.f + sa[jj]); w1[jj] = wb * gb[jj] * (1.f + sb[jj]); }
                split8(w0, w1, bhi, blo); }
#pragma unroll
            for (int rt = 0; rt < 4; ++rt) {
                const float* xp = x + ((size_t)tile * 64 + 16 * rt + l15) * 1024 + k0;
                const f32x4 xa = *(const f32x4*)xp, xb = *(const f32x4*)(xp + 4);
                ss[rt] += (xa[0] * xa[0] + xa[1] * xa[1]) + (xa[2] * xa[2] + xa[3] * xa[3]) + (xb[0] * xb[0] + xb[1] * xb[1]) + (xb[2] * xb[2] + xb[3] * xb[3]);
                bf16x8 ahi, alo; split8(xa, xb, ahi, alo);
                acc[rt] = mma16(ahi, bhi, acc[rt]); acc[rt] = mma16(alo, bhi, acc[rt]); acc[rt] = mma16(ahi, blo, acc[rt]);
            }
        }
#pragma unroll
        for (int rt = 0; rt < 4; ++rt) {
            float sv = ss[rt]; sv += __shfl_xor(sv, 16); sv += __shfl_xor(sv, 32);
            if (q4 == 0) SS[wave * 64 + 16 * rt + l15] = sv;
#pragma unroll
            for (int r = 0; r < 4; ++r) PL[(wave * 64 + 16 * rt + 4 * q4 + r) * 16 + l15] = acc[rt][r];
        }
        __syncthreads();
        {
            const int row = tid >> 3, n = tid & 7; float ssum = 0.f, sg = 0.f;
#pragma unroll
            for (int w = 0; w < 8; ++w) { ssum += SS[w * 64 + row]; sg += PL[(w * 64 + row) * 16 + n]; }
            const float rstd = rsqrtf(ssum * (1.f / 1024.f) + RMS_EPS);
            if (n == 0) RS[row] = rstd;
            const float vv = rstd * sg + GB[n];
            gates[((size_t)tile * 64 + row) * 8 + n] = (n < 4) ? vv : logsigmoidf_(vv);
        }
        __syncthreads();
        {
            float sc[4][4], sh[4][4];
#pragma unroll
            for (int j = 0; j < 4; ++j) { const int k = 256 * j + 4 * lane; const f32x4 gv = *(const f32x4*)(g1 + k), sv = *(const f32x4*)(mod + b * 6144 + 1024 + k), hv = *(const f32x4*)(mod + b * 6144 + k);
#pragma unroll
                for (int i = 0; i < 4; ++i) { sc[j][i] = gv[i] * (1.f + sv[i]); sh[j][i] = hv[i]; } }
            f32x4 nx[4][4];
#pragma unroll
            for (int p = 0; p < 4; ++p)
#pragma unroll
                for (int j = 0; j < 4; ++j) nx[p][j] = *(const f32x4*)(x + ((size_t)tile * 64 + wave + 8 * p) * 1024 + 256 * j + 4 * lane);
#pragma unroll
            for (int r8 = 0; r8 < 8; ++r8) {
                const int r = wave + 8 * r8; const size_t row = (size_t)tile * 64 + r;
                f32x4 v[4];
#pragma unroll
                for (int j = 0; j < 4; ++j) v[j] = nx[r8 & 3][j];
                if (r8 + 4 < 8) {
#pragma unroll
                    for (int j = 0; j < 4; ++j) nx[r8 & 3][j] = *(const f32x4*)(x + (row + 32) * 1024 + 256 * j + 4 * lane); }
                asm volatile("" ::: "memory");
                const float rstd = RS[r];
#pragma unroll
                for (int j = 0; j < 4; ++j) { v2u o; o.x = pk2(v[j][0] * rstd * sc[j][0] + sh[j][0], v[j][1] * rstd * sc[j][1] + sh[j][1]); o.y = pk2(v[j][2] * rstd * sc[j][2] + sh[j][2], v[j][3] * rstd * sc[j][3] + sh[j][3]);
                    *(v2u*)(h1 + row * 1024 + 256 * j + 4 * lane) = o; }
            }
        }
    }
    __syncthreads();
}

DEV void p3_conva(const Args& a, LAS unsigned char* lds, int bid, int G) {
    int tid = threadIdx.x; asm volatile("" : "+v"(tid));
    const int lane = tid & 63, wave = __builtin_amdgcn_readfirstlane(tid >> 6), sub = wave & 3, gsel = wave >> 2;
    const bf16* zu = (const bf16*)(a.ws + WS_ZU); bf16* uahm = (bf16*)(a.ws + WS_UAHM);
    const float* cw = a.in[7]; const float* cb = a.in[8]; const float* lg = a.in[9]; const float* lb = a.in[10];
    LAS float* red = (LAS float*)(lds + LDS_TAB);
    const int c0 = 128 * sub + 2 * lane;
    float w0[31], w1[31];
#pragma unroll
    for (int k = 0; k < 31; ++k) { w0[k] = cw[k * 512 + c0]; w1[k] = cw[k * 512 + c0 + 1]; }
    const float bias0 = cb[c0], bias1 = cb[c0 + 1], lg0 = lg[c0], lg1 = lg[c0 + 1], lb0 = lb[c0], lb1 = lb[c0 + 1];
    for (int it = bid; it < T / 32; it += G) {
        const int grp = it * 2 + gsel, tbase = grp * 16, s0 = tbase & (SEQ - 1);
        float acc0[16], acc1[16];
#pragma unroll
        for (int i = 0; i < 16; ++i) { acc0[i] = bias0; acc1[i] = bias1; }
#pragma unroll
        for (int r = 0; r < 46; ++r) {
            const int sp = s0 - 30 + r; const int src = tbase - 30 + r + ((sp < 0) ? -sp : 0); const float msk = (sp < 0) ? 0.f : 1.f;
            const unsigned wv = *(const unsigned*)(zu + (size_t)src * 512 + c0);
            const float u0 = bflo(wv) * msk, u1 = bfhi(wv) * msk;
#pragma unroll
            for (int i = 0; i < 16; ++i) { const int k = r - i; if (k >= 0 && k <= 30) { acc0[i] += w0[k] * u0; acc1[i] += w1[k] * u1; } }
        }
        float mean[16];
#pragma unroll
        for (int i = 0; i < 16; ++i) { const float s = wave_sum(acc0[i] + acc1[i]); if (lane == 0) red[(gsel * 4 + sub) * 16 + i] = s; }
        __syncthreads();
#pragma unroll
        for (int i = 0; i < 16; ++i) mean[i] = ((red[(gsel * 4 + 0) * 16 + i] + red[(gsel * 4 + 1) * 16 + i]) + (red[(gsel * 4 + 2) * 16 + i] + red[(gsel * 4 + 3) * 16 + i])) * (1.f / 512.f);
        __syncthreads();
#pragma unroll
        for (int i = 0; i < 16; ++i) { const float d0 = acc0[i] - mean[i], d1 = acc1[i] - mean[i]; const float s = wave_sum(d0 * d0 + d1 * d1); if (lane == 0) red[(gsel * 4 + sub) * 16 + i] = s; }
        __syncthreads();
#pragma unroll
        for (int i = 0; i < 16; ++i) {
            const float var = ((red[(gsel * 4 + 0) * 16 + i] + red[(gsel * 4 + 1) * 16 + i]) + (red[(gsel * 4 + 2) * 16 + i] + red[(gsel * 4 + 3) * 16 + i])) * (1.f / 512.f);
            const float rstd = rsqrtf(var + LN_EPS);
            const float y0 = (acc0[i] - mean[i]) * rstd * lg0 + lb0, y1 = (acc1[i] - mean[i]) * rstd * lg1 + lb1;
            *(unsigned*)(uahm + (size_t)(tbase + i) * 1024 + c0) = pk2(siluf_(y0), siluf_(y1));
        }
        __syncthreads();
    }
}

constexpr int ML_QS = 0, ML_KS = 17408, ML_KWT = 34816, ML_VT = 53248, ML_PS = 73984, ML_CT = 83200, ML_GT = 122368, ML_CW = 123648, ML_DEN = 128768, ML_PART = 129024, ML_VS = 130048;
template <bool OUT>
DEV void mlstm_unit(const Args& a, LAS unsigned char* lds, int unit) {
    int tid = threadIdx.x; asm volatile("" : "+v"(tid));
    const int lane = tid & 63, wave = __builtin_amdgcn_readfirstlane(tid >> 6), l15 = lane & 15, q4 = lane >> 4;
    const int j = unit & 7, bh = unit >> 3, h = bh & 3, b = bh >> 2, t0 = b * SEQ + 256 * j;
    const bf16* zq = (const bf16*)(a.ws + WS_ZQ); const bf16* zk = (const bf16*)(a.ws + WS_ZK); const bf16* zv = (const bf16*)(a.ws + WS_ZV); const bf16* zo = (const bf16*)(a.ws + WS_ZO);
    const float* gates = (const float*)(a.ws + WS_GATES); v2u* stateh = (v2u*)(a.ws + WS_STATE); float* stsc = (float*)(a.ws + WS_STSC);
    bf16* uahm = (bf16*)(a.ws + WS_UAHM); const float* qkw = a.in[12]; const float* qkb = a.in[13]; const float* mng = a.in[14];
    LAS bf16* QS = (LAS bf16*)(lds + ML_QS); LAS bf16* KS = (LAS bf16*)(lds + ML_KS); LAS bf16* KWT = (LAS bf16*)(lds + ML_KWT); LAS bf16* VT = (LAS bf16*)(lds + ML_VT);
    LAS bf16* PS = (LAS bf16*)(lds + ML_PS); LAS bf16* CT = (LAS bf16*)(lds + ML_CT); LAS bf16* VS = (LAS bf16*)(lds + ML_VS);
    LAS float* GTwk = (LAS float*)(lds + ML_GT); LAS float* GTsi = GTwk + 64; LAS float* GTlb = GTwk + 128; LAS float* GTg = GTwk + 192; LAS float* GTM = GTwk + 256;
    LAS float* CW = (LAS float*)(lds + ML_CW); LAS float* DEN = (LAS float*)(lds + ML_DEN); LAS float* PART = (LAS float*)(lds + ML_PART);
    __syncthreads();
    for (int i = tid; i < 1280; i += NTHREADS) {
        const float* p = (i < 512) ? (qkw + (i >> 7) * 1024 + h * 128 + (i & 127)) : (i < 1024) ? (qkw + ((i - 512) >> 7) * 1024 + 512 + h * 128 + (i & 127))
                       : (i < 1152) ? (qkb + h * 128 + (i - 1024)) : (qkb + 512 + h * 128 + (i - 1152));
        CW[i] = *p; }
    for (int i = tid; i < 16 * 72; i += NTHREADS) VT[128 * 72 + i] = (i < 64) ? (bf16)0x3F80 : (bf16)0;
    f32x4 accC[9];
#pragma unroll
    for (int i = 0; i < 9; ++i) accC[i] = (f32x4){0.f, 0.f, 0.f, 0.f};
    float mc = OUT ? 0.f : -1e30f, Btot = 0.f;
    if (OUT) {
        float wgt[7];
        {
            const int base = unit - j; float mi[7], Bi[7];
#pragma unroll
            for (int i = 0; i < 7; ++i) { const int u2 = base + ((i < j) ? i : 0); mi[i] = stsc[u2 * 4]; Bi[i] = stsc[u2 * 4 + 1]; }
#pragma unroll
            for (int i = 0; i < 7; ++i) if (i < j) mc = fmaxf(Bi[i] + mc, mi[i]);
            float suf = 0.f;
#pragma unroll
            for (int i = 6; i >= 0; --i) { wgt[i] = (i < j) ? __expf(mi[i] + suf - mc) : 0.f; if (i < j) suf += Bi[i]; }
        }
#pragma unroll
        for (int ii = 0; ii < 9; ++ii) {
            v2u ld[7];
#pragma unroll
            for (int i = 0; i < 7; ++i) { ld[i] = (v2u){0u, 0u}; if (i < j) ld[i] = stateh[((size_t)(unit - j + i) * 9 + ii) * 512 + tid]; }
#pragma unroll
            for (int i = 0; i < 7; ++i) { const f32x4 v = (f32x4){bflo(ld[i].x), bfhi(ld[i].x), bflo(ld[i].y), bfhi(ld[i].y)}; accC[ii] = accC[ii] + v * wgt[i]; }
        }
#pragma unroll
        for (int ii = 0; ii < 9; ++ii)
#pragma unroll
            for (int r = 0; r < 4; ++r) CT[(16 * ii + 4 * q4 + r) * 136 + 16 * wave + l15] = f2bf(accC[ii][r]);
    }
    __syncthreads();
    float li_n = gates[(size_t)(t0 + lane) * 8 + h], lf_n = gates[(size_t)(t0 + lane) * 8 + 4 + h];
    const int ncc = (OUT && (a.flags & 4096)) ? 1 : 4; const bool skipAB = OUT && (a.flags & 16384), skipQ = OUT && (a.flags & 32768);
    for (int cc = 0; cc < ncc; ++cc) {
        const int tc = t0 + 64 * cc;
        const float li = li_n, lf = lf_n;
        if (cc < 3) { li_n = gates[(size_t)(tc + 64 + lane) * 8 + h]; lf_n = gates[(size_t)(tc + 64 + lane) * 8 + 4 + h]; }
        const float bc = wave_scan_add(lf, lane);
        const float g = li - bc;
        const float cm = wave_scan_max(g, lane);
        const float M = fmaxf(mc, cm);
        const float M63 = rdlane(M, 63), blast = rdlane(bc, 63);
        const float wkv = __expf(g - M63), sc = __expf(mc - M63), mnew = blast + M63;
        if (wave == 0) { GTwk[lane] = wkv; GTsi[lane] = __expf(mc - M); GTlb[lane] = __expf(-(bc + M)); GTg[lane] = g; GTM[lane] = M; }
        {
            const int cg = tid & 15, rp = tid >> 4, s0 = 2 * rp;
            v4u kraw[5], qraw[5], vraw[2];
#pragma unroll
            for (int m = 0; m < 5; ++m) { const int spos = 256 * j + 64 * cc + s0 - 3 + m; const bool ok = spos >= 0; const int src = ok ? (tc + s0 - 3 + m) : tc;
                kraw[m] = *(const v4u*)(zk + (size_t)src * 512 + h * 128 + cg * 8); }
#pragma unroll
            for (int rr = 0; rr < 2; ++rr) vraw[rr] = *(const v4u*)(zv + (size_t)(tc + s0 + rr) * 512 + h * 128 + cg * 8);
#define ML_CONV(RAW, WOFF, BOFF, DST, SCALE) do { float ac[2][8]; \
            _Pragma("unroll") for (int e = 0; e < 8; ++e) { ac[0][e] = ac[1][e] = CW[(BOFF) + cg * 8 + e]; } \
            _Pragma("unroll") for (int m = 0; m < 5; ++m) { v4u rw_ = RAW[m]; if (256 * j + 64 * cc + s0 - 3 + m < 0) rw_ = (v4u){0u, 0u, 0u, 0u};     \
                const float xv[8] = {bflo(rw_.x), bfhi(rw_.x), bflo(rw_.y), bfhi(rw_.y), bflo(rw_.z), bfhi(rw_.z), bflo(rw_.w), bfhi(rw_.w)}; \
                _Pragma("unroll") for (int rr = 0; rr < 2; ++rr) { const int tap = m - rr; if (tap >= 0 && tap < 4) { \
                    _Pragma("unroll") for (int e = 0; e < 8; ++e) ac[rr][e] += CW[(WOFF) + tap * 128 + cg * 8 + e] * xv[e]; } } } \
            _Pragma("unroll") for (int rr = 0; rr < 2; ++rr) { v4u o; \
                o.x = pk2(siluf_(ac[rr][0]) * (SCALE), siluf_(ac[rr][1]) * (SCALE)); o.y = pk2(siluf_(ac[rr][2]) * (SCALE), siluf_(ac[rr][3]) * (SCALE)); \
                o.z = pk2(siluf_(ac[rr][4]) * (SCALE), siluf_(ac[rr][5]) * (SCALE)); o.w = pk2(siluf_(ac[rr][6]) * (SCALE), siluf_(ac[rr][7]) * (SCALE)); \
                *(LAS v4u*)((DST) + (s0 + rr) * 136 + cg * 8) = o; } } while (0)
            if (OUT && !skipQ) {
#pragma unroll
                for (int m = 0; m < 5; ++m) { const int spos = 256 * j + 64 * cc + s0 - 3 + m; const int src = (spos >= 0) ? (tc + s0 - 3 + m) : tc; qraw[m] = *(const v4u*)(zq + (size_t)src * 512 + h * 128 + cg * 8); } }
            ML_CONV(kraw, 512, 1152, KS, 1.f);
            asm volatile("" ::: "memory");
            if (OUT && !skipQ) ML_CONV(qraw, 0, 1024, QS, 0.08838834764831845f);
#undef ML_CONV
#pragma unroll
            for (int rr = 0; rr < 2; ++rr) *(LAS v4u*)(VS + (s0 + rr) * 136 + cg * 8) = vraw[rr];
        }
        __syncthreads();
        if (OUT && !skipAB) {
            const int tt = wave >> 1;
#pragma unroll
            for (int si = 0; si < 2; ++si) {
                const int st = 2 * (wave & 1) + si;
                f32x4 sacc = (f32x4){0.f, 0.f, 0.f, 0.f};
                if (st <= tt) {
#pragma unroll
                    for (int kk = 0; kk < 4; ++kk) sacc = mma16(*(const LAS bf16x8*)(QS + (16 * tt + l15) * 136 + 32 * kk + 8 * q4), *(const LAS bf16x8*)(KS + (16 * st + l15) * 136 + 32 * kk + 8 * q4), sacc);
                }
                const int sl = 16 * st + l15; const float gs = GTg[sl];
#pragma unroll
                for (int r = 0; r < 4; ++r) { const int tl = 16 * tt + 4 * q4 + r; const float w = (sl <= tl) ? __expf(gs - GTM[tl]) : 0.f; PS[tl * 72 + sl] = f2bf(sacc[r] * w); }
            }
        }
        {
            const int d = tid & 127, sg = tid >> 7; float kv[16];
#pragma unroll
            for (int i = 0; i < 16; ++i) kv[i] = bf2f(KS[(16 * sg + i) * 136 + d]) * GTwk[16 * sg + i];
            v4u o0, o1;
            o0.x = pk2(kv[0], kv[1]); o0.y = pk2(kv[2], kv[3]); o0.z = pk2(kv[4], kv[5]); o0.w = pk2(kv[6], kv[7]);
            o1.x = pk2(kv[8], kv[9]); o1.y = pk2(kv[10], kv[11]); o1.z = pk2(kv[12], kv[13]); o1.w = pk2(kv[14], kv[15]);
            *(LAS v4u*)(KWT + d * 72 + 16 * sg) = o0; *(LAS v4u*)(KWT + d * 72 + 16 * sg + 8) = o1;
            unsigned vw[8];
#pragma unroll
            for (int i = 0; i < 8; ++i) vw[i] = (unsigned)VS[(16 * sg + 2 * i) * 136 + d] | ((unsigned)VS[(16 * sg + 2 * i + 1) * 136 + d] << 16);
            o0.x = vw[0]; o0.y = vw[1]; o0.z = vw[2]; o0.w = vw[3]; o1.x = vw[4]; o1.y = vw[5]; o1.z = vw[6]; o1.w = vw[7];
            *(LAS v4u*)(VT + d * 72 + 16 * sg) = o0; *(LAS v4u*)(VT + d * 72 + 16 * sg + 8) = o1;
        }
        __syncthreads();
        f32x4 res[5];
        if (OUT && !skipAB) {
            const int tt = wave >> 1, dv0 = 4 * (wave & 1);
            bf16x8 pa[2], qa[4];
#pragma unroll
            for (int kk = 0; kk < 2; ++kk) pa[kk] = *(const LAS bf16x8*)(PS + (16 * tt + l15) * 72 + 32 * kk + 8 * q4);
#pragma unroll
            for (int kk = 0; kk < 4; ++kk) qa[kk] = *(const LAS bf16x8*)(QS + (16 * tt + l15) * 136 + 32 * kk + 8 * q4);
            float si[4];
#pragma unroll
            for (int r = 0; r < 4; ++r) si[r] = GTsi[16 * tt + 4 * q4 + r];
#pragma unroll
            for (int i = 0; i < 5; ++i) {
                const int dvt = (i < 4) ? (dv0 + i) : 8;
                if (i < 4 || (wave & 1) == 0) {
                    f32x4 a1 = (f32x4){0.f, 0.f, 0.f, 0.f}, a2 = (f32x4){0.f, 0.f, 0.f, 0.f};
#pragma unroll
                    for (int kk = 0; kk < 2; ++kk) a1 = mma16(pa[kk], *(const LAS bf16x8*)(VT + (16 * dvt + l15) * 72 + 32 * kk + 8 * q4), a1);
#pragma unroll
                    for (int kk = 0; kk < 4; ++kk) a2 = mma16(qa[kk], *(const LAS bf16x8*)(CT + (16 * dvt + l15) * 136 + 32 * kk + 8 * q4), a2);
#pragma unroll
                    for (int r = 0; r < 4; ++r) res[i][r] = a1[r] + si[r] * a2[r];
                } else res[i] = (f32x4){0.f, 0.f, 0.f, 0.f};
            }
            if ((wave & 1) == 0 && l15 == 0) {
#pragma unroll
                for (int r = 0; r < 4; ++r) DEN[16 * tt + 4 * q4 + r] = res[4][r];
            }
        }
        asm volatile("" ::: "memory");
        {
            bf16x8 kb[2];
#pragma unroll
            for (int kk = 0; kk < 2; ++kk) kb[kk] = *(const LAS bf16x8*)(KWT + (16 * wave + l15) * 72 + 32 * kk + 8 * q4);
#pragma unroll
            for (int i = 0; i < 9; ++i) { accC[i] = accC[i] * sc;
#pragma unroll
                for (int kk = 0; kk < 2; ++kk) accC[i] = mma16(*(const LAS bf16x8*)(VT + (16 * i + l15) * 72 + 32 * kk + 8 * q4), kb[kk], accC[i]); }
        }
        __syncthreads();
        if (OUT && !skipAB) {
            const int tt = wave >> 1;
            float den[4], lbv[4];
#pragma unroll
            for (int r = 0; r < 4; ++r) { den[r] = DEN[16 * tt + 4 * q4 + r]; lbv[r] = GTlb[16 * tt + 4 * q4 + r]; }
#pragma unroll
            for (int r = 0; r < 4; ++r) { const float inv = 1.f / fmaxf(fabsf(den[r]), lbv[r]); float s1 = 0.f, s2 = 0.f;
#pragma unroll
                for (int i = 0; i < 4; ++i) { res[i][r] *= inv; s1 += res[i][r]; s2 += res[i][r] * res[i][r]; }
                s1 = row16_sum(s1); s2 = row16_sum(s2);
                if (l15 == 0) { PART[((16 * tt + 4 * q4 + r) * 2 + (wave & 1)) * 2] = s1; PART[((16 * tt + 4 * q4 + r) * 2 + (wave & 1)) * 2 + 1] = s2; } }
#pragma unroll
            for (int ii = 0; ii < 9; ++ii)
#pragma unroll
                for (int r = 0; r < 4; ++r) CT[(16 * ii + 4 * q4 + r) * 136 + 16 * wave + l15] = f2bf(accC[ii][r]);
            __syncthreads();
            const int os = tid >> 3, ocg = tid & 7; const size_t orow = (size_t)(tc + os);
            const v4u zo0 = *(const v4u*)(zo + orow * 512 + h * 128 + 16 * ocg), zo1 = *(const v4u*)(zo + orow * 512 + h * 128 + 16 * ocg + 8);
            LAS float* YS = (LAS float*)(lds + ML_KWT);
#pragma unroll
            for (int r = 0; r < 4; ++r) { const int tl = 16 * tt + 4 * q4 + r;
                const float s1 = PART[(tl * 2) * 2] + PART[(tl * 2 + 1) * 2], s2 = PART[(tl * 2) * 2 + 1] + PART[(tl * 2 + 1) * 2 + 1];
                const float mean = s1 * (1.f / 128.f), var = fmaxf(s2 * (1.f / 128.f) - mean * mean, 0.f), rstd = rsqrtf(var + LN_EPS);
#pragma unroll
                for (int i = 0; i < 4; ++i) YS[tl * 132 + 16 * (4 * (wave & 1) + i) + l15] = (res[i][r] - mean) * rstd; }
            __syncthreads();
            {
                f32x4 yv[4];
#pragma unroll
                for (int q = 0; q < 4; ++q) yv[q] = *(const LAS f32x4*)(YS + os * 132 + 16 * ocg + 4 * q);
                f32x4 g0, g1, g2, g3; unpack8(zo0, g0, g1); unpack8(zo1, g2, g3);
                { const float* mp = mng + h * 128 + 16 * ocg; g0 = g0 * *(const f32x4*)mp; g1 = g1 * *(const f32x4*)(mp + 4); g2 = g2 * *(const f32x4*)(mp + 8); g3 = g3 * *(const f32x4*)(mp + 12); }
                *(v4u*)(uahm + orow * 1024 + 512 + h * 128 + 16 * ocg) = pack8(yv[0] * g0, yv[1] * g1);
                *(v4u*)(uahm + orow * 1024 + 512 + h * 128 + 16 * ocg + 8) = pack8(yv[2] * g2, yv[3] * g3);
            }
        }
        mc = mnew; Btot += blast;
    }
    if (!OUT) {
#pragma unroll
        for (int ii = 0; ii < 9; ++ii) { v2u pk; pk.x = pk2(accC[ii][0], accC[ii][1]); pk.y = pk2(accC[ii][2], accC[ii][3]); stateh[((size_t)unit * 9 + ii) * 512 + tid] = pk; }
        if (tid == 0) { stsc[unit * 4] = mc; stsc[unit * 4 + 1] = Btot; }
    }
}

DEV void p8_route(const Args& a, LAS unsigned char* lds, int bid, int G) {
    int tid = threadIdx.x; asm volatile("" : "+v"(tid));
    const int lane = tid & 63, wave = __builtin_amdgcn_readfirstlane(tid >> 6), l15 = lane & 15, q4 = lane >> 4;
    const float* x1 = a.out; const float* g2 = a.in[17]; const float* w_rg = a.in[18]; const float* w_re = a.in[20];
    const float* mod = (const float*)(a.ws + WS_MOD); const float* rbias = (const float*)(a.ws + WS_RBIAS); const v4u* rw = (const v4u*)(a.ws + WS_RW); bf16* h2 = (bf16*)(a.ws + WS_H);
    int* toke = (int*)(a.ws + WS_TOKE); float* tokw = (float*)(a.ws + WS_TOKW);
    int* listt = (int*)(a.ws + WS_LISTT); float* listw = (float*)(a.ws + WS_LISTW); unsigned* cnt = (unsigned*)(a.ws + WS_CTL) + CW_CNT;
    LAS float* PL = (LAS float*)lds;
    LAS float* SS = (LAS float*)(lds + 98304);
    LAS float* LG = (LAS float*)(lds + 100352);
    LAS float* RS = (LAS float*)(lds + 109568);
    LAS unsigned* lcnt = (LAS unsigned*)(lds + LDS_MISC + 256);
    LAS unsigned* lbase = lcnt + 32;
    LAS unsigned* lent = lcnt + 64;
    LAS float* lwt = (LAS float*)(lcnt + 192);
    for (int tile = bid; tile < T / 64; tile += G) {
        const int b = tile / 32;
        __syncthreads();
        if (tid < 32) lcnt[tid] = 0u;
        f32x4 acc[4][3]; float ss[4];
#pragma unroll
        for (int rt = 0; rt < 4; ++rt) { ss[rt] = 0.f;
#pragma unroll
            for (int nt = 0; nt < 3; ++nt) acc[rt][nt] = (f32x4){0.f, 0.f, 0.f, 0.f}; }
#pragma unroll 1
        for (int kk = 0; kk < 4; ++kk) {
            const int k0 = 128 * wave + 32 * kk + 8 * q4;
            bf16x8 bhi[3], blo[3];
#pragma unroll
            for (int nt = 0; nt < 3; ++nt) { const size_t it = ((size_t)(b * 8 + wave) * 4 + kk) * 3 + nt;
                bhi[nt] = __builtin_bit_cast(bf16x8, rw[(it * 2) * 64 + lane]); blo[nt] = __builtin_bit_cast(bf16x8, rw[(it * 2 + 1) * 64 + lane]); }
#pragma unroll
            for (int rt = 0; rt < 4; ++rt) {
                const float* xp = x1 + ((size_t)tile * 64 + 16 * rt + l15) * 1024 + k0;
                const f32x4 xa = *(const f32x4*)xp, xb = *(const f32x4*)(xp + 4);
                ss[rt] += (xa[0] * xa[0] + xa[1] * xa[1]) + (xa[2] * xa[2] + xa[3] * xa[3]) + (xb[0] * xb[0] + xb[1] * xb[1]) + (xb[2] * xb[2] + xb[3] * xb[3]);
                bf16x8 ahi, alo; split8(xa, xb, ahi, alo);
#pragma unroll
                for (int nt = 0; nt < 3; ++nt) { acc[rt][nt] = mma16(ahi, bhi[nt], acc[rt][nt]); acc[rt][nt] = mma16(alo, bhi[nt], acc[rt][nt]); acc[rt][nt] = mma16(ahi, blo[nt], acc[rt][nt]); }
            }
        }
#pragma unroll
        for (int rt = 0; rt < 4; ++rt) {
            float sv = ss[rt]; sv += __shfl_xor(sv, 16); sv += __shfl_xor(sv, 32);
            if (q4 == 0) SS[wave * 64 + 16 * rt + l15] = sv;
#pragma unroll
            for (int nt = 0; nt < 3; ++nt)
#pragma unroll
                for (int r = 0; r < 4; ++r) PL[(wave * 64 + 16 * rt + 4 * q4 + r) * 48 + 16 * nt + l15] = acc[rt][nt][r];
        }
        __syncthreads();
        {
            const int row = tid >> 3, part = tid & 7;
            float ssum = 0.f;
#pragma unroll
            for (int w = 0; w < 8; ++w) ssum += SS[w * 64 + row];
            const float rstd = rsqrtf(ssum * (1.f / 1024.f) + RMS_EPS);
            if (part == 0) RS[row] = rstd;
#pragma unroll
            for (int i = 0; i < 5; ++i) { const int n = part + 8 * i; if (n < 36) { float s = 0.f;
#pragma unroll
                    for (int w = 0; w < 8; ++w) s += PL[(w * 64 + row) * 48 + n];
                    LG[row * 36 + n] = rstd * s + rbias[b * 48 + n]; } }
        }
        __syncthreads();
        if (tid < 64) {
            const int r = tid; const size_t row = (size_t)tile * 64 + r;
            float lg[36];
#pragma unroll
            for (int q = 0; q < 36; ++q) lg[q] = LG[r * 36 + q];
            int gs = 0; float gm = lg[0];
#pragma unroll
            for (int q = 1; q < 4; ++q) if (lg[q] > gm) { gm = lg[q]; gs = q; }
            float se = 0.f;
#pragma unroll
            for (int q = 0; q < 4; ++q) se += __expf(lg[q] - gm);
            const float pg = 1.f / se;
            float le[8];
#pragma unroll
            for (int q = 0; q < 8; ++q) { float vsel = lg[4 + q];
#pragma unroll
                for (int gg = 1; gg < 4; ++gg) vsel = (gs == gg) ? lg[4 + 8 * gg + q] : vsel;
                le[q] = vsel; }
            int e0 = 0; float l0 = le[0];
#pragma unroll
            for (int q = 1; q < 8; ++q) if (le[q] > l0) { l0 = le[q]; e0 = q; }
            int e1 = -1; float l1 = -3.0e38f;
#pragma unroll
            for (int q = 0; q < 8; ++q) if (q != e0 && le[q] > l1) { l1 = le[q]; e1 = q; }
            const float rr = __expf(l1 - l0), w0 = pg / (1.f + rr), w1 = pg * rr / (1.f + rr);
#pragma unroll
            for (int sl = 0; sl < 2; ++sl) { const int e = gs * 8 + (sl ? e1 : e0); const float w = sl ? w1 : w0;
                toke[row * 2 + sl] = e; tokw[row * 2 + sl] = w;
                const unsigned lp = __hip_atomic_fetch_add(lcnt + e, 1u, __ATOMIC_RELAXED, __HIP_MEMORY_SCOPE_WORKGROUP);
                lent[r * 2 + sl] = (unsigned)e | (lp << 8); lwt[r * 2 + sl] = w; }
        }
        __syncthreads();
        if (tid < 32 && !(a.flags & 2)) { const unsigned n = lcnt[tid]; lbase[tid] = n ? atomicAdd(cnt + 16 * tid, n) : 0u; }
        {
            float sc[4][4], sh[4][4];
#pragma unroll
            for (int j = 0; j < 4; ++j) { const int k = 256 * j + 4 * lane; const f32x4 gv = *(const f32x4*)(g2 + k), sv = *(const f32x4*)(mod + b * 6144 + 4096 + k), hv = *(const f32x4*)(mod + b * 6144 + 3072 + k);
#pragma unroll
                for (int i = 0; i < 4; ++i) { sc[j][i] = gv[i] * (1.f + sv[i]); sh[j][i] = hv[i]; } }
            f32x4 nx[4];
#pragma unroll
            for (int j = 0; j < 4; ++j) nx[j] = *(const f32x4*)(x1 + ((size_t)tile * 64 + wave) * 1024 + 256 * j + 4 * lane);
#pragma unroll 1
            for (int r = wave; r < 64; r += NWAVES) {
                const size_t row = (size_t)tile * 64 + r; f32x4 v[4];
#pragma unroll
                for (int j = 0; j < 4; ++j) v[j] = nx[j];
                if (r + NWAVES < 64) {
#pragma unroll
                    for (int j = 0; j < 4; ++j) nx[j] = *(const f32x4*)(x1 + (row + NWAVES) * 1024 + 256 * j + 4 * lane); }
                asm volatile("" ::: "memory");
                const float rstd = RS[r];
#pragma unroll
                for (int j = 0; j < 4; ++j) { v2u o; o.x = pk2(v[j][0] * rstd * sc[j][0] + sh[j][0], v[j][1] * rstd * sc[j][1] + sh[j][1]); o.y = pk2(v[j][2] * rstd * sc[j][2] + sh[j][2], v[j][3] * rstd * sc[j][3] + sh[j][3]);
                    *(v2u*)(h2 + row * 1024 + 256 * j + 4 * lane) = o; }
            }
        }
        __syncthreads();
        if (tid < 128 && !(a.flags & 2)) { const unsigned en = lent[tid]; const unsigned e = en & 255u, lp = en >> 8; const unsigned pos = lbase[e] + lp;
            listt[e * 16384 + pos] = (tile * 64 + (tid >> 1)) * 2 + (tid & 1); listw[e * 16384 + pos] = lwt[tid]; }
    }
    __syncthreads();
}
DEV void p8_convert(const Args& a, LAS unsigned char* lds, int bid, int G) {
    int tid = threadIdx.x; asm volatile("" : "+v"(tid));
    const int lane = tid & 63, wave = __builtin_amdgcn_readfirstlane(tid >> 6);
    LAS float* scr = (LAS float*)(lds + wave * 16384);
    const float* wg = a.in[22]; const float* wu = a.in[23]; const float* wd = a.in[24];
    bf16* WGU = (bf16*)(a.ws + WS_WGU); bf16* WD = (bf16*)(a.ws + WS_WD);
    const int gw = bid * NWAVES + wave, NGW = G * NWAVES;
    for (int it = gw; it < 32 * 768; it += NGW) {
        const int e = it / 768; int r = it % 768;
        if (r < 512) { const int up = r >> 8; r &= 255; const int kb = r >> 4, nb = r & 15, n = 32 * nb, np = 256 * (n >> 7) + 128 * up + (n & 127);
            transpose_item((up ? wu : wg) + (size_t)e * 1024 * 512 + (size_t)(64 * kb) * 512 + n, 512, WGU + ((size_t)e * 1024 + np) * 1024 + 64 * kb, 1024, scr, lane); }
        else { r -= 512; const int kb = r >> 5, nb = r & 31;
            transpose_item(wd + (size_t)e * 512 * 1024 + (size_t)(64 * kb) * 1024 + 32 * nb, 1024, WD + ((size_t)e * 1024 + 32 * nb) * 512 + 64 * kb, 512, scr, lane); }
    }
}

struct MoeSched {
    const LAS int* tlist; const LAS int* rstart; const LAS int* ecnt; int U, G, c; unsigned bstride;
    DEV bool next(int i, Unit& u) const {
        const int L = i * G + c; if (L >= U) return false;
        const int ent = tlist[L >> 2]; const int e = ent & 255, rt = ent >> 8; u.pn = L & 3;
        const int left = ecnt[e] - 256 * rt;
        u.pm = 0; u.ak = 0; u.bk = (unsigned)e * bstride; u.slot = i; u.valid = left < 256 ? left : 256; u.arow0 = rstart[e] + 256 * rt; return true;
    }
};
DEV void moe_tables(const Args& a, LAS unsigned char* lds, int bid, int G, MoeSched& S, bool down) {
    int tid = threadIdx.x; asm volatile("" : "+v"(tid));
    LAS int* ti = (LAS int*)(lds + LDS_MISC + 1024); LAS int* rstart = ti, *ecnt = ti + 40, *tlist = ti + 80, *ntl = ti + 260;
    const unsigned* cnt = (const unsigned*)(a.ws + WS_CTL) + CW_CNT;
    const int* listt = (const int*)(a.ws + WS_LISTT); const float* listw = (const float*)(a.ws + WS_LISTW);
    __syncthreads();
    if (tid < 64) {
        const int lane = tid; const int n = (lane < 32) ? (int)__hip_atomic_load(cnt + 16 * (lane & 31), __ATOMIC_RELAXED, __HIP_MEMORY_SCOPE_AGENT) : 0;
        const int ntile = (n + 255) >> 8, nfull = (n + 127) >> 8, ntail = ntile - nfull;
        const int rs = (int)wave_scan_add((float)n, lane) - n, of = (int)wave_scan_add((float)nfull, lane) - nfull, ot = (int)wave_scan_add((float)ntail, lane) - ntail;
        const int totf = (int)rdlane(wave_scan_add((float)nfull, lane), 63), tott = (int)rdlane(wave_scan_add((float)ntail, lane), 63);
        if (lane < 32) { ecnt[lane] = n; rstart[lane] = rs;
            for (int rt = 0; rt < nfull; ++rt) tlist[of + rt] = lane | (rt << 8);
            if (ntail) tlist[totf + ot] = lane | (nfull << 8); }
        if (lane == 32) rstart[32] = rs;
        if (lane == 0) ntl[0] = totf + tott;
    }
    __syncthreads();
    S.tlist = tlist; S.rstart = rstart; S.ecnt = ecnt; S.U = 4 * ntl[0]; S.G = G; S.c = bid;
    LAS unsigned* tab0 = (LAS unsigned*)(lds + LDS_TAB); LAS float* tab1 = (LAS float*)(lds + LDS_TAB + 8192);
    Unit u;
    for (int i = 0; i < 8 && S.next(i, u); ++i) {
        if (tid < 256) { const int e = (int)(u.bk / S.bstride); const int pos = (u.arow0 - rstart[e]) + tid; unsigned v0 = 0u; float v1 = 0.f;
            if (tid < u.valid) { const int tk = listt[e * 16384 + pos]; v0 = down ? (unsigned)tk : (unsigned)(tk >> 1) * 2048u; v1 = listw[e * 16384 + pos]; }
            tab0[i * 256 + tid] = v0; tab1[i * 256 + tid] = v1; }
    }
    __syncthreads();
}

DEV void p11_final(const Args& a, int bid, int G) {
    int tid = threadIdx.x; asm volatile("" : "+v"(tid));
    const int lane = tid & 63, wave = __builtin_amdgcn_readfirstlane(tid >> 6);
    const float* mod = (const float*)(a.ws + WS_MOD); const bf16* ys = (const bf16*)(a.ws + WS_YS); const float* gf = a.in[25]; float* out = a.out;
    float* outw = (a.flags & 65536) ? (float*)(a.ws + WS_WGU) : a.out;
    for (int tile = bid; tile < T / 64; tile += G) {
        const int b = tile / 32;
        f32x4 nx[4], gtv[4], gfv[4]; v2u ny0[4], ny1[4];
#pragma unroll
        for (int j = 0; j < 4; ++j) { const int k = 256 * j + 4 * lane; gtv[j] = *(const f32x4*)(mod + b * 6144 + 5120 + k); gfv[j] = *(const f32x4*)(gf + k); }
#pragma unroll
        for (int j = 0; j < 4; ++j) { const size_t row = (size_t)tile * 64 + wave; const int k = 256 * j + 4 * lane;
            nx[j] = *(const f32x4*)(out + row * 1024 + k); ny0[j] = *(const v2u*)(ys + row * 2048 + k); ny1[j] = *(const v2u*)(ys + row * 2048 + 1024 + k); }
#pragma unroll 1
        for (int r = wave; r < 64; r += NWAVES) {
            const size_t row = (size_t)tile * 64 + r;
            f32x4 v[4]; float ss = 0.f;
#pragma unroll
            for (int j = 0; j < 4; ++j) { const int k = 256 * j + 4 * lane;
                const f32x4 xv = nx[j], gt = gtv[j]; const v2u y0 = ny0[j], y1 = ny1[j];
                v[j][0] = xv[0] + gt[0] * (bflo(y0.x) + bflo(y1.x)); v[j][1] = xv[1] + gt[1] * (bfhi(y0.x) + bfhi(y1.x));
                v[j][2] = xv[2] + gt[2] * (bflo(y0.y) + bflo(y1.y)); v[j][3] = xv[3] + gt[3] * (bfhi(y0.y) + bfhi(y1.y));
                ss += (v[j][0] * v[j][0] + v[j][1] * v[j][1]) + (v[j][2] * v[j][2] + v[j][3] * v[j][3]); }
            if (r + NWAVES < 64) {
#pragma unroll
                for (int j = 0; j < 4; ++j) { const size_t rn = row + NWAVES; const int k = 256 * j + 4 * lane;
                    nx[j] = *(const f32x4*)(out + rn * 1024 + k); ny0[j] = *(const v2u*)(ys + rn * 2048 + k); ny1[j] = *(const v2u*)(ys + rn * 2048 + 1024 + k); } }
            asm volatile("" ::: "memory");
            const float rstd = rsqrtf(wave_sum(ss) * (1.f / 1024.f) + RMS_EPS);
#pragma unroll
            for (int j = 0; j < 4; ++j) { const int k = 256 * j + 4 * lane; *(f32x4*)(outw + row * 1024 + k) = v[j] * rstd * gfv[j]; }
        }
    }
}

constexpr int NPHASE = 11;
template <int LO, int HI>
__global__ void __launch_bounds__(NTHREADS, 2) mk_fwd(Args a) {
    extern __shared__ __attribute__((aligned(16))) unsigned char lds_raw[];
    LAS unsigned char* lds = (LAS unsigned char*)lds_raw;
    const int tid = threadIdx.x, G = gridDim.x, bid = blockIdx.x;
    volatile LAS unsigned* MISC = (volatile LAS unsigned*)(lds + LDS_MISC);
    if (tid < 64) MISC[tid] = 0u;
    __syncthreads();
#if MK_ONE
#if USE_XCD_BARRIER
    XcdBarrier bar = xcd_barrier_post((unsigned*)(a.ws + WS_CTL) + CW_BAR, MISC + 8);
#define GRID_BAR() xcd_barrier(bar)
#else
    unsigned fgen = 0;
#define GRID_BAR() flat_barrier((unsigned*)(a.ws + WS_CTL) + CW_FLATBAR, fgen)
#endif
#else
#define GRID_BAR() do {} while (0)
#endif
    constexpr int lo = LO, hi = HI;
#define IN(k) (lo <= (k) && (k) < hi)
#define BOTH(k) (IN(k) && IN((k) + 1))
    if constexpr (IN(0)) { REPK(0) { p0_prologue(a, lds, bid, G); REPSYNC(); } if constexpr (BOTH(0)) __syncthreads(); }
    if constexpr (IN(1)) { REPK(1) { P1_FN(a, lds, bid, G); REPSYNC(); } if constexpr (BOTH(1)) GRID_BAR(); }
    if constexpr (IN(2)) {
        __syncthreads();
        ProbPlain P{(const bf16*)(a.ws + WS_H), (const bf16*)(a.ws + WS_W1T), 2048u, 2048u};
#if DBG_GATEFIRST
        struct SchedG { pg8::StaticOrder so; DEV bool next(int i, Unit& u) const { if (i >= 2) return false; return so.next(i + 3, u); } } S; S.so.init(T, 5120, G, bid);
#else
        pg8::StaticOrder S; S.init(T, 5120, G, bid);
#endif
        Epi1 E{(bf16*)(a.ws + WS_ZU), (bf16*)(a.ws + WS_ZGA), (a.flags >> 8) & 15};
        REPK(2) pg8::gemm_phase<ProbPlain, Epi1, decltype(S), true>(lds, P, S, E, 1024);
        if constexpr (BOTH(2)) GRID_BAR();
    }
    if constexpr (IN(3)) {
        REPK(3) { for (int u = bid; u < 256; u += G) mlstm_unit<false>(a, lds, u);
        __syncthreads(); }
        REPK(11) { p3_conva(a, lds, bid, G); REPSYNC(); }
        if constexpr (BOTH(3)) GRID_BAR();
    }
    if constexpr (IN(4)) {
        REPK(4) { for (int u = bid; u < 256; u += G) mlstm_unit<true>(a, lds, u); REPSYNC(); }
        if constexpr (BOTH(4)) GRID_BAR();
    }
    if constexpr (IN(5)) {
        __syncthreads();
        struct Sched2 { pg8::StaticOrder so; DEV bool next(int i, Unit& u) const { u.ak = (unsigned)(i & 1) * 1024u; u.bk = u.ak; u.slot = i & 1; u.valid = 256; u.arow0 = 0; return so.tile((i >> 1) * so.G + so.c, u.pm, u.pn); } } S;
        S.so.init(T, 1024, G, bid);
        ProbPlain P{(const bf16*)(a.ws + WS_UAHM), (const bf16*)(a.ws + WS_W2T), 2048u, 2048u};
        Epi2 E{(const bf16*)(a.ws + WS_ZGA), (const bf16*)(a.ws + WS_ZGB), (bf16*)(a.ws + WS_MERGED)};
        REPK(5) pg8::gemm_phase<ProbPlain, Epi2, Sched2, true>(lds, P, S, E, 512);
        if constexpr (BOTH(5)) GRID_BAR();
    }
    if constexpr (IN(6)) {
        __syncthreads();
        ProbPlain P{(const bf16*)(a.ws + WS_MERGED), (const bf16*)(a.ws + WS_W3T), 2048u, 2048u};
        pg8::StaticOrder S; S.init(T, 1024, G, bid);
        Epi3 E{a.in[0], (const float*)(a.ws + WS_MOD), a.out};
        REPK(6) pg8::gemm_phase<ProbPlain, Epi3, pg8::StaticOrder, true>(lds, P, S, E, 1024);
        if constexpr (BOTH(6)) { GRID_BAR(); for (int xb = 0; xb < DBG_XBAR; ++xb) GRID_BAR(); }
    }
    if constexpr (IN(7)) {
        if (!(a.flags & 1)) p8_route(a, lds, bid, G);
        __syncthreads();
        if (!(a.flags & 4)) { p8_convert(a, lds, bid, G); }
        if constexpr (BOTH(7)) GRID_BAR();
    }
    if constexpr (IN(8)) {
        MoeSched S; S.bstride = 1024u * 1024u * 2u;
        moe_tables(a, lds, bid, G, S, false);
        ProbMoeUp P{(const bf16*)(a.ws + WS_H), (const bf16*)(a.ws + WS_WGU), (const LAS unsigned*)(lds + LDS_TAB)};
        EpiUp E{(bf16*)(a.ws + WS_ACT)};
        REPK(8) pg8::gemm_phase<ProbMoeUp, EpiUp, MoeSched, true, true>(lds, P, S, E, 1024);
        if constexpr (BOTH(8)) GRID_BAR();
    }
    if constexpr (IN(9)) {
        MoeSched S; S.bstride = 1024u * 512u * 2u;
        moe_tables(a, lds, bid, G, S, true);
        ProbMoeDown P{(const bf16*)(a.ws + WS_ACT), (const bf16*)(a.ws + WS_WD)};
        EpiDown E{(bf16*)(a.ws + WS_YS), (const LAS unsigned*)(lds + LDS_TAB), (const LAS float*)(lds + LDS_TAB + 8192)};
        REPK(9) pg8::gemm_phase<ProbMoeDown, EpiDown, MoeSched, true, true>(lds, P, S, E, 512);
        if constexpr (BOTH(9)) GRID_BAR();
    }
    if constexpr (IN(10)) { p11_final(a, bid, G); }
#undef IN
#undef BOTH
}

#if NAIVE_MASK
__global__ __launch_bounds__(256) void k_fixw1t(const float* w_in, bf16* W1T) { const size_t i = (size_t)blockIdx.x * 256 + threadIdx.x; const size_t n = i / 1024, k = i % 1024; W1T[(3072 + n) * 1024 + k] = f2bf(w_in[k * 5128 + 3080 + n]); }
DEV float block_sum256(float v, float* red) {
#pragma unroll
    for (int o = 32; o >= 1; o >>= 1) v += __shfl_xor(v, o);
    __syncthreads();
    if ((threadIdx.x & 63) == 0) red[threadIdx.x >> 6] = v;
    __syncthreads();
    return (red[0] + red[1]) + (red[2] + red[3]);
}
__global__ __launch_bounds__(256) void k_mod(const float* c, const float* w_ada, const float* b_ada, float* mod) {
    const int idx = blockIdx.x * 256 + threadIdx.x; const int b = idx / 6144, n = idx % 6144;
    float acc = 0.f;
    for (int k = 0; k < D; ++k) acc += siluf_(c[b * D + k]) * w_ada[(size_t)k * 6144 + n];
    mod[idx] = acc + b_ada[n];
}
__global__ __launch_bounds__(256) void k_h1(const float* x, const float* g1, const float* mod, const float* w_in, const float* b_if, bf16* h1, float* gates) {
    __shared__ float red[4];
    const int t = blockIdx.x, b = t / SEQ, tid = threadIdx.x;
    const float4 xv = ((const float4*)(x + (size_t)t * D))[tid];
    float ss = xv.x * xv.x + xv.y * xv.y + xv.z * xv.z + xv.w * xv.w;
    ss = block_sum256(ss, red);
    const float rstd = rsqrtf(ss * (1.f / D) + RMS_EPS);
    const float* sh = mod + b * 6144, *sc = mod + b * 6144 + 1024;
    float hv[4]; const float xs[4] = {xv.x, xv.y, xv.z, xv.w};
#pragma unroll
    for (int j = 0; j < 4; ++j) { const int k = tid * 4 + j; hv[j] = xs[j] * rstd * g1[k] * (1.f + sc[k]) + sh[k]; }
    ushort4 o; o.x = f2bf(hv[0]); o.y = f2bf(hv[1]); o.z = f2bf(hv[2]); o.w = f2bf(hv[3]);
    ((ushort4*)(h1 + (size_t)t * D))[tid] = o;
    float g[8];
#pragma unroll
    for (int j = 0; j < 8; ++j) g[j] = 0.f;
#pragma unroll
    for (int i = 0; i < 4; ++i) { const float* wr = w_in + (size_t)(tid * 4 + i) * DIN + 3072;
#pragma unroll
        for (int j = 0; j < 8; ++j) g[j] += hv[i] * wr[j]; }
#pragma unroll
    for (int j = 0; j < 8; ++j) g[j] = block_sum256(g[j], red);
    if (tid < 8) { float v = g[0];
#pragma unroll
        for (int j = 1; j < 8; ++j) v = (tid == j) ? g[j] : v;
        v += b_if[tid];
        gates[(size_t)t * 8 + tid] = (tid < 4) ? v : logsigmoidf_(v); }
}
template <class Epi>
__global__ __launch_bounds__(256) void k_ngemm(const bf16* A, int lda, const float* W, int ldw, int N, int K, Epi epi) {
    __shared__ float As[16][68]; __shared__ float Ws[16][68];
    const int tid = threadIdx.x, tx = tid & 15, ty = tid >> 4;
    const int row0 = blockIdx.y * 64, col0 = blockIdx.x * 64;
    float acc[4][4];
#pragma unroll
    for (int i = 0; i < 4; ++i)
#pragma unroll
        for (int j = 0; j < 4; ++j) acc[i][j] = 0.f;
    const int ar = tid >> 2, ak = (tid & 3) * 4;
    const int wk = tid >> 4, wc = (tid & 15) * 4;
    for (int k0 = 0; k0 < K; k0 += 16) {
        const ushort4 av = *(const ushort4*)(A + (size_t)(row0 + ar) * lda + k0 + ak);
        As[ak + 0][ar] = bf2f(av.x); As[ak + 1][ar] = bf2f(av.y); As[ak + 2][ar] = bf2f(av.z); As[ak + 3][ar] = bf2f(av.w);
#pragma unroll
        for (int j = 0; j < 4; ++j) { const int cc = col0 + wc + j; Ws[wk][wc + j] = (cc < N) ? W[(size_t)(k0 + wk) * ldw + cc] : 0.f; }
        __syncthreads();
#pragma unroll
        for (int kk = 0; kk < 16; ++kk) {
            float av2[4], w[4];
#pragma unroll
            for (int i = 0; i < 4; ++i) av2[i] = As[kk][ty * 4 + i];
#pragma unroll
            for (int j = 0; j < 4; ++j) w[j] = Ws[kk][tx * 4 + j];
#pragma unroll
            for (int i = 0; i < 4; ++i)
#pragma unroll
                for (int j = 0; j < 4; ++j) acc[i][j] += av2[i] * w[j];
        }
        __syncthreads();
    }
#pragma unroll
    for (int i = 0; i < 4; ++i)
#pragma unroll
        for (int j = 0; j < 4; ++j) { const int cc = col0 + tx * 4 + j; if (cc < N) epi(row0 + ty * 4 + i, cc, acc[i][j]); }
}
struct NEpi1 {
    float* tmp; bf16 *zq, *zk, *zv, *zo, *zga, *zgb;
    DEV void operator()(int r, int c, float v) const {
        if (c < 1024) tmp[(size_t)r * 1024 + c] = v;
        else if (c < 1536) zq[(size_t)r * 512 + c - 1024] = f2bf(v);
        else if (c < 2048) zk[(size_t)r * 512 + c - 1536] = f2bf(v);
        else if (c < 2560) zv[(size_t)r * 512 + c - 2048] = f2bf(v);
        else if (c < 3072) zo[(size_t)r * 512 + c - 2560] = f2bf(sigmoidf_(v));
        else if (c < 3080) {}
        else if (c < 4104) zga[(size_t)r * 1024 + c - 3080] = f2bf(sigmoidf_(v));
        else zgb[(size_t)r * 1024 + c - 4104] = f2bf(sigmoidf_(v));
    }
};
struct NEpi2a { float* tmp; const bf16* zga; DEV void operator()(int r, int c, float v) const { tmp[(size_t)r * 1024 + c] = v * bf2f(zga[(size_t)r * 1024 + c]); } };
struct NEpi2b { const float* tmp; const bf16* zgb; bf16* merged; DEV void operator()(int r, int c, float v) const { merged[(size_t)r * 1024 + c] = f2bf(tmp[(size_t)r * 1024 + c] + v * bf2f(zgb[(size_t)r * 1024 + c])); } };
struct NEpi3 { const float* x; const float* mod; float* out; DEV void operator()(int r, int c, float v) const { const int b = r / SEQ; out[(size_t)r * 1024 + c] = x[(size_t)r * 1024 + c] + mod[b * 6144 + 2048 + c] * v; } };
__global__ __launch_bounds__(256) void k_glu(const float* tmp, bf16* zu) {
    const size_t i = (size_t)blockIdx.x * 256 + threadIdx.x; const size_t r = i / 512, c = i % 512;
    zu[i] = f2bf(tmp[r * 1024 + c] * sigmoidf_(tmp[r * 1024 + 512 + c]));
}
__global__ __launch_bounds__(256) void k_conva(const bf16* zu, const float* cw, const float* cb, const float* lg, const float* lb, bf16* uahm) {
    __shared__ float red[4];
    const int t = blockIdx.x, s = t % SEQ, tid = threadIdx.x;
    float v[2];
#pragma unroll
    for (int j = 0; j < 2; ++j) { const int c = tid + 256 * j; float a = cb[c];
        for (int k = 0; k < 31; ++k) { const int ss = s - 30 + k; if (ss >= 0) a += cw[k * 512 + c] * bf2f(zu[(size_t)(t - 30 + k) * 512 + c]); }
        v[j] = a; }
    const float mean = block_sum256(v[0] + v[1], red) * (1.f / 512.f);
    const float d0 = v[0] - mean, d1 = v[1] - mean;
    const float var = block_sum256(d0 * d0 + d1 * d1, red) * (1.f / 512.f);
    const float rstd = rsqrtf(var + LN_EPS);
#pragma unroll
    for (int j = 0; j < 2; ++j) { const int c = tid + 256 * j; const float y = (v[j] - mean) * rstd * lg[c] + lb[c]; uahm[(size_t)t * 1024 + c] = f2bf(siluf_(y)); }
}
__global__ __launch_bounds__(256) void k_qkconv(const bf16* zq, const bf16* zk, const float* w, const float* bq, bf16* qc, bf16* kc) {
    const int t = blockIdx.x, s = t % SEQ, tid = threadIdx.x;
#pragma unroll
    for (int j = 0; j < 4; ++j) { const int c = tid + 256 * j; const bf16* src = (c < 512) ? zq : zk; const int cc = c & 511; float a = bq[c];
#pragma unroll
        for (int k = 0; k < 4; ++k) { const int ss = s - 3 + k; if (ss >= 0) a += w[k * 1024 + c] * bf2f(src[(size_t)(t - 3 + k) * 512 + cc]); }
        ((c < 512) ? qc : kc)[(size_t)t * 512 + cc] = f2bf(siluf_(a)); }
}
__global__ __launch_bounds__(256) void k_mlstm_rec(const bf16* qc, const bf16* kc, const bf16* zv, const bf16* zo, const float* gates, const float* mng, bf16* uahm) {
    __shared__ float qs[128], ks[128], vs[128], part[2][128], red[8];
    const int b = blockIdx.x / NH, h = blockIdx.x % NH, tid = threadIdx.x, j = tid & 127, ih = tid >> 7;
    float C[64];
#pragma unroll
    for (int r = 0; r < 64; ++r) C[r] = 0.f;
    float nn = 0.f, m = 0.f;
    for (int s = 0; s < SEQ; ++s) {
        const size_t t = (size_t)b * SEQ + s;
        __syncthreads();
        if (tid < 128) { qs[tid] = bf2f(qc[t * 512 + h * 128 + tid]) * 0.08838834764831845f; ks[tid] = bf2f(kc[t * 512 + h * 128 + tid]); }
        else vs[tid - 128] = bf2f(zv[t * 512 + h * 128 + tid - 128]);
        const float li = gates[t * 8 + h], lf = gates[t * 8 + 4 + h];
        const float mn = fmaxf(lf + m, li), ip = __expf(li - mn), fp = __expf(lf + m - mn); m = mn;
        __syncthreads();
        const float vj = vs[j]; float p = 0.f;
#pragma unroll
        for (int r = 0; r < 64; ++r) { const int i = ih * 64 + r; C[r] = fp * C[r] + ip * ks[i] * vj; p += qs[i] * C[r]; }
        part[ih][j] = p;
        float dn = 0.f;
        if (tid < 128) { nn = fp * nn + ip * ks[tid]; dn = qs[tid] * nn; }
#pragma unroll
        for (int o = 32; o >= 1; o >>= 1) dn += __shfl_xor(dn, o);
        if ((tid & 63) == 0) red[tid >> 6] = dn;
        __syncthreads();
        float hv = 0.f, sm = 0.f;
        if (tid < 128) { const float den = red[0] + red[1]; hv = (part[0][tid] + part[1][tid]) / fmaxf(fabsf(den), __expf(-mn)); sm = hv; }
#pragma unroll
        for (int o = 32; o >= 1; o >>= 1) sm += __shfl_xor(sm, o);
        if ((tid & 63) == 0) red[4 + (tid >> 6)] = sm;
        __syncthreads();
        const float mu = (red[4] + red[5]) * (1.f / 128.f);
        float dv = (tid < 128) ? (hv - mu) : 0.f; float sq = dv * dv;
#pragma unroll
        for (int o = 32; o >= 1; o >>= 1) sq += __shfl_xor(sq, o);
        __syncthreads();
        if ((tid & 63) == 0) red[tid >> 6] = sq;
        __syncthreads();
        if (tid < 128) { const float var = (red[0] + red[1]) * (1.f / 128.f); const float y = dv * rsqrtf(var + LN_EPS) * mng[h * 128 + tid] * bf2f(zo[t * 512 + h * 128 + tid]);
            uahm[t * 1024 + 512 + h * 128 + tid] = f2bf(y); }
    }
}
__global__ __launch_bounds__(256) void k_h2route(const float* x1, const float* g2, const float* mod, const float* w_rg, const float* b_rg, const float* w_re, const float* b_re, bf16* h2, int* toke, float* tokw) {
    __shared__ float red[4]; __shared__ float lg[36];
    const int t = blockIdx.x, b = t / SEQ, tid = threadIdx.x;
    const float4 xv = ((const float4*)(x1 + (size_t)t * D))[tid];
    float ss = xv.x * xv.x + xv.y * xv.y + xv.z * xv.z + xv.w * xv.w;
    ss = block_sum256(ss, red);
    const float rstd = rsqrtf(ss * (1.f / D) + RMS_EPS);
    const float* sh = mod + b * 6144 + 3072, *sc = mod + b * 6144 + 4096;
    float hv[4]; const float xs[4] = {xv.x, xv.y, xv.z, xv.w};
#pragma unroll
    for (int j = 0; j < 4; ++j) { const int k = tid * 4 + j; hv[j] = xs[j] * rstd * g2[k] * (1.f + sc[k]) + sh[k]; }
    ushort4 o; o.x = f2bf(hv[0]); o.y = f2bf(hv[1]); o.z = f2bf(hv[2]); o.w = f2bf(hv[3]);
    ((ushort4*)(h2 + (size_t)t * D))[tid] = o;
    for (int j = 0; j < 36; ++j) {
        float a = 0.f;
#pragma unroll
        for (int i = 0; i < 4; ++i) { const int k = tid * 4 + i; a += hv[i] * ((j < 4) ? w_rg[k * 4 + j] : w_re[k * 32 + j - 4]); }
        a = block_sum256(a, red);
        if (tid == 0) lg[j] = a + ((j < 4) ? b_rg[j] : b_re[j - 4]);
    }
    __syncthreads();
    if (tid == 0) {
        int gs = 0; float gm = lg[0];
        for (int j = 1; j < 4; ++j) if (lg[j] > gm) { gm = lg[j]; gs = j; }
        float se = 0.f; for (int j = 0; j < 4; ++j) se += __expf(lg[j] - gm);
        const float pg = 1.f / se;
        const float* le = lg + 4 + gs * 8;
        int e0 = 0; float l0 = le[0];
        for (int j = 1; j < 8; ++j) if (le[j] > l0) { l0 = le[j]; e0 = j; }
        int e1 = -1; float l1 = -3.0e38f;
        for (int j = 0; j < 8; ++j) if (j != e0 && le[j] > l1) { l1 = le[j]; e1 = j; }
        const float r = __expf(l1 - l0);
        const float w0 = pg / (1.f + r), w1 = pg * r / (1.f + r);
        toke[t * 2] = gs * 8 + e0; toke[t * 2 + 1] = gs * 8 + e1; tokw[t * 2] = w0; tokw[t * 2 + 1] = w1;
    }
}
__global__ __launch_bounds__(256) void k_lists(const int* toke, const float* tokw, unsigned* cnt, int* listt, float* listw) {
    const int i = blockIdx.x * 256 + threadIdx.x; const int e = toke[i]; const unsigned pos = atomicAdd(cnt + 16 * e, 1u);
    listt[e * 16384 + pos] = i; listw[e * 16384 + pos] = tokw[i];
}
__global__ __launch_bounds__(256) void k_moe(const bf16* h2, const int* toke, const float* tokw, const float* wg, const float* wu, const float* wd, bf16* ys) {
    __shared__ float hs[1024]; __shared__ float hid[512];
    const int a = blockIdx.x, t = a >> 1, tid = threadIdx.x;
    const int e = toke[a]; const float w = tokw[a];
    for (int k = tid; k < 1024; k += 256) hs[k] = bf2f(h2[(size_t)t * 1024 + k]);
    __syncthreads();
    const float* Gp = wg + (size_t)e * 1024 * 512, *U = wu + (size_t)e * 1024 * 512, *Dn = wd + (size_t)e * 512 * 1024;
    float g0 = 0.f, g1 = 0.f, u0 = 0.f, u1 = 0.f;
    for (int k = 0; k < 1024; ++k) { const float hk = hs[k]; g0 += hk * Gp[(size_t)k * 512 + tid]; g1 += hk * Gp[(size_t)k * 512 + 256 + tid]; u0 += hk * U[(size_t)k * 512 + tid]; u1 += hk * U[(size_t)k * 512 + 256 + tid]; }
    hid[tid] = siluf_(g0) * u0; hid[tid + 256] = siluf_(g1) * u1;
    __syncthreads();
    float y[4] = {0.f, 0.f, 0.f, 0.f};
    for (int j = 0; j < 512; ++j) { const float hj = hid[j];
#pragma unroll
        for (int i = 0; i < 4; ++i) y[i] += hj * Dn[(size_t)j * 1024 + tid + 256 * i]; }
#pragma unroll
    for (int i = 0; i < 4; ++i) ys[(size_t)a * 1024 + tid + 256 * i] = f2bf(w * y[i]);
}
__global__ __launch_bounds__(256) void k_final(const float* x1, const bf16* ys, const float* mod, const float* gf, float* out) {
    __shared__ float red[4];
    const int t = blockIdx.x, b = t / SEQ, tid = threadIdx.x;
    const float4 xv = ((const float4*)(x1 + (size_t)t * D))[tid];
    const ushort4 y0 = ((const ushort4*)(ys + (size_t)t * 2048))[tid], y1 = ((const ushort4*)(ys + (size_t)t * 2048 + 1024))[tid];
    const float* gt = mod + b * 6144 + 5120 + tid * 4;
    float v[4];
    v[0] = xv.x + gt[0] * (bf2f(y0.x) + bf2f(y1.x)); v[1] = xv.y + gt[1] * (bf2f(y0.y) + bf2f(y1.y));
    v[2] = xv.z + gt[2] * (bf2f(y0.z) + bf2f(y1.z)); v[3] = xv.w + gt[3] * (bf2f(y0.w) + bf2f(y1.w));
    float ss = v[0] * v[0] + v[1] * v[1] + v[2] * v[2] + v[3] * v[3];
    ss = block_sum256(ss, red);
    const float rstd = rsqrtf(ss * (1.f / D) + RMS_EPS);
    float4 o; o.x = v[0] * rstd * gf[tid * 4]; o.y = v[1] * rstd * gf[tid * 4 + 1]; o.z = v[2] * rstd * gf[tid * 4 + 2]; o.w = v[3] * rstd * gf[tid * 4 + 3];
    ((float4*)(out + (size_t)t * D))[tid] = o;
}
#endif


#ifndef DBG_BENCH
#define DBG_BENCH 0
#endif
#if DBG_BENCH
__global__ void __launch_bounds__(512, 2) k_bench_a(const float* x, float* dummy) {
    extern __shared__ __attribute__((aligned(16))) unsigned char lds_b[];
    const int tid = threadIdx.x, lane = tid & 63, wave = tid >> 6, tile = blockIdx.x;
    f32x4 nx[4][4]; float acc = 0.f;
#pragma unroll
    for (int p = 0; p < 4; ++p)
#pragma unroll
        for (int j = 0; j < 4; ++j) nx[p][j] = *(const f32x4*)(x + ((size_t)tile * 64 + wave + 8 * p) * 1024 + 256 * j + 4 * lane);
#pragma unroll
    for (int r8 = 0; r8 < 8; ++r8) {
        const size_t row = (size_t)tile * 64 + wave + 8 * r8;
#pragma unroll
        for (int j = 0; j < 4; ++j) acc += (nx[r8 & 3][j][0] + nx[r8 & 3][j][1]) + (nx[r8 & 3][j][2] + nx[r8 & 3][j][3]);
        if (r8 + 4 < 8) {
#pragma unroll
            for (int j = 0; j < 4; ++j) nx[r8 & 3][j] = *(const f32x4*)(x + (row + 32) * 1024 + 256 * j + 4 * lane); }
    }
    if (acc == 123.456f) dummy[tid] = acc;
}
__global__ void __launch_bounds__(256) k_bench_b(const float* x, float* dummy) {
    const int tid = threadIdx.x, lane = tid & 63, wave = tid >> 6; const size_t row = (size_t)blockIdx.x * 4 + wave; float acc = 0.f;
#pragma unroll
    for (int j = 0; j < 4; ++j) { const f32x4 v = *(const f32x4*)(x + row * 1024 + 256 * j + 4 * lane); acc += (v[0] + v[1]) + (v[2] + v[3]); }
    if (acc == 123.456f) dummy[tid] = acc;
}
#endif
#if DBG_BENCH >= 4
template <int LVL>
__global__ void __launch_bounds__(512, 2) k_bench_d(const float* x, const float* g1, const float* mod, bf16* h1, float* dummy) {
    extern __shared__ __attribute__((aligned(16))) unsigned char lds_b[];
    const int tid = threadIdx.x, lane = tid & 63, wave = tid >> 6, tile = blockIdx.x, b = tile / 32;
    float sc[4][4], sh[4][4];
#pragma unroll
    for (int j = 0; j < 4; ++j) { const int k = 256 * j + 4 * lane; const f32x4 gv = *(const f32x4*)(g1 + k), sv = *(const f32x4*)(mod + b * 6144 + 1024 + k), hv = *(const f32x4*)(mod + b * 6144 + k);
#pragma unroll
        for (int i = 0; i < 4; ++i) { sc[j][i] = gv[i] * (1.f + sv[i]); sh[j][i] = hv[i]; } }
    f32x4 nx[4][4];
#pragma unroll
    for (int p = 0; p < 4; ++p)
#pragma unroll
        for (int j = 0; j < 4; ++j) nx[p][j] = *(const f32x4*)(x + ((size_t)tile * 64 + wave + 8 * p) * 1024 + 256 * j + 4 * lane);
#pragma unroll
    for (int r8 = 0; r8 < 8; ++r8) {
        const size_t row = (size_t)tile * 64 + wave + 8 * r8;
        f32x4 v[4]; float ss = 0.f;
#pragma unroll
        for (int j = 0; j < 4; ++j) { v[j] = nx[r8 & 3][j]; ss += (v[j][0] * v[j][0] + v[j][1] * v[j][1]) + (v[j][2] * v[j][2] + v[j][3] * v[j][3]); }
        if (r8 + 4 < 8) {
#pragma unroll
            for (int j = 0; j < 4; ++j) nx[r8 & 3][j] = *(const f32x4*)(x + (row + 32) * 1024 + 256 * j + 4 * lane); }
        asm volatile("" ::: "memory");
        const float rstd = rsqrtf(wave_sum(ss) * (1.f / 1024.f) + RMS_EPS);
        if (LVL >= 5) {
            float g[8];
#pragma unroll
            for (int q = 0; q < 8; ++q) g[q] = 0.f;
#pragma unroll
            for (int j = 0; j < 4; ++j) { float hh[4];
#pragma unroll
                for (int i = 0; i < 4; ++i) hh[i] = v[j][i] * rstd * sc[j][i] + sh[j][i];
                v2u o; o.x = pk2(hh[0], hh[1]); o.y = pk2(hh[2], hh[3]);
                *(v2u*)(h1 + row * 1024 + 256 * j + 4 * lane) = o;
                if (LVL >= 6) {
#pragma unroll
                    for (int i = 0; i < 4; ++i) { const LAS float* tp = (const LAS float*)lds_b + ((4 * j + i) * 64 + lane) * 8; f32x4 w0, w1;
                        if (LVL == 8) { w0 = (f32x4){1.f, 2.f, 3.f, 4.f}; w1 = (f32x4){5.f, 6.f, 7.f, 8.f}; } else { w0 = *(const LAS f32x4*)tp; w1 = *(const LAS f32x4*)(tp + 4); }
                        g[0] += hh[i] * w0[0]; g[1] += hh[i] * w0[1]; g[2] += hh[i] * w0[2]; g[3] += hh[i] * w0[3]; g[4] += hh[i] * w1[0]; g[5] += hh[i] * w1[1]; g[6] += hh[i] * w1[2]; g[7] += hh[i] * w1[3]; } } }
            if (LVL == 6 || LVL == 8) { const float t = ((g[0] + g[1]) + (g[2] + g[3])) + ((g[4] + g[5]) + (g[6] + g[7])); if (t == 123.456f) dummy[row] = t; }
            if (LVL == 7) { float mine = 0.f;
#pragma unroll
                for (int q = 0; q < 8; ++q) { const float sq = wave_sum(g[q]); mine = (lane == q) ? sq : mine; }
                if (lane < 8) dummy[row * 8 + lane] = (lane < 4) ? mine : logsigmoidf_(mine); }
        } else if (lane == 0) dummy[row] = rstd;
    }
}
#endif
#if DBG_BENCH == 3
__global__ void __launch_bounds__(512, 2) k_bench_c(float* dummy, float seed) {
    extern __shared__ __attribute__((aligned(16))) unsigned char lds_b[];
    float a0 = seed + threadIdx.x, a1 = a0 + 1.f, a2 = a0 + 2.f, a3 = a0 + 3.f; const float m = 1.0000001f, c = 1e-9f;
#pragma unroll 1
    for (int i = 0; i < 2048; ++i) {
#pragma unroll
        for (int j = 0; j < 4; ++j) { a0 = a0 * m + c; a1 = a1 * m + c; a2 = a2 * m + c; a3 = a3 * m + c; }
    }
    if (a0 + a1 + a2 + a3 == 123.456f) dummy[threadIdx.x] = a0;
}
#endif
#if MK_ONE
constexpr int NKERN = 1;
static const void* const mk_kernels[NKERN] = {(const void*)mk_fwd<0, NPHASE>};
#else
constexpr int NKERN = NPHASE;
static const void* const mk_kernels[NKERN] = {(const void*)mk_fwd<0, 1>, (const void*)mk_fwd<1, 2>, (const void*)mk_fwd<2, 3>, (const void*)mk_fwd<3, 4>, (const void*)mk_fwd<4, 5>, (const void*)mk_fwd<5, 6>,
    (const void*)mk_fwd<6, 7>, (const void*)mk_fwd<7, 8>, (const void*)mk_fwd<8, 9>, (const void*)mk_fwd<9, 10>, (const void*)mk_fwd<10, 11>};
#endif
extern "C" void kernel_launch(void* const* d_in, const int* in_sizes, int n_in, void* d_out, int out_size, void* d_ws, size_t ws_size, hipStream_t stream) {
    static int grid = 0;
    if (grid == 0) {
        int dev = 0, cus = 0;
        if (hipGetDevice(&dev) != hipSuccess || hipDeviceGetAttribute(&cus, hipDeviceAttributeMultiprocessorCount, dev) != hipSuccess) { grid = -1; return; }
        for (int k = 0; k < NKERN; ++k) if (hipFuncSetAttribute(mk_kernels[k], hipFuncAttributeMaxDynamicSharedMemorySize, LDS_BYTES) != hipSuccess) { grid = -1; return; }
        int per_cu = 0;
        (void)hipOccupancyMaxActiveBlocksPerMultiprocessor(&per_cu, mk_kernels[0], NTHREADS, LDS_BYTES);
        (void)hipGetLastError();
        grid = (per_cu >= 1) ? cus : -1;
    }
    if (grid < 0) return;
    (void)hipMemsetAsync((char*)d_ws + WS_CTL, 0, CTL_ZERO_BYTES, stream);
    Args a{};
    for (int i = 0; i < 26; ++i) a.in[i] = (const float*)d_in[i];
    a.out = (float*)d_out; a.ws = (unsigned char*)d_ws;
#if MK_ONE
    a.ph_lo = 0; a.ph_hi = NPHASE;
    { void* args[] = {&a}; (void)hipLaunchKernel(mk_kernels[0], dim3(grid), dim3(NTHREADS), args, LDS_BYTES, stream); }
#else
    unsigned char* ws = (unsigned char*)d_ws; float* out = (float*)d_out;
    float* mod = (float*)(ws + WS_MOD); float* gates = (float*)(ws + WS_GATES); int* toke = (int*)(ws + WS_TOKE); float* tokw = (float*)(ws + WS_TOKW);
    bf16* hb = (bf16*)(ws + WS_H); bf16* zu = (bf16*)(ws + WS_ZU); bf16* zq = (bf16*)(ws + WS_ZQ); bf16* zk = (bf16*)(ws + WS_ZK); bf16* zv = (bf16*)(ws + WS_ZV); bf16* zo = (bf16*)(ws + WS_ZO);
    bf16* zga = (bf16*)(ws + WS_ZGA); bf16* zgb = (bf16*)(ws + WS_ZGB); bf16* qc = (bf16*)(ws + WS_QC); bf16* kc = (bf16*)(ws + WS_KC); bf16* uahm = (bf16*)(ws + WS_UAHM);
    bf16* merged = (bf16*)(ws + WS_MERGED); bf16* ys = (bf16*)(ws + WS_YS);
    (void)mod; (void)gates; (void)toke; (void)tokw; (void)hb; (void)zu; (void)zq; (void)zk; (void)zv; (void)zo; (void)zga; (void)zgb; (void)qc; (void)kc; (void)uahm; (void)merged; (void)ys; (void)out;
#ifndef DBG_NPH
#define DBG_NPH NPHASE
#endif
#if DBG_BENCH == 1
    { static bool once = false; if (!once) { (void)hipFuncSetAttribute((const void*)k_bench_a, hipFuncAttributeMaxDynamicSharedMemorySize, LDS_BYTES); once = true; }
      for (int rep = 0; rep < 4; ++rep) hipLaunchKernelGGL(k_bench_a, dim3(256), dim3(512), LDS_BYTES, stream, (const float*)d_in[0], (float*)((char*)d_ws + WS_TOKE)); }
#elif DBG_BENCH >= 4
    { static bool once = false; if (!once) { (void)hipFuncSetAttribute((const void*)k_bench_d<DBG_BENCH>, hipFuncAttributeMaxDynamicSharedMemorySize, LDS_BYTES); once = true; }
      (void)hipMemsetAsync((char*)d_ws + WS_MOD, 0, 256 * 1024, stream);
      for (int rep = 0; rep < 2; ++rep) hipLaunchKernelGGL(k_bench_d<DBG_BENCH>, dim3(256), dim3(512), LDS_BYTES, stream, (const float*)d_in[0], (const float*)d_in[4], (const float*)((char*)d_ws + WS_MOD), (bf16*)((char*)d_ws + WS_H), (float*)((char*)d_ws + WS_TOKE)); }
#elif DBG_BENCH == 3
    { static bool once = false; if (!once) { (void)hipFuncSetAttribute((const void*)k_bench_c, hipFuncAttributeMaxDynamicSharedMemorySize, LDS_BYTES); once = true; }
      for (int rep = 0; rep < 2; ++rep) hipLaunchKernelGGL(k_bench_c, dim3(256), dim3(512), LDS_BYTES, stream, (float*)((char*)d_ws + WS_TOKE), 1.0f); }
#elif DBG_BENCH == 2
    for (int rep = 0; rep < 4; ++rep) hipLaunchKernelGGL(k_bench_b, dim3(4096), dim3(256), 0, stream, (const float*)d_in[0], (float*)((char*)d_ws + WS_TOKE));
#endif
    for (int ph = 0; ph < DBG_NPH; ++ph) {
        a.ph_lo = ph; a.ph_hi = ph + 1; a.flags = 0;
        bool mk = true;
#if NAIVE_MASK
        const float* const* I = (const float* const*)d_in;
        if ((NAIVE_MASK >> ph) & 1) {
            mk = false;
            switch (ph) {
            case 0: k_mod<<<8 * 6144 / 256, 256, 0, stream>>>(I[1], I[2], I[3], mod); mk = true; break;
            case 1: k_h1<<<T, 256, 0, stream>>>(I[0], I[4], mod, I[5], I[6], hb, gates); break;
            case 2: k_ngemm<NEpi1><<<dim3((DIN + 63) / 64, T / 64), 256, 0, stream>>>(hb, 1024, I[5], DIN, DIN, 1024, NEpi1{out, zq, zk, zv, zo, zga, zgb});
                    k_glu<<<T * 512 / 256, 256, 0, stream>>>(out, zu); a.flags = (DBG_CLS) << 8; mk = (DBG_CLS) != 0;
                    k_fixw1t<<<2048 * 1024 / 256, 256, 0, stream>>>(I[5], (bf16*)(ws + WS_W1T)); break;
            case 3: k_conva<<<T, 256, 0, stream>>>(zu, I[7], I[8], I[9], I[10], uahm); mk = ((NAIVE_MASK >> 4) & 1) ? false : true; break;
            case 4: k_qkconv<<<T, 256, 0, stream>>>(zq, zk, I[12], I[13], qc, kc);
                    k_mlstm_rec<<<BATCH * NH, 256, 0, stream>>>(qc, kc, zv, zo, gates, I[14], uahm); break;
            case 5: k_ngemm<NEpi2a><<<dim3(16, T / 64), 256, 0, stream>>>(uahm, 1024, I[11], 1024, 1024, 512, NEpi2a{out, zga});
                    k_ngemm<NEpi2b><<<dim3(16, T / 64), 256, 0, stream>>>(uahm + 512, 1024, I[15], 1024, 1024, 512, NEpi2b{out, zgb, merged}); break;
            case 6: k_ngemm<NEpi3><<<dim3(16, T / 64), 256, 0, stream>>>(merged, 1024, I[16], 1024, 1024, 1024, NEpi3{I[0], mod, out}); break;
            case 7: k_h2route<<<T, 256, 0, stream>>>(out, I[17], mod, I[18], I[19], I[20], I[21], hb, toke, tokw);
                    k_lists<<<T * 2 / 256, 256, 0, stream>>>(toke, tokw, (unsigned*)(ws + WS_CTL) + CW_CNT, (int*)(ws + WS_LISTT), (float*)(ws + WS_LISTW));
                    a.flags = 1; mk = true; break;
            case 8: break;
            case 9: k_moe<<<T * 2, 256, 0, stream>>>(hb, toke, tokw, I[22], I[23], I[24], (bf16*)(ws + WS_ZU)); break;
            case 10: k_final<<<T, 256, 0, stream>>>(out, (const bf16*)(ws + WS_ZU), mod, I[25], out); break;
            }
        }
#endif
        if (mk && ph == 10 && ((DBG_HREP >> 10) & 1)) { a.flags = 65536; void* args0[] = {&a}; (void)hipLaunchKernel(mk_kernels[ph], dim3(grid), dim3(NTHREADS), args0, LDS_BYTES, stream); a.flags = 0; }
        if (mk) { void* args[] = {&a}; (void)hipLaunchKernel(mk_kernels[ph], dim3(grid), dim3(NTHREADS), args, LDS_BYTES, stream);
            if (((DBG_HREP >> ph) & 1) && ph != 10) { if (ph == 7) a.flags |= DBG_F7; if (ph == 1) a.flags |= DBG_F1; if (ph == 4) a.flags |= DBG_F4; (void)hipLaunchKernel(mk_kernels[ph], dim3(grid), dim3(NTHREADS), args, LDS_BYTES, stream); } }
    }
#endif
}
```

```cpp
#include <hip/hip_runtime.h>
#include <stdint.h>
#include <cstdio>

#ifndef MK_ONE
#define MK_ONE 1
#endif
#ifndef NAIVE_MASK
#define NAIVE_MASK 0
#endif
#ifndef DBG_NPH
#define DBG_NPH 11
#endif
#ifndef P1_MFMA
#define P1_MFMA 0
#endif
#if P1_MFMA
#define P1_FN p1_h1_mfma
#else
#define P1_FN p1_h1
#endif
#ifndef XB_EARLY_ACQ
#define XB_EARLY_ACQ 1
#endif
#ifndef USE_XCD_BARRIER
#define USE_XCD_BARRIER 1
#endif
#ifndef DBG_XBAR
#define DBG_XBAR 0
#endif
#ifndef DBG_F4
#define DBG_F4 0
#endif
#ifndef DBG_F1
#define DBG_F1 0
#endif
#ifndef DBG_F7
#define DBG_F7 6
#endif
#ifndef DBG_HREP
#define DBG_HREP 0
#endif
#ifndef DBG_REP
#define DBG_REP 0
#endif
#if DBG_REP
#define REPK(k) for (int _r = 0; _r < 1 + ((DBG_REP >> (k)) & 1); ++_r)
#define REPSYNC() __syncthreads()
#else
#define REPK(k)
#define REPSYNC() do {} while (0)
#endif
#ifndef DBG_CLS
#define DBG_CLS 0
#endif
#ifndef DBG_GATEFIRST
#define DBG_GATEFIRST 0
#endif

typedef unsigned short bf16;
#define DEV __device__ __forceinline__
#define LAS __attribute__((address_space(3)))
typedef short bf16x8 __attribute__((ext_vector_type(8)));
typedef float f32x4 __attribute__((ext_vector_type(4)));
typedef unsigned v4u __attribute__((ext_vector_type(4)));
typedef unsigned v2u __attribute__((ext_vector_type(2)));

constexpr int BATCH = 8, SEQ = 2048, D = 1024, T = BATCH * SEQ;
constexpr int DIN = 5128, NH = 4;
constexpr float RMS_EPS = 1e-6f, LN_EPS = 1e-5f;
constexpr int NWAVES = 8, NTHREADS = 512;

DEV float bf2f(bf16 v) { return __uint_as_float(((unsigned)v) << 16); }
DEV float bflo(unsigned w) { return __uint_as_float(w << 16); }
DEV float bfhi(unsigned w) { return __uint_as_float(w & 0xffff0000u); }
DEV unsigned f2bfu(float f) { unsigned u = __float_as_uint(f); return (u + 0x7fffu + ((u >> 16) & 1u)) >> 16; }
DEV unsigned pk2(float lo, float hi);
DEV bf16 f2bf(float f) { return (bf16)(pk2(f, f) & 0xffffu); }
typedef float f32x2_cv __attribute__((ext_vector_type(2)));
typedef __bf16 bf16x2_cv __attribute__((ext_vector_type(2)));
DEV unsigned pk2(float lo, float hi) { const f32x2_cv v = {lo, hi}; const bf16x2_cv b = __builtin_convertvector(v, bf16x2_cv); return __builtin_bit_cast(unsigned, b); }
DEV float sigmoidf_(float x) { return __builtin_amdgcn_rcpf(1.f + __expf(-x)); }
DEV float siluf_(float x) { return x * __builtin_amdgcn_rcpf(1.f + __expf(-x)); }
DEV float logsigmoidf_(float x) { return fminf(x, 0.f) - log1pf(__expf(-fabsf(x))); }
template <int CTRL> DEV float dpp0(float v) { return __int_as_float(__builtin_amdgcn_update_dpp(0, __float_as_int(v), CTRL, 0xf, 0xf, true)); }
template <int CTRL> DEV float dppk(float v) { return __int_as_float(__builtin_amdgcn_update_dpp(__float_as_int(v), __float_as_int(v), CTRL, 0xf, 0xf, false)); }
DEV float rdlane(float v, int l) { return __int_as_float(__builtin_amdgcn_readlane(__float_as_int(v), l)); }
DEV float row16_sum(float v) {
    v += dpp0<0xB1>(v); v += dpp0<0x4E>(v); v += dpp0<0x141>(v); v += dpp0<0x140>(v); return v; }
DEV float wave_sum(float v) { v = row16_sum(v); return (rdlane(v, 0) + rdlane(v, 16)) + (rdlane(v, 32) + rdlane(v, 48)); }
DEV float wave_scan_add(float v, int lane) {
    v += dpp0<0x111>(v); v += dpp0<0x112>(v); v += dpp0<0x114>(v); v += dpp0<0x118>(v);
    const float r0 = rdlane(v, 15), r1 = rdlane(v, 31), r2 = rdlane(v, 47);
    return v + ((lane >= 48) ? (r0 + r1) + r2 : (lane >= 32) ? (r0 + r1) : (lane >= 16) ? r0 : 0.f); }
DEV float wave_scan_max(float v, int lane) {
    v = fmaxf(v, dppk<0x111>(v)); v = fmaxf(v, dppk<0x112>(v)); v = fmaxf(v, dppk<0x114>(v)); v = fmaxf(v, dppk<0x118>(v));
    const float r0 = rdlane(v, 15), r1 = rdlane(v, 31), r2 = rdlane(v, 47);
    const float p = (lane >= 48) ? fmaxf(fmaxf(r0, r1), r2) : (lane >= 32) ? fmaxf(r0, r1) : (lane >= 16) ? r0 : -3.0e38f;
    return fmaxf(v, p); }
#define LDS_WAIT() asm volatile("s_waitcnt lgkmcnt(0)" ::: "memory")

constexpr size_t MiB = 1u << 20;
constexpr size_t WS_CTL = 0, CTL_ZERO_BYTES = 65536;
constexpr size_t WS_MOD = 1 * MiB;
constexpr size_t WS_GATES = 1 * MiB + 256 * 1024;
constexpr size_t WS_STSC = 1 * MiB + 768 * 1024;
constexpr size_t WS_RBIAS = 1 * MiB + 800 * 1024;
constexpr size_t WS_WIF = 1 * MiB + 832 * 1024;
constexpr size_t WS_RW = 6 * MiB + 256 * 1024;
constexpr size_t WS_TOKE = 6 * MiB;
constexpr size_t WS_TOKW = 6 * MiB + 128 * 1024;
constexpr size_t WS_LISTT = 2 * MiB;
constexpr size_t WS_LISTW = 4 * MiB;
constexpr size_t WS_W1T = 8 * MiB;
constexpr size_t WS_W2T = 18 * MiB;
constexpr size_t WS_W3T = 20 * MiB;
constexpr size_t WS_STATE = 22 * MiB;
constexpr size_t WS_H = 40 * MiB;
constexpr size_t WS_ZU = 72 * MiB, WS_ZQ = 88 * MiB, WS_ZK = 104 * MiB, WS_ZV = 120 * MiB, WS_ZO = 136 * MiB;
constexpr size_t WS_ZGA = 152 * MiB, WS_ZGB = 184 * MiB;
constexpr size_t WS_UAHM = 216 * MiB;
constexpr size_t WS_MERGED = WS_ZQ;
constexpr size_t WS_WGU = 120 * MiB;
constexpr size_t WS_WD = 184 * MiB;
constexpr size_t WS_ACT = 216 * MiB;
constexpr size_t WS_YS = 40 * MiB;
constexpr size_t WS_QC = WS_H, WS_KC = WS_H + 16 * MiB;
constexpr int CW_BAR = 4096, CW_CNT = 8192, CW_MODCNT = 9216, CW_FLATBAR = 9280;

constexpr int LDS_TAB = 131072;
constexpr int LDS_MISC = 147456;
constexpr int LDS_BYTES = 151552;

struct Args { const float* in[26]; float* out; unsigned char* ws; int ph_lo, ph_hi, flags, pad; };

namespace pg8 {
constexpr int BM = 256, BK = 64, HALF = 128, HTB = HALF * BK * 2, NXCD = 8, WGM = 8;
DEV int lds_byte(int r, int c) { const int st = (r >> 4) * 2 + (c >> 5), rr = r & 15, cc = c & 31, ob = rr * 64 + cc * 2; return st * 1024 + (ob ^ (((ob >> 9) & 1) << 5)); }
DEV void stage_rc(int b, int& R, int& C) { const int st = b / 1024, sb = b % 1024, swz = sb ^ (((sb >> 9) & 1) << 5); R = (st >> 1) * 16 + swz / 64; C = (st & 1) * 32 + (swz % 64) / 2; }
DEV int perm32(int rho) { const int n = rho >> 4, i = rho & 15; return 8 * (i >> 2) + 4 * n + (i & 3); }
DEV unsigned cvt_pk_bf16(float lo, float hi) { return pk2(lo, hi); }

struct Unit { int pm, pn; unsigned ak, bk; int slot, valid, arow0; };

struct StaticOrder {
    int nM, nN, nwg, G, c;
    DEV void init(int M, int N, int G_, int c_) { nM = M / BM; nN = N / BM; nwg = nM * nN; G = G_; c = c_; }
    DEV bool tile(int L, int& pm, int& pn) const {
        if (L >= nwg) return false;
        int wgid = L; { const int q = nwg / NXCD, r = nwg % NXCD, xcd = wgid % NXCD, off = wgid / NXCD; wgid = (xcd < r ? xcd * (q + 1) : r * (q + 1) + (xcd - r) * q) + off; }
        const int nig = WGM * nN, gid = wgid / nig, fm = gid * WGM, gsz = (nM - fm) < WGM ? (nM - fm) : WGM;
        pm = fm + ((wgid % nig) % gsz); pn = (wgid % nig) / gsz; return true;
    }
    DEV bool next(int i, Unit& u) const { u.ak = 0; u.bk = 0; u.slot = 0; u.valid = 256; u.arow0 = 0; return tile(i * G + c, u.pm, u.pn); }
};

template <class Prob, class Epi, class Sched, bool ALIGN_EPI, bool SKIP = false>
DEV void gemm_phase(LAS unsigned char* lds, const Prob& P, const Sched& S, const Epi& E, const int K) {
    int tid = threadIdx.x; asm volatile("" : "+v"(tid));
    const int wid = __builtin_amdgcn_readfirstlane(tid >> 6), lane = tid & 63, wr = wid >> 2, wc = wid & 3, fr = lane & 15, fq = lane >> 4;
    const int nt = K / BK;
    int R[2], C[2], Rb[2];
#pragma unroll
    for (int i = 0; i < 2; ++i) { stage_rc(tid * 16 + i * 8192, R[i], C[i]); Rb[i] = Epi::PERM ? ((R[i] & ~31) + perm32(R[i] & 31)) : R[i]; }
    const unsigned kstep = BK * 2;
    const unsigned ldsw = (unsigned)wid * 1024u;
    const int aoff = lds_byte(wr * 64 + fr, fq * 8), boff = lds_byte(wc * 32 + fr, fq * 8);
    const char* const Abase = (const char*)P.A; const char* const Bbase = (const char*)P.B;
#define PG8_SA(b, h) (((b) * 2 + (h)) * HTB)
#define PG8_SB(b, h) ((4 + (b) * 2 + (h)) * HTB)
#define PG8_STAGE(bufoff, base, offs, kb) do { _Pragma("unroll") for (int _i = 0; _i < 2; ++_i) \
        __builtin_amdgcn_global_load_lds((const unsigned*)((base) + (size_t)((offs)[_i] + (kb))), (LAS unsigned*)(lds + (bufoff) + ldsw + _i * 8192), 16, 0, 0); } while (0)
#define PG8_LDA(dst, b, h) do { _Pragma("unroll") for (int m = 0; m < 4; ++m) _Pragma("unroll") for (int k = 0; k < 2; ++k) dst[m][k] = *(const LAS bf16x8*)(lds + PG8_SA(b, h) + aoff + m * 2048 + k * 1024); } while (0)
#define PG8_LDB(dst, b, h) do { _Pragma("unroll") for (int n = 0; n < 2; ++n) _Pragma("unroll") for (int k = 0; k < 2; ++k) dst[n][k] = *(const LAS bf16x8*)(lds + PG8_SB(b, h) + boff + n * 2048 + k * 1024); } while (0)
#define PG8_MMA(ai, bj, At, Bt) do { __builtin_amdgcn_s_setprio(1); _Pragma("unroll") for (int m = 0; m < 4; ++m) _Pragma("unroll") for (int n = 0; n < 2; ++n) _Pragma("unroll") for (int k = 0; k < 2; ++k) \
        acc[ai][bj][m][n] = __builtin_amdgcn_mfma_f32_16x16x32_bf16(Bt[n][k], At[m][k], acc[ai][bj][m][n], 0, 0, 0); __builtin_amdgcn_s_setprio(0); } while (0)
#define PG8_WAIT_V(n) asm volatile("s_waitcnt vmcnt(" #n ")" ::: "memory")
#define PG8_WAIT_L(n) asm volatile("s_waitcnt lgkmcnt(" #n ")" ::: "memory")
#define PG8_BAR __builtin_amdgcn_s_barrier()
#define PG8_SCHED __builtin_amdgcn_sched_barrier(0)
    Unit cur, nxt; int ui = 0;
    if (!S.next(0, cur)) return;
    f32x4 acc[2][2][4][2];
#pragma unroll
    for (int a = 0; a < 2; ++a)
#pragma unroll
        for (int b = 0; b < 2; ++b)
#pragma unroll
            for (int m = 0; m < 4; ++m)
#pragma unroll
                for (int n = 0; n < 2; ++n) acc[a][b][m][n] = (f32x4){0.f, 0.f, 0.f, 0.f};
    bf16x8 At[4][2], B0[2][2], B1[2][2];
    unsigned ca[2][2], cb[2][2], na[2][2], nb[2][2];
    P.aoffs(cur, R, C, ca); P.boffs(cur, Rb, C, cb);
    PG8_STAGE(PG8_SB(0, 0), Bbase, cb[0], 0u); PG8_STAGE(PG8_SB(0, 1), Bbase, cb[1], 0u); PG8_STAGE(PG8_SA(0, 0), Abase, ca[0], 0u); PG8_STAGE(PG8_SA(0, 1), Abase, ca[1], 0u);
    if (wr == 1) PG8_BAR;
    PG8_WAIT_V(2); PG8_BAR;
    PG8_STAGE(PG8_SB(1, 0), Bbase, cb[0], kstep); PG8_STAGE(PG8_SA(1, 0), Abase, ca[0], kstep); PG8_STAGE(PG8_SB(1, 1), Bbase, cb[1], kstep);
    PG8_WAIT_V(6); PG8_BAR;
    for (;;) {
        const bool has_next = S.next(ui + 1, nxt);
        if (has_next) { P.aoffs(nxt, R, C, na); P.boffs(nxt, Rb, C, nb); }
        else {
#pragma unroll
            for (int h = 0; h < 2; ++h)
#pragma unroll
                for (int i = 0; i < 2; ++i) { na[h][i] = ca[h][i]; nb[h][i] = cb[h][i]; } }
        const bool do0 = !(SKIP && cur.valid <= 64 && wr == 1), do1 = !(SKIP && cur.valid <= 128) && do0;
        for (int t = 0; t < nt; t += 2) {
            const bool last = (t == nt - 2);
            const unsigned k1 = (unsigned)(t + 1) * kstep;
            const unsigned kb2 = last ? 0u : (unsigned)(t + 2) * kstep, kb3 = kb2 + kstep;
            unsigned a2[2][2], b2[2][2];
#pragma unroll
            for (int h = 0; h < 2; ++h)
#pragma unroll
                for (int i = 0; i < 2; ++i) { a2[h][i] = last ? na[h][i] : ca[h][i]; b2[h][i] = last ? nb[h][i] : cb[h][i]; }
            PG8_LDB(B0, 0, 0); PG8_LDB(B1, 0, 1); PG8_SCHED; PG8_LDA(At, 0, 0); PG8_STAGE(PG8_SA(1, 1), Abase, ca[1], k1);
            PG8_WAIT_V(8); PG8_WAIT_L(0); PG8_BAR; if (do0) { PG8_MMA(0, 0, At, B0); PG8_MMA(0, 1, At, B1); } PG8_BAR; PG8_SCHED;
            PG8_LDA(At, 0, 1); PG8_STAGE(PG8_SB(0, 0), Bbase, b2[0], kb2); PG8_STAGE(PG8_SB(0, 1), Bbase, b2[1], kb2); PG8_STAGE(PG8_SA(0, 0), Abase, a2[0], kb2);
            PG8_WAIT_V(8); PG8_WAIT_L(0); PG8_BAR; if (do1) { PG8_MMA(1, 0, At, B0); PG8_MMA(1, 1, At, B1); } PG8_BAR; PG8_SCHED;
            PG8_LDB(B0, 1, 0); PG8_LDB(B1, 1, 1); PG8_SCHED; PG8_LDA(At, 1, 0); PG8_STAGE(PG8_SA(0, 1), Abase, a2[1], kb2);
            PG8_WAIT_V(8); PG8_WAIT_L(0); PG8_BAR; if (do0) { PG8_MMA(0, 0, At, B0); PG8_MMA(0, 1, At, B1); } PG8_BAR; PG8_SCHED;
            PG8_LDA(At, 1, 1); PG8_STAGE(PG8_SB(1, 0), Bbase, b2[0], kb3); PG8_STAGE(PG8_SB(1, 1), Bbase, b2[1], kb3); PG8_STAGE(PG8_SA(1, 0), Abase, a2[0], kb3);
            PG8_WAIT_V(8); PG8_WAIT_L(0); PG8_BAR; if (do1) { PG8_MMA(1, 0, At, B0); PG8_MMA(1, 1, At, B1); } PG8_BAR; PG8_SCHED;
        }
        if constexpr (ALIGN_EPI) { if (wr == 0) PG8_BAR; }
        E(acc, cur, wr, wc, fr, fq);
        if (!has_next) break;
        if (!E.keep(cur)) {
#pragma unroll
            for (int a = 0; a < 2; ++a)
#pragma unroll
                for (int b = 0; b < 2; ++b)
#pragma unroll
                    for (int m = 0; m < 4; ++m)
#pragma unroll
                        for (int n = 0; n < 2; ++n) acc[a][b][m][n] = (f32x4){0.f, 0.f, 0.f, 0.f};
        }
        cur = nxt; ++ui;
#pragma unroll
        for (int h = 0; h < 2; ++h)
#pragma unroll
            for (int i = 0; i < 2; ++i) { ca[h][i] = na[h][i]; cb[h][i] = nb[h][i]; }
        if constexpr (ALIGN_EPI) { if (wr == 1) PG8_BAR; }
    }
    PG8_WAIT_V(0);
    if constexpr (!ALIGN_EPI) { if (wr == 0) PG8_BAR; }
    PG8_BAR;
#undef PG8_SA
#undef PG8_SB
#undef PG8_STAGE
#undef PG8_LDA
#undef PG8_LDB
#undef PG8_MMA
#undef PG8_WAIT_V
#undef PG8_WAIT_L
#undef PG8_BAR
#undef PG8_SCHED
}
}
using pg8::Unit;

struct ProbPlain {
    const bf16* A; const bf16* B; unsigned lda2, ldb2;
    DEV void aoffs(const Unit& u, const int (&R)[2], const int (&C)[2], unsigned (&o)[2][2]) const {
#pragma unroll
        for (int h = 0; h < 2; ++h)
#pragma unroll
            for (int i = 0; i < 2; ++i) o[h][i] = (unsigned)(u.pm * 256 + 128 * h + R[i]) * lda2 + (unsigned)C[i] * 2u + u.ak; }
    DEV void boffs(const Unit& u, const int (&Rb)[2], const int (&C)[2], unsigned (&o)[2][2]) const {
#pragma unroll
        for (int h = 0; h < 2; ++h)
#pragma unroll
            for (int i = 0; i < 2; ++i) o[h][i] = (unsigned)(u.pn * 256 + 128 * h + Rb[i]) * ldb2 + (unsigned)C[i] * 2u + u.bk; }
};
struct ProbMoeUp {
    const bf16* A; const bf16* B; const LAS unsigned* rowtab;
    DEV void aoffs(const Unit& u, const int (&R)[2], const int (&C)[2], unsigned (&o)[2][2]) const {
#pragma unroll
        for (int h = 0; h < 2; ++h)
#pragma unroll
            for (int i = 0; i < 2; ++i) o[h][i] = rowtab[u.slot * 256 + 128 * h + R[i]] + (unsigned)C[i] * 2u; }
    DEV void boffs(const Unit& u, const int (&Rb)[2], const int (&C)[2], unsigned (&o)[2][2]) const {
#pragma unroll
        for (int h = 0; h < 2; ++h)
#pragma unroll
            for (int i = 0; i < 2; ++i) o[h][i] = (unsigned)(u.pn * 256 + 128 * h + Rb[i]) * 2048u + (unsigned)C[i] * 2u + u.bk; }
};
struct ProbMoeDown {
    const bf16* A; const bf16* B;
    DEV void aoffs(const Unit& u, const int (&R)[2], const int (&C)[2], unsigned (&o)[2][2]) const {
#pragma unroll
        for (int h = 0; h < 2; ++h)
#pragma unroll
            for (int i = 0; i < 2; ++i) o[h][i] = (unsigned)(u.arow0 + 128 * h + R[i]) * 1024u + (unsigned)C[i] * 2u; }
    DEV void boffs(const Unit& u, const int (&Rb)[2], const int (&C)[2], unsigned (&o)[2][2]) const {
#pragma unroll
        for (int h = 0; h < 2; ++h)
#pragma unroll
            for (int i = 0; i < 2; ++i) o[h][i] = (unsigned)(u.pn * 256 + 128 * h + Rb[i]) * 1024u + (unsigned)C[i] * 2u + u.bk; }
};

DEV void st16_wt(void* p, const v4u v) { asm volatile("global_store_dwordx4 %0, %1, off sc1\n\ts_nop 1" :: "v"(p), "v"(v) : "memory"); }
DEV v4u pack8(const f32x4 v0, const f32x4 v1) { v4u w; w.x = pg8::cvt_pk_bf16(v0[0], v0[1]); w.y = pg8::cvt_pk_bf16(v0[2], v0[3]); w.z = pg8::cvt_pk_bf16(v1[0], v1[1]); w.w = pg8::cvt_pk_bf16(v1[2], v1[3]); return w; }
DEV f32x4 sig4(f32x4 v) { f32x4 o; o[0] = sigmoidf_(v[0]); o[1] = sigmoidf_(v[1]); o[2] = sigmoidf_(v[2]); o[3] = sigmoidf_(v[3]); return o; }
DEV void unpack8(const v4u w, f32x4& lo, f32x4& hi) { lo[0] = bflo(w.x); lo[1] = bfhi(w.x); lo[2] = bflo(w.y); lo[3] = bfhi(w.y); hi[0] = bflo(w.z); hi[1] = bfhi(w.z); hi[2] = bflo(w.w); hi[3] = bfhi(w.w); }

struct Epi1 {
    static constexpr bool PERM = true;
    bf16* zu; bf16* zga; int cls;
    DEV bool keep(const Unit&) const { return false; }
    DEV void operator()(f32x4 (&acc)[2][2][4][2], const Unit& u, int wr, int wc, int fr, int fq) const {
        const int row0 = u.pm * 256 + wr * 64 + fr, cl = wc * 32 + 8 * fq;
        if (cls) { const int c = (u.pn < 4) ? 1 : (u.pn < 12) ? 2 : (u.pn < 16) ? 4 : 8; if (!(cls & c)) return; }
        if (u.pn < 4) {
#pragma unroll
            for (int ai = 0; ai < 2; ++ai)
#pragma unroll
                for (int m = 0; m < 4; ++m) { const size_t row = (size_t)(row0 + ai * 128 + m * 16);
                    const f32x4 v0 = acc[ai][0][m][0] * sig4(acc[ai][1][m][0]), v1 = acc[ai][0][m][1] * sig4(acc[ai][1][m][1]);
                    *(v4u*)(zu + row * 512 + 128 * u.pn + cl) = pack8(v0, v1); }
        } else {
            bf16* base; int ld, colb; bool sg;
            if (u.pn < 12) { const int ti = (u.pn - 4) >> 1; base = zu + (size_t)(1 + ti) * T * 512; ld = 512; colb = 256 * ((u.pn - 4) & 1); sg = (ti == 3); }
            else { const int ti = (u.pn - 12) >> 2; base = zga + (size_t)ti * T * 1024; ld = 1024; colb = 256 * ((u.pn - 12) & 3); sg = true; }
            if (u.pn >= 12) {
                bf16* fb = base + ((size_t)(u.pm * 4 + ((u.pn - 12) & 3)) * 65536) + (size_t)((wr * 4 + wc) * 64 + fq * 16 + fr) * 8;
#pragma unroll
                for (int ai = 0; ai < 2; ++ai)
#pragma unroll
                    for (int m = 0; m < 4; ++m)
#pragma unroll
                        for (int bj = 0; bj < 2; ++bj) *(v4u*)(fb + (size_t)(((ai * 4 + m) * 2 + bj) * 4096)) = pack8(sig4(acc[ai][bj][m][0]), sig4(acc[ai][bj][m][1]));
            } else
#pragma unroll
            for (int ai = 0; ai < 2; ++ai)
#pragma unroll
                for (int m = 0; m < 4; ++m) { const size_t row = (size_t)(row0 + ai * 128 + m * 16);
#pragma unroll
                    for (int bj = 0; bj < 2; ++bj) { f32x4 v0 = acc[ai][bj][m][0], v1 = acc[ai][bj][m][1]; if (sg) { v0 = sig4(v0); v1 = sig4(v1); }
                        *(v4u*)(base + row * ld + colb + 128 * bj + cl) = pack8(v0, v1); } }
        }
    }
};
struct Epi2 {
    static constexpr bool PERM = true;
    const bf16* zga; const bf16* zgb; bf16* merged;
    DEV bool keep(const Unit& u) const { return u.slot == 0; }
    DEV void operator()(f32x4 (&acc)[2][2][4][2], const Unit& u, int wr, int wc, int fr, int fq) const {
        const int row0 = u.pm * 256 + wr * 64 + fr, c0 = u.pn * 256 + wc * 32 + 8 * fq;
        const size_t fo = ((size_t)(u.pm * 4 + u.pn) * 65536) + (size_t)((wr * 4 + wc) * 64 + fq * 16 + fr) * 8;
#pragma unroll
        for (int ai = 0; ai < 2; ++ai)
#pragma unroll
            for (int m = 0; m < 4; ++m) { const size_t ro = (size_t)(row0 + ai * 128 + m * 16) * 1024 + c0;
#pragma unroll
                for (int bj = 0; bj < 2; ++bj) { const size_t fa = fo + (size_t)(((ai * 4 + m) * 2 + bj) * 4096);
                    f32x4 b0, b1; unpack8(*(const v4u*)(zgb + fa), b0, b1);
                    if (u.slot == 0) { f32x4 a0, a1; unpack8(*(const v4u*)(zga + fa), a0, a1);
#pragma unroll
                        for (int j = 0; j < 4; ++j) { acc[ai][bj][m][0][j] *= a0[j] * __builtin_amdgcn_rcpf(fmaxf(b0[j], 1e-30f)); acc[ai][bj][m][1][j] *= a1[j] * __builtin_amdgcn_rcpf(fmaxf(b1[j], 1e-30f)); }
                    } else { *(v4u*)(merged + ro + 128 * bj) = pack8(acc[ai][bj][m][0] * b0, acc[ai][bj][m][1] * b1); }
                } }
    }
};
struct Epi3 {
    static constexpr bool PERM = true;
    const float* x; const float* mod; float* out;
    DEV bool keep(const Unit&) const { return false; }
    DEV void operator()(f32x4 (&acc)[2][2][4][2], const Unit& u, int wr, int wc, int fr, int fq) const {
        const int row0 = u.pm * 256 + wr * 64 + fr, c0 = u.pn * 256 + wc * 32 + 8 * fq; const int b = u.pm >> 3;
        f32x4 gt[2][2];
#pragma unroll
        for (int bj = 0; bj < 2; ++bj)
#pragma unroll
            for (int n = 0; n < 2; ++n) gt[bj][n] = *(const f32x4*)(mod + b * 6144 + 2048 + c0 + 128 * bj + 4 * n);
#pragma unroll
        for (int ai = 0; ai < 2; ++ai)
#pragma unroll
            for (int m = 0; m < 4; ++m) { const size_t ro = (size_t)(row0 + ai * 128 + m * 16) * 1024 + c0;
#pragma unroll
                for (int bj = 0; bj < 2; ++bj)
#pragma unroll
                    for (int n = 0; n < 2; ++n) { const f32x4 xv = *(const f32x4*)(x + ro + 128 * bj + 4 * n); *(f32x4*)(out + ro + 128 * bj + 4 * n) = xv + gt[bj][n] * acc[ai][bj][m][n]; } }
    }
};
struct EpiUp {
    static constexpr bool PERM = true;
    bf16* act;
    DEV bool keep(const Unit&) const { return false; }
    DEV void operator()(f32x4 (&acc)[2][2][4][2], const Unit& u, int wr, int wc, int fr, int fq) const {
        const int cl = 128 * u.pn + wc * 32 + 8 * fq;
#pragma unroll
        for (int ai = 0; ai < 2; ++ai)
#pragma unroll
            for (int m = 0; m < 4; ++m) { const int rt = ai * 128 + wr * 64 + m * 16 + fr;
                if (rt < u.valid) { f32x4 v0, v1;
#pragma unroll
                    for (int j = 0; j < 4; ++j) { v0[j] = siluf_(acc[ai][0][m][0][j]) * acc[ai][1][m][0][j]; v1[j] = siluf_(acc[ai][0][m][1][j]) * acc[ai][1][m][1][j]; }
                    *(v4u*)(act + (size_t)(u.arow0 + rt) * 512 + cl) = pack8(v0, v1); } }
    }
};
struct EpiDown {
    static constexpr bool PERM = true;
    bf16* ys; const LAS unsigned* desttab; const LAS float* wtab;
    DEV bool keep(const Unit&) const { return false; }
    DEV void operator()(f32x4 (&acc)[2][2][4][2], const Unit& u, int wr, int wc, int fr, int fq) const {
        const int cl = 256 * u.pn + wc * 32 + 8 * fq;
#pragma unroll
        for (int ai = 0; ai < 2; ++ai)
#pragma unroll
            for (int m = 0; m < 4; ++m) { const int rt = ai * 128 + wr * 64 + m * 16 + fr;
                if (rt < u.valid) { const unsigned dest = desttab[u.slot * 256 + rt]; const float w = wtab[u.slot * 256 + rt];
#pragma unroll
                    for (int bj = 0; bj < 2; ++bj) *(v4u*)(ys + (size_t)dest * 1024 + cl + 128 * bj) = pack8(acc[ai][bj][m][0] * w, acc[ai][bj][m][1] * w); } }
    }
};

#define XB_TMO      128
#define XB_XCNT(j)  (256  + 64 * (j))
#define XB_XSUB(j)  (1280 + 64 * (j))
#define XB_XGEN(j)  (2304 + 64 * (j))
#define XB_TOP      3328
#define XB_TOPGEN   3392
#define XCD_BAR_WORDS 3456
#define XB_SPIN_CAP (1u << 18)
__device__ __forceinline__ unsigned xb_ld(unsigned* p)              { return __hip_atomic_load(p, __ATOMIC_RELAXED, __HIP_MEMORY_SCOPE_AGENT); }
__device__ __forceinline__ unsigned xb_add(unsigned* p, unsigned v) { return __hip_atomic_fetch_add(p, v, __ATOMIC_RELAXED, __HIP_MEMORY_SCOPE_AGENT); }
__device__ __forceinline__ unsigned xb_xcc_id() { return (unsigned)__builtin_amdgcn_s_getreg((3 << 11) | 20) & 0xFu; }
#define XB_SPIN(cond, bar) do { unsigned _sp = 0; while (cond) { __builtin_amdgcn_s_sleep(1); \
    if ((++_sp & 255u) == 0u) { if (xb_ld(&(bar)[XB_TMO])) break; if (_sp > XB_SPIN_CAP) { atomicAdd(&(bar)[XB_TMO], 1u); break; } } } } while (0)
struct XcdBarrier { unsigned* bar; unsigned x; volatile LAS unsigned* st; };
__device__ __forceinline__ XcdBarrier xcd_barrier_post(unsigned* bar, volatile LAS unsigned* st) {
    XcdBarrier b; b.bar = bar; b.x = xb_xcc_id(); b.st = st;
    if (threadIdx.x == 0) (void)xb_add(&bar[XB_XCNT(b.x)], 1u);
    return b;
}
__device__ __forceinline__ void xcd_barrier_complete(unsigned* bar, unsigned x, unsigned& nloc, unsigned& nx) {
    const unsigned G = gridDim.x * gridDim.y * gridDim.z;
    unsigned sum, cnt, mine, sp = 0u;
    for (;;) {
        sum = 0u; cnt = 0u; mine = 0u;
#pragma unroll
        for (unsigned j = 0; j < 16; ++j) { const unsigned c = xb_ld(&bar[XB_XCNT(j)]); sum += c; cnt += (c > 0u) ? 1u : 0u; mine = (j == x) ? c : mine; }
        if (sum == G) break;
        __builtin_amdgcn_s_sleep(1);
        if ((++sp & 255u) == 0u) { if (xb_ld(&bar[XB_TMO])) break; if (sp > XB_SPIN_CAP) { atomicAdd(&bar[XB_TMO], 1u); break; } }
    }
    nloc = mine > 0u ? mine : 1u; nx = cnt > 0u ? cnt : 1u;
}
__device__ __forceinline__ void xcd_barrier(const XcdBarrier& b) {
    asm volatile("s_waitcnt vmcnt(0)" ::: "memory");
    __syncthreads();
    if (threadIdx.x == 0) {
        unsigned* bar = b.bar;
        __builtin_amdgcn_s_waitcnt(0);
        unsigned nloc = b.st[0], nx = b.st[1];
        if (nloc == 0u) { xcd_barrier_complete(bar, b.x, nloc, nx); b.st[0] = nloc; b.st[1] = nx; }
        const unsigned old = xb_add(&bar[XB_XSUB(b.x)], 1u);
        const unsigned gen = old / nloc;
        if (old + 1u == (gen + 1u) * nloc) {
            __builtin_amdgcn_fence(__ATOMIC_RELEASE, "agent");
            asm volatile("s_waitcnt vmcnt(0)" ::: "memory");
            const unsigned og = xb_add(&bar[XB_TOP], 1u);
            const unsigned tg = og / nx;
            if (og + 1u == (tg + 1u) * nx) xb_add(&bar[XB_TOPGEN], 1u);
            else XB_SPIN(xb_ld(&bar[XB_TOPGEN]) == tg, bar);
            __builtin_amdgcn_fence(__ATOMIC_ACQUIRE, "agent");
            xb_add(&bar[XB_XGEN(b.x)], 1u);
            asm volatile("s_waitcnt vmcnt(0)" ::: "memory");
        } else {
#if XB_EARLY_ACQ
            __builtin_amdgcn_fence(__ATOMIC_ACQUIRE, "agent");
            XB_SPIN(xb_ld(&bar[XB_XGEN(b.x)]) == gen, bar);
            asm volatile("s_waitcnt vmcnt(0)" ::: "memory");
#else
            XB_SPIN(xb_ld(&bar[XB_XGEN(b.x)]) == gen, bar);
            __builtin_amdgcn_fence(__ATOMIC_ACQUIRE, "agent");
            asm volatile("s_waitcnt vmcnt(0)" ::: "memory");
#endif
        }
    }
    __syncthreads();
}

__device__ __forceinline__ void flat_barrier(unsigned* cnt, unsigned& gen) {
    asm volatile("s_waitcnt vmcnt(0)" ::: "memory");
    __syncthreads();
    ++gen;
    if (threadIdx.x == 0) {
        __builtin_amdgcn_fence(__ATOMIC_RELEASE, "agent");
        asm volatile("s_waitcnt vmcnt(0)" ::: "memory");
        (void)xb_add(cnt, 1u);
        const unsigned want = gen * gridDim.x; unsigned sp = 0;
        while (xb_ld(cnt) < want) { __builtin_amdgcn_s_sleep(1); if (++sp > (1u << 22)) break; }
        __builtin_amdgcn_fence(__ATOMIC_ACQUIRE, "agent");
        asm volatile("s_waitcnt vmcnt(0)" ::: "memory");
    }
    __syncthreads();
}
DEV f32x4 mma16(bf16x8 a, bf16x8 b, f32x4 c) { return __builtin_amdgcn_mfma_f32_16x16x32_bf16(a, b, c, 0, 0, 0); }
DEV void split8(const f32x4 a, const f32x4 b, bf16x8& hi, bf16x8& lo) {
    v4u h, l; const float r[8] = {a[0], a[1], a[2], a[3], b[0], b[1], b[2], b[3]}; unsigned hw[4], lw[4];
#pragma unroll
    for (int i = 0; i < 4; ++i) { hw[i] = pk2(r[2 * i], r[2 * i + 1]); lw[i] = pk2(r[2 * i] - bflo(hw[i]), r[2 * i + 1] - bfhi(hw[i])); }
    h.x = hw[0]; h.y = hw[1]; h.z = hw[2]; h.w = hw[3]; l.x = lw[0]; l.y = lw[1]; l.z = lw[2]; l.w = lw[3];
    hi = __builtin_bit_cast(bf16x8, h); lo = __builtin_bit_cast(bf16x8, l);
}
DEV void transpose_item(const float* src, int ldsrc, bf16* dst, int lddst, LAS float* scr, int lane) {
#pragma unroll 8
    for (int i = 0; i < 32; ++i) { const int kk = 2 * i + (lane >> 5); scr[kk * 33 + (lane & 31)] = src[(size_t)kk * ldsrc + (lane & 31)]; }
    LDS_WAIT(); asm volatile("" ::: "memory");
    const int c = lane & 7;
#pragma unroll
    for (int j = 0; j < 4; ++j) { const int n = (lane >> 3) + 8 * j; const LAS float* s = scr + (8 * c) * 33 + n;
        v4u o; o.x = pk2(s[0 * 33], s[1 * 33]); o.y = pk2(s[2 * 33], s[3 * 33]); o.z = pk2(s[4 * 33], s[5 * 33]); o.w = pk2(s[6 * 33], s[7 * 33]);
        *(v4u*)(dst + (size_t)n * lddst + 8 * c) = o; }
    LDS_WAIT(); asm volatile("" ::: "memory");
}

DEV void router_prep(const Args& a, int gw, int NGW, int lane) {
    const float* mod = (const float*)(a.ws + WS_MOD);
    const float* g2 = a.in[17]; const float* w_rg = a.in[18]; const float* b_rg = a.in[19]; const float* w_re = a.in[20]; const float* b_re = a.in[21];
    float* rbias = (float*)(a.ws + WS_RBIAS); v4u* rw = (v4u*)(a.ws + WS_RW);
    for (int it = gw; it < 8 * 36; it += NGW) { const int b = it / 36, n = it % 36; float sacc = 0.f;
#pragma unroll
        for (int i = 0; i < 16; ++i) { const int k = lane + 64 * i; const float w = (n < 4) ? w_rg[k * 4 + n] : w_re[k * 32 + n - 4]; sacc += mod[b * 6144 + 3072 + k] * w; }
        sacc = wave_sum(sacc);
        if (lane == 0) rbias[b * 48 + n] = sacc + ((n < 4) ? b_rg[n] : b_re[n - 4]); }
    for (int it = gw; it < 8 * 8 * 4 * 3; it += NGW) {
        const int nt = it % 3, kk = (it / 3) & 3, w8 = (it / 12) & 7, b = it / 96;
        const int n = 16 * nt + (lane & 15), k0 = 128 * w8 + 32 * kk + 8 * (lane >> 4);
        f32x4 w0, w1;
#pragma unroll
        for (int j = 0; j < 8; ++j) { const int k = k0 + j; const float* wp = (n < 4) ? (w_rg + k * 4 + n) : (w_re + k * 32 + ((n < 36) ? n - 4 : 0));
            float w = *wp; w = (n < 36) ? w : 0.f;
            w *= g2[k] * (1.f + mod[b * 6144 + 4096 + k]); if (j < 4) w0[j] = w; else w1[j - 4] = w; }
        bf16x8 hi, lo; split8(w0, w1, hi, lo);
        rw[((size_t)it * 2) * 64 + lane] = __builtin_bit_cast(v4u, hi); rw[((size_t)it * 2 + 1) * 64 + lane] = __builtin_bit_cast(v4u, lo);
    }
}
DEV void wait_mod(const Args& a, int tid) {
    if (tid == 0) {
        unsigned* mc = (unsigned*)(a.ws + WS_CTL) + CW_MODCNT; unsigned sp = 0;
        while (__hip_atomic_load(mc, __ATOMIC_RELAXED, __HIP_MEMORY_SCOPE_AGENT) < 192u) { __builtin_amdgcn_s_sleep(2); if (++sp > (1u << 22)) break; }
        __builtin_amdgcn_fence(__ATOMIC_ACQUIRE, "agent"); asm volatile("s_waitcnt vmcnt(0)" ::: "memory"); }
    __syncthreads();
}
DEV void p0_prologue(const Args& a, LAS unsigned char* lds, int bid, int G) {
    int tid = threadIdx.x; asm volatile("" : "+v"(tid));
    const int lane = tid & 63, wave = __builtin_amdgcn_readfirstlane(tid >> 6);
    const float* c = a.in[1]; const float* w_ada = a.in[2]; const float* b_ada = a.in[3];
    float* mod = (float*)(a.ws + WS_MOD);
    if (bid < 192) {
        LAS float* sil = (LAS float*)lds;
        LAS float* red = (LAS float*)(lds + 32768);
        for (int i = tid; i < 8192; i += NTHREADS) sil[i] = siluf_(c[i]);
        __syncthreads();
        for (int item = bid; item < 192; item += G) {
            const int n0 = item * 32, lg = lane >> 3, cq = lane & 7;
            float acc[8][4];
#pragma unroll
            for (int b = 0; b < 8; ++b)
#pragma unroll
                for (int j = 0; j < 4; ++j) acc[b][j] = 0.f;
#pragma unroll 4
            for (int j = 0; j < 16; ++j) { const int k = wave * 128 + j * 8 + lg; const f32x4 w = *(const f32x4*)(w_ada + (size_t)k * 6144 + n0 + cq * 4);
#pragma unroll
                for (int b = 0; b < 8; ++b) { const float s = sil[b * 1024 + k]; acc[b][0] += s * w[0]; acc[b][1] += s * w[1]; acc[b][2] += s * w[2]; acc[b][3] += s * w[3]; } }
#pragma unroll
            for (int b = 0; b < 8; ++b)
#pragma unroll
                for (int j = 0; j < 4; ++j) { float v = acc[b][j]; v += dpp0<0x128>(v); if ((lane & 8) == 0) red[(wave * 4 + (lane >> 4)) * 256 + b * 32 + cq * 4 + j] = v; }
            __syncthreads();
            if (tid < 256) { float s = 0.f;
#pragma unroll
                for (int w = 0; w < 32; ++w) s += red[w * 256 + tid];
                const int b = tid >> 5, col = tid & 31; mod[b * 6144 + n0 + col] = s + b_ada[n0 + col]; }
            asm volatile("s_waitcnt vmcnt(0)" ::: "memory");
            __syncthreads();
            if (tid == 0) { __builtin_amdgcn_fence(__ATOMIC_RELEASE, "agent"); asm volatile("s_waitcnt vmcnt(0)" ::: "memory");
                __hip_atomic_fetch_add((unsigned*)(a.ws + WS_CTL) + CW_MODCNT, 1u, __ATOMIC_RELAXED, __HIP_MEMORY_SCOPE_AGENT); }
        }
    }
    if (bid == G - 1) { const float* w_in0 = a.in[5]; float* wif = (float*)(a.ws + WS_WIF);
        for (int i = tid; i < 2048; i += NTHREADS) { const int k = i >> 1, hf = i & 1; *(f32x4*)(wif + k * 8 + 4 * hf) = *(const f32x4*)(w_in0 + (size_t)k * DIN + 3072 + 4 * hf); } }
    LAS float* scr = (LAS float*)(lds + wave * 16384);
    const int gw = bid * NWAVES + wave, NGW = G * NWAVES;
    const float* w_in = a.in[5]; const float* wco = a.in[11]; const float* wmo = a.in[15]; const float* wout = a.in[16];
    bf16* W1T = (bf16*)(a.ws + WS_W1T); bf16* W2T = (bf16*)(a.ws + WS_W2T); bf16* W3T = (bf16*)(a.ws + WS_W3T);
    constexpr int I1 = 16 * 160, I2 = 8 * 32, I3 = 16 * 32, NIT = I1 + 2 * I2 + I3;
    for (int it = gw; it < NIT; it += NGW) {
        int r = it;
        if (r < I1) { const int kb = r / 160, nb = r % 160, np = 32 * nb; int sc;
            if (np < 1024) { const int t = np >> 8, q = np & 255; sc = (q < 128) ? 128 * t + q : 512 + 128 * t + q - 128; } else if (np < 3072) sc = np; else sc = np + 8;
            transpose_item(w_in + (size_t)(64 * kb) * DIN + sc, DIN, W1T + (size_t)np * 1024 + 64 * kb, 1024, scr, lane); continue; }
        r -= I1;
        if (r < I2) { const int kb = r / 32, nb = r % 32; transpose_item(wco + (size_t)(64 * kb) * 1024 + 32 * nb, 1024, W2T + (size_t)(32 * nb) * 1024 + 64 * kb, 1024, scr, lane); continue; }
        r -= I2;
        if (r < I2) { const int kb = r / 32, nb = r % 32; transpose_item(wmo + (size_t)(64 * kb) * 1024 + 32 * nb, 1024, W2T + (size_t)(32 * nb) * 1024 + 512 + 64 * kb, 1024, scr, lane); continue; }
        r -= I2;
        { const int kb = r / 32, nb = r % 32; transpose_item(wout + (size_t)(64 * kb) * 1024 + 32 * nb, 1024, W3T + (size_t)(32 * nb) * 1024 + 64 * kb, 1024, scr, lane); }
    }
    if (G > 192 && bid >= 192) { wait_mod(a, tid); router_prep(a, (bid - 192) * NWAVES + wave, (G - 192) * NWAVES, lane); }
}

DEV void p1_h1(const Args& a, LAS unsigned char* lds, int bid, int G) {
    int tid = threadIdx.x; asm volatile("" : "+v"(tid));
    const int lane = tid & 63, wave = __builtin_amdgcn_readfirstlane(tid >> 6);
    if (tid == 0) {
        unsigned* mc = (unsigned*)(a.ws + WS_CTL) + CW_MODCNT; unsigned sp = 0;
        while (__hip_atomic_load(mc, __ATOMIC_RELAXED, __HIP_MEMORY_SCOPE_AGENT) < 192u) { __builtin_amdgcn_s_sleep(2); if (++sp > (1u << 22)) break; }
        __builtin_amdgcn_fence(__ATOMIC_ACQUIRE, "agent"); asm volatile("s_waitcnt vmcnt(0)" ::: "memory"); }
    __syncthreads();
    const float* x = a.in[0]; const float* g1 = a.in[4]; const float* w_in = a.in[5]; const float* b_if = a.in[6];
    const float* mod = (const float*)(a.ws + WS_MOD); bf16* h1 = (bf16*)(a.ws + WS_H); float* gates = (float*)(a.ws + WS_GATES);
    LAS float* tab = (LAS float*)lds;
    for (int k = tid; k < 1024; k += NTHREADS) { const int p = ((k >> 8) << 2) | (k & 3), l = (k >> 2) & 63;
        const f32x4 w0 = *(const f32x4*)(w_in + (size_t)k * DIN + 3072), w1 = *(const f32x4*)(w_in + (size_t)k * DIN + 3076);
        *(LAS f32x4*)(tab + (p * 64 + l) * 8) = w0; *(LAS f32x4*)(tab + (p * 64 + l) * 8 + 4) = w1; }
    __syncthreads();
    if (G <= 192) router_prep(a, bid * NWAVES + wave, G * NWAVES, lane);
    const float bifv = b_if[lane & 7];
    for (int tile = bid; tile < T / 64; tile += G) {
        const int b = tile / 32;
        float sc[4][4], sh[4][4];
#pragma unroll
        for (int j = 0; j < 4; ++j) { const int k = 256 * j + 4 * lane; const f32x4 gv = *(const f32x4*)(g1 + k), sv = *(const f32x4*)(mod + b * 6144 + 1024 + k), hv = *(const f32x4*)(mod + b * 6144 + k);
#pragma unroll
            for (int i = 0; i < 4; ++i) { sc[j][i] = gv[i] * (1.f + sv[i]); sh[j][i] = hv[i]; } }
        f32x4 xr[2][4];
#pragma unroll
        for (int p = 0; p < 2; ++p)
#pragma unroll
            for (int j = 0; j < 4; ++j) xr[p][j] = *(const f32x4*)(x + ((size_t)tile * 64 + wave + 8 * p) * 1024 + 256 * j + 4 * lane);
#pragma unroll 1
        for (int gq = 0; gq < 4; ++gq) {
            float rstd[2];
#pragma unroll
            for (int p = 0; p < 2; ++p) { float ss = 0.f;
#pragma unroll
                for (int j = 0; j < 4; ++j) { const f32x4 v = xr[p][j]; ss += (v[0] * v[0] + v[1] * v[1]) + (v[2] * v[2] + v[3] * v[3]); }
                rstd[p] = rsqrtf(wave_sum(ss) * (1.f / 1024.f) + RMS_EPS); }
            float g[2][8];
#pragma unroll
            for (int p = 0; p < 2; ++p)
#pragma unroll
                for (int q = 0; q < 8; ++q) g[p][q] = 0.f;
#pragma unroll
            for (int j = 0; j < 4; ++j) {
                float hh[2][4];
#pragma unroll
                for (int p = 0; p < 2; ++p) { const f32x4 v = xr[p][j]; const size_t row = (size_t)tile * 64 + wave + 8 * (2 * gq + p);
#pragma unroll
                    for (int i = 0; i < 4; ++i) hh[p][i] = v[i] * rstd[p] * sc[j][i] + sh[j][i];
                    if (gq < 3) xr[p][j] = *(const f32x4*)(x + (row + 16) * 1024 + 256 * j + 4 * lane);
                    v2u o; o.x = pk2(hh[p][0], hh[p][1]); o.y = pk2(hh[p][2], hh[p][3]);
                    *(v2u*)(h1 + row * 1024 + 256 * j + 4 * lane) = o; }
#pragma unroll
                for (int i = 0; i < 4; ++i) { const LAS float* tp = tab + ((4 * j + i) * 64 + lane) * 8; const f32x4 w0 = *(const LAS f32x4*)tp, w1 = *(const LAS f32x4*)(tp + 4);
#pragma unroll
                    for (int p = 0; p < 2; ++p) { const float hv = hh[p][i];
                        g[p][0] += hv * w0[0]; g[p][1] += hv * w0[1]; g[p][2] += hv * w0[2]; g[p][3] += hv * w0[3]; g[p][4] += hv * w1[0]; g[p][5] += hv * w1[1]; g[p][6] += hv * w1[2]; g[p][7] += hv * w1[3]; } }
                asm volatile("" ::: "memory");
            }
#pragma unroll
            for (int p = 0; p < 2; ++p) { const size_t row = (size_t)tile * 64 + wave + 8 * (2 * gq + p); float mine = 0.f;
#pragma unroll
                for (int q = 0; q < 8; ++q) { const float sq = wave_sum(g[p][q]); mine = (lane == q) ? sq : mine; }
                if (lane < 8) { const float vv = mine + bifv; gates[row * 8 + lane] = (lane < 4) ? vv : logsigmoidf_(vv); } }
        }
    }
}

DEV void p1_h1_mfma(const Args& a, LAS unsigned char* lds, int bid, int G) {
    int tid = threadIdx.x; asm volatile("" : "+v"(tid));
    const int lane = tid & 63, wave = __builtin_amdgcn_readfirstlane(tid >> 6), l15 = lane & 15, q4 = lane >> 4;
    if (tid == 0) {
        unsigned* mc = (unsigned*)(a.ws + WS_CTL) + CW_MODCNT; unsigned sp = 0;
        while (__hip_atomic_load(mc, __ATOMIC_RELAXED, __HIP_MEMORY_SCOPE_AGENT) < 192u) { __builtin_amdgcn_s_sleep(2); if (++sp > (1u << 22)) break; }
        __builtin_amdgcn_fence(__ATOMIC_ACQUIRE, "agent"); asm volatile("s_waitcnt vmcnt(0)" ::: "memory"); }
    __syncthreads();
    const float* x = a.in[0]; const float* g1 = a.in[4]; const float* b_if = a.in[6];
    const float* mod = (const float*)(a.ws + WS_MOD); bf16* h1 = (bf16*)(a.ws + WS_H); float* gates = (float*)(a.ws + WS_GATES);
    LAS float* PL = (LAS float*)lds;
    LAS float* SS = (LAS float*)(lds + 32768);
    LAS float* RS = (LAS float*)(lds + 34816);
    LAS float* GB = (LAS float*)(lds + 35072);
    LAS float* WF = (LAS float*)(lds + 36864);
    { const float* wif = (const float*)(a.ws + WS_WIF); for (int i = tid; i < 2048; i += NTHREADS) *(LAS f32x4*)(WF + 4 * i) = *(const f32x4*)(wif + 4 * i); }
    {
        const float* g2 = a.in[17]; const float* w_rg = a.in[18]; const float* b_rg = a.in[19]; const float* w_re = a.in[20]; const float* b_re = a.in[21];
        float* rbias = (float*)(a.ws + WS_RBIAS); v4u* rw = (v4u*)(a.ws + WS_RW);
        const int gw = bid * NWAVES + wave, NGW = G * NWAVES;
        for (int it = gw; it < 8 * 36; it += NGW) { const int b = it / 36, n = it % 36; float sacc = 0.f;
#pragma unroll
            for (int i = 0; i < 16; ++i) { const int k = lane + 64 * i; const float w = (n < 4) ? w_rg[k * 4 + n] : w_re[k * 32 + n - 4]; sacc += mod[b * 6144 + 3072 + k] * w; }
            sacc = wave_sum(sacc);
            if (lane == 0) rbias[b * 48 + n] = sacc + ((n < 4) ? b_rg[n] : b_re[n - 4]); }
        for (int it = gw; it < 8 * 8 * 4 * 3; it += NGW) {
            const int nt = it % 3, kk = (it / 3) & 3, w8 = (it / 12) & 7, b = it / 96;
            const int n = 16 * nt + (lane & 15), k0 = 128 * w8 + 32 * kk + 8 * (lane >> 4);
            f32x4 w0, w1;
#pragma unroll
            for (int j = 0; j < 8; ++j) { const int k = k0 + j; const float* wp = (n < 4) ? (w_rg + k * 4 + n) : (w_re + k * 32 + ((n < 36) ? n - 4 : 0));
                float w = *wp; w = (n < 36) ? w : 0.f;
                w *= g2[k] * (1.f + mod[b * 6144 + 4096 + k]); if (j < 4) w0[j] = w; else w1[j - 4] = w; }
            bf16x8 hi, lo; split8(w0, w1, hi, lo);
            rw[((size_t)it * 2) * 64 + lane] = __builtin_bit_cast(v4u, hi); rw[((size_t)it * 2 + 1) * 64 + lane] = __builtin_bit_cast(v4u, lo);
        }
    }
    for (int tile = bid; tile < T / 64; tile += G) {
        const int b = tile / 32, ncol = (l15 < 8) ? l15 : 0;
        __syncthreads();
        {
            float sacc = 0.f;
#pragma unroll
            for (int i = 0; i < 16; ++i) { const int k = lane + 64 * i; sacc += mod[b * 6144 + k] * WF[k * 8 + wave]; }
            sacc = wave_sum(sacc);
            if (lane == 0) GB[wave] = sacc + b_if[wave];
        }
        f32x4 acc[4]; float ss[4];
#pragma unroll
        for (int rt = 0; rt < 4; ++rt) { ss[rt] = 0.f; acc[rt] = (f32x4){0.f, 0.f, 0.f, 0.f}; }
#pragma unroll
        for (int kk = 0; kk < 4; ++kk) {
            const int k0 = 128 * wave + 32 * kk + 8 * q4;
            bf16x8 bhi, blo;
            { const f32x4 ga = *(const f32x4*)(g1 + k0), gb = *(const f32x4*)(g1 + k0 + 4), sa = *(const f32x4*)(mod + b * 6144 + 1024 + k0), sb = *(const f32x4*)(mod + b * 6144 + 1024 + k0 + 4);
                f32x4 w0, w1;
#pragma unroll
                for (int jj = 0; jj < 4; ++jj) { float wa = WF[(k0 + jj) * 8 + ncol], wb = WF[(k0 + 4 + jj) * 8 + ncol];
                    wa = (l15 < 8) ? wa : 0.f; wb = (l15 < 8) ? wb : 0.f; w0[jj] = wa * ga[jj] * (1.f + sa[jj]); w1[jj] = wb * gb[jj] * (1.f + sb[jj]); }
                split8(w0, w1, bhi, blo); }
#pragma unroll
            for (int rt = 0; rt < 4; ++rt) {
                const float* xp = x + ((size_t)tile * 64 + 16 * rt + l15) * 1024 + k0;
                const f32x4 xa = *(const f32x4*)xp, xb = *(const f32x4*)(xp + 4);
                ss[rt] += (xa[0] * xa[0] + xa[1] * xa[1]) + (xa[2] * xa[2] + xa[3] * xa[3]) + (xb[0] * xb[0] + xb[1] * xb[1]) + (xb[2] * xb[2] + xb[3] * xb[3]);
                bf16x8 ahi, alo; split8(xa, xb, ahi, alo);
                acc[rt] = mma16(ahi, bhi, acc[rt]); acc[rt] = mma16(alo, bhi, acc[rt]); acc[rt] = mma16(ahi, blo, acc[rt]);
            }
        }
#pragma unroll
        for (int rt = 0; rt < 4; ++rt) {
            float sv = ss[rt]; sv += __shfl_xor(sv, 16); sv += __shfl_xor(sv, 32);
            if (q4 == 0) SS[wave * 64 + 16 * rt + l15] = sv;
#pragma unroll
            for (int r = 0; r < 4; ++r) PL[(wave * 64 + 16 * rt + 4 * q4 + r) * 16 + l15] = acc[rt][r];
        }
        __syncthreads();
        {
            const int row = tid >> 3, n = tid & 7; float ssum = 0.f, sg = 0.f;
#pragma unroll
            for (int w = 0; w < 8; ++w) { ssum += SS[w * 64 + row]; sg += PL[(w * 64 + row) * 16 + n]; }
            const float rstd = rsqrtf(ssum * (1.f / 1024.f) + RMS_EPS);
            if (n == 0) RS[row] = rstd;
            const float vv = rstd * sg + GB[n];
            gates[((size_t)tile * 64 + row) * 8 + n] = (n < 4) ? vv : logsigmoidf_(vv);
        }
        __syncthreads();
        {
            float sc[4][4], sh[4][4];
#pragma unroll
            for (int j = 0; j < 4; ++j) { const int k = 256 * j + 4 * lane; const f32x4 gv = *(const f32x4*)(g1 + k), sv = *(const f32x4*)(mod + b * 6144 + 1024 + k), hv = *(const f32x4*)(mod + b * 6144 + k);
#pragma unroll
                for (int i = 0; i < 4; ++i) { sc[j][i] = gv[i] * (1.f + sv[i]); sh[j][i] = hv[i]; } }
            f32x4 nx[4][4];
#pragma unroll
            for (int p = 0; p < 4; ++p)
#pragma unroll
                for (int j = 0; j < 4; ++j) nx[p][j] = *(const f32x4*)(x + ((size_t)tile * 64 + wave + 8 * p) * 1024 + 256 * j + 4 * lane);
#pragma unroll
            for (int r8 = 0; r8 < 8; ++r8) {
                const int r = wave + 8 * r8; const size_t row = (size_t)tile * 64 + r;
                f32x4 v[4];
#pragma unroll
                for (int j = 0; j < 4; ++j) v[j] = nx[r8 & 3][j];
                if (r8 + 4 < 8) {
#pragma unroll
                    for (int j = 0; j < 4; ++j) nx[r8 & 3][j] = *(const f32x4*)(x + (row + 32) * 1024 + 256 * j + 4 * lane); }
                asm volatile("" ::: "memory");
                const float rstd = RS[r];
#pragma unroll
                for (int j = 0; j < 4; ++j) { v2u o; o.x = pk2(v[j][0] * rstd * sc[j][0] + sh[j][0], v[j][1] * rstd * sc[j][1] + sh[j][1]); o.y = pk2(v[j][2] * rstd * sc[j][2] + sh[j][2], v[j][3] * rstd * sc[j][3] + sh[j][3]);
                    *(v2u*)(h1 + row * 1024 + 256 * j + 4 * lane) = o; }
            }
        }
    }
    __syncthreads();
}

DEV void p3_conva(const Args& a, LAS unsigned char* lds, int bid, int G) {
    int tid = threadIdx.x; asm volatile("" : "+v"(tid));
    const int lane = tid & 63, wave = __builtin_amdgcn_readfirstlane(tid >> 6), sub = wave & 3, gsel = wave >> 2;
    const bf16* zu = (const bf16*)(a.ws + WS_ZU); bf16* uahm = (bf16*)(a.ws + WS_UAHM);
    const float* cw = a.in[7]; const float* cb = a.in[8]; const float* lg = a.in[9]; const float* lb = a.in[10];
    LAS float* red = (LAS float*)(lds + LDS_TAB);
    const int c0 = 128 * sub + 2 * lane;
    float w0[31], w1[31];
#pragma unroll
    for (int k = 0; k < 31; ++k) { w0[k] = cw[k * 512 + c0]; w1[k] = cw[k * 512 + c0 + 1]; }
    const float bias0 = cb[c0], bias1 = cb[c0 + 1], lg0 = lg[c0], lg1 = lg[c0 + 1], lb0 = lb[c0], lb1 = lb[c0 + 1];
    for (int it = bid; it < T / 32; it += G) {
        const int grp = it * 2 + gsel, tbase = grp * 16, s0 = tbase & (SEQ - 1);
        float acc0[16], acc1[16];
#pragma unroll
        for (int i = 0; i < 16; ++i) { acc0[i] = bias0; acc1[i] = bias1; }
#pragma unroll
        for (int r = 0; r < 46; ++r) {
            const int sp = s0 - 30 + r; const int src = tbase - 30 + r + ((sp < 0) ? -sp : 0); const float msk = (sp < 0) ? 0.f : 1.f;
            const unsigned wv = *(const unsigned*)(zu + (size_t)src * 512 + c0);
            const float u0 = bflo(wv) * msk, u1 = bfhi(wv) * msk;
#pragma unroll
            for (int i = 0; i < 16; ++i) { const int k = r - i; if (k >= 0 && k <= 30) { acc0[i] += w0[k] * u0; acc1[i] += w1[k] * u1; } }
        }
        float mean[16];
#pragma unroll
        for (int i = 0; i < 16; ++i) { const float s = wave_sum(acc0[i] + acc1[i]); if (lane == 0) red[(gsel * 4 + sub) * 16 + i] = s; }
        __syncthreads();
#pragma unroll
        for (int i = 0; i < 16; ++i) mean[i] = ((red[(gsel * 4 + 0) * 16 + i] + red[(gsel * 4 + 1) * 16 + i]) + (red[(gsel * 4 + 2) * 16 + i] + red[(gsel * 4 + 3) * 16 + i])) * (1.f / 512.f);
        __syncthreads();
#pragma unroll
        for (int i = 0; i < 16; ++i) { const float d0 = acc0[i] - mean[i], d1 = acc1[i] - mean[i]; const float s = wave_sum(d0 * d0 + d1 * d1); if (lane == 0) red[(gsel * 4 + sub) * 16 + i] = s; }
        __syncthreads();
#pragma unroll
        for (int i = 0; i < 16; ++i) {
            const float var = ((red[(gsel * 4 + 0) * 16 + i] + red[(gsel * 4 + 1) * 16 + i]) + (red[(gsel * 4 + 2) * 16 + i] + red[(gsel * 4 + 3) * 16 + i])) * (1.f / 512.f);
            const float rstd = rsqrtf(var + LN_EPS);
            const float y0 = (acc0[i] - mean[i]) * rstd * lg0 + lb0, y1 = (acc1[i] - mean[i]) * rstd * lg1 + lb1;
            *(unsigned*)(uahm + (size_t)(tbase + i) * 1024 + c0) = pk2(siluf_(y0), siluf_(y1));
        }
        __syncthreads();
    }
}

constexpr int ML_QS = 0, ML_KS = 17408, ML_KWT = 34816, ML_VT = 53248, ML_PS = 73984, ML_CT = 83200, ML_GT = 122368, ML_CW = 123648, ML_DEN = 128768, ML_PART = 129024, ML_VS = 130048;
template <bool OUT>
DEV void mlstm_unit(const Args& a, LAS unsigned char* lds, int unit) {
    int tid = threadIdx.x; asm volatile("" : "+v"(tid));
    const int lane = tid & 63, wave = __builtin_amdgcn_readfirstlane(tid >> 6), l15 = lane & 15, q4 = lane >> 4;
    const int j = unit & 7, bh = unit >> 3, h = bh & 3, b = bh >> 2, t0 = b * SEQ + 256 * j;
    const bf16* zq = (const bf16*)(a.ws + WS_ZQ); const bf16* zk = (const bf16*)(a.ws + WS_ZK); const bf16* zv = (const bf16*)(a.ws + WS_ZV); const bf16* zo = (const bf16*)(a.ws + WS_ZO);
    const float* gates = (const float*)(a.ws + WS_GATES); v2u* stateh = (v2u*)(a.ws + WS_STATE); float* stsc = (float*)(a.ws + WS_STSC);
    bf16* uahm = (bf16*)(a.ws + WS_UAHM); const float* qkw = a.in[12]; const float* qkb = a.in[13]; const float* mng = a.in[14];
    LAS bf16* QS = (LAS bf16*)(lds + ML_QS); LAS bf16* KS = (LAS bf16*)(lds + ML_KS); LAS bf16* KWT = (LAS bf16*)(lds + ML_KWT); LAS bf16* VT = (LAS bf16*)(lds + ML_VT);
    LAS bf16* PS = (LAS bf16*)(lds + ML_PS); LAS bf16* CT = (LAS bf16*)(lds + ML_CT); LAS bf16* VS = (LAS bf16*)(lds + ML_VS);
    LAS float* GTwk = (LAS float*)(lds + ML_GT); LAS float* GTsi = GTwk + 64; LAS float* GTlb = GTwk + 128; LAS float* GTg = GTwk + 192; LAS float* GTM = GTwk + 256;
    LAS float* CW = (LAS float*)(lds + ML_CW); LAS float* DEN = (LAS float*)(lds + ML_DEN); LAS float* PART = (LAS float*)(lds + ML_PART);
    __syncthreads();
    for (int i = tid; i < 1280; i += NTHREADS) {
        const float* p = (i < 512) ? (qkw + (i >> 7) * 1024 + h * 128 + (i & 127)) : (i < 1024) ? (qkw + ((i - 512) >> 7) * 1024 + 512 + h * 128 + (i & 127))
                       : (i < 1152) ? (qkb + h * 128 + (i - 1024)) : (qkb + 512 + h * 128 + (i - 1152));
        CW[i] = *p; }
    for (int i = tid; i < 16 * 72; i += NTHREADS) VT[128 * 72 + i] = (i < 64) ? (bf16)0x3F80 : (bf16)0;
    f32x4 accC[9];
#pragma unroll
    for (int i = 0; i < 9; ++i) accC[i] = (f32x4){0.f, 0.f, 0.f, 0.f};
    float mc = OUT ? 0.f : -1e30f, Btot = 0.f;
    if (OUT) {
        float wgt[7];
        {
            const int base = unit - j; float mi[7], Bi[7];
#pragma unroll
            for (int i = 0; i < 7; ++i) { const int u2 = base + ((i < j) ? i : 0); mi[i] = stsc[u2 * 4]; Bi[i] = stsc[u2 * 4 + 1]; }
#pragma unroll
            for (int i = 0; i < 7; ++i) if (i < j) mc = fmaxf(Bi[i] + mc, mi[i]);
            float suf = 0.f;
#pragma unroll
            for (int i = 6; i >= 0; --i) { wgt[i] = (i < j) ? __expf(mi[i] + suf - mc) : 0.f; if (i < j) suf += Bi[i]; }
        }
#pragma unroll
        for (int ii = 0; ii < 9; ++ii) {
            v2u ld[7];
#pragma unroll
            for (int i = 0; i < 7; ++i) { ld[i] = (v2u){0u, 0u}; if (i < j) ld[i] = stateh[((size_t)(unit - j + i) * 9 + ii) * 512 + tid]; }
#pragma unroll
            for (int i = 0; i < 7; ++i) { const f32x4 v = (f32x4){bflo(ld[i].x), bfhi(ld[i].x), bflo(ld[i].y), bfhi(ld[i].y)}; accC[ii] = accC[ii] + v * wgt[i]; }
        }
#pragma unroll
        for (int ii = 0; ii < 9; ++ii)
#pragma unroll
            for (int r = 0; r < 4; ++r) CT[(16 * ii + 4 * q4 + r) * 136 + 16 * wave + l15] = f2bf(accC[ii][r]);
    }
    __syncthreads();
    float li_n = gates[(size_t)(t0 + lane) * 8 + h], lf_n = gates[(size_t)(t0 + lane) * 8 + 4 + h];
    const int ncc = (OUT && (a.flags & 4096)) ? 1 : 4; const bool skipAB = OUT && (a.flags & 16384), skipQ = OUT && (a.flags & 32768);
    for (int cc = 0; cc < ncc; ++cc) {
        const int tc = t0 + 64 * cc;
        const float li = li_n, lf = lf_n;
        if (cc < 3) { li_n = gates[(size_t)(tc + 64 + lane) * 8 + h]; lf_n = gates[(size_t)(tc + 64 + lane) * 8 + 4 + h]; }
        const float bc = wave_scan_add(lf, lane);
        const float g = li - bc;
        const float cm = wave_scan_max(g, lane);
        const float M = fmaxf(mc, cm);
        const float M63 = rdlane(M, 63), blast = rdlane(bc, 63);
        const float wkv = __expf(g - M63), sc = __expf(mc - M63), mnew = blast + M63;
        if (wave == 0) { GTwk[lane] = wkv; GTsi[lane] = __expf(mc - M); GTlb[lane] = __expf(-(bc + M)); GTg[lane] = g; GTM[lane] = M; }
        {
            const int cg = tid & 15, rp = tid >> 4, s0 = 2 * rp;
            v4u kraw[5], qraw[5], vraw[2];
#pragma unroll
            for (int m = 0; m < 5; ++m) { const int spos = 256 * j + 64 * cc + s0 - 3 + m; const bool ok = spos >= 0; const int src = ok ? (tc + s0 - 3 + m) : tc;
                kraw[m] = *(const v4u*)(zk + (size_t)src * 512 + h * 128 + cg * 8); }
#pragma unroll
            for (int rr = 0; rr < 2; ++rr) vraw[rr] = *(const v4u*)(zv + (size_t)(tc + s0 + rr) * 512 + h * 128 + cg * 8);
#define ML_CONV(RAW, WOFF, BOFF, DST, SCALE) do { float ac[2][8]; \
            _Pragma("unroll") for (int e = 0; e < 8; ++e) { ac[0][e] = ac[1][e] = CW[(BOFF) + cg * 8 + e]; } \
            _Pragma("unroll") for (int m = 0; m < 5; ++m) { v4u rw_ = RAW[m]; if (256 * j + 64 * cc + s0 - 3 + m < 0) rw_ = (v4u){0u, 0u, 0u, 0u};     \
                const float xv[8] = {bflo(rw_.x), bfhi(rw_.x), bflo(rw_.y), bfhi(rw_.y), bflo(rw_.z), bfhi(rw_.z), bflo(rw_.w), bfhi(rw_.w)}; \
                _Pragma("unroll") for (int rr = 0; rr < 2; ++rr) { const int tap = m - rr; if (tap >= 0 && tap < 4) { \
                    _Pragma("unroll") for (int e = 0; e < 8; ++e) ac[rr][e] += CW[(WOFF) + tap * 128 + cg * 8 + e] * xv[e]; } } } \
            _Pragma("unroll") for (int rr = 0; rr < 2; ++rr) { v4u o; \
                o.x = pk2(siluf_(ac[rr][0]) * (SCALE), siluf_(ac[rr][1]) * (SCALE)); o.y = pk2(siluf_(ac[rr][2]) * (SCALE), siluf_(ac[rr][3]) * (SCALE)); \
                o.z = pk2(siluf_(ac[rr][4]) * (SCALE), siluf_(ac[rr][5]) * (SCALE)); o.w = pk2(siluf_(ac[rr][6]) * (SCALE), siluf_(ac[rr][7]) * (SCALE)); \
                *(LAS v4u*)((DST) + (s0 + rr) * 136 + cg * 8) = o; } } while (0)
            if (OUT && !skipQ) {
#pragma unroll
                for (int m = 0; m < 5; ++m) { const int spos = 256 * j + 64 * cc + s0 - 3 + m; const int src = (spos >= 0) ? (tc + s0 - 3 + m) : tc; qraw[m] = *(const v4u*)(zq + (size_t)src * 512 + h * 128 + cg * 8); } }
            ML_CONV(kraw, 512, 1152, KS, 1.f);
            asm volatile("" ::: "memory");
            if (OUT && !skipQ) ML_CONV(qraw, 0, 1024, QS, 0.08838834764831845f);
#undef ML_CONV
#pragma unroll
            for (int rr = 0; rr < 2; ++rr) *(LAS v4u*)(VS + (s0 + rr) * 136 + cg * 8) = vraw[rr];
        }
        __syncthreads();
        if (OUT && !skipAB) {
            const int tt = wave >> 1;
#pragma unroll
            for (int si = 0; si < 2; ++si) {
                const int st = 2 * (wave & 1) + si;
                f32x4 sacc = (f32x4){0.f, 0.f, 0.f, 0.f};
                if (st <= tt) {
#pragma unroll
                    for (int kk = 0; kk < 4; ++kk) sacc = mma16(*(const LAS bf16x8*)(QS + (16 * tt + l15) * 136 + 32 * kk + 8 * q4), *(const LAS bf16x8*)(KS + (16 * st + l15) * 136 + 32 * kk + 8 * q4), sacc);
                }
                const int sl = 16 * st + l15; const float gs = GTg[sl];
#pragma unroll
                for (int r = 0; r < 4; ++r) { const int tl = 16 * tt + 4 * q4 + r; const float w = (sl <= tl) ? __expf(gs - GTM[tl]) : 0.f; PS[tl * 72 + sl] = f2bf(sacc[r] * w); }
            }
        }
        {
            const int d = tid & 127, sg = tid >> 7; float kv[16];
#pragma unroll
            for (int i = 0; i < 16; ++i) kv[i] = bf2f(KS[(16 * sg + i) * 136 + d]) * GTwk[16 * sg + i];
            v4u o0, o1;
            o0.x = pk2(kv[0], kv[1]); o0.y = pk2(kv[2], kv[3]); o0.z = pk2(kv[4], kv[5]); o0.w = pk2(kv[6], kv[7]);
            o1.x = pk2(kv[8], kv[9]); o1.y = pk2(kv[10], kv[11]); o1.z = pk2(kv[12], kv[13]); o1.w = pk2(kv[14], kv[15]);
            *(LAS v4u*)(KWT + d * 72 + 16 * sg) = o0; *(LAS v4u*)(KWT + d * 72 + 16 * sg + 8) = o1;
            unsigned vw[8];
#pragma unroll
            for (int i = 0; i < 8; ++i) vw[i] = (unsigned)VS[(16 * sg + 2 * i) * 136 + d] | ((unsigned)VS[(16 * sg + 2 * i + 1) * 136 + d] << 16);
            o0.x = vw[0]; o0.y = vw[1]; o0.z = vw[2]; o0.w = vw[3]; o1.x = vw[4]; o1.y = vw[5]; o1.z = vw[6]; o1.w = vw[7];
            *(LAS v4u*)(VT + d * 72 + 16 * sg) = o0; *(LAS v4u*)(VT + d * 72 + 16 * sg + 8) = o1;
        }
        __syncthreads();
        f32x4 res[5];
        if (OUT && !skipAB) {
            const int tt = wave >> 1, dv0 = 4 * (wave & 1);
            bf16x8 pa[2], qa[4];
#pragma unroll
            for (int kk = 0; kk < 2; ++kk) pa[kk] = *(const LAS bf16x8*)(PS + (16 * tt + l15) * 72 + 32 * kk + 8 * q4);
#pragma unroll
            for (int kk = 0; kk < 4; ++kk) qa[kk] = *(const LAS bf16x8*)(QS + (16 * tt + l15) * 136 + 32 * kk + 8 * q4);
            float si[4];
#pragma unroll
            for (int r = 0; r < 4; ++r) si[r] = GTsi[16 * tt + 4 * q4 + r];
#pragma unroll
            for (int i = 0; i < 5; ++i) {
                const int dvt = (i < 4) ? (dv0 + i) : 8;
                if (i < 4 || (wave & 1) == 0) {
                    f32x4 a1 = (f32x4){0.f, 0.f, 0.f, 0.f}, a2 = (f32x4){0.f, 0.f, 0.f, 0.f};
#pragma unroll
                    for (int kk = 0; kk < 2; ++kk) a1 = mma16(pa[kk], *(const LAS bf16x8*)(VT + (16 * dvt + l15) * 72 + 32 * kk + 8 * q4), a1);
#pragma unroll
                    for (int kk = 0; kk < 4; ++kk) a2 = mma16(qa[kk], *(const LAS bf16x8*)(CT + (16 * dvt + l15) * 136 + 32 * kk + 8 * q4), a2);
#pragma unroll
                    for (int r = 0; r < 4; ++r) res[i][r] = a1[r] + si[r] * a2[r];
                } else res[i] = (f32x4){0.f, 0.f, 0.f, 0.f};
            }
            if ((wave & 1) == 0 && l15 == 0) {
#pragma unroll
                for (int r = 0; r < 4; ++r) DEN[16 * tt + 4 * q4 + r] = res[4][r];
            }
        }
        asm volatile("" ::: "memory");
        {
            bf16x8 kb[2];
#pragma unroll
            for (int kk = 0; kk < 2; ++kk) kb[kk] = *(const LAS bf16x8*)(KWT + (16 * wave + l15) * 72 + 32 * kk + 8 * q4);
#pragma unroll
            for (int i = 0; i < 9; ++i) { accC[i] = accC[i] * sc;
#pragma unroll
                for (int kk = 0; kk < 2; ++kk) accC[i] = mma16(*(const LAS bf16x8*)(VT + (16 * i + l15) * 72 + 32 * kk + 8 * q4), kb[kk], accC[i]); }
        }
        __syncthreads();
        if (OUT && !skipAB) {
            const int tt = wave >> 1;
            float den[4], lbv[4];
#pragma unroll
            for (int r = 0; r < 4; ++r) { den[r] = DEN[16 * tt + 4 * q4 + r]; lbv[r] = GTlb[16 * tt + 4 * q4 + r]; }
#pragma unroll
            for (int r = 0; r < 4; ++r) { const float inv = 1.f / fmaxf(fabsf(den[r]), lbv[r]); float s1 = 0.f, s2 = 0.f;
#pragma unroll
                for (int i = 0; i < 4; ++i) { res[i][r] *= inv; s1 += res[i][r]; s2 += res[i][r] * res[i][r]; }
                s1 = row16_sum(s1); s2 = row16_sum(s2);
                if (l15 == 0) { PART[((16 * tt + 4 * q4 + r) * 2 + (wave & 1)) * 2] = s1; PART[((16 * tt + 4 * q4 + r) * 2 + (wave & 1)) * 2 + 1] = s2; } }
#pragma unroll
            for (int ii = 0; ii < 9; ++ii)
#pragma unroll
                for (int r = 0; r < 4; ++r) CT[(16 * ii + 4 * q4 + r) * 136 + 16 * wave + l15] = f2bf(accC[ii][r]);
            __syncthreads();
            const int os = tid >> 3, ocg = tid & 7; const size_t orow = (size_t)(tc + os);
            const v4u zo0 = *(const v4u*)(zo + orow * 512 + h * 128 + 16 * ocg), zo1 = *(const v4u*)(zo + orow * 512 + h * 128 + 16 * ocg + 8);
            LAS float* YS = (LAS float*)(lds + ML_KWT);
#pragma unroll
            for (int r = 0; r < 4; ++r) { const int tl = 16 * tt + 4 * q4 + r;
                const float s1 = PART[(tl * 2) * 2] + PART[(tl * 2 + 1) * 2], s2 = PART[(tl * 2) * 2 + 1] + PART[(tl * 2 + 1) * 2 + 1];
                const float mean = s1 * (1.f / 128.f), var = fmaxf(s2 * (1.f / 128.f) - mean * mean, 0.f), rstd = rsqrtf(var + LN_EPS);
#pragma unroll
                for (int i = 0; i < 4; ++i) YS[tl * 132 + 16 * (4 * (wave & 1) + i) + l15] = (res[i][r] - mean) * rstd; }
            __syncthreads();
            {
                f32x4 yv[4];
#pragma unroll
                for (int q = 0; q < 4; ++q) yv[q] = *(const LAS f32x4*)(YS + os * 132 + 16 * ocg + 4 * q);
                f32x4 g0, g1, g2, g3; unpack8(zo0, g0, g1); unpack8(zo1, g2, g3);
                { const float* mp = mng + h * 128 + 16 * ocg; g0 = g0 * *(const f32x4*)mp; g1 = g1 * *(const f32x4*)(mp + 4); g2 = g2 * *(const f32x4*)(mp + 8); g3 = g3 * *(const f32x4*)(mp + 12); }
                *(v4u*)(uahm + orow * 1024 + 512 + h * 128 + 16 * ocg) = pack8(yv[0] * g0, yv[1] * g1);
                *(v4u*)(uahm + orow * 1024 + 512 + h * 128 + 16 * ocg + 8) = pack8(yv[2] * g2, yv[3] * g3);
            }
        }
        mc = mnew; Btot += blast;
    }
    if (!OUT) {
#pragma unroll
        for (int ii = 0; ii < 9; ++ii) { v2u pk; pk.x = pk2(accC[ii][0], accC[ii][1]); pk.y = pk2(accC[ii][2], accC[ii][3]); stateh[((size_t)unit * 9 + ii) * 512 + tid] = pk; }
        if (tid == 0) { stsc[unit * 4] = mc; stsc[unit * 4 + 1] = Btot; }
    }
}

DEV void p8_route(const Args& a, LAS unsigned char* lds, int bid, int G) {
    int tid = threadIdx.x; asm volatile("" : "+v"(tid));
    const int lane = tid & 63, wave = __builtin_amdgcn_readfirstlane(tid >> 6), l15 = lane & 15, q4 = lane >> 4;
    const float* x1 = a.out; const float* g2 = a.in[17]; const float* w_rg = a.in[18]; const float* w_re = a.in[20];
    const float* mod = (const float*)(a.ws + WS_MOD); const float* rbias = (const float*)(a.ws + WS_RBIAS); const v4u* rw = (const v4u*)(a.ws + WS_RW); bf16* h2 = (bf16*)(a.ws + WS_H);
    int* toke = (int*)(a.ws + WS_TOKE); float* tokw = (float*)(a.ws + WS_TOKW);
    int* listt = (int*)(a.ws + WS_LISTT); float* listw = (float*)(a.ws + WS_LISTW); unsigned* cnt = (unsigned*)(a.ws + WS_CTL) + CW_CNT;
    LAS float* PL = (LAS float*)lds;
    LAS float* SS = (LAS float*)(lds + 98304);
    LAS float* LG = (LAS float*)(lds + 100352);
    LAS float* RS = (LAS float*)(lds + 109568);
    LAS unsigned* lcnt = (LAS unsigned*)(lds + LDS_MISC + 256);
    LAS unsigned* lbase = lcnt + 32;
    LAS unsigned* lent = lcnt + 64;
    LAS float* lwt = (LAS float*)(lcnt + 192);
    for (int tile = bid; tile < T / 64; tile += G) {
        const int b = tile / 32;
        __syncthreads();
        if (tid < 32) lcnt[tid] = 0u;
        f32x4 acc[4][3]; float ss[4];
#pragma unroll
        for (int rt = 0; rt < 4; ++rt) { ss[rt] = 0.f;
#pragma unroll
            for (int nt = 0; nt < 3; ++nt) acc[rt][nt] = (f32x4){0.f, 0.f, 0.f, 0.f}; }
#pragma unroll 1
        for (int kk = 0; kk < 4; ++kk) {
            const int k0 = 128 * wave + 32 * kk + 8 * q4;
            bf16x8 bhi[3], blo[3];
#pragma unroll
            for (int nt = 0; nt < 3; ++nt) { const size_t it = ((size_t)(b * 8 + wave) * 4 + kk) * 3 + nt;
                bhi[nt] = __builtin_bit_cast(bf16x8, rw[(it * 2) * 64 + lane]); blo[nt] = __builtin_bit_cast(bf16x8, rw[(it * 2 + 1) * 64 + lane]); }
#pragma unroll
            for (int rt = 0; rt < 4; ++rt) {
                const float* xp = x1 + ((size_t)tile * 64 + 16 * rt + l15) * 1024 + k0;
                const f32x4 xa = *(const f32x4*)xp, xb = *(const f32x4*)(xp + 4);
                ss[rt] += (xa[0] * xa[0] + xa[1] * xa[1]) + (xa[2] * xa[2] + xa[3] * xa[3]) + (xb[0] * xb[0] + xb[1] * xb[1]) + (xb[2] * xb[2] + xb[3] * xb[3]);
                bf16x8 ahi, alo; split8(xa, xb, ahi, alo);
#pragma unroll
                for (int nt = 0; nt < 3; ++nt) { acc[rt][nt] = mma16(ahi, bhi[nt], acc[rt][nt]); acc[rt][nt] = mma16(alo, bhi[nt], acc[rt][nt]); acc[rt][nt] = mma16(ahi, blo[nt], acc[rt][nt]); }
            }
        }
#pragma unroll
        for (int rt = 0; rt < 4; ++rt) {
            float sv = ss[rt]; sv += __shfl_xor(sv, 16); sv += __shfl_xor(sv, 32);
            if (q4 == 0) SS[wave * 64 + 16 * rt + l15] = sv;
#pragma unroll
            for (int nt = 0; nt < 3; ++nt)
#pragma unroll
                for (int r = 0; r < 4; ++r) PL[(wave * 64 + 16 * rt + 4 * q4 + r) * 48 + 16 * nt + l15] = acc[rt][nt][r];
        }
        __syncthreads();
        {
            const int row = tid >> 3, part = tid & 7;
            float ssum = 0.f;
#pragma unroll
            for (int w = 0; w < 8; ++w) ssum += SS[w * 64 + row];
            const float rstd = rsqrtf(ssum * (1.f / 1024.f) + RMS_EPS);
            if (part == 0) RS[row] = rstd;
#pragma unroll
            for (int i = 0; i < 5; ++i) { const int n = part + 8 * i; if (n < 36) { float s = 0.f;
#pragma unroll
                    for (int w = 0; w < 8; ++w) s += PL[(w * 64 + row) * 48 + n];
                    LG[row * 36 + n] = rstd * s + rbias[b * 48 + n]; } }
        }
        __syncthreads();
        if (tid < 64) {
            const int r = tid; const size_t row = (size_t)tile * 64 + r;
            float lg[36];
#pragma unroll
            for (int q = 0; q < 36; ++q) lg[q] = LG[r * 36 + q];
            int gs = 0; float gm = lg[0];
#pragma unroll
            for (int q = 1; q < 4; ++q) if (lg[q] > gm) { gm = lg[q]; gs = q; }
            float se = 0.f;
#pragma unroll
            for (int q = 0; q < 4; ++q) se += __expf(lg[q] - gm);
            const float pg = 1.f / se;
            float le[8];
#pragma unroll
            for (int q = 0; q < 8; ++q) { float vsel = lg[4 + q];
#pragma unroll
                for (int gg = 1; gg < 4; ++gg) vsel = (gs == gg) ? lg[4 + 8 * gg + q] : vsel;
                le[q] = vsel; }
            int e0 = 0; float l0 = le[0];
#pragma unroll
            for (int q = 1; q < 8; ++q) if (le[q] > l0) { l0 = le[q]; e0 = q; }
            int e1 = -1; float l1 = -3.0e38f;
#pragma unroll
            for (int q = 0; q < 8; ++q) if (q != e0 && le[q] > l1) { l1 = le[q]; e1 = q; }
            const float rr = __expf(l1 - l0), w0 = pg / (1.f + rr), w1 = pg * rr / (1.f + rr);
#pragma unroll
            for (int sl = 0; sl < 2; ++sl) { const int e = gs * 8 + (sl ? e1 : e0); const float w = sl ? w1 : w0;
                toke[row * 2 + sl] = e; tokw[row * 2 + sl] = w;
                const unsigned lp = __hip_atomic_fetch_add(lcnt + e, 1u, __ATOMIC_RELAXED, __HIP_MEMORY_SCOPE_WORKGROUP);
                lent[r * 2 + sl] = (unsigned)e | (lp << 8); lwt[r * 2 + sl] = w; }
        }
        __syncthreads();
        if (tid < 32 && !(a.flags & 2)) { const unsigned n = lcnt[tid]; lbase[tid] = n ? atomicAdd(cnt + 16 * tid, n) : 0u; }
        {
            float sc[4][4], sh[4][4];
#pragma unroll
            for (int j = 0; j < 4; ++j) { const int k = 256 * j + 4 * lane; const f32x4 gv = *(const f32x4*)(g2 + k), sv = *(const f32x4*)(mod + b * 6144 + 4096 + k), hv = *(const f32x4*)(mod + b * 6144 + 3072 + k);
#pragma unroll
                for (int i = 0; i < 4; ++i) { sc[j][i] = gv[i] * (1.f + sv[i]); sh[j][i] = hv[i]; } }
            f32x4 nx[4];
#pragma unroll
            for (int j = 0; j < 4; ++j) nx[j] = *(const f32x4*)(x1 + ((size_t)tile * 64 + wave) * 1024 + 256 * j + 4 * lane);
#pragma unroll 1
            for (int r = wave; r < 64; r += NWAVES) {
                const size_t row = (size_t)tile * 64 + r; f32x4 v[4];
#pragma unroll
                for (int j = 0; j < 4; ++j) v[j] = nx[j];
                if (r + NWAVES < 64) {
#pragma unroll
                    for (int j = 0; j < 4; ++j) nx[j] = *(const f32x4*)(x1 + (row + NWAVES) * 1024 + 256 * j + 4 * lane); }
                asm volatile("" ::: "memory");
                const float rstd = RS[r];
#pragma unroll
                for (int j = 0; j < 4; ++j) { v2u o; o.x = pk2(v[j][0] * rstd * sc[j][0] + sh[j][0], v[j][1] * rstd * sc[j][1] + sh[j][1]); o.y = pk2(v[j][2] * rstd * sc[j][2] + sh[j][2], v[j][3] * rstd * sc[j][3] + sh[j][3]);
                    *(v2u*)(h2 + row * 1024 + 256 * j + 4 * lane) = o; }
            }
        }
        __syncthreads();
        if (tid < 128 && !(a.flags & 2)) { const unsigned en = lent[tid]; const unsigned e = en & 255u, lp = en >> 8; const unsigned pos = lbase[e] + lp;
            listt[e * 16384 + pos] = (tile * 64 + (tid >> 1)) * 2 + (tid & 1); listw[e * 16384 + pos] = lwt[tid]; }
    }
    __syncthreads();
}
DEV void p8_convert(const Args& a, LAS unsigned char* lds, int bid, int G) {
    int tid = threadIdx.x; asm volatile("" : "+v"(tid));
    const int lane = tid & 63, wave = __builtin_amdgcn_readfirstlane(tid >> 6);
    LAS float* scr = (LAS float*)(lds + wave * 16384);
    const float* wg = a.in[22]; const float* wu = a.in[23]; const float* wd = a.in[24];
    bf16* WGU = (bf16*)(a.ws + WS_WGU); bf16* WD = (bf16*)(a.ws + WS_WD);
    const int gw = bid * NWAVES + wave, NGW = G * NWAVES;
    for (int it = gw; it < 32 * 768; it += NGW) {
        const int e = it / 768; int r = it % 768;
        if (r < 512) { const int up = r >> 8; r &= 255; const int kb = r >> 4, nb = r & 15, n = 32 * nb, np = 256 * (n >> 7) + 128 * up + (n & 127);
            transpose_item((up ? wu : wg) + (size_t)e * 1024 * 512 + (size_t)(64 * kb) * 512 + n, 512, WGU + ((size_t)e * 1024 + np) * 1024 + 64 * kb, 1024, scr, lane); }
        else { r -= 512; const int kb = r >> 5, nb = r & 31;
            transpose_item(wd + (size_t)e * 512 * 1024 + (size_t)(64 * kb) * 1024 + 32 * nb, 1024, WD + ((size_t)e * 1024 + 32 * nb) * 512 + 64 * kb, 512, scr, lane); }
    }
}

struct MoeSched {
    const LAS int* tlist; const LAS int* rstart; const LAS int* ecnt; int U, G, c; unsigned bstride;
    DEV bool next(int i, Unit& u) const {
        const int L = i * G + c; if (L >= U) return false;
        const int ent = tlist[L >> 2]; const int e = ent & 255, rt = ent >> 8; u.pn = L & 3;
        const int left = ecnt[e] - 256 * rt;
        u.pm = 0; u.ak = 0; u.bk = (unsigned)e * bstride; u.slot = i; u.valid = left < 256 ? left : 256; u.arow0 = rstart[e] + 256 * rt; return true;
    }
};
DEV void moe_tables(const Args& a, LAS unsigned char* lds, int bid, int G, MoeSched& S, bool down) {
    int tid = threadIdx.x; asm volatile("" : "+v"(tid));
    LAS int* ti = (LAS int*)(lds + LDS_MISC + 1024); LAS int* rstart = ti, *ecnt = ti + 40, *tlist = ti + 80, *ntl = ti + 260;
    const unsigned* cnt = (const unsigned*)(a.ws + WS_CTL) + CW_CNT;
    const int* listt = (const int*)(a.ws + WS_LISTT); const float* listw = (const float*)(a.ws + WS_LISTW);
    __syncthreads();
    if (tid < 64) {
        const int lane = tid; const int n = (lane < 32) ? (int)__hip_atomic_load(cnt + 16 * (lane & 31), __ATOMIC_RELAXED, __HIP_MEMORY_SCOPE_AGENT) : 0;
        const int ntile = (n + 255) >> 8, nfull = (n + 127) >> 8, ntail = ntile - nfull;
        const int rs = (int)wave_scan_add((float)n, lane) - n, of = (int)wave_scan_add((float)nfull, lane) - nfull, ot = (int)wave_scan_add((float)ntail, lane) - ntail;
        const int totf = (int)rdlane(wave_scan_add((float)nfull, lane), 63), tott = (int)rdlane(wave_scan_add((float)ntail, lane), 63);
        if (lane < 32) { ecnt[lane] = n; rstart[lane] = rs;
            for (int rt = 0; rt < nfull; ++rt) tlist[of + rt] = lane | (rt << 8);
            if (ntail) tlist[totf + ot] = lane | (nfull << 8); }
        if (lane == 32) rstart[32] = rs;
        if (lane == 0) ntl[0] = totf + tott;
    }
    __syncthreads();
    S.tlist = tlist; S.rstart = rstart; S.ecnt = ecnt; S.U = 4 * ntl[0]; S.G = G;
    S.c = (G % 8 == 0) ? (bid % 8) * (G / 8) + bid / 8 : bid;
    LAS unsigned* tab0 = (LAS unsigned*)(lds + LDS_TAB); LAS float* tab1 = (LAS float*)(lds + LDS_TAB + 8192);
    Unit u;
    for (int i = 0; i < 8 && S.next(i, u); ++i) {
        if (tid < 256) { const int e = (int)(u.bk / S.bstride); const int pos = (u.arow0 - rstart[e]) + tid; unsigned v0 = 0u; float v1 = 0.f;
            if (tid < u.valid) { const int tk = listt[e * 16384 + pos]; v0 = down ? (unsigned)tk : (unsigned)(tk >> 1) * 2048u; v1 = listw[e * 16384 + pos]; }
            tab0[i * 256 + tid] = v0; tab1[i * 256 + tid] = v1; }
    }
    __syncthreads();
}

DEV void p11_final(const Args& a, int bid, int G) {
    int tid = threadIdx.x; asm volatile("" : "+v"(tid));
    const int lane = tid & 63, wave = __builtin_amdgcn_readfirstlane(tid >> 6);
    const float* mod = (const float*)(a.ws + WS_MOD); const bf16* ys = (const bf16*)(a.ws + WS_YS); const float* gf = a.in[25]; float* out = a.out;
    float* outw = (a.flags & 65536) ? (float*)(a.ws + WS_WGU) : a.out;
    for (int tile = bid; tile < T / 64; tile += G) {
        const int b = tile / 32;
        f32x4 nx[4], gtv[4], gfv[4]; v2u ny0[4], ny1[4];
#pragma unroll
        for (int j = 0; j < 4; ++j) { const int k = 256 * j + 4 * lane; gtv[j] = *(const f32x4*)(mod + b * 6144 + 5120 + k); gfv[j] = *(const f32x4*)(gf + k); }
#pragma unroll
        for (int j = 0; j < 4; ++j) { const size_t row = (size_t)tile * 64 + wave; const int k = 256 * j + 4 * lane;
            nx[j] = *(const f32x4*)(out + row * 1024 + k); ny0[j] = *(const v2u*)(ys + row * 2048 + k); ny1[j] = *(const v2u*)(ys + row * 2048 + 1024 + k); }
#pragma unroll 1
        for (int r = wave; r < 64; r += NWAVES) {
            const size_t row = (size_t)tile * 64 + r;
            f32x4 v[4]; float ss = 0.f;
#pragma unroll
            for (int j = 0; j < 4; ++j) { const int k = 256 * j + 4 * lane;
                const f32x4 xv = nx[j], gt = gtv[j]; const v2u y0 = ny0[j], y1 = ny1[j];
                v[j][0] = xv[0] + gt[0] * (bflo(y0.x) + bflo(y1.x)); v[j][1] = xv[1] + gt[1] * (bfhi(y0.x) + bfhi(y1.x));
                v[j][2] = xv[2] + gt[2] * (bflo(y0.y) + bflo(y1.y)); v[j][3] = xv[3] + gt[3] * (bfhi(y0.y) + bfhi(y1.y));
                ss += (v[j][0] * v[j][0] + v[j][1] * v[j][1]) + (v[j][2] * v[j][2] + v[j][3] * v[j][3]); }
            if (r + NWAVES < 64) {
#pragma unroll
                for (int j = 0; j < 4; ++j) { const size_t rn = row + NWAVES; const int k = 256 * j + 4 * lane;
                    nx[j] = *(const f32x4*)(out + rn * 1024 + k); ny0[j] = *(const v2u*)(ys + rn * 2048 + k); ny1[j] = *(const v2u*)(ys + rn * 2048 + 1024 + k); } }
            asm volatile("" ::: "memory");
            const float rstd = rsqrtf(wave_sum(ss) * (1.f / 1024.f) + RMS_EPS);
#pragma unroll
            for (int j = 0; j < 4; ++j) { const int k = 256 * j + 4 * lane; *(f32x4*)(outw + row * 1024 + k) = v[j] * rstd * gfv[j]; }
        }
    }
}

constexpr int NPHASE = 11;
template <int LO, int HI>
__global__ void __launch_bounds__(NTHREADS, 2) mk_fwd(Args a) {
    extern __shared__ __attribute__((aligned(16))) unsigned char lds_raw[];
    LAS unsigned char* lds = (LAS unsigned char*)lds_raw;
    const int tid = threadIdx.x, G = gridDim.x, bid = blockIdx.x;
    volatile LAS unsigned* MISC = (volatile LAS unsigned*)(lds + LDS_MISC);
    if (tid < 64) MISC[tid] = 0u;
    __syncthreads();
#if MK_ONE
#if USE_XCD_BARRIER
    XcdBarrier bar = xcd_barrier_post((unsigned*)(a.ws + WS_CTL) + CW_BAR, MISC + 8);
#define GRID_BAR() xcd_barrier(bar)
#else
    unsigned fgen = 0;
#define GRID_BAR() flat_barrier((unsigned*)(a.ws + WS_CTL) + CW_FLATBAR, fgen)
#endif
#else
#define GRID_BAR() do {} while (0)
#endif
    constexpr int lo = LO, hi = HI;
#define IN(k) (lo <= (k) && (k) < hi)
#define BOTH(k) (IN(k) && IN((k) + 1))
    if constexpr (IN(0)) { REPK(0) { p0_prologue(a, lds, bid, G); REPSYNC(); } if constexpr (BOTH(0)) __syncthreads(); }
    if constexpr (IN(1)) { REPK(1) { P1_FN(a, lds, bid, G); REPSYNC(); } if constexpr (BOTH(1)) GRID_BAR(); }
    if constexpr (IN(2)) {
        __syncthreads();
        ProbPlain P{(const bf16*)(a.ws + WS_H), (const bf16*)(a.ws + WS_W1T), 2048u, 2048u};
#if DBG_GATEFIRST
        struct SchedG { pg8::StaticOrder so; DEV bool next(int i, Unit& u) const { if (i >= 2) return false; return so.next(i + 3, u); } } S; S.so.init(T, 5120, G, bid);
#else
        pg8::StaticOrder S; S.init(T, 5120, G, bid);
#endif
        Epi1 E{(bf16*)(a.ws + WS_ZU), (bf16*)(a.ws + WS_ZGA), (a.flags >> 8) & 15};
        REPK(2) pg8::gemm_phase<ProbPlain, Epi1, decltype(S), true>(lds, P, S, E, 1024);
        if constexpr (BOTH(2)) GRID_BAR();
    }
    if constexpr (IN(3)) {
        REPK(3) { for (int u = bid; u < 256; u += G) mlstm_unit<false>(a, lds, u);
        __syncthreads(); }
        REPK(11) { p3_conva(a, lds, bid, G); REPSYNC(); }
        if constexpr (BOTH(3)) GRID_BAR();
    }
    if constexpr (IN(4)) {
        REPK(4) { for (int u = bid; u < 256; u += G) mlstm_unit<true>(a, lds, u); REPSYNC(); }
        if constexpr (BOTH(4)) GRID_BAR();
    }
    if constexpr (IN(5)) {
        __syncthreads();
        struct Sched2 { pg8::StaticOrder so; DEV bool next(int i, Unit& u) const { u.ak = (unsigned)(i & 1) * 1024u; u.bk = u.ak; u.slot = i & 1; u.valid = 256; u.arow0 = 0; return so.tile((i >> 1) * so.G + so.c, u.pm, u.pn); } } S;
        S.so.init(T, 1024, G, bid);
        ProbPlain P{(const bf16*)(a.ws + WS_UAHM), (const bf16*)(a.ws + WS_W2T), 2048u, 2048u};
        Epi2 E{(const bf16*)(a.ws + WS_ZGA), (const bf16*)(a.ws + WS_ZGB), (bf16*)(a.ws + WS_MERGED)};
        REPK(5) pg8::gemm_phase<ProbPlain, Epi2, Sched2, true>(lds, P, S, E, 512);
        if constexpr (BOTH(5)) GRID_BAR();
    }
    if constexpr (IN(6)) {
        __syncthreads();
        ProbPlain P{(const bf16*)(a.ws + WS_MERGED), (const bf16*)(a.ws + WS_W3T), 2048u, 2048u};
        pg8::StaticOrder S; S.init(T, 1024, G, bid);
        Epi3 E{a.in[0], (const float*)(a.ws + WS_MOD), a.out};
        REPK(6) pg8::gemm_phase<ProbPlain, Epi3, pg8::StaticOrder, true>(lds, P, S, E, 1024);
        if constexpr (BOTH(6)) { GRID_BAR(); for (int xb = 0; xb < DBG_XBAR; ++xb) GRID_BAR(); }
    }
    if constexpr (IN(7)) {
        if (!(a.flags & 1)) p8_route(a, lds, bid, G);
        __syncthreads();
        if (!(a.flags & 4)) { p8_convert(a, lds, bid, G); }
        if constexpr (BOTH(7)) GRID_BAR();
    }
    if constexpr (IN(8)) {
        MoeSched S; S.bstride = 1024u * 1024u * 2u;
        moe_tables(a, lds, bid, G, S, false);
        ProbMoeUp P{(const bf16*)(a.ws + WS_H), (const bf16*)(a.ws + WS_WGU), (const LAS unsigned*)(lds + LDS_TAB)};
        EpiUp E{(bf16*)(a.ws + WS_ACT)};
        REPK(8) pg8::gemm_phase<ProbMoeUp, EpiUp, MoeSched, true, true>(lds, P, S, E, 1024);
        if constexpr (BOTH(8)) GRID_BAR();
    }
    if constexpr (IN(9)) {
        MoeSched S; S.bstride = 1024u * 512u * 2u;
        moe_tables(a, lds, bid, G, S, true);
        ProbMoeDown P{(const bf16*)(a.ws + WS_ACT), (const bf16*)(a.ws + WS_WD)};
        EpiDown E{(bf16*)(a.ws + WS_YS), (const LAS unsigned*)(lds + LDS_TAB), (const LAS float*)(lds + LDS_TAB + 8192)};
        REPK(9) pg8::gemm_phase<ProbMoeDown, EpiDown, MoeSched, true, true>(lds, P, S, E, 512);
        if constexpr (BOTH(9)) GRID_BAR();
    }
    if constexpr (IN(10)) { p11_final(a, bid, G); }
#undef IN
#undef BOTH
}

#if NAIVE_MASK
__global__ __launch_bounds__(256) void k_fixw1t(const float* w_in, bf16* W1T) { const size_t i = (size_t)blockIdx.x * 256 + threadIdx.x; const size_t n = i / 1024, k = i % 1024; W1T[(3072 + n) * 1024 + k] = f2bf(w_in[k * 5128 + 3080 + n]); }
DEV float block_sum256(float v, float* red) {
#pragma unroll
    for (int o = 32; o >= 1; o >>= 1) v += __shfl_xor(v, o);
    __syncthreads();
    if ((threadIdx.x & 63) == 0) red[threadIdx.x >> 6] = v;
    __syncthreads();
    return (red[0] + red[1]) + (red[2] + red[3]);
}
__global__ __launch_bounds__(256) void k_mod(const float* c, const float* w_ada, const float* b_ada, float* mod) {
    const int idx = blockIdx.x * 256 + threadIdx.x; const int b = idx / 6144, n = idx % 6144;
    float acc = 0.f;
    for (int k = 0; k < D; ++k) acc += siluf_(c[b * D + k]) * w_ada[(size_t)k * 6144 + n];
    mod[idx] = acc + b_ada[n];
}
__global__ __launch_bounds__(256) void k_h1(const float* x, const float* g1, const float* mod, const float* w_in, const float* b_if, bf16* h1, float* gates) {
    __shared__ float red[4];
    const int t = blockIdx.x, b = t / SEQ, tid = threadIdx.x;
    const float4 xv = ((const float4*)(x + (size_t)t * D))[tid];
    float ss = xv.x * xv.x + xv.y * xv.y + xv.z * xv.z + xv.w * xv.w;
    ss = block_sum256(ss, red);
    const float rstd = rsqrtf(ss * (1.f / D) + RMS_EPS);
    const float* sh = mod + b * 6144, *sc = mod + b * 6144 + 1024;
    float hv[4]; const float xs[4] = {xv.x, xv.y, xv.z, xv.w};
#pragma unroll
    for (int j = 0; j < 4; ++j) { const int k = tid * 4 + j; hv[j] = xs[j] * rstd * g1[k] * (1.f + sc[k]) + sh[k]; }
    ushort4 o; o.x = f2bf(hv[0]); o.y = f2bf(hv[1]); o.z = f2bf(hv[2]); o.w = f2bf(hv[3]);
    ((ushort4*)(h1 + (size_t)t * D))[tid] = o;
    float g[8];
#pragma unroll
    for (int j = 0; j < 8; ++j) g[j] = 0.f;
#pragma unroll
    for (int i = 0; i < 4; ++i) { const float* wr = w_in + (size_t)(tid * 4 + i) * DIN + 3072;
#pragma unroll
        for (int j = 0; j < 8; ++j) g[j] += hv[i] * wr[j]; }
#pragma unroll
    for (int j = 0; j < 8; ++j) g[j] = block_sum256(g[j], red);
    if (tid < 8) { float v = g[0];
#pragma unroll
        for (int j = 1; j < 8; ++j) v = (tid == j) ? g[j] : v;
        v += b_if[tid];
        gates[(size_t)t * 8 + tid] = (tid < 4) ? v : logsigmoidf_(v); }
}
template <class Epi>
__global__ __launch_bounds__(256) void k_ngemm(const bf16* A, int lda, const float* W, int ldw, int N, int K, Epi epi) {
    __shared__ float As[16][68]; __shared__ float Ws[16][68];
    const int tid = threadIdx.x, tx = tid & 15, ty = tid >> 4;
    const int row0 = blockIdx.y * 64, col0 = blockIdx.x * 64;
    float acc[4][4];
#pragma unroll
    for (int i = 0; i < 4; ++i)
#pragma unroll
        for (int j = 0; j < 4; ++j) acc[i][j] = 0.f;
    const int ar = tid >> 2, ak = (tid & 3) * 4;
    const int wk = tid >> 4, wc = (tid & 15) * 4;
    for (int k0 = 0; k0 < K; k0 += 16) {
        const ushort4 av = *(const ushort4*)(A + (size_t)(row0 + ar) * lda + k0 + ak);
        As[ak + 0][ar] = bf2f(av.x); As[ak + 1][ar] = bf2f(av.y); As[ak + 2][ar] = bf2f(av.z); As[ak + 3][ar] = bf2f(av.w);
#pragma unroll
        for (int j = 0; j < 4; ++j) { const int cc = col0 + wc + j; Ws[wk][wc + j] = (cc < N) ? W[(size_t)(k0 + wk) * ldw + cc] : 0.f; }
        __syncthreads();
#pragma unroll
        for (int kk = 0; kk < 16; ++kk) {
            float av2[4], w[4];
#pragma unroll
            for (int i = 0; i < 4; ++i) av2[i] = As[kk][ty * 4 + i];
#pragma unroll
            for (int j = 0; j < 4; ++j) w[j] = Ws[kk][tx * 4 + j];
#pragma unroll
            for (int i = 0; i < 4; ++i)
#pragma unroll
                for (int j = 0; j < 4; ++j) acc[i][j] += av2[i] * w[j];
        }
        __syncthreads();
    }
#pragma unroll
    for (int i = 0; i < 4; ++i)
#pragma unroll
        for (int j = 0; j < 4; ++j) { const int cc = col0 + tx * 4 + j; if (cc < N) epi(row0 + ty * 4 + i, cc, acc[i][j]); }
}
struct NEpi1 {
    float* tmp; bf16 *zq, *zk, *zv, *zo, *zga, *zgb;
    DEV void operator()(int r, int c, float v) const {
        if (c < 1024) tmp[(size_t)r * 1024 + c] = v;
        else if (c < 1536) zq[(size_t)r * 512 + c - 1024] = f2bf(v);
        else if (c < 2048) zk[(size_t)r * 512 + c - 1536] = f2bf(v);
        else if (c < 2560) zv[(size_t)r * 512 + c - 2048] = f2bf(v);
        else if (c < 3072) zo[(size_t)r * 512 + c - 2560] = f2bf(sigmoidf_(v));
        else if (c < 3080) {}
        else if (c < 4104) zga[(size_t)r * 1024 + c - 3080] = f2bf(sigmoidf_(v));
        else zgb[(size_t)r * 1024 + c - 4104] = f2bf(sigmoidf_(v));
    }
};
struct NEpi2a { float* tmp; const bf16* zga; DEV void operator()(int r, int c, float v) const { tmp[(size_t)r * 1024 + c] = v * bf2f(zga[(size_t)r * 1024 + c]); } };
struct NEpi2b { const float* tmp; const bf16* zgb; bf16* merged; DEV void operator()(int r, int c, float v) const { merged[(size_t)r * 1024 + c] = f2bf(tmp[(size_t)r * 1024 + c] + v * bf2f(zgb[(size_t)r * 1024 + c])); } };
struct NEpi3 { const float* x; const float* mod; float* out; DEV void operator()(int r, int c, float v) const { const int b = r / SEQ; out[(size_t)r * 1024 + c] = x[(size_t)r * 1024 + c] + mod[b * 6144 + 2048 + c] * v; } };
__global__ __launch_bounds__(256) void k_glu(const float* tmp, bf16* zu) {
    const size_t i = (size_t)blockIdx.x * 256 + threadIdx.x; const size_t r = i / 512, c = i % 512;
    zu[i] = f2bf(tmp[r * 1024 + c] * sigmoidf_(tmp[r * 1024 + 512 + c]));
}
__global__ __launch_bounds__(256) void k_conva(const bf16* zu, const float* cw, const float* cb, const float* lg, const float* lb, bf16* uahm) {
    __shared__ float red[4];
    const int t = blockIdx.x, s = t % SEQ, tid = threadIdx.x;
    float v[2];
#pragma unroll
    for (int j = 0; j < 2; ++j) { const int c = tid + 256 * j; float a = cb[c];
        for (int k = 0; k < 31; ++k) { const int ss = s - 30 + k; if (ss >= 0) a += cw[k * 512 + c] * bf2f(zu[(size_t)(t - 30 + k) * 512 + c]); }
        v[j] = a; }
    const float mean = block_sum256(v[0] + v[1], red) * (1.f / 512.f);
    const float d0 = v[0] - mean, d1 = v[1] - mean;
    const float var = block_sum256(d0 * d0 + d1 * d1, red) * (1.f / 512.f);
    const float rstd = rsqrtf(var + LN_EPS);
#pragma unroll
    for (int j = 0; j < 2; ++j) { const int c = tid + 256 * j; const float y = (v[j] - mean) * rstd * lg[c] + lb[c]; uahm[(size_t)t * 1024 + c] = f2bf(siluf_(y)); }
}
__global__ __launch_bounds__(256) void k_qkconv(const bf16* zq, const bf16* zk, const float* w, const float* bq, bf16* qc, bf16* kc) {
    const int t = blockIdx.x, s = t % SEQ, tid = threadIdx.x;
#pragma unroll
    for (int j = 0; j < 4; ++j) { const int c = tid + 256 * j; const bf16* src = (c < 512) ? zq : zk; const int cc = c & 511; float a = bq[c];
#pragma unroll
        for (int k = 0; k < 4; ++k) { const int ss = s - 3 + k; if (ss >= 0) a += w[k * 1024 + c] * bf2f(src[(size_t)(t - 3 + k) * 512 + cc]); }
        ((c < 512) ? qc : kc)[(size_t)t * 512 + cc] = f2bf(siluf_(a)); }
}
__global__ __launch_bounds__(256) void k_mlstm_rec(const bf16* qc, const bf16* kc, const bf16* zv, const bf16* zo, const float* gates, const float* mng, bf16* uahm) {
    __shared__ float qs[128], ks[128], vs[128], part[2][128], red[8];
    const int b = blockIdx.x / NH, h = blockIdx.x % NH, tid = threadIdx.x, j = tid & 127, ih = tid >> 7;
    float C[64];
#pragma unroll
    for (int r = 0; r < 64; ++r) C[r] = 0.f;
    float nn = 0.f, m = 0.f;
    for (int s = 0; s < SEQ; ++s) {
        const size_t t = (size_t)b * SEQ + s;
        __syncthreads();
        if (tid < 128) { qs[tid] = bf2f(qc[t * 512 + h * 128 + tid]) * 0.08838834764831845f; ks[tid] = bf2f(kc[t * 512 + h * 128 + tid]); }
        else vs[tid - 128] = bf2f(zv[t * 512 + h * 128 + tid - 128]);
        const float li = gates[t * 8 + h], lf = gates[t * 8 + 4 + h];
        const float mn = fmaxf(lf + m, li), ip = __expf(li - mn), fp = __expf(lf + m - mn); m = mn;
        __syncthreads();
        const float vj = vs[j]; float p = 0.f;
#pragma unroll
        for (int r = 0; r < 64; ++r) { const int i = ih * 64 + r; C[r] = fp * C[r] + ip * ks[i] * vj; p += qs[i] * C[r]; }
        part[ih][j] = p;
        float dn = 0.f;
        if (tid < 128) { nn = fp * nn + ip * ks[tid]; dn = qs[tid] * nn; }
#pragma unroll
        for (int o = 32; o >= 1; o >>= 1) dn += __shfl_xor(dn, o);
        if ((tid & 63) == 0) red[tid >> 6] = dn;
        __syncthreads();
        float hv = 0.f, sm = 0.f;
        if (tid < 128) { const float den = red[0] + red[1]; hv = (part[0][tid] + part[1][tid]) / fmaxf(fabsf(den), __expf(-mn)); sm = hv; }
#pragma unroll
        for (int o = 32; o >= 1; o >>= 1) sm += __shfl_xor(sm, o);
        if ((tid & 63) == 0) red[4 + (tid >> 6)] = sm;
        __syncthreads();
        const float mu = (red[4] + red[5]) * (1.f / 128.f);
        float dv = (tid < 128) ? (hv - mu) : 0.f; float sq = dv * dv;
#pragma unroll
        for (int o = 32; o >= 1; o >>= 1) sq += __shfl_xor(sq, o);
        __syncthreads();
        if ((tid & 63) == 0) red[tid >> 6] = sq;
        __syncthreads();
        if (tid < 128) { const float var = (red[0] + red[1]) * (1.f / 128.f); const float y = dv * rsqrtf(var + LN_EPS) * mng[h * 128 + tid] * bf2f(zo[t * 512 + h * 128 + tid]);
            uahm[t * 1024 + 512 + h * 128 + tid] = f2bf(y); }
    }
}
__global__ __launch_bounds__(256) void k_h2route(const float* x1, const float* g2, const float* mod, const float* w_rg, const float* b_rg, const float* w_re, const float* b_re, bf16* h2, int* toke, float* tokw) {
    __shared__ float red[4]; __shared__ float lg[36];
    const int t = blockIdx.x, b = t / SEQ, tid = threadIdx.x;
    const float4 xv = ((const float4*)(x1 + (size_t)t * D))[tid];
    float ss = xv.x * xv.x + xv.y * xv.y + xv.z * xv.z + xv.w * xv.w;
    ss = block_sum256(ss, red);
    const float rstd = rsqrtf(ss * (1.f / D) + RMS_EPS);
    const float* sh = mod + b * 6144 + 3072, *sc = mod + b * 6144 + 4096;
    float hv[4]; const float xs[4] = {xv.x, xv.y, xv.z, xv.w};
#pragma unroll
    for (int j = 0; j < 4; ++j) { const int k = tid * 4 + j; hv[j] = xs[j] * rstd * g2[k] * (1.f + sc[k]) + sh[k]; }
    ushort4 o; o.x = f2bf(hv[0]); o.y = f2bf(hv[1]); o.z = f2bf(hv[2]); o.w = f2bf(hv[3]);
    ((ushort4*)(h2 + (size_t)t * D))[tid] = o;
    for (int j = 0; j < 36; ++j) {
        float a = 0.f;
#pragma unroll
        for (int i = 0; i < 4; ++i) { const int k = tid * 4 + i; a += hv[i] * ((j < 4) ? w_rg[k * 4 + j] : w_re[k * 32 + j - 4]); }
        a = block_sum256(a, red);
        if (tid == 0) lg[j] = a + ((j < 4) ? b_rg[j] : b_re[j - 4]);
    }
    __syncthreads();
    if (tid == 0) {
        int gs = 0; float gm = lg[0];
        for (int j = 1; j < 4; ++j) if (lg[j] > gm) { gm = lg[j]; gs = j; }
        float se = 0.f; for (int j = 0; j < 4; ++j) se += __expf(lg[j] - gm);
        const float pg = 1.f / se;
        const float* le = lg + 4 + gs * 8;
        int e0 = 0; float l0 = le[0];
        for (int j = 1; j < 8; ++j) if (le[j] > l0) { l0 = le[j]; e0 = j; }
        int e1 = -1; float l1 = -3.0e38f;
        for (int j = 0; j < 8; ++j) if (j != e0 && le[j] > l1) { l1 = le[j]; e1 = j; }
        const float r = __expf(l1 - l0);
        const float w0 = pg / (1.f + r), w1 = pg * r / (1.f + r);
        toke[t * 2] = gs * 8 + e0; toke[t * 2 + 1] = gs * 8 + e1; tokw[t * 2] = w0; tokw[t * 2 + 1] = w1;
    }
}
__global__ __launch_bounds__(256) void k_lists(const int* toke, const float* tokw, unsigned* cnt, int* listt, float* listw) {
    const int i = blockIdx.x * 256 + threadIdx.x; const int e = toke[i]; const unsigned pos = atomicAdd(cnt + 16 * e, 1u);
    listt[e * 16384 + pos] = i; listw[e * 16384 + pos] = tokw[i];
}
__global__ __launch_bounds__(256) void k_moe(const bf16* h2, const int* toke, const float* tokw, const float* wg, const float* wu, const float* wd, bf16* ys) {
    __shared__ float hs[1024]; __shared__ float hid[512];
    const int a = blockIdx.x, t = a >> 1, tid = threadIdx.x;
    const int e = toke[a]; const float w = tokw[a];
    for (int k = tid; k < 1024; k += 256) hs[k] = bf2f(h2[(size_t)t * 1024 + k]);
    __syncthreads();
    const float* Gp = wg + (size_t)e * 1024 * 512, *U = wu + (size_t)e * 1024 * 512, *Dn = wd + (size_t)e * 512 * 1024;
    float g0 = 0.f, g1 = 0.f, u0 = 0.f, u1 = 0.f;
    for (int k = 0; k < 1024; ++k) { const float hk = hs[k]; g0 += hk * Gp[(size_t)k * 512 + tid]; g1 += hk * Gp[(size_t)k * 512 + 256 + tid]; u0 += hk * U[(size_t)k * 512 + tid]; u1 += hk * U[(size_t)k * 512 + 256 + tid]; }
    hid[tid] = siluf_(g0) * u0; hid[tid + 256] = siluf_(g1) * u1;
    __syncthreads();
    float y[4] = {0.f, 0.f, 0.f, 0.f};
    for (int j = 0; j < 512; ++j) { const float hj = hid[j];
#pragma unroll
        for (int i = 0; i < 4; ++i) y[i] += hj * Dn[(size_t)j * 1024 + tid + 256 * i]; }
#pragma unroll
    for (int i = 0; i < 4; ++i) ys[(size_t)a * 1024 + tid + 256 * i] = f2bf(w * y[i]);
}
__global__ __launch_bounds__(256) void k_final(const float* x1, const bf16* ys, const float* mod, const float* gf, float* out) {
    __shared__ float red[4];
    const int t = blockIdx.x, b = t / SEQ, tid = threadIdx.x;
    const float4 xv = ((const float4*)(x1 + (size_t)t * D))[tid];
    const ushort4 y0 = ((const ushort4*)(ys + (size_t)t * 2048))[tid], y1 = ((const ushort4*)(ys + (size_t)t * 2048 + 1024))[tid];
    const float* gt = mod + b * 6144 + 5120 + tid * 4;
    float v[4];
    v[0] = xv.x + gt[0] * (bf2f(y0.x) + bf2f(y1.x)); v[1] = xv.y + gt[1] * (bf2f(y0.y) + bf2f(y1.y));
    v[2] = xv.z + gt[2] * (bf2f(y0.z) + bf2f(y1.z)); v[3] = xv.w + gt[3] * (bf2f(y0.w) + bf2f(y1.w));
    float ss = v[0] * v[0] + v[1] * v[1] + v[2] * v[2] + v[3] * v[3];
    ss = block_sum256(ss, red);
    const float rstd = rsqrtf(ss * (1.f / D) + RMS_EPS);
    float4 o; o.x = v[0] * rstd * gf[tid * 4]; o.y = v[1] * rstd * gf[tid * 4 + 1]; o.z = v[2] * rstd * gf[tid * 4 + 2]; o.w = v[3] * rstd * gf[tid * 4 + 3];
    ((float4*)(out + (size_t)t * D))[tid] = o;
}
#endif


#ifndef DBG_BENCH
#define DBG_BENCH 0
#endif
#if DBG_BENCH
__global__ void __launch_bounds__(512, 2) k_bench_a(const float* x, float* dummy) {
    extern __shared__ __attribute__((aligned(16))) unsigned char lds_b[];
    const int tid = threadIdx.x, lane = tid & 63, wave = tid >> 6, tile = blockIdx.x;
    f32x4 nx[4][4]; float acc = 0.f;
#pragma unroll
    for (int p = 0; p < 4; ++p)
#pragma unroll
        for (int j = 0; j < 4; ++j) nx[p][j] = *(const f32x4*)(x + ((size_t)tile * 64 + wave + 8 * p) * 1024 + 256 * j + 4 * lane);
#pragma unroll
    for (int r8 = 0; r8 < 8; ++r8) {
        const size_t row = (size_t)tile * 64 + wave + 8 * r8;
#pragma unroll
        for (int j = 0; j < 4; ++j) acc += (nx[r8 & 3][j][0] + nx[r8 & 3][j][1]) + (nx[r8 & 3][j][2] + nx[r8 & 3][j][3]);
        if (r8 + 4 < 8) {
#pragma unroll
            for (int j = 0; j < 4; ++j) nx[r8 & 3][j] = *(const f32x4*)(x + (row + 32) * 1024 + 256 * j + 4 * lane); }
    }
    if (acc == 123.456f) dummy[tid] = acc;
}
__global__ void __launch_bounds__(256) k_bench_b(const float* x, float* dummy) {
    const int tid = threadIdx.x, lane = tid & 63, wave = tid >> 6; const size_t row = (size_t)blockIdx.x * 4 + wave; float acc = 0.f;
#pragma unroll
    for (int j = 0; j < 4; ++j) { const f32x4 v = *(const f32x4*)(x + row * 1024 + 256 * j + 4 * lane); acc += (v[0] + v[1]) + (v[2] + v[3]); }
    if (acc == 123.456f) dummy[tid] = acc;
}
#endif
#if DBG_BENCH >= 4
template <int LVL>
__global__ void __launch_bounds__(512, 2) k_bench_d(const float* x, const float* g1, const float* mod, bf16* h1, float* dummy) {
    extern __shared__ __attribute__((aligned(16))) unsigned char lds_b[];
    const int tid = threadIdx.x, lane = tid & 63, wave = tid >> 6, tile = blockIdx.x, b = tile / 32;
    float sc[4][4], sh[4][4];
#pragma unroll
    for (int j = 0; j < 4; ++j) { const int k = 256 * j + 4 * lane; const f32x4 gv = *(const f32x4*)(g1 + k), sv = *(const f32x4*)(mod + b * 6144 + 1024 + k), hv = *(const f32x4*)(mod + b * 6144 + k);
#pragma unroll
        for (int i = 0; i < 4; ++i) { sc[j][i] = gv[i] * (1.f + sv[i]); sh[j][i] = hv[i]; } }
    f32x4 nx[4][4];
#pragma unroll
    for (int p = 0; p < 4; ++p)
#pragma unroll
        for (int j = 0; j < 4; ++j) nx[p][j] = *(const f32x4*)(x + ((size_t)tile * 64 + wave + 8 * p) * 1024 + 256 * j + 4 * lane);
#pragma unroll
    for (int r8 = 0; r8 < 8; ++r8) {
        const size_t row = (size_t)tile * 64 + wave + 8 * r8;
        f32x4 v[4]; float ss = 0.f;
#pragma unroll
        for (int j = 0; j < 4; ++j) { v[j] = nx[r8 & 3][j]; ss += (v[j][0] * v[j][0] + v[j][1] * v[j][1]) + (v[j][2] * v[j][2] + v[j][3] * v[j][3]); }
        if (r8 + 4 < 8) {
#pragma unroll
            for (int j = 0; j < 4; ++j) nx[r8 & 3][j] = *(const f32x4*)(x + (row + 32) * 1024 + 256 * j + 4 * lane); }
        asm volatile("" ::: "memory");
        const float rstd = rsqrtf(wave_sum(ss) * (1.f / 1024.f) + RMS_EPS);
        if (LVL >= 5) {
            float g[8];
#pragma unroll
            for (int q = 0; q < 8; ++q) g[q] = 0.f;
#pragma unroll
            for (int j = 0; j < 4; ++j) { float hh[4];
#pragma unroll
                for (int i = 0; i < 4; ++i) hh[i] = v[j][i] * rstd * sc[j][i] + sh[j][i];
                v2u o; o.x = pk2(hh[0], hh[1]); o.y = pk2(hh[2], hh[3]);
                *(v2u*)(h1 + row * 1024 + 256 * j + 4 * lane) = o;
                if (LVL >= 6) {
#pragma unroll
                    for (int i = 0; i < 4; ++i) { const LAS float* tp = (const LAS float*)lds_b + ((4 * j + i) * 64 + lane) * 8; f32x4 w0, w1;
                        if (LVL == 8) { w0 = (f32x4){1.f, 2.f, 3.f, 4.f}; w1 = (f32x4){5.f, 6.f, 7.f, 8.f}; } else { w0 = *(const LAS f32x4*)tp; w1 = *(const LAS f32x4*)(tp + 4); }
                        g[0] += hh[i] * w0[0]; g[1] += hh[i] * w0[1]; g[2] += hh[i] * w0[2]; g[3] += hh[i] * w0[3]; g[4] += hh[i] * w1[0]; g[5] += hh[i] * w1[1]; g[6] += hh[i] * w1[2]; g[7] += hh[i] * w1[3]; } } }
            if (LVL == 6 || LVL == 8) { const float t = ((g[0] + g[1]) + (g[2] + g[3])) + ((g[4] + g[5]) + (g[6] + g[7])); if (t == 123.456f) dummy[row] = t; }
            if (LVL == 7) { float mine = 0.f;
#pragma unroll
                for (int q = 0; q < 8; ++q) { const float sq = wave_sum(g[q]); mine = (lane == q) ? sq : mine; }
                if (lane < 8) dummy[row * 8 + lane] = (lane < 4) ? mine : logsigmoidf_(mine); }
        } else if (lane == 0) dummy[row] = rstd;
    }
}
#endif
#if DBG_BENCH == 3
__global__ void __launch_bounds__(512, 2) k_bench_c(float* dummy, float seed) {
    extern __shared__ __attribute__((aligned(16))) unsigned char lds_b[];
    float a0 = seed + threadIdx.x, a1 = a0 + 1.f, a2 = a0 + 2.f, a3 = a0 + 3.f; const float m = 1.0000001f, c = 1e-9f;
#pragma unroll 1
    for (int i = 0; i < 2048; ++i) {
#pragma unroll
        for (int j = 0; j < 4; ++j) { a0 = a0 * m + c; a1 = a1 * m + c; a2 = a2 * m + c; a3 = a3 * m + c; }
    }
    if (a0 + a1 + a2 + a3 == 123.456f) dummy[threadIdx.x] = a0;
}
#endif
#if MK_ONE
constexpr int NKERN = 1;
static const void* const mk_kernels[NKERN] = {(const void*)mk_fwd<0, NPHASE>};
#else
constexpr int NKERN = NPHASE;
static const void* const mk_kernels[NKERN] = {(const void*)mk_fwd<0, 1>, (const void*)mk_fwd<1, 2>, (const void*)mk_fwd<2, 3>, (const void*)mk_fwd<3, 4>, (const void*)mk_fwd<4, 5>, (const void*)mk_fwd<5, 6>,
    (const void*)mk_fwd<6, 7>, (const void*)mk_fwd<7, 8>, (const void*)mk_fwd<8, 9>, (const void*)mk_fwd<9, 10>, (const void*)mk_fwd<10, 11>};
#endif
extern "C" void kernel_launch(void* const* d_in, const int* in_sizes, int n_in, void* d_out, int out_size, void* d_ws, size_t ws_size, hipStream_t stream) {
    static int grid = 0;
    if (grid == 0) {
        int dev = 0, cus = 0;
        if (hipGetDevice(&dev) != hipSuccess || hipDeviceGetAttribute(&cus, hipDeviceAttributeMultiprocessorCount, dev) != hipSuccess) { grid = -1; return; }
        for (int k = 0; k < NKERN; ++k) if (hipFuncSetAttribute(mk_kernels[k], hipFuncAttributeMaxDynamicSharedMemorySize, LDS_BYTES) != hipSuccess) { grid = -1; return; }
        int per_cu = 0;
        (void)hipOccupancyMaxActiveBlocksPerMultiprocessor(&per_cu, mk_kernels[0], NTHREADS, LDS_BYTES);
        (void)hipGetLastError();
        grid = (per_cu >= 1) ? cus : -1;
    }
    if (grid < 0) return;
    (void)hipMemsetAsync((char*)d_ws + WS_CTL, 0, CTL_ZERO_BYTES, stream);
    Args a{};
    for (int i = 0; i < 26; ++i) a.in[i] = (const float*)d_in[i];
    a.out = (float*)d_out; a.ws = (unsigned char*)d_ws;
#if MK_ONE
    a.ph_lo = 0; a.ph_hi = NPHASE;
    { void* args[] = {&a}; (void)hipLaunchKernel(mk_kernels[0], dim3(grid), dim3(NTHREADS), args, LDS_BYTES, stream); }
#else
    unsigned char* ws = (unsigned char*)d_ws; float* out = (float*)d_out;
    float* mod = (float*)(ws + WS_MOD); float* gates = (float*)(ws + WS_GATES); int* toke = (int*)(ws + WS_TOKE); float* tokw = (float*)(ws + WS_TOKW);
    bf16* hb = (bf16*)(ws + WS_H); bf16* zu = (bf16*)(ws + WS_ZU); bf16* zq = (bf16*)(ws + WS_ZQ); bf16* zk = (bf16*)(ws + WS_ZK); bf16* zv = (bf16*)(ws + WS_ZV); bf16* zo = (bf16*)(ws + WS_ZO);
    bf16* zga = (bf16*)(ws + WS_ZGA); bf16* zgb = (bf16*)(ws + WS_ZGB); bf16* qc = (bf16*)(ws + WS_QC); bf16* kc = (bf16*)(ws + WS_KC); bf16* uahm = (bf16*)(ws + WS_UAHM);
    bf16* merged = (bf16*)(ws + WS_MERGED); bf16* ys = (bf16*)(ws + WS_YS);
    (void)mod; (void)gates; (void)toke; (void)tokw; (void)hb; (void)zu; (void)zq; (void)zk; (void)zv; (void)zo; (void)zga; (void)zgb; (void)qc; (void)kc; (void)uahm; (void)merged; (void)ys; (void)out;
#ifndef DBG_NPH
#define DBG_NPH NPHASE
#endif
#if DBG_BENCH == 1
    { static bool once = false; if (!once) { (void)hipFuncSetAttribute((const void*)k_bench_a, hipFuncAttributeMaxDynamicSharedMemorySize, LDS_BYTES); once = true; }
      for (int rep = 0; rep < 4; ++rep) hipLaunchKernelGGL(k_bench_a, dim3(256), dim3(512), LDS_BYTES, stream, (const float*)d_in[0], (float*)((char*)d_ws + WS_TOKE)); }
#elif DBG_BENCH >= 4
    { static bool once = false; if (!once) { (void)hipFuncSetAttribute((const void*)k_bench_d<DBG_BENCH>, hipFuncAttributeMaxDynamicSharedMemorySize, LDS_BYTES); once = true; }
      (void)hipMemsetAsync((char*)d_ws + WS_MOD, 0, 256 * 1024, stream);
      for (int rep = 0; rep < 2; ++rep) hipLaunchKernelGGL(k_bench_d<DBG_BENCH>, dim3(256), dim3(512), LDS_BYTES, stream, (const float*)d_in[0], (const float*)d_in[4], (const float*)((char*)d_ws + WS_MOD), (bf16*)((char*)d_ws + WS_H), (float*)((char*)d_ws + WS_TOKE)); }
#elif DBG_BENCH == 3
    { static bool once = false; if (!once) { (void)hipFuncSetAttribute((const void*)k_bench_c, hipFuncAttributeMaxDynamicSharedMemorySize, LDS_BYTES); once = true; }
      for (int rep = 0; rep < 2; ++rep) hipLaunchKernelGGL(k_bench_c, dim3(256), dim3(512), LDS_BYTES, stream, (float*)((char*)d_ws + WS_TOKE), 1.0f); }
#elif DBG_BENCH == 2
    for (int rep = 0; rep < 4; ++rep) hipLaunchKernelGGL(k_bench_b, dim3(4096), dim3(256), 0, stream, (const float*)d_in[0], (float*)((char*)d_ws + WS_TOKE));
#endif
    for (int ph = 0; ph < DBG_NPH; ++ph) {
        a.ph_lo = ph; a.ph_hi = ph + 1; a.flags = 0;
        bool mk = true;
#if NAIVE_MASK
        const float* const* I = (const float* const*)d_in;
        if ((NAIVE_MASK >> ph) & 1) {
            mk = false;
            switch (ph) {
            case 0: k_mod<<<8 * 6144 / 256, 256, 0, stream>>>(I[1], I[2], I[3], mod); mk = true; break;
            case 1: k_h1<<<T, 256, 0, stream>>>(I[0], I[4], mod, I[5], I[6], hb, gates); break;
            case 2: k_ngemm<NEpi1><<<dim3((DIN + 63) / 64, T / 64), 256, 0, stream>>>(hb, 1024, I[5], DIN, DIN, 1024, NEpi1{out, zq, zk, zv, zo, zga, zgb});
                    k_glu<<<T * 512 / 256, 256, 0, stream>>>(out, zu); a.flags = (DBG_CLS) << 8; mk = (DBG_CLS) != 0;
                    k_fixw1t<<<2048 * 1024 / 256, 256, 0, stream>>>(I[5], (bf16*)(ws + WS_W1T)); break;
            case 3: k_conva<<<T, 256, 0, stream>>>(zu, I[7], I[8], I[9], I[10], uahm); mk = ((NAIVE_MASK >> 4) & 1) ? false : true; break;
            case 4: k_qkconv<<<T, 256, 0, stream>>>(zq, zk, I[12], I[13], qc, kc);
                    k_mlstm_rec<<<BATCH * NH, 256, 0, stream>>>(qc, kc, zv, zo, gates, I[14], uahm); break;
            case 5: k_ngemm<NEpi2a><<<dim3(16, T / 64), 256, 0, stream>>>(uahm, 1024, I[11], 1024, 1024, 512, NEpi2a{out, zga});
                    k_ngemm<NEpi2b><<<dim3(16, T / 64), 256, 0, stream>>>(uahm + 512, 1024, I[15], 1024, 1024, 512, NEpi2b{out, zgb, merged}); break;
            case 6: k_ngemm<NEpi3><<<dim3(16, T / 64), 256, 0, stream>>>(merged, 1024, I[16], 1024, 1024, 1024, NEpi3{I[0], mod, out}); break;
            case 7: k_h2route<<<T, 256, 0, stream>>>(out, I[17], mod, I[18], I[19], I[20], I[21], hb, toke, tokw);
                    k_lists<<<T * 2 / 256, 256, 0, stream>>>(toke, tokw, (unsigned*)(ws + WS_CTL) + CW_CNT, (int*)(ws + WS_LISTT), (float*)(ws + WS_LISTW));
                    a.flags = 1; mk = true; break;
            case 8: break;
            case 9: k_moe<<<T * 2, 256, 0, stream>>>(hb, toke, tokw, I[22], I[23], I[24], (bf16*)(ws + WS_ZU)); break;
            case 10: k_final<<<T, 256, 0, stream>>>(out, (const bf16*)(ws + WS_ZU), mod, I[25], out); break;
            }
        }
#endif
        if (mk && ph == 10 && ((DBG_HREP >> 10) & 1)) { a.flags = 65536; void* args0[] = {&a}; (void)hipLaunchKernel(mk_kernels[ph], dim3(grid), dim3(NTHREADS), args0, LDS_BYTES, stream); a.flags = 0; }
        if (mk) { void* args[] = {&a}; (void)hipLaunchKernel(mk_kernels[ph], dim3(grid), dim3(NTHREADS), args, LDS_BYTES, stream);
            if (((DBG_HREP >> ph) & 1) && ph != 10) { if (ph == 7) a.flags |= DBG_F7; if (ph == 1) a.flags |= DBG_F1; if (ph == 4) a.flags |= DBG_F4; (void)hipLaunchKernel(mk_kernels[ph], dim3(grid), dim3(NTHREADS), args, LDS_BYTES, stream); } }
    }
#endif
}
```

```cpp
#include <hip/hip_runtime.h>
#include <stdint.h>
#include <cstdio>

#ifndef MK_ONE
#define MK_ONE 1
#endif
#ifndef NAIVE_MASK
#define NAIVE_MASK 0
#endif
#ifndef DBG_NPH
#define DBG_NPH 11
#endif
#ifndef P1_MFMA
#define P1_MFMA 0
#endif
#if P1_MFMA
#define P1_FN p1_h1_mfma
#else
#define P1_FN p1_h1
#endif
#ifndef XB_EARLY_ACQ
#define XB_EARLY_ACQ 1
#endif
#ifndef USE_XCD_BARRIER
#define USE_XCD_BARRIER 1
#endif
#ifndef DBG_XBAR
#define DBG_XBAR 0
#endif
#ifndef DBG_F4
#define DBG_F4 0
#endif
#ifndef DBG_F1
#define DBG_F1 0
#endif
#ifndef DBG_F7
#define DBG_F7 6
#endif
#ifndef DBG_HREP
#define DBG_HREP 0
#endif
#ifndef DBG_REP
#define DBG_REP 0
#endif
#if DBG_REP
#define REPK(k) for (int _r = 0; _r < 1 + ((DBG_REP >> (k)) & 1); ++_r)
#define REPSYNC() __syncthreads()
#else
#define REPK(k)
#define REPSYNC() do {} while (0)
#endif
#ifndef DBG_CLS
#define DBG_CLS 0
#endif
#ifndef DBG_GATEFIRST
#define DBG_GATEFIRST 0
#endif

typedef unsigned short bf16;
#define DEV __device__ __forceinline__
#define LAS __attribute__((address_space(3)))
typedef short bf16x8 __attribute__((ext_vector_type(8)));
typedef float f32x4 __attribute__((ext_vector_type(4)));
typedef unsigned v4u __attribute__((ext_vector_type(4)));
typedef unsigned v2u __attribute__((ext_vector_type(2)));

constexpr int BATCH = 8, SEQ = 2048, D = 1024, T = BATCH * SEQ;
constexpr int DIN = 5128, NH = 4;
constexpr float RMS_EPS = 1e-6f, LN_EPS = 1e-5f;
constexpr int NWAVES = 8, NTHREADS = 512;

DEV float bf2f(bf16 v) { return __uint_as_float(((unsigned)v) << 16); }
DEV float bflo(unsigned w) { return __uint_as_float(w << 16); }
DEV float bfhi(unsigned w) { return __uint_as_float(w & 0xffff0000u); }
DEV unsigned f2bfu(float f) { unsigned u = __float_as_uint(f); return (u + 0x7fffu + ((u >> 16) & 1u)) >> 16; }
DEV unsigned pk2(float lo, float hi);
DEV bf16 f2bf(float f) { return (bf16)(pk2(f, f) & 0xffffu); }
typedef float f32x2_cv __attribute__((ext_vector_type(2)));
typedef __bf16 bf16x2_cv __attribute__((ext_vector_type(2)));
DEV unsigned pk2(float lo, float hi) { const f32x2_cv v = {lo, hi}; const bf16x2_cv b = __builtin_convertvector(v, bf16x2_cv); return __builtin_bit_cast(unsigned, b); }
DEV float sigmoidf_(float x) { return __builtin_amdgcn_rcpf(1.f + __expf(-x)); }
DEV float siluf_(float x) { return x * __builtin_amdgcn_rcpf(1.f + __expf(-x)); }
DEV float logsigmoidf_(float x) { return fminf(x, 0.f) - log1pf(__expf(-fabsf(x))); }
template <int CTRL> DEV float dpp0(float v) { return __int_as_float(__builtin_amdgcn_update_dpp(0, __float_as_int(v), CTRL, 0xf, 0xf, true)); }
template <int CTRL> DEV float dppk(float v) { return __int_as_float(__builtin_amdgcn_update_dpp(__float_as_int(v), __float_as_int(v), CTRL, 0xf, 0xf, false)); }
DEV float rdlane(float v, int l) { return __int_as_float(__builtin_amdgcn_readlane(__float_as_int(v), l)); }
DEV float row16_sum(float v) {
    v += dpp0<0xB1>(v); v += dpp0<0x4E>(v); v += dpp0<0x141>(v); v += dpp0<0x140>(v); return v; }
DEV float wave_sum(float v) { v = row16_sum(v); return (rdlane(v, 0) + rdlane(v, 16)) + (rdlane(v, 32) + rdlane(v, 48)); }
DEV float wave_scan_add(float v, int lane) {
    v += dpp0<0x111>(v); v += dpp0<0x112>(v); v += dpp0<0x114>(v); v += dpp0<0x118>(v);
    const float r0 = rdlane(v, 15), r1 = rdlane(v, 31), r2 = rdlane(v, 47);
    return v + ((lane >= 48) ? (r0 + r1) + r2 : (lane >= 32) ? (r0 + r1) : (lane >= 16) ? r0 : 0.f); }
DEV float wave_scan_max(float v, int lane) {
    v = fmaxf(v, dppk<0x111>(v)); v = fmaxf(v, dppk<0x112>(v)); v = fmaxf(v, dppk<0x114>(v)); v = fmaxf(v, dppk<0x118>(v));
    const float r0 = rdlane(v, 15), r1 = rdlane(v, 31), r2 = rdlane(v, 47);
    const float p = (lane >= 48) ? fmaxf(fmaxf(r0, r1), r2) : (lane >= 32) ? fmaxf(r0, r1) : (lane >= 16) ? r0 : -3.0e38f;
    return fmaxf(v, p); }
#define LDS_WAIT() asm volatile("s_waitcnt lgkmcnt(0)" ::: "memory")

constexpr size_t MiB = 1u << 20;
constexpr size_t WS_CTL = 0, CTL_ZERO_BYTES = 65536;
constexpr size_t WS_MOD = 1 * MiB;
constexpr size_t WS_GATES = 1 * MiB + 256 * 1024;
constexpr size_t WS_STSC = 1 * MiB + 768 * 1024;
constexpr size_t WS_RBIAS = 1 * MiB + 800 * 1024;
constexpr size_t WS_WIF = 1 * MiB + 832 * 1024;
constexpr size_t WS_RW = 6 * MiB + 256 * 1024;
constexpr size_t WS_TOKE = 6 * MiB;
constexpr size_t WS_TOKW = 6 * MiB + 128 * 1024;
constexpr size_t WS_LISTT = 2 * MiB;
constexpr size_t WS_LISTW = 4 * MiB;
constexpr size_t WS_W1T = 8 * MiB;
constexpr size_t WS_W2T = 18 * MiB;
constexpr size_t WS_W3T = 20 * MiB;
constexpr size_t WS_STATE = 22 * MiB;
constexpr size_t WS_H = 40 * MiB;
constexpr size_t WS_ZU = 72 * MiB, WS_ZQ = 88 * MiB, WS_ZK = 104 * MiB, WS_ZV = 120 * MiB, WS_ZO = 136 * MiB;
constexpr size_t WS_ZGA = 152 * MiB, WS_ZGB = 184 * MiB;
constexpr size_t WS_UAHM = 216 * MiB;
constexpr size_t WS_MERGED = WS_ZQ;
constexpr size_t WS_WGU = 120 * MiB;
constexpr size_t WS_WD = 184 * MiB;
constexpr size_t WS_ACT = 216 * MiB;
constexpr size_t WS_YS = 40 * MiB;
constexpr size_t WS_QC = WS_H, WS_KC = WS_H + 16 * MiB;
constexpr int CW_BAR = 4096, CW_CNT = 8192, CW_MODCNT = 9216, CW_FLATBAR = 9280;

constexpr int LDS_TAB = 131072;
constexpr int LDS_MISC = 147456;
constexpr int LDS_BYTES = 151552;

struct Args { const float* in[26]; float* out; unsigned char* ws; int ph_lo, ph_hi, flags, pad; };
struct XDeal { int xr, nx, lr, nl;
    DEV int item(int i, int per) const { const int j = i * nl + lr; const int k = j / per; const int b = xr + k * nx; return (b < BATCH) ? b * per + (j - k * per) : -1; } };

namespace pg8 {
constexpr int BM = 256, BK = 64, HALF = 128, HTB = HALF * BK * 2, NXCD = 8, WGM = 8;
DEV int lds_byte(int r, int c) { const int st = (r >> 4) * 2 + (c >> 5), rr = r & 15, cc = c & 31, ob = rr * 64 + cc * 2; return st * 1024 + (ob ^ (((ob >> 9) & 1) << 5)); }
DEV void stage_rc(int b, int& R, int& C) { const int st = b / 1024, sb = b % 1024, swz = sb ^ (((sb >> 9) & 1) << 5); R = (st >> 1) * 16 + swz / 64; C = (st & 1) * 32 + (swz % 64) / 2; }
DEV int perm32(int rho) { const int n = rho >> 4, i = rho & 15; return 8 * (i >> 2) + 4 * n + (i & 3); }
DEV unsigned cvt_pk_bf16(float lo, float hi) { return pk2(lo, hi); }

struct Unit { int pm, pn; unsigned ak, bk; int slot, valid, arow0; };

struct StaticOrder {
    int nM, nN, nwg, G, c;
    DEV void init(int M, int N, int G_, int c_) { nM = M / BM; nN = N / BM; nwg = nM * nN; G = G_; c = c_; }
    DEV bool tile(int L, int& pm, int& pn) const {
        if (L >= nwg) return false;
        int wgid = L; { const int q = nwg / NXCD, r = nwg % NXCD, xcd = wgid % NXCD, off = wgid / NXCD; wgid = (xcd < r ? xcd * (q + 1) : r * (q + 1) + (xcd - r) * q) + off; }
        const int nig = WGM * nN, gid = wgid / nig, fm = gid * WGM, gsz = (nM - fm) < WGM ? (nM - fm) : WGM;
        pm = fm + ((wgid % nig) % gsz); pn = (wgid % nig) / gsz; return true;
    }
    DEV bool next(int i, Unit& u) const { u.ak = 0; u.bk = 0; u.slot = 0; u.valid = 256; u.arow0 = 0; return tile(i * G + c, u.pm, u.pn); }
};

template <class Prob, class Epi, class Sched, bool ALIGN_EPI, bool SKIP = false>
DEV void gemm_phase(LAS unsigned char* lds, const Prob& P, const Sched& S, const Epi& E, const int K) {
    int tid = threadIdx.x; asm volatile("" : "+v"(tid));
    const int wid = __builtin_amdgcn_readfirstlane(tid >> 6), lane = tid & 63, wr = wid >> 2, wc = wid & 3, fr = lane & 15, fq = lane >> 4;
    const int nt = K / BK;
    int R[2], C[2], Rb[2];
#pragma unroll
    for (int i = 0; i < 2; ++i) { stage_rc(tid * 16 + i * 8192, R[i], C[i]); Rb[i] = Epi::PERM ? ((R[i] & ~31) + perm32(R[i] & 31)) : R[i]; }
    const unsigned kstep = BK * 2;
    const unsigned ldsw = (unsigned)wid * 1024u;
    const int aoff = lds_byte(wr * 64 + fr, fq * 8), boff = lds_byte(wc * 32 + fr, fq * 8);
    const char* const Abase = (const char*)P.A; const char* const Bbase = (const char*)P.B;
#define PG8_SA(b, h) (((b) * 2 + (h)) * HTB)
#define PG8_SB(b, h) ((4 + (b) * 2 + (h)) * HTB)
#define PG8_STAGE(bufoff, base, offs, kb) do { _Pragma("unroll") for (int _i = 0; _i < 2; ++_i) \
        __builtin_amdgcn_global_load_lds((const unsigned*)((base) + (size_t)((offs)[_i] + (kb))), (LAS unsigned*)(lds + (bufoff) + ldsw + _i * 8192), 16, 0, 0); } while (0)
#define PG8_LDA(dst, b, h) do { _Pragma("unroll") for (int m = 0; m < 4; ++m) _Pragma("unroll") for (int k = 0; k < 2; ++k) dst[m][k] = *(const LAS bf16x8*)(lds + PG8_SA(b, h) + aoff + m * 2048 + k * 1024); } while (0)
#define PG8_LDB(dst, b, h) do { _Pragma("unroll") for (int n = 0; n < 2; ++n) _Pragma("unroll") for (int k = 0; k < 2; ++k) dst[n][k] = *(const LAS bf16x8*)(lds + PG8_SB(b, h) + boff + n * 2048 + k * 1024); } while (0)
#define PG8_MMA(ai, bj, At, Bt) do { __builtin_amdgcn_s_setprio(1); _Pragma("unroll") for (int m = 0; m < 4; ++m) _Pragma("unroll") for (int n = 0; n < 2; ++n) _Pragma("unroll") for (int k = 0; k < 2; ++k) \
        acc[ai][bj][m][n] = __builtin_amdgcn_mfma_f32_16x16x32_bf16(Bt[n][k], At[m][k], acc[ai][bj][m][n], 0, 0, 0); __builtin_amdgcn_s_setprio(0); } while (0)
#define PG8_WAIT_V(n) asm volatile("s_waitcnt vmcnt(" #n ")" ::: "memory")
#define PG8_WAIT_L(n) asm volatile("s_waitcnt lgkmcnt(" #n ")" ::: "memory")
#define PG8_BAR __builtin_amdgcn_s_barrier()
#define PG8_SCHED __builtin_amdgcn_sched_barrier(0)
    Unit cur, nxt; int ui = 0;
    if (!S.next(0, cur)) return;
    f32x4 acc[2][2][4][2];
#pragma unroll
    for (int a = 0; a < 2; ++a)
#pragma unroll
        for (int b = 0; b < 2; ++b)
#pragma unroll
            for (int m = 0; m < 4; ++m)
#pragma unroll
                for (int n = 0; n < 2; ++n) acc[a][b][m][n] = (f32x4){0.f, 0.f, 0.f, 0.f};
    bf16x8 At[4][2], B0[2][2], B1[2][2];
    unsigned ca[2][2], cb[2][2], na[2][2], nb[2][2];
    P.aoffs(cur, R, C, ca); P.boffs(cur, Rb, C, cb);
    PG8_STAGE(PG8_SB(0, 0), Bbase, cb[0], 0u); PG8_STAGE(PG8_SB(0, 1), Bbase, cb[1], 0u); PG8_STAGE(PG8_SA(0, 0), Abase, ca[0], 0u); PG8_STAGE(PG8_SA(0, 1), Abase, ca[1], 0u);
    if (wr == 1) PG8_BAR;
    PG8_WAIT_V(2); PG8_BAR;
    PG8_STAGE(PG8_SB(1, 0), Bbase, cb[0], kstep); PG8_STAGE(PG8_SA(1, 0), Abase, ca[0], kstep); PG8_STAGE(PG8_SB(1, 1), Bbase, cb[1], kstep);
    PG8_WAIT_V(6); PG8_BAR;
    for (;;) {
        const bool has_next = S.next(ui + 1, nxt);
        if (has_next) { P.aoffs(nxt, R, C, na); P.boffs(nxt, Rb, C, nb); }
        else {
#pragma unroll
            for (int h = 0; h < 2; ++h)
#pragma unroll
                for (int i = 0; i < 2; ++i) { na[h][i] = ca[h][i]; nb[h][i] = cb[h][i]; } }
        const bool do0 = !(SKIP && cur.valid <= 64 && wr == 1), do1 = !(SKIP && cur.valid <= 128) && do0;
        for (int t = 0; t < nt; t += 2) {
            const bool last = (t == nt - 2);
            const unsigned k1 = (unsigned)(t + 1) * kstep;
            const unsigned kb2 = last ? 0u : (unsigned)(t + 2) * kstep, kb3 = kb2 + kstep;
            unsigned a2[2][2], b2[2][2];
#pragma unroll
            for (int h = 0; h < 2; ++h)
#pragma unroll
                for (int i = 0; i < 2; ++i) { a2[h][i] = last ? na[h][i] : ca[h][i]; b2[h][i] = last ? nb[h][i] : cb[h][i]; }
            PG8_LDB(B0, 0, 0); PG8_LDB(B1, 0, 1); PG8_SCHED; PG8_LDA(At, 0, 0); PG8_STAGE(PG8_SA(1, 1), Abase, ca[1], k1);
            PG8_WAIT_V(8); PG8_WAIT_L(0); PG8_BAR; if (do0) { PG8_MMA(0, 0, At, B0); PG8_MMA(0, 1, At, B1); } PG8_BAR; PG8_SCHED;
            PG8_LDA(At, 0, 1); PG8_STAGE(PG8_SB(0, 0), Bbase, b2[0], kb2); PG8_STAGE(PG8_SB(0, 1), Bbase, b2[1], kb2); PG8_STAGE(PG8_SA(0, 0), Abase, a2[0], kb2);
            PG8_WAIT_V(8); PG8_WAIT_L(0); PG8_BAR; if (do1) { PG8_MMA(1, 0, At, B0); PG8_MMA(1, 1, At, B1); } PG8_BAR; PG8_SCHED;
            PG8_LDB(B0, 1, 0); PG8_LDB(B1, 1, 1); PG8_SCHED; PG8_LDA(At, 1, 0); PG8_STAGE(PG8_SA(0, 1), Abase, a2[1], kb2);
            PG8_WAIT_V(8); PG8_WAIT_L(0); PG8_BAR; if (do0) { PG8_MMA(0, 0, At, B0); PG8_MMA(0, 1, At, B1); } PG8_BAR; PG8_SCHED;
            PG8_LDA(At, 1, 1); PG8_STAGE(PG8_SB(1, 0), Bbase, b2[0], kb3); PG8_STAGE(PG8_SB(1, 1), Bbase, b2[1], kb3); PG8_STAGE(PG8_SA(1, 0), Abase, a2[0], kb3);
            PG8_WAIT_V(8); PG8_WAIT_L(0); PG8_BAR; if (do1) { PG8_MMA(1, 0, At, B0); PG8_MMA(1, 1, At, B1); } PG8_BAR; PG8_SCHED;
        }
        if constexpr (ALIGN_EPI) { if (wr == 0) PG8_BAR; }
        E(acc, cur, wr, wc, fr, fq);
        if (!has_next) break;
        if (!E.keep(cur)) {
#pragma unroll
            for (int a = 0; a < 2; ++a)
#pragma unroll
                for (int b = 0; b < 2; ++b)
#pragma unroll
                    for (int m = 0; m < 4; ++m)
#pragma unroll
                        for (int n = 0; n < 2; ++n) acc[a][b][m][n] = (f32x4){0.f, 0.f, 0.f, 0.f};
        }
        cur = nxt; ++ui;
#pragma unroll
        for (int h = 0; h < 2; ++h)
#pragma unroll
            for (int i = 0; i < 2; ++i) { ca[h][i] = na[h][i]; cb[h][i] = nb[h][i]; }
        if constexpr (ALIGN_EPI) { if (wr == 1) PG8_BAR; }
    }
    PG8_WAIT_V(0);
    if constexpr (!ALIGN_EPI) { if (wr == 0) PG8_BAR; }
    PG8_BAR;
#undef PG8_SA
#undef PG8_SB
#undef PG8_STAGE
#undef PG8_LDA
#undef PG8_LDB
#undef PG8_MMA
#undef PG8_WAIT_V
#undef PG8_WAIT_L
#undef PG8_BAR
#undef PG8_SCHED
}
}
using pg8::Unit;

struct ProbPlain {
    const bf16* A; const bf16* B; unsigned lda2, ldb2;
    DEV void aoffs(const Unit& u, const int (&R)[2], const int (&C)[2], unsigned (&o)[2][2]) const {
#pragma unroll
        for (int h = 0; h < 2; ++h)
#pragma unroll
            for (int i = 0; i < 2; ++i) o[h][i] = (unsigned)(u.pm * 256 + 128 * h + R[i]) * lda2 + (unsigned)C[i] * 2u + u.ak; }
    DEV void boffs(const Unit& u, const int (&Rb)[2], const int (&C)[2], unsigned (&o)[2][2]) const {
#pragma unroll
        for (int h = 0; h < 2; ++h)
#pragma unroll
            for (int i = 0; i < 2; ++i) o[h][i] = (unsigned)(u.pn * 256 + 128 * h + Rb[i]) * ldb2 + (unsigned)C[i] * 2u + u.bk; }
};
struct ProbMoeUp {
    const bf16* A; const bf16* B; const LAS unsigned* rowtab;
    DEV void aoffs(const Unit& u, const int (&R)[2], const int (&C)[2], unsigned (&o)[2][2]) const {
#pragma unroll
        for (int h = 0; h < 2; ++h)
#pragma unroll
            for (int i = 0; i < 2; ++i) o[h][i] = rowtab[u.slot * 256 + 128 * h + R[i]] + (unsigned)C[i] * 2u; }
    DEV void boffs(const Unit& u, const int (&Rb)[2], const int (&C)[2], unsigned (&o)[2][2]) const {
#pragma unroll
        for (int h = 0; h < 2; ++h)
#pragma unroll
            for (int i = 0; i < 2; ++i) o[h][i] = (unsigned)(u.pn * 256 + 128 * h + Rb[i]) * 2048u + (unsigned)C[i] * 2u + u.bk; }
};
struct ProbMoeDown {
    const bf16* A; const bf16* B;
    DEV void aoffs(const Unit& u, const int (&R)[2], const int (&C)[2], unsigned (&o)[2][2]) const {
#pragma unroll
        for (int h = 0; h < 2; ++h)
#pragma unroll
            for (int i = 0; i < 2; ++i) o[h][i] = (unsigned)(u.arow0 + 128 * h + R[i]) * 1024u + (unsigned)C[i] * 2u; }
    DEV void boffs(const Unit& u, const int (&Rb)[2], const int (&C)[2], unsigned (&o)[2][2]) const {
#pragma unroll
        for (int h = 0; h < 2; ++h)
#pragma unroll
            for (int i = 0; i < 2; ++i) o[h][i] = (unsigned)(u.pn * 256 + 128 * h + Rb[i]) * 1024u + (unsigned)C[i] * 2u + u.bk; }
};

DEV void st16_wt(void* p, const v4u v) { asm volatile("global_store_dwordx4 %0, %1, off sc1\n\ts_nop 1" :: "v"(p), "v"(v) : "memory"); }
DEV v4u pack8(const f32x4 v0, const f32x4 v1) { v4u w; w.x = pg8::cvt_pk_bf16(v0[0], v0[1]); w.y = pg8::cvt_pk_bf16(v0[2], v0[3]); w.z = pg8::cvt_pk_bf16(v1[0], v1[1]); w.w = pg8::cvt_pk_bf16(v1[2], v1[3]); return w; }
DEV f32x4 sig4(f32x4 v) { f32x4 o; o[0] = sigmoidf_(v[0]); o[1] = sigmoidf_(v[1]); o[2] = sigmoidf_(v[2]); o[3] = sigmoidf_(v[3]); return o; }
DEV void unpack8(const v4u w, f32x4& lo, f32x4& hi) { lo[0] = bflo(w.x); lo[1] = bfhi(w.x); lo[2] = bflo(w.y); lo[3] = bfhi(w.y); hi[0] = bflo(w.z); hi[1] = bfhi(w.z); hi[2] = bflo(w.w); hi[3] = bfhi(w.w); }

struct Epi1 {
    static constexpr bool PERM = true;
    bf16* zu; bf16* zga; int cls;
    DEV bool keep(const Unit&) const { return false; }
    DEV void operator()(f32x4 (&acc)[2][2][4][2], const Unit& u, int wr, int wc, int fr, int fq) const {
        const int row0 = u.pm * 256 + wr * 64 + fr, cl = wc * 32 + 8 * fq;
        if (cls) { const int c = (u.pn < 4) ? 1 : (u.pn < 12) ? 2 : (u.pn < 16) ? 4 : 8; if (!(cls & c)) return; }
        if (u.pn < 4) {
#pragma unroll
            for (int ai = 0; ai < 2; ++ai)
#pragma unroll
                for (int m = 0; m < 4; ++m) { const size_t row = (size_t)(row0 + ai * 128 + m * 16);
                    const f32x4 v0 = acc[ai][0][m][0] * sig4(acc[ai][1][m][0]), v1 = acc[ai][0][m][1] * sig4(acc[ai][1][m][1]);
                    *(v4u*)(zu + row * 512 + 128 * u.pn + cl) = pack8(v0, v1); }
        } else {
            bf16* base; int ld, colb; bool sg;
            if (u.pn < 12) { const int ti = (u.pn - 4) >> 1; base = zu + (size_t)(1 + ti) * T * 512; ld = 512; colb = 256 * ((u.pn - 4) & 1); sg = (ti == 3); }
            else { const int ti = (u.pn - 12) >> 2; base = zga + (size_t)ti * T * 1024; ld = 1024; colb = 256 * ((u.pn - 12) & 3); sg = true; }
            if (u.pn >= 12) {
                bf16* fb = base + ((size_t)(u.pm * 4 + ((u.pn - 12) & 3)) * 65536) + (size_t)((wr * 4 + wc) * 64 + fq * 16 + fr) * 8;
#pragma unroll
                for (int ai = 0; ai < 2; ++ai)
#pragma unroll
                    for (int m = 0; m < 4; ++m)
#pragma unroll
                        for (int bj = 0; bj < 2; ++bj) *(v4u*)(fb + (size_t)(((ai * 4 + m) * 2 + bj) * 4096)) = pack8(sig4(acc[ai][bj][m][0]), sig4(acc[ai][bj][m][1]));
            } else
#pragma unroll
            for (int ai = 0; ai < 2; ++ai)
#pragma unroll
                for (int m = 0; m < 4; ++m) { const size_t row = (size_t)(row0 + ai * 128 + m * 16);
#pragma unroll
                    for (int bj = 0; bj < 2; ++bj) { f32x4 v0 = acc[ai][bj][m][0], v1 = acc[ai][bj][m][1]; if (sg) { v0 = sig4(v0); v1 = sig4(v1); }
                        *(v4u*)(base + row * ld + colb + 128 * bj + cl) = pack8(v0, v1); } }
        }
    }
};
struct Epi2 {
    static constexpr bool PERM = true;
    const bf16* zga; const bf16* zgb; bf16* merged;
    DEV bool keep(const Unit& u) const { return u.slot == 0; }
    DEV void operator()(f32x4 (&acc)[2][2][4][2], const Unit& u, int wr, int wc, int fr, int fq) const {
        const int row0 = u.pm * 256 + wr * 64 + fr, c0 = u.pn * 256 + wc * 32 + 8 * fq;
        const size_t fo = ((size_t)(u.pm * 4 + u.pn) * 65536) + (size_t)((wr * 4 + wc) * 64 + fq * 16 + fr) * 8;
#pragma unroll
        for (int ai = 0; ai < 2; ++ai)
#pragma unroll
            for (int m = 0; m < 4; ++m) { const size_t ro = (size_t)(row0 + ai * 128 + m * 16) * 1024 + c0;
#pragma unroll
                for (int bj = 0; bj < 2; ++bj) { const size_t fa = fo + (size_t)(((ai * 4 + m) * 2 + bj) * 4096);
                    f32x4 b0, b1; unpack8(*(const v4u*)(zgb + fa), b0, b1);
                    if (u.slot == 0) { f32x4 a0, a1; unpack8(*(const v4u*)(zga + fa), a0, a1);
#pragma unroll
                        for (int j = 0; j < 4; ++j) { acc[ai][bj][m][0][j] *= a0[j] * __builtin_amdgcn_rcpf(fmaxf(b0[j], 1e-30f)); acc[ai][bj][m][1][j] *= a1[j] * __builtin_amdgcn_rcpf(fmaxf(b1[j], 1e-30f)); }
                    } else { *(v4u*)(merged + ro + 128 * bj) = pack8(acc[ai][bj][m][0] * b0, acc[ai][bj][m][1] * b1); }
                } }
    }
};
struct Epi3 {
    static constexpr bool PERM = true;
    const float* x; const float* mod; float* out;
    DEV bool keep(const Unit&) const { return false; }
    DEV void operator()(f32x4 (&acc)[2][2][4][2], const Unit& u, int wr, int wc, int fr, int fq) const {
        const int row0 = u.pm * 256 + wr * 64 + fr, c0 = u.pn * 256 + wc * 32 + 8 * fq; const int b = u.pm >> 3;
        f32x4 gt[2][2];
#pragma unroll
        for (int bj = 0; bj < 2; ++bj)
#pragma unroll
            for (int n = 0; n < 2; ++n) gt[bj][n] = *(const f32x4*)(mod + b * 6144 + 2048 + c0 + 128 * bj + 4 * n);
#pragma unroll
        for (int ai = 0; ai < 2; ++ai)
#pragma unroll
            for (int m = 0; m < 4; ++m) { const size_t ro = (size_t)(row0 + ai * 128 + m * 16) * 1024 + c0;
#pragma unroll
                for (int bj = 0; bj < 2; ++bj)
#pragma unroll
                    for (int n = 0; n < 2; ++n) { const f32x4 xv = *(const f32x4*)(x + ro + 128 * bj + 4 * n); *(f32x4*)(out + ro + 128 * bj + 4 * n) = xv + gt[bj][n] * acc[ai][bj][m][n]; } }
    }
};
struct EpiUp {
    static constexpr bool PERM = true;
    bf16* act;
    DEV bool keep(const Unit&) const { return false; }
    DEV void operator()(f32x4 (&acc)[2][2][4][2], const Unit& u, int wr, int wc, int fr, int fq) const {
        const int cl = 128 * u.pn + wc * 32 + 8 * fq;
#pragma unroll
        for (int ai = 0; ai < 2; ++ai)
#pragma unroll
            for (int m = 0; m < 4; ++m) { const int rt = ai * 128 + wr * 64 + m * 16 + fr;
                if (rt < u.valid) { f32x4 v0, v1;
#pragma unroll
                    for (int j = 0; j < 4; ++j) { v0[j] = siluf_(acc[ai][0][m][0][j]) * acc[ai][1][m][0][j]; v1[j] = siluf_(acc[ai][0][m][1][j]) * acc[ai][1][m][1][j]; }
                    *(v4u*)(act + (size_t)(u.arow0 + rt) * 512 + cl) = pack8(v0, v1); } }
    }
};
struct EpiDown {
    static constexpr bool PERM = true;
    bf16* ys; const LAS unsigned* desttab; const LAS float* wtab;
    DEV bool keep(const Unit&) const { return false; }
    DEV void operator()(f32x4 (&acc)[2][2][4][2], const Unit& u, int wr, int wc, int fr, int fq) const {
        const int cl = 256 * u.pn + wc * 32 + 8 * fq;
#pragma unroll
        for (int ai = 0; ai < 2; ++ai)
#pragma unroll
            for (int m = 0; m < 4; ++m) { const int rt = ai * 128 + wr * 64 + m * 16 + fr;
                if (rt < u.valid) { const unsigned dest = desttab[u.slot * 256 + rt]; const float w = wtab[u.slot * 256 + rt];
#pragma unroll
                    for (int bj = 0; bj < 2; ++bj) *(v4u*)(ys + (size_t)dest * 1024 + cl + 128 * bj) = pack8(acc[ai][bj][m][0] * w, acc[ai][bj][m][1] * w); } }
    }
};

#define XB_TMO      128
#define XB_XCNT(j)  (256  + 64 * (j))
#define XB_XSUB(j)  (1280 + 64 * (j))
#define XB_XGEN(j)  (2304 + 64 * (j))
#define XB_TOP      3328
#define XB_TOPGEN   3392
#define XCD_BAR_WORDS 3456
#define XB_SPIN_CAP (1u << 18)
__device__ __forceinline__ unsigned xb_ld(unsigned* p)              { return __hip_atomic_load(p, __ATOMIC_RELAXED, __HIP_MEMORY_SCOPE_AGENT); }
__device__ __forceinline__ unsigned xb_add(unsigned* p, unsigned v) { return __hip_atomic_fetch_add(p, v, __ATOMIC_RELAXED, __HIP_MEMORY_SCOPE_AGENT); }
__device__ __forceinline__ unsigned xb_xcc_id() { return (unsigned)__builtin_amdgcn_s_getreg((3 << 11) | 20) & 0xFu; }
#define XB_SPIN(cond, bar) do { unsigned _sp = 0; while (cond) { __builtin_amdgcn_s_sleep(1); \
    if ((++_sp & 255u) == 0u) { if (xb_ld(&(bar)[XB_TMO])) break; if (_sp > XB_SPIN_CAP) { atomicAdd(&(bar)[XB_TMO], 1u); break; } } } } while (0)
struct XcdBarrier { unsigned* bar; unsigned x; volatile LAS unsigned* st; };
__device__ __forceinline__ XcdBarrier xcd_barrier_post(unsigned* bar, volatile LAS unsigned* st) {
    XcdBarrier b; b.bar = bar; b.x = xb_xcc_id(); b.st = st;
    if (threadIdx.x == 0) st[4] = xb_add(&bar[XB_XCNT(b.x)], 1u);
    return b;
}
__device__ __forceinline__ void xcd_barrier_complete(unsigned* bar, unsigned x, unsigned& nloc, unsigned& nx, unsigned& xr) {
    const unsigned G = gridDim.x * gridDim.y * gridDim.z;
    unsigned sum, cnt, mine, below, sp = 0u;
    for (;;) {
        sum = 0u; cnt = 0u; mine = 0u; below = 0u;
#pragma unroll
        for (unsigned j = 0; j < 16; ++j) { const unsigned c = xb_ld(&bar[XB_XCNT(j)]); sum += c; cnt += (c > 0u) ? 1u : 0u; mine = (j == x) ? c : mine; below += (j < x && c > 0u) ? 1u : 0u; }
        if (sum == G) break;
        __builtin_amdgcn_s_sleep(1);
        if ((++sp & 255u) == 0u) { if (xb_ld(&bar[XB_TMO])) break; if (sp > XB_SPIN_CAP) { atomicAdd(&bar[XB_TMO], 1u); break; } }
    }
    nloc = mine > 0u ? mine : 1u; nx = cnt > 0u ? cnt : 1u; xr = below;
}
__device__ __forceinline__ void xcd_barrier(const XcdBarrier& b) {
    asm volatile("s_waitcnt vmcnt(0)" ::: "memory");
    __syncthreads();
    if (threadIdx.x == 0) {
        unsigned* bar = b.bar;
        __builtin_amdgcn_s_waitcnt(0);
        unsigned nloc = b.st[0], nx = b.st[1];
        if (nloc == 0u) { unsigned xr; xcd_barrier_complete(bar, b.x, nloc, nx, xr); b.st[0] = nloc; b.st[1] = nx; b.st[5] = xr; }
        const unsigned old = xb_add(&bar[XB_XSUB(b.x)], 1u);
        const unsigned gen = old / nloc;
        if (old + 1u == (gen + 1u) * nloc) {
            __builtin_amdgcn_fence(__ATOMIC_RELEASE, "agent");
            asm volatile("s_waitcnt vmcnt(0)" ::: "memory");
            const unsigned og = xb_add(&bar[XB_TOP], 1u);
            const unsigned tg = og / nx;
            if (og + 1u == (tg + 1u) * nx) xb_add(&bar[XB_TOPGEN], 1u);
            else XB_SPIN(xb_ld(&bar[XB_TOPGEN]) == tg, bar);
            __builtin_amdgcn_fence(__ATOMIC_ACQUIRE, "agent");
            xb_add(&bar[XB_XGEN(b.x)], 1u);
            asm volatile("s_waitcnt vmcnt(0)" ::: "memory");
        } else {
#if XB_EARLY_ACQ
            __builtin_amdgcn_fence(__ATOMIC_ACQUIRE, "agent");
            XB_SPIN(xb_ld(&bar[XB_XGEN(b.x)]) == gen, bar);
            asm volatile("s_waitcnt vmcnt(0)" ::: "memory");
#else
            XB_SPIN(xb_ld(&bar[XB_XGEN(b.x)]) == gen, bar);
            __builtin_amdgcn_fence(__ATOMIC_ACQUIRE, "agent");
            asm volatile("s_waitcnt vmcnt(0)" ::: "memory");
#endif
        }
    }
    __syncthreads();
}

__device__ __forceinline__ void flat_barrier(unsigned* cnt, unsigned& gen) {
    asm volatile("s_waitcnt vmcnt(0)" ::: "memory");
    __syncthreads();
    ++gen;
    if (threadIdx.x == 0) {
        __builtin_amdgcn_fence(__ATOMIC_RELEASE, "agent");
        asm volatile("s_waitcnt vmcnt(0)" ::: "memory");
        (void)xb_add(cnt, 1u);
        const unsigned want = gen * gridDim.x; unsigned sp = 0;
        while (xb_ld(cnt) < want) { __builtin_amdgcn_s_sleep(1); if (++sp > (1u << 22)) break; }
        __builtin_amdgcn_fence(__ATOMIC_ACQUIRE, "agent");
        asm volatile("s_waitcnt vmcnt(0)" ::: "memory");
    }
    __syncthreads();
}
constexpr int CW_LBAR = 10752;
template <int N>
__device__ __forceinline__ void xcd_local_barrier(const XcdBarrier& b, unsigned* lbar) {
    asm volatile("s_waitcnt vmcnt(0)" ::: "memory");
    __syncthreads();
    if (threadIdx.x == 0) {
        __builtin_amdgcn_s_waitcnt(0);
        const unsigned want = (unsigned)N * b.st[0];
        (void)xb_add(&lbar[64u * b.x], 1u);
        __builtin_amdgcn_fence(__ATOMIC_ACQUIRE, "agent");
        XB_SPIN(xb_ld(&lbar[64u * b.x]) < want, b.bar);
        asm volatile("s_waitcnt vmcnt(0)" ::: "memory");
    }
    __syncthreads();
}
DEV f32x4 mma16(bf16x8 a, bf16x8 b, f32x4 c) { return __builtin_amdgcn_mfma_f32_16x16x32_bf16(a, b, c, 0, 0, 0); }
DEV void split8(const f32x4 a, const f32x4 b, bf16x8& hi, bf16x8& lo) {
    v4u h, l; const float r[8] = {a[0], a[1], a[2], a[3], b[0], b[1], b[2], b[3]}; unsigned hw[4], lw[4];
#pragma unroll
    for (int i = 0; i < 4; ++i) { hw[i] = pk2(r[2 * i], r[2 * i + 1]); lw[i] = pk2(r[2 * i] - bflo(hw[i]), r[2 * i + 1] - bfhi(hw[i])); }
    h.x = hw[0]; h.y = hw[1]; h.z = hw[2]; h.w = hw[3]; l.x = lw[0]; l.y = lw[1]; l.z = lw[2]; l.w = lw[3];
    hi = __builtin_bit_cast(bf16x8, h); lo = __builtin_bit_cast(bf16x8, l);
}
DEV void transpose_item(const float* src, int ldsrc, bf16* dst, int lddst, LAS float* scr, int lane) {
#pragma unroll 8
    for (int i = 0; i < 32; ++i) { const int kk = 2 * i + (lane >> 5); scr[kk * 33 + (lane & 31)] = src[(size_t)kk * ldsrc + (lane & 31)]; }
    LDS_WAIT(); asm volatile("" ::: "memory");
    const int c = lane & 7;
#pragma unroll
    for (int j = 0; j < 4; ++j) { const int n = (lane >> 3) + 8 * j; const LAS float* s = scr + (8 * c) * 33 + n;
        v4u o; o.x = pk2(s[0 * 33], s[1 * 33]); o.y = pk2(s[2 * 33], s[3 * 33]); o.z = pk2(s[4 * 33], s[5 * 33]); o.w = pk2(s[6 * 33], s[7 * 33]);
        *(v4u*)(dst + (size_t)n * lddst + 8 * c) = o; }
    LDS_WAIT(); asm volatile("" ::: "memory");
}

DEV void router_prep(const Args& a, int gw, int NGW, int lane) {
    const float* mod = (const float*)(a.ws + WS_MOD);
    const float* g2 = a.in[17]; const float* w_rg = a.in[18]; const float* b_rg = a.in[19]; const float* w_re = a.in[20]; const float* b_re = a.in[21];
    float* rbias = (float*)(a.ws + WS_RBIAS); v4u* rw = (v4u*)(a.ws + WS_RW);
    for (int it = gw; it < 8 * 36; it += NGW) { const int b = it / 36, n = it % 36; float sacc = 0.f;
#pragma unroll
        for (int i = 0; i < 16; ++i) { const int k = lane + 64 * i; const float w = (n < 4) ? w_rg[k * 4 + n] : w_re[k * 32 + n - 4]; sacc += mod[b * 6144 + 3072 + k] * w; }
        sacc = wave_sum(sacc);
        if (lane == 0) rbias[b * 48 + n] = sacc + ((n < 4) ? b_rg[n] : b_re[n - 4]); }
    for (int it = gw; it < 8 * 8 * 4 * 3; it += NGW) {
        const int nt = it % 3, kk = (it / 3) & 3, w8 = (it / 12) & 7, b = it / 96;
        const int n = 16 * nt + (lane & 15), k0 = 128 * w8 + 32 * kk + 8 * (lane >> 4);
        f32x4 w0, w1;
#pragma unroll
        for (int j = 0; j < 8; ++j) { const int k = k0 + j; const float* wp = (n < 4) ? (w_rg + k * 4 + n) : (w_re + k * 32 + ((n < 36) ? n - 4 : 0));
            float w = *wp; w = (n < 36) ? w : 0.f;
            w *= g2[k] * (1.f + mod[b * 6144 + 4096 + k]); if (j < 4) w0[j] = w; else w1[j - 4] = w; }
        bf16x8 hi, lo; split8(w0, w1, hi, lo);
        rw[((size_t)it * 2) * 64 + lane] = __builtin_bit_cast(v4u, hi); rw[((size_t)it * 2 + 1) * 64 + lane] = __builtin_bit_cast(v4u, lo);
    }
}
DEV void wait_mod(const Args& a, int tid) {
    if (tid == 0) {
        unsigned* mc = (unsigned*)(a.ws + WS_CTL) + CW_MODCNT; unsigned sp = 0;
        while (__hip_atomic_load(mc, __ATOMIC_RELAXED, __HIP_MEMORY_SCOPE_AGENT) < 192u) { __builtin_amdgcn_s_sleep(2); if (++sp > (1u << 22)) break; }
        __builtin_amdgcn_fence(__ATOMIC_ACQUIRE, "agent"); asm volatile("s_waitcnt vmcnt(0)" ::: "memory"); }
    __syncthreads();
}
DEV void p0_prologue(const Args& a, LAS unsigned char* lds, int bid, int G) {
    int tid = threadIdx.x; asm volatile("" : "+v"(tid));
    const int lane = tid & 63, wave = __builtin_amdgcn_readfirstlane(tid >> 6);
    const float* c = a.in[1]; const float* w_ada = a.in[2]; const float* b_ada = a.in[3];
    float* mod = (float*)(a.ws + WS_MOD);
    if (bid < 192) {
        LAS float* sil = (LAS float*)lds;
        LAS float* red = (LAS float*)(lds + 32768);
        for (int i = tid; i < 8192; i += NTHREADS) sil[i] = siluf_(c[i]);
        __syncthreads();
        for (int item = bid; item < 192; item += G) {
            const int n0 = item * 32, lg = lane >> 3, cq = lane & 7;
            float acc[8][4];
#pragma unroll
            for (int b = 0; b < 8; ++b)
#pragma unroll
                for (int j = 0; j < 4; ++j) acc[b][j] = 0.f;
#pragma unroll 4
            for (int j = 0; j < 16; ++j) { const int k = wave * 128 + j * 8 + lg; const f32x4 w = *(const f32x4*)(w_ada + (size_t)k * 6144 + n0 + cq * 4);
#pragma unroll
                for (int b = 0; b < 8; ++b) { const float s = sil[b * 1024 + k]; acc[b][0] += s * w[0]; acc[b][1] += s * w[1]; acc[b][2] += s * w[2]; acc[b][3] += s * w[3]; } }
#pragma unroll
            for (int b = 0; b < 8; ++b)
#pragma unroll
                for (int j = 0; j < 4; ++j) { float v = acc[b][j]; v += dpp0<0x128>(v); if ((lane & 8) == 0) red[(wave * 4 + (lane >> 4)) * 256 + b * 32 + cq * 4 + j] = v; }
            __syncthreads();
            if (tid < 256) { float s = 0.f;
#pragma unroll
                for (int w = 0; w < 32; ++w) s += red[w * 256 + tid];
                const int b = tid >> 5, col = tid & 31; mod[b * 6144 + n0 + col] = s + b_ada[n0 + col]; }
            asm volatile("s_waitcnt vmcnt(0)" ::: "memory");
            __syncthreads();
            if (tid == 0) { __builtin_amdgcn_fence(__ATOMIC_RELEASE, "agent"); asm volatile("s_waitcnt vmcnt(0)" ::: "memory");
                __hip_atomic_fetch_add((unsigned*)(a.ws + WS_CTL) + CW_MODCNT, 1u, __ATOMIC_RELAXED, __HIP_MEMORY_SCOPE_AGENT); }
        }
    }
    if (bid == G - 1) { const float* w_in0 = a.in[5]; float* wif = (float*)(a.ws + WS_WIF);
        for (int i = tid; i < 2048; i += NTHREADS) { const int k = i >> 1, hf = i & 1; *(f32x4*)(wif + k * 8 + 4 * hf) = *(const f32x4*)(w_in0 + (size_t)k * DIN + 3072 + 4 * hf); } }
    LAS float* scr = (LAS float*)(lds + wave * 16384);
    const int gw = bid * NWAVES + wave, NGW = G * NWAVES;
    const float* w_in = a.in[5]; const float* wco = a.in[11]; const float* wmo = a.in[15]; const float* wout = a.in[16];
    bf16* W1T = (bf16*)(a.ws + WS_W1T); bf16* W2T = (bf16*)(a.ws + WS_W2T); bf16* W3T = (bf16*)(a.ws + WS_W3T);
    constexpr int I1 = 16 * 160, I2 = 8 * 32, I3 = 16 * 32, NIT = I1 + 2 * I2 + I3;
    for (int it = gw; it < NIT; it += NGW) {
        int r = it;
        if (r < I1) { const int kb = r / 160, nb = r % 160, np = 32 * nb; int sc;
            if (np < 1024) { const int t = np >> 8, q = np & 255; sc = (q < 128) ? 128 * t + q : 512 + 128 * t + q - 128; } else if (np < 3072) sc = np; else sc = np + 8;
            transpose_item(w_in + (size_t)(64 * kb) * DIN + sc, DIN, W1T + (size_t)np * 1024 + 64 * kb, 1024, scr, lane); continue; }
        r -= I1;
        if (r < I2) { const int kb = r / 32, nb = r % 32; transpose_item(wco + (size_t)(64 * kb) * 1024 + 32 * nb, 1024, W2T + (size_t)(32 * nb) * 1024 + 64 * kb, 1024, scr, lane); continue; }
        r -= I2;
        if (r < I2) { const int kb = r / 32, nb = r % 32; transpose_item(wmo + (size_t)(64 * kb) * 1024 + 32 * nb, 1024, W2T + (size_t)(32 * nb) * 1024 + 512 + 64 * kb, 1024, scr, lane); continue; }
        r -= I2;
        { const int kb = r / 32, nb = r % 32; transpose_item(wout + (size_t)(64 * kb) * 1024 + 32 * nb, 1024, W3T + (size_t)(32 * nb) * 1024 + 64 * kb, 1024, scr, lane); }
    }
    if (G > 192 && bid >= 192) { wait_mod(a, tid); router_prep(a, (bid - 192) * NWAVES + wave, (G - 192) * NWAVES, lane); }
}

DEV void p1_h1(const Args& a, LAS unsigned char* lds, int bid, int G) {
    int tid = threadIdx.x; asm volatile("" : "+v"(tid));
    const int lane = tid & 63, wave = __builtin_amdgcn_readfirstlane(tid >> 6);
    if (tid == 0) {
        unsigned* mc = (unsigned*)(a.ws + WS_CTL) + CW_MODCNT; unsigned sp = 0;
        while (__hip_atomic_load(mc, __ATOMIC_RELAXED, __HIP_MEMORY_SCOPE_AGENT) < 192u) { __builtin_amdgcn_s_sleep(2); if (++sp > (1u << 22)) break; }
        __builtin_amdgcn_fence(__ATOMIC_ACQUIRE, "agent"); asm volatile("s_waitcnt vmcnt(0)" ::: "memory"); }
    __syncthreads();
    const float* x = a.in[0]; const float* g1 = a.in[4]; const float* w_in = a.in[5]; const float* b_if = a.in[6];
    const float* mod = (const float*)(a.ws + WS_MOD); bf16* h1 = (bf16*)(a.ws + WS_H); float* gates = (float*)(a.ws + WS_GATES);
    LAS float* tab = (LAS float*)lds;
    for (int k = tid; k < 1024; k += NTHREADS) { const int p = ((k >> 8) << 2) | (k & 3), l = (k >> 2) & 63;
        const f32x4 w0 = *(const f32x4*)(w_in + (size_t)k * DIN + 3072), w1 = *(const f32x4*)(w_in + (size_t)k * DIN + 3076);
        *(LAS f32x4*)(tab + (p * 64 + l) * 8) = w0; *(LAS f32x4*)(tab + (p * 64 + l) * 8 + 4) = w1; }
    __syncthreads();
    if (G <= 192) router_prep(a, bid * NWAVES + wave, G * NWAVES, lane);
    const float bifv = b_if[lane & 7];
    for (int tile = bid; tile < T / 64; tile += G) {
        const int b = tile / 32;
        float sc[4][4], sh[4][4];
#pragma unroll
        for (int j = 0; j < 4; ++j) { const int k = 256 * j + 4 * lane; const f32x4 gv = *(const f32x4*)(g1 + k), sv = *(const f32x4*)(mod + b * 6144 + 1024 + k), hv = *(const f32x4*)(mod + b * 6144 + k);
#pragma unroll
            for (int i = 0; i < 4; ++i) { sc[j][i] = gv[i] * (1.f + sv[i]); sh[j][i] = hv[i]; } }
        f32x4 xr[2][4];
#pragma unroll
        for (int p = 0; p < 2; ++p)
#pragma unroll
            for (int j = 0; j < 4; ++j) xr[p][j] = *(const f32x4*)(x + ((size_t)tile * 64 + wave + 8 * p) * 1024 + 256 * j + 4 * lane);
#pragma unroll 1
        for (int gq = 0; gq < 4; ++gq) {
            float rstd[2];
#pragma unroll
            for (int p = 0; p < 2; ++p) { float ss = 0.f;
#pragma unroll
                for (int j = 0; j < 4; ++j) { const f32x4 v = xr[p][j]; ss += (v[0] * v[0] + v[1] * v[1]) + (v[2] * v[2] + v[3] * v[3]); }
                rstd[p] = rsqrtf(wave_sum(ss) * (1.f / 1024.f) + RMS_EPS); }
            float g[2][8];
#pragma unroll
            for (int p = 0; p < 2; ++p)
#pragma unroll
                for (int q = 0; q < 8; ++q) g[p][q] = 0.f;
#pragma unroll
            for (int j = 0; j < 4; ++j) {
                float hh[2][4];
#pragma unroll
                for (int p = 0; p < 2; ++p) { const f32x4 v = xr[p][j]; const size_t row = (size_t)tile * 64 + wave + 8 * (2 * gq + p);
#pragma unroll
                    for (int i = 0; i < 4; ++i) hh[p][i] = v[i] * rstd[p] * sc[j][i] + sh[j][i];
                    if (gq < 3) xr[p][j] = *(const f32x4*)(x + (row + 16) * 1024 + 256 * j + 4 * lane);
                    v2u o; o.x = pk2(hh[p][0], hh[p][1]); o.y = pk2(hh[p][2], hh[p][3]);
                    *(v2u*)(h1 + row * 1024 + 256 * j + 4 * lane) = o; }
#pragma unroll
                for (int i = 0; i < 4; ++i) { const LAS float* tp = tab + ((4 * j + i) * 64 + lane) * 8; const f32x4 w0 = *(const LAS f32x4*)tp, w1 = *(const LAS f32x4*)(tp + 4);
#pragma unroll
                    for (int p = 0; p < 2; ++p) { const float hv = hh[p][i];
                        g[p][0] += hv * w0[0]; g[p][1] += hv * w0[1]; g[p][2] += hv * w0[2]; g[p][3] += hv * w0[3]; g[p][4] += hv * w1[0]; g[p][5] += hv * w1[1]; g[p][6] += hv * w1[2]; g[p][7] += hv * w1[3]; } }
                asm volatile("" ::: "memory");
            }
#pragma unroll
            for (int p = 0; p < 2; ++p) { const size_t row = (size_t)tile * 64 + wave + 8 * (2 * gq + p); float mine = 0.f;
#pragma unroll
                for (int q = 0; q < 8; ++q) { const float sq = wave_sum(g[p][q]); mine = (lane == q) ? sq : mine; }
                if (lane < 8) { const float vv = mine + bifv; gates[row * 8 + lane] = (lane < 4) ? vv : logsigmoidf_(vv); } }
        }
    }
}

DEV void p1_h1_mfma(const Args& a, LAS unsigned char* lds, int bid, int G) {
    int tid = threadIdx.x; asm volatile("" : "+v"(tid));
    const int lane = tid & 63, wave = __builtin_amdgcn_readfirstlane(tid >> 6), l15 = lane & 15, q4 = lane >> 4;
    if (tid == 0) {
        unsigned* mc = (unsigned*)(a.ws + WS_CTL) + CW_MODCNT; unsigned sp = 0;
        while (__hip_atomic_load(mc, __ATOMIC_RELAXED, __HIP_MEMORY_SCOPE_AGENT) < 192u) { __builtin_amdgcn_s_sleep(2); if (++sp > (1u << 22)) break; }
        __builtin_amdgcn_fence(__ATOMIC_ACQUIRE, "agent"); asm volatile("s_waitcnt vmcnt(0)" ::: "memory"); }
    __syncthreads();
    const float* x = a.in[0]; const float* g1 = a.in[4]; const float* b_if = a.in[6];
    const float* mod = (const float*)(a.ws + WS_MOD); bf16* h1 = (bf16*)(a.ws + WS_H); float* gates = (float*)(a.ws + WS_GATES);
    LAS float* PL = (LAS float*)lds;
    LAS float* SS = (LAS float*)(lds + 32768);
    LAS float* RS = (LAS float*)(lds + 34816);
    LAS float* GB = (LAS float*)(lds + 35072);
    LAS float* WF = (LAS float*)(lds + 36864);
    { const float* wif = (const float*)(a.ws + WS_WIF); for (int i = tid; i < 2048; i += NTHREADS) *(LAS f32x4*)(WF + 4 * i) = *(const f32x4*)(wif + 4 * i); }
    {
        const float* g2 = a.in[17]; const float* w_rg = a.in[18]; const float* b_rg = a.in[19]; const float* w_re = a.in[20]; const float* b_re = a.in[21];
        float* rbias = (float*)(a.ws + WS_RBIAS); v4u* rw = (v4u*)(a.ws + WS_RW);
        const int gw = bid * NWAVES + wave, NGW = G * NWAVES;
        for (int it = gw; it < 8 * 36; it += NGW) { const int b = it / 36, n = it % 36; float sacc = 0.f;
#pragma unroll
            for (int i = 0; i < 16; ++i) { const int k = lane + 64 * i; const float w = (n < 4) ? w_rg[k * 4 + n] : w_re[k * 32 + n - 4]; sacc += mod[b * 6144 + 3072 + k] * w; }
            sacc = wave_sum(sacc);
            if (lane == 0) rbias[b * 48 + n] = sacc + ((n < 4) ? b_rg[n] : b_re[n - 4]); }
        for (int it = gw; it < 8 * 8 * 4 * 3; it += NGW) {
            const int nt = it % 3, kk = (it / 3) & 3, w8 = (it / 12) & 7, b = it / 96;
            const int n = 16 * nt + (lane & 15), k0 = 128 * w8 + 32 * kk + 8 * (lane >> 4);
            f32x4 w0, w1;
#pragma unroll
            for (int j = 0; j < 8; ++j) { const int k = k0 + j; const float* wp = (n < 4) ? (w_rg + k * 4 + n) : (w_re + k * 32 + ((n < 36) ? n - 4 : 0));
                float w = *wp; w = (n < 36) ? w : 0.f;
                w *= g2[k] * (1.f + mod[b * 6144 + 4096 + k]); if (j < 4) w0[j] = w; else w1[j - 4] = w; }
            bf16x8 hi, lo; split8(w0, w1, hi, lo);
            rw[((size_t)it * 2) * 64 + lane] = __builtin_bit_cast(v4u, hi); rw[((size_t)it * 2 + 1) * 64 + lane] = __builtin_bit_cast(v4u, lo);
        }
    }
    for (int tile = bid; tile < T / 64; tile += G) {
        const int b = tile / 32, ncol = (l15 < 8) ? l15 : 0;
        __syncthreads();
        {
            float sacc = 0.f;
#pragma unroll
            for (int i = 0; i < 16; ++i) { const int k = lane + 64 * i; sacc += mod[b * 6144 + k] * WF[k * 8 + wave]; }
            sacc = wave_sum(sacc);
            if (lane == 0) GB[wave] = sacc + b_if[wave];
        }
        f32x4 acc[4]; float ss[4];
#pragma unroll
        for (int rt = 0; rt < 4; ++rt) { ss[rt] = 0.f; acc[rt] = (f32x4){0.f, 0.f, 0.f, 0.f}; }
#pragma unroll
        for (int kk = 0; kk < 4; ++kk) {
            const int k0 = 128 * wave + 32 * kk + 8 * q4;
            bf16x8 bhi, blo;
            { const f32x4 ga = *(const f32x4*)(g1 + k0), gb = *(const f32x4*)(g1 + k0 + 4), sa = *(const f32x4*)(mod + b * 6144 + 1024 + k0), sb = *(const f32x4*)(mod + b * 6144 + 1024 + k0 + 4);
                f32x4 w0, w1;
#pragma unroll
                for (int jj = 0; jj < 4; ++jj) { float wa = WF[(k0 + jj) * 8 + ncol], wb = WF[(k0 + 4 + jj) * 8 + ncol];
                    wa = (l15 < 8) ? wa : 0.f; wb = (l15 < 8) ? wb : 0.f; w0[jj] = wa * ga[jj] * (1.f + sa[jj]); w1[jj] = wb * gb[jj] * (1.f + sb[jj]); }
                split8(w0, w1, bhi, blo); }
#pragma unroll
            for (int rt = 0; rt < 4; ++rt) {
                const float* xp = x + ((size_t)tile * 64 + 16 * rt + l15) * 1024 + k0;
                const f32x4 xa = *(const f32x4*)xp, xb = *(const f32x4*)(xp + 4);
                ss[rt] += (xa[0] * xa[0] + xa[1] * xa[1]) + (xa[2] * xa[2] + xa[3] * xa[3]) + (xb[0] * xb[0] + xb[1] * xb[1]) + (xb[2] * xb[2] + xb[3] * xb[3]);
                bf16x8 ahi, alo; split8(xa, xb, ahi, alo);
                acc[rt] = mma16(ahi, bhi, acc[rt]); acc[rt] = mma16(alo, bhi, acc[rt]); acc[rt] = mma16(ahi, blo, acc[rt]);
            }
        }
#pragma unroll
        for (int rt = 0; rt < 4; ++rt) {
            float sv = ss[rt]; sv += __shfl_xor(sv, 16); sv += __shfl_xor(sv, 32);
            if (q4 == 0) SS[wave * 64 + 16 * rt + l15] = sv;
#pragma unroll
            for (int r = 0; r < 4; ++r) PL[(wave * 64 + 16 * rt + 4 * q4 + r) * 16 + l15] = acc[rt][r];
        }
        __syncthreads();
        {
            const int row = tid >> 3, n = tid & 7; float ssum = 0.f, sg = 0.f;
#pragma unroll
            for (int w = 0; w < 8; ++w) { ssum += SS[w * 64 + row]; sg += PL[(w * 64 + row) * 16 + n]; }
            const float rstd = rsqrtf(ssum * (1.f / 1024.f) + RMS_EPS);
            if (n == 0) RS[row] = rstd;
            const float vv = rstd * sg + GB[n];
            gates[((size_t)tile * 64 + row) * 8 + n] = (n < 4) ? vv : logsigmoidf_(vv);
        }
        __syncthreads();
        {
            float sc[4][4], sh[4][4];
#pragma unroll
            for (int j = 0; j < 4; ++j) { const int k = 256 * j + 4 * lane; const f32x4 gv = *(const f32x4*)(g1 + k), sv = *(const f32x4*)(mod + b * 6144 + 1024 + k), hv = *(const f32x4*)(mod + b * 6144 + k);
#pragma unroll
                for (int i = 0; i < 4; ++i) { sc[j][i] = gv[i] * (1.f + sv[i]); sh[j][i] = hv[i]; } }
            f32x4 nx[4][4];
#pragma unroll
            for (int p = 0; p < 4; ++p)
#pragma unroll
                for (int j = 0; j < 4; ++j) nx[p][j] = *(const f32x4*)(x + ((size_t)tile * 64 + wave + 8 * p) * 1024 + 256 * j + 4 * lane);
#pragma unroll
            for (int r8 = 0; r8 < 8; ++r8) {
                const int r = wave + 8 * r8; const size_t row = (size_t)tile * 64 + r;
                f32x4 v[4];
#pragma unroll
                for (int j = 0; j < 4; ++j) v[j] = nx[r8 & 3][j];
                if (r8 + 4 < 8) {
#pragma unroll
                    for (int j = 0; j < 4; ++j) nx[r8 & 3][j] = *(const f32x4*)(x + (row + 32) * 1024 + 256 * j + 4 * lane); }
                asm volatile("" ::: "memory");
                const float rstd = RS[r];
#pragma unroll
                for (int j = 0; j < 4; ++j) { v2u o; o.x = pk2(v[j][0] * rstd * sc[j][0] + sh[j][0], v[j][1] * rstd * sc[j][1] + sh[j][1]); o.y = pk2(v[j][2] * rstd * sc[j][2] + sh[j][2], v[j][3] * rstd * sc[j][3] + sh[j][3]);
                    *(v2u*)(h1 + row * 1024 + 256 * j + 4 * lane) = o; }
            }
        }
    }
    __syncthreads();
}

DEV void p3_conva(const Args& a, LAS unsigned char* lds, const XDeal& X) {
    int tid = threadIdx.x; asm volatile("" : "+v"(tid));
    const int lane = tid & 63, wave = __builtin_amdgcn_readfirstlane(tid >> 6), sub = wave & 3, gsel = wave >> 2;
    const bf16* zu = (const bf16*)(a.ws + WS_ZU); bf16* uahm = (bf16*)(a.ws + WS_UAHM);
    const float* cw = a.in[7]; const float* cb = a.in[8]; const float* lg = a.in[9]; const float* lb = a.in[10];
    LAS float* red = (LAS float*)(lds + LDS_TAB);
    const int c0 = 128 * sub + 2 * lane;
    float w0[31], w1[31];
#pragma unroll
    for (int k = 0; k < 31; ++k) { w0[k] = cw[k * 512 + c0]; w1[k] = cw[k * 512 + c0 + 1]; }
    const float bias0 = cb[c0], bias1 = cb[c0 + 1], lg0 = lg[c0], lg1 = lg[c0 + 1], lb0 = lb[c0], lb1 = lb[c0 + 1];
    for (int ii = 0;; ++ii) {
        const int it = X.item(ii, SEQ / 32); if (it < 0) break;
        const int grp = it * 2 + gsel, tbase = grp * 16, s0 = tbase & (SEQ - 1);
        float acc0[16], acc1[16];
#pragma unroll
        for (int i = 0; i < 16; ++i) { acc0[i] = bias0; acc1[i] = bias1; }
#pragma unroll
        for (int r = 0; r < 46; ++r) {
            const int sp = s0 - 30 + r; const int src = tbase - 30 + r + ((sp < 0) ? -sp : 0); const float msk = (sp < 0) ? 0.f : 1.f;
            const unsigned wv = *(const unsigned*)(zu + (size_t)src * 512 + c0);
            const float u0 = bflo(wv) * msk, u1 = bfhi(wv) * msk;
#pragma unroll
            for (int i = 0; i < 16; ++i) { const int k = r - i; if (k >= 0 && k <= 30) { acc0[i] += w0[k] * u0; acc1[i] += w1[k] * u1; } }
        }
        float mean[16];
#pragma unroll
        for (int i = 0; i < 16; ++i) { const float s = wave_sum(acc0[i] + acc1[i]); if (lane == 0) red[(gsel * 4 + sub) * 16 + i] = s; }
        __syncthreads();
#pragma unroll
        for (int i = 0; i < 16; ++i) mean[i] = ((red[(gsel * 4 + 0) * 16 + i] + red[(gsel * 4 + 1) * 16 + i]) + (red[(gsel * 4 + 2) * 16 + i] + red[(gsel * 4 + 3) * 16 + i])) * (1.f / 512.f);
        __syncthreads();
#pragma unroll
        for (int i = 0; i < 16; ++i) { const float d0 = acc0[i] - mean[i], d1 = acc1[i] - mean[i]; const float s = wave_sum(d0 * d0 + d1 * d1); if (lane == 0) red[(gsel * 4 + sub) * 16 + i] = s; }
        __syncthreads();
#pragma unroll
        for (int i = 0; i < 16; ++i) {
            const float var = ((red[(gsel * 4 + 0) * 16 + i] + red[(gsel * 4 + 1) * 16 + i]) + (red[(gsel * 4 + 2) * 16 + i] + red[(gsel * 4 + 3) * 16 + i])) * (1.f / 512.f);
            const float rstd = rsqrtf(var + LN_EPS);
            const float y0 = (acc0[i] - mean[i]) * rstd * lg0 + lb0, y1 = (acc1[i] - mean[i]) * rstd * lg1 + lb1;
            *(unsigned*)(uahm + (size_t)(tbase + i) * 1024 + c0) = pk2(siluf_(y0), siluf_(y1));
        }
        __syncthreads();
    }
}

constexpr int ML_QS = 0, ML_KS = 17408, ML_KWT = 34816, ML_VT = 53248, ML_PS = 73984, ML_CT = 83200, ML_GT = 122368, ML_CW = 123648, ML_DEN = 128768, ML_PART = 129024, ML_VS = 130048;
template <bool OUT>
DEV void mlstm_unit(const Args& a, LAS unsigned char* lds, int unit) {
    int tid = threadIdx.x; asm volatile("" : "+v"(tid));
    const int lane = tid & 63, wave = __builtin_amdgcn_readfirstlane(tid >> 6), l15 = lane & 15, q4 = lane >> 4;
    const int j = unit & 7, bh = unit >> 3, h = bh & 3, b = bh >> 2, t0 = b * SEQ + 256 * j;
    const bf16* zq = (const bf16*)(a.ws + WS_ZQ); const bf16* zk = (const bf16*)(a.ws + WS_ZK); const bf16* zv = (const bf16*)(a.ws + WS_ZV); const bf16* zo = (const bf16*)(a.ws + WS_ZO);
    const float* gates = (const float*)(a.ws + WS_GATES); v2u* stateh = (v2u*)(a.ws + WS_STATE); float* stsc = (float*)(a.ws + WS_STSC);
    bf16* uahm = (bf16*)(a.ws + WS_UAHM); const float* qkw = a.in[12]; const float* qkb = a.in[13]; const float* mng = a.in[14];
    LAS bf16* QS = (LAS bf16*)(lds + ML_QS); LAS bf16* KS = (LAS bf16*)(lds + ML_KS); LAS bf16* KWT = (LAS bf16*)(lds + ML_KWT); LAS bf16* VT = (LAS bf16*)(lds + ML_VT);
    LAS bf16* PS = (LAS bf16*)(lds + ML_PS); LAS bf16* CT = (LAS bf16*)(lds + ML_CT); LAS bf16* VS = (LAS bf16*)(lds + ML_VS);
    LAS float* GTwk = (LAS float*)(lds + ML_GT); LAS float* GTsi = GTwk + 64; LAS float* GTlb = GTwk + 128; LAS float* GTg = GTwk + 192; LAS float* GTM = GTwk + 256;
    LAS float* CW = (LAS float*)(lds + ML_CW); LAS float* DEN = (LAS float*)(lds + ML_DEN); LAS float* PART = (LAS float*)(lds + ML_PART);
    __syncthreads();
    for (int i = tid; i < 1280; i += NTHREADS) {
        const float* p = (i < 512) ? (qkw + (i >> 7) * 1024 + h * 128 + (i & 127)) : (i < 1024) ? (qkw + ((i - 512) >> 7) * 1024 + 512 + h * 128 + (i & 127))
                       : (i < 1152) ? (qkb + h * 128 + (i - 1024)) : (qkb + 512 + h * 128 + (i - 1152));
        CW[i] = *p; }
    for (int i = tid; i < 16 * 72; i += NTHREADS) VT[128 * 72 + i] = (i < 64) ? (bf16)0x3F80 : (bf16)0;
    f32x4 accC[9];
#pragma unroll
    for (int i = 0; i < 9; ++i) accC[i] = (f32x4){0.f, 0.f, 0.f, 0.f};
    float mc = OUT ? 0.f : -1e30f, Btot = 0.f;
    if (OUT) {
        float wgt[7];
        {
            const int base = unit - j; float mi[7], Bi[7];
#pragma unroll
            for (int i = 0; i < 7; ++i) { const int u2 = base + ((i < j) ? i : 0); mi[i] = stsc[u2 * 4]; Bi[i] = stsc[u2 * 4 + 1]; }
#pragma unroll
            for (int i = 0; i < 7; ++i) if (i < j) mc = fmaxf(Bi[i] + mc, mi[i]);
            float suf = 0.f;
#pragma unroll
            for (int i = 6; i >= 0; --i) { wgt[i] = (i < j) ? __expf(mi[i] + suf - mc) : 0.f; if (i < j) suf += Bi[i]; }
        }
#pragma unroll
        for (int ii = 0; ii < 9; ++ii) {
            v2u ld[7];
#pragma unroll
            for (int i = 0; i < 7; ++i) { ld[i] = (v2u){0u, 0u}; if (i < j) ld[i] = stateh[((size_t)(unit - j + i) * 9 + ii) * 512 + tid]; }
#pragma unroll
            for (int i = 0; i < 7; ++i) { const f32x4 v = (f32x4){bflo(ld[i].x), bfhi(ld[i].x), bflo(ld[i].y), bfhi(ld[i].y)}; accC[ii] = accC[ii] + v * wgt[i]; }
        }
#pragma unroll
        for (int ii = 0; ii < 9; ++ii)
#pragma unroll
            for (int r = 0; r < 4; ++r) CT[(16 * ii + 4 * q4 + r) * 136 + 16 * wave + l15] = f2bf(accC[ii][r]);
    }
    __syncthreads();
    float li_n = gates[(size_t)(t0 + lane) * 8 + h], lf_n = gates[(size_t)(t0 + lane) * 8 + 4 + h];
    const int ncc = (OUT && (a.flags & 4096)) ? 1 : 4; const bool skipAB = OUT && (a.flags & 16384), skipQ = OUT && (a.flags & 32768);
    for (int cc = 0; cc < ncc; ++cc) {
        const int tc = t0 + 64 * cc;
        const float li = li_n, lf = lf_n;
        if (cc < 3) { li_n = gates[(size_t)(tc + 64 + lane) * 8 + h]; lf_n = gates[(size_t)(tc + 64 + lane) * 8 + 4 + h]; }
        const float bc = wave_scan_add(lf, lane);
        const float g = li - bc;
        const float cm = wave_scan_max(g, lane);
        const float M = fmaxf(mc, cm);
        const float M63 = rdlane(M, 63), blast = rdlane(bc, 63);
        const float wkv = __expf(g - M63), sc = __expf(mc - M63), mnew = blast + M63;
        if (wave == 0) { GTwk[lane] = wkv; GTsi[lane] = __expf(mc - M); GTlb[lane] = __expf(-(bc + M)); GTg[lane] = g; GTM[lane] = M; }
        {
            const int cg = tid & 15, rp = tid >> 4, s0 = 2 * rp;
            v4u kraw[5], qraw[5], vraw[2];
#pragma unroll
            for (int m = 0; m < 5; ++m) { const int spos = 256 * j + 64 * cc + s0 - 3 + m; const bool ok = spos >= 0; const int src = ok ? (tc + s0 - 3 + m) : tc;
                kraw[m] = *(const v4u*)(zk + (size_t)src * 512 + h * 128 + cg * 8); }
#pragma unroll
            for (int rr = 0; rr < 2; ++rr) vraw[rr] = *(const v4u*)(zv + (size_t)(tc + s0 + rr) * 512 + h * 128 + cg * 8);
#define ML_CONV(RAW, WOFF, BOFF, DST, SCALE) do { float ac[2][8]; \
            _Pragma("unroll") for (int e = 0; e < 8; ++e) { ac[0][e] = ac[1][e] = CW[(BOFF) + cg * 8 + e]; } \
            _Pragma("unroll") for (int m = 0; m < 5; ++m) { v4u rw_ = RAW[m]; if (256 * j + 64 * cc + s0 - 3 + m < 0) rw_ = (v4u){0u, 0u, 0u, 0u};     \
                const float xv[8] = {bflo(rw_.x), bfhi(rw_.x), bflo(rw_.y), bfhi(rw_.y), bflo(rw_.z), bfhi(rw_.z), bflo(rw_.w), bfhi(rw_.w)}; \
                _Pragma("unroll") for (int rr = 0; rr < 2; ++rr) { const int tap = m - rr; if (tap >= 0 && tap < 4) { \
                    _Pragma("unroll") for (int e = 0; e < 8; ++e) ac[rr][e] += CW[(WOFF) + tap * 128 + cg * 8 + e] * xv[e]; } } } \
            _Pragma("unroll") for (int rr = 0; rr < 2; ++rr) { v4u o; \
                o.x = pk2(siluf_(ac[rr][0]) * (SCALE), siluf_(ac[rr][1]) * (SCALE)); o.y = pk2(siluf_(ac[rr][2]) * (SCALE), siluf_(ac[rr][3]) * (SCALE)); \
                o.z = pk2(siluf_(ac[rr][4]) * (SCALE), siluf_(ac[rr][5]) * (SCALE)); o.w = pk2(siluf_(ac[rr][6]) * (SCALE), siluf_(ac[rr][7]) * (SCALE)); \
                *(LAS v4u*)((DST) + (s0 + rr) * 136 + cg * 8) = o; } } while (0)
            if (OUT && !skipQ) {
#pragma unroll
                for (int m = 0; m < 5; ++m) { const int spos = 256 * j + 64 * cc + s0 - 3 + m; const int src = (spos >= 0) ? (tc + s0 - 3 + m) : tc; qraw[m] = *(const v4u*)(zq + (size_t)src * 512 + h * 128 + cg * 8); } }
            ML_CONV(kraw, 512, 1152, KS, 1.f);
            asm volatile("" ::: "memory");
            if (OUT && !skipQ) ML_CONV(qraw, 0, 1024, QS, 0.08838834764831845f);
#undef ML_CONV
#pragma unroll
            for (int rr = 0; rr < 2; ++rr) *(LAS v4u*)(VS + (s0 + rr) * 136 + cg * 8) = vraw[rr];
        }
        __syncthreads();
        if (OUT && !skipAB) {
            const int tt = wave >> 1;
#pragma unroll
            for (int si = 0; si < 2; ++si) {
                const int st = 2 * (wave & 1) + si;
                f32x4 sacc = (f32x4){0.f, 0.f, 0.f, 0.f};
                if (st <= tt) {
#pragma unroll
                    for (int kk = 0; kk < 4; ++kk) sacc = mma16(*(const LAS bf16x8*)(QS + (16 * tt + l15) * 136 + 32 * kk + 8 * q4), *(const LAS bf16x8*)(KS + (16 * st + l15) * 136 + 32 * kk + 8 * q4), sacc);
                }
                const int sl = 16 * st + l15; const float gs = GTg[sl];
#pragma unroll
                for (int r = 0; r < 4; ++r) { const int tl = 16 * tt + 4 * q4 + r; const float w = (sl <= tl) ? __expf(gs - GTM[tl]) : 0.f; PS[tl * 72 + sl] = f2bf(sacc[r] * w); }
            }
        }
        {
            const int d = tid & 127, sg = tid >> 7; float kv[16];
#pragma unroll
            for (int i = 0; i < 16; ++i) kv[i] = bf2f(KS[(16 * sg + i) * 136 + d]) * GTwk[16 * sg + i];
            v4u o0, o1;
            o0.x = pk2(kv[0], kv[1]); o0.y = pk2(kv[2], kv[3]); o0.z = pk2(kv[4], kv[5]); o0.w = pk2(kv[6], kv[7]);
            o1.x = pk2(kv[8], kv[9]); o1.y = pk2(kv[10], kv[11]); o1.z = pk2(kv[12], kv[13]); o1.w = pk2(kv[14], kv[15]);
            *(LAS v4u*)(KWT + d * 72 + 16 * sg) = o0; *(LAS v4u*)(KWT + d * 72 + 16 * sg + 8) = o1;
            unsigned vw[8];
#pragma unroll
            for (int i = 0; i < 8; ++i) vw[i] = (unsigned)VS[(16 * sg + 2 * i) * 136 + d] | ((unsigned)VS[(16 * sg + 2 * i + 1) * 136 + d] << 16);
            o0.x = vw[0]; o0.y = vw[1]; o0.z = vw[2]; o0.w = vw[3]; o1.x = vw[4]; o1.y = vw[5]; o1.z = vw[6]; o1.w = vw[7];
            *(LAS v4u*)(VT + d * 72 + 16 * sg) = o0; *(LAS v4u*)(VT + d * 72 + 16 * sg + 8) = o1;
        }
        __syncthreads();
        f32x4 res[5];
        if (OUT && !skipAB) {
            const int tt = wave >> 1, dv0 = 4 * (wave & 1);
            bf16x8 pa[2], qa[4];
#pragma unroll
            for (int kk = 0; kk < 2; ++kk) pa[kk] = *(const LAS bf16x8*)(PS + (16 * tt + l15) * 72 + 32 * kk + 8 * q4);
#pragma unroll
            for (int kk = 0; kk < 4; ++kk) qa[kk] = *(const LAS bf16x8*)(QS + (16 * tt + l15) * 136 + 32 * kk + 8 * q4);
            float si[4];
#pragma unroll
            for (int r = 0; r < 4; ++r) si[r] = GTsi[16 * tt + 4 * q4 + r];
#pragma unroll
            for (int i = 0; i < 5; ++i) {
                const int dvt = (i < 4) ? (dv0 + i) : 8;
                if (i < 4 || (wave & 1) == 0) {
                    f32x4 a1 = (f32x4){0.f, 0.f, 0.f, 0.f}, a2 = (f32x4){0.f, 0.f, 0.f, 0.f};
#pragma unroll
                    for (int kk = 0; kk < 2; ++kk) a1 = mma16(pa[kk], *(const LAS bf16x8*)(VT + (16 * dvt + l15) * 72 + 32 * kk + 8 * q4), a1);
#pragma unroll
                    for (int kk = 0; kk < 4; ++kk) a2 = mma16(qa[kk], *(const LAS bf16x8*)(CT + (16 * dvt + l15) * 136 + 32 * kk + 8 * q4), a2);
#pragma unroll
                    for (int r = 0; r < 4; ++r) res[i][r] = a1[r] + si[r] * a2[r];
                } else res[i] = (f32x4){0.f, 0.f, 0.f, 0.f};
            }
            if ((wave & 1) == 0 && l15 == 0) {
#pragma unroll
                for (int r = 0; r < 4; ++r) DEN[16 * tt + 4 * q4 + r] = res[4][r];
            }
        }
        asm volatile("" ::: "memory");
        {
            bf16x8 kb[2];
#pragma unroll
            for (int kk = 0; kk < 2; ++kk) kb[kk] = *(const LAS bf16x8*)(KWT + (16 * wave + l15) * 72 + 32 * kk + 8 * q4);
#pragma unroll
            for (int i = 0; i < 9; ++i) { accC[i] = accC[i] * sc;
#pragma unroll
                for (int kk = 0; kk < 2; ++kk) accC[i] = mma16(*(const LAS bf16x8*)(VT + (16 * i + l15) * 72 + 32 * kk + 8 * q4), kb[kk], accC[i]); }
        }
        __syncthreads();
        if (OUT && !skipAB) {
            const int tt = wave >> 1;
            float den[4], lbv[4];
#pragma unroll
            for (int r = 0; r < 4; ++r) { den[r] = DEN[16 * tt + 4 * q4 + r]; lbv[r] = GTlb[16 * tt + 4 * q4 + r]; }
#pragma unroll
            for (int r = 0; r < 4; ++r) { const float inv = 1.f / fmaxf(fabsf(den[r]), lbv[r]); float s1 = 0.f, s2 = 0.f;
#pragma unroll
                for (int i = 0; i < 4; ++i) { res[i][r] *= inv; s1 += res[i][r]; s2 += res[i][r] * res[i][r]; }
                s1 = row16_sum(s1); s2 = row16_sum(s2);
                if (l15 == 0) { PART[((16 * tt + 4 * q4 + r) * 2 + (wave & 1)) * 2] = s1; PART[((16 * tt + 4 * q4 + r) * 2 + (wave & 1)) * 2 + 1] = s2; } }
#pragma unroll
            for (int ii = 0; ii < 9; ++ii)
#pragma unroll
                for (int r = 0; r < 4; ++r) CT[(16 * ii + 4 * q4 + r) * 136 + 16 * wave + l15] = f2bf(accC[ii][r]);
            __syncthreads();
            const int os = tid >> 3, ocg = tid & 7; const size_t orow = (size_t)(tc + os);
            const v4u zo0 = *(const v4u*)(zo + orow * 512 + h * 128 + 16 * ocg), zo1 = *(const v4u*)(zo + orow * 512 + h * 128 + 16 * ocg + 8);
            LAS float* YS = (LAS float*)(lds + ML_KWT);
#pragma unroll
            for (int r = 0; r < 4; ++r) { const int tl = 16 * tt + 4 * q4 + r;
                const float s1 = PART[(tl * 2) * 2] + PART[(tl * 2 + 1) * 2], s2 = PART[(tl * 2) * 2 + 1] + PART[(tl * 2 + 1) * 2 + 1];
                const float mean = s1 * (1.f / 128.f), var = fmaxf(s2 * (1.f / 128.f) - mean * mean, 0.f), rstd = rsqrtf(var + LN_EPS);
#pragma unroll
                for (int i = 0; i < 4; ++i) YS[tl * 132 + 16 * (4 * (wave & 1) + i) + l15] = (res[i][r] - mean) * rstd; }
            __syncthreads();
            {
                f32x4 yv[4];
#pragma unroll
                for (int q = 0; q < 4; ++q) yv[q] = *(const LAS f32x4*)(YS + os * 132 + 16 * ocg + 4 * q);
                f32x4 g0, g1, g2, g3; unpack8(zo0, g0, g1); unpack8(zo1, g2, g3);
                { const float* mp = mng + h * 128 + 16 * ocg; g0 = g0 * *(const f32x4*)mp; g1 = g1 * *(const f32x4*)(mp + 4); g2 = g2 * *(const f32x4*)(mp + 8); g3 = g3 * *(const f32x4*)(mp + 12); }
                *(v4u*)(uahm + orow * 1024 + 512 + h * 128 + 16 * ocg) = pack8(yv[0] * g0, yv[1] * g1);
                *(v4u*)(uahm + orow * 1024 + 512 + h * 128 + 16 * ocg + 8) = pack8(yv[2] * g2, yv[3] * g3);
            }
        }
        mc = mnew; Btot += blast;
    }
    if (!OUT) {
#pragma unroll
        for (int ii = 0; ii < 9; ++ii) { v2u pk; pk.x = pk2(accC[ii][0], accC[ii][1]); pk.y = pk2(accC[ii][2], accC[ii][3]); stateh[((size_t)unit * 9 + ii) * 512 + tid] = pk; }
        if (tid == 0) { stsc[unit * 4] = mc; stsc[unit * 4 + 1] = Btot; }
    }
}

DEV void p8_route(const Args& a, LAS unsigned char* lds, const XDeal& X) {
    int tid = threadIdx.x; asm volatile("" : "+v"(tid));
    const int lane = tid & 63, wave = __builtin_amdgcn_readfirstlane(tid >> 6), l15 = lane & 15, q4 = lane >> 4;
    const float* x1 = a.out; const float* g2 = a.in[17]; const float* w_rg = a.in[18]; const float* w_re = a.in[20];
    const float* mod = (const float*)(a.ws + WS_MOD); const float* rbias = (const float*)(a.ws + WS_RBIAS); const v4u* rw = (const v4u*)(a.ws + WS_RW); bf16* h2 = (bf16*)(a.ws + WS_H);
    int* toke = (int*)(a.ws + WS_TOKE); float* tokw = (float*)(a.ws + WS_TOKW);
    int* listt = (int*)(a.ws + WS_LISTT); float* listw = (float*)(a.ws + WS_LISTW); unsigned* cnt = (unsigned*)(a.ws + WS_CTL) + CW_CNT;
    LAS float* PL = (LAS float*)lds;
    LAS float* SS = (LAS float*)(lds + 98304);
    LAS float* LG = (LAS float*)(lds + 100352);
    LAS float* RS = (LAS float*)(lds + 109568);
    LAS unsigned* lcnt = (LAS unsigned*)(lds + LDS_MISC + 256);
    LAS unsigned* lbase = lcnt + 32;
    LAS unsigned* lent = lcnt + 64;
    LAS float* lwt = (LAS float*)(lcnt + 192);
    for (int ti = 0;; ++ti) {
        const int tile = X.item(ti, SEQ / 64); if (tile < 0) break;
        const int b = tile / 32;
        __syncthreads();
        if (tid < 32) lcnt[tid] = 0u;
        f32x4 acc[4][3]; float ss[4];
#pragma unroll
        for (int rt = 0; rt < 4; ++rt) { ss[rt] = 0.f;
#pragma unroll
            for (int nt = 0; nt < 3; ++nt) acc[rt][nt] = (f32x4){0.f, 0.f, 0.f, 0.f}; }
#pragma unroll 1
        for (int kk = 0; kk < 4; ++kk) {
            const int k0 = 128 * wave + 32 * kk + 8 * q4;
            bf16x8 bhi[3], blo[3];
#pragma unroll
            for (int nt = 0; nt < 3; ++nt) { const size_t it = ((size_t)(b * 8 + wave) * 4 + kk) * 3 + nt;
                bhi[nt] = __builtin_bit_cast(bf16x8, rw[(it * 2) * 64 + lane]); blo[nt] = __builtin_bit_cast(bf16x8, rw[(it * 2 + 1) * 64 + lane]); }
#pragma unroll
            for (int rt = 0; rt < 4; ++rt) {
                const float* xp = x1 + ((size_t)tile * 64 + 16 * rt + l15) * 1024 + k0;
                const f32x4 xa = *(const f32x4*)xp, xb = *(const f32x4*)(xp + 4);
                ss[rt] += (xa[0] * xa[0] + xa[1] * xa[1]) + (xa[2] * xa[2] + xa[3] * xa[3]) + (xb[0] * xb[0] + xb[1] * xb[1]) + (xb[2] * xb[2] + xb[3] * xb[3]);
                bf16x8 ahi, alo; split8(xa, xb, ahi, alo);
#pragma unroll
                for (int nt = 0; nt < 3; ++nt) { acc[rt][nt] = mma16(ahi, bhi[nt], acc[rt][nt]); acc[rt][nt] = mma16(alo, bhi[nt], acc[rt][nt]); acc[rt][nt] = mma16(ahi, blo[nt], acc[rt][nt]); }
            }
        }
#pragma unroll
        for (int rt = 0; rt < 4; ++rt) {
            float sv = ss[rt]; sv += __shfl_xor(sv, 16); sv += __shfl_xor(sv, 32);
            if (q4 == 0) SS[wave * 64 + 16 * rt + l15] = sv;
#pragma unroll
            for (int nt = 0; nt < 3; ++nt)
#pragma unroll
                for (int r = 0; r < 4; ++r) PL[(wave * 64 + 16 * rt + 4 * q4 + r) * 48 + 16 * nt + l15] = acc[rt][nt][r];
        }
        __syncthreads();
        {
            const int row = tid >> 3, part = tid & 7;
            float ssum = 0.f;
#pragma unroll
            for (int w = 0; w < 8; ++w) ssum += SS[w * 64 + row];
            const float rstd = rsqrtf(ssum * (1.f / 1024.f) + RMS_EPS);
            if (part == 0) RS[row] = rstd;
#pragma unroll
            for (int i = 0; i < 5; ++i) { const int n = part + 8 * i; if (n < 36) { float s = 0.f;
#pragma unroll
                    for (int w = 0; w < 8; ++w) s += PL[(w * 64 + row) * 48 + n];
                    LG[row * 36 + n] = rstd * s + rbias[b * 48 + n]; } }
        }
        __syncthreads();
        if (tid < 64) {
            const int r = tid; const size_t row = (size_t)tile * 64 + r;
            float lg[36];
#pragma unroll
            for (int q = 0; q < 36; ++q) lg[q] = LG[r * 36 + q];
            int gs = 0; float gm = lg[0];
#pragma unroll
            for (int q = 1; q < 4; ++q) if (lg[q] > gm) { gm = lg[q]; gs = q; }
            float se = 0.f;
#pragma unroll
            for (int q = 0; q < 4; ++q) se += __expf(lg[q] - gm);
            const float pg = 1.f / se;
            float le[8];
#pragma unroll
            for (int q = 0; q < 8; ++q) { float vsel = lg[4 + q];
#pragma unroll
                for (int gg = 1; gg < 4; ++gg) vsel = (gs == gg) ? lg[4 + 8 * gg + q] : vsel;
                le[q] = vsel; }
            int e0 = 0; float l0 = le[0];
#pragma unroll
            for (int q = 1; q < 8; ++q) if (le[q] > l0) { l0 = le[q]; e0 = q; }
            int e1 = -1; float l1 = -3.0e38f;
#pragma unroll
            for (int q = 0; q < 8; ++q) if (q != e0 && le[q] > l1) { l1 = le[q]; e1 = q; }
            const float rr = __expf(l1 - l0), w0 = pg / (1.f + rr), w1 = pg * rr / (1.f + rr);
#pragma unroll
            for (int sl = 0; sl < 2; ++sl) { const int e = gs * 8 + (sl ? e1 : e0); const float w = sl ? w1 : w0;
                toke[row * 2 + sl] = e; tokw[row * 2 + sl] = w;
                const unsigned lp = __hip_atomic_fetch_add(lcnt + e, 1u, __ATOMIC_RELAXED, __HIP_MEMORY_SCOPE_WORKGROUP);
                lent[r * 2 + sl] = (unsigned)e | (lp << 8); lwt[r * 2 + sl] = w; }
        }
        __syncthreads();
        if (tid < 32 && !(a.flags & 2)) { const unsigned n = lcnt[tid]; lbase[tid] = n ? atomicAdd(cnt + 16 * tid, n) : 0u; }
        {
            float sc[4][4], sh[4][4];
#pragma unroll
            for (int j = 0; j < 4; ++j) { const int k = 256 * j + 4 * lane; const f32x4 gv = *(const f32x4*)(g2 + k), sv = *(const f32x4*)(mod + b * 6144 + 4096 + k), hv = *(const f32x4*)(mod + b * 6144 + 3072 + k);
#pragma unroll
                for (int i = 0; i < 4; ++i) { sc[j][i] = gv[i] * (1.f + sv[i]); sh[j][i] = hv[i]; } }
            f32x4 nx[4];
#pragma unroll
            for (int j = 0; j < 4; ++j) nx[j] = *(const f32x4*)(x1 + ((size_t)tile * 64 + wave) * 1024 + 256 * j + 4 * lane);
#pragma unroll 1
            for (int r = wave; r < 64; r += NWAVES) {
                const size_t row = (size_t)tile * 64 + r; f32x4 v[4];
#pragma unroll
                for (int j = 0; j < 4; ++j) v[j] = nx[j];
                if (r + NWAVES < 64) {
#pragma unroll
                    for (int j = 0; j < 4; ++j) nx[j] = *(const f32x4*)(x1 + (row + NWAVES) * 1024 + 256 * j + 4 * lane); }
                asm volatile("" ::: "memory");
                const float rstd = RS[r];
#pragma unroll
                for (int j = 0; j < 4; ++j) { v2u o; o.x = pk2(v[j][0] * rstd * sc[j][0] + sh[j][0], v[j][1] * rstd * sc[j][1] + sh[j][1]); o.y = pk2(v[j][2] * rstd * sc[j][2] + sh[j][2], v[j][3] * rstd * sc[j][3] + sh[j][3]);
                    *(v2u*)(h2 + row * 1024 + 256 * j + 4 * lane) = o; }
            }
        }
        __syncthreads();
        if (tid < 128 && !(a.flags & 2)) { const unsigned en = lent[tid]; const unsigned e = en & 255u, lp = en >> 8; const unsigned pos = lbase[e] + lp;
            listt[e * 16384 + pos] = (tile * 64 + (tid >> 1)) * 2 + (tid & 1); listw[e * 16384 + pos] = lwt[tid]; }
    }
    __syncthreads();
}
DEV void p8_convert(const Args& a, LAS unsigned char* lds, int bid, int G) {
    int tid = threadIdx.x; asm volatile("" : "+v"(tid));
    const int lane = tid & 63, wave = __builtin_amdgcn_readfirstlane(tid >> 6);
    LAS float* scr = (LAS float*)(lds + wave * 16384);
    const float* wg = a.in[22]; const float* wu = a.in[23]; const float* wd = a.in[24];
    bf16* WGU = (bf16*)(a.ws + WS_WGU); bf16* WD = (bf16*)(a.ws + WS_WD);
    const int gw = bid * NWAVES + wave, NGW = G * NWAVES;
    for (int it = gw; it < 32 * 768; it += NGW) {
        const int e = it / 768; int r = it % 768;
        if (r < 512) { const int up = r >> 8; r &= 255; const int kb = r >> 4, nb = r & 15, n = 32 * nb, np = 256 * (n >> 7) + 128 * up + (n & 127);
            transpose_item((up ? wu : wg) + (size_t)e * 1024 * 512 + (size_t)(64 * kb) * 512 + n, 512, WGU + ((size_t)e * 1024 + np) * 1024 + 64 * kb, 1024, scr, lane); }
        else { r -= 512; const int kb = r >> 5, nb = r & 31;
            transpose_item(wd + (size_t)e * 512 * 1024 + (size_t)(64 * kb) * 1024 + 32 * nb, 1024, WD + ((size_t)e * 1024 + 32 * nb) * 512 + 64 * kb, 512, scr, lane); }
    }
}

struct MoeSched {
    const LAS int* tlist; const LAS int* rstart; const LAS int* ecnt; int U, G, c; unsigned bstride;
    DEV bool next(int i, Unit& u) const {
        const int L = i * G + c; if (L >= U) return false;
        const int ent = tlist[L >> 2]; const int e = ent & 255, rt = ent >> 8; u.pn = L & 3;
        const int left = ecnt[e] - 256 * rt;
        u.pm = 0; u.ak = 0; u.bk = (unsigned)e * bstride; u.slot = i; u.valid = left < 256 ? left : 256; u.arow0 = rstart[e] + 256 * rt; return true;
    }
};
DEV void moe_tables(const Args& a, LAS unsigned char* lds, int bid, int G, MoeSched& S, bool down) {
    int tid = threadIdx.x; asm volatile("" : "+v"(tid));
    LAS int* ti = (LAS int*)(lds + LDS_MISC + 1024); LAS int* rstart = ti, *ecnt = ti + 40, *tlist = ti + 80, *ntl = ti + 260;
    const unsigned* cnt = (const unsigned*)(a.ws + WS_CTL) + CW_CNT;
    const int* listt = (const int*)(a.ws + WS_LISTT); const float* listw = (const float*)(a.ws + WS_LISTW);
    __syncthreads();
    if (tid < 64) {
        const int lane = tid; const int n = (lane < 32) ? (int)__hip_atomic_load(cnt + 16 * (lane & 31), __ATOMIC_RELAXED, __HIP_MEMORY_SCOPE_AGENT) : 0;
        const int ntile = (n + 255) >> 8, nfull = (n + 127) >> 8, ntail = ntile - nfull;
        const int rs = (int)wave_scan_add((float)n, lane) - n, of = (int)wave_scan_add((float)nfull, lane) - nfull, ot = (int)wave_scan_add((float)ntail, lane) - ntail;
        const int totf = (int)rdlane(wave_scan_add((float)nfull, lane), 63), tott = (int)rdlane(wave_scan_add((float)ntail, lane), 63);
        if (lane < 32) { ecnt[lane] = n; rstart[lane] = rs;
            for (int rt = 0; rt < nfull; ++rt) tlist[of + rt] = lane | (rt << 8);
            if (ntail) tlist[totf + ot] = lane | (nfull << 8); }
        if (lane == 32) rstart[32] = rs;
        if (lane == 0) ntl[0] = totf + tott;
    }
    __syncthreads();
    S.tlist = tlist; S.rstart = rstart; S.ecnt = ecnt; S.U = 4 * ntl[0]; S.G = G;
    S.c = (G % 8 == 0) ? (bid % 8) * (G / 8) + bid / 8 : bid;
    LAS unsigned* tab0 = (LAS unsigned*)(lds + LDS_TAB); LAS float* tab1 = (LAS float*)(lds + LDS_TAB + 8192);
    Unit u;
    for (int i = 0; i < 8 && S.next(i, u); ++i) {
        if (tid < 256) { const int e = (int)(u.bk / S.bstride); const int pos = (u.arow0 - rstart[e]) + tid; unsigned v0 = 0u; float v1 = 0.f;
            if (tid < u.valid) { const int tk = listt[e * 16384 + pos]; v0 = down ? (unsigned)tk : (unsigned)(tk >> 1) * 2048u; v1 = listw[e * 16384 + pos]; }
            tab0[i * 256 + tid] = v0; tab1[i * 256 + tid] = v1; }
    }
    __syncthreads();
}

DEV void p11_final(const Args& a, int bid, int G) {
    int tid = threadIdx.x; asm volatile("" : "+v"(tid));
    const int lane = tid & 63, wave = __builtin_amdgcn_readfirstlane(tid >> 6);
    const float* mod = (const float*)(a.ws + WS_MOD); const bf16* ys = (const bf16*)(a.ws + WS_YS); const float* gf = a.in[25]; float* out = a.out;
    float* outw = (a.flags & 65536) ? (float*)(a.ws + WS_WGU) : a.out;
    for (int tile = bid; tile < T / 64; tile += G) {
        const int b = tile / 32;
        f32x4 nx[4], gtv[4], gfv[4]; v2u ny0[4], ny1[4];
#pragma unroll
        for (int j = 0; j < 4; ++j) { const int k = 256 * j + 4 * lane; gtv[j] = *(const f32x4*)(mod + b * 6144 + 5120 + k); gfv[j] = *(const f32x4*)(gf + k); }
#pragma unroll
        for (int j = 0; j < 4; ++j) { const size_t row = (size_t)tile * 64 + wave; const int k = 256 * j + 4 * lane;
            nx[j] = *(const f32x4*)(out + row * 1024 + k); ny0[j] = *(const v2u*)(ys + row * 2048 + k); ny1[j] = *(const v2u*)(ys + row * 2048 + 1024 + k); }
#pragma unroll 1
        for (int r = wave; r < 64; r += NWAVES) {
            const size_t row = (size_t)tile * 64 + r;
            f32x4 v[4]; float ss = 0.f;
#pragma unroll
            for (int j = 0; j < 4; ++j) { const int k = 256 * j + 4 * lane;
                const f32x4 xv = nx[j], gt = gtv[j]; const v2u y0 = ny0[j], y1 = ny1[j];
                v[j][0] = xv[0] + gt[0] * (bflo(y0.x) + bflo(y1.x)); v[j][1] = xv[1] + gt[1] * (bfhi(y0.x) + bfhi(y1.x));
                v[j][2] = xv[2] + gt[2] * (bflo(y0.y) + bflo(y1.y)); v[j][3] = xv[3] + gt[3] * (bfhi(y0.y) + bfhi(y1.y));
                ss += (v[j][0] * v[j][0] + v[j][1] * v[j][1]) + (v[j][2] * v[j][2] + v[j][3] * v[j][3]); }
            if (r + NWAVES < 64) {
#pragma unroll
                for (int j = 0; j < 4; ++j) { const size_t rn = row + NWAVES; const int k = 256 * j + 4 * lane;
                    nx[j] = *(const f32x4*)(out + rn * 1024 + k); ny0[j] = *(const v2u*)(ys + rn * 2048 + k); ny1[j] = *(const v2u*)(ys + rn * 2048 + 1024 + k); } }
            asm volatile("" ::: "memory");
            const float rstd = rsqrtf(wave_sum(ss) * (1.f / 1024.f) + RMS_EPS);
#pragma unroll
            for (int j = 0; j < 4; ++j) { const int k = 256 * j + 4 * lane; *(f32x4*)(outw + row * 1024 + k) = v[j] * rstd * gfv[j]; }
        }
    }
}

struct XOrder { XDeal X; int nN;
    DEV bool tile(int i, int& pm, int& pn) const { const int per = 8 * nN; const int it = X.item(i, per); if (it < 0) return false;
        const int b = it / per, w = it - b * per; const int r = w >> 5, s = w & 31; pn = 4 * r + (s & 3); pm = 8 * b + (s >> 2); return true; }
    DEV bool next(int i, Unit& u) const { u.ak = 0; u.bk = 0; u.slot = 0; u.valid = 256; u.arow0 = 0; return tile(i, u.pm, u.pn); }
};
constexpr int NPHASE = 11;
template <int LO, int HI>
__global__ void __launch_bounds__(NTHREADS, 2) mk_fwd(Args a) {
    extern __shared__ __attribute__((aligned(16))) unsigned char lds_raw[];
    LAS unsigned char* lds = (LAS unsigned char*)lds_raw;
    const int tid = threadIdx.x, G = gridDim.x, bid = blockIdx.x;
    volatile LAS unsigned* MISC = (volatile LAS unsigned*)(lds + LDS_MISC);
    if (tid < 64) MISC[tid] = 0u;
    __syncthreads();
#if MK_ONE
#if USE_XCD_BARRIER
    XcdBarrier bar = xcd_barrier_post((unsigned*)(a.ws + WS_CTL) + CW_BAR, MISC + 8);
#define GRID_BAR() xcd_barrier(bar)
#define LOCAL_BAR(n) xcd_local_barrier<n>(bar, (unsigned*)(a.ws + WS_CTL) + CW_LBAR)
#else
    unsigned fgen = 0;
#define GRID_BAR() flat_barrier((unsigned*)(a.ws + WS_CTL) + CW_FLATBAR, fgen)
#define LOCAL_BAR(n) GRID_BAR()
#endif
#else
#define GRID_BAR() do {} while (0)
#define LOCAL_BAR(n) do {} while (0)
#endif
    constexpr int lo = LO, hi = HI;
#define IN(k) (lo <= (k) && (k) < hi)
#define BOTH(k) (IN(k) && IN((k) + 1))
    if constexpr (IN(0)) { REPK(0) { p0_prologue(a, lds, bid, G); REPSYNC(); } if constexpr (BOTH(0)) __syncthreads(); }
    if constexpr (IN(1)) { REPK(1) { P1_FN(a, lds, bid, G); REPSYNC(); } if constexpr (BOTH(1)) GRID_BAR(); }
    XDeal X{0, 1, bid, G};
#if MK_ONE && USE_XCD_BARRIER
    if constexpr (BOTH(1)) {
        X.nl = __builtin_amdgcn_readfirstlane((int)MISC[8]); X.nx = __builtin_amdgcn_readfirstlane((int)MISC[9]); X.lr = __builtin_amdgcn_readfirstlane((int)MISC[12]); X.xr = __builtin_amdgcn_readfirstlane((int)MISC[13]); }
#endif
    if constexpr (IN(2)) {
        __syncthreads();
        ProbPlain P{(const bf16*)(a.ws + WS_H), (const bf16*)(a.ws + WS_W1T), 2048u, 2048u};
#if DBG_GATEFIRST
        struct SchedG { pg8::StaticOrder so; DEV bool next(int i, Unit& u) const { if (i >= 2) return false; return so.next(i + 3, u); } } S; S.so.init(T, 5120, G, bid);
#else
        XOrder S{X, 20};
#endif
        Epi1 E{(bf16*)(a.ws + WS_ZU), (bf16*)(a.ws + WS_ZGA), (a.flags >> 8) & 15};
        REPK(2) pg8::gemm_phase<ProbPlain, Epi1, decltype(S), true>(lds, P, S, E, 1024);
        if constexpr (BOTH(2)) LOCAL_BAR(1);
    }
    if constexpr (IN(3)) {
        REPK(3) { for (int i = 0;; ++i) { const int u = X.item(i, 32); if (u < 0) break; mlstm_unit<false>(a, lds, u); }
        __syncthreads(); }
        REPK(11) { p3_conva(a, lds, X); REPSYNC(); }
        if constexpr (BOTH(3)) LOCAL_BAR(2);
    }
    if constexpr (IN(4)) {
        REPK(4) { for (int i = 0;; ++i) { const int u = X.item(i, 32); if (u < 0) break; mlstm_unit<true>(a, lds, u); } REPSYNC(); }
        if constexpr (BOTH(4)) LOCAL_BAR(3);
    }
    if constexpr (IN(5)) {
        __syncthreads();
        struct Sched2 { XOrder xo; DEV bool next(int i, Unit& u) const { u.ak = (unsigned)(i & 1) * 1024u; u.bk = u.ak; u.slot = i & 1; u.valid = 256; u.arow0 = 0; return xo.tile(i >> 1, u.pm, u.pn); } } S;
        S.xo.X = X; S.xo.nN = 4;
        ProbPlain P{(const bf16*)(a.ws + WS_UAHM), (const bf16*)(a.ws + WS_W2T), 2048u, 2048u};
        Epi2 E{(const bf16*)(a.ws + WS_ZGA), (const bf16*)(a.ws + WS_ZGB), (bf16*)(a.ws + WS_MERGED)};
        REPK(5) pg8::gemm_phase<ProbPlain, Epi2, Sched2, true>(lds, P, S, E, 512);
        if constexpr (BOTH(5)) LOCAL_BAR(4);
    }
    if constexpr (IN(6)) {
        __syncthreads();
        ProbPlain P{(const bf16*)(a.ws + WS_MERGED), (const bf16*)(a.ws + WS_W3T), 2048u, 2048u};
        XOrder S{X, 4};
        Epi3 E{a.in[0], (const float*)(a.ws + WS_MOD), a.out};
        REPK(6) pg8::gemm_phase<ProbPlain, Epi3, XOrder, true>(lds, P, S, E, 1024);
        if constexpr (BOTH(6)) { LOCAL_BAR(5); for (int xb = 0; xb < DBG_XBAR; ++xb) GRID_BAR(); }
    }
    if constexpr (IN(7)) {
        if (!(a.flags & 1)) p8_route(a, lds, X);
        __syncthreads();
        if (!(a.flags & 4)) { p8_convert(a, lds, bid, G); }
        if constexpr (BOTH(7)) GRID_BAR();
    }
    if constexpr (IN(8)) {
        MoeSched S; S.bstride = 1024u * 1024u * 2u;
        moe_tables(a, lds, bid, G, S, false);
        ProbMoeUp P{(const bf16*)(a.ws + WS_H), (const bf16*)(a.ws + WS_WGU), (const LAS unsigned*)(lds + LDS_TAB)};
        EpiUp E{(bf16*)(a.ws + WS_ACT)};
        REPK(8) pg8::gemm_phase<ProbMoeUp, EpiUp, MoeSched, true, true>(lds, P, S, E, 1024);
        if constexpr (BOTH(8)) GRID_BAR();
    }
    if constexpr (IN(9)) {
        MoeSched S; S.bstride = 1024u * 512u * 2u;
        moe_tables(a, lds, bid, G, S, true);
        ProbMoeDown P{(const bf16*)(a.ws + WS_ACT), (const bf16*)(a.ws + WS_WD)};
        EpiDown E{(bf16*)(a.ws + WS_YS), (const LAS unsigned*)(lds + LDS_TAB), (const LAS float*)(lds + LDS_TAB + 8192)};
        REPK(9) pg8::gemm_phase<ProbMoeDown, EpiDown, MoeSched, true, true>(lds, P, S, E, 512);
        if constexpr (BOTH(9)) GRID_BAR();
    }
    if constexpr (IN(10)) { p11_final(a, bid, G); }
#undef IN
#undef BOTH
}

#if NAIVE_MASK
__global__ __launch_bounds__(256) void k_fixw1t(const float* w_in, bf16* W1T) { const size_t i = (size_t)blockIdx.x * 256 + threadIdx.x; const size_t n = i / 1024, k = i % 1024; W1T[(3072 + n) * 1024 + k] = f2bf(w_in[k * 5128 + 3080 + n]); }
DEV float block_sum256(float v, float* red) {
#pragma unroll
    for (int o = 32; o >= 1; o >>= 1) v += __shfl_xor(v, o);
    __syncthreads();
    if ((threadIdx.x & 63) == 0) red[threadIdx.x >> 6] = v;
    __syncthreads();
    return (red[0] + red[1]) + (red[2] + red[3]);
}
__global__ __launch_bounds__(256) void k_mod(const float* c, const float* w_ada, const float* b_ada, float* mod) {
    const int idx = blockIdx.x * 256 + threadIdx.x; const int b = idx / 6144, n = idx % 6144;
    float acc = 0.f;
    for (int k = 0; k < D; ++k) acc += siluf_(c[b * D + k]) * w_ada[(size_t)k * 6144 + n];
    mod[idx] = acc + b_ada[n];
}
__global__ __launch_bounds__(256) void k_h1(const float* x, const float* g1, const float* mod, const float* w_in, const float* b_if, bf16* h1, float* gates) {
    __shared__ float red[4];
    const int t = blockIdx.x, b = t / SEQ, tid = threadIdx.x;
    const float4 xv = ((const float4*)(x + (size_t)t * D))[tid];
    float ss = xv.x * xv.x + xv.y * xv.y + xv.z * xv.z + xv.w * xv.w;
    ss = block_sum256(ss, red);
    const float rstd = rsqrtf(ss * (1.f / D) + RMS_EPS);
    const float* sh = mod + b * 6144, *sc = mod + b * 6144 + 1024;
    float hv[4]; const float xs[4] = {xv.x, xv.y, xv.z, xv.w};
#pragma unroll
    for (int j = 0; j < 4; ++j) { const int k = tid * 4 + j; hv[j] = xs[j] * rstd * g1[k] * (1.f + sc[k]) + sh[k]; }
    ushort4 o; o.x = f2bf(hv[0]); o.y = f2bf(hv[1]); o.z = f2bf(hv[2]); o.w = f2bf(hv[3]);
    ((ushort4*)(h1 + (size_t)t * D))[tid] = o;
    float g[8];
#pragma unroll
    for (int j = 0; j < 8; ++j) g[j] = 0.f;
#pragma unroll
    for (int i = 0; i < 4; ++i) { const float* wr = w_in + (size_t)(tid * 4 + i) * DIN + 3072;
#pragma unroll
        for (int j = 0; j < 8; ++j) g[j] += hv[i] * wr[j]; }
#pragma unroll
    for (int j = 0; j < 8; ++j) g[j] = block_sum256(g[j], red);
    if (tid < 8) { float v = g[0];
#pragma unroll
        for (int j = 1; j < 8; ++j) v = (tid == j) ? g[j] : v;
        v += b_if[tid];
        gates[(size_t)t * 8 + tid] = (tid < 4) ? v : logsigmoidf_(v); }
}
template <class Epi>
__global__ __launch_bounds__(256) void k_ngemm(const bf16* A, int lda, const float* W, int ldw, int N, int K, Epi epi) {
    __shared__ float As[16][68]; __shared__ float Ws[16][68];
    const int tid = threadIdx.x, tx = tid & 15, ty = tid >> 4;
    const int row0 = blockIdx.y * 64, col0 = blockIdx.x * 64;
    float acc[4][4];
#pragma unroll
    for (int i = 0; i < 4; ++i)
#pragma unroll
        for (int j = 0; j < 4; ++j) acc[i][j] = 0.f;
    const int ar = tid >> 2, ak = (tid & 3) * 4;
    const int wk = tid >> 4, wc = (tid & 15) * 4;
    for (int k0 = 0; k0 < K; k0 += 16) {
        const ushort4 av = *(const ushort4*)(A + (size_t)(row0 + ar) * lda + k0 + ak);
        As[ak + 0][ar] = bf2f(av.x); As[ak + 1][ar] = bf2f(av.y); As[ak + 2][ar] = bf2f(av.z); As[ak + 3][ar] = bf2f(av.w);
#pragma unroll
        for (int j = 0; j < 4; ++j) { const int cc = col0 + wc + j; Ws[wk][wc + j] = (cc < N) ? W[(size_t)(k0 + wk) * ldw + cc] : 0.f; }
        __syncthreads();
#pragma unroll
        for (int kk = 0; kk < 16; ++kk) {
            float av2[4], w[4];
#pragma unroll
            for (int i = 0; i < 4; ++i) av2[i] = As[kk][ty * 4 + i];
#pragma unroll
            for (int j = 0; j < 4; ++j) w[j] = Ws[kk][tx * 4 + j];
#pragma unroll
            for (int i = 0; i < 4; ++i)
#pragma unroll
                for (int j = 0; j < 4; ++j) acc[i][j] += av2[i] * w[j];
        }
        __syncthreads();
    }
#pragma unroll
    for (int i = 0; i < 4; ++i)
#pragma unroll
        for (int j = 0; j < 4; ++j) { const int cc = col0 + tx * 4 + j; if (cc < N) epi(row0 + ty * 4 + i, cc, acc[i][j]); }
}
struct NEpi1 {
    float* tmp; bf16 *zq, *zk, *zv, *zo, *zga, *zgb;
    DEV void operator()(int r, int c, float v) const {
        if (c < 1024) tmp[(size_t)r * 1024 + c] = v;
        else if (c < 1536) zq[(size_t)r * 512 + c - 1024] = f2bf(v);
        else if (c < 2048) zk[(size_t)r * 512 + c - 1536] = f2bf(v);
        else if (c < 2560) zv[(size_t)r * 512 + c - 2048] = f2bf(v);
        else if (c < 3072) zo[(size_t)r * 512 + c - 2560] = f2bf(sigmoidf_(v));
        else if (c < 3080) {}
        else if (c < 4104) zga[(size_t)r * 1024 + c - 3080] = f2bf(sigmoidf_(v));
        else zgb[(size_t)r * 1024 + c - 4104] = f2bf(sigmoidf_(v));
    }
};
struct NEpi2a { float* tmp; const bf16* zga; DEV void operator()(int r, int c, float v) const { tmp[(size_t)r * 1024 + c] = v * bf2f(zga[(size_t)r * 1024 + c]); } };
struct NEpi2b { const float* tmp; const bf16* zgb; bf16* merged; DEV void operator()(int r, int c, float v) const { merged[(size_t)r * 1024 + c] = f2bf(tmp[(size_t)r * 1024 + c] + v * bf2f(zgb[(size_t)r * 1024 + c])); } };
struct NEpi3 { const float* x; const float* mod; float* out; DEV void operator()(int r, int c, float v) const { const int b = r / SEQ; out[(size_t)r * 1024 + c] = x[(size_t)r * 1024 + c] + mod[b * 6144 + 2048 + c] * v; } };
__global__ __launch_bounds__(256) void k_glu(const float* tmp, bf16* zu) {
    const size_t i = (size_t)blockIdx.x * 256 + threadIdx.x; const size_t r = i / 512, c = i % 512;
    zu[i] = f2bf(tmp[r * 1024 + c] * sigmoidf_(tmp[r * 1024 + 512 + c]));
}
__global__ __launch_bounds__(256) void k_conva(const bf16* zu, const float* cw, const float* cb, const float* lg, const float* lb, bf16* uahm) {
    __shared__ float red[4];
    const int t = blockIdx.x, s = t % SEQ, tid = threadIdx.x;
    float v[2];
#pragma unroll
    for (int j = 0; j < 2; ++j) { const int c = tid + 256 * j; float a = cb[c];
        for (int k = 0; k < 31; ++k) { const int ss = s - 30 + k; if (ss >= 0) a += cw[k * 512 + c] * bf2f(zu[(size_t)(t - 30 + k) * 512 + c]); }
        v[j] = a; }
    const float mean = block_sum256(v[0] + v[1], red) * (1.f / 512.f);
    const float d0 = v[0] - mean, d1 = v[1] - mean;
    const float var = block_sum256(d0 * d0 + d1 * d1, red) * (1.f / 512.f);
    const float rstd = rsqrtf(var + LN_EPS);
#pragma unroll
    for (int j = 0; j < 2; ++j) { const int c = tid + 256 * j; const float y = (v[j] - mean) * rstd * lg[c] + lb[c]; uahm[(size_t)t * 1024 + c] = f2bf(siluf_(y)); }
}
__global__ __launch_bounds__(256) void k_qkconv(const bf16* zq, const bf16* zk, const float* w, const float* bq, bf16* qc, bf16* kc) {
    const int t = blockIdx.x, s = t % SEQ, tid = threadIdx.x;
#pragma unroll
    for (int j = 0; j < 4; ++j) { const int c = tid + 256 * j; const bf16* src = (c < 512) ? zq : zk; const int cc = c & 511; float a = bq[c];
#pragma unroll
        for (int k = 0; k < 4; ++k) { const int ss = s - 3 + k; if (ss >= 0) a += w[k * 1024 + c] * bf2f(src[(size_t)(t - 3 + k) * 512 + cc]); }
        ((c < 512) ? qc : kc)[(size_t)t * 512 + cc] = f2bf(siluf_(a)); }
}
__global__ __launch_bounds__(256) void k_mlstm_rec(const bf16* qc, const bf16* kc, const bf16* zv, const bf16* zo, const float* gates, const float* mng, bf16* uahm) {
    __shared__ float qs[128], ks[128], vs[128], part[2][128], red[8];
    const int b = blockIdx.x / NH, h = blockIdx.x % NH, tid = threadIdx.x, j = tid & 127, ih = tid >> 7;
    float C[64];
#pragma unroll
    for (int r = 0; r < 64; ++r) C[r] = 0.f;
    float nn = 0.f, m = 0.f;
    for (int s = 0; s < SEQ; ++s) {
        const size_t t = (size_t)b * SEQ + s;
        __syncthreads();
        if (tid < 128) { qs[tid] = bf2f(qc[t * 512 + h * 128 + tid]) * 0.08838834764831845f; ks[tid] = bf2f(kc[t * 512 + h * 128 + tid]); }
        else vs[tid - 128] = bf2f(zv[t * 512 + h * 128 + tid - 128]);
        const float li = gates[t * 8 + h], lf = gates[t * 8 + 4 + h];
        const float mn = fmaxf(lf + m, li), ip = __expf(li - mn), fp = __expf(lf + m - mn); m = mn;
        __syncthreads();
        const float vj = vs[j]; float p = 0.f;
#pragma unroll
        for (int r = 0; r < 64; ++r) { const int i = ih * 64 + r; C[r] = fp * C[r] + ip * ks[i] * vj; p += qs[i] * C[r]; }
        part[ih][j] = p;
        float dn = 0.f;
        if (tid < 128) { nn = fp * nn + ip * ks[tid]; dn = qs[tid] * nn; }
#pragma unroll
        for (int o = 32; o >= 1; o >>= 1) dn += __shfl_xor(dn, o);
        if ((tid & 63) == 0) red[tid >> 6] = dn;
        __syncthreads();
        float hv = 0.f, sm = 0.f;
        if (tid < 128) { const float den = red[0] + red[1]; hv = (part[0][tid] + part[1][tid]) / fmaxf(fabsf(den), __expf(-mn)); sm = hv; }
#pragma unroll
        for (int o = 32; o >= 1; o >>= 1) sm += __shfl_xor(sm, o);
        if ((tid & 63) == 0) red[4 + (tid >> 6)] = sm;
        __syncthreads();
        const float mu = (red[4] + red[5]) * (1.f / 128.f);
        float dv = (tid < 128) ? (hv - mu) : 0.f; float sq = dv * dv;
#pragma unroll
        for (int o = 32; o >= 1; o >>= 1) sq += __shfl_xor(sq, o);
        __syncthreads();
        if ((tid & 63) == 0) red[tid >> 6] = sq;
        __syncthreads();
        if (tid < 128) { const float var = (red[0] + red[1]) * (1.f / 128.f); const float y = dv * rsqrtf(var + LN_EPS) * mng[h * 128 + tid] * bf2f(zo[t * 512 + h * 128 + tid]);
            uahm[t * 1024 + 512 + h * 128 + tid] = f2bf(y); }
    }
}
__global__ __launch_bounds__(256) void k_h2route(const float* x1, const float* g2, const float* mod, const float* w_rg, const float* b_rg, const float* w_re, const float* b_re, bf16* h2, int* toke, float* tokw) {
    __shared__ float red[4]; __shared__ float lg[36];
    const int t = blockIdx.x, b = t / SEQ, tid = threadIdx.x;
    const float4 xv = ((const float4*)(x1 + (size_t)t * D))[tid];
    float ss = xv.x * xv.x + xv.y * xv.y + xv.z * xv.z + xv.w * xv.w;
    ss = block_sum256(ss, red);
    const float rstd = rsqrtf(ss * (1.f / D) + RMS_EPS);
    const float* sh = mod + b * 6144 + 3072, *sc = mod + b * 6144 + 4096;
    float hv[4]; const float xs[4] = {xv.x, xv.y, xv.z, xv.w};
#pragma unroll
    for (int j = 0; j < 4; ++j) { const int k = tid * 4 + j; hv[j] = xs[j] * rstd * g2[k] * (1.f + sc[k]) + sh[k]; }
    ushort4 o; o.x = f2bf(hv[0]); o.y = f2bf(hv[1]); o.z = f2bf(hv[2]); o.w = f2bf(hv[3]);
    ((ushort4*)(h2 + (size_t)t * D))[tid] = o;
    for (int j = 0; j < 36; ++j) {
        float a = 0.f;
#pragma unroll
        for (int i = 0; i < 4; ++i) { const int k = tid * 4 + i; a += hv[i] * ((j < 4) ? w_rg[k * 4 + j] : w_re[k * 32 + j - 4]); }
        a = block_sum256(a, red);
        if (tid == 0) lg[j] = a + ((j < 4) ? b_rg[j] : b_re[j - 4]);
    }
    __syncthreads();
    if (tid == 0) {
        int gs = 0; float gm = lg[0];
        for (int j = 1; j < 4; ++j) if (lg[j] > gm) { gm = lg[j]; gs = j; }
        float se = 0.f; for (int j = 0; j < 4; ++j) se += __expf(lg[j] - gm);
        const float pg = 1.f / se;
        const float* le = lg + 4 + gs * 8;
        int e0 = 0; float l0 = le[0];
        for (int j = 1; j < 8; ++j) if (le[j] > l0) { l0 = le[j]; e0 = j; }
        int e1 = -1; float l1 = -3.0e38f;
        for (int j = 0; j < 8; ++j) if (j != e0 && le[j] > l1) { l1 = le[j]; e1 = j; }
        const float r = __expf(l1 - l0);
        const float w0 = pg / (1.f + r), w1 = pg * r / (1.f + r);
        toke[t * 2] = gs * 8 + e0; toke[t * 2 + 1] = gs * 8 + e1; tokw[t * 2] = w0; tokw[t * 2 + 1] = w1;
    }
}
__global__ __launch_bounds__(256) void k_lists(const int* toke, const float* tokw, unsigned* cnt, int* listt, float* listw) {
    const int i = blockIdx.x * 256 + threadIdx.x; const int e = toke[i]; const unsigned pos = atomicAdd(cnt + 16 * e, 1u);
    listt[e * 16384 + pos] = i; listw[e * 16384 + pos] = tokw[i];
}
__global__ __launch_bounds__(256) void k_moe(const bf16* h2, const int* toke, const float* tokw, const float* wg, const float* wu, const float* wd, bf16* ys) {
    __shared__ float hs[1024]; __shared__ float hid[512];
    const int a = blockIdx.x, t = a >> 1, tid = threadIdx.x;
    const int e = toke[a]; const float w = tokw[a];
    for (int k = tid; k < 1024; k += 256) hs[k] = bf2f(h2[(size_t)t * 1024 + k]);
    __syncthreads();
    const float* Gp = wg + (size_t)e * 1024 * 512, *U = wu + (size_t)e * 1024 * 512, *Dn = wd + (size_t)e * 512 * 1024;
    float g0 = 0.f, g1 = 0.f, u0 = 0.f, u1 = 0.f;
    for (int k = 0; k < 1024; ++k) { const float hk = hs[k]; g0 += hk * Gp[(size_t)k * 512 + tid]; g1 += hk * Gp[(size_t)k * 512 + 256 + tid]; u0 += hk * U[(size_t)k * 512 + tid]; u1 += hk * U[(size_t)k * 512 + 256 + tid]; }
    hid[tid] = siluf_(g0) * u0; hid[tid + 256] = siluf_(g1) * u1;
    __syncthreads();
    float y[4] = {0.f, 0.f, 0.f, 0.f};
    for (int j = 0; j < 512; ++j) { const float hj = hid[j];
#pragma unroll
        for (int i = 0; i < 4; ++i) y[i] += hj * Dn[(size_t)j * 1024 + tid + 256 * i]; }
#pragma unroll
    for (int i = 0; i < 4; ++i) ys[(size_t)a * 1024 + tid + 256 * i] = f2bf(w * y[i]);
}
__global__ __launch_bounds__(256) void k_final(const float* x1, const bf16* ys, const float* mod, const float* gf, float* out) {
    __shared__ float red[4];
    const int t = blockIdx.x, b = t / SEQ, tid = threadIdx.x;
    const float4 xv = ((const float4*)(x1 + (size_t)t * D))[tid];
    const ushort4 y0 = ((const ushort4*)(ys + (size_t)t * 2048))[tid], y1 = ((const ushort4*)(ys + (size_t)t * 2048 + 1024))[tid];
    const float* gt = mod + b * 6144 + 5120 + tid * 4;
    float v[4];
    v[0] = xv.x + gt[0] * (bf2f(y0.x) + bf2f(y1.x)); v[1] = xv.y + gt[1] * (bf2f(y0.y) + bf2f(y1.y));
    v[2] = xv.z + gt[2] * (bf2f(y0.z) + bf2f(y1.z)); v[3] = xv.w + gt[3] * (bf2f(y0.w) + bf2f(y1.w));
    float ss = v[0] * v[0] + v[1] * v[1] + v[2] * v[2] + v[3] * v[3];
    ss = block_sum256(ss, red);
    const float rstd = rsqrtf(ss * (1.f / D) + RMS_EPS);
    float4 o; o.x = v[0] * rstd * gf[tid * 4]; o.y = v[1] * rstd * gf[tid * 4 + 1]; o.z = v[2] * rstd * gf[tid * 4 + 2]; o.w = v[3] * rstd * gf[tid * 4 + 3];
    ((float4*)(out + (size_t)t * D))[tid] = o;
}
#endif


#ifndef DBG_BENCH
#define DBG_BENCH 0
#endif
#if DBG_BENCH
__global__ void __launch_bounds__(512, 2) k_bench_a(const float* x, float* dummy) {
    extern __shared__ __attribute__((aligned(16))) unsigned char lds_b[];
    const int tid = threadIdx.x, lane = tid & 63, wave = tid >> 6, tile = blockIdx.x;
    f32x4 nx[4][4]; float acc = 0.f;
#pragma unroll
    for (int p = 0; p < 4; ++p)
#pragma unroll
        for (int j = 0; j < 4; ++j) nx[p][j] = *(const f32x4*)(x + ((size_t)tile * 64 + wave + 8 * p) * 1024 + 256 * j + 4 * lane);
#pragma unroll
    for (int r8 = 0; r8 < 8; ++r8) {
        const size_t row = (size_t)tile * 64 + wave + 8 * r8;
#pragma unroll
        for (int j = 0; j < 4; ++j) acc += (nx[r8 & 3][j][0] + nx[r8 & 3][j][1]) + (nx[r8 & 3][j][2] + nx[r8 & 3][j][3]);
        if (r8 + 4 < 8) {
#pragma unroll
            for (int j = 0; j < 4; ++j) nx[r8 & 3][j] = *(const f32x4*)(x + (row + 32) * 1024 + 256 * j + 4 * lane); }
    }
    if (acc == 123.456f) dummy[tid] = acc;
}
__global__ void __launch_bounds__(256) k_bench_b(const float* x, float* dummy) {
    const int tid = threadIdx.x, lane = tid & 63, wave = tid >> 6; const size_t row = (size_t)blockIdx.x * 4 + wave; float acc = 0.f;
#pragma unroll
    for (int j = 0; j < 4; ++j) { const f32x4 v = *(const f32x4*)(x + row * 1024 + 256 * j + 4 * lane); acc += (v[0] + v[1]) + (v[2] + v[3]); }
    if (acc == 123.456f) dummy[tid] = acc;
}
#endif
#if DBG_BENCH >= 4
template <int LVL>
__global__ void __launch_bounds__(512, 2) k_bench_d(const float* x, const float* g1, const float* mod, bf16* h1, float* dummy) {
    extern __shared__ __attribute__((aligned(16))) unsigned char lds_b[];
    const int tid = threadIdx.x, lane = tid & 63, wave = tid >> 6, tile = blockIdx.x, b = tile / 32;
    float sc[4][4], sh[4][4];
#pragma unroll
    for (int j = 0; j < 4; ++j) { const int k = 256 * j + 4 * lane; const f32x4 gv = *(const f32x4*)(g1 + k), sv = *(const f32x4*)(mod + b * 6144 + 1024 + k), hv = *(const f32x4*)(mod + b * 6144 + k);
#pragma unroll
        for (int i = 0; i < 4; ++i) { sc[j][i] = gv[i] * (1.f + sv[i]); sh[j][i] = hv[i]; } }
    f32x4 nx[4][4];
#pragma unroll
    for (int p = 0; p < 4; ++p)
#pragma unroll
        for (int j = 0; j < 4; ++j) nx[p][j] = *(const f32x4*)(x + ((size_t)tile * 64 + wave + 8 * p) * 1024 + 256 * j + 4 * lane);
#pragma unroll
    for (int r8 = 0; r8 < 8; ++r8) {
        const size_t row = (size_t)tile * 64 + wave + 8 * r8;
        f32x4 v[4]; float ss = 0.f;
#pragma unroll
        for (int j = 0; j < 4; ++j) { v[j] = nx[r8 & 3][j]; ss += (v[j][0] * v[j][0] + v[j][1] * v[j][1]) + (v[j][2] * v[j][2] + v[j][3] * v[j][3]); }
        if (r8 + 4 < 8) {
#pragma unroll
            for (int j = 0; j < 4; ++j) nx[r8 & 3][j] = *(const f32x4*)(x + (row + 32) * 1024 + 256 * j + 4 * lane); }
        asm volatile("" ::: "memory");
        const float rstd = rsqrtf(wave_sum(ss) * (1.f / 1024.f) + RMS_EPS);
        if (LVL >= 5) {
            float g[8];
#pragma unroll
            for (int q = 0; q < 8; ++q) g[q] = 0.f;
#pragma unroll
            for (int j = 0; j < 4; ++j) { float hh[4];
#pragma unroll
                for (int i = 0; i < 4; ++i) hh[i] = v[j][i] * rstd * sc[j][i] + sh[j][i];
                v2u o; o.x = pk2(hh[0], hh[1]); o.y = pk2(hh[2], hh[3]);
                *(v2u*)(h1 + row * 1024 + 256 * j + 4 * lane) = o;
                if (LVL >= 6) {
#pragma unroll
                    for (int i = 0; i < 4; ++i) { const LAS float* tp = (const LAS float*)lds_b + ((4 * j + i) * 64 + lane) * 8; f32x4 w0, w1;
                        if (LVL == 8) { w0 = (f32x4){1.f, 2.f, 3.f, 4.f}; w1 = (f32x4){5.f, 6.f, 7.f, 8.f}; } else { w0 = *(const LAS f32x4*)tp; w1 = *(const LAS f32x4*)(tp + 4); }
                        g[0] += hh[i] * w0[0]; g[1] += hh[i] * w0[1]; g[2] += hh[i] * w0[2]; g[3] += hh[i] * w0[3]; g[4] += hh[i] * w1[0]; g[5] += hh[i] * w1[1]; g[6] += hh[i] * w1[2]; g[7] += hh[i] * w1[3]; } } }
            if (LVL == 6 || LVL == 8) { const float t = ((g[0] + g[1]) + (g[2] + g[3])) + ((g[4] + g[5]) + (g[6] + g[7])); if (t == 123.456f) dummy[row] = t; }
            if (LVL == 7) { float mine = 0.f;
#pragma unroll
                for (int q = 0; q < 8; ++q) { const float sq = wave_sum(g[q]); mine = (lane == q) ? sq : mine; }
                if (lane < 8) dummy[row * 8 + lane] = (lane < 4) ? mine : logsigmoidf_(mine); }
        } else if (lane == 0) dummy[row] = rstd;
    }
}
#endif
#if DBG_BENCH == 3
__global__ void __launch_bounds__(512, 2) k_bench_c(float* dummy, float seed) {
    extern __shared__ __attribute__((aligned(16))) unsigned char lds_b[];
    float a0 = seed + threadIdx.x, a1 = a0 + 1.f, a2 = a0 + 2.f, a3 = a0 + 3.f; const float m = 1.0000001f, c = 1e-9f;
#pragma unroll 1
    for (int i = 0; i < 2048; ++i) {
#pragma unroll
        for (int j = 0; j < 4; ++j) { a0 = a0 * m + c; a1 = a1 * m + c; a2 = a2 * m + c; a3 = a3 * m + c; }
    }
    if (a0 + a1 + a2 + a3 == 123.456f) dummy[threadIdx.x] = a0;
}
#endif
#if MK_ONE
constexpr int NKERN = 1;
static const void* const mk_kernels[NKERN] = {(const void*)mk_fwd<0, NPHASE>};
#else
constexpr int NKERN = NPHASE;
static const void* const mk_kernels[NKERN] = {(const void*)mk_fwd<0, 1>, (const void*)mk_fwd<1, 2>, (const void*)mk_fwd<2, 3>, (const void*)mk_fwd<3, 4>, (const void*)mk_fwd<4, 5>, (const void*)mk_fwd<5, 6>,
    (const void*)mk_fwd<6, 7>, (const void*)mk_fwd<7, 8>, (const void*)mk_fwd<8, 9>, (const void*)mk_fwd<9, 10>, (const void*)mk_fwd<10, 11>};
#endif
extern "C" void kernel_launch(void* const* d_in, const int* in_sizes, int n_in, void* d_out, int out_size, void* d_ws, size_t ws_size, hipStream_t stream) {
    static int grid = 0;
    if (grid == 0) {
        int dev = 0, cus = 0;
        if (hipGetDevice(&dev) != hipSuccess || hipDeviceGetAttribute(&cus, hipDeviceAttributeMultiprocessorCount, dev) != hipSuccess) { grid = -1; return; }
        for (int k = 0; k < NKERN; ++k) if (hipFuncSetAttribute(mk_kernels[k], hipFuncAttributeMaxDynamicSharedMemorySize, LDS_BYTES) != hipSuccess) { grid = -1; return; }
        int per_cu = 0;
        (void)hipOccupancyMaxActiveBlocksPerMultiprocessor(&per_cu, mk_kernels[0], NTHREADS, LDS_BYTES);
        (void)hipGetLastError();
        grid = (per_cu >= 1) ? cus : -1;
    }
    if (grid < 0) return;
    (void)hipMemsetAsync((char*)d_ws + WS_CTL, 0, CTL_ZERO_BYTES, stream);
    Args a{};
    for (int i = 0; i < 26; ++i) a.in[i] = (const float*)d_in[i];
    a.out = (float*)d_out; a.ws = (unsigned char*)d_ws;
#if MK_ONE
    a.ph_lo = 0; a.ph_hi = NPHASE;
    { void* args[] = {&a}; (void)hipLaunchKernel(mk_kernels[0], dim3(grid), dim3(NTHREADS), args, LDS_BYTES, stream); }
#else
    unsigned char* ws = (unsigned char*)d_ws; float* out = (float*)d_out;
    float* mod = (float*)(ws + WS_MOD); float* gates = (float*)(ws + WS_GATES); int* toke = (int*)(ws + WS_TOKE); float* tokw = (float*)(ws + WS_TOKW);
    bf16* hb = (bf16*)(ws + WS_H); bf16* zu = (bf16*)(ws + WS_ZU); bf16* zq = (bf16*)(ws + WS_ZQ); bf16* zk = (bf16*)(ws + WS_ZK); bf16* zv = (bf16*)(ws + WS_ZV); bf16* zo = (bf16*)(ws + WS_ZO);
    bf16* zga = (bf16*)(ws + WS_ZGA); bf16* zgb = (bf16*)(ws + WS_ZGB); bf16* qc = (bf16*)(ws + WS_QC); bf16* kc = (bf16*)(ws + WS_KC); bf16* uahm = (bf16*)(ws + WS_UAHM);
    bf16* merged = (bf16*)(ws + WS_MERGED); bf16* ys = (bf16*)(ws + WS_YS);
    (void)mod; (void)gates; (void)toke; (void)tokw; (void)hb; (void)zu; (void)zq; (void)zk; (void)zv; (void)zo; (void)zga; (void)zgb; (void)qc; (void)kc; (void)uahm; (void)merged; (void)ys; (void)out;
#ifndef DBG_NPH
#define DBG_NPH NPHASE
#endif
#if DBG_BENCH == 1
    { static bool once = false; if (!once) { (void)hipFuncSetAttribute((const void*)k_bench_a, hipFuncAttributeMaxDynamicSharedMemorySize, LDS_BYTES); once = true; }
      for (int rep = 0; rep < 4; ++rep) hipLaunchKernelGGL(k_bench_a, dim3(256), dim3(512), LDS_BYTES, stream, (const float*)d_in[0], (float*)((char*)d_ws + WS_TOKE)); }
#elif DBG_BENCH >= 4
    { static bool once = false; if (!once) { (void)hipFuncSetAttribute((const void*)k_bench_d<DBG_BENCH>, hipFuncAttributeMaxDynamicSharedMemorySize, LDS_BYTES); once = true; }
      (void)hipMemsetAsync((char*)d_ws + WS_MOD, 0, 256 * 1024, stream);
      for (int rep = 0; rep < 2; ++rep) hipLaunchKernelGGL(k_bench_d<DBG_BENCH>, dim3(256), dim3(512), LDS_BYTES, stream, (const float*)d_in[0], (const float*)d_in[4], (const float*)((char*)d_ws + WS_MOD), (bf16*)((char*)d_ws + WS_H), (float*)((char*)d_ws + WS_TOKE)); }
#elif DBG_BENCH == 3
    { static bool once = false; if (!once) { (void)hipFuncSetAttribute((const void*)k_bench_c, hipFuncAttributeMaxDynamicSharedMemorySize, LDS_BYTES); once = true; }
      for (int rep = 0; rep < 2; ++rep) hipLaunchKernelGGL(k_bench_c, dim3(256), dim3(512), LDS_BYTES, stream, (float*)((char*)d_ws + WS_TOKE), 1.0f); }
#elif DBG_BENCH == 2
    for (int rep = 0; rep < 4; ++rep) hipLaunchKernelGGL(k_bench_b, dim3(4096), dim3(256), 0, stream, (const float*)d_in[0], (float*)((char*)d_ws + WS_TOKE));
#endif
    for (int ph = 0; ph < DBG_NPH; ++ph) {
        a.ph_lo = ph; a.ph_hi = ph + 1; a.flags = 0;
        bool mk = true;
#if NAIVE_MASK
        const float* const* I = (const float* const*)d_in;
        if ((NAIVE_MASK >> ph) & 1) {
            mk = false;
            switch (ph) {
            case 0: k_mod<<<8 * 6144 / 256, 256, 0, stream>>>(I[1], I[2], I[3], mod); mk = true; break;
            case 1: k_h1<<<T, 256, 0, stream>>>(I[0], I[4], mod, I[5], I[6], hb, gates); break;
            case 2: k_ngemm<NEpi1><<<dim3((DIN + 63) / 64, T / 64), 256, 0, stream>>>(hb, 1024, I[5], DIN, DIN, 1024, NEpi1{out, zq, zk, zv, zo, zga, zgb});
                    k_glu<<<T * 512 / 256, 256, 0, stream>>>(out, zu); a.flags = (DBG_CLS) << 8; mk = (DBG_CLS) != 0;
                    k_fixw1t<<<2048 * 1024 / 256, 256, 0, stream>>>(I[5], (bf16*)(ws + WS_W1T)); break;
            case 3: k_conva<<<T, 256, 0, stream>>>(zu, I[7], I[8], I[9], I[10], uahm); mk = ((NAIVE_MASK >> 4) & 1) ? false : true; break;
            case 4: k_qkconv<<<T, 256, 0, stream>>>(zq, zk, I[12], I[13], qc, kc);
                    k_mlstm_rec<<<BATCH * NH, 256, 0, stream>>>(qc, kc, zv, zo, gates, I[14], uahm); break;
            case 5: k_ngemm<NEpi2a><<<dim3(16, T / 64), 256, 0, stream>>>(uahm, 1024, I[11], 1024, 1024, 512, NEpi2a{out, zga});
                    k_ngemm<NEpi2b><<<dim3(16, T / 64), 256, 0, stream>>>(uahm + 512, 1024, I[15], 1024, 1024, 512, NEpi2b{out, zgb, merged}); break;
            case 6: k_ngemm<NEpi3><<<dim3(16, T / 64), 256, 0, stream>>>(merged, 1024, I[16], 1024, 1024, 1024, NEpi3{I[0], mod, out}); break;
            case 7: k_h2route<<<T, 256, 0, stream>>>(out, I[17], mod, I[18], I[19], I[20], I[21], hb, toke, tokw);
                    k_lists<<<T * 2 / 256, 256, 0, stream>>>(toke, tokw, (unsigned*)(ws + WS_CTL) + CW_CNT, (int*)(ws + WS_LISTT), (float*)(ws + WS_LISTW));
                    a.flags = 1; mk = true; break;
            case 8: break;
            case 9: k_moe<<<T * 2, 256, 0, stream>>>(hb, toke, tokw, I[22], I[23], I[24], (bf16*)(ws + WS_ZU)); break;
            case 10: k_final<<<T, 256, 0, stream>>>(out, (const bf16*)(ws + WS_ZU), mod, I[25], out); break;
            }
        }
#endif
        if (mk && ph == 10 && ((DBG_HREP >> 10) & 1)) { a.flags = 65536; void* args0[] = {&a}; (void)hipLaunchKernel(mk_kernels[ph], dim3(grid), dim3(NTHREADS), args0, LDS_BYTES, stream); a.flags = 0; }
        if (mk) { void* args[] = {&a}; (void)hipLaunchKernel(mk_kernels[ph], dim3(grid), dim3(NTHREADS), args, LDS_BYTES, stream);
            if (((DBG_HREP >> ph) & 1) && ph != 10) { if (ph == 7) a.flags |= DBG_F7; if (ph == 1) a.flags |= DBG_F1; if (ph == 4) a.flags |= DBG_F4; (void)hipLaunchKernel(mk_kernels[ph], dim3(grid), dim3(NTHREADS), args, LDS_BYTES, stream); } }
    }
#endif
}
```

```cpp
#include <hip/hip_runtime.h>
#include <stdint.h>
#include <cstdio>

#ifndef MK_ONE
#define MK_ONE 1
#endif
#ifndef NAIVE_MASK
#define NAIVE_MASK 0
#endif
#ifndef DBG_NPH
#define DBG_NPH 11
#endif
#ifndef P1_MFMA
#define P1_MFMA 0
#endif
#if P1_MFMA
#define P1_FN p1_h1_mfma
#else
#define P1_FN p1_h1
#endif
#ifndef DBG_NPRE
#define DBG_NPRE 12
#endif
#ifndef XB_EARLY_ACQ
#define XB_EARLY_ACQ 1
#endif
#ifndef USE_XCD_BARRIER
#define USE_XCD_BARRIER 1
#endif
#ifndef DBG_XBAR
#define DBG_XBAR 0
#endif
#ifndef DBG_F4
#define DBG_F4 0
#endif
#ifndef DBG_F1
#define DBG_F1 0
#endif
#ifndef DBG_F7
#define DBG_F7 6
#endif
#ifndef DBG_HREP
#define DBG_HREP 0
#endif
#ifndef DBG_REP
#define DBG_REP 0
#endif
#if DBG_REP
#define REPK(k) for (int _r = 0; _r < 1 + ((DBG_REP >> (k)) & 1); ++_r)
#define REPSYNC() __syncthreads()
#else
#define REPK(k)
#define REPSYNC() do {} while (0)
#endif
#ifndef DBG_CLS
#define DBG_CLS 0
#endif
#ifndef DBG_GATEFIRST
#define DBG_GATEFIRST 0
#endif

typedef unsigned short bf16;
#define DEV __device__ __forceinline__
#define LAS __attribute__((address_space(3)))
typedef short bf16x8 __attribute__((ext_vector_type(8)));
typedef float f32x4 __attribute__((ext_vector_type(4)));
typedef unsigned v4u __attribute__((ext_vector_type(4)));
typedef unsigned v2u __attribute__((ext_vector_type(2)));

constexpr int BATCH = 8, SEQ = 2048, D = 1024, T = BATCH * SEQ;
constexpr int DIN = 5128, NH = 4;
constexpr float RMS_EPS = 1e-6f, LN_EPS = 1e-5f;
constexpr int NWAVES = 8, NTHREADS = 512;

DEV float bf2f(bf16 v) { return __uint_as_float(((unsigned)v) << 16); }
DEV float bflo(unsigned w) { return __uint_as_float(w << 16); }
DEV float bfhi(unsigned w) { return __uint_as_float(w & 0xffff0000u); }
DEV unsigned f2bfu(float f) { unsigned u = __float_as_uint(f); return (u + 0x7fffu + ((u >> 16) & 1u)) >> 16; }
DEV unsigned pk2(float lo, float hi);
DEV bf16 f2bf(float f) { return (bf16)(pk2(f, f) & 0xffffu); }
typedef float f32x2_cv __attribute__((ext_vector_type(2)));
typedef __bf16 bf16x2_cv __attribute__((ext_vector_type(2)));
DEV unsigned pk2(float lo, float hi) { const f32x2_cv v = {lo, hi}; const bf16x2_cv b = __builtin_convertvector(v, bf16x2_cv); return __builtin_bit_cast(unsigned, b); }
DEV float sigmoidf_(float x) { return __builtin_amdgcn_rcpf(1.f + __expf(-x)); }
DEV float siluf_(float x) { return x * __builtin_amdgcn_rcpf(1.f + __expf(-x)); }
DEV float logsigmoidf_(float x) { return fminf(x, 0.f) - log1pf(__expf(-fabsf(x))); }
template <int CTRL> DEV float dpp0(float v) { return __int_as_float(__builtin_amdgcn_update_dpp(0, __float_as_int(v), CTRL, 0xf, 0xf, true)); }
template <int CTRL> DEV float dppk(float v) { return __int_as_float(__builtin_amdgcn_update_dpp(__float_as_int(v), __float_as_int(v), CTRL, 0xf, 0xf, false)); }
DEV float rdlane(float v, int l) { return __int_as_float(__builtin_amdgcn_readlane(__float_as_int(v), l)); }
DEV float row16_sum(float v) {
    v += dpp0<0xB1>(v); v += dpp0<0x4E>(v); v += dpp0<0x141>(v); v += dpp0<0x140>(v); return v; }
DEV float wave_sum(float v) { v = row16_sum(v); return (rdlane(v, 0) + rdlane(v, 16)) + (rdlane(v, 32) + rdlane(v, 48)); }
DEV float wave_scan_add(float v, int lane) {
    v += dpp0<0x111>(v); v += dpp0<0x112>(v); v += dpp0<0x114>(v); v += dpp0<0x118>(v);
    const float r0 = rdlane(v, 15), r1 = rdlane(v, 31), r2 = rdlane(v, 47);
    return v + ((lane >= 48) ? (r0 + r1) + r2 : (lane >= 32) ? (r0 + r1) : (lane >= 16) ? r0 : 0.f); }
DEV float wave_scan_max(float v, int lane) {
    v = fmaxf(v, dppk<0x111>(v)); v = fmaxf(v, dppk<0x112>(v)); v = fmaxf(v, dppk<0x114>(v)); v = fmaxf(v, dppk<0x118>(v));
    const float r0 = rdlane(v, 15), r1 = rdlane(v, 31), r2 = rdlane(v, 47);
    const float p = (lane >= 48) ? fmaxf(fmaxf(r0, r1), r2) : (lane >= 32) ? fmaxf(r0, r1) : (lane >= 16) ? r0 : -3.0e38f;
    return fmaxf(v, p); }
#define LDS_WAIT() asm volatile("s_waitcnt lgkmcnt(0)" ::: "memory")

constexpr size_t MiB = 1u << 20;
constexpr size_t WS_CTL = 0, CTL_ZERO_BYTES = 65536;
constexpr size_t WS_MOD = 1 * MiB;
constexpr size_t WS_GATES = 1 * MiB + 256 * 1024;
constexpr size_t WS_STSC = 1 * MiB + 768 * 1024;
constexpr size_t WS_RBIAS = 1 * MiB + 800 * 1024;
constexpr size_t WS_WIF = 1 * MiB + 832 * 1024;
constexpr size_t WS_RW = 6 * MiB + 256 * 1024;
constexpr size_t WS_TOKE = 6 * MiB;
constexpr size_t WS_TOKW = 6 * MiB + 128 * 1024;
constexpr size_t WS_LISTT = 2 * MiB;
constexpr size_t WS_LISTW = 4 * MiB;
constexpr size_t WS_W1T = 8 * MiB;
constexpr size_t WS_W2T = 18 * MiB;
constexpr size_t WS_W3T = 20 * MiB;
constexpr size_t WS_STATE = 22 * MiB;
constexpr size_t WS_PSTA = 32 * MiB, WS_PSTB = 249 * MiB;
DEV float* pst_tile(unsigned char* ws, int pm, int pn) { return (float*)(ws + ((pn < 2) ? WS_PSTA : WS_PSTB)) + (size_t)((pm * 2 + (pn & 1)) * 256) * 40; }
constexpr size_t WS_H = 40 * MiB;
constexpr size_t WS_ZU = 72 * MiB, WS_ZQ = 88 * MiB, WS_ZK = 104 * MiB, WS_ZV = 120 * MiB, WS_ZO = 136 * MiB;
constexpr size_t WS_ZGA = 152 * MiB, WS_ZGB = 184 * MiB;
constexpr size_t WS_UAHM = 216 * MiB;
constexpr size_t WS_MERGED = WS_H;
constexpr size_t WS_WGU = 120 * MiB;
constexpr size_t WS_WD = 184 * MiB;
constexpr size_t WS_ACT = 216 * MiB;
constexpr size_t WS_YS0 = 8 * MiB, WS_YS1 = 72 * MiB, WS_YS = WS_YS0;
constexpr size_t WS_QC = WS_H, WS_KC = WS_H + 16 * MiB;
constexpr int CW_BAR = 4096, CW_CNT = 8192, CW_MODCNT = 9216, CW_FLATBAR = 9280, CW_P0DONE = 9344;

constexpr int LDS_TAB = 131072;
constexpr int LDS_MISC = 147456;
constexpr int LDS_BYTES = 151552;

struct Args { const float* in[26]; float* out; unsigned char* ws; int ph_lo, ph_hi, flags, pad; };
struct XDeal { int xr, nx, lr, nl;
    DEV int item(int i, int per) const { const int j = i * nl + lr; const int k = j / per; const int b = xr + k * nx; return (b < BATCH) ? b * per + (j - k * per) : -1; } };

namespace pg8 {
constexpr int BM = 256, BK = 64, HALF = 128, HTB = HALF * BK * 2, NXCD = 8, WGM = 8;
DEV int lds_byte(int r, int c) { const int st = (r >> 4) * 2 + (c >> 5), rr = r & 15, cc = c & 31, ob = rr * 64 + cc * 2; return st * 1024 + (ob ^ (((ob >> 9) & 1) << 5)); }
DEV void stage_rc(int b, int& R, int& C) { const int st = b / 1024, sb = b % 1024, swz = sb ^ (((sb >> 9) & 1) << 5); R = (st >> 1) * 16 + swz / 64; C = (st & 1) * 32 + (swz % 64) / 2; }
DEV int perm32(int rho) { const int n = rho >> 4, i = rho & 15; return 8 * (i >> 2) + 4 * n + (i & 3); }
DEV unsigned cvt_pk_bf16(float lo, float hi) { return pk2(lo, hi); }

struct Unit { int pm, pn; unsigned ak, bk; int slot, valid, arow0, tl; };

struct StaticOrder {
    static constexpr bool HOOKS = false;
    int nM, nN, nwg, G, c;
    DEV void init(int M, int N, int G_, int c_) { nM = M / BM; nN = N / BM; nwg = nM * nN; G = G_; c = c_; }
    DEV bool tile(int L, int& pm, int& pn) const {
        if (L >= nwg) return false;
        int wgid = L; { const int q = nwg / NXCD, r = nwg % NXCD, xcd = wgid % NXCD, off = wgid / NXCD; wgid = (xcd < r ? xcd * (q + 1) : r * (q + 1) + (xcd - r) * q) + off; }
        const int nig = WGM * nN, gid = wgid / nig, fm = gid * WGM, gsz = (nM - fm) < WGM ? (nM - fm) : WGM;
        pm = fm + ((wgid % nig) % gsz); pn = (wgid % nig) / gsz; return true;
    }
    DEV bool next(int i, Unit& u) const { u.ak = 0; u.bk = 0; u.slot = 0; u.valid = 256; u.arow0 = 0; return tile(i * G + c, u.pm, u.pn); }
};

template <class Prob, class Epi, class Sched, bool ALIGN_EPI, bool SKIP = false>
DEV void gemm_phase(LAS unsigned char* lds, const Prob& P, const Sched& S, const Epi& E, const int K) {
    int tid = threadIdx.x; asm volatile("" : "+v"(tid));
    const int wid = __builtin_amdgcn_readfirstlane(tid >> 6), lane = tid & 63, wr = wid >> 2, wc = wid & 3, fr = lane & 15, fq = lane >> 4;
    const int nt = K / BK;
    int R[2], C[2], Rb[2];
#pragma unroll
    for (int i = 0; i < 2; ++i) { stage_rc(tid * 16 + i * 8192, R[i], C[i]); Rb[i] = Epi::PERM ? ((R[i] & ~31) + perm32(R[i] & 31)) : R[i]; }
    const unsigned kstep = BK * 2;
    const unsigned ldsw = (unsigned)wid * 1024u;
    const int aoff = lds_byte(wr * 64 + fr, fq * 8), boff = lds_byte(wc * 32 + fr, fq * 8);
    const char* const Abase = (const char*)P.A; const char* const Bbase = (const char*)P.B;
#define PG8_SA(b, h) (((b) * 2 + (h)) * HTB)
#define PG8_SB(b, h) ((4 + (b) * 2 + (h)) * HTB)
#define PG8_STAGE(bufoff, base, offs, kb) do { _Pragma("unroll") for (int _i = 0; _i < 2; ++_i) \
        __builtin_amdgcn_global_load_lds((const unsigned*)((base) + (size_t)((offs)[_i] + (kb))), (LAS unsigned*)(lds + (bufoff) + ldsw + _i * 8192), 16, 0, 0); } while (0)
#define PG8_LDA(dst, b, h) do { _Pragma("unroll") for (int m = 0; m < 4; ++m) _Pragma("unroll") for (int k = 0; k < 2; ++k) dst[m][k] = *(const LAS bf16x8*)(lds + PG8_SA(b, h) + aoff + m * 2048 + k * 1024); } while (0)
#define PG8_LDB(dst, b, h) do { _Pragma("unroll") for (int n = 0; n < 2; ++n) _Pragma("unroll") for (int k = 0; k < 2; ++k) dst[n][k] = *(const LAS bf16x8*)(lds + PG8_SB(b, h) + boff + n * 2048 + k * 1024); } while (0)
#define PG8_MMA(ai, bj, At, Bt) do { __builtin_amdgcn_s_setprio(1); _Pragma("unroll") for (int m = 0; m < 4; ++m) _Pragma("unroll") for (int n = 0; n < 2; ++n) _Pragma("unroll") for (int k = 0; k < 2; ++k) \
        acc[ai][bj][m][n] = __builtin_amdgcn_mfma_f32_16x16x32_bf16(Bt[n][k], At[m][k], acc[ai][bj][m][n], 0, 0, 0); __builtin_amdgcn_s_setprio(0); } while (0)
#define PG8_WAIT_V(n) asm volatile("s_waitcnt vmcnt(" #n ")" ::: "memory")
#define PG8_WAIT_L(n) asm volatile("s_waitcnt lgkmcnt(" #n ")" ::: "memory")
#define PG8_BAR __builtin_amdgcn_s_barrier()
#define PG8_SCHED __builtin_amdgcn_sched_barrier(0)
    Unit cur, nxt; int ui = 0;
    if (!S.next(0, cur)) return;
    f32x4 acc[2][2][4][2];
#pragma unroll
    for (int a = 0; a < 2; ++a)
#pragma unroll
        for (int b = 0; b < 2; ++b)
#pragma unroll
            for (int m = 0; m < 4; ++m)
#pragma unroll
                for (int n = 0; n < 2; ++n) acc[a][b][m][n] = (f32x4){0.f, 0.f, 0.f, 0.f};
    bf16x8 At[4][2], B0[2][2], B1[2][2];
    unsigned ca[2][2], cb[2][2], na[2][2], nb[2][2];
    if constexpr (Sched::HOOKS) S.wait(cur);
    P.aoffs(cur, R, C, ca); P.boffs(cur, Rb, C, cb);
    PG8_STAGE(PG8_SB(0, 0), Bbase, cb[0], 0u); PG8_STAGE(PG8_SB(0, 1), Bbase, cb[1], 0u); PG8_STAGE(PG8_SA(0, 0), Abase, ca[0], 0u); PG8_STAGE(PG8_SA(0, 1), Abase, ca[1], 0u);
    if (wr == 1) PG8_BAR;
    PG8_WAIT_V(2); PG8_BAR;
    PG8_STAGE(PG8_SB(1, 0), Bbase, cb[0], kstep); PG8_STAGE(PG8_SA(1, 0), Abase, ca[0], kstep); PG8_STAGE(PG8_SB(1, 1), Bbase, cb[1], kstep);
    PG8_WAIT_V(6); PG8_BAR;
    for (;;) {
        const bool has_next = S.next(ui + 1, nxt);
        if (has_next) { if constexpr (Sched::HOOKS) S.wait(nxt); P.aoffs(nxt, R, C, na); P.boffs(nxt, Rb, C, nb); }
        else {
#pragma unroll
            for (int h = 0; h < 2; ++h)
#pragma unroll
                for (int i = 0; i < 2; ++i) { na[h][i] = ca[h][i]; nb[h][i] = cb[h][i]; } }
        const bool do0 = !(SKIP && cur.valid <= 64 && wr == 1), do1 = !(SKIP && cur.valid <= 128) && do0;
        for (int t = 0; t < nt; t += 2) {
            const bool last = (t == nt - 2);
            const unsigned k1 = (unsigned)(t + 1) * kstep;
            const unsigned kb2 = last ? 0u : (unsigned)(t + 2) * kstep, kb3 = kb2 + kstep;
            unsigned a2[2][2], b2[2][2];
#pragma unroll
            for (int h = 0; h < 2; ++h)
#pragma unroll
                for (int i = 0; i < 2; ++i) { a2[h][i] = last ? na[h][i] : ca[h][i]; b2[h][i] = last ? nb[h][i] : cb[h][i]; }
            PG8_LDB(B0, 0, 0); PG8_LDB(B1, 0, 1); PG8_SCHED; PG8_LDA(At, 0, 0); PG8_STAGE(PG8_SA(1, 1), Abase, ca[1], k1);
            PG8_WAIT_V(8); PG8_WAIT_L(0); PG8_BAR; if (do0) { PG8_MMA(0, 0, At, B0); PG8_MMA(0, 1, At, B1); } PG8_BAR; PG8_SCHED;
            PG8_LDA(At, 0, 1); PG8_STAGE(PG8_SB(0, 0), Bbase, b2[0], kb2); PG8_STAGE(PG8_SB(0, 1), Bbase, b2[1], kb2); PG8_STAGE(PG8_SA(0, 0), Abase, a2[0], kb2);
            PG8_WAIT_V(8); PG8_WAIT_L(0); PG8_BAR; if (do1) { PG8_MMA(1, 0, At, B0); PG8_MMA(1, 1, At, B1); } PG8_BAR; PG8_SCHED;
            PG8_LDB(B0, 1, 0); PG8_LDB(B1, 1, 1); PG8_SCHED; PG8_LDA(At, 1, 0); PG8_STAGE(PG8_SA(0, 1), Abase, a2[1], kb2);
            PG8_WAIT_V(8); PG8_WAIT_L(0); PG8_BAR; if (do0) { PG8_MMA(0, 0, At, B0); PG8_MMA(0, 1, At, B1); } PG8_BAR; PG8_SCHED;
            PG8_LDA(At, 1, 1); PG8_STAGE(PG8_SB(1, 0), Bbase, b2[0], kb3); PG8_STAGE(PG8_SB(1, 1), Bbase, b2[1], kb3); PG8_STAGE(PG8_SA(1, 0), Abase, a2[0], kb3);
            PG8_WAIT_V(8); PG8_WAIT_L(0); PG8_BAR; if (do1) { PG8_MMA(1, 0, At, B0); PG8_MMA(1, 1, At, B1); } PG8_BAR; PG8_SCHED;
        }
        if constexpr (ALIGN_EPI) { if (wr == 0) PG8_BAR; }
        E(acc, cur, wr, wc, fr, fq);
        if constexpr (Sched::HOOKS) S.signal(cur, lane);
        if (!has_next) break;
        if (!E.keep(cur)) {
#pragma unroll
            for (int a = 0; a < 2; ++a)
#pragma unroll
                for (int b = 0; b < 2; ++b)
#pragma unroll
                    for (int m = 0; m < 4; ++m)
#pragma unroll
                        for (int n = 0; n < 2; ++n) acc[a][b][m][n] = (f32x4){0.f, 0.f, 0.f, 0.f};
        }
        cur = nxt; ++ui;
#pragma unroll
        for (int h = 0; h < 2; ++h)
#pragma unroll
            for (int i = 0; i < 2; ++i) { ca[h][i] = na[h][i]; cb[h][i] = nb[h][i]; }
        if constexpr (ALIGN_EPI) { if (wr == 1) PG8_BAR; }
    }
    PG8_WAIT_V(0);
    if constexpr (!ALIGN_EPI) { if (wr == 0) PG8_BAR; }
    PG8_BAR;
#undef PG8_SA
#undef PG8_SB
#undef PG8_STAGE
#undef PG8_LDA
#undef PG8_LDB
#undef PG8_MMA
#undef PG8_WAIT_V
#undef PG8_WAIT_L
#undef PG8_BAR
#undef PG8_SCHED
}
}
using pg8::Unit;

struct ProbPlain {
    const bf16* A; const bf16* B; unsigned lda2, ldb2;
    DEV void aoffs(const Unit& u, const int (&R)[2], const int (&C)[2], unsigned (&o)[2][2]) const {
#pragma unroll
        for (int h = 0; h < 2; ++h)
#pragma unroll
            for (int i = 0; i < 2; ++i) o[h][i] = (unsigned)(u.pm * 256 + 128 * h + R[i]) * lda2 + (unsigned)C[i] * 2u + u.ak; }
    DEV void boffs(const Unit& u, const int (&Rb)[2], const int (&C)[2], unsigned (&o)[2][2]) const {
#pragma unroll
        for (int h = 0; h < 2; ++h)
#pragma unroll
            for (int i = 0; i < 2; ++i) o[h][i] = (unsigned)(u.pn * 256 + 128 * h + Rb[i]) * ldb2 + (unsigned)C[i] * 2u + u.bk; }
};
struct ProbMoeUp {
    const bf16* A; const bf16* B; const LAS unsigned* rowtab;
    DEV void aoffs(const Unit& u, const int (&R)[2], const int (&C)[2], unsigned (&o)[2][2]) const {
#pragma unroll
        for (int h = 0; h < 2; ++h)
#pragma unroll
            for (int i = 0; i < 2; ++i) o[h][i] = rowtab[u.slot * 256 + 128 * h + R[i]] + (unsigned)C[i] * 2u; }
    DEV void boffs(const Unit& u, const int (&Rb)[2], const int (&C)[2], unsigned (&o)[2][2]) const {
#pragma unroll
        for (int h = 0; h < 2; ++h)
#pragma unroll
            for (int i = 0; i < 2; ++i) o[h][i] = (unsigned)(u.pn * 256 + 128 * h + Rb[i]) * 2048u + (unsigned)C[i] * 2u + u.bk; }
};
struct ProbMoeDown {
    const bf16* A; const bf16* B;
    DEV void aoffs(const Unit& u, const int (&R)[2], const int (&C)[2], unsigned (&o)[2][2]) const {
#pragma unroll
        for (int h = 0; h < 2; ++h)
#pragma unroll
            for (int i = 0; i < 2; ++i) o[h][i] = (unsigned)(u.arow0 + 128 * h + R[i]) * 1024u + (unsigned)C[i] * 2u; }
    DEV void boffs(const Unit& u, const int (&Rb)[2], const int (&C)[2], unsigned (&o)[2][2]) const {
#pragma unroll
        for (int h = 0; h < 2; ++h)
#pragma unroll
            for (int i = 0; i < 2; ++i) o[h][i] = (unsigned)(u.pn * 256 + 128 * h + Rb[i]) * 1024u + (unsigned)C[i] * 2u + u.bk; }
};

DEV void st16_wt(void* p, const v4u v) { asm volatile("global_store_dwordx4 %0, %1, off sc1\n\ts_nop 1" :: "v"(p), "v"(v) : "memory"); }
DEV v4u pack8(const f32x4 v0, const f32x4 v1) { v4u w; w.x = pg8::cvt_pk_bf16(v0[0], v0[1]); w.y = pg8::cvt_pk_bf16(v0[2], v0[3]); w.z = pg8::cvt_pk_bf16(v1[0], v1[1]); w.w = pg8::cvt_pk_bf16(v1[2], v1[3]); return w; }
DEV f32x4 sig4(f32x4 v) { f32x4 o; o[0] = sigmoidf_(v[0]); o[1] = sigmoidf_(v[1]); o[2] = sigmoidf_(v[2]); o[3] = sigmoidf_(v[3]); return o; }
DEV f32x4 unpack4(const v2u w) { return (f32x4){bflo(w.x), bfhi(w.x), bflo(w.y), bfhi(w.y)}; }
DEV void unpack8(const v4u w, f32x4& lo, f32x4& hi) { lo[0] = bflo(w.x); lo[1] = bfhi(w.x); lo[2] = bflo(w.y); lo[3] = bfhi(w.y); hi[0] = bflo(w.z); hi[1] = bfhi(w.z); hi[2] = bflo(w.w); hi[3] = bfhi(w.w); }

struct Epi1 {
    static constexpr bool PERM = true;
    bf16* zu; bf16* zga; int cls;
    DEV bool keep(const Unit&) const { return false; }
    DEV void operator()(f32x4 (&acc)[2][2][4][2], const Unit& u, int wr, int wc, int fr, int fq) const {
        const int row0 = u.pm * 256 + wr * 64 + fr, cl = wc * 32 + 8 * fq;
        if (cls) { const int c = (u.pn < 4) ? 1 : (u.pn < 12) ? 2 : (u.pn < 16) ? 4 : 8; if (!(cls & c)) return; }
        if (u.pn < 4) {
#pragma unroll
            for (int ai = 0; ai < 2; ++ai)
#pragma unroll
                for (int m = 0; m < 4; ++m) { const size_t row = (size_t)(row0 + ai * 128 + m * 16);
                    const f32x4 v0 = acc[ai][0][m][0] * sig4(acc[ai][1][m][0]), v1 = acc[ai][0][m][1] * sig4(acc[ai][1][m][1]);
                    *(v4u*)(zu + row * 512 + 128 * u.pn + cl) = pack8(v0, v1); }
        } else {
            bf16* base; int ld, colb; bool sg;
            if (u.pn < 12) { const int ti = (u.pn - 4) >> 1; base = zu + (size_t)(1 + ti) * T * 512; ld = 512; colb = 256 * ((u.pn - 4) & 1); sg = (ti == 3); }
            else { const int ti = (u.pn - 12) >> 2; base = zga + (size_t)ti * T * 1024; ld = 1024; colb = 256 * ((u.pn - 12) & 3); sg = true; }
            if (u.pn >= 12) {
                const int t = u.pn - 12;
                const size_t fo = ((size_t)(u.pm * 4 + (t >> 1)) * 65536) + (size_t)((t & 1) * 4096) + (size_t)((wr * 4 + wc) * 64 + fq * 16 + fr) * 8;
                bf16* fr_ = zga + fo; bf16* fs_ = zga + (size_t)T * 1024 + fo;
#pragma unroll
                for (int ai = 0; ai < 2; ++ai)
#pragma unroll
                    for (int m = 0; m < 4; ++m) { f32x4 rr[2], sb[2];
#pragma unroll
                        for (int n = 0; n < 2; ++n) { const f32x4 sa = sig4(acc[ai][0][m][n]); sb[n] = sig4(acc[ai][1][m][n]);
#pragma unroll
                            for (int j = 0; j < 4; ++j) rr[n][j] = sa[j] * __builtin_amdgcn_rcpf(fmaxf(sb[n][j], 1e-30f)); }
                        *(v4u*)(fr_ + (size_t)((ai * 4 + m) * 2 * 4096)) = pack8(rr[0], rr[1]); *(v4u*)(fs_ + (size_t)((ai * 4 + m) * 2 * 4096)) = pack8(sb[0], sb[1]); }
            } else
#pragma unroll
            for (int ai = 0; ai < 2; ++ai)
#pragma unroll
                for (int m = 0; m < 4; ++m) { const size_t row = (size_t)(row0 + ai * 128 + m * 16);
#pragma unroll
                    for (int bj = 0; bj < 2; ++bj) { f32x4 v0 = acc[ai][bj][m][0], v1 = acc[ai][bj][m][1]; if (sg) { v0 = sig4(v0); v1 = sig4(v1); }
                        *(v4u*)(base + row * ld + colb + 128 * bj + cl) = pack8(v0, v1); } }
        }
    }
};
struct Epi2 {
    static constexpr bool PERM = true;
    const bf16* zga; const bf16* zgb; bf16* merged;
    DEV bool keep(const Unit& u) const { return u.slot == 0; }
    DEV void operator()(f32x4 (&acc)[2][2][4][2], const Unit& u, int wr, int wc, int fr, int fq) const {
        const int row0 = u.pm * 256 + wr * 64 + fr, c0 = u.pn * 256 + wc * 32 + 8 * fq;
        const size_t fo = ((size_t)(u.pm * 4 + u.pn) * 65536) + (size_t)((wr * 4 + wc) * 64 + fq * 16 + fr) * 8;
#pragma unroll
        for (int ai = 0; ai < 2; ++ai)
#pragma unroll
            for (int m = 0; m < 4; ++m) { const size_t ro = (size_t)(row0 + ai * 128 + m * 16) * 1024 + c0;
#pragma unroll
                for (int bj = 0; bj < 2; ++bj) { const size_t fa = fo + (size_t)(((ai * 4 + m) * 2 + bj) * 4096);
                    if (u.slot == 0) { f32x4 r0, r1; unpack8(*(const v4u*)(zga + fa), r0, r1);
                        acc[ai][bj][m][0] = acc[ai][bj][m][0] * r0; acc[ai][bj][m][1] = acc[ai][bj][m][1] * r1;
                    } else { f32x4 b0, b1; unpack8(*(const v4u*)(zgb + fa), b0, b1); *(v4u*)(merged + ro + 128 * bj) = pack8(acc[ai][bj][m][0] * b0, acc[ai][bj][m][1] * b1); }
                } }
    }
};
struct EpiUp {
    static constexpr bool PERM = true;
    bf16* act;
    DEV bool keep(const Unit&) const { return false; }
    DEV void operator()(f32x4 (&acc)[2][2][4][2], const Unit& u, int wr, int wc, int fr, int fq) const {
        const int cl = 128 * u.pn + wc * 32 + 8 * fq;
#pragma unroll
        for (int ai = 0; ai < 2; ++ai)
#pragma unroll
            for (int m = 0; m < 4; ++m) { const int rt = ai * 128 + wr * 64 + m * 16 + fr;
                if (rt < u.valid) { f32x4 v0, v1;
#pragma unroll
                    for (int j = 0; j < 4; ++j) { v0[j] = siluf_(acc[ai][0][m][0][j]) * acc[ai][1][m][0][j]; v1[j] = siluf_(acc[ai][0][m][1][j]) * acc[ai][1][m][1][j]; }
                    *(v4u*)(act + (size_t)(u.arow0 + rt) * 512 + cl) = pack8(v0, v1); } }
    }
};
struct EpiDown {
    static constexpr bool PERM = true;
    bf16* ys; const LAS unsigned* desttab; const LAS float* wtab;
    DEV bool keep(const Unit&) const { return false; }
    DEV void operator()(f32x4 (&acc)[2][2][4][2], const Unit& u, int wr, int wc, int fr, int fq) const {
        const int cl = 256 * u.pn + wc * 32 + 8 * fq;
#pragma unroll
        for (int ai = 0; ai < 2; ++ai)
#pragma unroll
            for (int m = 0; m < 4; ++m) { const int rt = ai * 128 + wr * 64 + m * 16 + fr;
                if (rt < u.valid) { const unsigned dest = desttab[u.slot * 256 + rt]; const float w = wtab[u.slot * 256 + rt];
#pragma unroll
                    for (int bj = 0; bj < 2; ++bj) *(v4u*)(ys + (size_t)dest + cl + 128 * bj) = pack8(acc[ai][bj][m][0] * w, acc[ai][bj][m][1] * w); } }
    }
};

#define XB_TMO      128
#define XB_XCNT(j)  (256  + 64 * (j))
#define XB_XSUB(j)  (1280 + 64 * (j))
#define XB_XGEN(j)  (2304 + 64 * (j))
#define XB_TOP      3328
#define XB_TOPGEN   3392
#define XCD_BAR_WORDS 3456
#define XB_SPIN_CAP (1u << 18)
__device__ __forceinline__ unsigned xb_ld(unsigned* p)              { return __hip_atomic_load(p, __ATOMIC_RELAXED, __HIP_MEMORY_SCOPE_AGENT); }
__device__ __forceinline__ unsigned xb_add(unsigned* p, unsigned v) { return __hip_atomic_fetch_add(p, v, __ATOMIC_RELAXED, __HIP_MEMORY_SCOPE_AGENT); }
__device__ __forceinline__ unsigned xb_xcc_id() { return (unsigned)__builtin_amdgcn_s_getreg((3 << 11) | 20) & 0xFu; }
#define XB_SPIN(cond, bar) do { unsigned _sp = 0; while (cond) { __builtin_amdgcn_s_sleep(1); \
    if ((++_sp & 255u) == 0u) { if (xb_ld(&(bar)[XB_TMO])) break; if (_sp > XB_SPIN_CAP) { atomicAdd(&(bar)[XB_TMO], 1u); break; } } } } while (0)
struct XcdBarrier { unsigned* bar; unsigned x; volatile LAS unsigned* st; };
__device__ __forceinline__ XcdBarrier xcd_barrier_post(unsigned* bar, volatile LAS unsigned* st) {
    XcdBarrier b; b.bar = bar; b.x = xb_xcc_id(); b.st = st;
    if (threadIdx.x == 0) st[4] = xb_add(&bar[XB_XCNT(b.x)], 1u);
    return b;
}
__device__ __forceinline__ void xcd_barrier_complete(unsigned* bar, unsigned x, unsigned& nloc, unsigned& nx, unsigned& xr) {
    const unsigned G = gridDim.x * gridDim.y * gridDim.z;
    unsigned sum, cnt, mine, below, sp = 0u;
    for (;;) {
        sum = 0u; cnt = 0u; mine = 0u; below = 0u;
#pragma unroll
        for (unsigned j = 0; j < 16; ++j) { const unsigned c = xb_ld(&bar[XB_XCNT(j)]); sum += c; cnt += (c > 0u) ? 1u : 0u; mine = (j == x) ? c : mine; below += (j < x && c > 0u) ? 1u : 0u; }
        if (sum == G) break;
        __builtin_amdgcn_s_sleep(1);
        if ((++sp & 255u) == 0u) { if (xb_ld(&bar[XB_TMO])) break; if (sp > XB_SPIN_CAP) { atomicAdd(&bar[XB_TMO], 1u); break; } }
    }
    nloc = mine > 0u ? mine : 1u; nx = cnt > 0u ? cnt : 1u; xr = below;
}
__device__ __forceinline__ void xcd_barrier(const XcdBarrier& b) {
    asm volatile("s_waitcnt vmcnt(0)" ::: "memory");
    __syncthreads();
    if (threadIdx.x == 0) {
        unsigned* bar = b.bar;
        __builtin_amdgcn_s_waitcnt(0);
        unsigned nloc = b.st[0], nx = b.st[1];
        if (nloc == 0u) { unsigned xr; xcd_barrier_complete(bar, b.x, nloc, nx, xr); b.st[0] = nloc; b.st[1] = nx; b.st[5] = xr; }
        const unsigned old = xb_add(&bar[XB_XSUB(b.x)], 1u);
        const unsigned gen = old / nloc;
        if (old + 1u == (gen + 1u) * nloc) {
            __builtin_amdgcn_fence(__ATOMIC_RELEASE, "agent");
            asm volatile("s_waitcnt vmcnt(0)" ::: "memory");
            const unsigned og = xb_add(&bar[XB_TOP], 1u);
            const unsigned tg = og / nx;
            if (og + 1u == (tg + 1u) * nx) xb_add(&bar[XB_TOPGEN], 1u);
            else XB_SPIN(xb_ld(&bar[XB_TOPGEN]) == tg, bar);
            __builtin_amdgcn_fence(__ATOMIC_ACQUIRE, "agent");
            xb_add(&bar[XB_XGEN(b.x)], 1u);
            asm volatile("s_waitcnt vmcnt(0)" ::: "memory");
        } else {
#if XB_EARLY_ACQ
            __builtin_amdgcn_fence(__ATOMIC_ACQUIRE, "agent");
            XB_SPIN(xb_ld(&bar[XB_XGEN(b.x)]) == gen, bar);
            asm volatile("s_waitcnt vmcnt(0)" ::: "memory");
#else
            XB_SPIN(xb_ld(&bar[XB_XGEN(b.x)]) == gen, bar);
            __builtin_amdgcn_fence(__ATOMIC_ACQUIRE, "agent");
            asm volatile("s_waitcnt vmcnt(0)" ::: "memory");
#endif
        }
    }
    __syncthreads();
}

__device__ __forceinline__ void flat_barrier(unsigned* cnt, unsigned& gen) {
    asm volatile("s_waitcnt vmcnt(0)" ::: "memory");
    __syncthreads();
    ++gen;
    if (threadIdx.x == 0) {
        __builtin_amdgcn_fence(__ATOMIC_RELEASE, "agent");
        asm volatile("s_waitcnt vmcnt(0)" ::: "memory");
        (void)xb_add(cnt, 1u);
        const unsigned want = gen * gridDim.x; unsigned sp = 0;
        while (xb_ld(cnt) < want) { __builtin_amdgcn_s_sleep(1); if (++sp > (1u << 22)) break; }
        __builtin_amdgcn_fence(__ATOMIC_ACQUIRE, "agent");
        asm volatile("s_waitcnt vmcnt(0)" ::: "memory");
    }
    __syncthreads();
}
constexpr int CW_LBAR = 10752;
constexpr int CW_TILE = 11776;
template <int N, bool P0 = false>
__device__ __forceinline__ void xcd_local_barrier(const XcdBarrier& b, unsigned* lbar, unsigned* p0done = nullptr) {
    asm volatile("s_waitcnt vmcnt(0)" ::: "memory");
    __syncthreads();
    if (threadIdx.x == 0) {
        __builtin_amdgcn_s_waitcnt(0);
        const unsigned want = (unsigned)N * b.st[0];
        (void)xb_add(&lbar[64u * b.x], 1u);
        __builtin_amdgcn_fence(__ATOMIC_ACQUIRE, "agent");
        XB_SPIN(xb_ld(&lbar[64u * b.x]) < want, b.bar);
        if (P0) { const unsigned G = gridDim.x; XB_SPIN(xb_ld(p0done) < G, b.bar); }
        asm volatile("s_waitcnt vmcnt(0)" ::: "memory");
    }
    __syncthreads();
}
__device__ __forceinline__ void xcd_local_arrive(const XcdBarrier& b, unsigned* lbar) {
    asm volatile("s_waitcnt vmcnt(0)" ::: "memory");
    __syncthreads();
    if (threadIdx.x == 0) { __builtin_amdgcn_s_waitcnt(0); (void)xb_add(&lbar[64u * b.x], 1u); }
}
template <int N>
__device__ __forceinline__ void xcd_local_wait(const XcdBarrier& b, unsigned* lbar) {
    if (threadIdx.x == 0) {
        const unsigned want = (unsigned)N * b.st[0];
        __builtin_amdgcn_fence(__ATOMIC_ACQUIRE, "agent");
        XB_SPIN(xb_ld(&lbar[64u * b.x]) < want, b.bar);
        asm volatile("s_waitcnt vmcnt(0)" ::: "memory");
    }
    __syncthreads();
}
constexpr int CW_GBAR = 14848;
template <int N>
__device__ __forceinline__ void xcd_group_barrier(const XcdBarrier& b, unsigned* gbar, int grp) {
    asm volatile("s_waitcnt vmcnt(0)" ::: "memory");
    __syncthreads();
    if (threadIdx.x == 0) {
        __builtin_amdgcn_s_waitcnt(0);
        unsigned* w = gbar + 16u * (2u * b.x + (unsigned)grp);
        (void)xb_add(w, 1u);
        __builtin_amdgcn_fence(__ATOMIC_ACQUIRE, "agent");
        XB_SPIN(xb_ld(w) < (unsigned)N * 16u, b.bar);
        asm volatile("s_waitcnt vmcnt(0)" ::: "memory");
    }
    __syncthreads();
}
constexpr int CW_QBAR = 15360;
__device__ __forceinline__ void xcd_quad_barrier(const XcdBarrier& b, unsigned* qbar, int quad) {
    asm volatile("s_waitcnt vmcnt(0)" ::: "memory");
    __syncthreads();
    if (threadIdx.x == 0) {
        __builtin_amdgcn_s_waitcnt(0);
        unsigned* w = qbar + 16u * (8u * b.x + (unsigned)quad);
        (void)xb_add(w, 1u);
        __builtin_amdgcn_fence(__ATOMIC_ACQUIRE, "agent");
        XB_SPIN(xb_ld(w) < 4u, b.bar);
        asm volatile("s_waitcnt vmcnt(0)" ::: "memory");
    }
    __syncthreads();
}
DEV f32x4 mma16(bf16x8 a, bf16x8 b, f32x4 c) { return __builtin_amdgcn_mfma_f32_16x16x32_bf16(a, b, c, 0, 0, 0); }
DEV void split8(const f32x4 a, const f32x4 b, bf16x8& hi, bf16x8& lo) {
    v4u h, l; const float r[8] = {a[0], a[1], a[2], a[3], b[0], b[1], b[2], b[3]}; unsigned hw[4], lw[4];
#pragma unroll
    for (int i = 0; i < 4; ++i) { hw[i] = pk2(r[2 * i], r[2 * i + 1]); lw[i] = pk2(r[2 * i] - bflo(hw[i]), r[2 * i + 1] - bfhi(hw[i])); }
    h.x = hw[0]; h.y = hw[1]; h.z = hw[2]; h.w = hw[3]; l.x = lw[0]; l.y = lw[1]; l.z = lw[2]; l.w = lw[3];
    hi = __builtin_bit_cast(bf16x8, h); lo = __builtin_bit_cast(bf16x8, l);
}
DEV void st_sc1(void* p, v4u v) {
    unsigned long long* q = (unsigned long long*)p;
    __hip_atomic_store(q, (unsigned long long)v.x | ((unsigned long long)v.y << 32), __ATOMIC_RELAXED, __HIP_MEMORY_SCOPE_AGENT);
    __hip_atomic_store(q + 1, (unsigned long long)v.z | ((unsigned long long)v.w << 32), __ATOMIC_RELAXED, __HIP_MEMORY_SCOPE_AGENT); }
template <bool SC1 = false>
DEV void transpose_item(const float* src, int ldsrc, bf16* dst, int lddst, LAS float* scr, int lane) {
#pragma unroll 8
    for (int i = 0; i < 32; ++i) { const int kk = 2 * i + (lane >> 5); scr[kk * 33 + (lane & 31)] = src[(size_t)kk * ldsrc + (lane & 31)]; }
    LDS_WAIT(); asm volatile("" ::: "memory");
    const int c = lane & 7;
#pragma unroll
    for (int j = 0; j < 4; ++j) { const int n = (lane >> 3) + 8 * j; const LAS float* s = scr + (8 * c) * 33 + n;
        v4u o; o.x = pk2(s[0 * 33], s[1 * 33]); o.y = pk2(s[2 * 33], s[3 * 33]); o.z = pk2(s[4 * 33], s[5 * 33]); o.w = pk2(s[6 * 33], s[7 * 33]);
        if (SC1) st_sc1(dst + (size_t)n * lddst + 8 * c, o); else *(v4u*)(dst + (size_t)n * lddst + 8 * c) = o; }
    LDS_WAIT(); asm volatile("" ::: "memory");
}

DEV void router_prep(const Args& a, int gw, int NGW, int lane) {
    const float* mod = (const float*)(a.ws + WS_MOD);
    const float* g2 = a.in[17]; const float* w_rg = a.in[18]; const float* b_rg = a.in[19]; const float* w_re = a.in[20]; const float* b_re = a.in[21];
    float* rbias = (float*)(a.ws + WS_RBIAS); v4u* rw = (v4u*)(a.ws + WS_RW);
    for (int it = gw; it < 8 * 36; it += NGW) { const int b = it / 36, n = it % 36; float sacc = 0.f;
#pragma unroll
        for (int i = 0; i < 16; ++i) { const int k = lane + 64 * i; const float w = (n < 4) ? w_rg[k * 4 + n] : w_re[k * 32 + n - 4]; sacc += mod[b * 6144 + 3072 + k] * w; }
        sacc = wave_sum(sacc);
        if (lane == 0) __hip_atomic_store(rbias + b * 48 + n, sacc + ((n < 4) ? b_rg[n] : b_re[n - 4]), __ATOMIC_RELAXED, __HIP_MEMORY_SCOPE_AGENT); }
    for (int it = gw; it < 8 * 8 * 4 * 3; it += NGW) {
        const int nt = it % 3, kk = (it / 3) & 3, w8 = (it / 12) & 7, b = it / 96;
        const int n = 16 * nt + (lane & 15), k0 = 128 * w8 + 32 * kk + 8 * (lane >> 4);
        f32x4 w0, w1;
#pragma unroll
        for (int j = 0; j < 8; ++j) { const int k = k0 + j; const float* wp = (n < 4) ? (w_rg + k * 4 + n) : (w_re + k * 32 + ((n < 36) ? n - 4 : 0));
            float w = *wp; w = (n < 36) ? w : 0.f;
            w *= g2[k] * (1.f + mod[b * 6144 + 4096 + k]); if (j < 4) w0[j] = w; else w1[j - 4] = w; }
        bf16x8 hi, lo; split8(w0, w1, hi, lo);
        st_sc1(rw + ((size_t)it * 2) * 64 + lane, __builtin_bit_cast(v4u, hi)); st_sc1(rw + ((size_t)it * 2 + 1) * 64 + lane, __builtin_bit_cast(v4u, lo));
    }
}
DEV void wait_mod(const Args& a, int tid) {
    if (tid == 0) {
        unsigned* mc = (unsigned*)(a.ws + WS_CTL) + CW_MODCNT; unsigned sp = 0;
        while (__hip_atomic_load(mc, __ATOMIC_RELAXED, __HIP_MEMORY_SCOPE_AGENT) < 192u) { __builtin_amdgcn_s_sleep(2); if (++sp > (1u << 22)) break; }
        __builtin_amdgcn_fence(__ATOMIC_ACQUIRE, "agent"); asm volatile("s_waitcnt vmcnt(0)" ::: "memory"); }
    __syncthreads();
}
DEV void p0_prologue(const Args& a, LAS unsigned char* lds, int bid, int G) {
    int tid = threadIdx.x; asm volatile("" : "+v"(tid));
    const int lane = tid & 63, wave = __builtin_amdgcn_readfirstlane(tid >> 6);
    const float* c = a.in[1]; const float* w_ada = a.in[2]; const float* b_ada = a.in[3];
    float* mod = (float*)(a.ws + WS_MOD);
    if (bid < 192) {
        LAS float* sil = (LAS float*)lds;
        LAS float* red = (LAS float*)(lds + 32768);
        for (int i = tid; i < 8192; i += NTHREADS) sil[i] = siluf_(c[i]);
        __syncthreads();
        for (int item = bid; item < 192; item += G) {
            const int n0 = item * 32, lg = lane >> 3, cq = lane & 7;
            float acc[8][4];
#pragma unroll
            for (int b = 0; b < 8; ++b)
#pragma unroll
                for (int j = 0; j < 4; ++j) acc[b][j] = 0.f;
#pragma unroll 4
            for (int j = 0; j < 16; ++j) { const int k = wave * 128 + j * 8 + lg; const f32x4 w = *(const f32x4*)(w_ada + (size_t)k * 6144 + n0 + cq * 4);
#pragma unroll
                for (int b = 0; b < 8; ++b) { const float s = sil[b * 1024 + k]; acc[b][0] += s * w[0]; acc[b][1] += s * w[1]; acc[b][2] += s * w[2]; acc[b][3] += s * w[3]; } }
#pragma unroll
            for (int b = 0; b < 8; ++b)
#pragma unroll
                for (int j = 0; j < 4; ++j) { float v = acc[b][j]; v += dpp0<0x128>(v); if ((lane & 8) == 0) red[(wave * 4 + (lane >> 4)) * 256 + b * 32 + cq * 4 + j] = v; }
            __syncthreads();
            if (tid < 256) { float s = 0.f;
#pragma unroll
                for (int w = 0; w < 32; ++w) s += red[w * 256 + tid];
                const int b = tid >> 5, col = tid & 31; __hip_atomic_store(mod + b * 6144 + n0 + col, s + b_ada[n0 + col], __ATOMIC_RELAXED, __HIP_MEMORY_SCOPE_AGENT); }
            asm volatile("s_waitcnt vmcnt(0)" ::: "memory");
            __syncthreads();
            if (tid == 0) __hip_atomic_fetch_add((unsigned*)(a.ws + WS_CTL) + CW_MODCNT, 1u, __ATOMIC_RELAXED, __HIP_MEMORY_SCOPE_AGENT);
        }
    }
#if P1_MFMA
    if (bid == G - 1) { const float* w_in0 = a.in[5]; float* wif = (float*)(a.ws + WS_WIF);
        for (int i = tid; i < 2048; i += NTHREADS) { const int k = i >> 1, hf = i & 1; *(f32x4*)(wif + k * 8 + 4 * hf) = *(const f32x4*)(w_in0 + (size_t)k * DIN + 3072 + 4 * hf); } }
#endif
    LAS float* scr = (LAS float*)(lds + wave * 16384);
    const bool dbl = (G == 256) && (bid >= 192);
    const int vb = dbl ? 192 + 2 * (bid - 192) : bid, NVB = (G == 256) ? 320 : G;
    const float* w_in = a.in[5]; const float* wco = a.in[11]; const float* wmo = a.in[15]; const float* wout = a.in[16];
    bf16* W1T = (bf16*)(a.ws + WS_W1T); bf16* W2T = (bf16*)(a.ws + WS_W2T); bf16* W3T = (bf16*)(a.ws + WS_W3T);
    constexpr int I1 = 16 * 160, I2 = 8 * 32, I3 = 16 * 32, NIT = I1 + 2 * I2 + I3;
    for (int pass = 0; pass < (dbl ? 2 : 1); ++pass)
    for (int it = (vb + pass) * NWAVES + wave; it < NIT; it += NVB * NWAVES) {
        int r = it;
        if (r < I1) { const int kb = r / 160, nb = r % 160, np = 32 * nb; int sc;
            if (np < 1024) { const int t = np >> 8, q = np & 255; sc = (q < 128) ? 128 * t + q : 512 + 128 * t + q - 128; } else if (np < 3072) sc = np; else { const int t = (np - 3072) >> 8, w = (np - 3072) & 255; sc = (w < 128) ? 3080 + 128 * t + w : 4104 + 128 * t + (w - 128); }
            transpose_item<true>(w_in + (size_t)(64 * kb) * DIN + sc, DIN, W1T + (size_t)np * 1024 + 64 * kb, 1024, scr, lane); continue; }
        r -= I1;
        if (r < I2) { const int kb = r / 32, nb = r % 32; transpose_item<true>(wco + (size_t)(64 * kb) * 1024 + 32 * nb, 1024, W2T + (size_t)(32 * nb) * 1024 + 64 * kb, 1024, scr, lane); continue; }
        r -= I2;
        if (r < I2) { const int kb = r / 32, nb = r % 32; transpose_item<true>(wmo + (size_t)(64 * kb) * 1024 + 32 * nb, 1024, W2T + (size_t)(32 * nb) * 1024 + 512 + 64 * kb, 1024, scr, lane); continue; }
        r -= I2;
        { const int kb = r / 32, nb = r % 32; transpose_item<true>(wout + (size_t)(64 * kb) * 1024 + 32 * nb, 1024, W3T + (size_t)(32 * nb) * 1024 + 64 * kb, 1024, scr, lane); }
    }
    if (G > 192 && bid >= 192) { wait_mod(a, tid); router_prep(a, (bid - 192) * NWAVES + wave, (G - 192) * NWAVES, lane); }
    asm volatile("s_waitcnt vmcnt(0)" ::: "memory");
    __syncthreads();
    if (tid == 0) __hip_atomic_fetch_add((unsigned*)(a.ws + WS_CTL) + CW_P0DONE, 1u, __ATOMIC_RELAXED, __HIP_MEMORY_SCOPE_AGENT);
}

DEV void p1_h1(const Args& a, LAS unsigned char* lds, int bid, int G, const XDeal& X) {
    int tid = threadIdx.x; asm volatile("" : "+v"(tid));
    const int lane = tid & 63, wave = __builtin_amdgcn_readfirstlane(tid >> 6);
    const float* x = a.in[0]; const float* g1 = a.in[4]; const float* w_in = a.in[5]; const float* b_if = a.in[6];
    const float* mod = (const float*)(a.ws + WS_MOD); bf16* h1 = (bf16*)(a.ws + WS_H); float* gates = (float*)(a.ws + WS_GATES);
    LAS float* tab = (LAS float*)lds;
    f32x4 tw[2][2];
#pragma unroll
    for (int q = 0; q < 2; ++q) { const int k = tid + NTHREADS * q; tw[q][0] = *(const f32x4*)(w_in + (size_t)k * DIN + 3072); tw[q][1] = *(const f32x4*)(w_in + (size_t)k * DIN + 3076); }
    asm volatile("" ::: "memory");
    if (tid == 0) {
        unsigned* mc = (unsigned*)(a.ws + WS_CTL) + CW_MODCNT; unsigned sp = 0;
        while (__hip_atomic_load(mc, __ATOMIC_RELAXED, __HIP_MEMORY_SCOPE_AGENT) < 192u) { __builtin_amdgcn_s_sleep(2); if (++sp > (1u << 22)) break; }
        __builtin_amdgcn_fence(__ATOMIC_ACQUIRE, "agent"); asm volatile("s_waitcnt vmcnt(0)" ::: "memory"); }
#pragma unroll
    for (int q = 0; q < 2; ++q) { const int k = tid + NTHREADS * q; const int p = ((k >> 8) << 2) | (k & 3), l = (k >> 2) & 63;
        *(LAS f32x4*)(tab + (p * 64 + l) * 8) = tw[q][0]; *(LAS f32x4*)(tab + (p * 64 + l) * 8 + 4) = tw[q][1]; }
    __syncthreads();
    if (G <= 192) router_prep(a, bid * NWAVES + wave, G * NWAVES, lane);
    const float bifv = b_if[lane & 7];
    for (int ti = 0;; ++ti) {
        const int tile = X.item(ti, SEQ / 64); if (tile < 0) break;
        const int b = tile / 32;
        float sc[4][4], sh[4][4];
#pragma unroll
        for (int j = 0; j < 4; ++j) { const int k = 256 * j + 4 * lane; const f32x4 gv = *(const f32x4*)(g1 + k), sv = *(const f32x4*)(mod + b * 6144 + 1024 + k), hv = *(const f32x4*)(mod + b * 6144 + k);
#pragma unroll
            for (int i = 0; i < 4; ++i) { sc[j][i] = gv[i] * (1.f + sv[i]); sh[j][i] = hv[i]; } }
        f32x4 xr[2][4];
#pragma unroll
        for (int p = 0; p < 2; ++p)
#pragma unroll
            for (int j = 0; j < 4; ++j) xr[p][j] = *(const f32x4*)(x + ((size_t)tile * 64 + wave + 8 * p) * 1024 + 256 * j + 4 * lane);
#pragma unroll 1
        for (int gq = 0; gq < 4; ++gq) {
            float rstd[2];
#pragma unroll
            for (int p = 0; p < 2; ++p) { float ss = 0.f;
#pragma unroll
                for (int j = 0; j < 4; ++j) { const f32x4 v = xr[p][j]; ss += (v[0] * v[0] + v[1] * v[1]) + (v[2] * v[2] + v[3] * v[3]); }
                rstd[p] = rsqrtf(wave_sum(ss) * (1.f / 1024.f) + RMS_EPS); }
            float g[2][8];
#pragma unroll
            for (int p = 0; p < 2; ++p)
#pragma unroll
                for (int q = 0; q < 8; ++q) g[p][q] = 0.f;
#pragma unroll
            for (int j = 0; j < 4; ++j) {
                float hh[2][4];
#pragma unroll
                for (int p = 0; p < 2; ++p) { const f32x4 v = xr[p][j]; const size_t row = (size_t)tile * 64 + wave + 8 * (2 * gq + p);
#pragma unroll
                    for (int i = 0; i < 4; ++i) hh[p][i] = v[i] * rstd[p] * sc[j][i] + sh[j][i];
                    if (gq < 3) xr[p][j] = *(const f32x4*)(x + (row + 16) * 1024 + 256 * j + 4 * lane);
                    v2u o; o.x = pk2(hh[p][0], hh[p][1]); o.y = pk2(hh[p][2], hh[p][3]);
                    *(v2u*)(h1 + row * 1024 + 256 * j + 4 * lane) = o; }
#pragma unroll
                for (int i = 0; i < 4; ++i) { const LAS float* tp = tab + ((4 * j + i) * 64 + lane) * 8; const f32x4 w0 = *(const LAS f32x4*)tp, w1 = *(const LAS f32x4*)(tp + 4);
#pragma unroll
                    for (int p = 0; p < 2; ++p) { const float hv = hh[p][i];
                        g[p][0] += hv * w0[0]; g[p][1] += hv * w0[1]; g[p][2] += hv * w0[2]; g[p][3] += hv * w0[3]; g[p][4] += hv * w1[0]; g[p][5] += hv * w1[1]; g[p][6] += hv * w1[2]; g[p][7] += hv * w1[3]; } }
                asm volatile("" ::: "memory");
            }
#pragma unroll
            for (int p = 0; p < 2; ++p) { const size_t row = (size_t)tile * 64 + wave + 8 * (2 * gq + p); float mine = 0.f;
#pragma unroll
                for (int q = 0; q < 8; ++q) { const float sq = wave_sum(g[p][q]); mine = (lane == q) ? sq : mine; }
                if (lane < 8) { const float vv = mine + bifv; gates[row * 8 + lane] = (lane < 4) ? vv : logsigmoidf_(vv); } }
        }
    }
}

DEV void p1_h1_mfma(const Args& a, LAS unsigned char* lds, int bid, int G, const XDeal&) {
    int tid = threadIdx.x; asm volatile("" : "+v"(tid));
    const int lane = tid & 63, wave = __builtin_amdgcn_readfirstlane(tid >> 6), l15 = lane & 15, q4 = lane >> 4;
    if (tid == 0) {
        unsigned* mc = (unsigned*)(a.ws + WS_CTL) + CW_MODCNT; unsigned sp = 0;
        while (__hip_atomic_load(mc, __ATOMIC_RELAXED, __HIP_MEMORY_SCOPE_AGENT) < 192u) { __builtin_amdgcn_s_sleep(2); if (++sp > (1u << 22)) break; }
        __builtin_amdgcn_fence(__ATOMIC_ACQUIRE, "agent"); asm volatile("s_waitcnt vmcnt(0)" ::: "memory"); }
    __syncthreads();
    const float* x = a.in[0]; const float* g1 = a.in[4]; const float* b_if = a.in[6];
    const float* mod = (const float*)(a.ws + WS_MOD); bf16* h1 = (bf16*)(a.ws + WS_H); float* gates = (float*)(a.ws + WS_GATES);
    LAS float* PL = (LAS float*)lds;
    LAS float* SS = (LAS float*)(lds + 32768);
    LAS float* RS = (LAS float*)(lds + 34816);
    LAS float* GB = (LAS float*)(lds + 35072);
    LAS float* WF = (LAS float*)(lds + 36864);
    { const float* wif = (const float*)(a.ws + WS_WIF); for (int i = tid; i < 2048; i += NTHREADS) *(LAS f32x4*)(WF + 4 * i) = *(const f32x4*)(wif + 4 * i); }
    {
        const float* g2 = a.in[17]; const float* w_rg = a.in[18]; const float* b_rg = a.in[19]; const float* w_re = a.in[20]; const float* b_re = a.in[21];
        float* rbias = (float*)(a.ws + WS_RBIAS); v4u* rw = (v4u*)(a.ws + WS_RW);
        const int gw = bid * NWAVES + wave, NGW = G * NWAVES;
        for (int it = gw; it < 8 * 36; it += NGW) { const int b = it / 36, n = it % 36; float sacc = 0.f;
#pragma unroll
            for (int i = 0; i < 16; ++i) { const int k = lane + 64 * i; const float w = (n < 4) ? w_rg[k * 4 + n] : w_re[k * 32 + n - 4]; sacc += mod[b * 6144 + 3072 + k] * w; }
            sacc = wave_sum(sacc);
            if (lane == 0) rbias[b * 48 + n] = sacc + ((n < 4) ? b_rg[n] : b_re[n - 4]); }
        for (int it = gw; it < 8 * 8 * 4 * 3; it += NGW) {
            const int nt = it % 3, kk = (it / 3) & 3, w8 = (it / 12) & 7, b = it / 96;
            const int n = 16 * nt + (lane & 15), k0 = 128 * w8 + 32 * kk + 8 * (lane >> 4);
            f32x4 w0, w1;
#pragma unroll
            for (int j = 0; j < 8; ++j) { const int k = k0 + j; const float* wp = (n < 4) ? (w_rg + k * 4 + n) : (w_re + k * 32 + ((n < 36) ? n - 4 : 0));
                float w = *wp; w = (n < 36) ? w : 0.f;
                w *= g2[k] * (1.f + mod[b * 6144 + 4096 + k]); if (j < 4) w0[j] = w; else w1[j - 4] = w; }
            bf16x8 hi, lo; split8(w0, w1, hi, lo);
            rw[((size_t)it * 2) * 64 + lane] = __builtin_bit_cast(v4u, hi); rw[((size_t)it * 2 + 1) * 64 + lane] = __builtin_bit_cast(v4u, lo);
        }
    }
    for (int tile = bid; tile < T / 64; tile += G) {
        const int b = tile / 32, ncol = (l15 < 8) ? l15 : 0;
        __syncthreads();
        {
            float sacc = 0.f;
#pragma unroll
            for (int i = 0; i < 16; ++i) { const int k = lane + 64 * i; sacc += mod[b * 6144 + k] * WF[k * 8 + wave]; }
            sacc = wave_sum(sacc);
            if (lane == 0) GB[wave] = sacc + b_if[wave];
        }
        f32x4 acc[4]; float ss[4];
#pragma unroll
        for (int rt = 0; rt < 4; ++rt) { ss[rt] = 0.f; acc[rt] = (f32x4){0.f, 0.f, 0.f, 0.f}; }
#pragma unroll
        for (int kk = 0; kk < 4; ++kk) {
            const int k0 = 128 * wave + 32 * kk + 8 * q4;
            bf16x8 bhi, blo;
            { const f32x4 ga = *(const f32x4*)(g1 + k0), gb = *(const f32x4*)(g1 + k0 + 4), sa = *(const f32x4*)(mod + b * 6144 + 1024 + k0), sb = *(const f32x4*)(mod + b * 6144 + 1024 + k0 + 4);
                f32x4 w0, w1;
#pragma unroll
                for (int jj = 0; jj < 4; ++jj) { float wa = WF[(k0 + jj) * 8 + ncol], wb = WF[(k0 + 4 + jj) * 8 + ncol];
                    wa = (l15 < 8) ? wa : 0.f; wb = (l15 < 8) ? wb : 0.f; w0[jj] = wa * ga[jj] * (1.f + sa[jj]); w1[jj] = wb * gb[jj] * (1.f + sb[jj]); }
                split8(w0, w1, bhi, blo); }
#pragma unroll
            for (int rt = 0; rt < 4; ++rt) {
                const float* xp = x + ((size_t)tile * 64 + 16 * rt + l15) * 1024 + k0;
                const f32x4 xa = *(const f32x4*)xp, xb = *(const f32x4*)(xp + 4);
                ss[rt] += (xa[0] * xa[0] + xa[1] * xa[1]) + (xa[2] * xa[2] + xa[3] * xa[3]) + (xb[0] * xb[0] + xb[1] * xb[1]) + (xb[2] * xb[2] + xb[3] * xb[3]);
                bf16x8 ahi, alo; split8(xa, xb, ahi, alo);
                acc[rt] = mma16(ahi, bhi, acc[rt]); acc[rt] = mma16(alo, bhi, acc[rt]); acc[rt] = mma16(ahi, blo, acc[rt]);
            }
        }
#pragma unroll
        for (int rt = 0; rt < 4; ++rt) {
            float sv = ss[rt]; sv += __shfl_xor(sv, 16); sv += __shfl_xor(sv, 32);
            if (q4 == 0) SS[wave * 64 + 16 * rt + l15] = sv;
#pragma unroll
            for (int r = 0; r < 4; ++r) PL[(wave * 64 + 16 * rt + 4 * q4 + r) * 16 + l15] = acc[rt][r];
        }
        __syncthreads();
        {
            const int row = tid >> 3, n = tid & 7; float ssum = 0.f, sg = 0.f;
#pragma unroll
            for (int w = 0; w < 8; ++w) { ssum += SS[w * 64 + row]; sg += PL[(w * 64 + row) * 16 + n]; }
            const float rstd = rsqrtf(ssum * (1.f / 1024.f) + RMS_EPS);
            if (n == 0) RS[row] = rstd;
            const float vv = rstd * sg + GB[n];
            gates[((size_t)tile * 64 + row) * 8 + n] = (n < 4) ? vv : logsigmoidf_(vv);
        }
        __syncthreads();
        {
            float sc[4][4], sh[4][4];
#pragma unroll
            for (int j = 0; j < 4; ++j) { const int k = 256 * j + 4 * lane; const f32x4 gv = *(const f32x4*)(g1 + k), sv = *(const f32x4*)(mod + b * 6144 + 1024 + k), hv = *(const f32x4*)(mod + b * 6144 + k);
#pragma unroll
                for (int i = 0; i < 4; ++i) { sc[j][i] = gv[i] * (1.f + sv[i]); sh[j][i] = hv[i]; } }
            f32x4 nx[4][4];
#pragma unroll
            for (int p = 0; p < 4; ++p)
#pragma unroll
                for (int j = 0; j < 4; ++j) nx[p][j] = *(const f32x4*)(x + ((size_t)tile * 64 + wave + 8 * p) * 1024 + 256 * j + 4 * lane);
#pragma unroll
            for (int r8 = 0; r8 < 8; ++r8) {
                const int r = wave + 8 * r8; const size_t row = (size_t)tile * 64 + r;
                f32x4 v[4];
#pragma unroll
                for (int j = 0; j < 4; ++j) v[j] = nx[r8 & 3][j];
                if (r8 + 4 < 8) {
#pragma unroll
                    for (int j = 0; j < 4; ++j) nx[r8 & 3][j] = *(const f32x4*)(x + (row + 32) * 1024 + 256 * j + 4 * lane); }
                asm volatile("" ::: "memory");
                const float rstd = RS[r];
#pragma unroll
                for (int j = 0; j < 4; ++j) { v2u o; o.x = pk2(v[j][0] * rstd * sc[j][0] + sh[j][0], v[j][1] * rstd * sc[j][1] + sh[j][1]); o.y = pk2(v[j][2] * rstd * sc[j][2] + sh[j][2], v[j][3] * rstd * sc[j][3] + sh[j][3]);
                    *(v2u*)(h1 + row * 1024 + 256 * j + 4 * lane) = o; }
            }
        }
    }
    __syncthreads();
}

DEV void p3_conva(const Args& a, LAS unsigned char* lds, const XDeal& X) {
    int tid = threadIdx.x; asm volatile("" : "+v"(tid));
    const int lane = tid & 63, wave = __builtin_amdgcn_readfirstlane(tid >> 6), sub = wave & 3, gsel = wave >> 2;
    const bf16* zu = (const bf16*)(a.ws + WS_ZU); bf16* uahm = (bf16*)(a.ws + WS_UAHM);
    const float* cw = a.in[7]; const float* cb = a.in[8]; const float* lg = a.in[9]; const float* lb = a.in[10];
    LAS float* red = (LAS float*)(lds + LDS_TAB);
    const int c0 = 128 * sub + 2 * lane;
    float w0[31], w1[31];
#pragma unroll
    for (int k = 0; k < 31; ++k) { w0[k] = cw[k * 512 + c0]; w1[k] = cw[k * 512 + c0 + 1]; }
    const float bias0 = cb[c0], bias1 = cb[c0 + 1], lg0 = lg[c0], lg1 = lg[c0 + 1], lb0 = lb[c0], lb1 = lb[c0 + 1];
    for (int ii = 0;; ++ii) {
        const int it = X.item(ii, SEQ / 32); if (it < 0) break;
        const int grp = it * 2 + gsel, tbase = grp * 16, s0 = tbase & (SEQ - 1);
        float acc0[16], acc1[16];
#pragma unroll
        for (int i = 0; i < 16; ++i) { acc0[i] = bias0; acc1[i] = bias1; }
#pragma unroll
        for (int r = 0; r < 46; ++r) {
            const int sp = s0 - 30 + r; const int src = tbase - 30 + r + ((sp < 0) ? -sp : 0); const float msk = (sp < 0) ? 0.f : 1.f;
            const unsigned wv = *(const unsigned*)(zu + (size_t)src * 512 + c0);
            const float u0 = bflo(wv) * msk, u1 = bfhi(wv) * msk;
#pragma unroll
            for (int i = 0; i < 16; ++i) { const int k = r - i; if (k >= 0 && k <= 30) { acc0[i] += w0[k] * u0; acc1[i] += w1[k] * u1; } }
        }
        float mean[16];
#pragma unroll
        for (int i = 0; i < 16; ++i) { const float s = wave_sum(acc0[i] + acc1[i]); if (lane == 0) red[(gsel * 4 + sub) * 16 + i] = s; }
        __syncthreads();
#pragma unroll
        for (int i = 0; i < 16; ++i) mean[i] = ((red[(gsel * 4 + 0) * 16 + i] + red[(gsel * 4 + 1) * 16 + i]) + (red[(gsel * 4 + 2) * 16 + i] + red[(gsel * 4 + 3) * 16 + i])) * (1.f / 512.f);
        __syncthreads();
#pragma unroll
        for (int i = 0; i < 16; ++i) { const float d0 = acc0[i] - mean[i], d1 = acc1[i] - mean[i]; const float s = wave_sum(d0 * d0 + d1 * d1); if (lane == 0) red[(gsel * 4 + sub) * 16 + i] = s; }
        __syncthreads();
#pragma unroll
        for (int i = 0; i < 16; ++i) {
            const float var = ((red[(gsel * 4 + 0) * 16 + i] + red[(gsel * 4 + 1) * 16 + i]) + (red[(gsel * 4 + 2) * 16 + i] + red[(gsel * 4 + 3) * 16 + i])) * (1.f / 512.f);
            const float rstd = rsqrtf(var + LN_EPS);
            const float y0 = (acc0[i] - mean[i]) * rstd * lg0 + lb0, y1 = (acc1[i] - mean[i]) * rstd * lg1 + lb1;
            *(unsigned*)(uahm + (size_t)(tbase + i) * 1024 + c0) = pk2(siluf_(y0), siluf_(y1));
        }
        __syncthreads();
    }
}

constexpr int ML_QS = 0, ML_KS = 17408, ML_KWT = 34816, ML_VT = 53248, ML_PS = 73984, ML_CT = 83200, ML_GT = 122368, ML_CW = 123648, ML_DEN = 128768, ML_PART = 129024, ML_VS = 130048;
#define LDS_SYNC() do { asm volatile("s_waitcnt lgkmcnt(0)" ::: "memory"); __builtin_amdgcn_s_barrier(); asm volatile("" ::: "memory"); } while (0)
template <bool OUT>
DEV void mlstm_unit(const Args& a, LAS unsigned char* lds, int unit) {
    int tid = threadIdx.x; asm volatile("" : "+v"(tid));
    const int lane = tid & 63, wave = __builtin_amdgcn_readfirstlane(tid >> 6), l15 = lane & 15, q4 = lane >> 4;
    const int j = unit & 7, bh = unit >> 3, h = bh & 3, b = bh >> 2, t0 = b * SEQ + 256 * j;
    const bf16* zq = (const bf16*)(a.ws + WS_ZQ); const bf16* zk = (const bf16*)(a.ws + WS_ZK); const bf16* zv = (const bf16*)(a.ws + WS_ZV); const bf16* zo = (const bf16*)(a.ws + WS_ZO);
    const float* gates = (const float*)(a.ws + WS_GATES); v2u* stateh = (v2u*)(a.ws + WS_STATE); float* stsc = (float*)(a.ws + WS_STSC);
    bf16* uahm = (bf16*)(a.ws + WS_UAHM); const float* qkw = a.in[12]; const float* qkb = a.in[13]; const float* mng = a.in[14];
    bf16* kcg = (bf16*)(a.ws + WS_H);
    LAS bf16* QS = (LAS bf16*)(lds + ML_QS); LAS bf16* KS = (LAS bf16*)(lds + ML_KS); LAS bf16* KWT = (LAS bf16*)(lds + ML_KWT); LAS bf16* VT = (LAS bf16*)(lds + ML_VT);
    LAS bf16* PS = (LAS bf16*)(lds + ML_PS); LAS bf16* CT = (LAS bf16*)(lds + ML_CT); LAS bf16* VS = (LAS bf16*)(lds + ML_VS);
    LAS float* GTwk = (LAS float*)(lds + ML_GT); LAS float* GTsi = GTwk + 64; LAS float* GTlb = GTwk + 128; LAS float* GTg = GTwk + 192; LAS float* GTM = GTwk + 256;
    LAS float* CW = (LAS float*)(lds + ML_CW); LAS float* DEN = (LAS float*)(lds + ML_DEN); LAS float* PART = (LAS float*)(lds + ML_PART);
    __syncthreads();
    for (int i = tid; i < 1280; i += NTHREADS) {
        const float* p = (i < 512) ? (qkw + (i >> 7) * 1024 + h * 128 + (i & 127)) : (i < 1024) ? (qkw + ((i - 512) >> 7) * 1024 + 512 + h * 128 + (i & 127))
                       : (i < 1152) ? (qkb + h * 128 + (i - 1024)) : (qkb + 512 + h * 128 + (i - 1152));
        CW[i] = *p; }
    for (int i = tid; i < 16 * 72; i += NTHREADS) VT[128 * 72 + i] = (i < 64) ? (bf16)0x3F80 : (bf16)0;
    LAS float* MNG = (LAS float*)(lds + LDS_MISC + 2048);
    if (OUT && tid < 128) MNG[tid] = mng[h * 128 + tid];
    f32x4 accC[9];
#pragma unroll
    for (int i = 0; i < 9; ++i) accC[i] = (f32x4){0.f, 0.f, 0.f, 0.f};
    float mc = OUT ? 0.f : -1e30f, Btot = 0.f;
    const int ncc = (OUT && (a.flags & 4096)) ? 1 : 4; const bool skipAB = OUT && (a.flags & 16384), skipQ = OUT && (a.flags & 32768);
    float li_n = gates[(size_t)(t0 + lane) * 8 + h], lf_n = gates[(size_t)(t0 + lane) * 8 + 4 + h];
    const int cg = tid & 15, rp = tid >> 4, s0 = 2 * rp;
    v4u kraw[5];
#define ML_LOAD(CC) do { const int tcl_ = t0 + 64 * (CC); \
        _Pragma("unroll") for (int m = 0; m < 5; ++m) { const int spos = 256 * j + 64 * (CC) + s0 - 3 + m; const int src = (spos >= 0) ? (tcl_ + s0 - 3 + m) : tcl_; \
            kraw[m] = *(const v4u*)(zk + (size_t)src * 512 + h * 128 + cg * 8); } } while (0)
    if (!OUT) ML_LOAD(0);
    if (OUT) {
        float wgt[7];
        {
            const int base = unit - j; float mi[7], Bi[7];
#pragma unroll
            for (int i = 0; i < 7; ++i) { const int u2 = base + ((i < j) ? i : 0); mi[i] = stsc[u2 * 4]; Bi[i] = stsc[u2 * 4 + 1]; }
#pragma unroll
            for (int i = 0; i < 7; ++i) if (i < j) mc = fmaxf(Bi[i] + mc, mi[i]);
            float suf = 0.f;
#pragma unroll
            for (int i = 6; i >= 0; --i) { wgt[i] = (i < j) ? __expf(mi[i] + suf - mc) : 0.f; if (i < j) suf += Bi[i]; }
        }
        const v4u* state4 = (const v4u*)(a.ws + WS_STATE);
#pragma unroll
        for (int i2 = 0; i2 < 5; ++i2) {
            v4u ld[7];
#pragma unroll
            for (int i = 0; i < 7; ++i) { ld[i] = (v4u){0u, 0u, 0u, 0u}; if (i < j) ld[i] = state4[((size_t)(unit - j + i) * 5 + i2) * 512 + tid]; }
#pragma unroll
            for (int i = 0; i < 7; ++i) { const f32x4 v0 = (f32x4){bflo(ld[i].x), bfhi(ld[i].x), bflo(ld[i].y), bfhi(ld[i].y)}; accC[2 * i2] = accC[2 * i2] + v0 * wgt[i];
                if (i2 < 4) { const f32x4 v1 = (f32x4){bflo(ld[i].z), bfhi(ld[i].z), bflo(ld[i].w), bfhi(ld[i].w)}; accC[2 * i2 + 1] = accC[2 * i2 + 1] + v1 * wgt[i]; } }
        }
#pragma unroll
        for (int ii = 0; ii < 9; ++ii)
#pragma unroll
            for (int r = 0; r < 4; ++r) CT[(16 * ii + 4 * q4 + r) * 136 + 16 * wave + l15] = f2bf(accC[ii][r]);
    }
    LDS_SYNC();
    for (int cc = 0; cc < ncc; ++cc) {
        const int tc = t0 + 64 * cc; const bool lastc = false;
        const float li = li_n, lf = lf_n;
        if (cc < 3) { li_n = gates[(size_t)(tc + 64 + lane) * 8 + h]; lf_n = gates[(size_t)(tc + 64 + lane) * 8 + 4 + h]; }
        const float bc = wave_scan_add(lf, lane);
        const float g = li - bc;
        const float cm = wave_scan_max(g, lane);
        const float M = fmaxf(mc, cm);
        const float M63 = rdlane(M, 63), blast = rdlane(bc, 63);
        const float wkv = __expf(g - M63), sc = __expf(mc - M63), mnew = blast + M63;
        if (wave == 0) { GTwk[lane] = wkv; GTsi[lane] = __expf(mc - M); GTlb[lane] = __expf(-(bc + M)); GTg[lane] = g; GTM[lane] = M; }
        {
#define ML_CONV(RAW, WOFF, BOFF, DST, SCALE, GDST) do { float ac[2][8]; \
            _Pragma("unroll") for (int e = 0; e < 8; ++e) { ac[0][e] = ac[1][e] = CW[(BOFF) + cg * 8 + e]; } \
            _Pragma("unroll") for (int m = 0; m < 5; ++m) { v4u rw_ = RAW[m]; if (256 * j + 64 * cc + s0 - 3 + m < 0) rw_ = (v4u){0u, 0u, 0u, 0u};     \
                const float xv[8] = {bflo(rw_.x), bfhi(rw_.x), bflo(rw_.y), bfhi(rw_.y), bflo(rw_.z), bfhi(rw_.z), bflo(rw_.w), bfhi(rw_.w)}; \
                _Pragma("unroll") for (int rr = 0; rr < 2; ++rr) { const int tap = m - rr; if (tap >= 0 && tap < 4) { \
                    _Pragma("unroll") for (int e = 0; e < 8; ++e) ac[rr][e] += CW[(WOFF) + tap * 128 + cg * 8 + e] * xv[e]; } } } \
            _Pragma("unroll") for (int rr = 0; rr < 2; ++rr) { v4u o; \
                o.x = pk2(siluf_(ac[rr][0]) * (SCALE), siluf_(ac[rr][1]) * (SCALE)); o.y = pk2(siluf_(ac[rr][2]) * (SCALE), siluf_(ac[rr][3]) * (SCALE)); \
                o.z = pk2(siluf_(ac[rr][4]) * (SCALE), siluf_(ac[rr][5]) * (SCALE)); o.w = pk2(siluf_(ac[rr][6]) * (SCALE), siluf_(ac[rr][7]) * (SCALE)); \
                *(LAS v4u*)((DST) + (s0 + rr) * 136 + cg * 8) = o; \
                if ((GDST) != nullptr) *(v4u*)((GDST) + (size_t)(tc + s0 + rr) * 1024 + h * 128 + cg * 8) = o; } } while (0)
            v4u qraw[5], vraw[2], kcv[2];
            if (OUT) {
#pragma unroll
                for (int rr = 0; rr < 2; ++rr) kcv[rr] = *(const v4u*)(kcg + (size_t)(tc + s0 + rr) * 1024 + h * 128 + cg * 8); }
#pragma unroll
            for (int rr = 0; rr < 2; ++rr) vraw[rr] = *(const v4u*)(zv + (size_t)(tc + s0 + rr) * 512 + h * 128 + cg * 8);
            if (OUT && !skipQ) {
#pragma unroll
                for (int m = 0; m < 5; ++m) { const int spos = 256 * j + 64 * cc + s0 - 3 + m; const int src = (spos >= 0) ? (tc + s0 - 3 + m) : tc; qraw[m] = *(const v4u*)(zq + (size_t)src * 512 + h * 128 + cg * 8); } }
            if (!OUT) ML_CONV(kraw, 512, 1152, KS, 1.f, kcg);
            else {
#pragma unroll
                for (int rr = 0; rr < 2; ++rr) *(LAS v4u*)(KS + (s0 + rr) * 136 + cg * 8) = kcv[rr]; }
            asm volatile("" ::: "memory");
            if (OUT && !skipQ) ML_CONV(qraw, 0, 1024, QS, 0.08838834764831845f, (bf16*)nullptr);
#undef ML_CONV
#pragma unroll
            for (int rr = 0; rr < 2; ++rr) *(LAS v4u*)(VS + (s0 + rr) * 136 + cg * 8) = vraw[rr];
            if (!OUT && cc + 1 < ncc) ML_LOAD(cc + 1);
        }
        LDS_SYNC();
        if (OUT && !skipAB) {
            const int tt = wave >> 1;
#pragma unroll
            for (int si = 0; si < 2; ++si) {
                const int st = 2 * (wave & 1) + si;
                f32x4 sacc = (f32x4){0.f, 0.f, 0.f, 0.f};
                if (st <= tt) {
#pragma unroll
                    for (int kk = 0; kk < 4; ++kk) sacc = mma16(*(const LAS bf16x8*)(QS + (16 * tt + l15) * 136 + 32 * kk + 8 * q4), *(const LAS bf16x8*)(KS + (16 * st + l15) * 136 + 32 * kk + 8 * q4), sacc);
                }
                const int sl = 16 * st + l15; const float gs = GTg[sl];
#pragma unroll
                for (int r = 0; r < 4; ++r) { const int tl = 16 * tt + 4 * q4 + r; const float w = (sl <= tl) ? __expf(gs - GTM[tl]) : 0.f; PS[tl * 72 + sl] = f2bf(sacc[r] * w); }
            }
        }
        {
            const int d = tid & 127, sg = tid >> 7;
            v4u o0, o1;
            if (!lastc) { float kv[16];
#pragma unroll
                for (int i = 0; i < 16; ++i) kv[i] = bf2f(KS[(16 * sg + i) * 136 + d]) * GTwk[16 * sg + i];
                o0.x = pk2(kv[0], kv[1]); o0.y = pk2(kv[2], kv[3]); o0.z = pk2(kv[4], kv[5]); o0.w = pk2(kv[6], kv[7]);
                o1.x = pk2(kv[8], kv[9]); o1.y = pk2(kv[10], kv[11]); o1.z = pk2(kv[12], kv[13]); o1.w = pk2(kv[14], kv[15]);
                *(LAS v4u*)(KWT + d * 72 + 16 * sg) = o0; *(LAS v4u*)(KWT + d * 72 + 16 * sg + 8) = o1; }
            unsigned vw[8];
#pragma unroll
            for (int i = 0; i < 8; ++i) vw[i] = (unsigned)VS[(16 * sg + 2 * i) * 136 + d] | ((unsigned)VS[(16 * sg + 2 * i + 1) * 136 + d] << 16);
            o0.x = vw[0]; o0.y = vw[1]; o0.z = vw[2]; o0.w = vw[3]; o1.x = vw[4]; o1.y = vw[5]; o1.z = vw[6]; o1.w = vw[7];
            *(LAS v4u*)(VT + d * 72 + 16 * sg) = o0; *(LAS v4u*)(VT + d * 72 + 16 * sg + 8) = o1;
        }
        LDS_SYNC();
        f32x4 res[5];
        if (OUT && !skipAB) {
            const int tt = wave >> 1, dv0 = 4 * (wave & 1);
            bf16x8 pa[2], qa[4];
#pragma unroll
            for (int kk = 0; kk < 2; ++kk) pa[kk] = *(const LAS bf16x8*)(PS + (16 * tt + l15) * 72 + 32 * kk + 8 * q4);
#pragma unroll
            for (int kk = 0; kk < 4; ++kk) qa[kk] = *(const LAS bf16x8*)(QS + (16 * tt + l15) * 136 + 32 * kk + 8 * q4);
            float si[4];
#pragma unroll
            for (int r = 0; r < 4; ++r) si[r] = GTsi[16 * tt + 4 * q4 + r];
#pragma unroll
            for (int i = 0; i < 5; ++i) {
                const int dvt = (i < 4) ? (dv0 + i) : 8;
                if (i < 4 || (wave & 1) == 0) {
                    f32x4 a1 = (f32x4){0.f, 0.f, 0.f, 0.f}, a2 = (f32x4){0.f, 0.f, 0.f, 0.f};
#pragma unroll
                    for (int kk = 0; kk < 2; ++kk) a1 = mma16(pa[kk], *(const LAS bf16x8*)(VT + (16 * dvt + l15) * 72 + 32 * kk + 8 * q4), a1);
#pragma unroll
                    for (int kk = 0; kk < 4; ++kk) a2 = mma16(qa[kk], *(const LAS bf16x8*)(CT + (16 * dvt + l15) * 136 + 32 * kk + 8 * q4), a2);
#pragma unroll
                    for (int r = 0; r < 4; ++r) res[i][r] = a1[r] + si[r] * a2[r];
                } else res[i] = (f32x4){0.f, 0.f, 0.f, 0.f};
            }
            if ((wave & 1) == 0 && l15 == 0) {
#pragma unroll
                for (int r = 0; r < 4; ++r) DEN[16 * tt + 4 * q4 + r] = res[4][r];
            }
        }
        asm volatile("" ::: "memory");
        if (!lastc) {
            bf16x8 kb[2];
#pragma unroll
            for (int kk = 0; kk < 2; ++kk) kb[kk] = *(const LAS bf16x8*)(KWT + (16 * wave + l15) * 72 + 32 * kk + 8 * q4);
#pragma unroll
            for (int i = 0; i < 9; ++i) { accC[i] = accC[i] * sc;
#pragma unroll
                for (int kk = 0; kk < 2; ++kk) accC[i] = mma16(*(const LAS bf16x8*)(VT + (16 * i + l15) * 72 + 32 * kk + 8 * q4), kb[kk], accC[i]); }
        }
        LDS_SYNC();
        if (OUT && !skipAB) {
            const int tt = wave >> 1;
            float den[4], lbv[4];
#pragma unroll
            for (int r = 0; r < 4; ++r) { den[r] = DEN[16 * tt + 4 * q4 + r]; lbv[r] = GTlb[16 * tt + 4 * q4 + r]; }
#pragma unroll
            for (int r = 0; r < 4; ++r) { const float inv = 1.f / fmaxf(fabsf(den[r]), lbv[r]); float s1 = 0.f, s2 = 0.f;
#pragma unroll
                for (int i = 0; i < 4; ++i) { res[i][r] *= inv; s1 += res[i][r]; s2 += res[i][r] * res[i][r]; }
                s1 = row16_sum(s1); s2 = row16_sum(s2);
                if (l15 == 0) { PART[((16 * tt + 4 * q4 + r) * 2 + (wave & 1)) * 2] = s1; PART[((16 * tt + 4 * q4 + r) * 2 + (wave & 1)) * 2 + 1] = s2; } }
            if (!lastc) {
#pragma unroll
                for (int ii = 0; ii < 9; ++ii)
#pragma unroll
                    for (int r = 0; r < 4; ++r) CT[(16 * ii + 4 * q4 + r) * 136 + 16 * wave + l15] = f2bf(accC[ii][r]); }
            LDS_SYNC();
            const int os = tid >> 3, ocg = tid & 7; const size_t orow = (size_t)(tc + os);
            const v4u zo0 = *(const v4u*)(zo + orow * 512 + h * 128 + 16 * ocg), zo1 = *(const v4u*)(zo + orow * 512 + h * 128 + 16 * ocg + 8);
            LAS float* YS = (LAS float*)(lds + ML_KWT);
#pragma unroll
            for (int r = 0; r < 4; ++r) { const int tl = 16 * tt + 4 * q4 + r;
                const float s1 = PART[(tl * 2) * 2] + PART[(tl * 2 + 1) * 2], s2 = PART[(tl * 2) * 2 + 1] + PART[(tl * 2 + 1) * 2 + 1];
                const float mean = s1 * (1.f / 128.f), var = fmaxf(s2 * (1.f / 128.f) - mean * mean, 0.f), rstd = rsqrtf(var + LN_EPS);
#pragma unroll
                for (int i = 0; i < 4; ++i) YS[tl * 132 + 16 * (4 * (wave & 1) + i) + l15] = (res[i][r] - mean) * rstd; }
            LDS_SYNC();
            {
                f32x4 yv[4];
#pragma unroll
                for (int q = 0; q < 4; ++q) yv[q] = *(const LAS f32x4*)(YS + os * 132 + 16 * ocg + 4 * q);
                f32x4 g0, g1, g2, g3; unpack8(zo0, g0, g1); unpack8(zo1, g2, g3);
                { const LAS float* mp = MNG + 16 * ocg; g0 = g0 * *(const LAS f32x4*)mp; g1 = g1 * *(const LAS f32x4*)(mp + 4); g2 = g2 * *(const LAS f32x4*)(mp + 8); g3 = g3 * *(const LAS f32x4*)(mp + 12); }
                *(v4u*)(uahm + orow * 1024 + 512 + h * 128 + 16 * ocg) = pack8(yv[0] * g0, yv[1] * g1);
                *(v4u*)(uahm + orow * 1024 + 512 + h * 128 + 16 * ocg + 8) = pack8(yv[2] * g2, yv[3] * g3);
            }
        }
        mc = mnew; Btot += blast;
    }
    if (!OUT) {
#pragma unroll
        for (int i2 = 0; i2 < 5; ++i2) { v4u pk; pk.x = pk2(accC[2 * i2][0], accC[2 * i2][1]); pk.y = pk2(accC[2 * i2][2], accC[2 * i2][3]);
            if (i2 < 4) { pk.z = pk2(accC[2 * i2 + 1][0], accC[2 * i2 + 1][1]); pk.w = pk2(accC[2 * i2 + 1][2], accC[2 * i2 + 1][3]); } else { pk.z = 0u; pk.w = 0u; }
            ((v4u*)(a.ws + WS_STATE))[((size_t)unit * 5 + i2) * 512 + tid] = pk; }
        if (tid == 0) { stsc[unit * 4] = mc; stsc[unit * 4 + 1] = Btot; }
    }
#undef ML_LOAD
}

DEV void p8_route(const Args& a, LAS unsigned char* lds, const XDeal& X, int fused) {
    int tid = threadIdx.x; asm volatile("" : "+v"(tid));
    const int lane = tid & 63, wave = __builtin_amdgcn_readfirstlane(tid >> 6), l15 = lane & 15, q4 = lane >> 4;
    const bf16* x1 = (const bf16*)a.out; const float* g2 = a.in[17]; const float* w_rg = a.in[18]; const float* w_re = a.in[20];
    const float* mod = (const float*)(a.ws + WS_MOD); const float* rbias = (const float*)(a.ws + WS_RBIAS); const v4u* rw = (const v4u*)(a.ws + WS_RW); bf16* h2 = (bf16*)(a.ws + WS_H);
    int* toke = (int*)(a.ws + WS_TOKE); float* tokw = (float*)(a.ws + WS_TOKW);
    int* listt = (int*)(a.ws + WS_LISTT); float* listw = (float*)(a.ws + WS_LISTW); unsigned* cnt = (unsigned*)(a.ws + WS_CTL) + CW_CNT;
    LAS float* PL = (LAS float*)lds;
    LAS float* SS = (LAS float*)(lds + 98304);
    LAS float* LG = (LAS float*)(lds + 100352);
    LAS float* RS = (LAS float*)(lds + 109568);
    LAS unsigned* lcnt = (LAS unsigned*)(lds + LDS_MISC + 256);
    LAS unsigned* lbase = lcnt + 32;
    LAS unsigned* lent = lcnt + 64;
    LAS float* lwt = (LAS float*)(lcnt + 192);
    for (int ti = 0;; ++ti) {
        const int tile = X.item(ti, SEQ / 64); if (tile < 0) break;
        const int b = tile / 32;
        __syncthreads();
        if (tid < 32) lcnt[tid] = 0u;
        if (!fused) {
        f32x4 acc[4][3]; float ss[4];
#pragma unroll
        for (int rt = 0; rt < 4; ++rt) { ss[rt] = 0.f;
#pragma unroll
            for (int nt = 0; nt < 3; ++nt) acc[rt][nt] = (f32x4){0.f, 0.f, 0.f, 0.f}; }
#pragma unroll 1
        for (int kk = 0; kk < 4; ++kk) {
            const int k0 = 128 * wave + 32 * kk + 8 * q4;
            bf16x8 bhi[3], blo[3];
#pragma unroll
            for (int nt = 0; nt < 3; ++nt) { const size_t it = ((size_t)(b * 8 + wave) * 4 + kk) * 3 + nt;
                bhi[nt] = __builtin_bit_cast(bf16x8, rw[(it * 2) * 64 + lane]); blo[nt] = __builtin_bit_cast(bf16x8, rw[(it * 2 + 1) * 64 + lane]); }
#pragma unroll
            for (int rt = 0; rt < 4; ++rt) {
                const bf16* xp = x1 + ((size_t)tile * 64 + 16 * rt + l15) * 2048 + k0;
                f32x4 xa, xb; unpack8(*(const v4u*)xp, xa, xb);
                ss[rt] += (xa[0] * xa[0] + xa[1] * xa[1]) + (xa[2] * xa[2] + xa[3] * xa[3]) + (xb[0] * xb[0] + xb[1] * xb[1]) + (xb[2] * xb[2] + xb[3] * xb[3]);
                bf16x8 ahi, alo; split8(xa, xb, ahi, alo);
#pragma unroll
                for (int nt = 0; nt < 3; ++nt) { acc[rt][nt] = mma16(ahi, bhi[nt], acc[rt][nt]); acc[rt][nt] = mma16(alo, bhi[nt], acc[rt][nt]); acc[rt][nt] = mma16(ahi, blo[nt], acc[rt][nt]); }
            }
        }
#pragma unroll
        for (int rt = 0; rt < 4; ++rt) {
            float sv = ss[rt]; sv += __shfl_xor(sv, 16); sv += __shfl_xor(sv, 32);
            if (q4 == 0) SS[wave * 64 + 16 * rt + l15] = sv;
#pragma unroll
            for (int nt = 0; nt < 3; ++nt)
#pragma unroll
                for (int r = 0; r < 4; ++r) PL[(wave * 64 + 16 * rt + 4 * q4 + r) * 48 + 16 * nt + l15] = acc[rt][nt][r];
        }
        }
        __syncthreads();
        {
            const int row = tid >> 3, part = tid & 7;
            if (!fused) {
                float ssum = 0.f;
#pragma unroll
                for (int w = 0; w < 8; ++w) ssum += SS[w * 64 + row];
                const float rstd = rsqrtf(ssum * (1.f / 1024.f) + RMS_EPS);
                if (part == 0) RS[row] = rstd;
#pragma unroll
                for (int i = 0; i < 5; ++i) { const int n = part + 8 * i; if (n < 36) { float s = 0.f;
#pragma unroll
                        for (int w = 0; w < 8; ++w) s += PL[(w * 64 + row) * 48 + n];
                        LG[row * 36 + n] = rstd * s + rbias[b * 48 + n]; } }
            } else {
                const int grow = tile * 64 + row;
                float pv[4][6];
#pragma unroll
                for (int pn = 0; pn < 4; ++pn) { const float* pp = pst_tile(a.ws, grow >> 8, pn) + (size_t)(grow & 255) * 40;
#pragma unroll
                    for (int i = 0; i < 5; ++i) { const int n = part + 8 * i; pv[pn][i] = pp[(n < 36) ? n : 0]; }
                    pv[pn][5] = pp[36]; }
                const float ssum = ((pv[0][5] + pv[1][5]) + pv[2][5]) + pv[3][5];
                const float rstd = rsqrtf(ssum * (1.f / 1024.f) + RMS_EPS);
                if (part == 0) RS[row] = rstd;
#pragma unroll
                for (int i = 0; i < 5; ++i) { const int n = part + 8 * i; if (n < 36) LG[row * 36 + n] = rstd * (((pv[0][i] + pv[1][i]) + pv[2][i]) + pv[3][i]) + rbias[b * 48 + n]; }
            }
        }
        __syncthreads();
        if (tid < 64) {
            const int r = tid; const size_t row = (size_t)tile * 64 + r;
            float lg[36];
#pragma unroll
            for (int q = 0; q < 36; ++q) lg[q] = LG[r * 36 + q];
            int gs = 0; float gm = lg[0];
#pragma unroll
            for (int q = 1; q < 4; ++q) if (lg[q] > gm) { gm = lg[q]; gs = q; }
            float se = 0.f;
#pragma unroll
            for (int q = 0; q < 4; ++q) se += __expf(lg[q] - gm);
            const float pg = 1.f / se;
            float le[8];
#pragma unroll
            for (int q = 0; q < 8; ++q) { float vsel = lg[4 + q];
#pragma unroll
                for (int gg = 1; gg < 4; ++gg) vsel = (gs == gg) ? lg[4 + 8 * gg + q] : vsel;
                le[q] = vsel; }
            int e0 = 0; float l0 = le[0];
#pragma unroll
            for (int q = 1; q < 8; ++q) if (le[q] > l0) { l0 = le[q]; e0 = q; }
            int e1 = -1; float l1 = -3.0e38f;
#pragma unroll
            for (int q = 0; q < 8; ++q) if (q != e0 && le[q] > l1) { l1 = le[q]; e1 = q; }
            const float rr = __expf(l1 - l0), w0 = pg / (1.f + rr), w1 = pg * rr / (1.f + rr);
#pragma unroll
            for (int sl = 0; sl < 2; ++sl) { const int e = gs * 8 + (sl ? e1 : e0); const float w = sl ? w1 : w0;
#if NAIVE_MASK
                toke[row * 2 + sl] = e; tokw[row * 2 + sl] = w;
#endif
                const unsigned lp = __hip_atomic_fetch_add(lcnt + e, 1u, __ATOMIC_RELAXED, __HIP_MEMORY_SCOPE_WORKGROUP);
                lent[r * 2 + sl] = (unsigned)e | (lp << 8); lwt[r * 2 + sl] = w; }
        }
        __syncthreads();
        if (tid < 32 && !(a.flags & 2)) { const unsigned n = lcnt[tid]; lbase[tid] = n ? atomicAdd(cnt + 16 * tid, n) : 0u; }
        {
            float sc[4][4], sh[4][4];
#pragma unroll
            for (int j = 0; j < 4; ++j) { const int k = 256 * j + 4 * lane; const f32x4 gv = *(const f32x4*)(g2 + k), sv = *(const f32x4*)(mod + b * 6144 + 4096 + k), hv = *(const f32x4*)(mod + b * 6144 + 3072 + k);
#pragma unroll
                for (int i = 0; i < 4; ++i) { sc[j][i] = gv[i] * (1.f + sv[i]); sh[j][i] = hv[i]; } }
            f32x4 nx[4];
#pragma unroll
            for (int j = 0; j < 4; ++j) nx[j] = unpack4(*(const v2u*)(x1 + ((size_t)tile * 64 + wave) * 2048 + 256 * j + 4 * lane));
#pragma unroll 1
            for (int r = wave; r < 64; r += NWAVES) {
                const size_t row = (size_t)tile * 64 + r; f32x4 v[4];
#pragma unroll
                for (int j = 0; j < 4; ++j) v[j] = nx[j];
                if (r + NWAVES < 64) {
#pragma unroll
                    for (int j = 0; j < 4; ++j) nx[j] = unpack4(*(const v2u*)(x1 + (row + NWAVES) * 2048 + 256 * j + 4 * lane)); }
                asm volatile("" ::: "memory");
                const float rstd = RS[r];
#pragma unroll
                for (int j = 0; j < 4; ++j) { v2u o; o.x = pk2(v[j][0] * rstd * sc[j][0] + sh[j][0], v[j][1] * rstd * sc[j][1] + sh[j][1]); o.y = pk2(v[j][2] * rstd * sc[j][2] + sh[j][2], v[j][3] * rstd * sc[j][3] + sh[j][3]);
                    *(v2u*)(h2 + row * 1024 + 256 * j + 4 * lane) = o; }
            }
        }
        __syncthreads();
        if (tid < 128 && !(a.flags & 2)) { const unsigned en = lent[tid]; const unsigned e = en & 255u, lp = en >> 8; const unsigned pos = lbase[e] + lp;
            listt[e * 16384 + pos] = (tile * 64 + (tid >> 1)) * 2 + (tid & 1); listw[e * 16384 + pos] = lwt[tid]; }
    }
    __syncthreads();
}
DEV void p8_convert(const Args& a, LAS unsigned char* lds, const XDeal& X, int i0 = 0, int i1 = 1 << 30) {
    int tid = threadIdx.x; asm volatile("" : "+v"(tid));
    const int lane = tid & 63, wave = __builtin_amdgcn_readfirstlane(tid >> 6);
    LAS float* scr = (LAS float*)(lds + wave * 16384);
    const float* wg = a.in[22]; const float* wu = a.in[23]; const float* wd = a.in[24];
    bf16* WGU = (bf16*)(a.ws + WS_WGU); bf16* WD = (bf16*)(a.ws + WS_WD);
    for (int i = i0; i < i1; ++i) {
        const int g = X.item(i, 384); if (g < 0) break;
        const int b = g / 384, w = (g - b * 384) * 8 + wave;
        if (w < 2048) { const int q = w >> 9; int r = w & 511; const int e = (q == 0) ? b : (q == 1) ? 8 + b : 14 + 2 * b + q;
            const int up = r >> 8; r &= 255; const int kb = r >> 4, nb = r & 15, n = 32 * nb, np = 256 * (n >> 7) + 128 * up + (n & 127);
            transpose_item((up ? wu : wg) + (size_t)e * 1024 * 512 + (size_t)(64 * kb) * 512 + n, 512, WGU + ((size_t)e * 1024 + np) * 1024 + 64 * kb, 1024, scr, lane); }
        else { const int w2 = w - 2048; const int e = 4 * b + (w2 >> 8), r = w2 & 255; const int kb = r >> 5, nb = r & 31;
            transpose_item(wd + (size_t)e * 512 * 1024 + (size_t)(64 * kb) * 1024 + 32 * nb, 1024, WD + ((size_t)e * 1024 + 32 * nb) * 512 + 64 * kb, 512, scr, lane); }
    }
}

struct MoeSched {
    static constexpr bool HOOKS = true;
    unsigned* tcnt; int down;
    const LAS int* tlist; const LAS int* rstart; const LAS int* ecnt; int ntl, nfl; XDeal X; unsigned bstride;
    DEV bool next(int i, Unit& u) const {
        const int f0 = X.xr * nfl / X.nx, f1 = (X.xr + 1) * nfl / X.nx, nt = ntl - nfl;
        int t0 = X.xr * nt / X.nx, t1 = (X.xr + 1) * nt / X.nx;
        if (nt >= X.nx) { t0 = X.xr * ntl / X.nx - f0; t1 = (X.xr + 1) * ntl / X.nx - f1; }
        const int U = 4 * ((f1 - f0) + (t1 - t0));
        int j = i * X.nl + X.lr;
        if (down) { const int r = U % X.nl, nlt = X.nl - r, i3 = (X.lr >= r) ? i - 2 : i;
            j = (i3 < 0) ? i * nlt + (X.lr - r) : U - 1 - (i3 * X.nl + X.lr);
            if (i3 >= 0 && j < 2 * nlt) return false; }
        if (j >= U) return false;
        const int m = j >> 2;
        const int tl = (m < f1 - f0) ? f0 + m : nfl + t0 + (m - (f1 - f0));
        const int ent = tlist[tl]; const int e = ent & 255, rt = ent >> 8; u.pn = j & 3;
        const int left = ecnt[e] - 256 * rt;
        u.pm = 0; u.ak = 0; u.bk = (unsigned)e * bstride; u.slot = i; u.valid = left < 256 ? left : 256; u.arow0 = rstart[e] + 256 * rt; u.tl = tl; return true;
    }
    DEV void signal(const Unit& u, int lane) const { if (down) return; asm volatile("s_waitcnt vmcnt(0)" ::: "memory"); if (lane == 0) (void)xb_add(tcnt + 16 * u.tl, 1u); }
    DEV void wait(const Unit& u) const { if (!down) return; unsigned sp = 0u; while (xb_ld(tcnt + 16 * u.tl) < 32u) { __builtin_amdgcn_s_sleep(1); if (++sp > XB_SPIN_CAP) break; } }
};
DEV void moe_tables(const Args& a, LAS unsigned char* lds, const XDeal& X, MoeSched& S, bool down, bool reuse = false) {
    int tid = threadIdx.x; asm volatile("" : "+v"(tid));
    LAS int* ti = (LAS int*)(lds + LDS_MISC + 1024); LAS int* rstart = ti, *ecnt = ti + 40, *tlist = ti + 80, *ntl = ti + 260;
    const unsigned* cnt = (const unsigned*)(a.ws + WS_CTL) + CW_CNT;
    const int* listt = (const int*)(a.ws + WS_LISTT); const float* listw = (const float*)(a.ws + WS_LISTW);
    __syncthreads();
    if (tid < 64 && !reuse) {
        const int lane = tid; const int n = (lane < 32) ? (int)__hip_atomic_load(cnt + 16 * (lane & 31), __ATOMIC_RELAXED, __HIP_MEMORY_SCOPE_AGENT) : 0;
        const int ntile = (n + 255) >> 8, nfull = (n + 127) >> 8, ntail = ntile - nfull;
        const int rs = (int)wave_scan_add((float)n, lane) - n, of = (int)wave_scan_add((float)nfull, lane) - nfull, ot = (int)wave_scan_add((float)ntail, lane) - ntail;
        const int totf = (int)rdlane(wave_scan_add((float)nfull, lane), 63), tott = (int)rdlane(wave_scan_add((float)ntail, lane), 63);
        if (lane < 32) { ecnt[lane] = n; rstart[lane] = rs;
            for (int rt = 0; rt < nfull; ++rt) tlist[of + rt] = lane | (rt << 8);
            if (ntail) tlist[totf + ot] = lane | (nfull << 8); }
        if (lane == 32) rstart[32] = rs;
        if (lane == 0) { ntl[0] = totf + tott; ntl[1] = totf; }
    }
    __syncthreads();
    S.tlist = tlist; S.rstart = rstart; S.ecnt = ecnt; S.ntl = ntl[0]; S.nfl = ntl[1]; S.X = X; S.tcnt = (unsigned*)(a.ws + WS_CTL) + CW_TILE; S.down = down ? 1 : 0;
    LAS unsigned* tab0 = (LAS unsigned*)(lds + LDS_TAB); LAS float* tab1 = (LAS float*)(lds + LDS_TAB + 8192);
    const int half = __builtin_amdgcn_readfirstlane(tid >> 8), row = tid & 255;
    int tkv[4], okv[4]; float wv[4];
#pragma unroll
    for (int s = 0; s < 4; ++s) { Unit u; okv[s] = 0; tkv[s] = 0; wv[s] = 0.f;
        if (S.next(2 * s + half, u)) { okv[s] = 1; const int e = (int)(u.bk / S.bstride); const int pos = (u.arow0 - rstart[e]) + row;
            if (row < u.valid) { okv[s] = 2; tkv[s] = listt[e * 16384 + pos]; wv[s] = listw[e * 16384 + pos]; } } }
#pragma unroll
    for (int s = 0; s < 4; ++s) if (okv[s]) { const int i = 2 * s + half; unsigned v0 = 0u; float v1 = 0.f;
        if (okv[s] == 2) { const int tk = tkv[s]; v0 = down ? (unsigned)(tk & 1) * (unsigned)((WS_YS1 - WS_YS0) / 2) + (unsigned)(tk >> 1) * 1024u : (unsigned)(tk >> 1) * 2048u; v1 = wv[s]; }
        tab0[i * 256 + row] = v0; tab1[i * 256 + row] = v1; }
    __syncthreads();
}

DEV void p11_final(const Args& a, int bid, int G) {
    int tid = threadIdx.x; asm volatile("" : "+v"(tid));
    const int lane = tid & 63, wave = __builtin_amdgcn_readfirstlane(tid >> 6);
    const float* mod = (const float*)(a.ws + WS_MOD); const bf16* ys0 = (const bf16*)(a.ws + WS_YS0); const bf16* ys1 = (const bf16*)(a.ws + WS_YS1); const float* gf = a.in[25]; float* out = a.out;
    float* outw = (a.flags & 65536) ? (float*)(a.ws + WS_WGU) : a.out;
    for (int tile = bid; tile < T / 64; tile += G) {
        const int b = tile / 32;
        f32x4 nx[4], gtv[4], gfv[4]; v2u ny0[4], ny1[4];
#pragma unroll
        for (int j = 0; j < 4; ++j) { const int k = 256 * j + 4 * lane; gtv[j] = *(const f32x4*)(mod + b * 6144 + 5120 + k); gfv[j] = *(const f32x4*)(gf + k); }
#pragma unroll
        for (int j = 0; j < 4; ++j) { const size_t row = (size_t)tile * 64 + wave; const int k = 256 * j + 4 * lane;
            nx[j] = unpack4(*(const v2u*)((const bf16*)out + row * 2048 + k)); ny0[j] = *(const v2u*)(ys0 + row * 1024 + k); ny1[j] = *(const v2u*)(ys1 + row * 1024 + k); }
#pragma unroll 1
        for (int r = wave; r < 64; r += NWAVES) {
            const size_t row = (size_t)tile * 64 + r;
            f32x4 v[4]; float ss = 0.f;
#pragma unroll
            for (int j = 0; j < 4; ++j) { const int k = 256 * j + 4 * lane;
                const f32x4 xv = nx[j], gt = gtv[j]; const v2u y0 = ny0[j], y1 = ny1[j];
                v[j][0] = xv[0] + gt[0] * (bflo(y0.x) + bflo(y1.x)); v[j][1] = xv[1] + gt[1] * (bfhi(y0.x) + bfhi(y1.x));
                v[j][2] = xv[2] + gt[2] * (bflo(y0.y) + bflo(y1.y)); v[j][3] = xv[3] + gt[3] * (bfhi(y0.y) + bfhi(y1.y));
                ss += (v[j][0] * v[j][0] + v[j][1] * v[j][1]) + (v[j][2] * v[j][2] + v[j][3] * v[j][3]); }
            if (r + NWAVES < 64) {
#pragma unroll
                for (int j = 0; j < 4; ++j) { const size_t rn = row + NWAVES; const int k = 256 * j + 4 * lane;
                    nx[j] = unpack4(*(const v2u*)((const bf16*)out + rn * 2048 + k)); ny0[j] = *(const v2u*)(ys0 + rn * 1024 + k); ny1[j] = *(const v2u*)(ys1 + rn * 1024 + k); } }
            asm volatile("" ::: "memory");
            const float rstd = rsqrtf(wave_sum(ss) * (1.f / 1024.f) + RMS_EPS);
#pragma unroll
            for (int j = 0; j < 4; ++j) { const int k = 256 * j + 4 * lane; *(f32x4*)(outw + row * 1024 + k) = v[j] * rstd * gfv[j]; }
        }
    }
}

struct Epi3 {
    static constexpr bool PERM = true;
    const float* x; const float* mod; float* out; const v4u* rw; unsigned char* ws; LAS unsigned char* lds; int fuse;
    DEV bool keep(const Unit&) const { return false; }
    DEV void operator()(f32x4 (&acc)[2][2][4][2], const Unit& u, int wr, int wc, int fr, int fq) const {
        const int row0 = u.pm * 256 + wr * 64 + fr, c0 = u.pn * 256 + wc * 32 + 8 * fq; const int b = u.pm >> 3;
        const int lane = fq * 16 + fr, tid = (wr * 4 + wc) * 64 + lane;
        LAS v4u* FR = (LAS v4u*)lds;
        LAS float* PT = (LAS float*)(lds + 49152);
        LAS float* SP = (LAS float*)(lds + LDS_TAB);
#define E3_SYNC() do { asm volatile("s_waitcnt lgkmcnt(0)" ::: "memory"); __builtin_amdgcn_s_barrier(); asm volatile("" ::: "memory"); } while (0)
        f32x4 gt[2][2];
#pragma unroll
        for (int bj = 0; bj < 2; ++bj)
#pragma unroll
            for (int n = 0; n < 2; ++n) gt[bj][n] = *(const f32x4*)(mod + b * 6144 + 2048 + c0 + 128 * bj + 4 * n);
        if (fuse) {
            asm volatile("s_waitcnt vmcnt(0)" ::: "memory"); E3_SYNC();
            const int bjs = wr;
#pragma unroll
            for (int nt = 0; nt < 3; ++nt)
#pragma unroll
                for (int hl = 0; hl < 2; ++hl) { const size_t it = ((size_t)(b * 8 + 2 * u.pn + bjs) * 4 + wc) * 3 + nt;
                    FR[((((wc * 2 + bjs) * 3 + nt) * 2) + hl) * 64 + lane] = rw[(it * 2 + hl) * 64 + lane]; }
            E3_SYNC();
        }
#pragma unroll
        for (int ai = 0; ai < 2; ++ai) {
#pragma unroll
            for (int m = 0; m < 4; ++m) { const size_t ro = (size_t)(row0 + ai * 128 + m * 16) * 1024 + c0;
                f32x4 lacc[3]; float ssl = 0.f;
#pragma unroll
                for (int nt = 0; nt < 3; ++nt) lacc[nt] = (f32x4){0.f, 0.f, 0.f, 0.f};
#pragma unroll
                for (int bj = 0; bj < 2; ++bj) { f32x4 xo[2];
#pragma unroll
                    for (int n = 0; n < 2; ++n) { const f32x4 xv = *(const f32x4*)(x + ro + 128 * bj + 4 * n); xo[n] = xv + gt[bj][n] * acc[ai][bj][m][n]; }
                    *(v4u*)((bf16*)out + 2 * (ro - c0) + c0 + 128 * bj) = pack8(xo[0], xo[1]);
                    if (fuse) {
                        ssl += (xo[0][0] * xo[0][0] + xo[0][1] * xo[0][1]) + (xo[0][2] * xo[0][2] + xo[0][3] * xo[0][3]) + (xo[1][0] * xo[1][0] + xo[1][1] * xo[1][1]) + (xo[1][2] * xo[1][2] + xo[1][3] * xo[1][3]);
                        bf16x8 ahi, alo; split8(xo[0], xo[1], ahi, alo);
#pragma unroll
                        for (int nt = 0; nt < 3; ++nt) { const LAS v4u* fp = FR + (((wc * 2 + bj) * 3 + nt) * 2) * 64 + lane;
                            const bf16x8 bhi = __builtin_bit_cast(bf16x8, fp[0]), blo = __builtin_bit_cast(bf16x8, fp[64]);
                            lacc[nt] = mma16(ahi, bhi, lacc[nt]); lacc[nt] = mma16(alo, bhi, lacc[nt]); lacc[nt] = mma16(ahi, blo, lacc[nt]); }
                    }
                }
                if (fuse) {
                    ssl += __shfl_xor(ssl, 16); ssl += __shfl_xor(ssl, 32);
                    const int rl = 64 * wr + 16 * m;
                    if (fq == 0) SP[wc * 128 + rl + fr] = ssl;
#pragma unroll
                    for (int nt = 0; nt < 3; ++nt)
#pragma unroll
                        for (int r = 0; r < 4; ++r) { const int n = 16 * nt + fr; if (n < 40) PT[(wc * 128 + rl + 4 * fq + r) * 40 + n] = lacc[nt][r]; }
                    asm volatile("" ::: "memory");
                }
            }
            if (fuse) {
                E3_SYNC();
                { const int row = tid >> 2, part = tid & 3; float* dst = pst_tile(ws, u.pm, u.pn) + (size_t)(128 * ai + row) * 40;
#pragma unroll
                    for (int i = 0; i < 10; ++i) { const int n = part + 4 * i;
                        float sv;
                        if (n < 36) sv = ((PT[(0 * 128 + row) * 40 + n] + PT[(1 * 128 + row) * 40 + n]) + PT[(2 * 128 + row) * 40 + n]) + PT[(3 * 128 + row) * 40 + n];
                        else sv = ((SP[row] + SP[128 + row]) + SP[256 + row]) + SP[384 + row];
                        if (n <= 36) dst[n] = sv; } }
                E3_SYNC();
            }
        }
#undef E3_SYNC
    }
};
struct XOrder { static constexpr bool HOOKS = false; XDeal X; int nN;
    DEV bool tile(int i, int& pm, int& pn) const { const int per = 8 * nN; const int it = X.item(i, per); if (it < 0) return false;
        const int b = it / per, w = it - b * per; const int r = w >> 5, s = w & 31; pn = 4 * r + (s & 3); pm = 8 * b + (s >> 2); return true; }
    DEV bool next(int i, Unit& u) const { u.ak = 0; u.bk = 0; u.slot = 0; u.valid = 256; u.arow0 = 0; return tile(i, u.pm, u.pn); }
};
struct Sched2 { static constexpr bool HOOKS = false; XOrder xo; DEV bool next(int i, Unit& u) const { u.ak = (unsigned)(i & 1) * 1024u; u.bk = u.ak; u.slot = i & 1; u.valid = 256; u.arow0 = 0; return xo.tile(i >> 1, u.pm, u.pn); } };
#if DBG_GATEFIRST
struct SchedG { static constexpr bool HOOKS = false; pg8::StaticOrder so; DEV bool next(int i, Unit& u) const { if (i >= 2) return false; return so.next(i + 3, u); } };
#endif
constexpr int NPHASE = 11;
template <int LO, int HI>
__global__ void __launch_bounds__(NTHREADS, 2) mk_fwd(Args a) {
    extern __shared__ __attribute__((aligned(16))) unsigned char lds_raw[];
    LAS unsigned char* lds = (LAS unsigned char*)lds_raw;
    const int tid = threadIdx.x, G = gridDim.x, bid = blockIdx.x;
    volatile LAS unsigned* MISC = (volatile LAS unsigned*)(lds + LDS_MISC);
    if (tid < 64) MISC[tid] = 0u;
    __syncthreads();
#if MK_ONE
#if USE_XCD_BARRIER
    XcdBarrier bar = xcd_barrier_post((unsigned*)(a.ws + WS_CTL) + CW_BAR, MISC + 8);
#define GRID_BAR() xcd_barrier(bar)
#define LOCAL_BAR(n) xcd_local_barrier<n>(bar, (unsigned*)(a.ws + WS_CTL) + CW_LBAR)
#define LOCAL_ARRIVE() xcd_local_arrive(bar, (unsigned*)(a.ws + WS_CTL) + CW_LBAR)
#define LOCAL_WAIT(n) xcd_local_wait<n>(bar, (unsigned*)(a.ws + WS_CTL) + CW_LBAR)
#define GROUP_BAR(n) xcd_group_barrier<n>(bar, (unsigned*)(a.ws + WS_CTL) + CW_GBAR, grp)
#define QUAD_BAR() xcd_quad_barrier(bar, (unsigned*)(a.ws + WS_CTL) + CW_QBAR, X.lr >> 2)
#define LOCAL_BAR_P0(n) xcd_local_barrier<n, true>(bar, (unsigned*)(a.ws + WS_CTL) + CW_LBAR, (unsigned*)(a.ws + WS_CTL) + CW_P0DONE)
#else
    unsigned fgen = 0;
#define GRID_BAR() flat_barrier((unsigned*)(a.ws + WS_CTL) + CW_FLATBAR, fgen)
#define LOCAL_BAR(n) GRID_BAR()
#define LOCAL_ARRIVE() do {} while (0)
#define LOCAL_WAIT(n) GRID_BAR()
#define GROUP_BAR(n) GRID_BAR()
#define QUAD_BAR() GRID_BAR()
#define LOCAL_BAR_P0(n) GRID_BAR()
#endif
#else
#define GRID_BAR() do {} while (0)
#define LOCAL_BAR(n) do {} while (0)
#define LOCAL_ARRIVE() do {} while (0)
#define LOCAL_WAIT(n) do {} while (0)
#define GROUP_BAR(n) do {} while (0)
#define QUAD_BAR() do {} while (0)
#define LOCAL_BAR_P0(n) do {} while (0)
#endif
    constexpr int lo = LO, hi = HI;
#define IN(k) (lo <= (k) && (k) < hi)
#define BOTH(k) (IN(k) && IN((k) + 1))
    if constexpr (IN(0)) { REPK(0) { p0_prologue(a, lds, bid, G); REPSYNC(); } if constexpr (BOTH(0)) __syncthreads(); }
    XDeal X{0, 1, bid, G};
#if MK_ONE && USE_XCD_BARRIER
    if constexpr (BOTH(0)) {
        if (tid == 0) { unsigned nloc, nx, xr; xcd_barrier_complete(bar.bar, bar.x, nloc, nx, xr); MISC[8] = nloc; MISC[9] = nx; MISC[13] = xr; }
        __syncthreads();
        X.nl = __builtin_amdgcn_readfirstlane((int)MISC[8]); X.nx = __builtin_amdgcn_readfirstlane((int)MISC[9]); X.lr = __builtin_amdgcn_readfirstlane((int)MISC[12]); X.xr = __builtin_amdgcn_readfirstlane((int)MISC[13]); }
#endif
    if constexpr (IN(1)) { REPK(1) { P1_FN(a, lds, bid, G, X); REPSYNC(); } if constexpr (BOTH(1)) LOCAL_BAR_P0(1); }
    const bool gm = (MK_ONE != 0) && (USE_XCD_BARRIER != 0) && BOTH(0) && X.nl == 32 && X.nx == 8;
    const int grp = (X.lr >> 2) & 1;
    constexpr int NPRE = DBG_NPRE;
    int fuse3; { XOrder S3{X, 4}; Unit tu; fuse3 = S3.next(1, tu) ? 0 : 1; }
    if constexpr (IN(2)) {
        __syncthreads();
        ProbPlain P{(const bf16*)(a.ws + WS_H), (const bf16*)(a.ws + WS_W1T), 2048u, 2048u};
#if DBG_GATEFIRST
        SchedG S; S.so.init(T, 5120, G, bid);
#else
        XOrder S{X, 20};
#endif
        Epi1 E{(bf16*)(a.ws + WS_ZU), (bf16*)(a.ws + WS_ZGA), (a.flags >> 8) & 15};
        REPK(2) pg8::gemm_phase<ProbPlain, Epi1, decltype(S), true>(lds, P, S, E, 1024);
        if constexpr (BOTH(2)) LOCAL_BAR(2);
    }
    if constexpr (IN(3)) {
        REPK(3) { for (int i = 0;; ++i) { const int u = X.item(i, 32); if (u < 0) break; mlstm_unit<false>(a, lds, u); }
        __syncthreads(); }
        if constexpr (BOTH(3)) LOCAL_ARRIVE();
        REPK(11) { p3_conva(a, lds, X); REPSYNC(); }
        if constexpr (BOTH(3)) LOCAL_WAIT(3);
    }
    if constexpr (IN(4)) {
        REPK(4) { for (int i = 0;; ++i) { const int u = X.item(i, 32); if (u < 0) break; mlstm_unit<true>(a, lds, u); } REPSYNC(); }
        if constexpr (BOTH(4)) LOCAL_BAR(4);
    }
    if constexpr (IN(5)) {
        __syncthreads();
        Sched2 S;
        S.xo.X = X; S.xo.nN = 4;
        ProbPlain P{(const bf16*)(a.ws + WS_UAHM), (const bf16*)(a.ws + WS_W2T), 2048u, 2048u};
        Epi2 E{(const bf16*)(a.ws + WS_ZGA), (const bf16*)(a.ws + WS_ZGB), (bf16*)(a.ws + WS_MERGED)};
        REPK(5) pg8::gemm_phase<ProbPlain, Epi2, Sched2, true>(lds, P, S, E, 512);
        if constexpr (BOTH(5)) LOCAL_BAR(5);
    }
    if constexpr (IN(6)) {
        if (gm && grp == 1 && !(a.flags & 4)) p8_convert(a, lds, X, 0, NPRE);
        __syncthreads();
        ProbPlain P{(const bf16*)(a.ws + WS_MERGED), (const bf16*)(a.ws + WS_W3T), 2048u, 2048u};
        XOrder S{X, 4};
        Epi3 E{a.in[0], (const float*)(a.ws + WS_MOD), a.out, (const v4u*)(a.ws + WS_RW), a.ws, lds, fuse3};
        REPK(6) pg8::gemm_phase<ProbPlain, Epi3, XOrder, true>(lds, P, S, E, 1024);
        if constexpr (BOTH(6)) { if (gm) QUAD_BAR(); else LOCAL_BAR(6); for (int xb = 0; xb < DBG_XBAR; ++xb) GRID_BAR(); }
    }
    if constexpr (IN(7)) {
        if (gm) {
            if (!(a.flags & 1)) p8_route(a, lds, X, fuse3);
            __syncthreads();
            if (!(a.flags & 4)) p8_convert(a, lds, X, grp == 1 ? NPRE : 0);
        } else if (X.lr & 1) {
            if (!(a.flags & 4)) { p8_convert(a, lds, X); }
            __syncthreads();
            if (!(a.flags & 1)) p8_route(a, lds, X, fuse3);
        } else {
            if (!(a.flags & 1)) p8_route(a, lds, X, fuse3);
            __syncthreads();
            if (!(a.flags & 4)) { p8_convert(a, lds, X); }
        }
        if constexpr (BOTH(7)) GRID_BAR();
    }
    if constexpr (IN(8)) {
        MoeSched S; S.bstride = 1024u * 1024u * 2u;
        moe_tables(a, lds, X, S, false);
        ProbMoeUp P{(const bf16*)(a.ws + WS_H), (const bf16*)(a.ws + WS_WGU), (const LAS unsigned*)(lds + LDS_TAB)};
        EpiUp E{(bf16*)(a.ws + WS_ACT)};
        REPK(8) pg8::gemm_phase<ProbMoeUp, EpiUp, MoeSched, true, true>(lds, P, S, E, 1024);
    }
    if constexpr (IN(9)) {
        MoeSched S; S.bstride = 1024u * 512u * 2u;
        moe_tables(a, lds, X, S, true, BOTH(8));
        ProbMoeDown P{(const bf16*)(a.ws + WS_ACT), (const bf16*)(a.ws + WS_WD)};
        EpiDown E{(bf16*)(a.ws + WS_YS0), (const LAS unsigned*)(lds + LDS_TAB), (const LAS float*)(lds + LDS_TAB + 8192)};
        REPK(9) pg8::gemm_phase<ProbMoeDown, EpiDown, MoeSched, true, true>(lds, P, S, E, 512);
        if constexpr (BOTH(9)) GRID_BAR();
    }
    if constexpr (IN(10)) { p11_final(a, bid, G); }
#undef IN
#undef BOTH
}

#if NAIVE_MASK
__global__ __launch_bounds__(256) void k_fixw1t(const float* w_in, bf16* W1T) { const size_t i = (size_t)blockIdx.x * 256 + threadIdx.x; const size_t n = i / 1024, k = i % 1024; W1T[(3072 + n) * 1024 + k] = f2bf(w_in[k * 5128 + 3080 + n]); }
DEV float block_sum256(float v, float* red) {
#pragma unroll
    for (int o = 32; o >= 1; o >>= 1) v += __shfl_xor(v, o);
    __syncthreads();
    if ((threadIdx.x & 63) == 0) red[threadIdx.x >> 6] = v;
    __syncthreads();
    return (red[0] + red[1]) + (red[2] + red[3]);
}
__global__ __launch_bounds__(256) void k_mod(const float* c, const float* w_ada, const float* b_ada, float* mod) {
    const int idx = blockIdx.x * 256 + threadIdx.x; const int b = idx / 6144, n = idx % 6144;
    float acc = 0.f;
    for (int k = 0; k < D; ++k) acc += siluf_(c[b * D + k]) * w_ada[(size_t)k * 6144 + n];
    mod[idx] = acc + b_ada[n];
}
__global__ __launch_bounds__(256) void k_h1(const float* x, const float* g1, const float* mod, const float* w_in, const float* b_if, bf16* h1, float* gates) {
    __shared__ float red[4];
    const int t = blockIdx.x, b = t / SEQ, tid = threadIdx.x;
    const float4 xv = ((const float4*)(x + (size_t)t * D))[tid];
    float ss = xv.x * xv.x + xv.y * xv.y + xv.z * xv.z + xv.w * xv.w;
    ss = block_sum256(ss, red);
    const float rstd = rsqrtf(ss * (1.f / D) + RMS_EPS);
    const float* sh = mod + b * 6144, *sc = mod + b * 6144 + 1024;
    float hv[4]; const float xs[4] = {xv.x, xv.y, xv.z, xv.w};
#pragma unroll
    for (int j = 0; j < 4; ++j) { const int k = tid * 4 + j; hv[j] = xs[j] * rstd * g1[k] * (1.f + sc[k]) + sh[k]; }
    ushort4 o; o.x = f2bf(hv[0]); o.y = f2bf(hv[1]); o.z = f2bf(hv[2]); o.w = f2bf(hv[3]);
    ((ushort4*)(h1 + (size_t)t * D))[tid] = o;
    float g[8];
#pragma unroll
    for (int j = 0; j < 8; ++j) g[j] = 0.f;
#pragma unroll
    for (int i = 0; i < 4; ++i) { const float* wr = w_in + (size_t)(tid * 4 + i) * DIN + 3072;
#pragma unroll
        for (int j = 0; j < 8; ++j) g[j] += hv[i] * wr[j]; }
#pragma unroll
    for (int j = 0; j < 8; ++j) g[j] = block_sum256(g[j], red);
    if (tid < 8) { float v = g[0];
#pragma unroll
        for (int j = 1; j < 8; ++j) v = (tid == j) ? g[j] : v;
        v += b_if[tid];
        gates[(size_t)t * 8 + tid] = (tid < 4) ? v : logsigmoidf_(v); }
}
template <class Epi>
__global__ __launch_bounds__(256) void k_ngemm(const bf16* A, int lda, const float* W, int ldw, int N, int K, Epi epi) {
    __shared__ float As[16][68]; __shared__ float Ws[16][68];
    const int tid = threadIdx.x, tx = tid & 15, ty = tid >> 4;
    const int row0 = blockIdx.y * 64, col0 = blockIdx.x * 64;
    float acc[4][4];
#pragma unroll
    for (int i = 0; i < 4; ++i)
#pragma unroll
        for (int j = 0; j < 4; ++j) acc[i][j] = 0.f;
    const int ar = tid >> 2, ak = (tid & 3) * 4;
    const int wk = tid >> 4, wc = (tid & 15) * 4;
    for (int k0 = 0; k0 < K; k0 += 16) {
        const ushort4 av = *(const ushort4*)(A + (size_t)(row0 + ar) * lda + k0 + ak);
        As[ak + 0][ar] = bf2f(av.x); As[ak + 1][ar] = bf2f(av.y); As[ak + 2][ar] = bf2f(av.z); As[ak + 3][ar] = bf2f(av.w);
#pragma unroll
        for (int j = 0; j < 4; ++j) { const int cc = col0 + wc + j; Ws[wk][wc + j] = (cc < N) ? W[(size_t)(k0 + wk) * ldw + cc] : 0.f; }
        __syncthreads();
#pragma unroll
        for (int kk = 0; kk < 16; ++kk) {
            float av2[4], w[4];
#pragma unroll
            for (int i = 0; i < 4; ++i) av2[i] = As[kk][ty * 4 + i];
#pragma unroll
            for (int j = 0; j < 4; ++j) w[j] = Ws[kk][tx * 4 + j];
#pragma unroll
            for (int i = 0; i < 4; ++i)
#pragma unroll
                for (int j = 0; j < 4; ++j) acc[i][j] += av2[i] * w[j];
        }
        __syncthreads();
    }
#pragma unroll
    for (int i = 0; i < 4; ++i)
#pragma unroll
        for (int j = 0; j < 4; ++j) { const int cc = col0 + tx * 4 + j; if (cc < N) epi(row0 + ty * 4 + i, cc, acc[i][j]); }
}
struct NEpi1 {
    float* tmp; bf16 *zq, *zk, *zv, *zo, *zga, *zgb;
    DEV void operator()(int r, int c, float v) const {
        if (c < 1024) tmp[(size_t)r * 1024 + c] = v;
        else if (c < 1536) zq[(size_t)r * 512 + c - 1024] = f2bf(v);
        else if (c < 2048) zk[(size_t)r * 512 + c - 1536] = f2bf(v);
        else if (c < 2560) zv[(size_t)r * 512 + c - 2048] = f2bf(v);
        else if (c < 3072) zo[(size_t)r * 512 + c - 2560] = f2bf(sigmoidf_(v));
        else if (c < 3080) {}
        else if (c < 4104) zga[(size_t)r * 1024 + c - 3080] = f2bf(sigmoidf_(v));
        else zgb[(size_t)r * 1024 + c - 4104] = f2bf(sigmoidf_(v));
    }
};
struct NEpi2a { float* tmp; const bf16* zga; DEV void operator()(int r, int c, float v) const { tmp[(size_t)r * 1024 + c] = v * bf2f(zga[(size_t)r * 1024 + c]); } };
struct NEpi2b { const float* tmp; const bf16* zgb; bf16* merged; DEV void operator()(int r, int c, float v) const { merged[(size_t)r * 1024 + c] = f2bf(tmp[(size_t)r * 1024 + c] + v * bf2f(zgb[(size_t)r * 1024 + c])); } };
struct NEpi3 { const float* x; const float* mod; float* out; DEV void operator()(int r, int c, float v) const { const int b = r / SEQ; out[(size_t)r * 1024 + c] = x[(size_t)r * 1024 + c] + mod[b * 6144 + 2048 + c] * v; } };
__global__ __launch_bounds__(256) void k_glu(const float* tmp, bf16* zu) {
    const size_t i = (size_t)blockIdx.x * 256 + threadIdx.x; const size_t r = i / 512, c = i % 512;
    zu[i] = f2bf(tmp[r * 1024 + c] * sigmoidf_(tmp[r * 1024 + 512 + c]));
}
__global__ __launch_bounds__(256) void k_conva(const bf16* zu, const float* cw, const float* cb, const float* lg, const float* lb, bf16* uahm) {
    __shared__ float red[4];
    const int t = blockIdx.x, s = t % SEQ, tid = threadIdx.x;
    float v[2];
#pragma unroll
    for (int j = 0; j < 2; ++j) { const int c = tid + 256 * j; float a = cb[c];
        for (int k = 0; k < 31; ++k) { const int ss = s - 30 + k; if (ss >= 0) a += cw[k * 512 + c] * bf2f(zu[(size_t)(t - 30 + k) * 512 + c]); }
        v[j] = a; }
    const float mean = block_sum256(v[0] + v[1], red) * (1.f / 512.f);
    const float d0 = v[0] - mean, d1 = v[1] - mean;
    const float var = block_sum256(d0 * d0 + d1 * d1, red) * (1.f / 512.f);
    const float rstd = rsqrtf(var + LN_EPS);
#pragma unroll
    for (int j = 0; j < 2; ++j) { const int c = tid + 256 * j; const float y = (v[j] - mean) * rstd * lg[c] + lb[c]; uahm[(size_t)t * 1024 + c] = f2bf(siluf_(y)); }
}
__global__ __launch_bounds__(256) void k_qkconv(const bf16* zq, const bf16* zk, const float* w, const float* bq, bf16* qc, bf16* kc) {
    const int t = blockIdx.x, s = t % SEQ, tid = threadIdx.x;
#pragma unroll
    for (int j = 0; j < 4; ++j) { const int c = tid + 256 * j; const bf16* src = (c < 512) ? zq : zk; const int cc = c & 511; float a = bq[c];
#pragma unroll
        for (int k = 0; k < 4; ++k) { const int ss = s - 3 + k; if (ss >= 0) a += w[k * 1024 + c] * bf2f(src[(size_t)(t - 3 + k) * 512 + cc]); }
        ((c < 512) ? qc : kc)[(size_t)t * 512 + cc] = f2bf(siluf_(a)); }
}
__global__ __launch_bounds__(256) void k_mlstm_rec(const bf16* qc, const bf16* kc, const bf16* zv, const bf16* zo, const float* gates, const float* mng, bf16* uahm) {
    __shared__ float qs[128], ks[128], vs[128], part[2][128], red[8];
    const int b = blockIdx.x / NH, h = blockIdx.x % NH, tid = threadIdx.x, j = tid & 127, ih = tid >> 7;
    float C[64];
#pragma unroll
    for (int r = 0; r < 64; ++r) C[r] = 0.f;
    float nn = 0.f, m = 0.f;
    for (int s = 0; s < SEQ; ++s) {
        const size_t t = (size_t)b * SEQ + s;
        __syncthreads();
        if (tid < 128) { qs[tid] = bf2f(qc[t * 512 + h * 128 + tid]) * 0.08838834764831845f; ks[tid] = bf2f(kc[t * 512 + h * 128 + tid]); }
        else vs[tid - 128] = bf2f(zv[t * 512 + h * 128 + tid - 128]);
        const float li = gates[t * 8 + h], lf = gates[t * 8 + 4 + h];
        const float mn = fmaxf(lf + m, li), ip = __expf(li - mn), fp = __expf(lf + m - mn); m = mn;
        __syncthreads();
        const float vj = vs[j]; float p = 0.f;
#pragma unroll
        for (int r = 0; r < 64; ++r) { const int i = ih * 64 + r; C[r] = fp * C[r] + ip * ks[i] * vj; p += qs[i] * C[r]; }
        part[ih][j] = p;
        float dn = 0.f;
        if (tid < 128) { nn = fp * nn + ip * ks[tid]; dn = qs[tid] * nn; }
#pragma unroll
        for (int o = 32; o >= 1; o >>= 1) dn += __shfl_xor(dn, o);
        if ((tid & 63) == 0) red[tid >> 6] = dn;
        __syncthreads();
        float hv = 0.f, sm = 0.f;
        if (tid < 128) { const float den = red[0] + red[1]; hv = (part[0][tid] + part[1][tid]) / fmaxf(fabsf(den), __expf(-mn)); sm = hv; }
#pragma unroll
        for (int o = 32; o >= 1; o >>= 1) sm += __shfl_xor(sm, o);
        if ((tid & 63) == 0) red[4 + (tid >> 6)] = sm;
        __syncthreads();
        const float mu = (red[4] + red[5]) * (1.f / 128.f);
        float dv = (tid < 128) ? (hv - mu) : 0.f; float sq = dv * dv;
#pragma unroll
        for (int o = 32; o >= 1; o >>= 1) sq += __shfl_xor(sq, o);
        __syncthreads();
        if ((tid & 63) == 0) red[tid >> 6] = sq;
        __syncthreads();
        if (tid < 128) { const float var = (red[0] + red[1]) * (1.f / 128.f); const float y = dv * rsqrtf(var + LN_EPS) * mng[h * 128 + tid] * bf2f(zo[t * 512 + h * 128 + tid]);
            uahm[t * 1024 + 512 + h * 128 + tid] = f2bf(y); }
    }
}
__global__ __launch_bounds__(256) void k_h2route(const float* x1, const float* g2, const float* mod, const float* w_rg, const float* b_rg, const float* w_re, const float* b_re, bf16* h2, int* toke, float* tokw) {
    __shared__ float red[4]; __shared__ float lg[36];
    const int t = blockIdx.x, b = t / SEQ, tid = threadIdx.x;
    const float4 xv = ((const float4*)(x1 + (size_t)t * D))[tid];
    float ss = xv.x * xv.x + xv.y * xv.y + xv.z * xv.z + xv.w * xv.w;
    ss = block_sum256(ss, red);
    const float rstd = rsqrtf(ss * (1.f / D) + RMS_EPS);
    const float* sh = mod + b * 6144 + 3072, *sc = mod + b * 6144 + 4096;
    float hv[4]; const float xs[4] = {xv.x, xv.y, xv.z, xv.w};
#pragma unroll
    for (int j = 0; j < 4; ++j) { const int k = tid * 4 + j; hv[j] = xs[j] * rstd * g2[k] * (1.f + sc[k]) + sh[k]; }
    ushort4 o; o.x = f2bf(hv[0]); o.y = f2bf(hv[1]); o.z = f2bf(hv[2]); o.w = f2bf(hv[3]);
    ((ushort4*)(h2 + (size_t)t * D))[tid] = o;
    for (int j = 0; j < 36; ++j) {
        float a = 0.f;
#pragma unroll
        for (int i = 0; i < 4; ++i) { const int k = tid * 4 + i; a += hv[i] * ((j < 4) ? w_rg[k * 4 + j] : w_re[k * 32 + j - 4]); }
        a = block_sum256(a, red);
        if (tid == 0) lg[j] = a + ((j < 4) ? b_rg[j] : b_re[j - 4]);
    }
    __syncthreads();
    if (tid == 0) {
        int gs = 0; float gm = lg[0];
        for (int j = 1; j < 4; ++j) if (lg[j] > gm) { gm = lg[j]; gs = j; }
        float se = 0.f; for (int j = 0; j < 4; ++j) se += __expf(lg[j] - gm);
        const float pg = 1.f / se;
        const float* le = lg + 4 + gs * 8;
        int e0 = 0; float l0 = le[0];
        for (int j = 1; j < 8; ++j) if (le[j] > l0) { l0 = le[j]; e0 = j; }
        int e1 = -1; float l1 = -3.0e38f;
        for (int j = 0; j < 8; ++j) if (j != e0 && le[j] > l1) { l1 = le[j]; e1 = j; }
        const float r = __expf(l1 - l0);
        const float w0 = pg / (1.f + r), w1 = pg * r / (1.f + r);
        toke[t * 2] = gs * 8 + e0; toke[t * 2 + 1] = gs * 8 + e1; tokw[t * 2] = w0; tokw[t * 2 + 1] = w1;
    }
}
__global__ __launch_bounds__(256) void k_lists(const int* toke, const float* tokw, unsigned* cnt, int* listt, float* listw) {
    const int i = blockIdx.x * 256 + threadIdx.x; const int e = toke[i]; const unsigned pos = atomicAdd(cnt + 16 * e, 1u);
    listt[e * 16384 + pos] = i; listw[e * 16384 + pos] = tokw[i];
}
__global__ __launch_bounds__(256) void k_moe(const bf16* h2, const int* toke, const float* tokw, const float* wg, const float* wu, const float* wd, bf16* ys) {
    __shared__ float hs[1024]; __shared__ float hid[512];
    const int a = blockIdx.x, t = a >> 1, tid = threadIdx.x;
    const int e = toke[a]; const float w = tokw[a];
    for (int k = tid; k < 1024; k += 256) hs[k] = bf2f(h2[(size_t)t * 1024 + k]);
    __syncthreads();
    const float* Gp = wg + (size_t)e * 1024 * 512, *U = wu + (size_t)e * 1024 * 512, *Dn = wd + (size_t)e * 512 * 1024;
    float g0 = 0.f, g1 = 0.f, u0 = 0.f, u1 = 0.f;
    for (int k = 0; k < 1024; ++k) { const float hk = hs[k]; g0 += hk * Gp[(size_t)k * 512 + tid]; g1 += hk * Gp[(size_t)k * 512 + 256 + tid]; u0 += hk * U[(size_t)k * 512 + tid]; u1 += hk * U[(size_t)k * 512 + 256 + tid]; }
    hid[tid] = siluf_(g0) * u0; hid[tid + 256] = siluf_(g1) * u1;
    __syncthreads();
    float y[4] = {0.f, 0.f, 0.f, 0.f};
    for (int j = 0; j < 512; ++j) { const float hj = hid[j];
#pragma unroll
        for (int i = 0; i < 4; ++i) y[i] += hj * Dn[(size_t)j * 1024 + tid + 256 * i]; }
#pragma unroll
    for (int i = 0; i < 4; ++i) ys[(size_t)a * 1024 + tid + 256 * i] = f2bf(w * y[i]);
}
__global__ __launch_bounds__(256) void k_final(const float* x1, const bf16* ys, const float* mod, const float* gf, float* out) {
    __shared__ float red[4];
    const int t = blockIdx.x, b = t / SEQ, tid = threadIdx.x;
    const float4 xv = ((const float4*)(x1 + (size_t)t * D))[tid];
    const ushort4 y0 = ((const ushort4*)(ys + (size_t)t * 2048))[tid], y1 = ((const ushort4*)(ys + (size_t)t * 2048 + 1024))[tid];
    const float* gt = mod + b * 6144 + 5120 + tid * 4;
    float v[4];
    v[0] = xv.x + gt[0] * (bf2f(y0.x) + bf2f(y1.x)); v[1] = xv.y + gt[1] * (bf2f(y0.y) + bf2f(y1.y));
    v[2] = xv.z + gt[2] * (bf2f(y0.z) + bf2f(y1.z)); v[3] = xv.w + gt[3] * (bf2f(y0.w) + bf2f(y1.w));
    float ss = v[0] * v[0] + v[1] * v[1] + v[2] * v[2] + v[3] * v[3];
    ss = block_sum256(ss, red);
    const float rstd = rsqrtf(ss * (1.f / D) + RMS_EPS);
    float4 o; o.x = v[0] * rstd * gf[tid * 4]; o.y = v[1] * rstd * gf[tid * 4 + 1]; o.z = v[2] * rstd * gf[tid * 4 + 2]; o.w = v[3] * rstd * gf[tid * 4 + 3];
    ((float4*)(out + (size_t)t * D))[tid] = o;
}
#endif


#ifndef DBG_BENCH
#define DBG_BENCH 0
#endif
#if DBG_BENCH
__global__ void __launch_bounds__(512, 2) k_bench_a(const float* x, float* dummy) {
    extern __shared__ __attribute__((aligned(16))) unsigned char lds_b[];
    const int tid = threadIdx.x, lane = tid & 63, wave = tid >> 6, tile = blockIdx.x;
    f32x4 nx[4][4]; float acc = 0.f;
#pragma unroll
    for (int p = 0; p < 4; ++p)
#pragma unroll
        for (int j = 0; j < 4; ++j) nx[p][j] = *(const f32x4*)(x + ((size_t)tile * 64 + wave + 8 * p) * 1024 + 256 * j + 4 * lane);
#pragma unroll
    for (int r8 = 0; r8 < 8; ++r8) {
        const size_t row = (size_t)tile * 64 + wave + 8 * r8;
#pragma unroll
        for (int j = 0; j < 4; ++j) acc += (nx[r8 & 3][j][0] + nx[r8 & 3][j][1]) + (nx[r8 & 3][j][2] + nx[r8 & 3][j][3]);
        if (r8 + 4 < 8) {
#pragma unroll
            for (int j = 0; j < 4; ++j) nx[r8 & 3][j] = *(const f32x4*)(x + (row + 32) * 1024 + 256 * j + 4 * lane); }
    }
    if (acc == 123.456f) dummy[tid] = acc;
}
__global__ void __launch_bounds__(256) k_bench_b(const float* x, float* dummy) {
    const int tid = threadIdx.x, lane = tid & 63, wave = tid >> 6; const size_t row = (size_t)blockIdx.x * 4 + wave; float acc = 0.f;
#pragma unroll
    for (int j = 0; j < 4; ++j) { const f32x4 v = *(const f32x4*)(x + row * 1024 + 256 * j + 4 * lane); acc += (v[0] + v[1]) + (v[2] + v[3]); }
    if (acc == 123.456f) dummy[tid] = acc;
}
#endif
#if DBG_BENCH >= 4
template <int LVL>
__global__ void __launch_bounds__(512, 2) k_bench_d(const float* x, const float* g1, const float* mod, bf16* h1, float* dummy) {
    extern __shared__ __attribute__((aligned(16))) unsigned char lds_b[];
    const int tid = threadIdx.x, lane = tid & 63, wave = tid >> 6, tile = blockIdx.x, b = tile / 32;
    float sc[4][4], sh[4][4];
#pragma unroll
    for (int j = 0; j < 4; ++j) { const int k = 256 * j + 4 * lane; const f32x4 gv = *(const f32x4*)(g1 + k), sv = *(const f32x4*)(mod + b * 6144 + 1024 + k), hv = *(const f32x4*)(mod + b * 6144 + k);
#pragma unroll
        for (int i = 0; i < 4; ++i) { sc[j][i] = gv[i] * (1.f + sv[i]); sh[j][i] = hv[i]; } }
    f32x4 nx[4][4];
#pragma unroll
    for (int p = 0; p < 4; ++p)
#pragma unroll
        for (int j = 0; j < 4; ++j) nx[p][j] = *(const f32x4*)(x + ((size_t)tile * 64 + wave + 8 * p) * 1024 + 256 * j + 4 * lane);
#pragma unroll
    for (int r8 = 0; r8 < 8; ++r8) {
        const size_t row = (size_t)tile * 64 + wave + 8 * r8;
        f32x4 v[4]; float ss = 0.f;
#pragma unroll
        for (int j = 0; j < 4; ++j) { v[j] = nx[r8 & 3][j]; ss += (v[j][0] * v[j][0] + v[j][1] * v[j][1]) + (v[j][2] * v[j][2] + v[j][3] * v[j][3]); }
        if (r8 + 4 < 8) {
#pragma unroll
            for (int j = 0; j < 4; ++j) nx[r8 & 3][j] = *(const f32x4*)(x + (row + 32) * 1024 + 256 * j + 4 * lane); }
        asm volatile("" ::: "memory");
        const float rstd = rsqrtf(wave_sum(ss) * (1.f / 1024.f) + RMS_EPS);
        if (LVL >= 5) {
            float g[8];
#pragma unroll
            for (int q = 0; q < 8; ++q) g[q] = 0.f;
#pragma unroll
            for (int j = 0; j < 4; ++j) { float hh[4];
#pragma unroll
                for (int i = 0; i < 4; ++i) hh[i] = v[j][i] * rstd * sc[j][i] + sh[j][i];
                v2u o; o.x = pk2(hh[0], hh[1]); o.y = pk2(hh[2], hh[3]);
                *(v2u*)(h1 + row * 1024 + 256 * j + 4 * lane) = o;
                if (LVL >= 6) {
#pragma unroll
                    for (int i = 0; i < 4; ++i) { const LAS float* tp = (const LAS float*)lds_b + ((4 * j + i) * 64 + lane) * 8; f32x4 w0, w1;
                        if (LVL == 8) { w0 = (f32x4){1.f, 2.f, 3.f, 4.f}; w1 = (f32x4){5.f, 6.f, 7.f, 8.f}; } else { w0 = *(const LAS f32x4*)tp; w1 = *(const LAS f32x4*)(tp + 4); }
                        g[0] += hh[i] * w0[0]; g[1] += hh[i] * w0[1]; g[2] += hh[i] * w0[2]; g[3] += hh[i] * w0[3]; g[4] += hh[i] * w1[0]; g[5] += hh[i] * w1[1]; g[6] += hh[i] * w1[2]; g[7] += hh[i] * w1[3]; } } }
            if (LVL == 6 || LVL == 8) { const float t = ((g[0] + g[1]) + (g[2] + g[3])) + ((g[4] + g[5]) + (g[6] + g[7])); if (t == 123.456f) dummy[row] = t; }
            if (LVL == 7) { float mine = 0.f;
#pragma unroll
                for (int q = 0; q < 8; ++q) { const float sq = wave_sum(g[q]); mine = (lane == q) ? sq : mine; }
                if (lane < 8) dummy[row * 8 + lane] = (lane < 4) ? mine : logsigmoidf_(mine); }
        } else if (lane == 0) dummy[row] = rstd;
    }
}
#endif
#if DBG_BENCH == 3
__global__ void __launch_bounds__(512, 2) k_bench_c(float* dummy, float seed) {
    extern __shared__ __attribute__((aligned(16))) unsigned char lds_b[];
    float a0 = seed + threadIdx.x, a1 = a0 + 1.f, a2 = a0 + 2.f, a3 = a0 + 3.f; const float m = 1.0000001f, c = 1e-9f;
#pragma unroll 1
    for (int i = 0; i < 2048; ++i) {
#pragma unroll
        for (int j = 0; j < 4; ++j) { a0 = a0 * m + c; a1 = a1 * m + c; a2 = a2 * m + c; a3 = a3 * m + c; }
    }
    if (a0 + a1 + a2 + a3 == 123.456f) dummy[threadIdx.x] = a0;
}
#endif
#if MK_ONE
constexpr int NKERN = 1;
static const void* const mk_kernels[NKERN] = {(const void*)mk_fwd<0, NPHASE>};
#else
constexpr int NKERN = NPHASE;
static const void* const mk_kernels[NKERN] = {(const void*)mk_fwd<0, 1>, (const void*)mk_fwd<1, 2>, (const void*)mk_fwd<2, 3>, (const void*)mk_fwd<3, 4>, (const void*)mk_fwd<4, 5>, (const void*)mk_fwd<5, 6>,
    (const void*)mk_fwd<6, 7>, (const void*)mk_fwd<7, 8>, (const void*)mk_fwd<8, 9>, (const void*)mk_fwd<9, 10>, (const void*)mk_fwd<10, 11>};
#endif
extern "C" void kernel_launch(void* const* d_in, const int* in_sizes, int n_in, void* d_out, int out_size, void* d_ws, size_t ws_size, hipStream_t stream) {
    static int grid = 0;
    if (grid == 0) {
        int dev = 0, cus = 0;
        if (hipGetDevice(&dev) != hipSuccess || hipDeviceGetAttribute(&cus, hipDeviceAttributeMultiprocessorCount, dev) != hipSuccess) { grid = -1; return; }
        for (int k = 0; k < NKERN; ++k) if (hipFuncSetAttribute(mk_kernels[k], hipFuncAttributeMaxDynamicSharedMemorySize, LDS_BYTES) != hipSuccess) { grid = -1; return; }
        int per_cu = 0;
        (void)hipOccupancyMaxActiveBlocksPerMultiprocessor(&per_cu, mk_kernels[0], NTHREADS, LDS_BYTES);
        (void)hipGetLastError();
        grid = (per_cu >= 1) ? cus : -1;
    }
    if (grid < 0) return;
    (void)hipMemsetAsync((char*)d_ws + WS_CTL, 0, CTL_ZERO_BYTES, stream);
    Args a{};
    for (int i = 0; i < 26; ++i) a.in[i] = (const float*)d_in[i];
    a.out = (float*)d_out; a.ws = (unsigned char*)d_ws;
#if MK_ONE
    a.ph_lo = 0; a.ph_hi = NPHASE;
    { void* args[] = {&a}; (void)hipLaunchKernel(mk_kernels[0], dim3(grid), dim3(NTHREADS), args, LDS_BYTES, stream); }
#else
    unsigned char* ws = (unsigned char*)d_ws; float* out = (float*)d_out;
    float* mod = (float*)(ws + WS_MOD); float* gates = (float*)(ws + WS_GATES); int* toke = (int*)(ws + WS_TOKE); float* tokw = (float*)(ws + WS_TOKW);
    bf16* hb = (bf16*)(ws + WS_H); bf16* zu = (bf16*)(ws + WS_ZU); bf16* zq = (bf16*)(ws + WS_ZQ); bf16* zk = (bf16*)(ws + WS_ZK); bf16* zv = (bf16*)(ws + WS_ZV); bf16* zo = (bf16*)(ws + WS_ZO);
    bf16* zga = (bf16*)(ws + WS_ZGA); bf16* zgb = (bf16*)(ws + WS_ZGB); bf16* qc = (bf16*)(ws + WS_QC); bf16* kc = (bf16*)(ws + WS_KC); bf16* uahm = (bf16*)(ws + WS_UAHM);
    bf16* merged = (bf16*)(ws + WS_MERGED); bf16* ys = (bf16*)(ws + WS_YS);
    (void)mod; (void)gates; (void)toke; (void)tokw; (void)hb; (void)zu; (void)zq; (void)zk; (void)zv; (void)zo; (void)zga; (void)zgb; (void)qc; (void)kc; (void)uahm; (void)merged; (void)ys; (void)out;
#ifndef DBG_NPH
#define DBG_NPH NPHASE
#endif
#if DBG_BENCH == 1
    { static bool once = false; if (!once) { (void)hipFuncSetAttribute((const void*)k_bench_a, hipFuncAttributeMaxDynamicSharedMemorySize, LDS_BYTES); once = true; }
      for (int rep = 0; rep < 4; ++rep) hipLaunchKernelGGL(k_bench_a, dim3(256), dim3(512), LDS_BYTES, stream, (const float*)d_in[0], (float*)((char*)d_ws + WS_TOKE)); }
#elif DBG_BENCH >= 4
    { static bool once = false; if (!once) { (void)hipFuncSetAttribute((const void*)k_bench_d<DBG_BENCH>, hipFuncAttributeMaxDynamicSharedMemorySize, LDS_BYTES); once = true; }
      (void)hipMemsetAsync((char*)d_ws + WS_MOD, 0, 256 * 1024, stream);
      for (int rep = 0; rep < 2; ++rep) hipLaunchKernelGGL(k_bench_d<DBG_BENCH>, dim3(256), dim3(512), LDS_BYTES, stream, (const float*)d_in[0], (const float*)d_in[4], (const float*)((char*)d_ws + WS_MOD), (bf16*)((char*)d_ws + WS_H), (float*)((char*)d_ws + WS_TOKE)); }
#elif DBG_BENCH == 3
    { static bool once = false; if (!once) { (void)hipFuncSetAttribute((const void*)k_bench_c, hipFuncAttributeMaxDynamicSharedMemorySize, LDS_BYTES); once = true; }
      for (int rep = 0; rep < 2; ++rep) hipLaunchKernelGGL(k_bench_c, dim3(256), dim3(512), LDS_BYTES, stream, (float*)((char*)d_ws + WS_TOKE), 1.0f); }
#elif DBG_BENCH == 2
    for (int rep = 0; rep < 4; ++rep) hipLaunchKernelGGL(k_bench_b, dim3(4096), dim3(256), 0, stream, (const float*)d_in[0], (float*)((char*)d_ws + WS_TOKE));
#endif
    for (int ph = 0; ph < DBG_NPH; ++ph) {
        a.ph_lo = ph; a.ph_hi = ph + 1; a.flags = 0;
        bool mk = true;
#if NAIVE_MASK
        const float* const* I = (const float* const*)d_in;
        if ((NAIVE_MASK >> ph) & 1) {
            mk = false;
            switch (ph) {
            case 0: k_mod<<<8 * 6144 / 256, 256, 0, stream>>>(I[1], I[2], I[3], mod); mk = true; break;
            case 1: k_h1<<<T, 256, 0, stream>>>(I[0], I[4], mod, I[5], I[6], hb, gates); break;
            case 2: k_ngemm<NEpi1><<<dim3((DIN + 63) / 64, T / 64), 256, 0, stream>>>(hb, 1024, I[5], DIN, DIN, 1024, NEpi1{out, zq, zk, zv, zo, zga, zgb});
                    k_glu<<<T * 512 / 256, 256, 0, stream>>>(out, zu); a.flags = (DBG_CLS) << 8; mk = (DBG_CLS) != 0;
                    k_fixw1t<<<2048 * 1024 / 256, 256, 0, stream>>>(I[5], (bf16*)(ws + WS_W1T)); break;
            case 3: k_conva<<<T, 256, 0, stream>>>(zu, I[7], I[8], I[9], I[10], uahm); mk = ((NAIVE_MASK >> 4) & 1) ? false : true; break;
            case 4: k_qkconv<<<T, 256, 0, stream>>>(zq, zk, I[12], I[13], qc, kc);
                    k_mlstm_rec<<<BATCH * NH, 256, 0, stream>>>(qc, kc, zv, zo, gates, I[14], uahm); break;
            case 5: k_ngemm<NEpi2a><<<dim3(16, T / 64), 256, 0, stream>>>(uahm, 1024, I[11], 1024, 1024, 512, NEpi2a{out, zga});
                    k_ngemm<NEpi2b><<<dim3(16, T / 64), 256, 0, stream>>>(uahm + 512, 1024, I[15], 1024, 1024, 512, NEpi2b{out, zgb, merged}); break;
            case 6: k_ngemm<NEpi3><<<dim3(16, T / 64), 256, 0, stream>>>(merged, 1024, I[16], 1024, 1024, 1024, NEpi3{I[0], mod, out}); break;
            case 7: k_h2route<<<T, 256, 0, stream>>>(out, I[17], mod, I[18], I[19], I[20], I[21], hb, toke, tokw);
                    k_lists<<<T * 2 / 256, 256, 0, stream>>>(toke, tokw, (unsigned*)(ws + WS_CTL) + CW_CNT, (int*)(ws + WS_LISTT), (float*)(ws + WS_LISTW));
                    a.flags = 1; mk = true; break;
            case 8: break;
            case 9: k_moe<<<T * 2, 256, 0, stream>>>(hb, toke, tokw, I[22], I[23], I[24], (bf16*)(ws + WS_ZU)); break;
            case 10: k_final<<<T, 256, 0, stream>>>(out, (const bf16*)(ws + WS_ZU), mod, I[25], out); break;
            }
        }
#endif
        if (mk && ph == 10 && ((DBG_HREP >> 10) & 1)) { a.flags = 65536; void* args0[] = {&a}; (void)hipLaunchKernel(mk_kernels[ph], dim3(grid), dim3(NTHREADS), args0, LDS_BYTES, stream); a.flags = 0; }
        if (mk) { void* args[] = {&a}; (void)hipLaunchKernel(mk_kernels[ph], dim3(grid), dim3(NTHREADS), args, LDS_BYTES, stream);
            if (((DBG_HREP >> ph) & 1) && ph != 10) { if (ph == 7) a.flags |= DBG_F7; if (ph == 1) a.flags |= DBG_F1; if (ph == 4) a.flags |= DBG_F4; (void)hipLaunchKernel(mk_kernels[ph], dim3(grid), dim3(NTHREADS), args, LDS_BYTES, stream); } }
    }
#endif
}
```
